# Optimizing an MI355X kernel written in HIP

```python
import math
import jax, jax.numpy as jnp
from jax import lax
import numpy as np

D_MODEL = 1024
BATCH = 4
SEQ = 8192
DEPTH = 2
DEC_BATCH = 16
DEC_SEQ = 4096
PAST_LEN = 128

HEAD_DIM = 64
GW = D_MODEL // 4
N_HEADS = GW // HEAD_DIM
MLA_Q_RANK = D_MODEL // 4
MLA_KV_RANK = D_MODEL // 8
MLA_NOPE_DIM = HEAD_DIM
MLA_ROPE_DIM = HEAD_DIM // 2
MLA_V_DIM = HEAD_DIM
ROPE_BASE = 10000.0
ATTN_BLOCK = 128
GRID_W = 64
NA_KH_MAX = 8
NA_KW = 16
NA_QROWS = 2
NA_QCOL = 16
NA_KCOL = 32
HG_CHUNK = 32
RW_W_RANK = 64
RW_A_RANK = 64
RW_G_RANK = 128
RW_DECAY_SCALE = math.exp(-0.5)
RW_GN_EPS = 64e-5
N_EXPERTS = 16
D_EXPERT = 512
CAPACITY = 2
D_PLE = 256
ALPHA = (2 * DEPTH) ** 0.25
BETA = (8 * DEPTH) ** -0.25
A_COLS = MLA_Q_RANK + MLA_KV_RANK + MLA_ROPE_DIM
B_COLS = 3 * GW
C_COLS = 5 * GW
D_COLS = 3 * GW + 2 * RW_W_RANK + 2 * RW_A_RANK + RW_G_RANK
D_IN = A_COLS + B_COLS + C_COLS + D_COLS
F32 = jnp.float32

kernel_name = 'hybrid_bidir_mla_natten_hgrn2_rwkv7_ecmoe_encoder'


def _split(z, widths):
    return jnp.split(z, np.cumsum(widths)[:-1].tolist(), axis=-1)


def _rmsnorm(x, g, eps=1e-6):
    xf = x.astype(F32)
    y = xf * lax.rsqrt(jnp.mean(xf * xf, axis=-1, keepdims=True) + eps)
    return (y * g.astype(F32)).astype(x.dtype)


def _layernorm(x, g, b, eps=1e-5):
    xf = x.astype(F32)
    mu = jnp.mean(xf, axis=-1, keepdims=True)
    var = jnp.mean(jnp.square(xf - mu), axis=-1, keepdims=True)
    return ((xf - mu) * lax.rsqrt(var + eps) * g.astype(F32) + b.astype(F32)).astype(x.dtype)


def _rope(x, cos, sin):
    xf = x.astype(F32)
    x1, x2 = jnp.split(xf, 2, axis=-1)
    return jnp.concatenate([x1 * cos - x2 * sin, x1 * sin + x2 * cos], axis=-1).astype(x.dtype)


def _bidir(fwd, bwd):
    return jnp.stack([fwd, jnp.flip(bwd, axis=1)])


def _merge_dirs(o):
    return o[0] + jnp.flip(o[1], axis=1)


def _heads(t):
    return t.reshape(t.shape[:-1] + (N_HEADS, HEAD_DIM))


def _mla(zA, gq, gkv, wuq, wuk, wuv):
    B, N, _ = zA.shape
    cq, ckv, kr = _split(zA, (MLA_Q_RANK, MLA_KV_RANK, MLA_ROPE_DIM))
    q = (_rmsnorm(cq, gq) @ wuq).reshape(B, N, N_HEADS, MLA_NOPE_DIM + MLA_ROPE_DIM)
    q_nope, q_rope = q[..., :MLA_NOPE_DIM], q[..., MLA_NOPE_DIM:]
    ckv = _rmsnorm(ckv, gkv)
    k_nope = (ckv @ wuk).reshape(B, N, N_HEADS, MLA_NOPE_DIM)
    v = (ckv @ wuv).reshape(B, N, N_HEADS, MLA_V_DIM)
    inv_freq = ROPE_BASE ** (-jnp.arange(0, MLA_ROPE_DIM, 2, dtype=F32) / MLA_ROPE_DIM)
    ang = jnp.arange(N, dtype=F32)[:, None] * inv_freq[None, :]
    cos, sin = jnp.cos(ang), jnp.sin(ang)
    q_rope = _rope(q_rope, cos[:, None, :], sin[:, None, :])
    k_rope = _rope(kr, cos, sin)
    scale = (MLA_NOPE_DIM + MLA_ROPE_DIM) ** -0.5
    nb = N // ATTN_BLOCK
    qn = q_nope.reshape(B, nb, ATTN_BLOCK, N_HEADS, MLA_NOPE_DIM).transpose(1, 0, 2, 3, 4)
    qr = q_rope.reshape(B, nb, ATTN_BLOCK, N_HEADS, MLA_ROPE_DIM).transpose(1, 0, 2, 3, 4)

    def block(args):
        qn_b, qr_b = args
        s = (jnp.einsum('bqhd,bkhd->bhqk', qn_b, k_nope)
             + jnp.einsum('bqhr,bkr->bhqk', qr_b, k_rope)).astype(F32) * scale
        pr = jax.nn.softmax(s, axis=-1).astype(v.dtype)
        return jnp.einsum('bhqk,bkhd->bqhd', pr, v)

    o = lax.map(block, (qn, qr))
    return o.transpose(1, 0, 2, 3, 4).reshape(B, N, N_HEADS * MLA_V_DIM)


def _neighbourhood_attention(zB, bias):
    B, N, _ = zB.shape
    rows = N // GRID_W
    kh = min(NA_KH_MAX, rows)
    kbh = min(kh + NA_QROWS - 1, rows)
    n_rb = rows // NA_QROWS
    n_cb = GRID_W // NA_QCOL
    q, k, v = _split(zB, (GW, GW, GW))
    grid = lambda t: t.reshape(B, rows, GRID_W, N_HEADS, HEAD_DIM)
    q = grid(q * (HEAD_DIM ** -0.5)).reshape(B, rows, n_cb, NA_QCOL, N_HEADS, HEAD_DIM)
    qcol = np.arange(n_cb)[:, None] * NA_QCOL + np.arange(NA_QCOL)[None, :]
    kstart = np.clip(np.arange(n_cb) * NA_QCOL - NA_KW // 2, 0, GRID_W - NA_KCOL)
    kcol = kstart[:, None] + np.arange(NA_KCOL)[None, :]
    k = grid(k)[:, :, kcol]
    v = grid(v)[:, :, kcol]
    cstart = np.clip(qcol - NA_KW // 2, 0, GRID_W - NA_KW)
    col_ok = (kcol[:, None, :] >= cstart[..., None]) & (kcol[:, None, :] < cstart[..., None] + NA_KW)
    dcol = np.clip(kcol[:, None, :] - qcol[..., None] + NA_KW - 1, 0, 2 * NA_KW - 2)

    def row_block(rb):
        qrow = rb * NA_QROWS + jnp.arange(NA_QROWS)
        rstart = jnp.clip(qrow - kh // 2, 0, rows - kh)
        k0 = jnp.clip(rstart[0], 0, rows - kbh)
        krow = k0 + jnp.arange(kbh)
        row_ok = (krow[None, :] >= rstart[:, None]) & (krow[None, :] < rstart[:, None] + kh)
        drow = jnp.clip(krow[None, :] - qrow[:, None] + NA_KH_MAX - 1, 0, 2 * NA_KH_MAX - 2)
        q_b = lax.dynamic_slice_in_dim(q, rb * NA_QROWS, NA_QROWS, axis=1)
        k_b = lax.dynamic_slice_in_dim(k, k0, kbh, axis=1)
        v_b = lax.dynamic_slice_in_dim(v, k0, kbh, axis=1)
        s = jnp.einsum('bicuhd,bjcwhd->bhciujw', q_b, k_b).astype(F32)
        s = s + bias[:, drow[None, :, None, :, None], dcol[:, None, :, None, :]].astype(F32)
        mask = row_ok[None, :, None, :, None] & col_ok[:, None, :, None, :]
        s = jnp.where(mask, s, -jnp.inf)
        pr = jax.nn.softmax(s.reshape(s.shape[:-2] + (kbh * NA_KCOL,)), axis=-1)
        pr = pr.reshape(s.shape).astype(v.dtype)
        return jnp.einsum('bhciujw,bjcwhd->bicuhd', pr, v_b)

    o = lax.map(row_block, jnp.arange(n_rb))
    return o.transpose(1, 0, 2, 3, 4, 5, 6).reshape(B, N, GW)


def _hgrn2(zC, lb, gnorm):
    B, N, _ = zC.shape
    L = HG_CHUNK
    nc = N // L
    zf = zC.astype(F32)
    q, f_fw, f_bw, i_in, g = _split(zf, (GW,) * 5)
    lb = lb.astype(F32)
    f_fw = lb[0] + (1.0 - lb[0]) * jax.nn.sigmoid(f_fw)
    f_bw = lb[1] + (1.0 - lb[1]) * jax.nn.sigmoid(f_bw)

    def chunked(t):
        return _heads(t).reshape(2, B, nc, L, N_HEADS, HEAD_DIM).transpose(2, 0, 1, 4, 3, 5)

    qs = chunked(_bidir(q, q))
    ks = chunked(_bidir(1.0 - f_fw, 1.0 - f_bw))
    vs = chunked(_bidir(i_in, i_in))
    gs = chunked(_bidir(jnp.log(f_fw), jnp.log(f_bw)))
    tri = np.tril(np.ones((L, L), dtype=bool))[:, :, None]

    def step(S, inp):
        qc, kc, vc, gc = inp
        b = jnp.cumsum(gc, axis=-2)
        o_inter = jnp.einsum('zbhtd,zbhdv->zbhtv', qc * jnp.exp(b), S)
        diff = b[..., :, None, :] - b[..., None, :, :]
        dec = jnp.exp(jnp.where(tri, diff, -jnp.inf))
        att = jnp.einsum('zbhtd,zbhsd,zbhtsd->zbhts', qc, kc, dec)
        o = o_inter + jnp.einsum('zbhts,zbhsv->zbhtv', att, vc)
        bl = b[..., -1:, :]
        S = (jnp.exp(bl)[..., 0, :, None] * S
             + jnp.einsum('zbhsd,zbhsv->zbhdv', kc * jnp.exp(bl - b), vc))
        return S, o

    S0 = jnp.zeros((2, B, N_HEADS, HEAD_DIM, HEAD_DIM), F32)
    _, o = lax.scan(step, S0, (qs, ks, vs, gs))
    o = o.transpose(1, 2, 0, 4, 3, 5).reshape(2, B, N, N_HEADS, HEAD_DIM)
    o = _rmsnorm(_merge_dirs(o), gnorm.reshape(N_HEADS, HEAD_DIM)).reshape(B, N, GW)
    return (o * jax.nn.silu(g)).astype(zC.dtype)


def _rwkv7(zD, mu, w0, w_up, a0, a_up, g_up, k_k, k_a, r_k, ln_w, ln_b):
    B, N, _ = zD.shape
    zf = zD.astype(F32)
    mu = mu.astype(F32)
    zp = jnp.pad(zf, ((0, 0), (1, 1), (0, 0)))
    zf = zf + mu[0] * (zp[:, :-2] - zf) + mu[1] * (zp[:, 2:] - zf)
    r, k, v, wdf, wdb, adf, adb, gd = _split(
        zf, (GW, GW, GW, RW_W_RANK, RW_W_RANK, RW_A_RANK, RW_A_RANK, RW_G_RANK))
    w0, w_up, a0, a_up = w0.astype(F32), w_up.astype(F32), a0.astype(F32), a_up.astype(F32)
    dec_f = jnp.exp(-RW_DECAY_SCALE * jax.nn.sigmoid(w0[0] + jnp.tanh(wdf) @ w_up[0]))
    dec_b = jnp.exp(-RW_DECAY_SCALE * jax.nn.sigmoid(w0[1] + jnp.tanh(wdb) @ w_up[1]))
    a_f = jax.nn.sigmoid(a0[0] + adf @ a_up[0])
    a_b = jax.nn.sigmoid(a0[1] + adb @ a_up[1])
    g = jax.nn.sigmoid(gd) @ g_up.astype(F32)
    r, k, v = _heads(r), _heads(k), _heads(v)
    dec_f, dec_b, a_f, a_b = _heads(dec_f), _heads(dec_b), _heads(a_f), _heads(a_b)
    kk = k * k_k.astype(F32).reshape(N_HEADS, HEAD_DIM)
    kk = kk / jnp.maximum(jnp.sqrt(jnp.sum(kk * kk, axis=-1, keepdims=True)), 1e-12)
    ka = k_a.astype(F32).reshape(N_HEADS, HEAD_DIM)
    kt_f = k * (1.0 + (a_f - 1.0) * ka)
    kt_b = k * (1.0 + (a_b - 1.0) * ka)
    tm = lambda t: t.transpose(2, 0, 1, 3, 4)
    xs = (tm(_bidir(r, r)), tm(_bidir(dec_f, dec_b)), tm(_bidir(kk, kk)),
          tm(_bidir(a_f, a_b)), tm(_bidir(kt_f, kt_b)), tm(_bidir(v, v)))

    def step(S, inp):
        r_t, w_t, kk_t, a_t, k_t, v_t = inp
        sa = jnp.einsum('zbhvk,zbhk->zbhv', S, -kk_t)
        S = (S * w_t[..., None, :] + sa[..., :, None] * (kk_t * a_t)[..., None, :]
             + v_t[..., :, None] * k_t[..., None, :])
        return S, jnp.einsum('zbhvk,zbhk->zbhv', S, r_t)

    S0 = jnp.zeros((2, B, N_HEADS, HEAD_DIM, HEAD_DIM), F32)
    _, o = lax.scan(step, S0, xs)
    o = _merge_dirs(o.transpose(1, 2, 0, 3, 4))
    o = _layernorm(o, ln_w.reshape(N_HEADS, HEAD_DIM), ln_b.reshape(N_HEADS, HEAD_DIM), RW_GN_EPS)
    bonus = jnp.sum(r * k * r_k.astype(F32).reshape(N_HEADS, HEAD_DIM), axis=-1, keepdims=True) * v
    return ((o + bonus).reshape(B, N, GW) * g).astype(zD.dtype)


def _expert_choice_ffn(x, w_router, w1, w3, w2):
    B, N, D = x.shape
    T = B * N
    xt = x.reshape(T, D)
    aff = jax.nn.softmax((xt @ w_router).astype(F32), axis=-1)
    cap = CAPACITY * T // N_EXPERTS
    gate, idx = lax.top_k(aff.T, cap)

    def body(y, e_in):
        w1e, w3e, w2e, ie, ge = e_in
        xe = xt[ie]
        he = jax.nn.silu(xe @ w1e) * (xe @ w3e)
        return y.at[ie].add((he @ w2e) * ge[:, None].astype(x.dtype)), None

    y, _ = lax.scan(body, jnp.zeros_like(xt), (w1, w3, w2, idx, gate))
    return y.reshape(B, N, D)


def _layer(x, p_i, i, lb_i, prm):
    z = x @ prm['w_in'][i]
    zA, zB, zC, zD = _split(z, (A_COLS, B_COLS, C_COLS, D_COLS))
    oA = _mla(zA, prm['mla_gq'][i], prm['mla_gkv'][i], prm['mla_wuq'][i],
              prm['mla_wuk'][i], prm['mla_wuv'][i])
    oB = _neighbourhood_attention(zB, prm['na_bias'][i])
    oC = _hgrn2(zC, lb_i, prm['hg_gnorm'][i])
    oD = _rwkv7(zD, prm['rw_mu'][i], prm['rw_w0'][i], prm['rw_w_up'][i], prm['rw_a0'][i],
                prm['rw_a_up'][i], prm['rw_g_up'][i], prm['rw_kk'][i], prm['rw_ka'][i],
                prm['rw_rk'][i], prm['rw_ln_w'][i], prm['rw_ln_b'][i])
    mix = jnp.concatenate([oA, oB, oC, oD], axis=-1) @ prm['w_out'][i]
    x = _layernorm(ALPHA * x + mix, prm['ln1_g'][i], prm['ln1_b'][i])
    u = ALPHA * x + _expert_choice_ffn(x, prm['moe_router'][i], prm['moe_w1'][i],
                                       prm['moe_w3'][i], prm['moe_w2'][i])
    ple = jax.nn.sigmoid(u @ prm['ple_gate'][i]) * (p_i @ prm['ple_proj'][i])
    return _layernorm(u + ple, prm['ln2_g'][i], prm['ln2_b'][i])


def _trunk(x, p, lb, prm):
    for i in range(DEPTH):
        x = _layer(x, p[i], i, lb[i], prm)
    return x


def setup_inputs(seed: int = 0) -> dict:
    key = jax.random.key(seed)
    ks = iter(jax.random.split(key, 64))

    def nrm(shape, scale):
        return jax.random.normal(next(ks), shape, F32) * scale

    def gain(shape):
        return 1.0 + nrm(shape, 0.02)

    L = DEPTH
    return {
        'x_prompt': nrm((BATCH, SEQ, D_MODEL), 1.0),
        'x_sample': nrm((DEC_BATCH, DEC_SEQ, D_MODEL), 1.0),
        'p_prompt': nrm((DEPTH, BATCH, SEQ, D_PLE), 1.0),
        'p_sample': nrm((DEPTH, DEC_BATCH, DEC_SEQ, D_PLE), 1.0),
        'w_in': nrm((L, D_MODEL, D_IN), D_MODEL ** -0.5),
        'mla_gq': gain((L, MLA_Q_RANK)),
        'mla_gkv': gain((L, MLA_KV_RANK)),
        'mla_wuq': nrm((L, MLA_Q_RANK, N_HEADS * (MLA_NOPE_DIM + MLA_ROPE_DIM)), MLA_Q_RANK ** -0.5),
        'mla_wuk': nrm((L, MLA_KV_RANK, N_HEADS * MLA_NOPE_DIM), MLA_KV_RANK ** -0.5),
        'mla_wuv': nrm((L, MLA_KV_RANK, N_HEADS * MLA_V_DIM), MLA_KV_RANK ** -0.5),
        'na_bias': nrm((L, N_HEADS, 2 * NA_KH_MAX - 1, 2 * NA_KW - 1), 0.1),
        'hg_lb': nrm((L, 2, GW), 0.1),
        'hg_gnorm': gain((L, GW)),
        'rw_mu': jax.random.uniform(next(ks), (L, 2, D_COLS), F32, 0.0, 0.5),
        'rw_w0': nrm((L, 2, GW), 0.5),
        'rw_w_up': nrm((L, 2, RW_W_RANK, GW), 0.5 * RW_W_RANK ** -0.5),
        'rw_a0': nrm((L, 2, GW), 0.5),
        'rw_a_up': nrm((L, 2, RW_A_RANK, GW), 0.5 * RW_A_RANK ** -0.5),
        'rw_g_up': nrm((L, RW_G_RANK, GW), RW_G_RANK ** -0.5),
        'rw_kk': 0.85 + nrm((L, GW), 0.02),
        'rw_ka': gain((L, GW)),
        'rw_rk': nrm((L, GW), 0.1),
        'rw_ln_w': gain((L, GW)),
        'rw_ln_b': nrm((L, GW), 0.02),
        'w_out': nrm((L, D_MODEL, D_MODEL), BETA * D_MODEL ** -0.5),
        'ln1_g': gain((L, D_MODEL)),
        'ln1_b': nrm((L, D_MODEL), 0.02),
        'moe_router': nrm((L, D_MODEL, N_EXPERTS), D_MODEL ** -0.5),
        'moe_w1': nrm((L, N_EXPERTS, D_MODEL, D_EXPERT), D_MODEL ** -0.5),
        'moe_w3': nrm((L, N_EXPERTS, D_MODEL, D_EXPERT), D_MODEL ** -0.5),
        'moe_w2': nrm((L, N_EXPERTS, D_EXPERT, D_MODEL), BETA * D_EXPERT ** -0.5),
        'ln2_g': gain((L, D_MODEL)),
        'ln2_b': nrm((L, D_MODEL), 0.02),
        'ple_gate': nrm((L, D_MODEL, D_MODEL), D_MODEL ** -0.5),
        'ple_proj': nrm((L, D_PLE, D_MODEL), BETA * D_PLE ** -0.5),
    }


def reference(x_prompt, x_sample, p_prompt, p_sample, w_in, mla_gq, mla_gkv, mla_wuq, mla_wuk,
              mla_wuv, na_bias, hg_lb, hg_gnorm, rw_mu, rw_w0, rw_w_up, rw_a0, rw_a_up, rw_g_up,
              rw_kk, rw_ka, rw_rk, rw_ln_w, rw_ln_b, w_out, ln1_g, ln1_b, moe_router, moe_w1,
              moe_w3, moe_w2, ln2_g, ln2_b, ple_gate, ple_proj):
    prm = dict(w_in=w_in, mla_gq=mla_gq, mla_gkv=mla_gkv, mla_wuq=mla_wuq, mla_wuk=mla_wuk,
               mla_wuv=mla_wuv, na_bias=na_bias, hg_gnorm=hg_gnorm, rw_mu=rw_mu, rw_w0=rw_w0,
               rw_w_up=rw_w_up, rw_a0=rw_a0, rw_a_up=rw_a_up, rw_g_up=rw_g_up, rw_kk=rw_kk,
               rw_ka=rw_ka, rw_rk=rw_rk, rw_ln_w=rw_ln_w, rw_ln_b=rw_ln_b, w_out=w_out,
               ln1_g=ln1_g, ln1_b=ln1_b, moe_router=moe_router, moe_w1=moe_w1, moe_w3=moe_w3,
               moe_w2=moe_w2, ln2_g=ln2_g, ln2_b=ln2_b, ple_gate=ple_gate, ple_proj=ple_proj)
    sm = jax.nn.softmax(hg_lb.astype(F32), axis=0)
    lb = jnp.cumsum(sm, axis=0) - sm[0]
    y_prompt = _trunk(x_prompt, p_prompt, lb, prm)
    y_sample = _trunk(x_sample, p_sample, lb, prm)
    return (y_prompt, y_sample)
```

```cpp
#include <hip/hip_runtime.h>
#include <hip/hip_cooperative_groups.h>
#include <cstdio>
#include <cmath>
#include <cstring>
namespace cg = cooperative_groups;

typedef unsigned short u16;
using bf16x8 = __attribute__((ext_vector_type(8))) short;
using f32x4 = __attribute__((ext_vector_type(4))) float;
using f32x16 = __attribute__((ext_vector_type(16))) float;

#define DI __device__ __forceinline__
#define NTHR 256
#define T_ALL 98304
#define T_SUB 32768
#define ZLD 3616
#define ZB_OFF 416
#define ZC_OFF 1184
#define ZD_OFF 2464
#define LOG2E 1.4426950408889634f
#define ALPHA_F 1.4142135623730951f

struct Params {
  const float *x_prompt, *x_sample, *p_prompt, *p_sample;
  const float *w_in, *mla_gq, *mla_gkv, *mla_wuq, *mla_wuk, *mla_wuv, *na_bias, *hg_lb, *hg_gnorm;
  const float *rw_mu, *rw_w0, *rw_w_up, *rw_a0, *rw_a_up, *rw_g_up, *rw_kk, *rw_ka, *rw_rk, *rw_ln_w, *rw_ln_b;
  const float *w_out, *ln1_g, *ln1_b, *moe_router, *moe_w1, *moe_w3, *moe_w2, *ln2_g, *ln2_b, *ple_gate, *ple_proj;
  float* out;
  u16 *w_in_t, *wuq_t, *wkv_t, *wup_t, *aup_t, *gup_t, *wout_t, *w13_t, *w2_t, *wg_t, *wp_t;
  float *ropec, *ropes, *lb, *affT, *gate;
  int* idx;
  u16 *z, *cat, *Q, *Kb, *Vt, *cqn, *ckvn, *S1, *rs, *ks, *vs, *kk, *gD, *dec, *kka, *kt, *oC, *oD;
  float* bonus;
  float* Y;
  u16* H;
  double inv_freq[16];
  int pb, pe;
};

DI u16 f2bf(float f) { unsigned u = __float_as_uint(f); u += 0x7fffu + ((u >> 16) & 1u); return (u16)(u >> 16); }
DI float bf2f(u16 h) { return __uint_as_float(((unsigned)h) << 16); }
DI unsigned pack2(float a, float b) { return (unsigned)f2bf(a) | ((unsigned)f2bf(b) << 16); }
DI float blo(unsigned u) { return __uint_as_float(u << 16); }
DI float bhi(unsigned u) { return __uint_as_float(u & 0xffff0000u); }
DI float sigm(float x) { return 1.f / (1.f + __expf(-x)); }
DI float tanh_(float x) { return 1.f - 2.f / (__expf(2.f * x) + 1.f); }
DI float ex2(float x) { return __builtin_amdgcn_exp2f(x); }
DI int clampi(int v, int lo, int hi) { return v < lo ? lo : (v > hi ? hi : v); }
DI int swap23(int x) { return (x & ~12) | ((x & 4) << 1) | ((x & 8) >> 1); }

template <int CTRL> DI float dpp_f(float v) {
  return __int_as_float(__builtin_amdgcn_update_dpp(0, __float_as_int(v), CTRL, 0xF, 0xF, true));
}
DI float reduce16(float v) {
  v += dpp_f<0xB1>(v);
  v += dpp_f<0x4E>(v);
  v += dpp_f<0x141>(v);
  v += dpp_f<0x140>(v);
  return v;
}
DI float wave_sum(float v) {
  v = reduce16(v);
  v += __shfl_xor(v, 16);
  v += __shfl_xor(v, 32);
  return v;
}

struct TileIter {
  int bid, nb, off;
  DI int first(int n) { int f = bid - off; if (f < 0) f += nb; off = (off + n) % nb; return f; }
};

DI void convT_job(const float* __restrict__ W, int K, int N, int Npad, u16* __restrict__ Wt, int mode, char* lds,
                  TileIter& it, int tid) {
  float(*tile)[65] = (float(*)[65])lds;
  int tk = K >> 6, tn = Npad >> 6;
  int nt = tk * tn;
  for (int t = it.first(nt); t < nt; t += it.nb) {
    int k0 = (t % tk) << 6, n0 = (t / tk) << 6;
#pragma unroll
    for (int i = 0; i < 16; i++) {
      int kl = (tid >> 6) + 4 * i, nl = tid & 63;
      int n = n0 + nl;
      tile[kl][nl] = (n < N) ? W[(size_t)(k0 + kl) * N + n] : 0.f;
    }
    __syncthreads();
    {
      int nl = tid >> 2, ks = (tid & 3) * 16;
      int n = n0 + nl;
      int row = n;
      if (mode == 1) row = (n >> 4) * 32 + (n & 15);
      if (mode == 2) row = (n >> 4) * 32 + 16 + (n & 15);
      unsigned pk[8];
#pragma unroll
      for (int j = 0; j < 8; j++) pk[j] = pack2(tile[ks + 2 * j][nl], tile[ks + 2 * j + 1][nl]);
      uint4* dst = (uint4*)(Wt + (size_t)row * K + k0 + ks);
      dst[0] = make_uint4(pk[0], pk[1], pk[2], pk[3]);
      dst[1] = make_uint4(pk[4], pk[5], pk[6], pk[7]);
    }
    __syncthreads();
  }
}

DI void phase_convert(const Params& p, char* lds, int bid, int nb, int tid) {
  TileIter it{bid, nb, 0};
  for (int l = 0; l < 2; l++) {
    convT_job(p.w_in + (size_t)l * 1024 * 3616, 1024, 3616, 3712, p.w_in_t + (size_t)l * 3712 * 1024, 0, lds, it, tid);
    convT_job(p.mla_wuq + (size_t)l * 256 * 384, 256, 384, 384, p.wuq_t + (size_t)l * 384 * 256, 0, lds, it, tid);
    convT_job(p.mla_wuk + (size_t)l * 128 * 256, 128, 256, 256, p.wkv_t + (size_t)l * 512 * 128, 0, lds, it, tid);
    convT_job(p.mla_wuv + (size_t)l * 128 * 256, 128, 256, 256, p.wkv_t + (size_t)l * 512 * 128 + 256 * 128, 0, lds, it, tid);
    for (int d = 0; d < 2; d++) {
      convT_job(p.rw_w_up + (size_t)(l * 2 + d) * 64 * 256, 64, 256, 256, p.wup_t + (size_t)(l * 2 + d) * 256 * 64, 0, lds, it, tid);
      convT_job(p.rw_a_up + (size_t)(l * 2 + d) * 64 * 256, 64, 256, 256, p.aup_t + (size_t)(l * 2 + d) * 256 * 64, 0, lds, it, tid);
    }
    convT_job(p.rw_g_up + (size_t)l * 128 * 256, 128, 256, 256, p.gup_t + (size_t)l * 256 * 128, 0, lds, it, tid);
    convT_job(p.w_out + (size_t)l * 1024 * 1024, 1024, 1024, 1024, p.wout_t + (size_t)l * 1024 * 1024, 0, lds, it, tid);
    for (int e = 0; e < 16; e++) {
      size_t le = (size_t)(l * 16 + e);
      convT_job(p.moe_w1 + le * 1024 * 512, 1024, 512, 512, p.w13_t + le * 1024 * 1024, 1, lds, it, tid);
      convT_job(p.moe_w3 + le * 1024 * 512, 1024, 512, 512, p.w13_t + le * 1024 * 1024, 2, lds, it, tid);
      convT_job(p.moe_w2 + le * 512 * 1024, 512, 1024, 1024, p.w2_t + le * 1024 * 512, 0, lds, it, tid);
    }
    convT_job(p.ple_gate + (size_t)l * 1024 * 1024, 1024, 1024, 1024, p.wg_t + (size_t)l * 1024 * 1024, 0, lds, it, tid);
    convT_job(p.ple_proj + (size_t)l * 256 * 1024, 256, 1024, 1024, p.wp_t + (size_t)l * 1024 * 256, 0, lds, it, tid);
  }
  int gt = bid * NTHR + tid, ng = nb * NTHR;
  for (int i = gt; i < 8192 * 16; i += ng) {
    int n = i >> 4, f = i & 15;
    double ifq = 0.0;
#pragma unroll
    for (int j = 0; j < 16; j++) ifq = (f == j) ? p.inv_freq[j] : ifq;
    double rev = (double)n * ifq * 0.15915494309189535;
    double fr = rev - rint(rev);
    float ff = (float)fr;
    p.ropec[i] = __builtin_amdgcn_cosf(ff);
    p.ropes[i] = __builtin_amdgcn_sinf(ff);
  }
  for (int i = gt; i < 512; i += ng) {
    float h0 = p.hg_lb[i], h1 = p.hg_lb[512 + i];
    p.lb[i] = 0.f;
    p.lb[512 + i] = 1.f / (1.f + __expf(h0 - h1));
  }
}

constexpr int G_PITCH_B = 144;
constexpr int G_OP_BYTES = 128 * G_PITCH_B;

template <bool AF32, class RowFn, class Epi>
DI void gemm_tile(RowFn rowfn, const u16* __restrict__ Bt, int K, Epi epi, char* lds, int tid) {
  const int lane = tid & 63, wid = tid >> 6, wr = wid >> 1, wc = wid & 1, fr = lane & 15, fq = lane >> 4;
  f32x4 acc[4][4];
#pragma unroll
  for (int m = 0; m < 4; m++)
#pragma unroll
    for (int n = 0; n < 4; n++) acc[m][n] = f32x4{0.f, 0.f, 0.f, 0.f};

  const float* apf[8];
  const u16* aph[4];
  const u16* bp[4];
  if constexpr (AF32) {
#pragma unroll
    for (int i = 0; i < 8; i++) apf[i] = (const float*)rowfn(i * 16 + (tid >> 4)) + (tid & 15) * 4;
  } else {
#pragma unroll
    for (int i = 0; i < 4; i++) aph[i] = (const u16*)rowfn(i * 32 + (tid >> 3)) + (tid & 7) * 8;
  }
#pragma unroll
  for (int i = 0; i < 4; i++) bp[i] = Bt + (size_t)(i * 32 + (tid >> 3)) * K + (tid & 7) * 8;

  float4 raf[8];
  uint4 rah[4];
  uint4 rb[4];
  auto gload = [&](int k0) {
    if constexpr (AF32) {
#pragma unroll
      for (int i = 0; i < 8; i++) raf[i] = *(const float4*)(apf[i] + k0);
    } else {
#pragma unroll
      for (int i = 0; i < 4; i++) rah[i] = *(const uint4*)(aph[i] + k0);
    }
#pragma unroll
    for (int i = 0; i < 4; i++) rb[i] = *(const uint4*)(bp[i] + k0);
  };
  auto lstore = [&](int buf) {
    char* A = lds + buf * 2 * G_OP_BYTES;
    char* B = A + G_OP_BYTES;
    if constexpr (AF32) {
#pragma unroll
      for (int i = 0; i < 8; i++) {
        uint2 v = make_uint2(pack2(raf[i].x, raf[i].y), pack2(raf[i].z, raf[i].w));
        *(uint2*)(A + (i * 16 + (tid >> 4)) * G_PITCH_B + (tid & 15) * 8) = v;
      }
    } else {
#pragma unroll
      for (int i = 0; i < 4; i++) *(uint4*)(A + (i * 32 + (tid >> 3)) * G_PITCH_B + (tid & 7) * 16) = rah[i];
    }
#pragma unroll
    for (int i = 0; i < 4; i++) *(uint4*)(B + (i * 32 + (tid >> 3)) * G_PITCH_B + (tid & 7) * 16) = rb[i];
  };

  const int nk = K >> 6;
  gload(0);
  lstore(0);
  __syncthreads();
  for (int kt = 0; kt < nk; kt++) {
    if (kt + 1 < nk) gload((kt + 1) << 6);
    const char* A = lds + (kt & 1) * 2 * G_OP_BYTES;
    const char* B = A + G_OP_BYTES;
#pragma unroll
    for (int kk = 0; kk < 2; kk++) {
      bf16x8 af[4], bfr[4];
#pragma unroll
      for (int m = 0; m < 4; m++) af[m] = *(const bf16x8*)(A + (wr * 64 + m * 16 + fr) * G_PITCH_B + kk * 64 + fq * 16);
#pragma unroll
      for (int n = 0; n < 4; n++) bfr[n] = *(const bf16x8*)(B + (wc * 64 + n * 16 + fr) * G_PITCH_B + kk * 64 + fq * 16);
#pragma unroll
      for (int m = 0; m < 4; m++)
#pragma unroll
        for (int n = 0; n < 4; n++) acc[m][n] = __builtin_amdgcn_mfma_f32_16x16x32_bf16(bfr[n], af[m], acc[m][n], 0, 0, 0);
    }
    if (kt + 1 < nk) lstore((kt + 1) & 1);
    __syncthreads();
  }
  epi(acc, wr * 64 + fr, wc * 64 + fq * 4);
}

#define EPI_LOOP(...)                                    \
  _Pragma("unroll") for (int m = 0; m < 4; m++)          \
  _Pragma("unroll") for (int n = 0; n < 4; n++) {        \
    const int row = rbase + m * 16;                      \
    const int col = cbase + n * 16;                      \
    const f32x4 v = acc[m][n];                           \
    __VA_ARGS__                                          \
  }

DI void st_bf4(u16* dst, f32x4 v) { *(uint2*)dst = make_uint2(pack2(v[0], v[1]), pack2(v[2], v[3])); }

DI const float* xin_row(const Params& p, int l, int tg) {
  if (l == 0) return tg < 32768 ? p.x_prompt + (size_t)tg * 1024 : p.x_sample + (size_t)(tg - 32768) * 1024;
  return p.out + (size_t)tg * 1024;
}

DI void phase_inproj(const Params& p, int l, int tok0, char* lds, int bid, int nb, int tid) {
  const int NT = 29, MT = T_SUB / 128;
  for (int t = bid; t < NT * MT; t += nb) {
    int nt = t % NT, mt = t / NT;
    int m0 = mt * 128, n0 = nt * 128;
    auto rowfn = [&](int r) -> const void* { return xin_row(p, l, tok0 + m0 + r); };
    u16* z = p.z;
    auto epi = [&](f32x4(&acc)[4][4], int rbase, int cbase) {
      EPI_LOOP({
        int c = n0 + col;
        if (c < ZLD) st_bf4(z + (size_t)(m0 + row) * ZLD + c, v);
      })
    };
    gemm_tile<true>(rowfn, p.w_in_t + ((size_t)l * 3712 + n0) * 1024, 1024, epi, lds, tid);
  }
}

DI void phase_prep(const Params& p, int l, int N, int bid, int nb, int tid) {
  const int lane = tid & 63, wv = tid >> 6;
  const float* gq = p.mla_gq + l * 256;
  const float* gkv = p.mla_gkv + l * 128;
  const float* lb = p.lb + l * 512;
  const float* mu0 = p.rw_mu + (size_t)l * 2 * 1152;
  const float* mu1 = mu0 + 1152;
  const float* k_k = p.rw_kk + l * 256;
  const float* r_k = p.rw_rk + l * 256;
  for (int t = bid * 4 + wv; t < T_SUB; t += nb * 4) {
    u16* zr = p.z + (size_t)t * ZLD;
    const int n = t & (N - 1);
    {
      uint2 raw = *(const uint2*)(zr + lane * 4);
      float v0 = blo(raw.x), v1 = bhi(raw.x), v2 = blo(raw.y), v3 = bhi(raw.y);
      float ss = wave_sum(v0 * v0 + v1 * v1 + v2 * v2 + v3 * v3);
      float ri = rsqrtf(ss * (1.f / 256.f) + 1e-6f);
      const float* g = gq + lane * 4;
      *(uint2*)(p.cqn + (size_t)t * 256 + lane * 4) =
          make_uint2(pack2(v0 * ri * g[0], v1 * ri * g[1]), pack2(v2 * ri * g[2], v3 * ri * g[3]));
    }
    {
      unsigned raw = *(const unsigned*)(zr + 256 + lane * 2);
      float v0 = blo(raw), v1 = bhi(raw);
      float ss = wave_sum(v0 * v0 + v1 * v1);
      float ri = rsqrtf(ss * (1.f / 128.f) + 1e-6f);
      *(unsigned*)(p.ckvn + (size_t)t * 128 + lane * 2) = pack2(v0 * ri * gkv[lane * 2], v1 * ri * gkv[lane * 2 + 1]);
    }
    if (lane < 16) {
      float x1 = bf2f(zr[384 + lane]), x2 = bf2f(zr[400 + lane]);
      float c = p.ropec[n * 16 + lane], s = p.ropes[n * 16 + lane];
      u16 k1 = f2bf(x1 * c - x2 * s), k2 = f2bf(x1 * s + x2 * c);
      u16* kb = p.Kb + (size_t)t * 384;
#pragma unroll
      for (int h = 0; h < 4; h++) {
        kb[h * 96 + 64 + lane] = k1;
        kb[h * 96 + 80 + lane] = k2;
      }
    }
    {
      uint4* ptr = (uint4*)(zr + ZC_OFF + 256 + lane * 8);
      uint4 raw = *ptr;
      const float* lbp = lb + lane * 8;
      unsigned w[4] = {raw.x, raw.y, raw.z, raw.w};
#pragma unroll
      for (int j = 0; j < 4; j++) {
        float a = blo(w[j]), b = bhi(w[j]);
        float la = lbp[2 * j], lb2 = lbp[2 * j + 1];
        a = la + (1.f - la) * sigm(a);
        b = lb2 + (1.f - lb2) * sigm(b);
        w[j] = pack2(a, b);
      }
      *ptr = make_uint4(w[0], w[1], w[2], w[3]);
    }
    {
      const u16* zd = zr + ZD_OFF;
      const bool hp = n > 0, hn = n < N - 1;
      float rr[4], kx[4], vx[4];
#pragma unroll
      for (int part = 0; part < 3; part++) {
        int c = part * 256 + lane * 4;
        uint2 cur = *(const uint2*)(zd + c);
        uint2 prv = hp ? *(const uint2*)(zd - ZLD + c) : make_uint2(0, 0);
        uint2 nxt = hn ? *(const uint2*)(zd + ZLD + c) : make_uint2(0, 0);
        float cz[4] = {blo(cur.x), bhi(cur.x), blo(cur.y), bhi(cur.y)};
        float pz[4] = {blo(prv.x), bhi(prv.x), blo(prv.y), bhi(prv.y)};
        float nz[4] = {blo(nxt.x), bhi(nxt.x), blo(nxt.y), bhi(nxt.y)};
#pragma unroll
        for (int j = 0; j < 4; j++) {
          float o = cz[j] + mu0[c + j] * (pz[j] - cz[j]) + mu1[c + j] * (nz[j] - cz[j]);
          if (part == 0) rr[j] = o;
          if (part == 1) kx[j] = o;
          if (part == 2) vx[j] = o;
        }
      }
      int c4 = lane * 4;
      *(uint2*)(p.rs + (size_t)t * 256 + c4) = make_uint2(pack2(rr[0], rr[1]), pack2(rr[2], rr[3]));
      *(uint2*)(p.ks + (size_t)t * 256 + c4) = make_uint2(pack2(kx[0], kx[1]), pack2(kx[2], kx[3]));
      *(uint2*)(p.vs + (size_t)t * 256 + c4) = make_uint2(pack2(vx[0], vx[1]), pack2(vx[2], vx[3]));
      float kq[4], ss = 0.f, bo = 0.f;
#pragma unroll
      for (int j = 0; j < 4; j++) {
        kq[j] = kx[j] * k_k[c4 + j];
        ss += kq[j] * kq[j];
        bo += rr[j] * kx[j] * r_k[c4 + j];
      }
      ss = reduce16(ss);
      bo = reduce16(bo);
      float inv = 1.f / fmaxf(sqrtf(ss), 1e-12f);
      *(uint2*)(p.kk + (size_t)t * 256 + c4) = make_uint2(pack2(kq[0] * inv, kq[1] * inv), pack2(kq[2] * inv, kq[3] * inv));
      if ((lane & 15) == 0) p.bonus[(size_t)t * 4 + (lane >> 4)] = bo;
#pragma unroll
      for (int i = 0; i < 6; i++) {
        int c = 768 + lane + 64 * i;
        float cz = bf2f(zd[c]);
        float pz = hp ? bf2f(zd[c - ZLD]) : 0.f;
        float nz = hn ? bf2f(zd[c + ZLD]) : 0.f;
        float o = cz + mu0[c] * (pz - cz) + mu1[c] * (nz - cz);
        if (i < 2) o = tanh_(o);
        else if (i >= 4) o = sigm(o);
        p.S1[(size_t)t * 384 + lane + 64 * i] = f2bf(o);
      }
    }
  }
}

DI void phase_smallgemm(const Params& p, int l, int B, int N, char* lds, int bid, int nb, int tid) {
  TileIter it{bid, nb, 0};
  const int MT = T_SUB / 128;
  {
    const int NT = 3;
    for (int t = it.first(NT * MT); t < NT * MT; t += nb) {
      int nt = t % NT, mt = t / NT, m0 = mt * 128, n0 = nt * 128;
      auto rowfn = [&](int r) -> const void* { return p.cqn + (size_t)(m0 + r) * 256; };
      u16* Q = p.Q;
      auto epi = [&](f32x4(&acc)[4][4], int rbase, int cbase) {
        const float SC = 0.10206207261596577f * LOG2E;
        EPI_LOOP({ st_bf4(Q + (size_t)(m0 + row) * 384 + n0 + col, v * SC); })
      };
      gemm_tile<false>(rowfn, p.wuq_t + ((size_t)l * 384 + n0) * 256, 256, epi, lds, tid);
    }
  }
  {
    const int NT = 4;
    for (int t = it.first(NT * MT); t < NT * MT; t += nb) {
      int nt = t % NT, mt = t / NT, m0 = mt * 128, n0 = nt * 128;
      auto rowfn = [&](int r) -> const void* { return p.ckvn + (size_t)(m0 + r) * 128; };
      u16* Kb = p.Kb;
      u16* Vt = p.Vt;
      auto epi = [&](f32x4(&acc)[4][4], int rbase, int cbase) {
        EPI_LOOP({
          int c = n0 + col;
          int tk = m0 + row;
          if (c < 256) {
            int h = c >> 6, d = c & 63;
            st_bf4(Kb + (size_t)tk * 384 + h * 96 + d, v);
          } else {
            int cc = c - 256;
            int b = tk / N, nn = tk - b * N;
            u16* dst = Vt + ((size_t)(b * 256 + cc)) * N + nn;
            dst[0] = f2bf(v[0]);
            dst[(size_t)N] = f2bf(v[1]);
            dst[(size_t)2 * N] = f2bf(v[2]);
            dst[(size_t)3 * N] = f2bf(v[3]);
          }
        })
      };
      gemm_tile<false>(rowfn, p.wkv_t + ((size_t)l * 512 + n0) * 128, 128, epi, lds, tid);
    }
  }
  for (int d = 0; d < 2; d++) {
    const int NT = 2;
    for (int t = it.first(NT * MT); t < NT * MT; t += nb) {
      int nt = t % NT, mt = t / NT, m0 = mt * 128, n0 = nt * 128;
      auto rowfn = [&](int r) -> const void* { return p.S1 + (size_t)(m0 + r) * 384 + d * 64; };
      u16* dst = p.dec + (size_t)d * T_SUB * 256;
      const float* w0 = p.rw_w0 + (l * 2 + d) * 256;
      auto epi = [&](f32x4(&acc)[4][4], int rbase, int cbase) {
        EPI_LOOP({
          f32x4 o;
          for (int j = 0; j < 4; j++) o[j] = __expf(-0.6065306597126334f * sigm(w0[n0 + col + j] + v[j]));
          st_bf4(dst + (size_t)(m0 + row) * 256 + n0 + col, o);
        })
      };
      gemm_tile<false>(rowfn, p.wup_t + ((size_t)(l * 2 + d) * 256 + n0) * 64, 64, epi, lds, tid);
    }
  }
  for (int d = 0; d < 2; d++) {
    const int NT = 2;
    for (int t = it.first(NT * MT); t < NT * MT; t += nb) {
      int nt = t % NT, mt = t / NT, m0 = mt * 128, n0 = nt * 128;
      auto rowfn = [&](int r) -> const void* { return p.S1 + (size_t)(m0 + r) * 384 + 128 + d * 64; };
      u16* dka = p.kka + (size_t)d * T_SUB * 256;
      u16* dkt = p.kt + (size_t)d * T_SUB * 256;
      const float* a0 = p.rw_a0 + (l * 2 + d) * 256;
      const float* ka = p.rw_ka + l * 256;
      const u16* kkp = p.kk;
      const u16* ksp = p.ks;
      auto epi = [&](f32x4(&acc)[4][4], int rbase, int cbase) {
        EPI_LOOP({
          size_t o = (size_t)(m0 + row) * 256 + n0 + col;
          uint2 kkr = *(const uint2*)(kkp + o);
          uint2 ksr = *(const uint2*)(ksp + o);
          float kkv[4] = {blo(kkr.x), bhi(kkr.x), blo(kkr.y), bhi(kkr.y)};
          float ksv[4] = {blo(ksr.x), bhi(ksr.x), blo(ksr.y), bhi(ksr.y)};
          f32x4 o1, o2;
          for (int j = 0; j < 4; j++) {
            float a = sigm(a0[n0 + col + j] + v[j]);
            o1[j] = kkv[j] * a;
            o2[j] = ksv[j] * (1.f + (a - 1.f) * ka[n0 + col + j]);
          }
          st_bf4(dka + o, o1);
          st_bf4(dkt + o, o2);
        })
      };
      gemm_tile<false>(rowfn, p.aup_t + ((size_t)(l * 2 + d) * 256 + n0) * 64, 64, epi, lds, tid);
    }
  }
  {
    const int NT = 2;
    for (int t = it.first(NT * MT); t < NT * MT; t += nb) {
      int nt = t % NT, mt = t / NT, m0 = mt * 128, n0 = nt * 128;
      auto rowfn = [&](int r) -> const void* { return p.S1 + (size_t)(m0 + r) * 384 + 256; };
      u16* dst = p.gD;
      auto epi = [&](f32x4(&acc)[4][4], int rbase, int cbase) {
        EPI_LOOP({ st_bf4(dst + (size_t)(m0 + row) * 256 + n0 + col, v); })
      };
      gemm_tile<false>(rowfn, p.gup_t + ((size_t)l * 256 + n0) * 128, 128, epi, lds, tid);
    }
  }
}

DI bf16x8 pack8(const f32x16& s, int o) {
  bf16x8 r;
#pragma unroll
  for (int j = 0; j < 8; j++) r[j] = (short)f2bf(s[o + j]);
  return r;
}

constexpr int AT_KP = 208, AT_VP = 144, AT_BUF = 64 * AT_KP + 64 * AT_VP;
DI void phase_attn(const Params& p, int B, int N, char* lds, int bid, int nb, int tid) {
  const int lane = tid & 63, wv = tid >> 6, r = lane & 31, hf = lane >> 5;
  const int nqb = N >> 7;
  const int ntask = B * 4 * nqb;
  for (int task = bid; task < ntask; task += nb) {
    const int qb = task % nqb, bh = task / nqb, h = bh & 3, b = bh >> 2;
    const size_t tb = (size_t)b * N;
    const int q = qb * 128 + wv * 32 + r;
    bf16x8 qf[6];
    {
      const u16* qrow = p.Q + (tb + q) * 384 + h * 96;
#pragma unroll
      for (int ks = 0; ks < 4; ks++) qf[ks] = *(const bf16x8*)(qrow + ks * 16 + hf * 8);
      bf16x8 x1r = *(const bf16x8*)(qrow + 64 + hf * 8);
      bf16x8 x2r = *(const bf16x8*)(qrow + 80 + hf * 8);
      const float* cp = p.ropec + q * 16 + hf * 8;
      const float* sp = p.ropes + q * 16 + hf * 8;
      bf16x8 o1, o2;
#pragma unroll
      for (int j = 0; j < 8; j++) {
        float xa = bf2f((u16)x1r[j]), ya = bf2f((u16)x2r[j]);
        float c0 = cp[j], s0 = sp[j];
        o1[j] = (short)f2bf(xa * c0 - ya * s0);
        o2[j] = (short)f2bf(xa * s0 + ya * c0);
      }
      qf[4] = o1;
      qf[5] = o2;
    }
    const u16* Kg = p.Kb + tb * 384 + h * 96;
    const u16* Vg = p.Vt + ((size_t)(b * 4 + h) * 64) * N;
    uint4 kr0, kr1, kr2, vr0, vr1;
    const int lkey = tid >> 2, lpart = tid & 3;
    const int lrow = swap23(lkey);
#define AT_GLOAD(kt_)                                                              \
  {                                                                                \
    const u16* kp_ = Kg + (size_t)((kt_) * 64 + lkey) * 384 + lpart * 24;          \
    kr0 = *(const uint4*)(kp_);                                                    \
    kr1 = *(const uint4*)(kp_ + 8);                                                \
    kr2 = *(const uint4*)(kp_ + 16);                                               \
    const u16* vp_ = Vg + (size_t)lkey * N + (kt_) * 64 + lpart * 16;              \
    vr0 = *(const uint4*)(vp_);                                                    \
    vr1 = *(const uint4*)(vp_ + 8);                                                \
  }
#define AT_LSTORE(buf_)                                                            \
  {                                                                                \
    char* Kl_ = lds + (buf_) * AT_BUF;                                             \
    char* Vl_ = Kl_ + 64 * AT_KP;                                                  \
    *(uint4*)(Kl_ + lrow * AT_KP + (lpart * 3 + 0) * 16) = kr0;                    \
    *(uint4*)(Kl_ + lrow * AT_KP + (lpart * 3 + 1) * 16) = kr1;                    \
    *(uint4*)(Kl_ + lrow * AT_KP + (lpart * 3 + 2) * 16) = kr2;                    \
    *(uint4*)(Vl_ + lkey * AT_VP + (lpart * 2 + 0) * 16) = vr0;                    \
    *(uint4*)(Vl_ + lkey * AT_VP + (lpart * 2 + 1) * 16) = vr1;                    \
  }
    f32x16 O0, O1;
#pragma unroll
    for (int i = 0; i < 16; i++) { O0[i] = 0.f; O1[i] = 0.f; }
    float mrun = -1e30f, lrun = 0.f;
    const int nt = N >> 6;
    __syncthreads();
    AT_GLOAD(0);
    AT_LSTORE(0);
    __syncthreads();
    for (int kt = 0; kt < nt; kt++) {
      if (kt + 1 < nt) AT_GLOAD(kt + 1);
      const char* Kl = lds + (kt & 1) * AT_BUF;
      const char* Vl = Kl + 64 * AT_KP;
      f32x16 S0, S1;
#pragma unroll
      for (int i = 0; i < 16; i++) { S0[i] = 0.f; S1[i] = 0.f; }
#pragma unroll
      for (int ks = 0; ks < 6; ks++) {
        bf16x8 a0 = *(const bf16x8*)(Kl + r * AT_KP + ks * 32 + hf * 16);
        bf16x8 a1 = *(const bf16x8*)(Kl + (32 + r) * AT_KP + ks * 32 + hf * 16);
        S0 = __builtin_amdgcn_mfma_f32_32x32x16_bf16(a0, qf[ks], S0, 0, 0, 0);
        S1 = __builtin_amdgcn_mfma_f32_32x32x16_bf16(a1, qf[ks], S1, 0, 0, 0);
      }
      float mx = S0[0];
#pragma unroll
      for (int i = 1; i < 16; i++) mx = fmaxf(mx, S0[i]);
#pragma unroll
      for (int i = 0; i < 16; i++) mx = fmaxf(mx, S1[i]);
      mx = fmaxf(mx, __shfl_xor(mx, 32));
      float mn = fmaxf(mrun, mx);
      float alpha = ex2(mrun - mn);
      mrun = mn;
      float ls = 0.f;
#pragma unroll
      for (int i = 0; i < 16; i++) {
        S0[i] = ex2(S0[i] - mn);
        S1[i] = ex2(S1[i] - mn);
        ls += S0[i] + S1[i];
      }
      lrun = lrun * alpha + ls;
#pragma unroll
      for (int i = 0; i < 16; i++) { O0[i] *= alpha; O1[i] *= alpha; }
#pragma unroll
      for (int sp = 0; sp < 4; sp++) {
        bf16x8 pb = (sp < 2) ? pack8(S0, (sp & 1) * 8) : pack8(S1, (sp & 1) * 8);
        bf16x8 v0 = *(const bf16x8*)(Vl + r * AT_VP + sp * 32 + hf * 16);
        bf16x8 v1 = *(const bf16x8*)(Vl + (32 + r) * AT_VP + sp * 32 + hf * 16);
        O0 = __builtin_amdgcn_mfma_f32_32x32x16_bf16(v0, pb, O0, 0, 0, 0);
        O1 = __builtin_amdgcn_mfma_f32_32x32x16_bf16(v1, pb, O1, 0, 0, 0);
      }
      if (kt + 1 < nt) AT_LSTORE((kt + 1) & 1);
      __syncthreads();
    }
    float lt = lrun + __shfl_xor(lrun, 32);
    float inv = 1.f / lt;
    u16* orow = p.cat + (tb + q) * 1024 + h * 64;
#pragma unroll
    for (int g = 0; g < 4; g++) {
      int d0 = 8 * g + 4 * hf;
      *(uint2*)(orow + d0) = make_uint2(pack2(O0[4 * g] * inv, O0[4 * g + 1] * inv), pack2(O0[4 * g + 2] * inv, O0[4 * g + 3] * inv));
      *(uint2*)(orow + 32 + d0) = make_uint2(pack2(O1[4 * g] * inv, O1[4 * g + 1] * inv), pack2(O1[4 * g + 2] * inv, O1[4 * g + 3] * inv));
    }
  }
}

DI void phase_na(const Params& p, int l, int B, int N, int bid, int nb, int tid) {
  const int lane = tid & 63, head = tid >> 6, r = lane & 31, hf = lane >> 5;
  const int rows = N >> 6;
  const int nrb = rows >> 1;
  const int ntask = B * nrb * 4;
  const float* bias = p.na_bias + (size_t)(l * 4 + head) * 15 * 31;
  for (int task = bid; task < ntask; task += nb) {
    const int cb = task & 3, rb = (task >> 2) % nrb, b = (task >> 2) / nrb;
    const size_t tb = (size_t)b * N;
    const int qrow0 = rb * 2;
    const int rstart0 = clampi(qrow0 - 4, 0, rows - 8);
    const int k0 = clampi(rstart0, 0, rows - 9);
    const int kstart = clampi(cb * 16 - 8, 0, 32);
    const int iq = r >> 4, u = r & 15;
    const int qrow = qrow0 + iq, qcol = cb * 16 + u;
    const int rstart = clampi(qrow - 4, 0, rows - 8);
    const int cstart = clampi(qcol - 8, 0, 48);
    bf16x8 qf[4];
    {
      const u16* qp = p.z + (tb + qrow * 64 + qcol) * ZLD + ZB_OFF + head * 64;
#pragma unroll
      for (int ks = 0; ks < 4; ks++) qf[ks] = *(const bf16x8*)(qp + ks * 16 + hf * 8);
    }
    f32x16 O0, O1;
#pragma unroll
    for (int i = 0; i < 16; i++) { O0[i] = 0.f; O1[i] = 0.f; }
    float mrun = -1e30f, lrun = 0.f;
    const int wk = swap23(r);
    for (int j = 0; j < 9; j++) {
      const int krow = k0 + j;
      const u16* kp = p.z + (tb + krow * 64 + kstart + wk) * ZLD + ZB_OFF + 256 + head * 64;
      f32x16 S;
#pragma unroll
      for (int i = 0; i < 16; i++) S[i] = 0.f;
#pragma unroll
      for (int ks = 0; ks < 4; ks++) {
        bf16x8 a = *(const bf16x8*)(kp + ks * 16 + hf * 8);
        S = __builtin_amdgcn_mfma_f32_32x32x16_bf16(a, qf[ks], S, 0, 0, 0);
      }
      const bool rok = (krow >= rstart) && (krow < rstart + 8);
      const int drow = clampi(krow - qrow + 7, 0, 14);
      const float* brow = bias + drow * 31;
      float mx = -1e30f;
#pragma unroll
      for (int i = 0; i < 16; i++) {
        int w = 16 * (i >> 3) + 8 * hf + 4 * ((i >> 2) & 1) + (i & 3);
        int kcol = kstart + w;
        bool ok = rok && (kcol >= cstart) && (kcol < cstart + 16);
        int dcol = clampi(kcol - qcol + 15, 0, 30);
        float s = (S[i] * 0.125f + brow[dcol]) * LOG2E;
        S[i] = ok ? s : -1e30f;
        mx = fmaxf(mx, S[i]);
      }
      mx = fmaxf(mx, __shfl_xor(mx, 32));
      float mn = fmaxf(mrun, mx);
      float alpha = ex2(mrun - mn);
      mrun = mn;
      float ls = 0.f;
#pragma unroll
      for (int i = 0; i < 16; i++) {
        float pv = (S[i] > -1e29f) ? ex2(S[i] - mn) : 0.f;
        S[i] = pv;
        ls += pv;
      }
      lrun = lrun * alpha + ls;
#pragma unroll
      for (int i = 0; i < 16; i++) { O0[i] *= alpha; O1[i] *= alpha; }
      const u16* vbase = p.z + (tb + krow * 64 + kstart) * ZLD + ZB_OFF + 512 + head * 64 + r;
#pragma unroll
      for (int s = 0; s < 2; s++) {
        bf16x8 pb = pack8(S, s * 8);
        bf16x8 v0, v1;
#pragma unroll
        for (int jj = 0; jj < 8; jj++) {
          const u16* vp = vbase + (size_t)(16 * s + 8 * hf + jj) * ZLD;
          v0[jj] = (short)vp[0];
          v1[jj] = (short)vp[32];
        }
        O0 = __builtin_amdgcn_mfma_f32_32x32x16_bf16(v0, pb, O0, 0, 0, 0);
        O1 = __builtin_amdgcn_mfma_f32_32x32x16_bf16(v1, pb, O1, 0, 0, 0);
      }
    }
    float lt = lrun + __shfl_xor(lrun, 32);
    float inv = 1.f / lt;
    u16* orow = p.cat + (tb + qrow * 64 + qcol) * 1024 + 256 + head * 64;
#pragma unroll
    for (int g = 0; g < 4; g++) {
      int d0 = 8 * g + 4 * hf;
      *(uint2*)(orow + d0) = make_uint2(pack2(O0[4 * g] * inv, O0[4 * g + 1] * inv), pack2(O0[4 * g + 2] * inv, O0[4 * g + 3] * inv));
      *(uint2*)(orow + 32 + d0) = make_uint2(pack2(O1[4 * g] * inv, O1[4 * g + 1] * inv), pack2(O1[4 * g + 2] * inv, O1[4 * g + 3] * inv));
    }
  }
}

template <bool RW> struct ScanBatch {
  uint2 r[8], w[8], kk[8], ka[8], kt[8];
  u16 v[8];
};

template <bool RW>
DI void scan_task(const Params& p, int task, int N, int tid) {
  const int lane = tid & 63, wv = tid >> 6, kq = lane & 15;
  const int rq = task & 3, hh = (task >> 2) & 3, dir = (task >> 4) & 1, b = task >> 5;
  const int row = rq * 16 + wv * 4 + (lane >> 4);
  const size_t tb = (size_t)b * N;
  const int cv = hh * 64 + kq * 4;
  const int cr = hh * 64 + row;
  const u16 *pr, *pw, *pk = nullptr, *pa = nullptr, *pt = nullptr, *pv;
  int ld;
  u16* po;
  if (RW) {
    ld = 256;
    pr = p.rs + cv;
    pw = p.dec + (size_t)dir * T_SUB * 256 + cv;
    pk = p.kk + cv;
    pa = p.kka + (size_t)dir * T_SUB * 256 + cv;
    pt = p.kt + (size_t)dir * T_SUB * 256 + cv;
    pv = p.vs + cr;
    po = p.oD + (size_t)dir * T_SUB * 256 + cr;
  } else {
    ld = ZLD;
    pr = p.z + ZC_OFF + cv;
    pw = p.z + ZC_OFF + 256 * (1 + dir) + cv;
    pv = p.z + ZC_OFF + 768 + cr;
    po = p.oC + (size_t)dir * T_SUB * 256 + cr;
  }
  float S0 = 0.f, S1 = 0.f, S2 = 0.f, S3 = 0.f;
  ScanBatch<RW> A, Bb;
  auto load = [&](ScanBatch<RW>& X, int t0) {
#pragma unroll
    for (int u = 0; u < 8; u++) {
      int tau = t0 + u;
      size_t tk = tb + (dir ? (N - 1 - tau) : tau);
      X.r[u] = *(const uint2*)(pr + tk * ld);
      X.w[u] = *(const uint2*)(pw + tk * ld);
      X.v[u] = pv[tk * ld];
      if (RW) {
        X.kk[u] = *(const uint2*)(pk + tk * ld);
        X.ka[u] = *(const uint2*)(pa + tk * ld);
        X.kt[u] = *(const uint2*)(pt + tk * ld);
      }
    }
  };
  auto compute = [&](const ScanBatch<RW>& X, int t0) {
#pragma unroll
    for (int u = 0; u < 8; u++) {
      int tau = t0 + u;
      size_t tk = tb + (dir ? (N - 1 - tau) : tau);
      float r0 = blo(X.r[u].x), r1 = bhi(X.r[u].x), r2 = blo(X.r[u].y), r3 = bhi(X.r[u].y);
      float w0 = blo(X.w[u].x), w1 = bhi(X.w[u].x), w2 = blo(X.w[u].y), w3 = bhi(X.w[u].y);
      float vv = bf2f(X.v[u]);
      if (RW) {
        float k0 = blo(X.kk[u].x), k1 = bhi(X.kk[u].x), k2 = blo(X.kk[u].y), k3 = bhi(X.kk[u].y);
        float a0 = blo(X.ka[u].x), a1 = bhi(X.ka[u].x), a2 = blo(X.ka[u].y), a3 = bhi(X.ka[u].y);
        float t0_ = blo(X.kt[u].x), t1 = bhi(X.kt[u].x), t2 = blo(X.kt[u].y), t3 = bhi(X.kt[u].y);
        float sa = -reduce16(S0 * k0 + S1 * k1 + S2 * k2 + S3 * k3);
        S0 = S0 * w0 + sa * a0 + vv * t0_;
        S1 = S1 * w1 + sa * a1 + vv * t1;
        S2 = S2 * w2 + sa * a2 + vv * t2;
        S3 = S3 * w3 + sa * a3 + vv * t3;
      } else {
        S0 = S0 * w0 + vv * (1.f - w0);
        S1 = S1 * w1 + vv * (1.f - w1);
        S2 = S2 * w2 + vv * (1.f - w2);
        S3 = S3 * w3 + vv * (1.f - w3);
      }
      float o = reduce16(S0 * r0 + S1 * r1 + S2 * r2 + S3 * r3);
      if (kq == 0) po[tk * 256] = f2bf(o);
    }
  };
  load(A, 0);
  for (int t0 = 0; t0 < N; t0 += 16) {
    load(Bb, t0 + 8);
    compute(A, t0);
    if (t0 + 16 < N) load(A, t0 + 16);
    compute(Bb, t0 + 8);
  }
}

DI void phase_scan(const Params& p, int B, int N, int bid, int nb, int tid) {
  const int nper = B * 32;
  for (int task = bid; task < 2 * nper; task += nb) {
    if (task < nper) scan_task<true>(p, task, N, tid);
    else scan_task<false>(p, task - nper, N, tid);
  }
}

DI void phase_final(const Params& p, int l, int bid, int nb, int tid) {
  const int lane = tid & 63, wv = tid >> 6, c4 = lane * 4;
  const float* gn = p.hg_gnorm + l * 256 + c4;
  const float* lw = p.rw_ln_w + l * 256 + c4;
  const float* lbb = p.rw_ln_b + l * 256 + c4;
  for (int t = bid * 4 + wv; t < T_SUB; t += nb * 4) {
    {
      uint2 a = *(const uint2*)(p.oC + (size_t)t * 256 + c4);
      uint2 bq = *(const uint2*)(p.oC + (size_t)(T_SUB + t) * 256 + c4);
      float o[4] = {blo(a.x) + blo(bq.x), bhi(a.x) + bhi(bq.x), blo(a.y) + blo(bq.y), bhi(a.y) + bhi(bq.y)};
      float ss = reduce16(o[0] * o[0] + o[1] * o[1] + o[2] * o[2] + o[3] * o[3]);
      float ri = rsqrtf(ss * (1.f / 64.f) + 1e-6f);
      uint2 gr = *(const uint2*)(p.z + (size_t)t * ZLD + ZC_OFF + 1024 + c4);
      float g[4] = {blo(gr.x), bhi(gr.x), blo(gr.y), bhi(gr.y)};
      float y[4];
#pragma unroll
      for (int j = 0; j < 4; j++) y[j] = o[j] * ri * gn[j] * (g[j] * sigm(g[j]));
      *(uint2*)(p.cat + (size_t)t * 1024 + 512 + c4) = make_uint2(pack2(y[0], y[1]), pack2(y[2], y[3]));
    }
    {
      uint2 a = *(const uint2*)(p.oD + (size_t)t * 256 + c4);
      uint2 bq = *(const uint2*)(p.oD + (size_t)(T_SUB + t) * 256 + c4);
      float o[4] = {blo(a.x) + blo(bq.x), bhi(a.x) + bhi(bq.x), blo(a.y) + blo(bq.y), bhi(a.y) + bhi(bq.y)};
      float mu = reduce16(o[0] + o[1] + o[2] + o[3]) * (1.f / 64.f);
      float d0 = o[0] - mu, d1 = o[1] - mu, d2 = o[2] - mu, d3 = o[3] - mu;
      float var = reduce16(d0 * d0 + d1 * d1 + d2 * d2 + d3 * d3) * (1.f / 64.f);
      float ri = rsqrtf(var + 64e-5f);
      float bo = p.bonus[(size_t)t * 4 + (lane >> 4)];
      uint2 vr = *(const uint2*)(p.vs + (size_t)t * 256 + c4);
      uint2 gr = *(const uint2*)(p.gD + (size_t)t * 256 + c4);
      float vv[4] = {blo(vr.x), bhi(vr.x), blo(vr.y), bhi(vr.y)};
      float g[4] = {blo(gr.x), bhi(gr.x), blo(gr.y), bhi(gr.y)};
      float dd[4] = {d0, d1, d2, d3};
      float y[4];
#pragma unroll
      for (int j = 0; j < 4; j++) y[j] = (dd[j] * ri * lw[j] + lbb[j] + bo * vv[j]) * g[j];
      *(uint2*)(p.cat + (size_t)t * 1024 + 768 + c4) = make_uint2(pack2(y[0], y[1]), pack2(y[2], y[3]));
    }
  }
}

DI void phase_wout(const Params& p, int l, int tok0, char* lds, int bid, int nb, int tid) {
  const int NT = 8, MT = T_SUB / 128;
  for (int t = bid; t < NT * MT; t += nb) {
    int nt = t % NT, mt = t / NT, m0 = mt * 128, n0 = nt * 128;
    auto rowfn = [&](int r) -> const void* { return p.cat + (size_t)(m0 + r) * 1024; };
    auto epi = [&](f32x4(&acc)[4][4], int rbase, int cbase) {
      EPI_LOOP({
        int tg = tok0 + m0 + row;
        float4 xv = *(const float4*)(xin_row(p, l, tg) + n0 + col);
        float4 o = make_float4(ALPHA_F * xv.x + v[0], ALPHA_F * xv.y + v[1], ALPHA_F * xv.z + v[2], ALPHA_F * xv.w + v[3]);
        *(float4*)(p.out + (size_t)tg * 1024 + n0 + col) = o;
      })
    };
    gemm_tile<false>(rowfn, p.wout_t + ((size_t)l * 1024 + n0) * 1024, 1024, epi, lds, tid);
  }
}

template <bool ROUTER>
DI void phase_ln(const Params& p, const float* g, const float* bta, const float* wrouter, int tok0, int ntok, char* lds,
                 int bid, int nb, int tid) {
  const int lane = tid & 63, wv = tid >> 6;
  float* wl = (float*)lds;
  if (ROUTER) {
    __syncthreads();
    for (int i = tid; i < 16384; i += NTHR) {
      int k = i >> 4, e = i & 15;
      wl[e * 1024 + k] = wrouter[i];
    }
    __syncthreads();
  }
  for (int t = bid * 4 + wv; t < ntok; t += nb * 4) {
    const int tg = tok0 + t;
    float* xr = p.out + (size_t)tg * 1024;
    float4 x[4];
    float s = 0.f;
#pragma unroll
    for (int i = 0; i < 4; i++) {
      x[i] = *(const float4*)(xr + i * 256 + lane * 4);
      s += x[i].x + x[i].y + x[i].z + x[i].w;
    }
    float mu = wave_sum(s) * (1.f / 1024.f);
    float vs = 0.f;
#pragma unroll
    for (int i = 0; i < 4; i++) {
      x[i].x -= mu; x[i].y -= mu; x[i].z -= mu; x[i].w -= mu;
      vs += x[i].x * x[i].x + x[i].y * x[i].y + x[i].z * x[i].z + x[i].w * x[i].w;
    }
    float ri = rsqrtf(wave_sum(vs) * (1.f / 1024.f) + 1e-5f);
#pragma unroll
    for (int i = 0; i < 4; i++) {
      float4 gg = *(const float4*)(g + i * 256 + lane * 4);
      float4 bb = *(const float4*)(bta + i * 256 + lane * 4);
      x[i].x = x[i].x * ri * gg.x + bb.x;
      x[i].y = x[i].y * ri * gg.y + bb.y;
      x[i].z = x[i].z * ri * gg.z + bb.z;
      x[i].w = x[i].w * ri * gg.w + bb.w;
      *(float4*)(xr + i * 256 + lane * 4) = x[i];
    }
    if (ROUTER) {
      float mine = 0.f;
#pragma unroll 1
      for (int e = 0; e < 16; e++) {
        float a = 0.f;
#pragma unroll
        for (int i = 0; i < 4; i++) {
          float4 w = *(const float4*)(wl + e * 1024 + i * 256 + lane * 4);
          a += x[i].x * w.x + x[i].y * w.y + x[i].z * w.z + x[i].w * w.w;
        }
        a = wave_sum(a);
        mine = (lane == e) ? a : mine;
      }
      float mx = mine;
      mx = fmaxf(mx, dpp_f<0xB1>(mx));
      mx = fmaxf(mx, dpp_f<0x4E>(mx));
      mx = fmaxf(mx, dpp_f<0x141>(mx));
      mx = fmaxf(mx, dpp_f<0x140>(mx));
      float ex = __expf(mine - mx);
      float sum = reduce16(ex);
      mine = ex / sum;
      if (lane < 16) {
        if (tg < 32768) p.affT[(size_t)lane * 32768 + tg] = mine;
        else p.affT[(size_t)16 * 32768 + (size_t)lane * 65536 + (tg - 32768)] = mine;
      }
    }
  }
}

DI void phase_topk(const Params& p, char* lds, int bid, int nb, int tid) {
  if (bid < 32) {
    unsigned* hist = (unsigned*)lds;
    unsigned* sh = hist + 256;
    unsigned* eqc = sh + 8;
    const int g = bid >> 4, e = bid & 15;
    const int T = g ? 65536 : 32768, cap = T >> 3;
    const int tok0 = g ? 32768 : 0;
    const float* vals = p.affT + (g ? (size_t)16 * 32768 : 0) + (size_t)e * T;
    int* oidx = p.idx + (g ? 65536 : 0) + e * cap;
    float* ogate = p.gate + (g ? 65536 : 0) + e * cap;
    unsigned prefix = 0, mask = 0;
    int remaining = cap;
    for (int pass = 0; pass < 4; pass++) {
      const int shift = 24 - 8 * pass;
      hist[tid] = 0;
      __syncthreads();
      for (int i = tid; i < T; i += NTHR) {
        unsigned u = __float_as_uint(vals[i]);
        if ((u & mask) == prefix) atomicAdd(&hist[(u >> shift) & 255], 1u);
      }
      __syncthreads();
      if (tid == 0) {
        int cum = 0, sel = 0;
        for (int bq = 255; bq >= 0; bq--) {
          int hc = (int)hist[bq];
          if (cum + hc >= remaining) { sel = bq; break; }
          cum += hc;
        }
        sh[0] = (unsigned)sel;
        sh[1] = (unsigned)(remaining - cum);
      }
      __syncthreads();
      prefix |= sh[0] << shift;
      remaining = (int)sh[1];
      mask |= 0xFFu << shift;
      __syncthreads();
    }
    const unsigned thr = prefix;
    const int need = remaining;
    const int ch = T >> 8;
    const float* my = vals + tid * ch;
    int ec = 0;
    for (int i = 0; i < ch; i++) ec += (__float_as_uint(my[i]) == thr) ? 1 : 0;
    eqc[tid] = ec;
    if (tid == 0) sh[2] = 0;
    __syncthreads();
    int eq_rank = 0;
    for (int i = 0; i < tid; i++) eq_rank += eqc[i];
    for (int i = 0; i < ch; i++) {
      float v = my[i];
      unsigned u = __float_as_uint(v);
      if (u > thr) {
        int pos = (int)atomicAdd(&sh[2], 1u);
        oidx[pos] = tok0 + tid * ch + i;
        ogate[pos] = v;
      } else if (u == thr) {
        if (eq_rank < need) {
          int pos = cap - need + eq_rank;
          oidx[pos] = tok0 + tid * ch + i;
          ogate[pos] = v;
        }
        eq_rank++;
      }
    }
    __syncthreads();
  } else {
    const size_t n4 = (size_t)T_ALL * 1024 / 4;
    const float4* src = (const float4*)p.out;
    float4* dst = (float4*)p.Y;
    for (size_t i = (size_t)(bid - 32) * NTHR + tid; i < n4; i += (size_t)(nb - 32) * NTHR) {
      float4 v = src[i];
      dst[i] = make_float4(v.x * ALPHA_F, v.y * ALPHA_F, v.z * ALPHA_F, v.w * ALPHA_F);
    }
  }
}

DI void moe_rowinfo(int row0, int l, int& e, int& ioff) {
  if (row0 < 65536) { e = row0 >> 12; }
  else { e = (row0 - 65536) >> 13; }
  ioff = row0;
}

DI void phase_moe1(const Params& p, int l, char* lds, int bid, int nb, int tid) {
  const int NT = 8, MT = 196608 / 128;
  for (int t = bid; t < NT * MT; t += nb) {
    int nt = t % NT, mt = t / NT, m0 = mt * 128, n0 = nt * 128;
    int e, ioff;
    moe_rowinfo(m0, l, e, ioff);
    const int* ip = p.idx + ioff;
    auto rowfn = [&](int r) -> const void* { return p.out + (size_t)ip[r] * 1024; };
    u16* H = p.H;
    auto epi = [&](f32x4(&acc)[4][4], int rbase, int cbase) {
#pragma unroll
      for (int m = 0; m < 4; m++)
#pragma unroll
        for (int n = 0; n < 4; n += 2) {
          int row = rbase + m * 16;
          int col = cbase + n * 16;
          int blk = (n0 + (col & ~31)) >> 1;
          int hc = blk + (col & 15);
          f32x4 a = acc[m][n], bq = acc[m][n + 1];
          f32x4 o;
          for (int j = 0; j < 4; j++) o[j] = a[j] * sigm(a[j]) * bq[j];
          st_bf4(H + (size_t)(m0 + row) * 512 + hc, o);
        }
    };
    gemm_tile<true>(rowfn, p.w13_t + ((size_t)(l * 16 + e) * 1024 + n0) * 1024, 1024, epi, lds, tid);
  }
}

DI void phase_moe2(const Params& p, int l, char* lds, int bid, int nb, int tid) {
  TileIter it{bid, nb, 0};
  {
    const int NT = 8, MT = 196608 / 128;
    for (int t = it.first(NT * MT); t < NT * MT; t += nb) {
      int nt = t % NT, mt = t / NT, m0 = mt * 128, n0 = nt * 128;
      int e, ioff;
      moe_rowinfo(m0, l, e, ioff);
      const int* ip = p.idx + ioff;
      const float* gp = p.gate + ioff;
      auto rowfn = [&](int r) -> const void* { return p.H + (size_t)(m0 + r) * 512; };
      float* Y = p.Y;
      auto epi = [&](f32x4(&acc)[4][4], int rbase, int cbase) {
        EPI_LOOP({
          int tk = ip[row];
          float gt = gp[row];
          float* dst = Y + (size_t)tk * 1024 + n0 + col;
          for (int j = 0; j < 4; j++) unsafeAtomicAdd(dst + j, gt * v[j]);
        })
      };
      gemm_tile<false>(rowfn, p.w2_t + ((size_t)(l * 16 + e) * 1024 + n0) * 512, 512, epi, lds, tid);
    }
  }
  {
    const int NT = 8, MT = T_ALL / 128;
    for (int t = it.first(NT * MT); t < NT * MT; t += nb) {
      int nt = t % NT, mt = t / NT, m0 = mt * 128, n0 = nt * 128;
      auto rowfn = [&](int r) -> const void* {
        int tg = m0 + r;
        return tg < 32768 ? p.p_prompt + ((size_t)l * 32768 + tg) * 256 : p.p_sample + ((size_t)l * 65536 + (tg - 32768)) * 256;
      };
      auto epi = [&](f32x4(&acc)[4][4], int rbase, int cbase) {
        EPI_LOOP({ *(float4*)(p.out + (size_t)(m0 + row) * 1024 + n0 + col) = make_float4(v[0], v[1], v[2], v[3]); })
      };
      gemm_tile<true>(rowfn, p.wp_t + ((size_t)l * 1024 + n0) * 256, 256, epi, lds, tid);
    }
  }
}

DI void phase_ple(const Params& p, int l, char* lds, int bid, int nb, int tid) {
  const int NT = 8, MT = T_ALL / 128;
  for (int t = bid; t < NT * MT; t += nb) {
    int nt = t % NT, mt = t / NT, m0 = mt * 128, n0 = nt * 128;
    auto rowfn = [&](int r) -> const void* { return p.Y + (size_t)(m0 + r) * 1024; };
    auto epi = [&](f32x4(&acc)[4][4], int rbase, int cbase) {
      EPI_LOOP({
        size_t o = (size_t)(m0 + row) * 1024 + n0 + col;
        float4 u = *(const float4*)(p.Y + o);
        float4 pp = *(const float4*)(p.out + o);
        *(float4*)(p.out + o) = make_float4(u.x + sigm(v[0]) * pp.x, u.y + sigm(v[1]) * pp.y, u.z + sigm(v[2]) * pp.z,
                                            u.w + sigm(v[3]) * pp.w);
      })
    };
    gemm_tile<true>(rowfn, p.wg_t + ((size_t)l * 1024 + n0) * 1024, 1024, epi, lds, tid);
  }
}

__global__ void __launch_bounds__(NTHR, 2) mega(Params p) {
  __shared__ __attribute__((aligned(16))) char lds[73728];
  cg::grid_group grid = cg::this_grid();
  const int tid0 = threadIdx.x, bid0 = blockIdx.x, nb = gridDim.x;
  int pc = 0;
#define PHASE(...)                                      \
  {                                                     \
    if (pc >= p.pb && pc < p.pe) {                      \
      if (pc > p.pb) grid.sync();                       \
      int tid = tid0, bid = bid0;                       \
      asm volatile("" : "+v"(tid), "+s"(bid));          \
      __VA_ARGS__;                                      \
    }                                                   \
    pc++;                                               \
  }
  PHASE(phase_convert(p, lds, bid, nb, tid));
  for (int l = 0; l < 2; l++) {
    for (int sg = 0; sg < 3; sg++) {
      const int tok0 = sg * T_SUB;
      const int B = sg == 0 ? 4 : 8, N = sg == 0 ? 8192 : 4096;
      PHASE(phase_inproj(p, l, tok0, lds, bid, nb, tid));
      PHASE(phase_prep(p, l, N, bid, nb, tid));
      PHASE(phase_smallgemm(p, l, B, N, lds, bid, nb, tid));
      PHASE(phase_attn(p, B, N, lds, bid, nb, tid));
      PHASE(phase_na(p, l, B, N, bid, nb, tid));
      PHASE(phase_scan(p, B, N, bid, nb, tid));
      PHASE(phase_final(p, l, bid, nb, tid));
      PHASE(phase_wout(p, l, tok0, lds, bid, nb, tid));
      PHASE(phase_ln<true>(p, p.ln1_g + l * 1024, p.ln1_b + l * 1024, p.moe_router + (size_t)l * 16384, tok0, T_SUB, lds, bid, nb, tid));
    }
    PHASE(phase_topk(p, lds, bid, nb, tid));
    PHASE(phase_moe1(p, l, lds, bid, nb, tid));
    PHASE(phase_moe2(p, l, lds, bid, nb, tid));
    PHASE(phase_ple(p, l, lds, bid, nb, tid));
    PHASE(phase_ln<false>(p, p.ln2_g + l * 1024, p.ln2_b + l * 1024, nullptr, 0, T_ALL, lds, bid, nb, tid));
  }
}

#define N_PHASES 65
#ifndef FUSED
#define FUSED 1
#endif

extern "C" void kernel_launch(void* const* d_in, const int* in_sizes, int n_in, void* d_out, int out_size, void* d_ws,
                              size_t ws_size, hipStream_t stream) {
  static int grid_blocks = 0;
  if (!grid_blocks) {
    int dev = 0, cus = 0, per_cu = 0;
    (void)hipGetDevice(&dev);
    (void)hipDeviceGetAttribute(&cus, hipDeviceAttributeMultiprocessorCount, dev);
    (void)hipOccupancyMaxActiveBlocksPerMultiprocessor(&per_cu, mega, NTHR, 0);
    if (per_cu > 2) per_cu = 2;
    if (per_cu < 1) per_cu = 1;
    grid_blocks = cus * per_cu;
  }
  Params p;
  memset(&p, 0, sizeof(p));
  const float* const* in = (const float* const*)d_in;
  int k = 0;
  p.x_prompt = in[k++]; p.x_sample = in[k++]; p.p_prompt = in[k++]; p.p_sample = in[k++];
  p.w_in = in[k++]; p.mla_gq = in[k++]; p.mla_gkv = in[k++]; p.mla_wuq = in[k++]; p.mla_wuk = in[k++]; p.mla_wuv = in[k++];
  p.na_bias = in[k++]; p.hg_lb = in[k++]; p.hg_gnorm = in[k++];
  p.rw_mu = in[k++]; p.rw_w0 = in[k++]; p.rw_w_up = in[k++]; p.rw_a0 = in[k++]; p.rw_a_up = in[k++]; p.rw_g_up = in[k++];
  p.rw_kk = in[k++]; p.rw_ka = in[k++]; p.rw_rk = in[k++]; p.rw_ln_w = in[k++]; p.rw_ln_b = in[k++];
  p.w_out = in[k++]; p.ln1_g = in[k++]; p.ln1_b = in[k++]; p.moe_router = in[k++]; p.moe_w1 = in[k++]; p.moe_w3 = in[k++];
  p.moe_w2 = in[k++]; p.ln2_g = in[k++]; p.ln2_b = in[k++]; p.ple_gate = in[k++]; p.ple_proj = in[k++];
  p.out = (float*)d_out;
  char* ws = (char*)d_ws;
  size_t off = 0;
  auto take = [&](size_t bytes) { char* r = ws + off; off += (bytes + 255) & ~(size_t)255; return r; };
  p.w_in_t = (u16*)take((size_t)2 * 3712 * 1024 * 2);
  p.wuq_t = (u16*)take((size_t)2 * 384 * 256 * 2);
  p.wkv_t = (u16*)take((size_t)2 * 512 * 128 * 2);
  p.wup_t = (u16*)take((size_t)4 * 256 * 64 * 2);
  p.aup_t = (u16*)take((size_t)4 * 256 * 64 * 2);
  p.gup_t = (u16*)take((size_t)2 * 256 * 128 * 2);
  p.wout_t = (u16*)take((size_t)2 * 1024 * 1024 * 2);
  p.w13_t = (u16*)take((size_t)32 * 1024 * 1024 * 2);
  p.w2_t = (u16*)take((size_t)32 * 1024 * 512 * 2);
  p.wg_t = (u16*)take((size_t)2 * 1024 * 1024 * 2);
  p.wp_t = (u16*)take((size_t)2 * 1024 * 256 * 2);
  p.ropec = (float*)take((size_t)8192 * 16 * 4);
  p.ropes = (float*)take((size_t)8192 * 16 * 4);
  p.lb = (float*)take(1024 * 4);
  p.affT = (float*)take((size_t)16 * T_ALL * 4);
  p.gate = (float*)take((size_t)196608 * 4);
  p.idx = (int*)take((size_t)196608 * 4);
  const size_t stage0 = off;
  p.z = (u16*)take((size_t)T_SUB * ZLD * 2);
  p.cat = (u16*)take((size_t)T_SUB * 1024 * 2);
  p.Q = (u16*)take((size_t)T_SUB * 384 * 2);
  p.Kb = (u16*)take((size_t)T_SUB * 384 * 2);
  p.Vt = (u16*)take((size_t)T_SUB * 256 * 2);
  p.cqn = (u16*)take((size_t)T_SUB * 256 * 2);
  p.ckvn = (u16*)take((size_t)T_SUB * 128 * 2);
  p.S1 = (u16*)take((size_t)T_SUB * 384 * 2);
  p.rs = (u16*)take((size_t)T_SUB * 256 * 2);
  p.ks = (u16*)take((size_t)T_SUB * 256 * 2);
  p.vs = (u16*)take((size_t)T_SUB * 256 * 2);
  p.kk = (u16*)take((size_t)T_SUB * 256 * 2);
  p.gD = (u16*)take((size_t)T_SUB * 256 * 2);
  p.dec = (u16*)take((size_t)2 * T_SUB * 256 * 2);
  p.kka = (u16*)take((size_t)2 * T_SUB * 256 * 2);
  p.kt = (u16*)take((size_t)2 * T_SUB * 256 * 2);
  p.oC = (u16*)take((size_t)2 * T_SUB * 256 * 2);
  p.oD = (u16*)take((size_t)2 * T_SUB * 256 * 2);
  p.bonus = (float*)take((size_t)T_SUB * 4 * 4);
  off = stage0;
  p.Y = (float*)take((size_t)T_ALL * 1024 * 4);
  p.H = (u16*)take((size_t)196608 * 512 * 2);
  for (int i = 0; i < 16; i++) p.inv_freq[i] = pow(10000.0, -(double)i / 16.0);
#if FUSED
  p.pb = 0;
  p.pe = N_PHASES;
  {
    void* args[] = {&p};
    hipError_t e = hipLaunchCooperativeKernel((void*)mega, dim3(grid_blocks), dim3(NTHR), args, 0, stream);
    if (e != hipSuccess) fprintf(stderr, "cooperative launch failed: %s (grid %d)\n", hipGetErrorString(e), grid_blocks);
  }
#else
  for (int ph = 0; ph < N_PHASES; ph++) {
    p.pb = ph;
    p.pe = ph + 1;
    void* args[] = {&p};
    hipError_t e = hipLaunchCooperativeKernel((void*)mega, dim3(grid_blocks), dim3(NTHR), args, 0, stream);
    if (e != hipSuccess) fprintf(stderr, "cooperative launch failed: %s (grid %d)\n", hipGetErrorString(e), grid_blocks);
  }
#endif
}
```

```cpp
#include <hip/hip_runtime.h>
#include <hip/hip_cooperative_groups.h>
#include <cstdio>
#include <cmath>
#include <cstring>
namespace cg = cooperative_groups;

typedef unsigned short u16;
using bf16x8 = __attribute__((ext_vector_type(8))) short;
using f32x4 = __attribute__((ext_vector_type(4))) float;
using f32x16 = __attribute__((ext_vector_type(16))) float;

#define REP_INPROJ 0
#define REP_ATTN 0
#define REP_NA 0
#define REP_SCAN 0
#define REP_MOE1 0
#define DI __device__ __forceinline__
#define NTHR 256
#define T_ALL 98304
#define T_SUB 32768
#define ZLD 3616
#define ZB_OFF 416
#define ZC_OFF 1184
#define ZD_OFF 2464
#define LOG2E 1.4426950408889634f
#define ALPHA_F 1.4142135623730951f

struct Params {
  const float *x_prompt, *x_sample, *p_prompt, *p_sample;
  const float *w_in, *mla_gq, *mla_gkv, *mla_wuq, *mla_wuk, *mla_wuv, *na_bias, *hg_lb, *hg_gnorm;
  const float *rw_mu, *rw_w0, *rw_w_up, *rw_a0, *rw_a_up, *rw_g_up, *rw_kk, *rw_ka, *rw_rk, *rw_ln_w, *rw_ln_b;
  const float *w_out, *ln1_g, *ln1_b, *moe_router, *moe_w1, *moe_w3, *moe_w2, *ln2_g, *ln2_b, *ple_gate, *ple_proj;
  float* out;
  u16 *w_in_t, *wuq_t, *wkv_t, *wup_t, *aup_t, *gup_t, *wout_t, *w13_t, *w2_t, *wg_t, *wp_t;
  float *ropec, *ropes, *lb, *affT, *gate;
  int* idx;
  u16 *z, *cat, *Q, *Kb, *Vt, *cqn, *ckvn, *S1, *rs, *ks, *vs, *kk, *gD, *dec, *kka, *kt, *oC, *oD;
  float* bonus;
  u16* xb;
  float* Y;
  u16* H;
  double inv_freq[16];
  int pb, pe;
};

DI u16 f2bf(float f) { unsigned u = __float_as_uint(f); u += 0x7fffu + ((u >> 16) & 1u); return (u16)(u >> 16); }
DI float bf2f(u16 h) { return __uint_as_float(((unsigned)h) << 16); }
DI unsigned pack2(float a, float b) { return (unsigned)f2bf(a) | ((unsigned)f2bf(b) << 16); }
DI float blo(unsigned u) { return __uint_as_float(u << 16); }
DI float bhi(unsigned u) { return __uint_as_float(u & 0xffff0000u); }
DI float sigm(float x) { return 1.f / (1.f + __expf(-x)); }
DI float tanh_(float x) { return 1.f - 2.f / (__expf(2.f * x) + 1.f); }
DI float ex2(float x) { return __builtin_amdgcn_exp2f(x); }
DI int clampi(int v, int lo, int hi) { return v < lo ? lo : (v > hi ? hi : v); }
DI int swap23(int x) { return (x & ~12) | ((x & 4) << 1) | ((x & 8) >> 1); }

template <int CTRL> DI float dpp_f(float v) {
  return __int_as_float(__builtin_amdgcn_update_dpp(0, __float_as_int(v), CTRL, 0xF, 0xF, true));
}
DI float reduce16(float v) {
  v += dpp_f<0xB1>(v);
  v += dpp_f<0x4E>(v);
  v += dpp_f<0x141>(v);
  v += dpp_f<0x140>(v);
  return v;
}
DI float wave_sum(float v) {
  v = reduce16(v);
  v += __shfl_xor(v, 16);
  v += __shfl_xor(v, 32);
  return v;
}

struct TileIter {
  int bid, nb, off;
  DI int first(int n) { int f = bid - off; if (f < 0) f += nb; off = (off + n) % nb; return f; }
};

DI bool xcd_tile(int it, int bid, int nb, int MT, int NT, int& mt, int& nt) {
  const int x = bid & 7, slot = bid >> 3, nslots = nb >> 3;
  const int mper = MT >> 3;
  const int i = slot + it * nslots;
  if (i >= mper * NT) return false;
  const int mi = i & 7, rest = i >> 3;
  nt = rest % NT;
  mt = x * mper + (rest / NT) * 8 + mi;
  return true;
}

DI void convT_job(const float* __restrict__ W, int K, int N, int Npad, u16* __restrict__ Wt, int mode, char* lds,
                  TileIter& it, int tid) {
  float(*tile)[65] = (float(*)[65])lds;
  int tk = K >> 6, tn = Npad >> 6;
  int nt = tk * tn;
  for (int t = it.first(nt); t < nt; t += it.nb) {
    int k0 = (t % tk) << 6, n0 = (t / tk) << 6;
#pragma unroll
    for (int i = 0; i < 16; i++) {
      int kl = (tid >> 6) + 4 * i, nl = tid & 63;
      int n = n0 + nl;
      tile[kl][nl] = (n < N) ? W[(size_t)(k0 + kl) * N + n] : 0.f;
    }
    __syncthreads();
    {
      int nl = tid >> 2, ks = (tid & 3) * 16;
      int n = n0 + nl;
      int row = n;
      if (mode == 1) row = (n >> 4) * 32 + (n & 15);
      if (mode == 2) row = (n >> 4) * 32 + 16 + (n & 15);
      unsigned pk[8];
#pragma unroll
      for (int j = 0; j < 8; j++) pk[j] = pack2(tile[ks + 2 * j][nl], tile[ks + 2 * j + 1][nl]);
      uint4* dst = (uint4*)(Wt + (size_t)row * K + k0 + ks);
      dst[0] = make_uint4(pk[0], pk[1], pk[2], pk[3]);
      dst[1] = make_uint4(pk[4], pk[5], pk[6], pk[7]);
    }
    __syncthreads();
  }
}

DI void phase_convert(const Params& p, char* lds, int bid, int nb, int tid) {
  TileIter it{bid, nb, 0};
  for (int l = 0; l < 2; l++) {
    convT_job(p.w_in + (size_t)l * 1024 * 3616, 1024, 3616, 3712, p.w_in_t + (size_t)l * 3712 * 1024, 0, lds, it, tid);
    convT_job(p.mla_wuq + (size_t)l * 256 * 384, 256, 384, 384, p.wuq_t + (size_t)l * 384 * 256, 0, lds, it, tid);
    convT_job(p.mla_wuk + (size_t)l * 128 * 256, 128, 256, 256, p.wkv_t + (size_t)l * 512 * 128, 0, lds, it, tid);
    convT_job(p.mla_wuv + (size_t)l * 128 * 256, 128, 256, 256, p.wkv_t + (size_t)l * 512 * 128 + 256 * 128, 0, lds, it, tid);
    for (int d = 0; d < 2; d++) {
      convT_job(p.rw_w_up + (size_t)(l * 2 + d) * 64 * 256, 64, 256, 256, p.wup_t + (size_t)(l * 2 + d) * 256 * 64, 0, lds, it, tid);
      convT_job(p.rw_a_up + (size_t)(l * 2 + d) * 64 * 256, 64, 256, 256, p.aup_t + (size_t)(l * 2 + d) * 256 * 64, 0, lds, it, tid);
    }
    convT_job(p.rw_g_up + (size_t)l * 128 * 256, 128, 256, 256, p.gup_t + (size_t)l * 256 * 128, 0, lds, it, tid);
    convT_job(p.w_out + (size_t)l * 1024 * 1024, 1024, 1024, 1024, p.wout_t + (size_t)l * 1024 * 1024, 0, lds, it, tid);
    for (int e = 0; e < 16; e++) {
      size_t le = (size_t)(l * 16 + e);
      convT_job(p.moe_w1 + le * 1024 * 512, 1024, 512, 512, p.w13_t + le * 1024 * 1024, 1, lds, it, tid);
      convT_job(p.moe_w3 + le * 1024 * 512, 1024, 512, 512, p.w13_t + le * 1024 * 1024, 2, lds, it, tid);
      convT_job(p.moe_w2 + le * 512 * 1024, 512, 1024, 1024, p.w2_t + le * 1024 * 512, 0, lds, it, tid);
    }
    convT_job(p.ple_gate + (size_t)l * 1024 * 1024, 1024, 1024, 1024, p.wg_t + (size_t)l * 1024 * 1024, 0, lds, it, tid);
    convT_job(p.ple_proj + (size_t)l * 256 * 1024, 256, 1024, 1024, p.wp_t + (size_t)l * 1024 * 256, 0, lds, it, tid);
  }
  int gt = bid * NTHR + tid, ng = nb * NTHR;
  for (size_t i = gt; i < (size_t)T_ALL * 256; i += ng) {
    float4 v = (i < (size_t)32768 * 256) ? ((const float4*)p.x_prompt)[i] : ((const float4*)p.x_sample)[i - (size_t)32768 * 256];
    ((uint2*)p.xb)[i] = make_uint2(pack2(v.x, v.y), pack2(v.z, v.w));
  }
  for (int i = gt; i < 8192 * 16; i += ng) {
    int n = i >> 4, f = i & 15;
    double ifq = 0.0;
#pragma unroll
    for (int j = 0; j < 16; j++) ifq = (f == j) ? p.inv_freq[j] : ifq;
    double rev = (double)n * ifq * 0.15915494309189535;
    double fr = rev - rint(rev);
    float ff = (float)fr;
    p.ropec[i] = __builtin_amdgcn_cosf(ff);
    p.ropes[i] = __builtin_amdgcn_sinf(ff);
  }
  for (int i = gt; i < 512; i += ng) {
    float h0 = p.hg_lb[i], h1 = p.hg_lb[512 + i];
    p.lb[i] = 0.f;
    p.lb[512 + i] = 1.f / (1.f + __expf(h0 - h1));
  }
}

constexpr int G_STAGE = 32768;

template <bool AF32, class RowFn, class Epi>
DI void gemm_tile(RowFn rowfn, const u16* __restrict__ Bt, int K, Epi epi, char* lds, int tid) {
  const int lane = tid & 63, wid = tid >> 6, wr = wid >> 1, wc = wid & 1, fr = lane & 15, fq = lane >> 4;
  f32x4 acc[4][4];
#pragma unroll
  for (int m = 0; m < 4; m++)
#pragma unroll
    for (int n = 0; n < 4; n++) acc[m][n] = f32x4{0.f, 0.f, 0.f, 0.f};

  const int lrow = tid >> 3;
  const int lc = (tid & 7) ^ ((tid >> 4) & 7);
  const float* apf[8];
  const u16* aph[4];
  const u16* bp[4];
  if constexpr (AF32) {
#pragma unroll
    for (int i = 0; i < 8; i++) apf[i] = (const float*)rowfn(i * 16 + (tid >> 4)) + (tid & 15) * 4;
  } else {
#pragma unroll
    for (int i = 0; i < 4; i++) aph[i] = (const u16*)rowfn(lrow + i * 32) + lc * 8;
  }
#pragma unroll
  for (int i = 0; i < 4; i++) bp[i] = Bt + (size_t)(lrow + i * 32) * K + lc * 8;
  const int afoff = (tid >> 4) * 128 + ((((tid & 15) >> 1) ^ ((tid >> 5) & 7)) * 16) + (tid & 1) * 8;

  float4 raf[8];
  auto issue = [&](int buf, int k0) {
    char* A = lds + buf * G_STAGE;
    char* B = A + 16384;
#pragma unroll
    for (int i = 0; i < 4; i++)
      __builtin_amdgcn_global_load_lds((const unsigned*)(bp[i] + k0), (unsigned*)(B + wid * 1024 + i * 4096), 16, 0, 0);
    if constexpr (AF32) {
#pragma unroll
      for (int i = 0; i < 8; i++) raf[i] = *(const float4*)(apf[i] + k0);
    } else {
#pragma unroll
      for (int i = 0; i < 4; i++)
        __builtin_amdgcn_global_load_lds((const unsigned*)(aph[i] + k0), (unsigned*)(A + wid * 1024 + i * 4096), 16, 0, 0);
    }
  };
  auto astore = [&](int buf) {
    if constexpr (AF32) {
      char* A = lds + buf * G_STAGE;
#pragma unroll
      for (int i = 0; i < 8; i++) asm volatile("" : "+v"(raf[i].x), "+v"(raf[i].y), "+v"(raf[i].z), "+v"(raf[i].w));
#pragma unroll
      for (int i = 0; i < 8; i++)
        *(uint2*)(A + afoff + i * 2048) = make_uint2(pack2(raf[i].x, raf[i].y), pack2(raf[i].z, raf[i].w));
    }
  };
  const int abase = (wr * 64 + fr) * 128, bbase = 16384 + (wc * 64 + fr) * 128;
  const int sw0 = ((fq) ^ (fr >> 1)) * 16, sw1 = ((4 + fq) ^ (fr >> 1)) * 16;

  const int nk = K >> 6;
  issue(0, 0);
  astore(0);
  __syncthreads();
  for (int kt = 0; kt < nk; kt++) {
    if (kt + 1 < nk) issue((kt + 1) & 1, (kt + 1) << 6);
    __builtin_amdgcn_sched_barrier(0);
    const char* S = lds + (kt & 1) * G_STAGE;
#pragma unroll
    for (int kk = 0; kk < 2; kk++) {
      const int sw = kk ? sw1 : sw0;
      bf16x8 af[4], bfr[4];
#pragma unroll
      for (int m = 0; m < 4; m++) af[m] = *(const bf16x8*)(S + abase + m * 2048 + sw);
#pragma unroll
      for (int n = 0; n < 4; n++) bfr[n] = *(const bf16x8*)(S + bbase + n * 2048 + sw);
#pragma unroll
      for (int m = 0; m < 4; m++)
#pragma unroll
        for (int n = 0; n < 4; n++) acc[m][n] = __builtin_amdgcn_mfma_f32_16x16x32_bf16(bfr[n], af[m], acc[m][n], 0, 0, 0);
    }
    __builtin_amdgcn_sched_barrier(0);
    if (kt + 1 < nk) astore((kt + 1) & 1);
    __syncthreads();
  }
  epi(acc, wr * 64 + fr, wc * 64 + fq * 4);
}

#define EPI_LOOP(...)                                    \
  _Pragma("unroll") for (int m = 0; m < 4; m++)          \
  _Pragma("unroll") for (int n = 0; n < 4; n++) {        \
    const int row = rbase + m * 16;                      \
    const int col = cbase + n * 16;                      \
    const f32x4 v = acc[m][n];                           \
    __VA_ARGS__                                          \
  }

DI void st_bf4(u16* dst, f32x4 v) { *(uint2*)dst = make_uint2(pack2(v[0], v[1]), pack2(v[2], v[3])); }

DI const float* xin_row(const Params& p, int l, int tg) {
  if (l == 0) return tg < 32768 ? p.x_prompt + (size_t)tg * 1024 : p.x_sample + (size_t)(tg - 32768) * 1024;
  return p.out + (size_t)tg * 1024;
}

DI void phase_inproj(const Params& p, int l, int tok0, char* lds, int bid, int nb, int tid) {
  const int NT = 29, MT = T_SUB / 128;
  for (int it = 0;; it++) {
    int nt, mt;
    if (!xcd_tile(it, bid, nb, MT, NT, mt, nt)) break;
    int m0 = mt * 128, n0 = nt * 128;
    auto rowfn = [&](int r) -> const void* { return p.xb + (size_t)(tok0 + m0 + r) * 1024; };
    u16* z = p.z;
    auto epi = [&](f32x4(&acc)[4][4], int rbase, int cbase) {
      EPI_LOOP({
        int c = n0 + col;
        if (c < ZLD) st_bf4(z + (size_t)(m0 + row) * ZLD + c, v);
      })
    };
    gemm_tile<false>(rowfn, p.w_in_t + ((size_t)l * 3712 + n0) * 1024, 1024, epi, lds, tid);
  }
}

DI void phase_prep(const Params& p, int l, int N, int bid, int nb, int tid) {
  const int lane = tid & 63, wv = tid >> 6;
  const float* gq = p.mla_gq + l * 256;
  const float* gkv = p.mla_gkv + l * 128;
  const float* lb = p.lb + l * 512;
  const float* mu0 = p.rw_mu + (size_t)l * 2 * 1152;
  const float* mu1 = mu0 + 1152;
  const float* k_k = p.rw_kk + l * 256;
  const float* r_k = p.rw_rk + l * 256;
  for (int t = bid * 4 + wv; t < T_SUB; t += nb * 4) {
    u16* zr = p.z + (size_t)t * ZLD;
    const int n = t & (N - 1);
    {
      uint2 raw = *(const uint2*)(zr + lane * 4);
      float v0 = blo(raw.x), v1 = bhi(raw.x), v2 = blo(raw.y), v3 = bhi(raw.y);
      float ss = wave_sum(v0 * v0 + v1 * v1 + v2 * v2 + v3 * v3);
      float ri = rsqrtf(ss * (1.f / 256.f) + 1e-6f);
      const float* g = gq + lane * 4;
      *(uint2*)(p.cqn + (size_t)t * 256 + lane * 4) =
          make_uint2(pack2(v0 * ri * g[0], v1 * ri * g[1]), pack2(v2 * ri * g[2], v3 * ri * g[3]));
    }
    {
      unsigned raw = *(const unsigned*)(zr + 256 + lane * 2);
      float v0 = blo(raw), v1 = bhi(raw);
      float ss = wave_sum(v0 * v0 + v1 * v1);
      float ri = rsqrtf(ss * (1.f / 128.f) + 1e-6f);
      *(unsigned*)(p.ckvn + (size_t)t * 128 + lane * 2) = pack2(v0 * ri * gkv[lane * 2], v1 * ri * gkv[lane * 2 + 1]);
    }
    if (lane < 16) {
      float x1 = bf2f(zr[384 + lane]), x2 = bf2f(zr[400 + lane]);
      float c = p.ropec[n * 16 + lane], s = p.ropes[n * 16 + lane];
      u16 k1 = f2bf(x1 * c - x2 * s), k2 = f2bf(x1 * s + x2 * c);
      u16* kb = p.Kb + (size_t)t * 384;
#pragma unroll
      for (int h = 0; h < 4; h++) {
        kb[h * 96 + 64 + lane] = k1;
        kb[h * 96 + 80 + lane] = k2;
      }
    }
    {
      uint4* ptr = (uint4*)(zr + ZC_OFF + 256 + lane * 8);
      uint4 raw = *ptr;
      const float* lbp = lb + lane * 8;
      unsigned w[4] = {raw.x, raw.y, raw.z, raw.w};
#pragma unroll
      for (int j = 0; j < 4; j++) {
        float a = blo(w[j]), b = bhi(w[j]);
        float la = lbp[2 * j], lb2 = lbp[2 * j + 1];
        a = la + (1.f - la) * sigm(a);
        b = lb2 + (1.f - lb2) * sigm(b);
        w[j] = pack2(a, b);
      }
      *ptr = make_uint4(w[0], w[1], w[2], w[3]);
    }
    {
      const u16* zd = zr + ZD_OFF;
      const bool hp = n > 0, hn = n < N - 1;
      float rr[4], kx[4], vx[4];
#pragma unroll
      for (int part = 0; part < 3; part++) {
        int c = part * 256 + lane * 4;
        uint2 cur = *(const uint2*)(zd + c);
        uint2 prv = hp ? *(const uint2*)(zd - ZLD + c) : make_uint2(0, 0);
        uint2 nxt = hn ? *(const uint2*)(zd + ZLD + c) : make_uint2(0, 0);
        float cz[4] = {blo(cur.x), bhi(cur.x), blo(cur.y), bhi(cur.y)};
        float pz[4] = {blo(prv.x), bhi(prv.x), blo(prv.y), bhi(prv.y)};
        float nz[4] = {blo(nxt.x), bhi(nxt.x), blo(nxt.y), bhi(nxt.y)};
#pragma unroll
        for (int j = 0; j < 4; j++) {
          float o = cz[j] + mu0[c + j] * (pz[j] - cz[j]) + mu1[c + j] * (nz[j] - cz[j]);
          if (part == 0) rr[j] = o;
          if (part == 1) kx[j] = o;
          if (part == 2) vx[j] = o;
        }
      }
      int c4 = lane * 4;
      *(uint2*)(p.rs + (size_t)t * 256 + c4) = make_uint2(pack2(rr[0], rr[1]), pack2(rr[2], rr[3]));
      *(uint2*)(p.ks + (size_t)t * 256 + c4) = make_uint2(pack2(kx[0], kx[1]), pack2(kx[2], kx[3]));
      *(uint2*)(p.vs + (size_t)t * 256 + c4) = make_uint2(pack2(vx[0], vx[1]), pack2(vx[2], vx[3]));
      float kq[4], ss = 0.f, bo = 0.f;
#pragma unroll
      for (int j = 0; j < 4; j++) {
        kq[j] = kx[j] * k_k[c4 + j];
        ss += kq[j] * kq[j];
        bo += rr[j] * kx[j] * r_k[c4 + j];
      }
      ss = reduce16(ss);
      bo = reduce16(bo);
      float inv = 1.f / fmaxf(sqrtf(ss), 1e-12f);
      *(uint2*)(p.kk + (size_t)t * 256 + c4) = make_uint2(pack2(kq[0] * inv, kq[1] * inv), pack2(kq[2] * inv, kq[3] * inv));
      if ((lane & 15) == 0) p.bonus[(size_t)t * 4 + (lane >> 4)] = bo;
#pragma unroll
      for (int i = 0; i < 6; i++) {
        int c = 768 + lane + 64 * i;
        float cz = bf2f(zd[c]);
        float pz = hp ? bf2f(zd[c - ZLD]) : 0.f;
        float nz = hn ? bf2f(zd[c + ZLD]) : 0.f;
        float o = cz + mu0[c] * (pz - cz) + mu1[c] * (nz - cz);
        if (i < 2) o = tanh_(o);
        else if (i >= 4) o = sigm(o);
        p.S1[(size_t)t * 384 + lane + 64 * i] = f2bf(o);
      }
    }
  }
}

DI void phase_smallgemm(const Params& p, int l, int B, int N, char* lds, int bid, int nb, int tid) {
  TileIter it{bid, nb, 0};
  const int MT = T_SUB / 128;
  {
    const int NT = 3;
    for (int itx = 0;; itx++) {
      int nt, mt;
      if (!xcd_tile(itx, bid, nb, MT, NT, mt, nt)) break;
      int m0 = mt * 128, n0 = nt * 128;
      auto rowfn = [&](int r) -> const void* { return p.cqn + (size_t)(m0 + r) * 256; };
      u16* Q = p.Q;
      auto epi = [&](f32x4(&acc)[4][4], int rbase, int cbase) {
        const float SC = 0.10206207261596577f * LOG2E;
        EPI_LOOP({ st_bf4(Q + (size_t)(m0 + row) * 384 + n0 + col, v * SC); })
      };
      gemm_tile<false>(rowfn, p.wuq_t + ((size_t)l * 384 + n0) * 256, 256, epi, lds, tid);
    }
  }
  {
    const int NT = 4;
    for (int itx = 0;; itx++) {
      int nt, mt;
      if (!xcd_tile(itx, bid, nb, MT, NT, mt, nt)) break;
      int m0 = mt * 128, n0 = nt * 128;
      auto rowfn = [&](int r) -> const void* { return p.ckvn + (size_t)(m0 + r) * 128; };
      u16* Kb = p.Kb;
      u16* Vt = p.Vt;
      auto epi = [&](f32x4(&acc)[4][4], int rbase, int cbase) {
        EPI_LOOP({
          int c = n0 + col;
          int tk = m0 + row;
          if (c < 256) {
            int h = c >> 6, d = c & 63;
            st_bf4(Kb + (size_t)tk * 384 + h * 96 + d, v);
          } else {
            int cc = c - 256;
            int b = tk / N, nn = tk - b * N;
            u16* dst = Vt + ((size_t)(b * 256 + cc)) * N + nn;
            dst[0] = f2bf(v[0]);
            dst[(size_t)N] = f2bf(v[1]);
            dst[(size_t)2 * N] = f2bf(v[2]);
            dst[(size_t)3 * N] = f2bf(v[3]);
          }
        })
      };
      gemm_tile<false>(rowfn, p.wkv_t + ((size_t)l * 512 + n0) * 128, 128, epi, lds, tid);
    }
  }
  for (int d = 0; d < 2; d++) {
    const int NT = 2;
    for (int itx = 0;; itx++) {
      int nt, mt;
      if (!xcd_tile(itx, bid, nb, MT, NT, mt, nt)) break;
      int m0 = mt * 128, n0 = nt * 128;
      auto rowfn = [&](int r) -> const void* { return p.S1 + (size_t)(m0 + r) * 384 + d * 64; };
      u16* dst = p.dec + (size_t)d * T_SUB * 256;
      const float* w0 = p.rw_w0 + (l * 2 + d) * 256;
      auto epi = [&](f32x4(&acc)[4][4], int rbase, int cbase) {
        EPI_LOOP({
          f32x4 o;
          for (int j = 0; j < 4; j++) o[j] = __expf(-0.6065306597126334f * sigm(w0[n0 + col + j] + v[j]));
          st_bf4(dst + (size_t)(m0 + row) * 256 + n0 + col, o);
        })
      };
      gemm_tile<false>(rowfn, p.wup_t + ((size_t)(l * 2 + d) * 256 + n0) * 64, 64, epi, lds, tid);
    }
  }
  for (int d = 0; d < 2; d++) {
    const int NT = 2;
    for (int itx = 0;; itx++) {
      int nt, mt;
      if (!xcd_tile(itx, bid, nb, MT, NT, mt, nt)) break;
      int m0 = mt * 128, n0 = nt * 128;
      auto rowfn = [&](int r) -> const void* { return p.S1 + (size_t)(m0 + r) * 384 + 128 + d * 64; };
      u16* dka = p.kka + (size_t)d * T_SUB * 256;
      u16* dkt = p.kt + (size_t)d * T_SUB * 256;
      const float* a0 = p.rw_a0 + (l * 2 + d) * 256;
      const float* ka = p.rw_ka + l * 256;
      const u16* kkp = p.kk;
      const u16* ksp = p.ks;
      auto epi = [&](f32x4(&acc)[4][4], int rbase, int cbase) {
        EPI_LOOP({
          size_t o = (size_t)(m0 + row) * 256 + n0 + col;
          uint2 kkr = *(const uint2*)(kkp + o);
          uint2 ksr = *(const uint2*)(ksp + o);
          float kkv[4] = {blo(kkr.x), bhi(kkr.x), blo(kkr.y), bhi(kkr.y)};
          float ksv[4] = {blo(ksr.x), bhi(ksr.x), blo(ksr.y), bhi(ksr.y)};
          f32x4 o1, o2;
          for (int j = 0; j < 4; j++) {
            float a = sigm(a0[n0 + col + j] + v[j]);
            o1[j] = kkv[j] * a;
            o2[j] = ksv[j] * (1.f + (a - 1.f) * ka[n0 + col + j]);
          }
          st_bf4(dka + o, o1);
          st_bf4(dkt + o, o2);
        })
      };
      gemm_tile<false>(rowfn, p.aup_t + ((size_t)(l * 2 + d) * 256 + n0) * 64, 64, epi, lds, tid);
    }
  }
  {
    const int NT = 2;
    for (int itx = 0;; itx++) {
      int nt, mt;
      if (!xcd_tile(itx, bid, nb, MT, NT, mt, nt)) break;
      int m0 = mt * 128, n0 = nt * 128;
      auto rowfn = [&](int r) -> const void* { return p.S1 + (size_t)(m0 + r) * 384 + 256; };
      u16* dst = p.gD;
      auto epi = [&](f32x4(&acc)[4][4], int rbase, int cbase) {
        EPI_LOOP({ st_bf4(dst + (size_t)(m0 + row) * 256 + n0 + col, v); })
      };
      gemm_tile<false>(rowfn, p.gup_t + ((size_t)l * 256 + n0) * 128, 128, epi, lds, tid);
    }
  }
}

DI bf16x8 pack8(const f32x16& s, int o) {
  bf16x8 r;
#pragma unroll
  for (int j = 0; j < 8; j++) r[j] = (short)f2bf(s[o + j]);
  return r;
}

constexpr int AT_KP = 208, AT_VP = 144, AT_BUF = 64 * AT_KP + 64 * AT_VP;
DI void phase_attn(const Params& p, int B, int N, char* lds, int bid, int nb, int tid) {
  const int lane = tid & 63, wv = tid >> 6, r = lane & 31, hf = lane >> 5;
  const int nqb = N >> 7;
  const int ntask = B * 4 * nqb;
  for (int task = bid; task < ntask; task += nb) {
    const int qb = task % nqb, bh = task / nqb, h = bh & 3, b = bh >> 2;
    const size_t tb = (size_t)b * N;
    const int q = qb * 128 + wv * 32 + r;
    bf16x8 qf[6];
    {
      const u16* qrow = p.Q + (tb + q) * 384 + h * 96;
#pragma unroll
      for (int ks = 0; ks < 4; ks++) qf[ks] = *(const bf16x8*)(qrow + ks * 16 + hf * 8);
      bf16x8 x1r = *(const bf16x8*)(qrow + 64 + hf * 8);
      bf16x8 x2r = *(const bf16x8*)(qrow + 80 + hf * 8);
      const float* cp = p.ropec + q * 16 + hf * 8;
      const float* sp = p.ropes + q * 16 + hf * 8;
      bf16x8 o1, o2;
#pragma unroll
      for (int j = 0; j < 8; j++) {
        float xa = bf2f((u16)x1r[j]), ya = bf2f((u16)x2r[j]);
        float c0 = cp[j], s0 = sp[j];
        o1[j] = (short)f2bf(xa * c0 - ya * s0);
        o2[j] = (short)f2bf(xa * s0 + ya * c0);
      }
      qf[4] = o1;
      qf[5] = o2;
    }
    const u16* Kg = p.Kb + tb * 384 + h * 96;
    const u16* Vg = p.Vt + ((size_t)(b * 4 + h) * 64) * N;
    uint4 kr0, kr1, kr2, vr0, vr1;
    const int lkey = tid >> 2, lpart = tid & 3;
    const int lrow = swap23(lkey);
#define AT_GLOAD(kt_)                                                              \
  {                                                                                \
    const u16* kp_ = Kg + (size_t)((kt_) * 64 + lkey) * 384 + lpart * 24;          \
    kr0 = *(const uint4*)(kp_);                                                    \
    kr1 = *(const uint4*)(kp_ + 8);                                                \
    kr2 = *(const uint4*)(kp_ + 16);                                               \
    const u16* vp_ = Vg + (size_t)lkey * N + (kt_) * 64 + lpart * 16;              \
    vr0 = *(const uint4*)(vp_);                                                    \
    vr1 = *(const uint4*)(vp_ + 8);                                                \
  }
#define AT_LSTORE(buf_)                                                            \
  {                                                                                \
    char* Kl_ = lds + (buf_) * AT_BUF;                                             \
    char* Vl_ = Kl_ + 64 * AT_KP;                                                  \
    *(uint4*)(Kl_ + lrow * AT_KP + (lpart * 3 + 0) * 16) = kr0;                    \
    *(uint4*)(Kl_ + lrow * AT_KP + (lpart * 3 + 1) * 16) = kr1;                    \
    *(uint4*)(Kl_ + lrow * AT_KP + (lpart * 3 + 2) * 16) = kr2;                    \
    *(uint4*)(Vl_ + lkey * AT_VP + (lpart * 2 + 0) * 16) = vr0;                    \
    *(uint4*)(Vl_ + lkey * AT_VP + (lpart * 2 + 1) * 16) = vr1;                    \
  }
    f32x16 O0, O1;
#pragma unroll
    for (int i = 0; i < 16; i++) { O0[i] = 0.f; O1[i] = 0.f; }
    float mrun = -1e30f, lrun = 0.f;
    const int nt = N >> 6;
    __syncthreads();
    AT_GLOAD(0);
    AT_LSTORE(0);
    __syncthreads();
    for (int kt = 0; kt < nt; kt++) {
      if (kt + 1 < nt) AT_GLOAD(kt + 1);
      __builtin_amdgcn_sched_barrier(0);
      const char* Kl = lds + (kt & 1) * AT_BUF;
      const char* Vl = Kl + 64 * AT_KP;
      f32x16 S0, S1;
#pragma unroll
      for (int i = 0; i < 16; i++) { S0[i] = 0.f; S1[i] = 0.f; }
#pragma unroll
      for (int ks = 0; ks < 6; ks++) {
        bf16x8 a0 = *(const bf16x8*)(Kl + r * AT_KP + ks * 32 + hf * 16);
        bf16x8 a1 = *(const bf16x8*)(Kl + (32 + r) * AT_KP + ks * 32 + hf * 16);
        S0 = __builtin_amdgcn_mfma_f32_32x32x16_bf16(a0, qf[ks], S0, 0, 0, 0);
        S1 = __builtin_amdgcn_mfma_f32_32x32x16_bf16(a1, qf[ks], S1, 0, 0, 0);
      }
      float mx = S0[0];
#pragma unroll
      for (int i = 1; i < 16; i++) mx = fmaxf(mx, S0[i]);
#pragma unroll
      for (int i = 0; i < 16; i++) mx = fmaxf(mx, S1[i]);
      mx = fmaxf(mx, __shfl_xor(mx, 32));
      float mn = fmaxf(mrun, mx);
      float alpha = ex2(mrun - mn);
      mrun = mn;
      float ls = 0.f;
#pragma unroll
      for (int i = 0; i < 16; i++) {
        S0[i] = ex2(S0[i] - mn);
        S1[i] = ex2(S1[i] - mn);
        ls += S0[i] + S1[i];
      }
      lrun = lrun * alpha + ls;
#pragma unroll
      for (int i = 0; i < 16; i++) { O0[i] *= alpha; O1[i] *= alpha; }
#pragma unroll
      for (int sp = 0; sp < 4; sp++) {
        bf16x8 pb = (sp < 2) ? pack8(S0, (sp & 1) * 8) : pack8(S1, (sp & 1) * 8);
        bf16x8 v0 = *(const bf16x8*)(Vl + r * AT_VP + sp * 32 + hf * 16);
        bf16x8 v1 = *(const bf16x8*)(Vl + (32 + r) * AT_VP + sp * 32 + hf * 16);
        O0 = __builtin_amdgcn_mfma_f32_32x32x16_bf16(v0, pb, O0, 0, 0, 0);
        O1 = __builtin_amdgcn_mfma_f32_32x32x16_bf16(v1, pb, O1, 0, 0, 0);
      }
      __builtin_amdgcn_sched_barrier(0);
      if (kt + 1 < nt) AT_LSTORE((kt + 1) & 1);
      __syncthreads();
    }
    float lt = lrun + __shfl_xor(lrun, 32);
    float inv = 1.f / lt;
    u16* orow = p.cat + (tb + q) * 1024 + h * 64;
#pragma unroll
    for (int g = 0; g < 4; g++) {
      int d0 = 8 * g + 4 * hf;
      *(uint2*)(orow + d0) = make_uint2(pack2(O0[4 * g] * inv, O0[4 * g + 1] * inv), pack2(O0[4 * g + 2] * inv, O0[4 * g + 3] * inv));
      *(uint2*)(orow + 32 + d0) = make_uint2(pack2(O1[4 * g] * inv, O1[4 * g + 1] * inv), pack2(O1[4 * g + 2] * inv, O1[4 * g + 3] * inv));
    }
  }
}

DI void phase_na(const Params& p, int l, int B, int N, int bid, int nb, int tid) {
  const int lane = tid & 63, head = tid >> 6, r = lane & 31, hf = lane >> 5;
  const int rows = N >> 6;
  const int nrb = rows >> 1;
  const int ntask = B * nrb * 4;
  const float* bias = p.na_bias + (size_t)(l * 4 + head) * 15 * 31;
  for (int task = bid; task < ntask; task += nb) {
    const int cb = task & 3, rb = (task >> 2) % nrb, b = (task >> 2) / nrb;
    const size_t tb = (size_t)b * N;
    const int qrow0 = rb * 2;
    const int rstart0 = clampi(qrow0 - 4, 0, rows - 8);
    const int k0 = clampi(rstart0, 0, rows - 9);
    const int kstart = clampi(cb * 16 - 8, 0, 32);
    const int iq = r >> 4, u = r & 15;
    const int qrow = qrow0 + iq, qcol = cb * 16 + u;
    const int rstart = clampi(qrow - 4, 0, rows - 8);
    const int cstart = clampi(qcol - 8, 0, 48);
    bf16x8 qf[4];
    {
      const u16* qp = p.z + (tb + qrow * 64 + qcol) * ZLD + ZB_OFF + head * 64;
#pragma unroll
      for (int ks = 0; ks < 4; ks++) qf[ks] = *(const bf16x8*)(qp + ks * 16 + hf * 8);
    }
    f32x16 O0, O1;
#pragma unroll
    for (int i = 0; i < 16; i++) { O0[i] = 0.f; O1[i] = 0.f; }
    float mrun = -1e30f, lrun = 0.f;
    const int wk = swap23(r);
    for (int j = 0; j < 9; j++) {
      const int krow = k0 + j;
      const u16* kp = p.z + (tb + krow * 64 + kstart + wk) * ZLD + ZB_OFF + 256 + head * 64;
      f32x16 S;
#pragma unroll
      for (int i = 0; i < 16; i++) S[i] = 0.f;
#pragma unroll
      for (int ks = 0; ks < 4; ks++) {
        bf16x8 a = *(const bf16x8*)(kp + ks * 16 + hf * 8);
        S = __builtin_amdgcn_mfma_f32_32x32x16_bf16(a, qf[ks], S, 0, 0, 0);
      }
      const bool rok = (krow >= rstart) && (krow < rstart + 8);
      const int drow = clampi(krow - qrow + 7, 0, 14);
      const float* brow = bias + drow * 31;
      float mx = -1e30f;
#pragma unroll
      for (int i = 0; i < 16; i++) {
        int w = 16 * (i >> 3) + 8 * hf + 4 * ((i >> 2) & 1) + (i & 3);
        int kcol = kstart + w;
        bool ok = rok && (kcol >= cstart) && (kcol < cstart + 16);
        int dcol = clampi(kcol - qcol + 15, 0, 30);
        float s = (S[i] * 0.125f + brow[dcol]) * LOG2E;
        S[i] = ok ? s : -1e30f;
        mx = fmaxf(mx, S[i]);
      }
      mx = fmaxf(mx, __shfl_xor(mx, 32));
      float mn = fmaxf(mrun, mx);
      float alpha = ex2(mrun - mn);
      mrun = mn;
      float ls = 0.f;
#pragma unroll
      for (int i = 0; i < 16; i++) {
        float pv = (S[i] > -1e29f) ? ex2(S[i] - mn) : 0.f;
        S[i] = pv;
        ls += pv;
      }
      lrun = lrun * alpha + ls;
#pragma unroll
      for (int i = 0; i < 16; i++) { O0[i] *= alpha; O1[i] *= alpha; }
      const u16* vbase = p.z + (tb + krow * 64 + kstart) * ZLD + ZB_OFF + 512 + head * 64 + r;
#pragma unroll
      for (int s = 0; s < 2; s++) {
        bf16x8 pb = pack8(S, s * 8);
        bf16x8 v0, v1;
#pragma unroll
        for (int jj = 0; jj < 8; jj++) {
          const u16* vp = vbase + (size_t)(16 * s + 8 * hf + jj) * ZLD;
          v0[jj] = (short)vp[0];
          v1[jj] = (short)vp[32];
        }
        O0 = __builtin_amdgcn_mfma_f32_32x32x16_bf16(v0, pb, O0, 0, 0, 0);
        O1 = __builtin_amdgcn_mfma_f32_32x32x16_bf16(v1, pb, O1, 0, 0, 0);
      }
    }
    float lt = lrun + __shfl_xor(lrun, 32);
    float inv = 1.f / lt;
    u16* orow = p.cat + (tb + qrow * 64 + qcol) * 1024 + 256 + head * 64;
#pragma unroll
    for (int g = 0; g < 4; g++) {
      int d0 = 8 * g + 4 * hf;
      *(uint2*)(orow + d0) = make_uint2(pack2(O0[4 * g] * inv, O0[4 * g + 1] * inv), pack2(O0[4 * g + 2] * inv, O0[4 * g + 3] * inv));
      *(uint2*)(orow + 32 + d0) = make_uint2(pack2(O1[4 * g] * inv, O1[4 * g + 1] * inv), pack2(O1[4 * g + 2] * inv, O1[4 * g + 3] * inv));
    }
  }
}

using f32x2 = __attribute__((ext_vector_type(2))) float;
constexpr int SC_STEPS = 16;

DI void sc_store(char* buf, int dst, uint4 R, bool hgw) {
  float4 lo = make_float4(blo(R.x), bhi(R.x), blo(R.y), bhi(R.y));
  float4 hi = make_float4(blo(R.z), bhi(R.z), blo(R.w), bhi(R.w));
  *(float4*)(buf + dst) = lo;
  *(float4*)(buf + dst + 16) = hi;
  if (hgw) {
    *(float4*)(buf + dst + 256) = make_float4(1.f - lo.x, 1.f - lo.y, 1.f - lo.z, 1.f - lo.w);
    *(float4*)(buf + dst + 272) = make_float4(1.f - hi.x, 1.f - hi.y, 1.f - hi.z, 1.f - hi.w);
  }
}

template <bool RW>
DI void scan_task(const Params& p, int task, int N, char* lds, int tid) {
  constexpr int NA = RW ? 5 : 3;
  constexpr int VOFF = SC_STEPS * NA * 256;
  constexpr int BUF = VOFF + SC_STEPS * 64;
  const int lane = tid & 63, wv = tid >> 6, kq = lane & 15, rg = lane >> 4;
  const int rq = task & 3, hh = (task >> 2) & 3, dir = (task >> 4) & 1, b = task >> 5;
  const size_t tb = (size_t)b * N;
  const int sub = tid >> 7, lt = tid & 127, lstep = lt >> 3, lpart = lt & 7;
  const int vstep = lt >> 1, vhalf = lt & 1;
  const u16 *src0 = nullptr, *src1 = nullptr, *src2 = nullptr;
  int dst0 = 0, dst1 = 0, dst2 = 0, st0 = 0, st1 = 0, st2 = 0;
  bool act0 = false, act1 = false, act2 = false, hgw = false;
  int ld;
  const int acol = hh * 64 + lpart * 8;
  const int vcol = hh * 64 + rq * 16 + vhalf * 8;
  const int vdst = VOFF + vstep * 64 + vhalf * 32;
  if (RW) {
    ld = 256;
    act0 = true; st0 = lstep;
    src0 = sub ? (p.dec + (size_t)dir * T_SUB * 256 + acol) : (p.rs + acol);
    dst0 = (lstep * NA + (sub ? 1 : 0)) * 256 + lpart * 32;
    act1 = true; st1 = lstep;
    src1 = sub ? (p.kk + acol) : (p.kt + (size_t)dir * T_SUB * 256 + acol);
    dst1 = (lstep * NA + (sub ? 3 : 2)) * 256 + lpart * 32;
    if (sub == 0) { act2 = true; st2 = lstep; src2 = p.kka + (size_t)dir * T_SUB * 256 + acol; dst2 = (lstep * NA + 4) * 256 + lpart * 32; }
    else { act2 = lt < 32; st2 = vstep; src2 = p.vs + vcol; dst2 = vdst; }
  } else {
    ld = ZLD;
    act0 = true; st0 = lstep;
    src0 = sub ? (p.z + ZC_OFF + 256 * (1 + dir) + acol) : (p.z + ZC_OFF + acol);
    dst0 = (lstep * NA + (sub ? 1 : 0)) * 256 + lpart * 32;
    hgw = sub != 0;
    if (sub == 0) { act1 = lt < 32; st1 = vstep; src1 = p.z + ZC_OFF + 768 + vcol; dst1 = vdst; }
  }
  u16* pout = (RW ? p.oD : p.oC) + (size_t)dir * T_SUB * 256 + hh * 64 + rq * 16 + wv * 4 + rg;
  pout += (tb + (dir ? (N - 1) : 0)) * 256;
  const int ostride = dir ? -256 : 256;

#define SC_TOK(c_, st_) (tb + (size_t)(dir ? (N - 1 - ((c_) * SC_STEPS + (st_))) : ((c_) * SC_STEPS + (st_))))
#define SC_ISSUE(Ra, Rb, Rc, c_)                                               \
  {                                                                            \
    if (act0) Ra = *(const uint4*)(src0 + SC_TOK(c_, st0) * ld);               \
    if (act1) Rb = *(const uint4*)(src1 + SC_TOK(c_, st1) * ld);               \
    if (act2) Rc = *(const uint4*)(src2 + SC_TOK(c_, st2) * ld);               \
  }
#define SC_STORE(Ra, Rb, Rc, buf_)                                             \
  {                                                                            \
    if (act0) sc_store(buf_, dst0, Ra, hgw);                                   \
    if (act1) sc_store(buf_, dst1, Rb, false);                                 \
    if (act2) sc_store(buf_, dst2, Rc, false);                                 \
  }
  f32x2 S01 = {0.f, 0.f}, S23 = {0.f, 0.f};
#define SC_LD(buf_, s_, r_, w_, t_, k_, a_, v_)                                              \
  {                                                                                          \
    const char* rowp_ = (buf_) + (s_) * NA * 256 + kq * 16;                                  \
    r_ = *(const float4*)(rowp_);                                                            \
    w_ = *(const float4*)(rowp_ + 256);                                                      \
    t_ = *(const float4*)(rowp_ + 512);                                                      \
    if (RW) {                                                                                \
      k_ = *(const float4*)(rowp_ + 768);                                                    \
      a_ = *(const float4*)(rowp_ + 1024);                                                   \
    }                                                                                        \
    v_ = *(const float*)((buf_) + VOFF + (s_) * 64 + (wv * 4 + rg) * 4);                     \
  }
#define SC_COMPUTE(buf_)                                                                     \
  {                                                                                          \
    float osel = 0.f;                                                                        \
    float4 r4, w4, t4, k4, a4, nr4, nw4, nt4, nk4, na4;                                      \
    float vv, nvv;                                                                           \
    k4 = a4 = nk4 = na4 = make_float4(0.f, 0.f, 0.f, 0.f);                                   \
    SC_LD(buf_, 0, r4, w4, t4, k4, a4, vv);                                                  \
    _Pragma("unroll") for (int s = 0; s < SC_STEPS; s++) {                                   \
      if (s + 1 < SC_STEPS) SC_LD(buf_, s + 1, nr4, nw4, nt4, nk4, na4, nvv);                \
      f32x2 ta = f32x2{t4.x, t4.y} * vv, tb2 = f32x2{t4.z, t4.w} * vv;                       \
      if (RW) {                                                                              \
        f32x2 pp = S01 * f32x2{k4.x, k4.y};                                                  \
        pp = S23 * f32x2{k4.z, k4.w} + pp;                                                   \
        const float sa = -reduce16(pp.x + pp.y);                                             \
        ta = f32x2{a4.x, a4.y} * sa + ta;                                                    \
        tb2 = f32x2{a4.z, a4.w} * sa + tb2;                                                  \
      }                                                                                      \
      S01 = S01 * f32x2{w4.x, w4.y} + ta;                                                    \
      S23 = S23 * f32x2{w4.z, w4.w} + tb2;                                                   \
      f32x2 qq = S01 * f32x2{r4.x, r4.y};                                                    \
      qq = S23 * f32x2{r4.z, r4.w} + qq;                                                     \
      const float o = reduce16(qq.x + qq.y);                                                 \
      osel = (kq == s) ? o : osel;                                                           \
      r4 = nr4; w4 = nw4; t4 = nt4; k4 = nk4; a4 = na4; vv = nvv;                            \
    }                                                                                        \
    pout[kq * ostride] = f2bf(osel);                                                         \
    pout += SC_STEPS * ostride;                                                              \
  }
  uint4 A0 = make_uint4(0, 0, 0, 0), A1 = A0, A2 = A0, B0 = A0, B1 = A0, B2 = A0;
  char* buf0 = lds;
  char* buf1 = lds + BUF;
  const int nch = N / SC_STEPS;
  __syncthreads();
  SC_ISSUE(A0, A1, A2, 0);
  SC_ISSUE(B0, B1, B2, 1);
  SC_STORE(A0, A1, A2, buf0);
  __syncthreads();
  for (int c = 0; c < nch; c += 2) {
    if (c + 2 < nch) SC_ISSUE(A0, A1, A2, c + 2);
    __builtin_amdgcn_sched_barrier(0);
    SC_COMPUTE(buf0);
    __builtin_amdgcn_sched_barrier(0);
    SC_STORE(B0, B1, B2, buf1);
    __syncthreads();
    if (c + 3 < nch) SC_ISSUE(B0, B1, B2, c + 3);
    __builtin_amdgcn_sched_barrier(0);
    SC_COMPUTE(buf1);
    __builtin_amdgcn_sched_barrier(0);
    if (c + 2 < nch) SC_STORE(A0, A1, A2, buf0);
    __syncthreads();
  }
}

DI void phase_scan(const Params& p, int B, int N, char* lds, int bid, int nb, int tid) {
  const int nper = B * 32;
  for (int task = bid; task < 2 * nper; task += nb) {
    if (task < nper) scan_task<true>(p, task, N, lds, tid);
    else scan_task<false>(p, task - nper, N, lds, tid);
  }
}

DI void phase_final(const Params& p, int l, int bid, int nb, int tid) {
  const int lane = tid & 63, wv = tid >> 6, c4 = lane * 4;
  const float* gn = p.hg_gnorm + l * 256 + c4;
  const float* lw = p.rw_ln_w + l * 256 + c4;
  const float* lbb = p.rw_ln_b + l * 256 + c4;
  for (int t = bid * 4 + wv; t < T_SUB; t += nb * 4) {
    {
      uint2 a = *(const uint2*)(p.oC + (size_t)t * 256 + c4);
      uint2 bq = *(const uint2*)(p.oC + (size_t)(T_SUB + t) * 256 + c4);
      float o[4] = {blo(a.x) + blo(bq.x), bhi(a.x) + bhi(bq.x), blo(a.y) + blo(bq.y), bhi(a.y) + bhi(bq.y)};
      float ss = reduce16(o[0] * o[0] + o[1] * o[1] + o[2] * o[2] + o[3] * o[3]);
      float ri = rsqrtf(ss * (1.f / 64.f) + 1e-6f);
      uint2 gr = *(const uint2*)(p.z + (size_t)t * ZLD + ZC_OFF + 1024 + c4);
      float g[4] = {blo(gr.x), bhi(gr.x), blo(gr.y), bhi(gr.y)};
      float y[4];
#pragma unroll
      for (int j = 0; j < 4; j++) y[j] = o[j] * ri * gn[j] * (g[j] * sigm(g[j]));
      *(uint2*)(p.cat + (size_t)t * 1024 + 512 + c4) = make_uint2(pack2(y[0], y[1]), pack2(y[2], y[3]));
    }
    {
      uint2 a = *(const uint2*)(p.oD + (size_t)t * 256 + c4);
      uint2 bq = *(const uint2*)(p.oD + (size_t)(T_SUB + t) * 256 + c4);
      float o[4] = {blo(a.x) + blo(bq.x), bhi(a.x) + bhi(bq.x), blo(a.y) + blo(bq.y), bhi(a.y) + bhi(bq.y)};
      float mu = reduce16(o[0] + o[1] + o[2] + o[3]) * (1.f / 64.f);
      float d0 = o[0] - mu, d1 = o[1] - mu, d2 = o[2] - mu, d3 = o[3] - mu;
      float var = reduce16(d0 * d0 + d1 * d1 + d2 * d2 + d3 * d3) * (1.f / 64.f);
      float ri = rsqrtf(var + 64e-5f);
      float bo = p.bonus[(size_t)t * 4 + (lane >> 4)];
      uint2 vr = *(const uint2*)(p.vs + (size_t)t * 256 + c4);
      uint2 gr = *(const uint2*)(p.gD + (size_t)t * 256 + c4);
      float vv[4] = {blo(vr.x), bhi(vr.x), blo(vr.y), bhi(vr.y)};
      float g[4] = {blo(gr.x), bhi(gr.x), blo(gr.y), bhi(gr.y)};
      float dd[4] = {d0, d1, d2, d3};
      float y[4];
#pragma unroll
      for (int j = 0; j < 4; j++) y[j] = (dd[j] * ri * lw[j] + lbb[j] + bo * vv[j]) * g[j];
      *(uint2*)(p.cat + (size_t)t * 1024 + 768 + c4) = make_uint2(pack2(y[0], y[1]), pack2(y[2], y[3]));
    }
  }
}

DI void phase_wout(const Params& p, int l, int tok0, char* lds, int bid, int nb, int tid) {
  const int NT = 8, MT = T_SUB / 128;
  for (int it = 0;; it++) {
    int nt, mt;
    if (!xcd_tile(it, bid, nb, MT, NT, mt, nt)) break;
    int m0 = mt * 128, n0 = nt * 128;
    auto rowfn = [&](int r) -> const void* { return p.cat + (size_t)(m0 + r) * 1024; };
    auto epi = [&](f32x4(&acc)[4][4], int rbase, int cbase) {
      EPI_LOOP({
        int tg = tok0 + m0 + row;
        float4 xv = *(const float4*)(xin_row(p, l, tg) + n0 + col);
        float4 o = make_float4(ALPHA_F * xv.x + v[0], ALPHA_F * xv.y + v[1], ALPHA_F * xv.z + v[2], ALPHA_F * xv.w + v[3]);
        *(float4*)(p.out + (size_t)tg * 1024 + n0 + col) = o;
      })
    };
    gemm_tile<false>(rowfn, p.wout_t + ((size_t)l * 1024 + n0) * 1024, 1024, epi, lds, tid);
  }
}

template <bool ROUTER>
DI void phase_ln(const Params& p, const float* g, const float* bta, const float* wrouter, int tok0, int ntok, char* lds,
                 int bid, int nb, int tid) {
  const int lane = tid & 63, wv = tid >> 6;
  float* wl = (float*)lds;
  if (ROUTER) {
    __syncthreads();
    for (int i = tid; i < 16384; i += NTHR) {
      int k = i >> 4, e = i & 15;
      wl[e * 1024 + k] = wrouter[i];
    }
    __syncthreads();
  }
  for (int t = bid * 4 + wv; t < ntok; t += nb * 4) {
    const int tg = tok0 + t;
    float* xr = p.out + (size_t)tg * 1024;
    float4 x[4];
    float s = 0.f;
#pragma unroll
    for (int i = 0; i < 4; i++) {
      x[i] = *(const float4*)(xr + i * 256 + lane * 4);
      s += x[i].x + x[i].y + x[i].z + x[i].w;
    }
    float mu = wave_sum(s) * (1.f / 1024.f);
    float vs = 0.f;
#pragma unroll
    for (int i = 0; i < 4; i++) {
      x[i].x -= mu; x[i].y -= mu; x[i].z -= mu; x[i].w -= mu;
      vs += x[i].x * x[i].x + x[i].y * x[i].y + x[i].z * x[i].z + x[i].w * x[i].w;
    }
    float ri = rsqrtf(wave_sum(vs) * (1.f / 1024.f) + 1e-5f);
#pragma unroll
    for (int i = 0; i < 4; i++) {
      float4 gg = *(const float4*)(g + i * 256 + lane * 4);
      float4 bb = *(const float4*)(bta + i * 256 + lane * 4);
      x[i].x = x[i].x * ri * gg.x + bb.x;
      x[i].y = x[i].y * ri * gg.y + bb.y;
      x[i].z = x[i].z * ri * gg.z + bb.z;
      x[i].w = x[i].w * ri * gg.w + bb.w;
      *(float4*)(xr + i * 256 + lane * 4) = x[i];
      *(uint2*)(p.xb + (size_t)tg * 1024 + i * 256 + lane * 4) = make_uint2(pack2(x[i].x, x[i].y), pack2(x[i].z, x[i].w));
    }
    if (ROUTER) {
      float mine = 0.f;
#pragma unroll 1
      for (int e = 0; e < 16; e++) {
        float a = 0.f;
#pragma unroll
        for (int i = 0; i < 4; i++) {
          float4 w = *(const float4*)(wl + e * 1024 + i * 256 + lane * 4);
          a += x[i].x * w.x + x[i].y * w.y + x[i].z * w.z + x[i].w * w.w;
        }
        a = wave_sum(a);
        mine = (lane == e) ? a : mine;
      }
      float mx = mine;
      mx = fmaxf(mx, dpp_f<0xB1>(mx));
      mx = fmaxf(mx, dpp_f<0x4E>(mx));
      mx = fmaxf(mx, dpp_f<0x141>(mx));
      mx = fmaxf(mx, dpp_f<0x140>(mx));
      float ex = __expf(mine - mx);
      float sum = reduce16(ex);
      mine = ex / sum;
      if (lane < 16) {
        if (tg < 32768) p.affT[(size_t)lane * 32768 + tg] = mine;
        else p.affT[(size_t)16 * 32768 + (size_t)lane * 65536 + (tg - 32768)] = mine;
      }
    }
  }
}

DI void phase_topk(const Params& p, char* lds, int bid, int nb, int tid) {
  if (bid < 32) {
    unsigned* hist = (unsigned*)lds;
    unsigned* sh = hist + 256;
    unsigned* eqc = sh + 8;
    const int g = bid >> 4, e = bid & 15;
    const int T = g ? 65536 : 32768, cap = T >> 3;
    const int tok0 = g ? 32768 : 0;
    const float* vals = p.affT + (g ? (size_t)16 * 32768 : 0) + (size_t)e * T;
    int* oidx = p.idx + (g ? 65536 : 0) + e * cap;
    float* ogate = p.gate + (g ? 65536 : 0) + e * cap;
    unsigned prefix = 0, mask = 0;
    int remaining = cap;
    for (int pass = 0; pass < 4; pass++) {
      const int shift = 24 - 8 * pass;
      hist[tid] = 0;
      __syncthreads();
      for (int i = tid; i < T; i += NTHR) {
        unsigned u = __float_as_uint(vals[i]);
        if ((u & mask) == prefix) atomicAdd(&hist[(u >> shift) & 255], 1u);
      }
      __syncthreads();
      if (tid == 0) {
        int cum = 0, sel = 0;
        for (int bq = 255; bq >= 0; bq--) {
          int hc = (int)hist[bq];
          if (cum + hc >= remaining) { sel = bq; break; }
          cum += hc;
        }
        sh[0] = (unsigned)sel;
        sh[1] = (unsigned)(remaining - cum);
      }
      __syncthreads();
      prefix |= sh[0] << shift;
      remaining = (int)sh[1];
      mask |= 0xFFu << shift;
      __syncthreads();
    }
    const unsigned thr = prefix;
    const int need = remaining;
    const int ch = T >> 8;
    const float* my = vals + tid * ch;
    int ec = 0;
    for (int i = 0; i < ch; i++) ec += (__float_as_uint(my[i]) == thr) ? 1 : 0;
    eqc[tid] = ec;
    if (tid == 0) sh[2] = 0;
    __syncthreads();
    int eq_rank = 0;
    for (int i = 0; i < tid; i++) eq_rank += eqc[i];
    for (int i = 0; i < ch; i++) {
      float v = my[i];
      unsigned u = __float_as_uint(v);
      if (u > thr) {
        int pos = (int)atomicAdd(&sh[2], 1u);
        oidx[pos] = tok0 + tid * ch + i;
        ogate[pos] = v;
      } else if (u == thr) {
        if (eq_rank < need) {
          int pos = cap - need + eq_rank;
          oidx[pos] = tok0 + tid * ch + i;
          ogate[pos] = v;
        }
        eq_rank++;
      }
    }
    __syncthreads();
  } else {
    const size_t n4 = (size_t)T_ALL * 1024 / 4;
    const float4* src = (const float4*)p.out;
    float4* dst = (float4*)p.Y;
    for (size_t i = (size_t)(bid - 32) * NTHR + tid; i < n4; i += (size_t)(nb - 32) * NTHR) {
      float4 v = src[i];
      dst[i] = make_float4(v.x * ALPHA_F, v.y * ALPHA_F, v.z * ALPHA_F, v.w * ALPHA_F);
    }
  }
}

DI void moe_rowinfo(int row0, int l, int& e, int& ioff) {
  if (row0 < 65536) { e = row0 >> 12; }
  else { e = (row0 - 65536) >> 13; }
  ioff = row0;
}

DI void phase_moe1(const Params& p, int l, char* lds, int bid, int nb, int tid) {
  const int NT = 8, MT = 196608 / 128;
  for (int it = 0;; it++) {
    int nt, mt;
    if (!xcd_tile(it, bid, nb, MT, NT, mt, nt)) break;
    int m0 = mt * 128, n0 = nt * 128;
    int e, ioff;
    moe_rowinfo(m0, l, e, ioff);
    const int* ip = p.idx + ioff;
    auto rowfn = [&](int r) -> const void* { return p.xb + (size_t)ip[r] * 1024; };
    u16* H = p.H;
    auto epi = [&](f32x4(&acc)[4][4], int rbase, int cbase) {
#pragma unroll
      for (int m = 0; m < 4; m++)
#pragma unroll
        for (int n = 0; n < 4; n += 2) {
          int row = rbase + m * 16;
          int col = cbase + n * 16;
          int blk = (n0 + (col & ~31)) >> 1;
          int hc = blk + (col & 15);
          f32x4 a = acc[m][n], bq = acc[m][n + 1];
          f32x4 o;
          for (int j = 0; j < 4; j++) o[j] = a[j] * sigm(a[j]) * bq[j];
          st_bf4(H + (size_t)(m0 + row) * 512 + hc, o);
        }
    };
    gemm_tile<false>(rowfn, p.w13_t + ((size_t)(l * 16 + e) * 1024 + n0) * 1024, 1024, epi, lds, tid);
  }
}

DI void phase_moe2(const Params& p, int l, char* lds, int bid, int nb, int tid) {
  TileIter it{bid, nb, 0};
  {
    const int NT = 8, MT = 196608 / 128;
    for (int itx = 0;; itx++) {
      int nt, mt;
      if (!xcd_tile(itx, bid, nb, MT, NT, mt, nt)) break;
      int m0 = mt * 128, n0 = nt * 128;
      int e, ioff;
      moe_rowinfo(m0, l, e, ioff);
      const int* ip = p.idx + ioff;
      const float* gp = p.gate + ioff;
      auto rowfn = [&](int r) -> const void* { return p.H + (size_t)(m0 + r) * 512; };
      float* Y = p.Y;
      auto epi = [&](f32x4(&acc)[4][4], int rbase, int cbase) {
        EPI_LOOP({
          int tk = ip[row];
          float gt = gp[row];
          float* dst = Y + (size_t)tk * 1024 + n0 + col;
          for (int j = 0; j < 4; j++) unsafeAtomicAdd(dst + j, gt * v[j]);
        })
      };
      gemm_tile<false>(rowfn, p.w2_t + ((size_t)(l * 16 + e) * 1024 + n0) * 512, 512, epi, lds, tid);
    }
  }
  {
    const int NT = 8, MT = T_ALL / 128;
    for (int itx = 0;; itx++) {
      int nt, mt;
      if (!xcd_tile(itx, bid, nb, MT, NT, mt, nt)) break;
      int m0 = mt * 128, n0 = nt * 128;
      auto rowfn = [&](int r) -> const void* {
        int tg = m0 + r;
        return tg < 32768 ? p.p_prompt + ((size_t)l * 32768 + tg) * 256 : p.p_sample + ((size_t)l * 65536 + (tg - 32768)) * 256;
      };
      auto epi = [&](f32x4(&acc)[4][4], int rbase, int cbase) {
        EPI_LOOP({ *(float4*)(p.out + (size_t)(m0 + row) * 1024 + n0 + col) = make_float4(v[0], v[1], v[2], v[3]); })
      };
      gemm_tile<true>(rowfn, p.wp_t + ((size_t)l * 1024 + n0) * 256, 256, epi, lds, tid);
    }
  }
}

DI void phase_ple(const Params& p, int l, char* lds, int bid, int nb, int tid) {
  const int NT = 8, MT = T_ALL / 128;
  for (int it = 0;; it++) {
    int nt, mt;
    if (!xcd_tile(it, bid, nb, MT, NT, mt, nt)) break;
    int m0 = mt * 128, n0 = nt * 128;
    auto rowfn = [&](int r) -> const void* { return p.Y + (size_t)(m0 + r) * 1024; };
    auto epi = [&](f32x4(&acc)[4][4], int rbase, int cbase) {
      EPI_LOOP({
        size_t o = (size_t)(m0 + row) * 1024 + n0 + col;
        float4 u = *(const float4*)(p.Y + o);
        float4 pp = *(const float4*)(p.out + o);
        *(float4*)(p.out + o) = make_float4(u.x + sigm(v[0]) * pp.x, u.y + sigm(v[1]) * pp.y, u.z + sigm(v[2]) * pp.z,
                                            u.w + sigm(v[3]) * pp.w);
      })
    };
    gemm_tile<true>(rowfn, p.wg_t + ((size_t)l * 1024 + n0) * 1024, 1024, epi, lds, tid);
  }
}

__global__ void __launch_bounds__(NTHR, 2) mega(Params p) {
  __shared__ __attribute__((aligned(16))) char lds[73728];
  cg::grid_group grid = cg::this_grid();
  const int tid0 = threadIdx.x, bid0 = blockIdx.x, nb = gridDim.x;
  int pc = 0;
#define PHASE(...)                                      \
  {                                                     \
    if (pc >= p.pb && pc < p.pe) {                      \
      if (pc > p.pb) grid.sync();                       \
      int tid = tid0, bid = bid0;                       \
      asm volatile("" : "+v"(tid), "+s"(bid));          \
      __VA_ARGS__;                                      \
    }                                                   \
    pc++;                                               \
  }
  PHASE(phase_convert(p, lds, bid, nb, tid));
  for (int l = 0; l < 2; l++) {
    for (int sg = 0; sg < 3; sg++) {
      const int tok0 = sg * T_SUB;
      const int B = sg == 0 ? 4 : 8, N = sg == 0 ? 8192 : 4096;
      PHASE(phase_inproj(p, l, tok0, lds, bid, nb, tid));
#if REP_INPROJ
      PHASE(phase_inproj(p, l, tok0, lds, bid, nb, tid));
#endif
      PHASE(phase_prep(p, l, N, bid, nb, tid));
      PHASE(phase_smallgemm(p, l, B, N, lds, bid, nb, tid));
      PHASE(phase_attn(p, B, N, lds, bid, nb, tid));
#if REP_ATTN
      PHASE(phase_attn(p, B, N, lds, bid, nb, tid));
#endif
      PHASE(phase_na(p, l, B, N, bid, nb, tid));
#if REP_NA
      PHASE(phase_na(p, l, B, N, bid, nb, tid));
#endif
      PHASE(phase_scan(p, B, N, lds, bid, nb, tid));
#if REP_SCAN
      PHASE(phase_scan(p, B, N, lds, bid, nb, tid));
#endif
      PHASE(phase_final(p, l, bid, nb, tid));
      PHASE(phase_wout(p, l, tok0, lds, bid, nb, tid));
      PHASE(phase_ln<true>(p, p.ln1_g + l * 1024, p.ln1_b + l * 1024, p.moe_router + (size_t)l * 16384, tok0, T_SUB, lds, bid, nb, tid));
    }
    PHASE(phase_topk(p, lds, bid, nb, tid));
    PHASE(phase_moe1(p, l, lds, bid, nb, tid));
#if REP_MOE1
    PHASE(phase_moe1(p, l, lds, bid, nb, tid));
#endif
    PHASE(phase_moe2(p, l, lds, bid, nb, tid));
    PHASE(phase_ple(p, l, lds, bid, nb, tid));
    PHASE(phase_ln<false>(p, p.ln2_g + l * 1024, p.ln2_b + l * 1024, nullptr, 0, T_ALL, lds, bid, nb, tid));
  }
}

#define N_PHASES 1000
#ifndef FUSED
#define FUSED 1
#endif

extern "C" void kernel_launch(void* const* d_in, const int* in_sizes, int n_in, void* d_out, int out_size, void* d_ws,
                              size_t ws_size, hipStream_t stream) {
  static int grid_blocks = 0;
  if (!grid_blocks) {
    int dev = 0, cus = 0, per_cu = 0;
    (void)hipGetDevice(&dev);
    (void)hipDeviceGetAttribute(&cus, hipDeviceAttributeMultiprocessorCount, dev);
    (void)hipOccupancyMaxActiveBlocksPerMultiprocessor(&per_cu, mega, NTHR, 0);
    if (per_cu > 2) per_cu = 2;
    if (per_cu < 1) per_cu = 1;
    grid_blocks = cus * per_cu;
  }
  Params p;
  memset(&p, 0, sizeof(p));
  const float* const* in = (const float* const*)d_in;
  int k = 0;
  p.x_prompt = in[k++]; p.x_sample = in[k++]; p.p_prompt = in[k++]; p.p_sample = in[k++];
  p.w_in = in[k++]; p.mla_gq = in[k++]; p.mla_gkv = in[k++]; p.mla_wuq = in[k++]; p.mla_wuk = in[k++]; p.mla_wuv = in[k++];
  p.na_bias = in[k++]; p.hg_lb = in[k++]; p.hg_gnorm = in[k++];
  p.rw_mu = in[k++]; p.rw_w0 = in[k++]; p.rw_w_up = in[k++]; p.rw_a0 = in[k++]; p.rw_a_up = in[k++]; p.rw_g_up = in[k++];
  p.rw_kk = in[k++]; p.rw_ka = in[k++]; p.rw_rk = in[k++]; p.rw_ln_w = in[k++]; p.rw_ln_b = in[k++];
  p.w_out = in[k++]; p.ln1_g = in[k++]; p.ln1_b = in[k++]; p.moe_router = in[k++]; p.moe_w1 = in[k++]; p.moe_w3 = in[k++];
  p.moe_w2 = in[k++]; p.ln2_g = in[k++]; p.ln2_b = in[k++]; p.ple_gate = in[k++]; p.ple_proj = in[k++];
  p.out = (float*)d_out;
  char* ws = (char*)d_ws;
  size_t off = 0;
  auto take = [&](size_t bytes) { char* r = ws + off; off += (bytes + 255) & ~(size_t)255; return r; };
  p.w_in_t = (u16*)take((size_t)2 * 3712 * 1024 * 2);
  p.wuq_t = (u16*)take((size_t)2 * 384 * 256 * 2);
  p.wkv_t = (u16*)take((size_t)2 * 512 * 128 * 2);
  p.wup_t = (u16*)take((size_t)4 * 256 * 64 * 2);
  p.aup_t = (u16*)take((size_t)4 * 256 * 64 * 2);
  p.gup_t = (u16*)take((size_t)2 * 256 * 128 * 2);
  p.wout_t = (u16*)take((size_t)2 * 1024 * 1024 * 2);
  p.w13_t = (u16*)take((size_t)32 * 1024 * 1024 * 2);
  p.w2_t = (u16*)take((size_t)32 * 1024 * 512 * 2);
  p.wg_t = (u16*)take((size_t)2 * 1024 * 1024 * 2);
  p.wp_t = (u16*)take((size_t)2 * 1024 * 256 * 2);
  p.ropec = (float*)take((size_t)8192 * 16 * 4);
  p.ropes = (float*)take((size_t)8192 * 16 * 4);
  p.lb = (float*)take(1024 * 4);
  p.affT = (float*)take((size_t)16 * T_ALL * 4);
  p.gate = (float*)take((size_t)196608 * 4);
  p.idx = (int*)take((size_t)196608 * 4);
  p.xb = (u16*)take((size_t)T_ALL * 1024 * 2);
  const size_t stage0 = off;
  p.z = (u16*)take((size_t)T_SUB * ZLD * 2);
  p.cat = (u16*)take((size_t)T_SUB * 1024 * 2);
  p.Q = (u16*)take((size_t)T_SUB * 384 * 2);
  p.Kb = (u16*)take((size_t)T_SUB * 384 * 2);
  p.Vt = (u16*)take((size_t)T_SUB * 256 * 2);
  p.cqn = (u16*)take((size_t)T_SUB * 256 * 2);
  p.ckvn = (u16*)take((size_t)T_SUB * 128 * 2);
  p.S1 = (u16*)take((size_t)T_SUB * 384 * 2);
  p.rs = (u16*)take((size_t)T_SUB * 256 * 2);
  p.ks = (u16*)take((size_t)T_SUB * 256 * 2);
  p.vs = (u16*)take((size_t)T_SUB * 256 * 2);
  p.kk = (u16*)take((size_t)T_SUB * 256 * 2);
  p.gD = (u16*)take((size_t)T_SUB * 256 * 2);
  p.dec = (u16*)take((size_t)2 * T_SUB * 256 * 2);
  p.kka = (u16*)take((size_t)2 * T_SUB * 256 * 2);
  p.kt = (u16*)take((size_t)2 * T_SUB * 256 * 2);
  p.oC = (u16*)take((size_t)2 * T_SUB * 256 * 2);
  p.oD = (u16*)take((size_t)2 * T_SUB * 256 * 2);
  p.bonus = (float*)take((size_t)T_SUB * 4 * 4);
  off = stage0;
  p.Y = (float*)take((size_t)T_ALL * 1024 * 4);
  p.H = (u16*)take((size_t)196608 * 512 * 2);
  for (int i = 0; i < 16; i++) p.inv_freq[i] = pow(10000.0, -(double)i / 16.0);
#if FUSED
  p.pb = 0;
  p.pe = N_PHASES;
  {
    void* args[] = {&p};
    hipError_t e = hipLaunchCooperativeKernel((void*)mega, dim3(grid_blocks), dim3(NTHR), args, 0, stream);
    if (e != hipSuccess) fprintf(stderr, "cooperative launch failed: %s (grid %d)\n", hipGetErrorString(e), grid_blocks);
  }
#else
  for (int ph = 0; ph < N_PHASES; ph++) {
    p.pb = ph;
    p.pe = ph + 1;
    void* args[] = {&p};
    hipError_t e = hipLaunchCooperativeKernel((void*)mega, dim3(grid_blocks), dim3(NTHR), args, 0, stream);
    if (e != hipSuccess) fprintf(stderr, "cooperative launch failed: %s (grid %d)\n", hipGetErrorString(e), grid_blocks);
  }
#endif
}
```

```cpp
#include <hip/hip_runtime.h>
#include <hip/hip_cooperative_groups.h>
#include <cstdio>
#include <cmath>
#include <cstring>
namespace cg = cooperative_groups;

typedef unsigned short u16;
using bf16x8 = __attribute__((ext_vector_type(8))) short;
using f32x4 = __attribute__((ext_vector_type(4))) float;
using f32x16 = __attribute__((ext_vector_type(16))) float;

#define REP_INPROJ 0
#define REP_ATTN 0
#define REP_NA 0
#define REP_SCAN 0
#define REP_MOE1 0
#define REP_MOE2 0
#define DI __device__ __forceinline__
#define NTHR 256
#define T_ALL 98304
#define T_SUB 32768
#define ZLD 3616
#define ZB_OFF 416
#define ZC_OFF 1184
#define ZD_OFF 2464
#define LOG2E 1.4426950408889634f
#define ALPHA_F 1.4142135623730951f

struct Params {
  const float *x_prompt, *x_sample, *p_prompt, *p_sample;
  const float *w_in, *mla_gq, *mla_gkv, *mla_wuq, *mla_wuk, *mla_wuv, *na_bias, *hg_lb, *hg_gnorm;
  const float *rw_mu, *rw_w0, *rw_w_up, *rw_a0, *rw_a_up, *rw_g_up, *rw_kk, *rw_ka, *rw_rk, *rw_ln_w, *rw_ln_b;
  const float *w_out, *ln1_g, *ln1_b, *moe_router, *moe_w1, *moe_w3, *moe_w2, *ln2_g, *ln2_b, *ple_gate, *ple_proj;
  float* out;
  u16 *w_in_t, *wuq_t, *wkv_t, *wup_t, *aup_t, *gup_t, *wout_t, *w13_t, *w2_t, *wg_t, *wp_t;
  float *ropec, *ropes, *lb, *affT, *gate;
  int* idx;
  int *inv_cnt, *inv_slot;
  u16 *z, *cat, *Q, *Kb, *Vt, *cqn, *ckvn, *S1, *rs, *ks, *vs, *kk, *gD, *dec, *kka, *kt, *oC, *oD;
  float* bonus;
  u16* xb;
  u16* O;
  u16* H;
  double inv_freq[16];
  int pb, pe;
};

DI u16 f2bf(float f) { unsigned u = __float_as_uint(f); u += 0x7fffu + ((u >> 16) & 1u); return (u16)(u >> 16); }
DI float bf2f(u16 h) { return __uint_as_float(((unsigned)h) << 16); }
DI unsigned pack2(float a, float b) { return (unsigned)f2bf(a) | ((unsigned)f2bf(b) << 16); }
DI float blo(unsigned u) { return __uint_as_float(u << 16); }
DI float bhi(unsigned u) { return __uint_as_float(u & 0xffff0000u); }
DI float sigm(float x) { return 1.f / (1.f + __expf(-x)); }
DI float tanh_(float x) { return 1.f - 2.f / (__expf(2.f * x) + 1.f); }
DI float ex2(float x) { return __builtin_amdgcn_exp2f(x); }
DI int clampi(int v, int lo, int hi) { return v < lo ? lo : (v > hi ? hi : v); }
DI int swap23(int x) { return (x & ~12) | ((x & 4) << 1) | ((x & 8) >> 1); }

template <int CTRL> DI float dpp_f(float v) {
  return __int_as_float(__builtin_amdgcn_update_dpp(0, __float_as_int(v), CTRL, 0xF, 0xF, true));
}
DI float reduce16(float v) {
  v += dpp_f<0xB1>(v);
  v += dpp_f<0x4E>(v);
  v += dpp_f<0x141>(v);
  v += dpp_f<0x140>(v);
  return v;
}
DI float wave_sum(float v) {
  v = reduce16(v);
  v += __shfl_xor(v, 16);
  v += __shfl_xor(v, 32);
  return v;
}

struct TileIter {
  int bid, nb, off;
  DI int first(int n) { int f = bid - off; if (f < 0) f += nb; off = (off + n) % nb; return f; }
};

DI bool xcd_tile(int it, int bid, int nb, int MT, int NT, int& mt, int& nt) {
  const int x = bid & 7, slot = bid >> 3, nslots = nb >> 3;
  const int mper = MT >> 3;
  const int i = slot + it * nslots;
  if (i >= mper * NT) return false;
  const int mi = i & 7, rest = i >> 3;
  nt = rest % NT;
  mt = x * mper + (rest / NT) * 8 + mi;
  return true;
}

DI void convT_job(const float* __restrict__ W, int K, int N, int Npad, u16* __restrict__ Wt, int mode, char* lds,
                  TileIter& it, int tid) {
  float(*tile)[65] = (float(*)[65])lds;
  int tk = K >> 6, tn = Npad >> 6;
  int nt = tk * tn;
  for (int t = it.first(nt); t < nt; t += it.nb) {
    int k0 = (t % tk) << 6, n0 = (t / tk) << 6;
#pragma unroll
    for (int i = 0; i < 16; i++) {
      int kl = (tid >> 6) + 4 * i, nl = tid & 63;
      int n = n0 + nl;
      tile[kl][nl] = (n < N) ? W[(size_t)(k0 + kl) * N + n] : 0.f;
    }
    __syncthreads();
    {
      int nl = tid >> 2, ks = (tid & 3) * 16;
      int n = n0 + nl;
      int row = n;
      if (mode == 1) row = (n >> 4) * 32 + (n & 15);
      if (mode == 2) row = (n >> 4) * 32 + 16 + (n & 15);
      unsigned pk[8];
#pragma unroll
      for (int j = 0; j < 8; j++) pk[j] = pack2(tile[ks + 2 * j][nl], tile[ks + 2 * j + 1][nl]);
      uint4* dst = (uint4*)(Wt + (size_t)row * K + k0 + ks);
      dst[0] = make_uint4(pk[0], pk[1], pk[2], pk[3]);
      dst[1] = make_uint4(pk[4], pk[5], pk[6], pk[7]);
    }
    __syncthreads();
  }
}

DI void phase_convert(const Params& p, char* lds, int bid, int nb, int tid) {
  TileIter it{bid, nb, 0};
  for (int l = 0; l < 2; l++) {
    convT_job(p.w_in + (size_t)l * 1024 * 3616, 1024, 3616, 3712, p.w_in_t + (size_t)l * 3712 * 1024, 0, lds, it, tid);
    convT_job(p.mla_wuq + (size_t)l * 256 * 384, 256, 384, 384, p.wuq_t + (size_t)l * 384 * 256, 0, lds, it, tid);
    convT_job(p.mla_wuk + (size_t)l * 128 * 256, 128, 256, 256, p.wkv_t + (size_t)l * 512 * 128, 0, lds, it, tid);
    convT_job(p.mla_wuv + (size_t)l * 128 * 256, 128, 256, 256, p.wkv_t + (size_t)l * 512 * 128 + 256 * 128, 0, lds, it, tid);
    for (int d = 0; d < 2; d++) {
      convT_job(p.rw_w_up + (size_t)(l * 2 + d) * 64 * 256, 64, 256, 256, p.wup_t + (size_t)(l * 2 + d) * 256 * 64, 0, lds, it, tid);
      convT_job(p.rw_a_up + (size_t)(l * 2 + d) * 64 * 256, 64, 256, 256, p.aup_t + (size_t)(l * 2 + d) * 256 * 64, 0, lds, it, tid);
    }
    convT_job(p.rw_g_up + (size_t)l * 128 * 256, 128, 256, 256, p.gup_t + (size_t)l * 256 * 128, 0, lds, it, tid);
    convT_job(p.w_out + (size_t)l * 1024 * 1024, 1024, 1024, 1024, p.wout_t + (size_t)l * 1024 * 1024, 0, lds, it, tid);
    for (int e = 0; e < 16; e++) {
      size_t le = (size_t)(l * 16 + e);
      convT_job(p.moe_w1 + le * 1024 * 512, 1024, 512, 512, p.w13_t + le * 1024 * 1024, 1, lds, it, tid);
      convT_job(p.moe_w3 + le * 1024 * 512, 1024, 512, 512, p.w13_t + le * 1024 * 1024, 2, lds, it, tid);
      convT_job(p.moe_w2 + le * 512 * 1024, 512, 1024, 1024, p.w2_t + le * 1024 * 512, 0, lds, it, tid);
    }
    convT_job(p.ple_gate + (size_t)l * 1024 * 1024, 1024, 1024, 1024, p.wg_t + (size_t)l * 1024 * 1024, 0, lds, it, tid);
    convT_job(p.ple_proj + (size_t)l * 256 * 1024, 256, 1024, 1024, p.wp_t + (size_t)l * 1024 * 256, 0, lds, it, tid);
  }
  int gt = bid * NTHR + tid, ng = nb * NTHR;
  for (size_t i = gt; i < (size_t)T_ALL * 256; i += ng) {
    float4 v = (i < (size_t)32768 * 256) ? ((const float4*)p.x_prompt)[i] : ((const float4*)p.x_sample)[i - (size_t)32768 * 256];
    ((uint2*)p.xb)[i] = make_uint2(pack2(v.x, v.y), pack2(v.z, v.w));
  }
  for (int i = gt; i < 8192 * 16; i += ng) {
    int n = i >> 4, f = i & 15;
    double ifq = 0.0;
#pragma unroll
    for (int j = 0; j < 16; j++) ifq = (f == j) ? p.inv_freq[j] : ifq;
    double rev = (double)n * ifq * 0.15915494309189535;
    double fr = rev - rint(rev);
    float ff = (float)fr;
    p.ropec[i] = __builtin_amdgcn_cosf(ff);
    p.ropes[i] = __builtin_amdgcn_sinf(ff);
  }
  for (int i = gt; i < 512; i += ng) {
    float h0 = p.hg_lb[i], h1 = p.hg_lb[512 + i];
    p.lb[i] = 0.f;
    p.lb[512 + i] = 1.f / (1.f + __expf(h0 - h1));
  }
}

constexpr int G_STAGE = 32768;

template <bool AF32, class RowFn, class Epi>
DI void gemm_tile(RowFn rowfn, const u16* __restrict__ Bt, int K, Epi epi, char* lds, int tid) {
  const int lane = tid & 63, wid = tid >> 6, wr = wid >> 1, wc = wid & 1, fr = lane & 15, fq = lane >> 4;
  f32x4 acc[4][4];
#pragma unroll
  for (int m = 0; m < 4; m++)
#pragma unroll
    for (int n = 0; n < 4; n++) acc[m][n] = f32x4{0.f, 0.f, 0.f, 0.f};

  const int lrow = tid >> 3;
  const int lc = (tid & 7) ^ ((tid >> 4) & 7);
  const float* apf[8];
  const u16* aph[4];
  const u16* bp[4];
  if constexpr (AF32) {
#pragma unroll
    for (int i = 0; i < 8; i++) apf[i] = (const float*)rowfn(i * 16 + (tid >> 4)) + (tid & 15) * 4;
  } else {
#pragma unroll
    for (int i = 0; i < 4; i++) aph[i] = (const u16*)rowfn(lrow + i * 32) + lc * 8;
  }
#pragma unroll
  for (int i = 0; i < 4; i++) bp[i] = Bt + (size_t)(lrow + i * 32) * K + lc * 8;
  const int afoff = (tid >> 4) * 128 + ((((tid & 15) >> 1) ^ ((tid >> 5) & 7)) * 16) + (tid & 1) * 8;

  float4 raf[8];
  auto issue = [&](int buf, int k0) {
    char* A = lds + buf * G_STAGE;
    char* B = A + 16384;
#pragma unroll
    for (int i = 0; i < 4; i++)
      __builtin_amdgcn_global_load_lds((const unsigned*)(bp[i] + k0), (unsigned*)(B + wid * 1024 + i * 4096), 16, 0, 0);
    if constexpr (AF32) {
#pragma unroll
      for (int i = 0; i < 8; i++) raf[i] = *(const float4*)(apf[i] + k0);
    } else {
#pragma unroll
      for (int i = 0; i < 4; i++)
        __builtin_amdgcn_global_load_lds((const unsigned*)(aph[i] + k0), (unsigned*)(A + wid * 1024 + i * 4096), 16, 0, 0);
    }
  };
  auto astore = [&](int buf) {
    if constexpr (AF32) {
      char* A = lds + buf * G_STAGE;
#pragma unroll
      for (int i = 0; i < 8; i++) asm volatile("" : "+v"(raf[i].x), "+v"(raf[i].y), "+v"(raf[i].z), "+v"(raf[i].w));
#pragma unroll
      for (int i = 0; i < 8; i++)
        *(uint2*)(A + afoff + i * 2048) = make_uint2(pack2(raf[i].x, raf[i].y), pack2(raf[i].z, raf[i].w));
    }
  };
  const int abase = (wr * 64 + fr) * 128, bbase = 16384 + (wc * 64 + fr) * 128;
  const int sw0 = ((fq) ^ (fr >> 1)) * 16, sw1 = ((4 + fq) ^ (fr >> 1)) * 16;

  const int nk = K >> 6;
  issue(0, 0);
  astore(0);
  __syncthreads();
  for (int kt = 0; kt < nk; kt++) {
    if (kt + 1 < nk) issue((kt + 1) & 1, (kt + 1) << 6);
    __builtin_amdgcn_sched_barrier(0);
    const char* S = lds + (kt & 1) * G_STAGE;
#pragma unroll
    for (int kk = 0; kk < 2; kk++) {
      const int sw = kk ? sw1 : sw0;
      bf16x8 af[4], bfr[4];
#pragma unroll
      for (int m = 0; m < 4; m++) af[m] = *(const bf16x8*)(S + abase + m * 2048 + sw);
#pragma unroll
      for (int n = 0; n < 4; n++) bfr[n] = *(const bf16x8*)(S + bbase + n * 2048 + sw);
#pragma unroll
      for (int m = 0; m < 4; m++)
#pragma unroll
        for (int n = 0; n < 4; n++) acc[m][n] = __builtin_amdgcn_mfma_f32_16x16x32_bf16(bfr[n], af[m], acc[m][n], 0, 0, 0);
    }
    __builtin_amdgcn_sched_barrier(0);
    if (kt + 1 < nk) astore((kt + 1) & 1);
    __syncthreads();
  }
  epi(acc, wr * 64 + fr, wc * 64 + fq * 4);
}

#define EPI_LOOP(...)                                    \
  _Pragma("unroll") for (int m = 0; m < 4; m++)          \
  _Pragma("unroll") for (int n = 0; n < 4; n++) {        \
    const int row = rbase + m * 16;                      \
    const int col = cbase + n * 16;                      \
    const f32x4 v = acc[m][n];                           \
    __VA_ARGS__                                          \
  }

DI void st_bf4(u16* dst, f32x4 v) { *(uint2*)dst = make_uint2(pack2(v[0], v[1]), pack2(v[2], v[3])); }

DI const float* xin_row(const Params& p, int l, int tg) {
  if (l == 0) return tg < 32768 ? p.x_prompt + (size_t)tg * 1024 : p.x_sample + (size_t)(tg - 32768) * 1024;
  return p.out + (size_t)tg * 1024;
}

DI void phase_inproj(const Params& p, int l, int tok0, char* lds, int bid, int nb, int tid) {
  const int NT = 29, MT = T_SUB / 128;
  for (int it = 0;; it++) {
    int nt, mt;
    if (!xcd_tile(it, bid, nb, MT, NT, mt, nt)) break;
    int m0 = mt * 128, n0 = nt * 128;
    auto rowfn = [&](int r) -> const void* { return p.xb + (size_t)(tok0 + m0 + r) * 1024; };
    u16* z = p.z;
    auto epi = [&](f32x4(&acc)[4][4], int rbase, int cbase) {
      EPI_LOOP({
        int c = n0 + col;
        if (c < ZLD) st_bf4(z + (size_t)(m0 + row) * ZLD + c, v);
      })
    };
    gemm_tile<false>(rowfn, p.w_in_t + ((size_t)l * 3712 + n0) * 1024, 1024, epi, lds, tid);
  }
}

DI void phase_prep(const Params& p, int l, int N, int bid, int nb, int tid) {
  const int lane = tid & 63, wv = tid >> 6;
  const float* gq = p.mla_gq + l * 256;
  const float* gkv = p.mla_gkv + l * 128;
  const float* lb = p.lb + l * 512;
  const float* mu0 = p.rw_mu + (size_t)l * 2 * 1152;
  const float* mu1 = mu0 + 1152;
  const float* k_k = p.rw_kk + l * 256;
  const float* r_k = p.rw_rk + l * 256;
  for (int t = bid * 4 + wv; t < T_SUB; t += nb * 4) {
    u16* zr = p.z + (size_t)t * ZLD;
    const int n = t & (N - 1);
    {
      uint2 raw = *(const uint2*)(zr + lane * 4);
      float v0 = blo(raw.x), v1 = bhi(raw.x), v2 = blo(raw.y), v3 = bhi(raw.y);
      float ss = wave_sum(v0 * v0 + v1 * v1 + v2 * v2 + v3 * v3);
      float ri = rsqrtf(ss * (1.f / 256.f) + 1e-6f);
      const float* g = gq + lane * 4;
      *(uint2*)(p.cqn + (size_t)t * 256 + lane * 4) =
          make_uint2(pack2(v0 * ri * g[0], v1 * ri * g[1]), pack2(v2 * ri * g[2], v3 * ri * g[3]));
    }
    {
      unsigned raw = *(const unsigned*)(zr + 256 + lane * 2);
      float v0 = blo(raw), v1 = bhi(raw);
      float ss = wave_sum(v0 * v0 + v1 * v1);
      float ri = rsqrtf(ss * (1.f / 128.f) + 1e-6f);
      *(unsigned*)(p.ckvn + (size_t)t * 128 + lane * 2) = pack2(v0 * ri * gkv[lane * 2], v1 * ri * gkv[lane * 2 + 1]);
    }
    if (lane < 16) {
      float x1 = bf2f(zr[384 + lane]), x2 = bf2f(zr[400 + lane]);
      float c = p.ropec[n * 16 + lane], s = p.ropes[n * 16 + lane];
      u16 k1 = f2bf(x1 * c - x2 * s), k2 = f2bf(x1 * s + x2 * c);
      u16* kb = p.Kb + (size_t)t * 384;
#pragma unroll
      for (int h = 0; h < 4; h++) {
        kb[h * 96 + 64 + lane] = k1;
        kb[h * 96 + 80 + lane] = k2;
      }
    }
    {
      uint4* ptr = (uint4*)(zr + ZC_OFF + 256 + lane * 8);
      uint4 raw = *ptr;
      const float* lbp = lb + lane * 8;
      unsigned w[4] = {raw.x, raw.y, raw.z, raw.w};
#pragma unroll
      for (int j = 0; j < 4; j++) {
        float a = blo(w[j]), b = bhi(w[j]);
        float la = lbp[2 * j], lb2 = lbp[2 * j + 1];
        a = la + (1.f - la) * sigm(a);
        b = lb2 + (1.f - lb2) * sigm(b);
        w[j] = pack2(a, b);
      }
      *ptr = make_uint4(w[0], w[1], w[2], w[3]);
    }
    {
      const u16* zd = zr + ZD_OFF;
      const bool hp = n > 0, hn = n < N - 1;
      float rr[4], kx[4], vx[4];
#pragma unroll
      for (int part = 0; part < 3; part++) {
        int c = part * 256 + lane * 4;
        uint2 cur = *(const uint2*)(zd + c);
        uint2 prv = hp ? *(const uint2*)(zd - ZLD + c) : make_uint2(0, 0);
        uint2 nxt = hn ? *(const uint2*)(zd + ZLD + c) : make_uint2(0, 0);
        float cz[4] = {blo(cur.x), bhi(cur.x), blo(cur.y), bhi(cur.y)};
        float pz[4] = {blo(prv.x), bhi(prv.x), blo(prv.y), bhi(prv.y)};
        float nz[4] = {blo(nxt.x), bhi(nxt.x), blo(nxt.y), bhi(nxt.y)};
#pragma unroll
        for (int j = 0; j < 4; j++) {
          float o = cz[j] + mu0[c + j] * (pz[j] - cz[j]) + mu1[c + j] * (nz[j] - cz[j]);
          if (part == 0) rr[j] = o;
          if (part == 1) kx[j] = o;
          if (part == 2) vx[j] = o;
        }
      }
      int c4 = lane * 4;
      *(uint2*)(p.rs + (size_t)t * 256 + c4) = make_uint2(pack2(rr[0], rr[1]), pack2(rr[2], rr[3]));
      *(uint2*)(p.ks + (size_t)t * 256 + c4) = make_uint2(pack2(kx[0], kx[1]), pack2(kx[2], kx[3]));
      *(uint2*)(p.vs + (size_t)t * 256 + c4) = make_uint2(pack2(vx[0], vx[1]), pack2(vx[2], vx[3]));
      float kq[4], ss = 0.f, bo = 0.f;
#pragma unroll
      for (int j = 0; j < 4; j++) {
        kq[j] = kx[j] * k_k[c4 + j];
        ss += kq[j] * kq[j];
        bo += rr[j] * kx[j] * r_k[c4 + j];
      }
      ss = reduce16(ss);
      bo = reduce16(bo);
      float inv = 1.f / fmaxf(sqrtf(ss), 1e-12f);
      *(uint2*)(p.kk + (size_t)t * 256 + c4) = make_uint2(pack2(kq[0] * inv, kq[1] * inv), pack2(kq[2] * inv, kq[3] * inv));
      if ((lane & 15) == 0) p.bonus[(size_t)t * 4 + (lane >> 4)] = bo;
#pragma unroll
      for (int i = 0; i < 6; i++) {
        int c = 768 + lane + 64 * i;
        float cz = bf2f(zd[c]);
        float pz = hp ? bf2f(zd[c - ZLD]) : 0.f;
        float nz = hn ? bf2f(zd[c + ZLD]) : 0.f;
        float o = cz + mu0[c] * (pz - cz) + mu1[c] * (nz - cz);
        if (i < 2) o = tanh_(o);
        else if (i >= 4) o = sigm(o);
        p.S1[(size_t)t * 384 + lane + 64 * i] = f2bf(o);
      }
    }
  }
}

DI void phase_smallgemm(const Params& p, int l, int B, int N, char* lds, int bid, int nb, int tid) {
  TileIter it{bid, nb, 0};
  const int MT = T_SUB / 128;
  {
    const int NT = 3;
    for (int itx = 0;; itx++) {
      int nt, mt;
      if (!xcd_tile(itx, bid, nb, MT, NT, mt, nt)) break;
      int m0 = mt * 128, n0 = nt * 128;
      auto rowfn = [&](int r) -> const void* { return p.cqn + (size_t)(m0 + r) * 256; };
      u16* Q = p.Q;
      auto epi = [&](f32x4(&acc)[4][4], int rbase, int cbase) {
        const float SC = 0.10206207261596577f * LOG2E;
        EPI_LOOP({ st_bf4(Q + (size_t)(m0 + row) * 384 + n0 + col, v * SC); })
      };
      gemm_tile<false>(rowfn, p.wuq_t + ((size_t)l * 384 + n0) * 256, 256, epi, lds, tid);
    }
  }
  {
    const int NT = 4;
    for (int itx = 0;; itx++) {
      int nt, mt;
      if (!xcd_tile(itx, bid, nb, MT, NT, mt, nt)) break;
      int m0 = mt * 128, n0 = nt * 128;
      auto rowfn = [&](int r) -> const void* { return p.ckvn + (size_t)(m0 + r) * 128; };
      u16* Kb = p.Kb;
      u16* Vt = p.Vt;
      auto epi = [&](f32x4(&acc)[4][4], int rbase, int cbase) {
        EPI_LOOP({
          int c = n0 + col;
          int tk = m0 + row;
          if (c < 256) {
            int h = c >> 6, d = c & 63;
            st_bf4(Kb + (size_t)tk * 384 + h * 96 + d, v);
          } else {
            int cc = c - 256;
            int b = tk / N, nn = tk - b * N;
            u16* dst = Vt + ((size_t)(b * 256 + cc)) * N + nn;
            dst[0] = f2bf(v[0]);
            dst[(size_t)N] = f2bf(v[1]);
            dst[(size_t)2 * N] = f2bf(v[2]);
            dst[(size_t)3 * N] = f2bf(v[3]);
          }
        })
      };
      gemm_tile<false>(rowfn, p.wkv_t + ((size_t)l * 512 + n0) * 128, 128, epi, lds, tid);
    }
  }
  for (int d = 0; d < 2; d++) {
    const int NT = 2;
    for (int itx = 0;; itx++) {
      int nt, mt;
      if (!xcd_tile(itx, bid, nb, MT, NT, mt, nt)) break;
      int m0 = mt * 128, n0 = nt * 128;
      auto rowfn = [&](int r) -> const void* { return p.S1 + (size_t)(m0 + r) * 384 + d * 64; };
      u16* dst = p.dec + (size_t)d * T_SUB * 256;
      const float* w0 = p.rw_w0 + (l * 2 + d) * 256;
      auto epi = [&](f32x4(&acc)[4][4], int rbase, int cbase) {
        EPI_LOOP({
          f32x4 o;
          for (int j = 0; j < 4; j++) o[j] = __expf(-0.6065306597126334f * sigm(w0[n0 + col + j] + v[j]));
          st_bf4(dst + (size_t)(m0 + row) * 256 + n0 + col, o);
        })
      };
      gemm_tile<false>(rowfn, p.wup_t + ((size_t)(l * 2 + d) * 256 + n0) * 64, 64, epi, lds, tid);
    }
  }
  for (int d = 0; d < 2; d++) {
    const int NT = 2;
    for (int itx = 0;; itx++) {
      int nt, mt;
      if (!xcd_tile(itx, bid, nb, MT, NT, mt, nt)) break;
      int m0 = mt * 128, n0 = nt * 128;
      auto rowfn = [&](int r) -> const void* { return p.S1 + (size_t)(m0 + r) * 384 + 128 + d * 64; };
      u16* dka = p.kka + (size_t)d * T_SUB * 256;
      u16* dkt = p.kt + (size_t)d * T_SUB * 256;
      const float* a0 = p.rw_a0 + (l * 2 + d) * 256;
      const float* ka = p.rw_ka + l * 256;
      const u16* kkp = p.kk;
      const u16* ksp = p.ks;
      auto epi = [&](f32x4(&acc)[4][4], int rbase, int cbase) {
        EPI_LOOP({
          size_t o = (size_t)(m0 + row) * 256 + n0 + col;
          uint2 kkr = *(const uint2*)(kkp + o);
          uint2 ksr = *(const uint2*)(ksp + o);
          float kkv[4] = {blo(kkr.x), bhi(kkr.x), blo(kkr.y), bhi(kkr.y)};
          float ksv[4] = {blo(ksr.x), bhi(ksr.x), blo(ksr.y), bhi(ksr.y)};
          f32x4 o1, o2;
          for (int j = 0; j < 4; j++) {
            float a = sigm(a0[n0 + col + j] + v[j]);
            o1[j] = kkv[j] * a;
            o2[j] = ksv[j] * (1.f + (a - 1.f) * ka[n0 + col + j]);
          }
          st_bf4(dka + o, o1);
          st_bf4(dkt + o, o2);
        })
      };
      gemm_tile<false>(rowfn, p.aup_t + ((size_t)(l * 2 + d) * 256 + n0) * 64, 64, epi, lds, tid);
    }
  }
  {
    const int NT = 2;
    for (int itx = 0;; itx++) {
      int nt, mt;
      if (!xcd_tile(itx, bid, nb, MT, NT, mt, nt)) break;
      int m0 = mt * 128, n0 = nt * 128;
      auto rowfn = [&](int r) -> const void* { return p.S1 + (size_t)(m0 + r) * 384 + 256; };
      u16* dst = p.gD;
      auto epi = [&](f32x4(&acc)[4][4], int rbase, int cbase) {
        EPI_LOOP({ st_bf4(dst + (size_t)(m0 + row) * 256 + n0 + col, v); })
      };
      gemm_tile<false>(rowfn, p.gup_t + ((size_t)l * 256 + n0) * 128, 128, epi, lds, tid);
    }
  }
}

DI bf16x8 pack8(const f32x16& s, int o) {
  bf16x8 r;
#pragma unroll
  for (int j = 0; j < 8; j++) r[j] = (short)f2bf(s[o + j]);
  return r;
}

constexpr int AT_KP = 208, AT_VP = 144, AT_BUF = 64 * AT_KP + 64 * AT_VP;
DI void phase_attn(const Params& p, int B, int N, char* lds, int bid, int nb, int tid) {
  const int lane = tid & 63, wv = tid >> 6, r = lane & 31, hf = lane >> 5;
  const int nqb = N >> 7;
  const int ntask = B * 4 * nqb;
  for (int task = bid; task < ntask; task += nb) {
    const int qb = task % nqb, bh = task / nqb, h = bh & 3, b = bh >> 2;
    const size_t tb = (size_t)b * N;
    const int q = qb * 128 + wv * 32 + r;
    bf16x8 qf[6];
    {
      const u16* qrow = p.Q + (tb + q) * 384 + h * 96;
#pragma unroll
      for (int ks = 0; ks < 4; ks++) qf[ks] = *(const bf16x8*)(qrow + ks * 16 + hf * 8);
      bf16x8 x1r = *(const bf16x8*)(qrow + 64 + hf * 8);
      bf16x8 x2r = *(const bf16x8*)(qrow + 80 + hf * 8);
      const float* cp = p.ropec + q * 16 + hf * 8;
      const float* sp = p.ropes + q * 16 + hf * 8;
      bf16x8 o1, o2;
#pragma unroll
      for (int j = 0; j < 8; j++) {
        float xa = bf2f((u16)x1r[j]), ya = bf2f((u16)x2r[j]);
        float c0 = cp[j], s0 = sp[j];
        o1[j] = (short)f2bf(xa * c0 - ya * s0);
        o2[j] = (short)f2bf(xa * s0 + ya * c0);
      }
      qf[4] = o1;
      qf[5] = o2;
    }
    const u16* Kg = p.Kb + tb * 384 + h * 96;
    const u16* Vg = p.Vt + ((size_t)(b * 4 + h) * 64) * N;
    uint4 kr0, kr1, kr2, vr0, vr1;
    const int lkey = tid >> 2, lpart = tid & 3;
    const int lrow = swap23(lkey);
#define AT_GLOAD(kt_)                                                              \
  {                                                                                \
    const u16* kp_ = Kg + (size_t)((kt_) * 64 + lkey) * 384 + lpart * 24;          \
    kr0 = *(const uint4*)(kp_);                                                    \
    kr1 = *(const uint4*)(kp_ + 8);                                                \
    kr2 = *(const uint4*)(kp_ + 16);                                               \
    const u16* vp_ = Vg + (size_t)lkey * N + (kt_) * 64 + lpart * 16;              \
    vr0 = *(const uint4*)(vp_);                                                    \
    vr1 = *(const uint4*)(vp_ + 8);                                                \
  }
#define AT_LSTORE(buf_)                                                            \
  {                                                                                \
    char* Kl_ = lds + (buf_) * AT_BUF;                                             \
    char* Vl_ = Kl_ + 64 * AT_KP;                                                  \
    *(uint4*)(Kl_ + lrow * AT_KP + (lpart * 3 + 0) * 16) = kr0;                    \
    *(uint4*)(Kl_ + lrow * AT_KP + (lpart * 3 + 1) * 16) = kr1;                    \
    *(uint4*)(Kl_ + lrow * AT_KP + (lpart * 3 + 2) * 16) = kr2;                    \
    *(uint4*)(Vl_ + lkey * AT_VP + (lpart * 2 + 0) * 16) = vr0;                    \
    *(uint4*)(Vl_ + lkey * AT_VP + (lpart * 2 + 1) * 16) = vr1;                    \
  }
    f32x16 O0, O1;
#pragma unroll
    for (int i = 0; i < 16; i++) { O0[i] = 0.f; O1[i] = 0.f; }
    float mrun = -1e30f, lrun = 0.f;
    const int nt = N >> 6;
    __syncthreads();
    AT_GLOAD(0);
    AT_LSTORE(0);
    __syncthreads();
    for (int kt = 0; kt < nt; kt++) {
      if (kt + 1 < nt) AT_GLOAD(kt + 1);
      __builtin_amdgcn_sched_barrier(0);
      const char* Kl = lds + (kt & 1) * AT_BUF;
      const char* Vl = Kl + 64 * AT_KP;
      f32x16 S0, S1;
#pragma unroll
      for (int i = 0; i < 16; i++) { S0[i] = 0.f; S1[i] = 0.f; }
#pragma unroll
      for (int ks = 0; ks < 6; ks++) {
        bf16x8 a0 = *(const bf16x8*)(Kl + r * AT_KP + ks * 32 + hf * 16);
        bf16x8 a1 = *(const bf16x8*)(Kl + (32 + r) * AT_KP + ks * 32 + hf * 16);
        S0 = __builtin_amdgcn_mfma_f32_32x32x16_bf16(a0, qf[ks], S0, 0, 0, 0);
        S1 = __builtin_amdgcn_mfma_f32_32x32x16_bf16(a1, qf[ks], S1, 0, 0, 0);
      }
      float mx = S0[0];
#pragma unroll
      for (int i = 1; i < 16; i++) mx = fmaxf(mx, S0[i]);
#pragma unroll
      for (int i = 0; i < 16; i++) mx = fmaxf(mx, S1[i]);
      mx = fmaxf(mx, __shfl_xor(mx, 32));
      float mn = fmaxf(mrun, mx);
      float alpha = ex2(mrun - mn);
      mrun = mn;
      float ls = 0.f;
#pragma unroll
      for (int i = 0; i < 16; i++) {
        S0[i] = ex2(S0[i] - mn);
        S1[i] = ex2(S1[i] - mn);
        ls += S0[i] + S1[i];
      }
      lrun = lrun * alpha + ls;
#pragma unroll
      for (int i = 0; i < 16; i++) { O0[i] *= alpha; O1[i] *= alpha; }
#pragma unroll
      for (int sp = 0; sp < 4; sp++) {
        bf16x8 pb = (sp < 2) ? pack8(S0, (sp & 1) * 8) : pack8(S1, (sp & 1) * 8);
        bf16x8 v0 = *(const bf16x8*)(Vl + r * AT_VP + sp * 32 + hf * 16);
        bf16x8 v1 = *(const bf16x8*)(Vl + (32 + r) * AT_VP + sp * 32 + hf * 16);
        O0 = __builtin_amdgcn_mfma_f32_32x32x16_bf16(v0, pb, O0, 0, 0, 0);
        O1 = __builtin_amdgcn_mfma_f32_32x32x16_bf16(v1, pb, O1, 0, 0, 0);
      }
      __builtin_amdgcn_sched_barrier(0);
      if (kt + 1 < nt) AT_LSTORE((kt + 1) & 1);
      __syncthreads();
    }
    float lt = lrun + __shfl_xor(lrun, 32);
    float inv = 1.f / lt;
    u16* orow = p.cat + (tb + q) * 1024 + h * 64;
#pragma unroll
    for (int g = 0; g < 4; g++) {
      int d0 = 8 * g + 4 * hf;
      *(uint2*)(orow + d0) = make_uint2(pack2(O0[4 * g] * inv, O0[4 * g + 1] * inv), pack2(O0[4 * g + 2] * inv, O0[4 * g + 3] * inv));
      *(uint2*)(orow + 32 + d0) = make_uint2(pack2(O1[4 * g] * inv, O1[4 * g + 1] * inv), pack2(O1[4 * g + 2] * inv, O1[4 * g + 3] * inv));
    }
  }
}

DI void phase_na(const Params& p, int l, int B, int N, int bid, int nb, int tid) {
  const int lane = tid & 63, head = tid >> 6, r = lane & 31, hf = lane >> 5;
  const int rows = N >> 6;
  const int nrb = rows >> 1;
  const int ntask = B * nrb * 4;
  const float* bias = p.na_bias + (size_t)(l * 4 + head) * 15 * 31;
  for (int task = bid; task < ntask; task += nb) {
    const int cb = task & 3, rb = (task >> 2) % nrb, b = (task >> 2) / nrb;
    const size_t tb = (size_t)b * N;
    const int qrow0 = rb * 2;
    const int rstart0 = clampi(qrow0 - 4, 0, rows - 8);
    const int k0 = clampi(rstart0, 0, rows - 9);
    const int kstart = clampi(cb * 16 - 8, 0, 32);
    const int iq = r >> 4, u = r & 15;
    const int qrow = qrow0 + iq, qcol = cb * 16 + u;
    const int rstart = clampi(qrow - 4, 0, rows - 8);
    const int cstart = clampi(qcol - 8, 0, 48);
    bf16x8 qf[4];
    {
      const u16* qp = p.z + (tb + qrow * 64 + qcol) * ZLD + ZB_OFF + head * 64;
#pragma unroll
      for (int ks = 0; ks < 4; ks++) qf[ks] = *(const bf16x8*)(qp + ks * 16 + hf * 8);
    }
    f32x16 O0, O1;
#pragma unroll
    for (int i = 0; i < 16; i++) { O0[i] = 0.f; O1[i] = 0.f; }
    float mrun = -1e30f, lrun = 0.f;
    const int wk = swap23(r);
    for (int j = 0; j < 9; j++) {
      const int krow = k0 + j;
      const u16* kp = p.z + (tb + krow * 64 + kstart + wk) * ZLD + ZB_OFF + 256 + head * 64;
      f32x16 S;
#pragma unroll
      for (int i = 0; i < 16; i++) S[i] = 0.f;
#pragma unroll
      for (int ks = 0; ks < 4; ks++) {
        bf16x8 a = *(const bf16x8*)(kp + ks * 16 + hf * 8);
        S = __builtin_amdgcn_mfma_f32_32x32x16_bf16(a, qf[ks], S, 0, 0, 0);
      }
      const bool rok = (krow >= rstart) && (krow < rstart + 8);
      const int drow = clampi(krow - qrow + 7, 0, 14);
      const float* brow = bias + drow * 31;
      float mx = -1e30f;
#pragma unroll
      for (int i = 0; i < 16; i++) {
        int w = 16 * (i >> 3) + 8 * hf + 4 * ((i >> 2) & 1) + (i & 3);
        int kcol = kstart + w;
        bool ok = rok && (kcol >= cstart) && (kcol < cstart + 16);
        int dcol = clampi(kcol - qcol + 15, 0, 30);
        float s = (S[i] * 0.125f + brow[dcol]) * LOG2E;
        S[i] = ok ? s : -1e30f;
        mx = fmaxf(mx, S[i]);
      }
      mx = fmaxf(mx, __shfl_xor(mx, 32));
      float mn = fmaxf(mrun, mx);
      float alpha = ex2(mrun - mn);
      mrun = mn;
      float ls = 0.f;
#pragma unroll
      for (int i = 0; i < 16; i++) {
        float pv = (S[i] > -1e29f) ? ex2(S[i] - mn) : 0.f;
        S[i] = pv;
        ls += pv;
      }
      lrun = lrun * alpha + ls;
#pragma unroll
      for (int i = 0; i < 16; i++) { O0[i] *= alpha; O1[i] *= alpha; }
      const u16* vbase = p.z + (tb + krow * 64 + kstart) * ZLD + ZB_OFF + 512 + head * 64 + r;
#pragma unroll
      for (int s = 0; s < 2; s++) {
        bf16x8 pb = pack8(S, s * 8);
        bf16x8 v0, v1;
#pragma unroll
        for (int jj = 0; jj < 8; jj++) {
          const u16* vp = vbase + (size_t)(16 * s + 8 * hf + jj) * ZLD;
          v0[jj] = (short)vp[0];
          v1[jj] = (short)vp[32];
        }
        O0 = __builtin_amdgcn_mfma_f32_32x32x16_bf16(v0, pb, O0, 0, 0, 0);
        O1 = __builtin_amdgcn_mfma_f32_32x32x16_bf16(v1, pb, O1, 0, 0, 0);
      }
    }
    float lt = lrun + __shfl_xor(lrun, 32);
    float inv = 1.f / lt;
    u16* orow = p.cat + (tb + qrow * 64 + qcol) * 1024 + 256 + head * 64;
#pragma unroll
    for (int g = 0; g < 4; g++) {
      int d0 = 8 * g + 4 * hf;
      *(uint2*)(orow + d0) = make_uint2(pack2(O0[4 * g] * inv, O0[4 * g + 1] * inv), pack2(O0[4 * g + 2] * inv, O0[4 * g + 3] * inv));
      *(uint2*)(orow + 32 + d0) = make_uint2(pack2(O1[4 * g] * inv, O1[4 * g + 1] * inv), pack2(O1[4 * g + 2] * inv, O1[4 * g + 3] * inv));
    }
  }
}

using f32x2 = __attribute__((ext_vector_type(2))) float;
constexpr int SC_STEPS = 16;

DI void sc_store(char* buf, int dst, uint4 R, bool hgw) {
  float4 lo = make_float4(blo(R.x), bhi(R.x), blo(R.y), bhi(R.y));
  float4 hi = make_float4(blo(R.z), bhi(R.z), blo(R.w), bhi(R.w));
  *(float4*)(buf + dst) = lo;
  *(float4*)(buf + dst + 16) = hi;
  if (hgw) {
    *(float4*)(buf + dst + 256) = make_float4(1.f - lo.x, 1.f - lo.y, 1.f - lo.z, 1.f - lo.w);
    *(float4*)(buf + dst + 272) = make_float4(1.f - hi.x, 1.f - hi.y, 1.f - hi.z, 1.f - hi.w);
  }
}

template <bool RW>
DI void scan_task(const Params& p, int task, int N, char* lds, int tid) {
  constexpr int NA = RW ? 5 : 3;
  constexpr int VOFF = SC_STEPS * NA * 256;
  constexpr int BUF = VOFF + SC_STEPS * 64;
  const int lane = tid & 63, wv = tid >> 6, kq = lane & 15, rg = lane >> 4;
  const int rq = task & 3, hh = (task >> 2) & 3, dir = (task >> 4) & 1, b = task >> 5;
  const size_t tb = (size_t)b * N;
  const int sub = tid >> 7, lt = tid & 127, lstep = lt >> 3, lpart = lt & 7;
  const int vstep = lt >> 1, vhalf = lt & 1;
  const u16 *src0 = nullptr, *src1 = nullptr, *src2 = nullptr;
  int dst0 = 0, dst1 = 0, dst2 = 0, st0 = 0, st1 = 0, st2 = 0;
  bool act0 = false, act1 = false, act2 = false, hgw = false;
  int ld;
  const int acol = hh * 64 + lpart * 8;
  const int vcol = hh * 64 + rq * 16 + vhalf * 8;
  const int vdst = VOFF + vstep * 64 + vhalf * 32;
  if (RW) {
    ld = 256;
    act0 = true; st0 = lstep;
    src0 = sub ? (p.dec + (size_t)dir * T_SUB * 256 + acol) : (p.rs + acol);
    dst0 = (lstep * NA + (sub ? 1 : 0)) * 256 + lpart * 32;
    act1 = true; st1 = lstep;
    src1 = sub ? (p.kk + acol) : (p.kt + (size_t)dir * T_SUB * 256 + acol);
    dst1 = (lstep * NA + (sub ? 3 : 2)) * 256 + lpart * 32;
    if (sub == 0) { act2 = true; st2 = lstep; src2 = p.kka + (size_t)dir * T_SUB * 256 + acol; dst2 = (lstep * NA + 4) * 256 + lpart * 32; }
    else { act2 = lt < 32; st2 = vstep; src2 = p.vs + vcol; dst2 = vdst; }
  } else {
    ld = ZLD;
    act0 = true; st0 = lstep;
    src0 = sub ? (p.z + ZC_OFF + 256 * (1 + dir) + acol) : (p.z + ZC_OFF + acol);
    dst0 = (lstep * NA + (sub ? 1 : 0)) * 256 + lpart * 32;
    hgw = sub != 0;
    if (sub == 0) { act1 = lt < 32; st1 = vstep; src1 = p.z + ZC_OFF + 768 + vcol; dst1 = vdst; }
  }
  u16* pout = (RW ? p.oD : p.oC) + (size_t)dir * T_SUB * 256 + hh * 64 + rq * 16 + wv * 4 + rg;
  pout += (tb + (dir ? (N - 1) : 0)) * 256;
  const int ostride = dir ? -256 : 256;

#define SC_TOK(c_, st_) (tb + (size_t)(dir ? (N - 1 - ((c_) * SC_STEPS + (st_))) : ((c_) * SC_STEPS + (st_))))
#define SC_ISSUE(Ra, Rb, Rc, c_)                                               \
  {                                                                            \
    if (act0) Ra = *(const uint4*)(src0 + SC_TOK(c_, st0) * ld);               \
    if (act1) Rb = *(const uint4*)(src1 + SC_TOK(c_, st1) * ld);               \
    if (act2) Rc = *(const uint4*)(src2 + SC_TOK(c_, st2) * ld);               \
  }
#define SC_STORE(Ra, Rb, Rc, buf_)                                             \
  {                                                                            \
    if (act0) sc_store(buf_, dst0, Ra, hgw);                                   \
    if (act1) sc_store(buf_, dst1, Rb, false);                                 \
    if (act2) sc_store(buf_, dst2, Rc, false);                                 \
  }
  f32x2 S01 = {0.f, 0.f}, S23 = {0.f, 0.f};
#define SC_LD(buf_, s_, r_, w_, t_, k_, a_, v_)                                              \
  {                                                                                          \
    const char* rowp_ = (buf_) + (s_) * NA * 256 + kq * 16;                                  \
    r_ = *(const float4*)(rowp_);                                                            \
    w_ = *(const float4*)(rowp_ + 256);                                                      \
    t_ = *(const float4*)(rowp_ + 512);                                                      \
    if (RW) {                                                                                \
      k_ = *(const float4*)(rowp_ + 768);                                                    \
      a_ = *(const float4*)(rowp_ + 1024);                                                   \
    }                                                                                        \
    v_ = *(const float*)((buf_) + VOFF + (s_) * 64 + (wv * 4 + rg) * 4);                     \
  }
#define SC_COMPUTE(buf_)                                                                     \
  {                                                                                          \
    float osel = 0.f;                                                                        \
    float4 r4, w4, t4, k4, a4, nr4, nw4, nt4, nk4, na4;                                      \
    float vv, nvv;                                                                           \
    k4 = a4 = nk4 = na4 = make_float4(0.f, 0.f, 0.f, 0.f);                                   \
    SC_LD(buf_, 0, r4, w4, t4, k4, a4, vv);                                                  \
    _Pragma("unroll") for (int s = 0; s < SC_STEPS; s++) {                                   \
      if (s + 1 < SC_STEPS) SC_LD(buf_, s + 1, nr4, nw4, nt4, nk4, na4, nvv);                \
      f32x2 ta = f32x2{t4.x, t4.y} * vv, tb2 = f32x2{t4.z, t4.w} * vv;                       \
      if (RW) {                                                                              \
        f32x2 pp = S01 * f32x2{k4.x, k4.y};                                                  \
        pp = S23 * f32x2{k4.z, k4.w} + pp;                                                   \
        const float sa = -reduce16(pp.x + pp.y);                                             \
        ta = f32x2{a4.x, a4.y} * sa + ta;                                                    \
        tb2 = f32x2{a4.z, a4.w} * sa + tb2;                                                  \
      }                                                                                      \
      S01 = S01 * f32x2{w4.x, w4.y} + ta;                                                    \
      S23 = S23 * f32x2{w4.z, w4.w} + tb2;                                                   \
      f32x2 qq = S01 * f32x2{r4.x, r4.y};                                                    \
      qq = S23 * f32x2{r4.z, r4.w} + qq;                                                     \
      const float o = reduce16(qq.x + qq.y);                                                 \
      osel = (kq == s) ? o : osel;                                                           \
      r4 = nr4; w4 = nw4; t4 = nt4; k4 = nk4; a4 = na4; vv = nvv;                            \
    }                                                                                        \
    pout[kq * ostride] = f2bf(osel);                                                         \
    pout += SC_STEPS * ostride;                                                              \
  }
  uint4 A0 = make_uint4(0, 0, 0, 0), A1 = A0, A2 = A0, B0 = A0, B1 = A0, B2 = A0;
  char* buf0 = lds;
  char* buf1 = lds + BUF;
  const int nch = N / SC_STEPS;
  __syncthreads();
  SC_ISSUE(A0, A1, A2, 0);
  SC_ISSUE(B0, B1, B2, 1);
  SC_STORE(A0, A1, A2, buf0);
  __syncthreads();
  for (int c = 0; c < nch; c += 2) {
    if (c + 2 < nch) SC_ISSUE(A0, A1, A2, c + 2);
    __builtin_amdgcn_sched_barrier(0);
    SC_COMPUTE(buf0);
    __builtin_amdgcn_sched_barrier(0);
    SC_STORE(B0, B1, B2, buf1);
    __syncthreads();
    if (c + 3 < nch) SC_ISSUE(B0, B1, B2, c + 3);
    __builtin_amdgcn_sched_barrier(0);
    SC_COMPUTE(buf1);
    __builtin_amdgcn_sched_barrier(0);
    if (c + 2 < nch) SC_STORE(A0, A1, A2, buf0);
    __syncthreads();
  }
}

DI void phase_scan(const Params& p, int B, int N, char* lds, int bid, int nb, int tid) {
  const int nper = B * 32;
  for (int task = bid; task < 2 * nper; task += nb) {
    if (task < nper) scan_task<true>(p, task, N, lds, tid);
    else scan_task<false>(p, task - nper, N, lds, tid);
  }
}

DI void phase_final(const Params& p, int l, int bid, int nb, int tid) {
  const int lane = tid & 63, wv = tid >> 6, c4 = lane * 4;
  const float* gn = p.hg_gnorm + l * 256 + c4;
  const float* lw = p.rw_ln_w + l * 256 + c4;
  const float* lbb = p.rw_ln_b + l * 256 + c4;
  for (int t = bid * 4 + wv; t < T_SUB; t += nb * 4) {
    {
      uint2 a = *(const uint2*)(p.oC + (size_t)t * 256 + c4);
      uint2 bq = *(const uint2*)(p.oC + (size_t)(T_SUB + t) * 256 + c4);
      float o[4] = {blo(a.x) + blo(bq.x), bhi(a.x) + bhi(bq.x), blo(a.y) + blo(bq.y), bhi(a.y) + bhi(bq.y)};
      float ss = reduce16(o[0] * o[0] + o[1] * o[1] + o[2] * o[2] + o[3] * o[3]);
      float ri = rsqrtf(ss * (1.f / 64.f) + 1e-6f);
      uint2 gr = *(const uint2*)(p.z + (size_t)t * ZLD + ZC_OFF + 1024 + c4);
      float g[4] = {blo(gr.x), bhi(gr.x), blo(gr.y), bhi(gr.y)};
      float y[4];
#pragma unroll
      for (int j = 0; j < 4; j++) y[j] = o[j] * ri * gn[j] * (g[j] * sigm(g[j]));
      *(uint2*)(p.cat + (size_t)t * 1024 + 512 + c4) = make_uint2(pack2(y[0], y[1]), pack2(y[2], y[3]));
    }
    {
      uint2 a = *(const uint2*)(p.oD + (size_t)t * 256 + c4);
      uint2 bq = *(const uint2*)(p.oD + (size_t)(T_SUB + t) * 256 + c4);
      float o[4] = {blo(a.x) + blo(bq.x), bhi(a.x) + bhi(bq.x), blo(a.y) + blo(bq.y), bhi(a.y) + bhi(bq.y)};
      float mu = reduce16(o[0] + o[1] + o[2] + o[3]) * (1.f / 64.f);
      float d0 = o[0] - mu, d1 = o[1] - mu, d2 = o[2] - mu, d3 = o[3] - mu;
      float var = reduce16(d0 * d0 + d1 * d1 + d2 * d2 + d3 * d3) * (1.f / 64.f);
      float ri = rsqrtf(var + 64e-5f);
      float bo = p.bonus[(size_t)t * 4 + (lane >> 4)];
      uint2 vr = *(const uint2*)(p.vs + (size_t)t * 256 + c4);
      uint2 gr = *(const uint2*)(p.gD + (size_t)t * 256 + c4);
      float vv[4] = {blo(vr.x), bhi(vr.x), blo(vr.y), bhi(vr.y)};
      float g[4] = {blo(gr.x), bhi(gr.x), blo(gr.y), bhi(gr.y)};
      float dd[4] = {d0, d1, d2, d3};
      float y[4];
#pragma unroll
      for (int j = 0; j < 4; j++) y[j] = (dd[j] * ri * lw[j] + lbb[j] + bo * vv[j]) * g[j];
      *(uint2*)(p.cat + (size_t)t * 1024 + 768 + c4) = make_uint2(pack2(y[0], y[1]), pack2(y[2], y[3]));
    }
  }
}

DI void phase_wout(const Params& p, int l, int tok0, char* lds, int bid, int nb, int tid) {
  const int NT = 8, MT = T_SUB / 128;
  for (int it = 0;; it++) {
    int nt, mt;
    if (!xcd_tile(it, bid, nb, MT, NT, mt, nt)) break;
    int m0 = mt * 128, n0 = nt * 128;
    auto rowfn = [&](int r) -> const void* { return p.cat + (size_t)(m0 + r) * 1024; };
    auto epi = [&](f32x4(&acc)[4][4], int rbase, int cbase) {
      EPI_LOOP({
        int tg = tok0 + m0 + row;
        float4 xv = *(const float4*)(xin_row(p, l, tg) + n0 + col);
        float4 o = make_float4(ALPHA_F * xv.x + v[0], ALPHA_F * xv.y + v[1], ALPHA_F * xv.z + v[2], ALPHA_F * xv.w + v[3]);
        *(float4*)(p.out + (size_t)tg * 1024 + n0 + col) = o;
      })
    };
    gemm_tile<false>(rowfn, p.wout_t + ((size_t)l * 1024 + n0) * 1024, 1024, epi, lds, tid);
  }
}

template <bool ROUTER>
DI void phase_ln(const Params& p, const float* g, const float* bta, const float* wrouter, int tok0, int ntok, char* lds,
                 int bid, int nb, int tid) {
  const int lane = tid & 63, wv = tid >> 6;
  float* wl = (float*)lds;
  if (ROUTER) {
    __syncthreads();
    for (int i = tid; i < 16384; i += NTHR) {
      int k = i >> 4, e = i & 15;
      wl[e * 1024 + k] = wrouter[i];
    }
    __syncthreads();
  }
  for (int t = bid * 4 + wv; t < ntok; t += nb * 4) {
    const int tg = tok0 + t;
    float* xr = p.out + (size_t)tg * 1024;
    float4 x[4];
    float s = 0.f;
#pragma unroll
    for (int i = 0; i < 4; i++) {
      x[i] = *(const float4*)(xr + i * 256 + lane * 4);
      s += x[i].x + x[i].y + x[i].z + x[i].w;
    }
    float mu = wave_sum(s) * (1.f / 1024.f);
    float vs = 0.f;
#pragma unroll
    for (int i = 0; i < 4; i++) {
      x[i].x -= mu; x[i].y -= mu; x[i].z -= mu; x[i].w -= mu;
      vs += x[i].x * x[i].x + x[i].y * x[i].y + x[i].z * x[i].z + x[i].w * x[i].w;
    }
    float ri = rsqrtf(wave_sum(vs) * (1.f / 1024.f) + 1e-5f);
#pragma unroll
    for (int i = 0; i < 4; i++) {
      float4 gg = *(const float4*)(g + i * 256 + lane * 4);
      float4 bb = *(const float4*)(bta + i * 256 + lane * 4);
      x[i].x = x[i].x * ri * gg.x + bb.x;
      x[i].y = x[i].y * ri * gg.y + bb.y;
      x[i].z = x[i].z * ri * gg.z + bb.z;
      x[i].w = x[i].w * ri * gg.w + bb.w;
      *(float4*)(xr + i * 256 + lane * 4) = x[i];
      *(uint2*)(p.xb + (size_t)tg * 1024 + i * 256 + lane * 4) = make_uint2(pack2(x[i].x, x[i].y), pack2(x[i].z, x[i].w));
    }
    if (ROUTER) {
      float mine = 0.f;
#pragma unroll 1
      for (int e = 0; e < 16; e++) {
        float a = 0.f;
#pragma unroll
        for (int i = 0; i < 4; i++) {
          float4 w = *(const float4*)(wl + e * 1024 + i * 256 + lane * 4);
          a += x[i].x * w.x + x[i].y * w.y + x[i].z * w.z + x[i].w * w.w;
        }
        a = wave_sum(a);
        mine = (lane == e) ? a : mine;
      }
      float mx = mine;
      mx = fmaxf(mx, dpp_f<0xB1>(mx));
      mx = fmaxf(mx, dpp_f<0x4E>(mx));
      mx = fmaxf(mx, dpp_f<0x141>(mx));
      mx = fmaxf(mx, dpp_f<0x140>(mx));
      float ex = __expf(mine - mx);
      float sum = reduce16(ex);
      mine = ex / sum;
      if (lane == 0) p.inv_cnt[tg] = 0;
      if (lane < 16) {
        if (tg < 32768) p.affT[(size_t)lane * 32768 + tg] = mine;
        else p.affT[(size_t)16 * 32768 + (size_t)lane * 65536 + (tg - 32768)] = mine;
      }
    }
  }
}

DI void phase_topk(const Params& p, char* lds, int bid, int nb, int tid) {
  if (bid < 32) {
    unsigned* hist = (unsigned*)lds;
    unsigned* sh = hist + 256;
    unsigned* eqc = sh + 8;
    const int g = bid >> 4, e = bid & 15;
    const int T = g ? 65536 : 32768, cap = T >> 3;
    const int tok0 = g ? 32768 : 0;
    const float* vals = p.affT + (g ? (size_t)16 * 32768 : 0) + (size_t)e * T;
    int* oidx = p.idx + (g ? 65536 : 0) + e * cap;
    float* ogate = p.gate + (g ? 65536 : 0) + e * cap;
    unsigned prefix = 0, mask = 0;
    int remaining = cap;
    for (int pass = 0; pass < 4; pass++) {
      const int shift = 24 - 8 * pass;
      hist[tid] = 0;
      __syncthreads();
      for (int i = tid; i < T; i += NTHR) {
        unsigned u = __float_as_uint(vals[i]);
        if ((u & mask) == prefix) atomicAdd(&hist[(u >> shift) & 255], 1u);
      }
      __syncthreads();
      if (tid == 0) {
        int cum = 0, sel = 0;
        for (int bq = 255; bq >= 0; bq--) {
          int hc = (int)hist[bq];
          if (cum + hc >= remaining) { sel = bq; break; }
          cum += hc;
        }
        sh[0] = (unsigned)sel;
        sh[1] = (unsigned)(remaining - cum);
      }
      __syncthreads();
      prefix |= sh[0] << shift;
      remaining = (int)sh[1];
      mask |= 0xFFu << shift;
      __syncthreads();
    }
    const unsigned thr = prefix;
    const int need = remaining;
    const int ch = T >> 8;
    const float* my = vals + tid * ch;
    int ec = 0;
    for (int i = 0; i < ch; i++) ec += (__float_as_uint(my[i]) == thr) ? 1 : 0;
    eqc[tid] = ec;
    if (tid == 0) sh[2] = 0;
    __syncthreads();
    int eq_rank = 0;
    for (int i = 0; i < tid; i++) eq_rank += eqc[i];
    for (int i = 0; i < ch; i++) {
      float v = my[i];
      unsigned u = __float_as_uint(v);
      int pos = -1;
      if (u > thr) {
        pos = (int)atomicAdd(&sh[2], 1u);
      } else if (u == thr) {
        if (eq_rank < need) pos = cap - need + eq_rank;
        eq_rank++;
      }
      if (pos >= 0) {
        const int tok = tok0 + tid * ch + i;
        oidx[pos] = tok;
        ogate[pos] = v;
        const int kslot = atomicAdd(&p.inv_cnt[tok], 1);
        p.inv_slot[(size_t)tok * 16 + kslot] = (g ? 65536 : 0) + e * cap + pos;
      }
    }
    __syncthreads();
  }
}

DI void moe_rowinfo(int row0, int l, int& e, int& ioff) {
  if (row0 < 65536) { e = row0 >> 12; }
  else { e = (row0 - 65536) >> 13; }
  ioff = row0;
}

DI void phase_moe1(const Params& p, int l, char* lds, int bid, int nb, int tid) {
  const int NT = 8, MT = 196608 / 128;
  for (int it = 0;; it++) {
    int nt, mt;
    if (!xcd_tile(it, bid, nb, MT, NT, mt, nt)) break;
    int m0 = mt * 128, n0 = nt * 128;
    int e, ioff;
    moe_rowinfo(m0, l, e, ioff);
    const int* ip = p.idx + ioff;
    auto rowfn = [&](int r) -> const void* { return p.xb + (size_t)ip[r] * 1024; };
    u16* H = p.H;
    auto epi = [&](f32x4(&acc)[4][4], int rbase, int cbase) {
#pragma unroll
      for (int m = 0; m < 4; m++)
#pragma unroll
        for (int n = 0; n < 4; n += 2) {
          int row = rbase + m * 16;
          int col = cbase + n * 16;
          int blk = (n0 + (col & ~31)) >> 1;
          int hc = blk + (col & 15);
          f32x4 a = acc[m][n], bq = acc[m][n + 1];
          f32x4 o;
          for (int j = 0; j < 4; j++) o[j] = a[j] * sigm(a[j]) * bq[j];
          st_bf4(H + (size_t)(m0 + row) * 512 + hc, o);
        }
    };
    gemm_tile<false>(rowfn, p.w13_t + ((size_t)(l * 16 + e) * 1024 + n0) * 1024, 1024, epi, lds, tid);
  }
}

DI void phase_moe2(const Params& p, int l, char* lds, int bid, int nb, int tid) {
  TileIter it{bid, nb, 0};
  {
    const int NT = 8, MT = 196608 / 128;
    for (int itx = 0;; itx++) {
      int nt, mt;
      if (!xcd_tile(itx, bid, nb, MT, NT, mt, nt)) break;
      int m0 = mt * 128, n0 = nt * 128;
      int e, ioff;
      moe_rowinfo(m0, l, e, ioff);
      auto rowfn = [&](int r) -> const void* { return p.H + (size_t)(m0 + r) * 512; };
      u16* O = p.O;
      auto epi = [&](f32x4(&acc)[4][4], int rbase, int cbase) {
        EPI_LOOP({ st_bf4(O + (size_t)(m0 + row) * 1024 + n0 + col, v); })
      };
      gemm_tile<false>(rowfn, p.w2_t + ((size_t)(l * 16 + e) * 1024 + n0) * 512, 512, epi, lds, tid);
    }
  }
  {
    const int NT = 8, MT = T_ALL / 128;
    for (int itx = 0;; itx++) {
      int nt, mt;
      if (!xcd_tile(itx, bid, nb, MT, NT, mt, nt)) break;
      int m0 = mt * 128, n0 = nt * 128;
      auto rowfn = [&](int r) -> const void* {
        int tg = m0 + r;
        return tg < 32768 ? p.p_prompt + ((size_t)l * 32768 + tg) * 256 : p.p_sample + ((size_t)l * 65536 + (tg - 32768)) * 256;
      };
      auto epi = [&](f32x4(&acc)[4][4], int rbase, int cbase) {
        EPI_LOOP({ st_bf4(p.xb + (size_t)(m0 + row) * 1024 + n0 + col, v); })
      };
      gemm_tile<true>(rowfn, p.wp_t + ((size_t)l * 1024 + n0) * 256, 256, epi, lds, tid);
    }
  }
}

DI void phase_combine(const Params& p, int bid, int nb, int tid) {
  const int lane = tid & 63, wv = tid >> 6;
  u16* ub = p.H;
  for (int t = bid * 4 + wv; t < T_ALL; t += nb * 4) {
    float* xr = p.out + (size_t)t * 1024;
    float4 a[4];
#pragma unroll
    for (int i = 0; i < 4; i++) {
      float4 x = *(const float4*)(xr + i * 256 + lane * 4);
      a[i] = make_float4(x.x * ALPHA_F, x.y * ALPHA_F, x.z * ALPHA_F, x.w * ALPHA_F);
    }
    const int cnt = p.inv_cnt[t];
    for (int j = 0; j < cnt; j++) {
      const int slot = p.inv_slot[(size_t)t * 16 + j];
      const float g = p.gate[slot];
      const u16* orow = p.O + (size_t)slot * 1024;
#pragma unroll
      for (int i = 0; i < 4; i++) {
        uint2 r = *(const uint2*)(orow + i * 256 + lane * 4);
        a[i].x += g * blo(r.x);
        a[i].y += g * bhi(r.x);
        a[i].z += g * blo(r.y);
        a[i].w += g * bhi(r.y);
      }
    }
#pragma unroll
    for (int i = 0; i < 4; i++) {
      *(float4*)(xr + i * 256 + lane * 4) = a[i];
      *(uint2*)(ub + (size_t)t * 1024 + i * 256 + lane * 4) = make_uint2(pack2(a[i].x, a[i].y), pack2(a[i].z, a[i].w));
    }
  }
}

DI void phase_ple(const Params& p, int l, char* lds, int bid, int nb, int tid) {
  const int NT = 8, MT = T_ALL / 128;
  for (int it = 0;; it++) {
    int nt, mt;
    if (!xcd_tile(it, bid, nb, MT, NT, mt, nt)) break;
    int m0 = mt * 128, n0 = nt * 128;
    auto rowfn = [&](int r) -> const void* { return p.H + (size_t)(m0 + r) * 1024; };
    auto epi = [&](f32x4(&acc)[4][4], int rbase, int cbase) {
      EPI_LOOP({
        size_t o = (size_t)(m0 + row) * 1024 + n0 + col;
        float4 u = *(const float4*)(p.out + o);
        uint2 pr = *(const uint2*)(p.xb + o);
        *(float4*)(p.out + o) = make_float4(u.x + sigm(v[0]) * blo(pr.x), u.y + sigm(v[1]) * bhi(pr.x),
                                            u.z + sigm(v[2]) * blo(pr.y), u.w + sigm(v[3]) * bhi(pr.y));
      })
    };
    gemm_tile<false>(rowfn, p.wg_t + ((size_t)l * 1024 + n0) * 1024, 1024, epi, lds, tid);
  }
}

__global__ void __launch_bounds__(NTHR, 2) mega(Params p) {
  __shared__ __attribute__((aligned(16))) char lds[73728];
  cg::grid_group grid = cg::this_grid();
  const int tid0 = threadIdx.x, bid0 = blockIdx.x, nb = gridDim.x;
  int pc = 0;
#define PHASE(...)                                      \
  {                                                     \
    if (pc >= p.pb && pc < p.pe) {                      \
      if (pc > p.pb) grid.sync();                       \
      int tid = tid0, bid = bid0;                       \
      asm volatile("" : "+v"(tid), "+s"(bid));          \
      __VA_ARGS__;                                      \
    }                                                   \
    pc++;                                               \
  }
  PHASE(phase_convert(p, lds, bid, nb, tid));
  for (int l = 0; l < 2; l++) {
    for (int sg = 0; sg < 3; sg++) {
      const int tok0 = sg * T_SUB;
      const int B = sg == 0 ? 4 : 8, N = sg == 0 ? 8192 : 4096;
      PHASE(phase_inproj(p, l, tok0, lds, bid, nb, tid));
#if REP_INPROJ
      PHASE(phase_inproj(p, l, tok0, lds, bid, nb, tid));
#endif
      PHASE(phase_prep(p, l, N, bid, nb, tid));
      PHASE(phase_smallgemm(p, l, B, N, lds, bid, nb, tid));
      PHASE(phase_attn(p, B, N, lds, bid, nb, tid));
#if REP_ATTN
      PHASE(phase_attn(p, B, N, lds, bid, nb, tid));
#endif
      PHASE(phase_na(p, l, B, N, bid, nb, tid));
#if REP_NA
      PHASE(phase_na(p, l, B, N, bid, nb, tid));
#endif
      PHASE(phase_scan(p, B, N, lds, bid, nb, tid));
#if REP_SCAN
      PHASE(phase_scan(p, B, N, lds, bid, nb, tid));
#endif
      PHASE(phase_final(p, l, bid, nb, tid));
      PHASE(phase_wout(p, l, tok0, lds, bid, nb, tid));
      PHASE(phase_ln<true>(p, p.ln1_g + l * 1024, p.ln1_b + l * 1024, p.moe_router + (size_t)l * 16384, tok0, T_SUB, lds, bid, nb, tid));
    }
    PHASE(phase_topk(p, lds, bid, nb, tid));
    PHASE(phase_moe1(p, l, lds, bid, nb, tid));
#if REP_MOE1
    PHASE(phase_moe1(p, l, lds, bid, nb, tid));
#endif
    PHASE(phase_moe2(p, l, lds, bid, nb, tid));
    PHASE(phase_combine(p, bid, nb, tid));
    PHASE(phase_ple(p, l, lds, bid, nb, tid));
    PHASE(phase_ln<false>(p, p.ln2_g + l * 1024, p.ln2_b + l * 1024, nullptr, 0, T_ALL, lds, bid, nb, tid));
  }
}

#define N_PHASES 1000
#ifndef FUSED
#define FUSED 1
#endif

extern "C" void kernel_launch(void* const* d_in, const int* in_sizes, int n_in, void* d_out, int out_size, void* d_ws,
                              size_t ws_size, hipStream_t stream) {
  static int grid_blocks = 0;
  if (!grid_blocks) {
    int dev = 0, cus = 0, per_cu = 0;
    (void)hipGetDevice(&dev);
    (void)hipDeviceGetAttribute(&cus, hipDeviceAttributeMultiprocessorCount, dev);
    (void)hipOccupancyMaxActiveBlocksPerMultiprocessor(&per_cu, mega, NTHR, 0);
    if (per_cu > 2) per_cu = 2;
    if (per_cu < 1) per_cu = 1;
    grid_blocks = cus * per_cu;
  }
  Params p;
  memset(&p, 0, sizeof(p));
  const float* const* in = (const float* const*)d_in;
  int k = 0;
  p.x_prompt = in[k++]; p.x_sample = in[k++]; p.p_prompt = in[k++]; p.p_sample = in[k++];
  p.w_in = in[k++]; p.mla_gq = in[k++]; p.mla_gkv = in[k++]; p.mla_wuq = in[k++]; p.mla_wuk = in[k++]; p.mla_wuv = in[k++];
  p.na_bias = in[k++]; p.hg_lb = in[k++]; p.hg_gnorm = in[k++];
  p.rw_mu = in[k++]; p.rw_w0 = in[k++]; p.rw_w_up = in[k++]; p.rw_a0 = in[k++]; p.rw_a_up = in[k++]; p.rw_g_up = in[k++];
  p.rw_kk = in[k++]; p.rw_ka = in[k++]; p.rw_rk = in[k++]; p.rw_ln_w = in[k++]; p.rw_ln_b = in[k++];
  p.w_out = in[k++]; p.ln1_g = in[k++]; p.ln1_b = in[k++]; p.moe_router = in[k++]; p.moe_w1 = in[k++]; p.moe_w3 = in[k++];
  p.moe_w2 = in[k++]; p.ln2_g = in[k++]; p.ln2_b = in[k++]; p.ple_gate = in[k++]; p.ple_proj = in[k++];
  p.out = (float*)d_out;
  char* ws = (char*)d_ws;
  size_t off = 0;
  auto take = [&](size_t bytes) { char* r = ws + off; off += (bytes + 255) & ~(size_t)255; return r; };
  p.w_in_t = (u16*)take((size_t)2 * 3712 * 1024 * 2);
  p.wuq_t = (u16*)take((size_t)2 * 384 * 256 * 2);
  p.wkv_t = (u16*)take((size_t)2 * 512 * 128 * 2);
  p.wup_t = (u16*)take((size_t)4 * 256 * 64 * 2);
  p.aup_t = (u16*)take((size_t)4 * 256 * 64 * 2);
  p.gup_t = (u16*)take((size_t)2 * 256 * 128 * 2);
  p.wout_t = (u16*)take((size_t)2 * 1024 * 1024 * 2);
  p.w13_t = (u16*)take((size_t)32 * 1024 * 1024 * 2);
  p.w2_t = (u16*)take((size_t)32 * 1024 * 512 * 2);
  p.wg_t = (u16*)take((size_t)2 * 1024 * 1024 * 2);
  p.wp_t = (u16*)take((size_t)2 * 1024 * 256 * 2);
  p.ropec = (float*)take((size_t)8192 * 16 * 4);
  p.ropes = (float*)take((size_t)8192 * 16 * 4);
  p.lb = (float*)take(1024 * 4);
  p.affT = (float*)take((size_t)16 * T_ALL * 4);
  p.gate = (float*)take((size_t)196608 * 4);
  p.idx = (int*)take((size_t)196608 * 4);
  p.inv_cnt = (int*)take((size_t)T_ALL * 4);
  p.inv_slot = (int*)take((size_t)T_ALL * 16 * 4);
  p.xb = (u16*)take((size_t)T_ALL * 1024 * 2);
  const size_t stage0 = off;
  p.z = (u16*)take((size_t)T_SUB * ZLD * 2);
  p.cat = (u16*)take((size_t)T_SUB * 1024 * 2);
  p.Q = (u16*)take((size_t)T_SUB * 384 * 2);
  p.Kb = (u16*)take((size_t)T_SUB * 384 * 2);
  p.Vt = (u16*)take((size_t)T_SUB * 256 * 2);
  p.cqn = (u16*)take((size_t)T_SUB * 256 * 2);
  p.ckvn = (u16*)take((size_t)T_SUB * 128 * 2);
  p.S1 = (u16*)take((size_t)T_SUB * 384 * 2);
  p.rs = (u16*)take((size_t)T_SUB * 256 * 2);
  p.ks = (u16*)take((size_t)T_SUB * 256 * 2);
  p.vs = (u16*)take((size_t)T_SUB * 256 * 2);
  p.kk = (u16*)take((size_t)T_SUB * 256 * 2);
  p.gD = (u16*)take((size_t)T_SUB * 256 * 2);
  p.dec = (u16*)take((size_t)2 * T_SUB * 256 * 2);
  p.kka = (u16*)take((size_t)2 * T_SUB * 256 * 2);
  p.kt = (u16*)take((size_t)2 * T_SUB * 256 * 2);
  p.oC = (u16*)take((size_t)2 * T_SUB * 256 * 2);
  p.oD = (u16*)take((size_t)2 * T_SUB * 256 * 2);
  p.bonus = (float*)take((size_t)T_SUB * 4 * 4);
  off = stage0;
  p.O = (u16*)take((size_t)196608 * 1024 * 2);
  p.H = (u16*)take((size_t)196608 * 512 * 2);
  for (int i = 0; i < 16; i++) p.inv_freq[i] = pow(10000.0, -(double)i / 16.0);
#if FUSED
  p.pb = 0;
  p.pe = N_PHASES;
  {
    void* args[] = {&p};
    hipError_t e = hipLaunchCooperativeKernel((void*)mega, dim3(grid_blocks), dim3(NTHR), args, 0, stream);
    if (e != hipSuccess) fprintf(stderr, "cooperative launch failed: %s (grid %d)\n", hipGetErrorString(e), grid_blocks);
  }
#else
  for (int ph = 0; ph < N_PHASES; ph++) {
    p.pb = ph;
    p.pe = ph + 1;
    void* args[] = {&p};
    hipError_t e = hipLaunchCooperativeKernel((void*)mega, dim3(grid_blocks), dim3(NTHR), args, 0, stream);
    if (e != hipSuccess) fprintf(stderr, "cooperative launch failed: %s (grid %d)\n", hipGetErrorString(e), grid_blocks);
  }
#endif
}
```

```cpp
#include <hip/hip_runtime.h>
#include <hip/hip_cooperative_groups.h>
#include <cstdio>
#include <cmath>
#include <cstring>
namespace cg = cooperative_groups;

typedef unsigned short u16;
using bf16x8 = __attribute__((ext_vector_type(8))) short;
using f32x4 = __attribute__((ext_vector_type(4))) float;
using f32x16 = __attribute__((ext_vector_type(16))) float;

#define REP_INPROJ 0
#define REP_ATTN 0
#define REP_NA 0
#define REP_SCAN 0
#define REP_MOE1 0
#define REP_MOE2 0
#define REP_SYNC 0
#define DI __device__ __forceinline__
#define NTHR 256
#define T_ALL 98304
#define T_SUB 32768
#define ZLD 3616
#define ZB_OFF 416
#define ZC_OFF 1184
#define ZD_OFF 2464
#define LOG2E 1.4426950408889634f
#define ALPHA_F 1.4142135623730951f

struct Params {
  const float *x_prompt, *x_sample, *p_prompt, *p_sample;
  const float *w_in, *mla_gq, *mla_gkv, *mla_wuq, *mla_wuk, *mla_wuv, *na_bias, *hg_lb, *hg_gnorm;
  const float *rw_mu, *rw_w0, *rw_w_up, *rw_a0, *rw_a_up, *rw_g_up, *rw_kk, *rw_ka, *rw_rk, *rw_ln_w, *rw_ln_b;
  const float *w_out, *ln1_g, *ln1_b, *moe_router, *moe_w1, *moe_w3, *moe_w2, *ln2_g, *ln2_b, *ple_gate, *ple_proj;
  float* out;
  u16 *w_in_t, *wuq_t, *wkv_t, *wup_t, *aup_t, *gup_t, *wout_t, *w13_t, *w2_t, *wg_t, *wp_t;
  float *ropec, *ropes, *lb, *affT, *gate;
  int* idx;
  unsigned* bar;
  int *inv_cnt, *inv_slot;
  u16 *z, *cat, *Q, *Kb, *Vt, *cqn, *ckvn, *S1, *rs, *ks, *vs, *kk, *gD, *dec, *kka, *kt, *oC, *oD;
  float* bonus;
  u16* xb;
  u16* O;
  u16* H;
  double inv_freq[16];
  int pb, pe;
};

DI u16 f2bf(float f) { unsigned u = __float_as_uint(f); u += 0x7fffu + ((u >> 16) & 1u); return (u16)(u >> 16); }
DI float bf2f(u16 h) { return __uint_as_float(((unsigned)h) << 16); }
DI unsigned pack2(float a, float b) { return (unsigned)f2bf(a) | ((unsigned)f2bf(b) << 16); }
DI float blo(unsigned u) { return __uint_as_float(u << 16); }
DI float bhi(unsigned u) { return __uint_as_float(u & 0xffff0000u); }
DI float sigm(float x) { return 1.f / (1.f + __expf(-x)); }
DI float tanh_(float x) { return 1.f - 2.f / (__expf(2.f * x) + 1.f); }
DI float ex2(float x) { return __builtin_amdgcn_exp2f(x); }
DI int clampi(int v, int lo, int hi) { return v < lo ? lo : (v > hi ? hi : v); }
DI int swap23(int x) { return (x & ~12) | ((x & 4) << 1) | ((x & 8) >> 1); }

template <int CTRL> DI float dpp_f(float v) {
  return __int_as_float(__builtin_amdgcn_update_dpp(0, __float_as_int(v), CTRL, 0xF, 0xF, true));
}
DI float reduce16(float v) {
  v += dpp_f<0xB1>(v);
  v += dpp_f<0x4E>(v);
  v += dpp_f<0x141>(v);
  v += dpp_f<0x140>(v);
  return v;
}
DI float wave_sum(float v) {
  v = reduce16(v);
  v += __shfl_xor(v, 16);
  v += __shfl_xor(v, 32);
  return v;
}

struct TileIter {
  int bid, nb, off;
  DI int first(int n) { int f = bid - off; if (f < 0) f += nb; off = (off + n) % nb; return f; }
};

DI bool xcd_tile(int it, int bid, int nb, int MT, int NT, int& mt, int& nt) {
  const int x = bid & 7, slot = bid >> 3, nslots = nb >> 3;
  const int mper = MT >> 3;
  const int i = slot + it * nslots;
  if (i >= mper * NT) return false;
  const int mi = i & 7, rest = i >> 3;
  nt = rest % NT;
  mt = x * mper + (rest / NT) * 8 + mi;
  return true;
}

DI void convT_job(const float* __restrict__ W, int K, int N, int Npad, u16* __restrict__ Wt, int mode, char* lds,
                  TileIter& it, int tid) {
  float(*tile)[65] = (float(*)[65])lds;
  int tk = K >> 6, tn = Npad >> 6;
  int nt = tk * tn;
  for (int t = it.first(nt); t < nt; t += it.nb) {
    int k0 = (t % tk) << 6, n0 = (t / tk) << 6;
#pragma unroll
    for (int i = 0; i < 16; i++) {
      int kl = (tid >> 6) + 4 * i, nl = tid & 63;
      int n = n0 + nl;
      tile[kl][nl] = (n < N) ? W[(size_t)(k0 + kl) * N + n] : 0.f;
    }
    __syncthreads();
    {
      int nl = tid >> 2, ks = (tid & 3) * 16;
      int n = n0 + nl;
      int row = n;
      if (mode == 1) row = (n >> 4) * 32 + (n & 15);
      if (mode == 2) row = (n >> 4) * 32 + 16 + (n & 15);
      unsigned pk[8];
#pragma unroll
      for (int j = 0; j < 8; j++) pk[j] = pack2(tile[ks + 2 * j][nl], tile[ks + 2 * j + 1][nl]);
      uint4* dst = (uint4*)(Wt + (size_t)row * K + k0 + ks);
      dst[0] = make_uint4(pk[0], pk[1], pk[2], pk[3]);
      dst[1] = make_uint4(pk[4], pk[5], pk[6], pk[7]);
    }
    __syncthreads();
  }
}

DI void phase_convert(const Params& p, char* lds, int bid, int nb, int tid) {
  TileIter it{bid, nb, 0};
  for (int l = 0; l < 2; l++) {
    convT_job(p.w_in + (size_t)l * 1024 * 3616, 1024, 3616, 3712, p.w_in_t + (size_t)l * 3712 * 1024, 0, lds, it, tid);
    convT_job(p.mla_wuq + (size_t)l * 256 * 384, 256, 384, 384, p.wuq_t + (size_t)l * 384 * 256, 0, lds, it, tid);
    convT_job(p.mla_wuk + (size_t)l * 128 * 256, 128, 256, 256, p.wkv_t + (size_t)l * 512 * 128, 0, lds, it, tid);
    convT_job(p.mla_wuv + (size_t)l * 128 * 256, 128, 256, 256, p.wkv_t + (size_t)l * 512 * 128 + 256 * 128, 0, lds, it, tid);
    for (int d = 0; d < 2; d++) {
      convT_job(p.rw_w_up + (size_t)(l * 2 + d) * 64 * 256, 64, 256, 256, p.wup_t + (size_t)(l * 2 + d) * 256 * 64, 0, lds, it, tid);
      convT_job(p.rw_a_up + (size_t)(l * 2 + d) * 64 * 256, 64, 256, 256, p.aup_t + (size_t)(l * 2 + d) * 256 * 64, 0, lds, it, tid);
    }
    convT_job(p.rw_g_up + (size_t)l * 128 * 256, 128, 256, 256, p.gup_t + (size_t)l * 256 * 128, 0, lds, it, tid);
    convT_job(p.w_out + (size_t)l * 1024 * 1024, 1024, 1024, 1024, p.wout_t + (size_t)l * 1024 * 1024, 0, lds, it, tid);
    for (int e = 0; e < 16; e++) {
      size_t le = (size_t)(l * 16 + e);
      convT_job(p.moe_w1 + le * 1024 * 512, 1024, 512, 512, p.w13_t + le * 1024 * 1024, 1, lds, it, tid);
      convT_job(p.moe_w3 + le * 1024 * 512, 1024, 512, 512, p.w13_t + le * 1024 * 1024, 2, lds, it, tid);
      convT_job(p.moe_w2 + le * 512 * 1024, 512, 1024, 1024, p.w2_t + le * 1024 * 512, 0, lds, it, tid);
    }
    convT_job(p.ple_gate + (size_t)l * 1024 * 1024, 1024, 1024, 1024, p.wg_t + (size_t)l * 1024 * 1024, 0, lds, it, tid);
    convT_job(p.ple_proj + (size_t)l * 256 * 1024, 256, 1024, 1024, p.wp_t + (size_t)l * 1024 * 256, 0, lds, it, tid);
  }
  int gt = bid * NTHR + tid, ng = nb * NTHR;
  for (size_t i = gt; i < (size_t)T_ALL * 256; i += ng) {
    float4 v = (i < (size_t)32768 * 256) ? ((const float4*)p.x_prompt)[i] : ((const float4*)p.x_sample)[i - (size_t)32768 * 256];
    ((uint2*)p.xb)[i] = make_uint2(pack2(v.x, v.y), pack2(v.z, v.w));
  }
  for (int i = gt; i < 8192 * 16; i += ng) {
    int n = i >> 4, f = i & 15;
    double ifq = 0.0;
#pragma unroll
    for (int j = 0; j < 16; j++) ifq = (f == j) ? p.inv_freq[j] : ifq;
    double rev = (double)n * ifq * 0.15915494309189535;
    double fr = rev - rint(rev);
    float ff = (float)fr;
    p.ropec[i] = __builtin_amdgcn_cosf(ff);
    p.ropes[i] = __builtin_amdgcn_sinf(ff);
  }
  for (int i = gt; i < 512; i += ng) {
    float h0 = p.hg_lb[i], h1 = p.hg_lb[512 + i];
    p.lb[i] = 0.f;
    p.lb[512 + i] = 1.f / (1.f + __expf(h0 - h1));
  }
}

constexpr int G_STAGE = 32768;

template <bool AF32, class RowFn, class Epi>
DI void gemm_tile(RowFn rowfn, const u16* __restrict__ Bt, int K, Epi epi, char* lds, int tid) {
  const int lane = tid & 63, wid = tid >> 6, wr = wid >> 1, wc = wid & 1, fr = lane & 15, fq = lane >> 4;
  f32x4 acc[4][4];
#pragma unroll
  for (int m = 0; m < 4; m++)
#pragma unroll
    for (int n = 0; n < 4; n++) acc[m][n] = f32x4{0.f, 0.f, 0.f, 0.f};

  const int lrow = tid >> 3;
  const int lc = (tid & 7) ^ ((tid >> 4) & 7);
  const float* apf[8];
  const u16* aph[4];
  const u16* bp[4];
  if constexpr (AF32) {
#pragma unroll
    for (int i = 0; i < 8; i++) apf[i] = (const float*)rowfn(i * 16 + (tid >> 4)) + (tid & 15) * 4;
  } else {
#pragma unroll
    for (int i = 0; i < 4; i++) aph[i] = (const u16*)rowfn(lrow + i * 32) + lc * 8;
  }
#pragma unroll
  for (int i = 0; i < 4; i++) bp[i] = Bt + (size_t)(lrow + i * 32) * K + lc * 8;
  const int afoff = (tid >> 4) * 128 + ((((tid & 15) >> 1) ^ ((tid >> 5) & 7)) * 16) + (tid & 1) * 8;

  float4 raf[8];
  auto issue = [&](int buf, int k0) {
    char* A = lds + buf * G_STAGE;
    char* B = A + 16384;
#pragma unroll
    for (int i = 0; i < 4; i++)
      __builtin_amdgcn_global_load_lds((const unsigned*)(bp[i] + k0), (unsigned*)(B + wid * 1024 + i * 4096), 16, 0, 0);
    if constexpr (AF32) {
#pragma unroll
      for (int i = 0; i < 8; i++) raf[i] = *(const float4*)(apf[i] + k0);
    } else {
#pragma unroll
      for (int i = 0; i < 4; i++)
        __builtin_amdgcn_global_load_lds((const unsigned*)(aph[i] + k0), (unsigned*)(A + wid * 1024 + i * 4096), 16, 0, 0);
    }
  };
  auto astore = [&](int buf) {
    if constexpr (AF32) {
      char* A = lds + buf * G_STAGE;
#pragma unroll
      for (int i = 0; i < 8; i++) asm volatile("" : "+v"(raf[i].x), "+v"(raf[i].y), "+v"(raf[i].z), "+v"(raf[i].w));
#pragma unroll
      for (int i = 0; i < 8; i++)
        *(uint2*)(A + afoff + i * 2048) = make_uint2(pack2(raf[i].x, raf[i].y), pack2(raf[i].z, raf[i].w));
    }
  };
  const int abase = (wr * 64 + fr) * 128, bbase = 16384 + (wc * 64 + fr) * 128;
  const int sw0 = ((fq) ^ (fr >> 1)) * 16, sw1 = ((4 + fq) ^ (fr >> 1)) * 16;

  const int nk = K >> 6;
  issue(0, 0);
  astore(0);
  __syncthreads();
  for (int kt = 0; kt < nk; kt++) {
    if (kt + 1 < nk) issue((kt + 1) & 1, (kt + 1) << 6);
    __builtin_amdgcn_sched_barrier(0);
    const char* S = lds + (kt & 1) * G_STAGE;
#pragma unroll
    for (int kk = 0; kk < 2; kk++) {
      const int sw = kk ? sw1 : sw0;
      bf16x8 af[4], bfr[4];
#pragma unroll
      for (int m = 0; m < 4; m++) af[m] = *(const bf16x8*)(S + abase + m * 2048 + sw);
#pragma unroll
      for (int n = 0; n < 4; n++) bfr[n] = *(const bf16x8*)(S + bbase + n * 2048 + sw);
#pragma unroll
      for (int m = 0; m < 4; m++)
#pragma unroll
        for (int n = 0; n < 4; n++) acc[m][n] = __builtin_amdgcn_mfma_f32_16x16x32_bf16(bfr[n], af[m], acc[m][n], 0, 0, 0);
    }
    __builtin_amdgcn_sched_barrier(0);
    if (kt + 1 < nk) astore((kt + 1) & 1);
    __syncthreads();
  }
  epi(acc, wr * 64 + fr, wc * 64 + fq * 4);
}

#define EPI_LOOP(...)                                    \
  _Pragma("unroll") for (int m = 0; m < 4; m++)          \
  _Pragma("unroll") for (int n = 0; n < 4; n++) {        \
    const int row = rbase + m * 16;                      \
    const int col = cbase + n * 16;                      \
    const f32x4 v = acc[m][n];                           \
    __VA_ARGS__                                          \
  }

DI void st_bf4(u16* dst, f32x4 v) { *(uint2*)dst = make_uint2(pack2(v[0], v[1]), pack2(v[2], v[3])); }

DI const float* xin_row(const Params& p, int l, int tg) {
  if (l == 0) return tg < 32768 ? p.x_prompt + (size_t)tg * 1024 : p.x_sample + (size_t)(tg - 32768) * 1024;
  return p.out + (size_t)tg * 1024;
}

DI void phase_inproj(const Params& p, int l, int tok0, char* lds, int bid, int nb, int tid) {
  const int NT = 29, MT = T_SUB / 128;
  for (int it = 0;; it++) {
    int nt, mt;
    if (!xcd_tile(it, bid, nb, MT, NT, mt, nt)) break;
    int m0 = mt * 128, n0 = nt * 128;
    auto rowfn = [&](int r) -> const void* { return p.xb + (size_t)(tok0 + m0 + r) * 1024; };
    u16* z = p.z;
    auto epi = [&](f32x4(&acc)[4][4], int rbase, int cbase) {
      EPI_LOOP({
        int c = n0 + col;
        if (c < ZLD) st_bf4(z + (size_t)(m0 + row) * ZLD + c, v);
      })
    };
    gemm_tile<false>(rowfn, p.w_in_t + ((size_t)l * 3712 + n0) * 1024, 1024, epi, lds, tid);
  }
}

DI void phase_prep(const Params& p, int l, int N, int bid, int nb, int tid) {
  const int lane = tid & 63, wv = tid >> 6;
  const float* gq = p.mla_gq + l * 256;
  const float* gkv = p.mla_gkv + l * 128;
  const float* lb = p.lb + l * 512;
  const float* mu0 = p.rw_mu + (size_t)l * 2 * 1152;
  const float* mu1 = mu0 + 1152;
  const float* k_k = p.rw_kk + l * 256;
  const float* r_k = p.rw_rk + l * 256;
  for (int t = bid * 4 + wv; t < T_SUB; t += nb * 4) {
    u16* zr = p.z + (size_t)t * ZLD;
    const int n = t & (N - 1);
    {
      uint2 raw = *(const uint2*)(zr + lane * 4);
      float v0 = blo(raw.x), v1 = bhi(raw.x), v2 = blo(raw.y), v3 = bhi(raw.y);
      float ss = wave_sum(v0 * v0 + v1 * v1 + v2 * v2 + v3 * v3);
      float ri = rsqrtf(ss * (1.f / 256.f) + 1e-6f);
      const float* g = gq + lane * 4;
      *(uint2*)(p.cqn + (size_t)t * 256 + lane * 4) =
          make_uint2(pack2(v0 * ri * g[0], v1 * ri * g[1]), pack2(v2 * ri * g[2], v3 * ri * g[3]));
    }
    {
      unsigned raw = *(const unsigned*)(zr + 256 + lane * 2);
      float v0 = blo(raw), v1 = bhi(raw);
      float ss = wave_sum(v0 * v0 + v1 * v1);
      float ri = rsqrtf(ss * (1.f / 128.f) + 1e-6f);
      *(unsigned*)(p.ckvn + (size_t)t * 128 + lane * 2) = pack2(v0 * ri * gkv[lane * 2], v1 * ri * gkv[lane * 2 + 1]);
    }
    if (lane < 16) {
      float x1 = bf2f(zr[384 + lane]), x2 = bf2f(zr[400 + lane]);
      float c = p.ropec[n * 16 + lane], s = p.ropes[n * 16 + lane];
      u16 k1 = f2bf(x1 * c - x2 * s), k2 = f2bf(x1 * s + x2 * c);
      u16* kb = p.Kb + (size_t)t * 384;
#pragma unroll
      for (int h = 0; h < 4; h++) {
        kb[h * 96 + 64 + lane] = k1;
        kb[h * 96 + 80 + lane] = k2;
      }
    }
    {
      uint4* ptr = (uint4*)(zr + ZC_OFF + 256 + lane * 8);
      uint4 raw = *ptr;
      const float* lbp = lb + lane * 8;
      unsigned w[4] = {raw.x, raw.y, raw.z, raw.w};
#pragma unroll
      for (int j = 0; j < 4; j++) {
        float a = blo(w[j]), b = bhi(w[j]);
        float la = lbp[2 * j], lb2 = lbp[2 * j + 1];
        a = la + (1.f - la) * sigm(a);
        b = lb2 + (1.f - lb2) * sigm(b);
        w[j] = pack2(a, b);
      }
      *ptr = make_uint4(w[0], w[1], w[2], w[3]);
    }
    {
      const u16* zd = zr + ZD_OFF;
      const bool hp = n > 0, hn = n < N - 1;
      float rr[4], kx[4], vx[4];
#pragma unroll
      for (int part = 0; part < 3; part++) {
        int c = part * 256 + lane * 4;
        uint2 cur = *(const uint2*)(zd + c);
        uint2 prv = hp ? *(const uint2*)(zd - ZLD + c) : make_uint2(0, 0);
        uint2 nxt = hn ? *(const uint2*)(zd + ZLD + c) : make_uint2(0, 0);
        float cz[4] = {blo(cur.x), bhi(cur.x), blo(cur.y), bhi(cur.y)};
        float pz[4] = {blo(prv.x), bhi(prv.x), blo(prv.y), bhi(prv.y)};
        float nz[4] = {blo(nxt.x), bhi(nxt.x), blo(nxt.y), bhi(nxt.y)};
#pragma unroll
        for (int j = 0; j < 4; j++) {
          float o = cz[j] + mu0[c + j] * (pz[j] - cz[j]) + mu1[c + j] * (nz[j] - cz[j]);
          if (part == 0) rr[j] = o;
          if (part == 1) kx[j] = o;
          if (part == 2) vx[j] = o;
        }
      }
      int c4 = lane * 4;
      *(uint2*)(p.rs + (size_t)t * 256 + c4) = make_uint2(pack2(rr[0], rr[1]), pack2(rr[2], rr[3]));
      *(uint2*)(p.ks + (size_t)t * 256 + c4) = make_uint2(pack2(kx[0], kx[1]), pack2(kx[2], kx[3]));
      *(uint2*)(p.vs + (size_t)t * 256 + c4) = make_uint2(pack2(vx[0], vx[1]), pack2(vx[2], vx[3]));
      float kq[4], ss = 0.f, bo = 0.f;
#pragma unroll
      for (int j = 0; j < 4; j++) {
        kq[j] = kx[j] * k_k[c4 + j];
        ss += kq[j] * kq[j];
        bo += rr[j] * kx[j] * r_k[c4 + j];
      }
      ss = reduce16(ss);
      bo = reduce16(bo);
      float inv = 1.f / fmaxf(sqrtf(ss), 1e-12f);
      *(uint2*)(p.kk + (size_t)t * 256 + c4) = make_uint2(pack2(kq[0] * inv, kq[1] * inv), pack2(kq[2] * inv, kq[3] * inv));
      if ((lane & 15) == 0) p.bonus[(size_t)t * 4 + (lane >> 4)] = bo;
#pragma unroll
      for (int i = 0; i < 6; i++) {
        int c = 768 + lane + 64 * i;
        float cz = bf2f(zd[c]);
        float pz = hp ? bf2f(zd[c - ZLD]) : 0.f;
        float nz = hn ? bf2f(zd[c + ZLD]) : 0.f;
        float o = cz + mu0[c] * (pz - cz) + mu1[c] * (nz - cz);
        if (i < 2) o = tanh_(o);
        else if (i >= 4) o = sigm(o);
        p.S1[(size_t)t * 384 + lane + 64 * i] = f2bf(o);
      }
    }
  }
}

DI void phase_smallgemm(const Params& p, int l, int B, int N, char* lds, int bid, int nb, int tid) {
  TileIter it{bid, nb, 0};
  const int MT = T_SUB / 128;
  {
    const int NT = 3;
    for (int itx = 0;; itx++) {
      int nt, mt;
      if (!xcd_tile(itx, bid, nb, MT, NT, mt, nt)) break;
      int m0 = mt * 128, n0 = nt * 128;
      auto rowfn = [&](int r) -> const void* { return p.cqn + (size_t)(m0 + r) * 256; };
      u16* Q = p.Q;
      auto epi = [&](f32x4(&acc)[4][4], int rbase, int cbase) {
        const float SC = 0.10206207261596577f * LOG2E;
        EPI_LOOP({ st_bf4(Q + (size_t)(m0 + row) * 384 + n0 + col, v * SC); })
      };
      gemm_tile<false>(rowfn, p.wuq_t + ((size_t)l * 384 + n0) * 256, 256, epi, lds, tid);
    }
  }
  {
    const int NT = 4;
    for (int itx = 0;; itx++) {
      int nt, mt;
      if (!xcd_tile(itx, bid, nb, MT, NT, mt, nt)) break;
      int m0 = mt * 128, n0 = nt * 128;
      auto rowfn = [&](int r) -> const void* { return p.ckvn + (size_t)(m0 + r) * 128; };
      u16* Kb = p.Kb;
      u16* Vt = p.Vt;
      auto epi = [&](f32x4(&acc)[4][4], int rbase, int cbase) {
        EPI_LOOP({
          int c = n0 + col;
          int tk = m0 + row;
          if (c < 256) {
            int h = c >> 6, d = c & 63;
            st_bf4(Kb + (size_t)tk * 384 + h * 96 + d, v);
          } else {
            int cc = c - 256;
            int b = tk / N, nn = tk - b * N;
            u16* dst = Vt + ((size_t)(b * 256 + cc)) * N + nn;
            dst[0] = f2bf(v[0]);
            dst[(size_t)N] = f2bf(v[1]);
            dst[(size_t)2 * N] = f2bf(v[2]);
            dst[(size_t)3 * N] = f2bf(v[3]);
          }
        })
      };
      gemm_tile<false>(rowfn, p.wkv_t + ((size_t)l * 512 + n0) * 128, 128, epi, lds, tid);
    }
  }
  for (int d = 0; d < 2; d++) {
    const int NT = 2;
    for (int itx = 0;; itx++) {
      int nt, mt;
      if (!xcd_tile(itx, bid, nb, MT, NT, mt, nt)) break;
      int m0 = mt * 128, n0 = nt * 128;
      auto rowfn = [&](int r) -> const void* { return p.S1 + (size_t)(m0 + r) * 384 + d * 64; };
      u16* dst = p.dec + (size_t)d * T_SUB * 256;
      const float* w0 = p.rw_w0 + (l * 2 + d) * 256;
      auto epi = [&](f32x4(&acc)[4][4], int rbase, int cbase) {
        EPI_LOOP({
          f32x4 o;
          for (int j = 0; j < 4; j++) o[j] = __expf(-0.6065306597126334f * sigm(w0[n0 + col + j] + v[j]));
          st_bf4(dst + (size_t)(m0 + row) * 256 + n0 + col, o);
        })
      };
      gemm_tile<false>(rowfn, p.wup_t + ((size_t)(l * 2 + d) * 256 + n0) * 64, 64, epi, lds, tid);
    }
  }
  for (int d = 0; d < 2; d++) {
    const int NT = 2;
    for (int itx = 0;; itx++) {
      int nt, mt;
      if (!xcd_tile(itx, bid, nb, MT, NT, mt, nt)) break;
      int m0 = mt * 128, n0 = nt * 128;
      auto rowfn = [&](int r) -> const void* { return p.S1 + (size_t)(m0 + r) * 384 + 128 + d * 64; };
      u16* dka = p.kka + (size_t)d * T_SUB * 256;
      u16* dkt = p.kt + (size_t)d * T_SUB * 256;
      const float* a0 = p.rw_a0 + (l * 2 + d) * 256;
      const float* ka = p.rw_ka + l * 256;
      const u16* kkp = p.kk;
      const u16* ksp = p.ks;
      auto epi = [&](f32x4(&acc)[4][4], int rbase, int cbase) {
        EPI_LOOP({
          size_t o = (size_t)(m0 + row) * 256 + n0 + col;
          uint2 kkr = *(const uint2*)(kkp + o);
          uint2 ksr = *(const uint2*)(ksp + o);
          float kkv[4] = {blo(kkr.x), bhi(kkr.x), blo(kkr.y), bhi(kkr.y)};
          float ksv[4] = {blo(ksr.x), bhi(ksr.x), blo(ksr.y), bhi(ksr.y)};
          f32x4 o1, o2;
          for (int j = 0; j < 4; j++) {
            float a = sigm(a0[n0 + col + j] + v[j]);
            o1[j] = kkv[j] * a;
            o2[j] = ksv[j] * (1.f + (a - 1.f) * ka[n0 + col + j]);
          }
          st_bf4(dka + o, o1);
          st_bf4(dkt + o, o2);
        })
      };
      gemm_tile<false>(rowfn, p.aup_t + ((size_t)(l * 2 + d) * 256 + n0) * 64, 64, epi, lds, tid);
    }
  }
  {
    const int NT = 2;
    for (int itx = 0;; itx++) {
      int nt, mt;
      if (!xcd_tile(itx, bid, nb, MT, NT, mt, nt)) break;
      int m0 = mt * 128, n0 = nt * 128;
      auto rowfn = [&](int r) -> const void* { return p.S1 + (size_t)(m0 + r) * 384 + 256; };
      u16* dst = p.gD;
      auto epi = [&](f32x4(&acc)[4][4], int rbase, int cbase) {
        EPI_LOOP({ st_bf4(dst + (size_t)(m0 + row) * 256 + n0 + col, v); })
      };
      gemm_tile<false>(rowfn, p.gup_t + ((size_t)l * 256 + n0) * 128, 128, epi, lds, tid);
    }
  }
}

DI bf16x8 pack8(const f32x16& s, int o) {
  bf16x8 r;
#pragma unroll
  for (int j = 0; j < 8; j++) r[j] = (short)f2bf(s[o + j]);
  return r;
}

constexpr int AT_KP = 208, AT_VP = 144, AT_BUF = 64 * AT_KP + 64 * AT_VP;
DI void phase_attn(const Params& p, int B, int N, char* lds, int bid, int nb, int tid) {
  const int lane = tid & 63, wv = tid >> 6, r = lane & 31, hf = lane >> 5;
  const int nqb = N >> 7;
  const int ntask = B * 4 * nqb;
  for (int task = bid; task < ntask; task += nb) {
    const int qb = task % nqb, bh = task / nqb, h = bh & 3, b = bh >> 2;
    const size_t tb = (size_t)b * N;
    const int q = qb * 128 + wv * 32 + r;
    bf16x8 qf[6];
    {
      const u16* qrow = p.Q + (tb + q) * 384 + h * 96;
#pragma unroll
      for (int ks = 0; ks < 4; ks++) qf[ks] = *(const bf16x8*)(qrow + ks * 16 + hf * 8);
      bf16x8 x1r = *(const bf16x8*)(qrow + 64 + hf * 8);
      bf16x8 x2r = *(const bf16x8*)(qrow + 80 + hf * 8);
      const float* cp = p.ropec + q * 16 + hf * 8;
      const float* sp = p.ropes + q * 16 + hf * 8;
      bf16x8 o1, o2;
#pragma unroll
      for (int j = 0; j < 8; j++) {
        float xa = bf2f((u16)x1r[j]), ya = bf2f((u16)x2r[j]);
        float c0 = cp[j], s0 = sp[j];
        o1[j] = (short)f2bf(xa * c0 - ya * s0);
        o2[j] = (short)f2bf(xa * s0 + ya * c0);
      }
      qf[4] = o1;
      qf[5] = o2;
    }
    const u16* Kg = p.Kb + tb * 384 + h * 96;
    const u16* Vg = p.Vt + ((size_t)(b * 4 + h) * 64) * N;
    uint4 kr0, kr1, kr2, vr0, vr1;
    const int lkey = tid >> 2, lpart = tid & 3;
    const int lrow = swap23(lkey);
#define AT_GLOAD(kt_)                                                              \
  {                                                                                \
    const u16* kp_ = Kg + (size_t)((kt_) * 64 + lkey) * 384 + lpart * 24;          \
    kr0 = *(const uint4*)(kp_);                                                    \
    kr1 = *(const uint4*)(kp_ + 8);                                                \
    kr2 = *(const uint4*)(kp_ + 16);                                               \
    const u16* vp_ = Vg + (size_t)lkey * N + (kt_) * 64 + lpart * 16;              \
    vr0 = *(const uint4*)(vp_);                                                    \
    vr1 = *(const uint4*)(vp_ + 8);                                                \
  }
#define AT_LSTORE(buf_)                                                            \
  {                                                                                \
    char* Kl_ = lds + (buf_) * AT_BUF;                                             \
    char* Vl_ = Kl_ + 64 * AT_KP;                                                  \
    *(uint4*)(Kl_ + lrow * AT_KP + (lpart * 3 + 0) * 16) = kr0;                    \
    *(uint4*)(Kl_ + lrow * AT_KP + (lpart * 3 + 1) * 16) = kr1;                    \
    *(uint4*)(Kl_ + lrow * AT_KP + (lpart * 3 + 2) * 16) = kr2;                    \
    *(uint4*)(Vl_ + lkey * AT_VP + (lpart * 2 + 0) * 16) = vr0;                    \
    *(uint4*)(Vl_ + lkey * AT_VP + (lpart * 2 + 1) * 16) = vr1;                    \
  }
    f32x16 O0, O1;
#pragma unroll
    for (int i = 0; i < 16; i++) { O0[i] = 0.f; O1[i] = 0.f; }
    float mrun = -1e30f, lrun = 0.f;
    const int nt = N >> 6;
    __syncthreads();
    AT_GLOAD(0);
    AT_LSTORE(0);
    __syncthreads();
    for (int kt = 0; kt < nt; kt++) {
      if (kt + 1 < nt) AT_GLOAD(kt + 1);
      __builtin_amdgcn_sched_barrier(0);
      const char* Kl = lds + (kt & 1) * AT_BUF;
      const char* Vl = Kl + 64 * AT_KP;
      f32x16 S0, S1;
#pragma unroll
      for (int i = 0; i < 16; i++) { S0[i] = 0.f; S1[i] = 0.f; }
#pragma unroll
      for (int ks = 0; ks < 6; ks++) {
        bf16x8 a0 = *(const bf16x8*)(Kl + r * AT_KP + ks * 32 + hf * 16);
        bf16x8 a1 = *(const bf16x8*)(Kl + (32 + r) * AT_KP + ks * 32 + hf * 16);
        S0 = __builtin_amdgcn_mfma_f32_32x32x16_bf16(a0, qf[ks], S0, 0, 0, 0);
        S1 = __builtin_amdgcn_mfma_f32_32x32x16_bf16(a1, qf[ks], S1, 0, 0, 0);
      }
      float mx = S0[0];
#pragma unroll
      for (int i = 1; i < 16; i++) mx = fmaxf(mx, S0[i]);
#pragma unroll
      for (int i = 0; i < 16; i++) mx = fmaxf(mx, S1[i]);
      mx = fmaxf(mx, __shfl_xor(mx, 32));
      float mn = fmaxf(mrun, mx);
      float alpha = ex2(mrun - mn);
      mrun = mn;
      float ls = 0.f;
#pragma unroll
      for (int i = 0; i < 16; i++) {
        S0[i] = ex2(S0[i] - mn);
        S1[i] = ex2(S1[i] - mn);
        ls += S0[i] + S1[i];
      }
      lrun = lrun * alpha + ls;
#pragma unroll
      for (int i = 0; i < 16; i++) { O0[i] *= alpha; O1[i] *= alpha; }
#pragma unroll
      for (int sp = 0; sp < 4; sp++) {
        bf16x8 pb = (sp < 2) ? pack8(S0, (sp & 1) * 8) : pack8(S1, (sp & 1) * 8);
        bf16x8 v0 = *(const bf16x8*)(Vl + r * AT_VP + sp * 32 + hf * 16);
        bf16x8 v1 = *(const bf16x8*)(Vl + (32 + r) * AT_VP + sp * 32 + hf * 16);
        O0 = __builtin_amdgcn_mfma_f32_32x32x16_bf16(v0, pb, O0, 0, 0, 0);
        O1 = __builtin_amdgcn_mfma_f32_32x32x16_bf16(v1, pb, O1, 0, 0, 0);
      }
      __builtin_amdgcn_sched_barrier(0);
      if (kt + 1 < nt) AT_LSTORE((kt + 1) & 1);
      __syncthreads();
    }
    float lt = lrun + __shfl_xor(lrun, 32);
    float inv = 1.f / lt;
    u16* orow = p.cat + (tb + q) * 1024 + h * 64;
#pragma unroll
    for (int g = 0; g < 4; g++) {
      int d0 = 8 * g + 4 * hf;
      *(uint2*)(orow + d0) = make_uint2(pack2(O0[4 * g] * inv, O0[4 * g + 1] * inv), pack2(O0[4 * g + 2] * inv, O0[4 * g + 3] * inv));
      *(uint2*)(orow + 32 + d0) = make_uint2(pack2(O1[4 * g] * inv, O1[4 * g + 1] * inv), pack2(O1[4 * g + 2] * inv, O1[4 * g + 3] * inv));
    }
  }
}

DI void phase_na(const Params& p, int l, int B, int N, int bid, int nb, int tid) {
  const int lane = tid & 63, head = tid >> 6, r = lane & 31, hf = lane >> 5;
  const int rows = N >> 6;
  const int nrb = rows >> 1;
  const int ntask = B * nrb * 4;
  const float* bias = p.na_bias + (size_t)(l * 4 + head) * 15 * 31;
  for (int task = bid; task < ntask; task += nb) {
    const int cb = task & 3, rb = (task >> 2) % nrb, b = (task >> 2) / nrb;
    const size_t tb = (size_t)b * N;
    const int qrow0 = rb * 2;
    const int rstart0 = clampi(qrow0 - 4, 0, rows - 8);
    const int k0 = clampi(rstart0, 0, rows - 9);
    const int kstart = clampi(cb * 16 - 8, 0, 32);
    const int iq = r >> 4, u = r & 15;
    const int qrow = qrow0 + iq, qcol = cb * 16 + u;
    const int rstart = clampi(qrow - 4, 0, rows - 8);
    const int cstart = clampi(qcol - 8, 0, 48);
    bf16x8 qf[4];
    {
      const u16* qp = p.z + (tb + qrow * 64 + qcol) * ZLD + ZB_OFF + head * 64;
#pragma unroll
      for (int ks = 0; ks < 4; ks++) qf[ks] = *(const bf16x8*)(qp + ks * 16 + hf * 8);
    }
    f32x16 O0, O1;
#pragma unroll
    for (int i = 0; i < 16; i++) { O0[i] = 0.f; O1[i] = 0.f; }
    float mrun = -1e30f, lrun = 0.f;
    const int wk = swap23(r);
    for (int j = 0; j < 9; j++) {
      const int krow = k0 + j;
      const u16* kp = p.z + (tb + krow * 64 + kstart + wk) * ZLD + ZB_OFF + 256 + head * 64;
      f32x16 S;
#pragma unroll
      for (int i = 0; i < 16; i++) S[i] = 0.f;
#pragma unroll
      for (int ks = 0; ks < 4; ks++) {
        bf16x8 a = *(const bf16x8*)(kp + ks * 16 + hf * 8);
        S = __builtin_amdgcn_mfma_f32_32x32x16_bf16(a, qf[ks], S, 0, 0, 0);
      }
      const bool rok = (krow >= rstart) && (krow < rstart + 8);
      const int drow = clampi(krow - qrow + 7, 0, 14);
      const float* brow = bias + drow * 31;
      float mx = -1e30f;
#pragma unroll
      for (int i = 0; i < 16; i++) {
        int w = 16 * (i >> 3) + 8 * hf + 4 * ((i >> 2) & 1) + (i & 3);
        int kcol = kstart + w;
        bool ok = rok && (kcol >= cstart) && (kcol < cstart + 16);
        int dcol = clampi(kcol - qcol + 15, 0, 30);
        float s = (S[i] * 0.125f + brow[dcol]) * LOG2E;
        S[i] = ok ? s : -1e30f;
        mx = fmaxf(mx, S[i]);
      }
      mx = fmaxf(mx, __shfl_xor(mx, 32));
      float mn = fmaxf(mrun, mx);
      float alpha = ex2(mrun - mn);
      mrun = mn;
      float ls = 0.f;
#pragma unroll
      for (int i = 0; i < 16; i++) {
        float pv = (S[i] > -1e29f) ? ex2(S[i] - mn) : 0.f;
        S[i] = pv;
        ls += pv;
      }
      lrun = lrun * alpha + ls;
#pragma unroll
      for (int i = 0; i < 16; i++) { O0[i] *= alpha; O1[i] *= alpha; }
      const u16* vbase = p.z + (tb + krow * 64 + kstart) * ZLD + ZB_OFF + 512 + head * 64 + r;
#pragma unroll
      for (int s = 0; s < 2; s++) {
        bf16x8 pb = pack8(S, s * 8);
        bf16x8 v0, v1;
#pragma unroll
        for (int jj = 0; jj < 8; jj++) {
          const u16* vp = vbase + (size_t)(16 * s + 8 * hf + jj) * ZLD;
          v0[jj] = (short)vp[0];
          v1[jj] = (short)vp[32];
        }
        O0 = __builtin_amdgcn_mfma_f32_32x32x16_bf16(v0, pb, O0, 0, 0, 0);
        O1 = __builtin_amdgcn_mfma_f32_32x32x16_bf16(v1, pb, O1, 0, 0, 0);
      }
    }
    float lt = lrun + __shfl_xor(lrun, 32);
    float inv = 1.f / lt;
    u16* orow = p.cat + (tb + qrow * 64 + qcol) * 1024 + 256 + head * 64;
#pragma unroll
    for (int g = 0; g < 4; g++) {
      int d0 = 8 * g + 4 * hf;
      *(uint2*)(orow + d0) = make_uint2(pack2(O0[4 * g] * inv, O0[4 * g + 1] * inv), pack2(O0[4 * g + 2] * inv, O0[4 * g + 3] * inv));
      *(uint2*)(orow + 32 + d0) = make_uint2(pack2(O1[4 * g] * inv, O1[4 * g + 1] * inv), pack2(O1[4 * g + 2] * inv, O1[4 * g + 3] * inv));
    }
  }
}

using f32x2 = __attribute__((ext_vector_type(2))) float;
constexpr int SC_STEPS = 16;

DI void sc_store(char* buf, int dst, uint4 R, bool hgw) {
  float4 lo = make_float4(blo(R.x), bhi(R.x), blo(R.y), bhi(R.y));
  float4 hi = make_float4(blo(R.z), bhi(R.z), blo(R.w), bhi(R.w));
  *(float4*)(buf + dst) = lo;
  *(float4*)(buf + dst + 16) = hi;
  if (hgw) {
    *(float4*)(buf + dst + 256) = make_float4(1.f - lo.x, 1.f - lo.y, 1.f - lo.z, 1.f - lo.w);
    *(float4*)(buf + dst + 272) = make_float4(1.f - hi.x, 1.f - hi.y, 1.f - hi.z, 1.f - hi.w);
  }
}

template <bool RW>
DI void scan_task(const Params& p, int task, int N, char* lds, int tid) {
  constexpr int NA = RW ? 5 : 3;
  constexpr int VOFF = SC_STEPS * NA * 256;
  constexpr int BUF = VOFF + SC_STEPS * 64;
  const int lane = tid & 63, wv = tid >> 6, kq = lane & 15, rg = lane >> 4;
  const int rq = task & 3, hh = (task >> 2) & 3, dir = (task >> 4) & 1, b = task >> 5;
  const size_t tb = (size_t)b * N;
  const int sub = tid >> 7, lt = tid & 127, lstep = lt >> 3, lpart = lt & 7;
  const int vstep = lt >> 1, vhalf = lt & 1;
  const u16 *src0 = nullptr, *src1 = nullptr, *src2 = nullptr;
  int dst0 = 0, dst1 = 0, dst2 = 0, st0 = 0, st1 = 0, st2 = 0;
  bool act0 = false, act1 = false, act2 = false, hgw = false;
  int ld;
  const int acol = hh * 64 + lpart * 8;
  const int vcol = hh * 64 + rq * 16 + vhalf * 8;
  const int vdst = VOFF + vstep * 64 + vhalf * 32;
  if (RW) {
    ld = 256;
    act0 = true; st0 = lstep;
    src0 = sub ? (p.dec + (size_t)dir * T_SUB * 256 + acol) : (p.rs + acol);
    dst0 = (lstep * NA + (sub ? 1 : 0)) * 256 + lpart * 32;
    act1 = true; st1 = lstep;
    src1 = sub ? (p.kk + acol) : (p.kt + (size_t)dir * T_SUB * 256 + acol);
    dst1 = (lstep * NA + (sub ? 3 : 2)) * 256 + lpart * 32;
    if (sub == 0) { act2 = true; st2 = lstep; src2 = p.kka + (size_t)dir * T_SUB * 256 + acol; dst2 = (lstep * NA + 4) * 256 + lpart * 32; }
    else { act2 = lt < 32; st2 = vstep; src2 = p.vs + vcol; dst2 = vdst; }
  } else {
    ld = ZLD;
    act0 = true; st0 = lstep;
    src0 = sub ? (p.z + ZC_OFF + 256 * (1 + dir) + acol) : (p.z + ZC_OFF + acol);
    dst0 = (lstep * NA + (sub ? 1 : 0)) * 256 + lpart * 32;
    hgw = sub != 0;
    if (sub == 0) { act1 = lt < 32; st1 = vstep; src1 = p.z + ZC_OFF + 768 + vcol; dst1 = vdst; }
  }
  u16* pout = (RW ? p.oD : p.oC) + (size_t)dir * T_SUB * 256 + hh * 64 + rq * 16 + wv * 4 + rg;
  pout += (tb + (dir ? (N - 1) : 0)) * 256;
  const int ostride = dir ? -256 : 256;

#define SC_TOK(c_, st_) (tb + (size_t)(dir ? (N - 1 - ((c_) * SC_STEPS + (st_))) : ((c_) * SC_STEPS + (st_))))
#define SC_ISSUE(Ra, Rb, Rc, c_)                                               \
  {                                                                            \
    if (act0) Ra = *(const uint4*)(src0 + SC_TOK(c_, st0) * ld);               \
    if (act1) Rb = *(const uint4*)(src1 + SC_TOK(c_, st1) * ld);               \
    if (act2) Rc = *(const uint4*)(src2 + SC_TOK(c_, st2) * ld);               \
  }
#define SC_STORE(Ra, Rb, Rc, buf_)                                             \
  {                                                                            \
    if (act0) sc_store(buf_, dst0, Ra, hgw);                                   \
    if (act1) sc_store(buf_, dst1, Rb, false);                                 \
    if (act2) sc_store(buf_, dst2, Rc, false);                                 \
  }
  f32x2 S01 = {0.f, 0.f}, S23 = {0.f, 0.f};
#define SC_LD(buf_, s_, r_, w_, t_, k_, a_, v_)                                              \
  {                                                                                          \
    const char* rowp_ = (buf_) + (s_) * NA * 256 + kq * 16;                                  \
    r_ = *(const float4*)(rowp_);                                                            \
    w_ = *(const float4*)(rowp_ + 256);                                                      \
    t_ = *(const float4*)(rowp_ + 512);                                                      \
    if (RW) {                                                                                \
      k_ = *(const float4*)(rowp_ + 768);                                                    \
      a_ = *(const float4*)(rowp_ + 1024);                                                   \
    }                                                                                        \
    v_ = *(const float*)((buf_) + VOFF + (s_) * 64 + (wv * 4 + rg) * 4);                     \
  }
#define SC_COMPUTE(buf_)                                                                     \
  {                                                                                          \
    float osel = 0.f;                                                                        \
    float4 r4, w4, t4, k4, a4, nr4, nw4, nt4, nk4, na4;                                      \
    float vv, nvv;                                                                           \
    k4 = a4 = nk4 = na4 = make_float4(0.f, 0.f, 0.f, 0.f);                                   \
    SC_LD(buf_, 0, r4, w4, t4, k4, a4, vv);                                                  \
    _Pragma("unroll") for (int s = 0; s < SC_STEPS; s++) {                                   \
      if (s + 1 < SC_STEPS) SC_LD(buf_, s + 1, nr4, nw4, nt4, nk4, na4, nvv);                \
      f32x2 ta = f32x2{t4.x, t4.y} * vv, tb2 = f32x2{t4.z, t4.w} * vv;                       \
      if (RW) {                                                                              \
        f32x2 pp = S01 * f32x2{k4.x, k4.y};                                                  \
        pp = S23 * f32x2{k4.z, k4.w} + pp;                                                   \
        const float sa = -reduce16(pp.x + pp.y);                                             \
        ta = f32x2{a4.x, a4.y} * sa + ta;                                                    \
        tb2 = f32x2{a4.z, a4.w} * sa + tb2;                                                  \
      }                                                                                      \
      S01 = S01 * f32x2{w4.x, w4.y} + ta;                                                    \
      S23 = S23 * f32x2{w4.z, w4.w} + tb2;                                                   \
      f32x2 qq = S01 * f32x2{r4.x, r4.y};                                                    \
      qq = S23 * f32x2{r4.z, r4.w} + qq;                                                     \
      const float o = reduce16(qq.x + qq.y);                                                 \
      osel = (kq == s) ? o : osel;                                                           \
      r4 = nr4; w4 = nw4; t4 = nt4; k4 = nk4; a4 = na4; vv = nvv;                            \
    }                                                                                        \
    pout[kq * ostride] = f2bf(osel);                                                         \
    pout += SC_STEPS * ostride;                                                              \
  }
  uint4 A0 = make_uint4(0, 0, 0, 0), A1 = A0, A2 = A0, B0 = A0, B1 = A0, B2 = A0;
  char* buf0 = lds;
  char* buf1 = lds + BUF;
  const int nch = N / SC_STEPS;
  __syncthreads();
  SC_ISSUE(A0, A1, A2, 0);
  SC_ISSUE(B0, B1, B2, 1);
  SC_STORE(A0, A1, A2, buf0);
  __syncthreads();
  for (int c = 0; c < nch; c += 2) {
    if (c + 2 < nch) SC_ISSUE(A0, A1, A2, c + 2);
    __builtin_amdgcn_sched_barrier(0);
    SC_COMPUTE(buf0);
    __builtin_amdgcn_sched_barrier(0);
    SC_STORE(B0, B1, B2, buf1);
    __syncthreads();
    if (c + 3 < nch) SC_ISSUE(B0, B1, B2, c + 3);
    __builtin_amdgcn_sched_barrier(0);
    SC_COMPUTE(buf1);
    __builtin_amdgcn_sched_barrier(0);
    if (c + 2 < nch) SC_STORE(A0, A1, A2, buf0);
    __syncthreads();
  }
}

DI void phase_scan(const Params& p, int B, int N, char* lds, int bid, int nb, int tid) {
  const int nper = B * 32;
  for (int task = bid; task < 2 * nper; task += nb) {
    if (task < nper) scan_task<true>(p, task, N, lds, tid);
    else scan_task<false>(p, task - nper, N, lds, tid);
  }
}

DI void phase_final(const Params& p, int l, int bid, int nb, int tid) {
  const int lane = tid & 63, wv = tid >> 6, c4 = lane * 4;
  const float* gn = p.hg_gnorm + l * 256 + c4;
  const float* lw = p.rw_ln_w + l * 256 + c4;
  const float* lbb = p.rw_ln_b + l * 256 + c4;
  for (int t = bid * 4 + wv; t < T_SUB; t += nb * 4) {
    {
      uint2 a = *(const uint2*)(p.oC + (size_t)t * 256 + c4);
      uint2 bq = *(const uint2*)(p.oC + (size_t)(T_SUB + t) * 256 + c4);
      float o[4] = {blo(a.x) + blo(bq.x), bhi(a.x) + bhi(bq.x), blo(a.y) + blo(bq.y), bhi(a.y) + bhi(bq.y)};
      float ss = reduce16(o[0] * o[0] + o[1] * o[1] + o[2] * o[2] + o[3] * o[3]);
      float ri = rsqrtf(ss * (1.f / 64.f) + 1e-6f);
      uint2 gr = *(const uint2*)(p.z + (size_t)t * ZLD + ZC_OFF + 1024 + c4);
      float g[4] = {blo(gr.x), bhi(gr.x), blo(gr.y), bhi(gr.y)};
      float y[4];
#pragma unroll
      for (int j = 0; j < 4; j++) y[j] = o[j] * ri * gn[j] * (g[j] * sigm(g[j]));
      *(uint2*)(p.cat + (size_t)t * 1024 + 512 + c4) = make_uint2(pack2(y[0], y[1]), pack2(y[2], y[3]));
    }
    {
      uint2 a = *(const uint2*)(p.oD + (size_t)t * 256 + c4);
      uint2 bq = *(const uint2*)(p.oD + (size_t)(T_SUB + t) * 256 + c4);
      float o[4] = {blo(a.x) + blo(bq.x), bhi(a.x) + bhi(bq.x), blo(a.y) + blo(bq.y), bhi(a.y) + bhi(bq.y)};
      float mu = reduce16(o[0] + o[1] + o[2] + o[3]) * (1.f / 64.f);
      float d0 = o[0] - mu, d1 = o[1] - mu, d2 = o[2] - mu, d3 = o[3] - mu;
      float var = reduce16(d0 * d0 + d1 * d1 + d2 * d2 + d3 * d3) * (1.f / 64.f);
      float ri = rsqrtf(var + 64e-5f);
      float bo = p.bonus[(size_t)t * 4 + (lane >> 4)];
      uint2 vr = *(const uint2*)(p.vs + (size_t)t * 256 + c4);
      uint2 gr = *(const uint2*)(p.gD + (size_t)t * 256 + c4);
      float vv[4] = {blo(vr.x), bhi(vr.x), blo(vr.y), bhi(vr.y)};
      float g[4] = {blo(gr.x), bhi(gr.x), blo(gr.y), bhi(gr.y)};
      float dd[4] = {d0, d1, d2, d3};
      float y[4];
#pragma unroll
      for (int j = 0; j < 4; j++) y[j] = (dd[j] * ri * lw[j] + lbb[j] + bo * vv[j]) * g[j];
      *(uint2*)(p.cat + (size_t)t * 1024 + 768 + c4) = make_uint2(pack2(y[0], y[1]), pack2(y[2], y[3]));
    }
  }
}

DI void phase_wout(const Params& p, int l, int tok0, char* lds, int bid, int nb, int tid) {
  const int NT = 8, MT = T_SUB / 128;
  for (int it = 0;; it++) {
    int nt, mt;
    if (!xcd_tile(it, bid, nb, MT, NT, mt, nt)) break;
    int m0 = mt * 128, n0 = nt * 128;
    auto rowfn = [&](int r) -> const void* { return p.cat + (size_t)(m0 + r) * 1024; };
    auto epi = [&](f32x4(&acc)[4][4], int rbase, int cbase) {
      EPI_LOOP({
        int tg = tok0 + m0 + row;
        float4 xv = *(const float4*)(xin_row(p, l, tg) + n0 + col);
        float4 o = make_float4(ALPHA_F * xv.x + v[0], ALPHA_F * xv.y + v[1], ALPHA_F * xv.z + v[2], ALPHA_F * xv.w + v[3]);
        *(float4*)(p.out + (size_t)tg * 1024 + n0 + col) = o;
      })
    };
    gemm_tile<false>(rowfn, p.wout_t + ((size_t)l * 1024 + n0) * 1024, 1024, epi, lds, tid);
  }
}

template <bool ROUTER>
DI void phase_ln(const Params& p, const float* g, const float* bta, const float* wrouter, int tok0, int ntok, char* lds,
                 int bid, int nb, int tid) {
  const int lane = tid & 63, wv = tid >> 6;
  float* wl = (float*)lds;
  if (ROUTER) {
    __syncthreads();
    for (int i = tid; i < 16384; i += NTHR) {
      int k = i >> 4, e = i & 15;
      wl[e * 1024 + k] = wrouter[i];
    }
    __syncthreads();
  }
  for (int t = bid * 4 + wv; t < ntok; t += nb * 4) {
    const int tg = tok0 + t;
    float* xr = p.out + (size_t)tg * 1024;
    float4 x[4];
    float s = 0.f;
#pragma unroll
    for (int i = 0; i < 4; i++) {
      x[i] = *(const float4*)(xr + i * 256 + lane * 4);
      s += x[i].x + x[i].y + x[i].z + x[i].w;
    }
    float mu = wave_sum(s) * (1.f / 1024.f);
    float vs = 0.f;
#pragma unroll
    for (int i = 0; i < 4; i++) {
      x[i].x -= mu; x[i].y -= mu; x[i].z -= mu; x[i].w -= mu;
      vs += x[i].x * x[i].x + x[i].y * x[i].y + x[i].z * x[i].z + x[i].w * x[i].w;
    }
    float ri = rsqrtf(wave_sum(vs) * (1.f / 1024.f) + 1e-5f);
#pragma unroll
    for (int i = 0; i < 4; i++) {
      float4 gg = *(const float4*)(g + i * 256 + lane * 4);
      float4 bb = *(const float4*)(bta + i * 256 + lane * 4);
      x[i].x = x[i].x * ri * gg.x + bb.x;
      x[i].y = x[i].y * ri * gg.y + bb.y;
      x[i].z = x[i].z * ri * gg.z + bb.z;
      x[i].w = x[i].w * ri * gg.w + bb.w;
      *(float4*)(xr + i * 256 + lane * 4) = x[i];
      *(uint2*)(p.xb + (size_t)tg * 1024 + i * 256 + lane * 4) = make_uint2(pack2(x[i].x, x[i].y), pack2(x[i].z, x[i].w));
    }
    if (ROUTER) {
      float mine = 0.f;
#pragma unroll 1
      for (int e = 0; e < 16; e++) {
        float a = 0.f;
#pragma unroll
        for (int i = 0; i < 4; i++) {
          float4 w = *(const float4*)(wl + e * 1024 + i * 256 + lane * 4);
          a += x[i].x * w.x + x[i].y * w.y + x[i].z * w.z + x[i].w * w.w;
        }
        a = wave_sum(a);
        mine = (lane == e) ? a : mine;
      }
      float mx = mine;
      mx = fmaxf(mx, dpp_f<0xB1>(mx));
      mx = fmaxf(mx, dpp_f<0x4E>(mx));
      mx = fmaxf(mx, dpp_f<0x141>(mx));
      mx = fmaxf(mx, dpp_f<0x140>(mx));
      float ex = __expf(mine - mx);
      float sum = reduce16(ex);
      mine = ex / sum;
      if (lane == 0) p.inv_cnt[tg] = 0;
      if (lane < 16) {
        if (tg < 32768) p.affT[(size_t)lane * 32768 + tg] = mine;
        else p.affT[(size_t)16 * 32768 + (size_t)lane * 65536 + (tg - 32768)] = mine;
      }
    }
  }
}

DI void phase_topk(const Params& p, char* lds, int bid, int nb, int tid) {
  if (bid < 32) {
    unsigned* hist = (unsigned*)lds;
    unsigned* sh = hist + 256;
    unsigned* eqc = sh + 8;
    const int g = bid >> 4, e = bid & 15;
    const int T = g ? 65536 : 32768, cap = T >> 3;
    const int tok0 = g ? 32768 : 0;
    const float* vals = p.affT + (g ? (size_t)16 * 32768 : 0) + (size_t)e * T;
    int* oidx = p.idx + (g ? 65536 : 0) + e * cap;
    float* ogate = p.gate + (g ? 65536 : 0) + e * cap;
    unsigned prefix = 0, mask = 0;
    int remaining = cap;
    for (int pass = 0; pass < 4; pass++) {
      const int shift = 24 - 8 * pass;
      hist[tid] = 0;
      __syncthreads();
      for (int i = tid; i < T; i += NTHR) {
        unsigned u = __float_as_uint(vals[i]);
        if ((u & mask) == prefix) atomicAdd(&hist[(u >> shift) & 255], 1u);
      }
      __syncthreads();
      if (tid == 0) {
        int cum = 0, sel = 0;
        for (int bq = 255; bq >= 0; bq--) {
          int hc = (int)hist[bq];
          if (cum + hc >= remaining) { sel = bq; break; }
          cum += hc;
        }
        sh[0] = (unsigned)sel;
        sh[1] = (unsigned)(remaining - cum);
      }
      __syncthreads();
      prefix |= sh[0] << shift;
      remaining = (int)sh[1];
      mask |= 0xFFu << shift;
      __syncthreads();
    }
    const unsigned thr = prefix;
    const int need = remaining;
    const int ch = T >> 8;
    const float* my = vals + tid * ch;
    int ec = 0;
    for (int i = 0; i < ch; i++) ec += (__float_as_uint(my[i]) == thr) ? 1 : 0;
    eqc[tid] = ec;
    if (tid == 0) sh[2] = 0;
    __syncthreads();
    int eq_rank = 0;
    for (int i = 0; i < tid; i++) eq_rank += eqc[i];
    for (int i = 0; i < ch; i++) {
      float v = my[i];
      unsigned u = __float_as_uint(v);
      int pos = -1;
      if (u > thr) {
        pos = (int)atomicAdd(&sh[2], 1u);
      } else if (u == thr) {
        if (eq_rank < need) pos = cap - need + eq_rank;
        eq_rank++;
      }
      if (pos >= 0) {
        const int tok = tok0 + tid * ch + i;
        oidx[pos] = tok;
        ogate[pos] = v;
        const int kslot = atomicAdd(&p.inv_cnt[tok], 1);
        p.inv_slot[(size_t)tok * 16 + kslot] = (g ? 65536 : 0) + e * cap + pos;
      }
    }
    __syncthreads();
  }
}

DI void moe_rowinfo(int row0, int l, int& e, int& ioff) {
  if (row0 < 65536) { e = row0 >> 12; }
  else { e = (row0 - 65536) >> 13; }
  ioff = row0;
}

DI void phase_moe1(const Params& p, int l, char* lds, int bid, int nb, int tid) {
  const int NT = 8, MT = 196608 / 128;
  for (int it = 0;; it++) {
    int nt, mt;
    if (!xcd_tile(it, bid, nb, MT, NT, mt, nt)) break;
    int m0 = mt * 128, n0 = nt * 128;
    int e, ioff;
    moe_rowinfo(m0, l, e, ioff);
    const int* ip = p.idx + ioff;
    auto rowfn = [&](int r) -> const void* { return p.xb + (size_t)ip[r] * 1024; };
    u16* H = p.H;
    auto epi = [&](f32x4(&acc)[4][4], int rbase, int cbase) {
#pragma unroll
      for (int m = 0; m < 4; m++)
#pragma unroll
        for (int n = 0; n < 4; n += 2) {
          int row = rbase + m * 16;
          int col = cbase + n * 16;
          int blk = (n0 + (col & ~31)) >> 1;
          int hc = blk + (col & 15);
          f32x4 a = acc[m][n], bq = acc[m][n + 1];
          f32x4 o;
          for (int j = 0; j < 4; j++) o[j] = a[j] * sigm(a[j]) * bq[j];
          st_bf4(H + (size_t)(m0 + row) * 512 + hc, o);
        }
    };
    gemm_tile<false>(rowfn, p.w13_t + ((size_t)(l * 16 + e) * 1024 + n0) * 1024, 1024, epi, lds, tid);
  }
}

DI void phase_moe2(const Params& p, int l, char* lds, int bid, int nb, int tid) {
  TileIter it{bid, nb, 0};
  {
    const int NT = 8, MT = 196608 / 128;
    for (int itx = 0;; itx++) {
      int nt, mt;
      if (!xcd_tile(itx, bid, nb, MT, NT, mt, nt)) break;
      int m0 = mt * 128, n0 = nt * 128;
      int e, ioff;
      moe_rowinfo(m0, l, e, ioff);
      auto rowfn = [&](int r) -> const void* { return p.H + (size_t)(m0 + r) * 512; };
      u16* O = p.O;
      auto epi = [&](f32x4(&acc)[4][4], int rbase, int cbase) {
        EPI_LOOP({ st_bf4(O + (size_t)(m0 + row) * 1024 + n0 + col, v); })
      };
      gemm_tile<false>(rowfn, p.w2_t + ((size_t)(l * 16 + e) * 1024 + n0) * 512, 512, epi, lds, tid);
    }
  }
  {
    const int NT = 8, MT = T_ALL / 128;
    for (int itx = 0;; itx++) {
      int nt, mt;
      if (!xcd_tile(itx, bid, nb, MT, NT, mt, nt)) break;
      int m0 = mt * 128, n0 = nt * 128;
      auto rowfn = [&](int r) -> const void* {
        int tg = m0 + r;
        return tg < 32768 ? p.p_prompt + ((size_t)l * 32768 + tg) * 256 : p.p_sample + ((size_t)l * 65536 + (tg - 32768)) * 256;
      };
      auto epi = [&](f32x4(&acc)[4][4], int rbase, int cbase) {
        EPI_LOOP({ st_bf4(p.xb + (size_t)(m0 + row) * 1024 + n0 + col, v); })
      };
      gemm_tile<true>(rowfn, p.wp_t + ((size_t)l * 1024 + n0) * 256, 256, epi, lds, tid);
    }
  }
}

DI void phase_combine(const Params& p, int bid, int nb, int tid) {
  const int lane = tid & 63, wv = tid >> 6;
  u16* ub = p.H;
  for (int t = bid * 4 + wv; t < T_ALL; t += nb * 4) {
    float* xr = p.out + (size_t)t * 1024;
    float4 a[4];
#pragma unroll
    for (int i = 0; i < 4; i++) {
      float4 x = *(const float4*)(xr + i * 256 + lane * 4);
      a[i] = make_float4(x.x * ALPHA_F, x.y * ALPHA_F, x.z * ALPHA_F, x.w * ALPHA_F);
    }
    const int cnt = p.inv_cnt[t];
    for (int j = 0; j < cnt; j++) {
      const int slot = p.inv_slot[(size_t)t * 16 + j];
      const float g = p.gate[slot];
      const u16* orow = p.O + (size_t)slot * 1024;
#pragma unroll
      for (int i = 0; i < 4; i++) {
        uint2 r = *(const uint2*)(orow + i * 256 + lane * 4);
        a[i].x += g * blo(r.x);
        a[i].y += g * bhi(r.x);
        a[i].z += g * blo(r.y);
        a[i].w += g * bhi(r.y);
      }
    }
#pragma unroll
    for (int i = 0; i < 4; i++) {
      *(float4*)(xr + i * 256 + lane * 4) = a[i];
      *(uint2*)(ub + (size_t)t * 1024 + i * 256 + lane * 4) = make_uint2(pack2(a[i].x, a[i].y), pack2(a[i].z, a[i].w));
    }
  }
}

DI void phase_ple(const Params& p, int l, char* lds, int bid, int nb, int tid) {
  const int NT = 8, MT = T_ALL / 128;
  for (int it = 0;; it++) {
    int nt, mt;
    if (!xcd_tile(it, bid, nb, MT, NT, mt, nt)) break;
    int m0 = mt * 128, n0 = nt * 128;
    auto rowfn = [&](int r) -> const void* { return p.H + (size_t)(m0 + r) * 1024; };
    auto epi = [&](f32x4(&acc)[4][4], int rbase, int cbase) {
      EPI_LOOP({
        size_t o = (size_t)(m0 + row) * 1024 + n0 + col;
        float4 u = *(const float4*)(p.out + o);
        uint2 pr = *(const uint2*)(p.xb + o);
        *(float4*)(p.out + o) = make_float4(u.x + sigm(v[0]) * blo(pr.x), u.y + sigm(v[1]) * bhi(pr.x),
                                            u.z + sigm(v[2]) * blo(pr.y), u.w + sigm(v[3]) * bhi(pr.y));
      })
    };
    gemm_tile<false>(rowfn, p.wg_t + ((size_t)l * 1024 + n0) * 1024, 1024, epi, lds, tid);
  }
}

#define XB_TMO      128
#define XB_XCNT(j)  (256  + 64 * (j))
#define XB_XSUB(j)  (1280 + 64 * (j))
#define XB_XGEN(j)  (2304 + 64 * (j))
#define XB_TOP      3328
#define XB_TOPGEN   3392
#define XCD_BAR_WORDS 3456
#define XB_SPIN_CAP (1u << 22)
#define LAS __attribute__((address_space(3)))
DI unsigned xb_ld(unsigned* p) { return __hip_atomic_load(p, __ATOMIC_RELAXED, __HIP_MEMORY_SCOPE_AGENT); }
DI unsigned xb_add(unsigned* p, unsigned v) { return __hip_atomic_fetch_add(p, v, __ATOMIC_RELAXED, __HIP_MEMORY_SCOPE_AGENT); }
DI unsigned xb_xcc_id() { return (unsigned)__builtin_amdgcn_s_getreg((3 << 11) | 20) & 0xFu; }
#define XB_SPIN(cond, bar) do { unsigned _sp = 0; while (cond) { __builtin_amdgcn_s_sleep(1); \
    if ((++_sp & 255u) == 0u) { if (xb_ld(&(bar)[XB_TMO])) break; if (_sp > XB_SPIN_CAP) { atomicAdd(&(bar)[XB_TMO], 1u); break; } } } } while (0)
struct XcdBarrier { unsigned* bar; unsigned x; volatile LAS unsigned* st; };
DI XcdBarrier xcd_barrier_post(unsigned* bar, volatile LAS unsigned* st) {
  XcdBarrier b; b.bar = bar; b.x = xb_xcc_id(); b.st = st;
  if (threadIdx.x == 0) (void)xb_add(&bar[XB_XCNT(b.x)], 1u);
  return b;
}
DI void xcd_barrier_complete(unsigned* bar, unsigned x, unsigned& nloc, unsigned& nx) {
  const unsigned G = gridDim.x * gridDim.y * gridDim.z;
  unsigned sum, cnt, mine, sp = 0u;
  for (;;) {
    sum = 0u; cnt = 0u; mine = 0u;
#pragma unroll
    for (unsigned j = 0; j < 16; ++j) { const unsigned c = xb_ld(&bar[XB_XCNT(j)]); sum += c; cnt += (c > 0u) ? 1u : 0u; mine = (j == x) ? c : mine; }
    if (sum == G) break;
    __builtin_amdgcn_s_sleep(1);
    if ((++sp & 255u) == 0u) { if (xb_ld(&bar[XB_TMO])) break; if (sp > XB_SPIN_CAP) { atomicAdd(&bar[XB_TMO], 1u); break; } }
  }
  nloc = mine > 0u ? mine : 1u; nx = cnt > 0u ? cnt : 1u;
}
DI void xcd_barrier(const XcdBarrier& b) {
  asm volatile("s_waitcnt vmcnt(0)" ::: "memory");
  __syncthreads();
  if (threadIdx.x == 0) {
    unsigned* bar = b.bar;
    __builtin_amdgcn_s_waitcnt(0);
    unsigned nloc = b.st[0], nx = b.st[1];
    if (nloc == 0u) { xcd_barrier_complete(bar, b.x, nloc, nx); b.st[0] = nloc; b.st[1] = nx; }
    const unsigned old = xb_add(&bar[XB_XSUB(b.x)], 1u);
    const unsigned gen = old / nloc;
    if (old + 1u == (gen + 1u) * nloc) {
      __builtin_amdgcn_fence(__ATOMIC_RELEASE, "agent");
      asm volatile("s_waitcnt vmcnt(0)" ::: "memory");
      const unsigned og = xb_add(&bar[XB_TOP], 1u);
      const unsigned tg = og / nx;
      if (og + 1u == (tg + 1u) * nx) xb_add(&bar[XB_TOPGEN], 1u);
      else XB_SPIN(xb_ld(&bar[XB_TOPGEN]) == tg, bar);
      __builtin_amdgcn_fence(__ATOMIC_ACQUIRE, "agent");
      xb_add(&bar[XB_XGEN(b.x)], 1u);
      asm volatile("s_waitcnt vmcnt(0)" ::: "memory");
    } else {
      XB_SPIN(xb_ld(&bar[XB_XGEN(b.x)]) == gen, bar);
      __builtin_amdgcn_fence(__ATOMIC_ACQUIRE, "agent");
      asm volatile("s_waitcnt vmcnt(0)" ::: "memory");
    }
  }
  __syncthreads();
}

__global__ void __launch_bounds__(NTHR, 2) mega(Params p) {
  __shared__ __attribute__((aligned(16))) char lds[73728];
  cg::grid_group grid = cg::this_grid();
  const int tid0 = threadIdx.x, bid0 = blockIdx.x, nb = gridDim.x;
  __shared__ uint4 xb_words;
  if (tid0 == 0) xb_words = make_uint4(0u, 0u, 0u, 0u);
  __syncthreads();
  const XcdBarrier xb = xcd_barrier_post(p.bar, (volatile LAS unsigned*)&xb_words);
  int pc = 0;
#define PHASE(...)                                      \
  {                                                     \
    if (pc >= p.pb && pc < p.pe) {                      \
      if (pc == p.pb + 1) grid.sync();                  \
      else if (pc > p.pb + 1) xcd_barrier(xb);          \
      int tid = tid0, bid = bid0;                       \
      asm volatile("" : "+v"(tid), "+s"(bid));          \
      __VA_ARGS__;                                      \
    }                                                   \
    pc++;                                               \
  }
  PHASE(phase_convert(p, lds, bid, nb, tid));
  for (int i = 0; i < REP_SYNC; i++) PHASE((void)0);
  for (int l = 0; l < 2; l++) {
    for (int sg = 0; sg < 3; sg++) {
      const int tok0 = sg * T_SUB;
      const int B = sg == 0 ? 4 : 8, N = sg == 0 ? 8192 : 4096;
      PHASE(phase_inproj(p, l, tok0, lds, bid, nb, tid));
#if REP_INPROJ
      PHASE(phase_inproj(p, l, tok0, lds, bid, nb, tid));
#endif
      PHASE(phase_prep(p, l, N, bid, nb, tid));
      PHASE(phase_smallgemm(p, l, B, N, lds, bid, nb, tid));
      PHASE(phase_attn(p, B, N, lds, bid, nb, tid));
#if REP_ATTN
      PHASE(phase_attn(p, B, N, lds, bid, nb, tid));
#endif
      PHASE(phase_na(p, l, B, N, bid, nb, tid));
#if REP_NA
      PHASE(phase_na(p, l, B, N, bid, nb, tid));
#endif
      PHASE(phase_scan(p, B, N, lds, bid, nb, tid));
#if REP_SCAN
      PHASE(phase_scan(p, B, N, lds, bid, nb, tid));
#endif
      PHASE(phase_final(p, l, bid, nb, tid));
      PHASE(phase_wout(p, l, tok0, lds, bid, nb, tid));
      PHASE(phase_ln<true>(p, p.ln1_g + l * 1024, p.ln1_b + l * 1024, p.moe_router + (size_t)l * 16384, tok0, T_SUB, lds, bid, nb, tid));
    }
    PHASE(phase_topk(p, lds, bid, nb, tid));
    PHASE(phase_moe1(p, l, lds, bid, nb, tid));
#if REP_MOE1
    PHASE(phase_moe1(p, l, lds, bid, nb, tid));
#endif
    PHASE(phase_moe2(p, l, lds, bid, nb, tid));
    PHASE(phase_combine(p, bid, nb, tid));
    PHASE(phase_ple(p, l, lds, bid, nb, tid));
    PHASE(phase_ln<false>(p, p.ln2_g + l * 1024, p.ln2_b + l * 1024, nullptr, 0, T_ALL, lds, bid, nb, tid));
  }
}

#define N_PHASES 1000
#ifndef FUSED
#define FUSED 1
#endif

extern "C" void kernel_launch(void* const* d_in, const int* in_sizes, int n_in, void* d_out, int out_size, void* d_ws,
                              size_t ws_size, hipStream_t stream) {
  static int grid_blocks = 0;
  if (!grid_blocks) {
    int dev = 0, cus = 0, per_cu = 0;
    (void)hipGetDevice(&dev);
    (void)hipDeviceGetAttribute(&cus, hipDeviceAttributeMultiprocessorCount, dev);
    (void)hipOccupancyMaxActiveBlocksPerMultiprocessor(&per_cu, mega, NTHR, 0);
    if (per_cu > 2) per_cu = 2;
    if (per_cu < 1) per_cu = 1;
    grid_blocks = cus * per_cu;
  }
  Params p;
  memset(&p, 0, sizeof(p));
  const float* const* in = (const float* const*)d_in;
  int k = 0;
  p.x_prompt = in[k++]; p.x_sample = in[k++]; p.p_prompt = in[k++]; p.p_sample = in[k++];
  p.w_in = in[k++]; p.mla_gq = in[k++]; p.mla_gkv = in[k++]; p.mla_wuq = in[k++]; p.mla_wuk = in[k++]; p.mla_wuv = in[k++];
  p.na_bias = in[k++]; p.hg_lb = in[k++]; p.hg_gnorm = in[k++];
  p.rw_mu = in[k++]; p.rw_w0 = in[k++]; p.rw_w_up = in[k++]; p.rw_a0 = in[k++]; p.rw_a_up = in[k++]; p.rw_g_up = in[k++];
  p.rw_kk = in[k++]; p.rw_ka = in[k++]; p.rw_rk = in[k++]; p.rw_ln_w = in[k++]; p.rw_ln_b = in[k++];
  p.w_out = in[k++]; p.ln1_g = in[k++]; p.ln1_b = in[k++]; p.moe_router = in[k++]; p.moe_w1 = in[k++]; p.moe_w3 = in[k++];
  p.moe_w2 = in[k++]; p.ln2_g = in[k++]; p.ln2_b = in[k++]; p.ple_gate = in[k++]; p.ple_proj = in[k++];
  p.out = (float*)d_out;
  char* ws = (char*)d_ws;
  size_t off = 0;
  auto take = [&](size_t bytes) { char* r = ws + off; off += (bytes + 255) & ~(size_t)255; return r; };
  p.w_in_t = (u16*)take((size_t)2 * 3712 * 1024 * 2);
  p.wuq_t = (u16*)take((size_t)2 * 384 * 256 * 2);
  p.wkv_t = (u16*)take((size_t)2 * 512 * 128 * 2);
  p.wup_t = (u16*)take((size_t)4 * 256 * 64 * 2);
  p.aup_t = (u16*)take((size_t)4 * 256 * 64 * 2);
  p.gup_t = (u16*)take((size_t)2 * 256 * 128 * 2);
  p.wout_t = (u16*)take((size_t)2 * 1024 * 1024 * 2);
  p.w13_t = (u16*)take((size_t)32 * 1024 * 1024 * 2);
  p.w2_t = (u16*)take((size_t)32 * 1024 * 512 * 2);
  p.wg_t = (u16*)take((size_t)2 * 1024 * 1024 * 2);
  p.wp_t = (u16*)take((size_t)2 * 1024 * 256 * 2);
  p.ropec = (float*)take((size_t)8192 * 16 * 4);
  p.ropes = (float*)take((size_t)8192 * 16 * 4);
  p.lb = (float*)take(1024 * 4);
  p.affT = (float*)take((size_t)16 * T_ALL * 4);
  p.gate = (float*)take((size_t)196608 * 4);
  p.idx = (int*)take((size_t)196608 * 4);
  p.bar = (unsigned*)take((size_t)XCD_BAR_WORDS * 4);
  p.inv_cnt = (int*)take((size_t)T_ALL * 4);
  p.inv_slot = (int*)take((size_t)T_ALL * 16 * 4);
  p.xb = (u16*)take((size_t)T_ALL * 1024 * 2);
  const size_t stage0 = off;
  p.z = (u16*)take((size_t)T_SUB * ZLD * 2);
  p.cat = (u16*)take((size_t)T_SUB * 1024 * 2);
  p.Q = (u16*)take((size_t)T_SUB * 384 * 2);
  p.Kb = (u16*)take((size_t)T_SUB * 384 * 2);
  p.Vt = (u16*)take((size_t)T_SUB * 256 * 2);
  p.cqn = (u16*)take((size_t)T_SUB * 256 * 2);
  p.ckvn = (u16*)take((size_t)T_SUB * 128 * 2);
  p.S1 = (u16*)take((size_t)T_SUB * 384 * 2);
  p.rs = (u16*)take((size_t)T_SUB * 256 * 2);
  p.ks = (u16*)take((size_t)T_SUB * 256 * 2);
  p.vs = (u16*)take((size_t)T_SUB * 256 * 2);
  p.kk = (u16*)take((size_t)T_SUB * 256 * 2);
  p.gD = (u16*)take((size_t)T_SUB * 256 * 2);
  p.dec = (u16*)take((size_t)2 * T_SUB * 256 * 2);
  p.kka = (u16*)take((size_t)2 * T_SUB * 256 * 2);
  p.kt = (u16*)take((size_t)2 * T_SUB * 256 * 2);
  p.oC = (u16*)take((size_t)2 * T_SUB * 256 * 2);
  p.oD = (u16*)take((size_t)2 * T_SUB * 256 * 2);
  p.bonus = (float*)take((size_t)T_SUB * 4 * 4);
  off = stage0;
  p.O = (u16*)take((size_t)196608 * 1024 * 2);
  p.H = (u16*)take((size_t)196608 * 512 * 2);
  for (int i = 0; i < 16; i++) p.inv_freq[i] = pow(10000.0, -(double)i / 16.0);
  (void)hipMemsetAsync(p.bar, 0, (size_t)XCD_BAR_WORDS * 4, stream);
#if FUSED
  p.pb = 0;
  p.pe = N_PHASES;
  {
    void* args[] = {&p};
    hipError_t e = hipLaunchCooperativeKernel((void*)mega, dim3(grid_blocks), dim3(NTHR), args, 0, stream);
    if (e != hipSuccess) fprintf(stderr, "cooperative launch failed: %s (grid %d)\n", hipGetErrorString(e), grid_blocks);
  }
#else
  for (int ph = 0; ph < N_PHASES; ph++) {
    p.pb = ph;
    p.pe = ph + 1;
    void* args[] = {&p};
    hipError_t e = hipLaunchCooperativeKernel((void*)mega, dim3(grid_blocks), dim3(NTHR), args, 0, stream);
    if (e != hipSuccess) fprintf(stderr, "cooperative launch failed: %s (grid %d)\n", hipGetErrorString(e), grid_blocks);
  }
#endif
}
```

```cpp
#include <hip/hip_runtime.h>
#include <hip/hip_cooperative_groups.h>
#include <cstdio>
#include <cmath>
#include <cstring>
namespace cg = cooperative_groups;

typedef unsigned short u16;
using bf16x8 = __attribute__((ext_vector_type(8))) short;
using f32x4 = __attribute__((ext_vector_type(4))) float;
using f32x16 = __attribute__((ext_vector_type(16))) float;

#define REP_INPROJ 0
#define REP_ATTN 0
#define REP_NA 0
#define REP_SCAN 0
#define REP_MOE1 0
#define REP_MOE2 0
#define REP_SYNC 0
#define REP_MIX 0
#define REP_GEMMS 0
#define DI __device__ __forceinline__
#define NTHR 256
#define T_ALL 98304
#define T_SUB 32768
#define ZLD 3616
#define ZB_OFF 416
#define ZC_OFF 1184
#define ZD_OFF 2464
#define LOG2E 1.4426950408889634f
#define ALPHA_F 1.4142135623730951f

struct Params {
  const float *x_prompt, *x_sample, *p_prompt, *p_sample;
  const float *w_in, *mla_gq, *mla_gkv, *mla_wuq, *mla_wuk, *mla_wuv, *na_bias, *hg_lb, *hg_gnorm;
  const float *rw_mu, *rw_w0, *rw_w_up, *rw_a0, *rw_a_up, *rw_g_up, *rw_kk, *rw_ka, *rw_rk, *rw_ln_w, *rw_ln_b;
  const float *w_out, *ln1_g, *ln1_b, *moe_router, *moe_w1, *moe_w3, *moe_w2, *ln2_g, *ln2_b, *ple_gate, *ple_proj;
  float* out;
  u16 *w_in_t, *wuq_t, *wkv_t, *wup_t, *aup_t, *gup_t, *wout_t, *w13_t, *w2_t, *wg_t, *wp_t;
  float *ropec, *ropes, *lb, *affT, *gate;
  int* idx;
  unsigned* bar;
  int *inv_cnt, *inv_slot;
  u16 *z, *cat, *Q, *Kb, *Vt, *cqn, *ckvn, *S1, *rs, *ks, *vs, *kk, *gD, *dec, *kka, *kt, *oC, *oD;
  float* bonus;
  u16* xb;
  u16* O;
  u16* H;
  double inv_freq[16];
  int pb, pe;
};

typedef __bf16 v2bf_t __attribute__((ext_vector_type(2)));
typedef float v2f_t __attribute__((ext_vector_type(2)));
typedef unsigned u32x4_t __attribute__((ext_vector_type(4)));
DI unsigned pack2(float a, float b) {
  v2f_t f = {a, b};
  v2bf_t h = __builtin_convertvector(f, v2bf_t);
  return __builtin_bit_cast(unsigned, h);
}
DI u16 f2bf(float f) { return (u16)(pack2(f, 0.f) & 0xffffu); }
DI float bf2f(u16 h) { return __uint_as_float(((unsigned)h) << 16); }
DI float blo(unsigned u) { return __uint_as_float(u << 16); }
DI float bhi(unsigned u) { return __uint_as_float(u & 0xffff0000u); }
DI float sigm(float x) { return 1.f / (1.f + __expf(-x)); }
DI float tanh_(float x) { return 1.f - 2.f / (__expf(2.f * x) + 1.f); }
DI float ex2(float x) { return __builtin_amdgcn_exp2f(x); }
DI int clampi(int v, int lo, int hi) { return v < lo ? lo : (v > hi ? hi : v); }
DI int swap23(int x) { return (x & ~12) | ((x & 4) << 1) | ((x & 8) >> 1); }

template <int CTRL> DI float dpp_f(float v) {
  return __int_as_float(__builtin_amdgcn_update_dpp(0, __float_as_int(v), CTRL, 0xF, 0xF, true));
}
DI float reduce16(float v) {
  v += dpp_f<0xB1>(v);
  v += dpp_f<0x4E>(v);
  v += dpp_f<0x141>(v);
  v += dpp_f<0x140>(v);
  return v;
}
DI float wave_sum(float v) {
  v = reduce16(v);
  v += __shfl_xor(v, 16);
  v += __shfl_xor(v, 32);
  return v;
}

struct TileIter {
  int bid, nb, off;
  DI int first(int n) { int f = bid - off; if (f < 0) f += nb; off = (off + n) % nb; return f; }
};

DI bool xcd_tile(int it, int bid, int nb, int MT, int NT, int& mt, int& nt) {
  const int x = bid & 7, slot = bid >> 3, nslots = nb >> 3;
  const int mper = MT >> 3;
  const int i = slot + it * nslots;
  if (i >= mper * NT) return false;
  const int mi = i & 7, rest = i >> 3;
  nt = rest % NT;
  mt = x * mper + (rest / NT) * 8 + mi;
  return true;
}

DI void convT_job(const float* __restrict__ W, int K, int N, int Npad, u16* __restrict__ Wt, int mode, char* lds,
                  TileIter& it, int tid) {
  float(*tile)[65] = (float(*)[65])lds;
  int tk = K >> 6, tn = Npad >> 6;
  int nt = tk * tn;
  for (int t = it.first(nt); t < nt; t += it.nb) {
    int k0 = (t % tk) << 6, n0 = (t / tk) << 6;
#pragma unroll
    for (int i = 0; i < 16; i++) {
      int kl = (tid >> 6) + 4 * i, nl = tid & 63;
      int n = n0 + nl;
      tile[kl][nl] = (n < N) ? W[(size_t)(k0 + kl) * N + n] : 0.f;
    }
    __syncthreads();
    {
      int nl = tid >> 2, ks = (tid & 3) * 16;
      int n = n0 + nl;
      int row = n;
      if (mode == 1) row = (n >> 4) * 32 + (n & 15);
      if (mode == 2) row = (n >> 4) * 32 + 16 + (n & 15);
      unsigned pk[8];
#pragma unroll
      for (int j = 0; j < 8; j++) pk[j] = pack2(tile[ks + 2 * j][nl], tile[ks + 2 * j + 1][nl]);
      uint4* dst = (uint4*)(Wt + (size_t)row * K + k0 + ks);
      dst[0] = make_uint4(pk[0], pk[1], pk[2], pk[3]);
      dst[1] = make_uint4(pk[4], pk[5], pk[6], pk[7]);
    }
    __syncthreads();
  }
}

DI void phase_convert(const Params& p, char* lds, int bid, int nb, int tid) {
  TileIter it{bid, nb, 0};
  for (int l = 0; l < 2; l++) {
    convT_job(p.w_in + (size_t)l * 1024 * 3616, 1024, 3616, 3712, p.w_in_t + (size_t)l * 3712 * 1024, 0, lds, it, tid);
    convT_job(p.mla_wuq + (size_t)l * 256 * 384, 256, 384, 384, p.wuq_t + (size_t)l * 384 * 256, 0, lds, it, tid);
    convT_job(p.mla_wuk + (size_t)l * 128 * 256, 128, 256, 256, p.wkv_t + (size_t)l * 512 * 128, 0, lds, it, tid);
    convT_job(p.mla_wuv + (size_t)l * 128 * 256, 128, 256, 256, p.wkv_t + (size_t)l * 512 * 128 + 256 * 128, 0, lds, it, tid);
    for (int d = 0; d < 2; d++) {
      convT_job(p.rw_w_up + (size_t)(l * 2 + d) * 64 * 256, 64, 256, 256, p.wup_t + (size_t)(l * 2 + d) * 256 * 64, 0, lds, it, tid);
      convT_job(p.rw_a_up + (size_t)(l * 2 + d) * 64 * 256, 64, 256, 256, p.aup_t + (size_t)(l * 2 + d) * 256 * 64, 0, lds, it, tid);
    }
    convT_job(p.rw_g_up + (size_t)l * 128 * 256, 128, 256, 256, p.gup_t + (size_t)l * 256 * 128, 0, lds, it, tid);
    convT_job(p.w_out + (size_t)l * 1024 * 1024, 1024, 1024, 1024, p.wout_t + (size_t)l * 1024 * 1024, 0, lds, it, tid);
    for (int e = 0; e < 16; e++) {
      size_t le = (size_t)(l * 16 + e);
      convT_job(p.moe_w1 + le * 1024 * 512, 1024, 512, 512, p.w13_t + le * 1024 * 1024, 1, lds, it, tid);
      convT_job(p.moe_w3 + le * 1024 * 512, 1024, 512, 512, p.w13_t + le * 1024 * 1024, 2, lds, it, tid);
      convT_job(p.moe_w2 + le * 512 * 1024, 512, 1024, 1024, p.w2_t + le * 1024 * 512, 0, lds, it, tid);
    }
    convT_job(p.ple_gate + (size_t)l * 1024 * 1024, 1024, 1024, 1024, p.wg_t + (size_t)l * 1024 * 1024, 0, lds, it, tid);
    convT_job(p.ple_proj + (size_t)l * 256 * 1024, 256, 1024, 1024, p.wp_t + (size_t)l * 1024 * 256, 0, lds, it, tid);
  }
  int gt = bid * NTHR + tid, ng = nb * NTHR;
  for (size_t i0 = gt; i0 < (size_t)T_ALL * 256; i0 += (size_t)ng * 8) {
    float4 v[8];
#pragma unroll
    for (int u = 0; u < 8; u++) {
      const size_t i = i0 + (size_t)u * ng;
      v[u] = make_float4(0.f, 0.f, 0.f, 0.f);
      if (i < (size_t)T_ALL * 256)
        v[u] = (i < (size_t)32768 * 256) ? ((const float4*)p.x_prompt)[i] : ((const float4*)p.x_sample)[i - (size_t)32768 * 256];
    }
#pragma unroll
    for (int u = 0; u < 8; u++) {
      const size_t i = i0 + (size_t)u * ng;
      if (i < (size_t)T_ALL * 256) ((uint2*)p.xb)[i] = make_uint2(pack2(v[u].x, v[u].y), pack2(v[u].z, v[u].w));
    }
  }
  for (int i = gt; i < 8192 * 16; i += ng) {
    int n = i >> 4, f = i & 15;
    double ifq = 0.0;
#pragma unroll
    for (int j = 0; j < 16; j++) ifq = (f == j) ? p.inv_freq[j] : ifq;
    double rev = (double)n * ifq * 0.15915494309189535;
    double fr = rev - rint(rev);
    float ff = (float)fr;
    p.ropec[i] = __builtin_amdgcn_cosf(ff);
    p.ropes[i] = __builtin_amdgcn_sinf(ff);
  }
  for (int i = gt; i < 512; i += ng) {
    float h0 = p.hg_lb[i], h1 = p.hg_lb[512 + i];
    p.lb[i] = 0.f;
    p.lb[512 + i] = 1.f / (1.f + __expf(h0 - h1));
  }
}

constexpr int G_STAGE = 32768;

template <bool AF32, class RowFn, class Epi>
DI void gemm_tile(RowFn rowfn, const u16* __restrict__ Bt, int K, Epi epi, char* lds, int tid) {
  const int lane = tid & 63, wid = tid >> 6, wr = wid >> 1, wc = wid & 1, fr = lane & 15, fq = lane >> 4;
  f32x4 acc[4][4];
#pragma unroll
  for (int m = 0; m < 4; m++)
#pragma unroll
    for (int n = 0; n < 4; n++) acc[m][n] = f32x4{0.f, 0.f, 0.f, 0.f};

  const int lrow = tid >> 3;
  const int lc = (tid & 7) ^ ((tid >> 4) & 7);
  const float* apf[8];
  const u16* aph[4];
  const u16* bp[4];
  if constexpr (AF32) {
#pragma unroll
    for (int i = 0; i < 8; i++) apf[i] = (const float*)rowfn(i * 16 + (tid >> 4)) + (tid & 15) * 4;
  } else {
#pragma unroll
    for (int i = 0; i < 4; i++) aph[i] = (const u16*)rowfn(lrow + i * 32) + lc * 8;
  }
#pragma unroll
  for (int i = 0; i < 4; i++) bp[i] = Bt + (size_t)(lrow + i * 32) * K + lc * 8;
  const int afoff = (tid >> 4) * 128 + ((((tid & 15) >> 1) ^ ((tid >> 5) & 7)) * 16) + (tid & 1) * 8;

  float4 raf[8];
  auto issue = [&](int buf, int k0) {
    char* A = lds + buf * G_STAGE;
    char* B = A + 16384;
#pragma unroll
    for (int i = 0; i < 4; i++)
      __builtin_amdgcn_global_load_lds((const unsigned*)(bp[i] + k0), (unsigned*)(B + wid * 1024 + i * 4096), 16, 0, 0);
    if constexpr (AF32) {
#pragma unroll
      for (int i = 0; i < 8; i++) raf[i] = *(const float4*)(apf[i] + k0);
    } else {
#pragma unroll
      for (int i = 0; i < 4; i++)
        __builtin_amdgcn_global_load_lds((const unsigned*)(aph[i] + k0), (unsigned*)(A + wid * 1024 + i * 4096), 16, 0, 0);
    }
  };
  auto astore = [&](int buf) {
    if constexpr (AF32) {
      char* A = lds + buf * G_STAGE;
#pragma unroll
      for (int i = 0; i < 8; i++) asm volatile("" : "+v"(raf[i].x), "+v"(raf[i].y), "+v"(raf[i].z), "+v"(raf[i].w));
#pragma unroll
      for (int i = 0; i < 8; i++)
        *(uint2*)(A + afoff + i * 2048) = make_uint2(pack2(raf[i].x, raf[i].y), pack2(raf[i].z, raf[i].w));
    }
  };
  const int abase = (wr * 64 + fr) * 128, bbase = 16384 + (wc * 64 + fr) * 128;
  const int sw0 = ((fq) ^ (fr >> 1)) * 16, sw1 = ((4 + fq) ^ (fr >> 1)) * 16;

  const int nk = K >> 6;
  issue(0, 0);
  astore(0);
  __syncthreads();
  for (int kt = 0; kt < nk; kt++) {
    if (kt + 1 < nk) issue((kt + 1) & 1, (kt + 1) << 6);
    __builtin_amdgcn_sched_barrier(0);
    const char* S = lds + (kt & 1) * G_STAGE;
#pragma unroll
    for (int kk = 0; kk < 2; kk++) {
      const int sw = kk ? sw1 : sw0;
      bf16x8 af[4], bfr[4];
#pragma unroll
      for (int m = 0; m < 4; m++) af[m] = *(const bf16x8*)(S + abase + m * 2048 + sw);
#pragma unroll
      for (int n = 0; n < 4; n++) bfr[n] = *(const bf16x8*)(S + bbase + n * 2048 + sw);
#pragma unroll
      for (int m = 0; m < 4; m++)
#pragma unroll
        for (int n = 0; n < 4; n++) acc[m][n] = __builtin_amdgcn_mfma_f32_16x16x32_bf16(bfr[n], af[m], acc[m][n], 0, 0, 0);
    }
    __builtin_amdgcn_sched_barrier(0);
    if (kt + 1 < nk) astore((kt + 1) & 1);
    __syncthreads();
  }
  epi(acc, wr * 64 + fr, wc * 64 + fq * 4);
}

#define EPI_LOOP(...)                                    \
  _Pragma("unroll") for (int m = 0; m < 4; m++)          \
  _Pragma("unroll") for (int n = 0; n < 4; n++) {        \
    const int row = rbase + m * 16;                      \
    const int col = cbase + n * 16;                      \
    const f32x4 v = acc[m][n];                           \
    __VA_ARGS__                                          \
  }

DI void st_bf4(u16* dst, f32x4 v) { *(uint2*)dst = make_uint2(pack2(v[0], v[1]), pack2(v[2], v[3])); }

DI const float* xin_row(const Params& p, int l, int tg) {
  if (l == 0) return tg < 32768 ? p.x_prompt + (size_t)tg * 1024 : p.x_sample + (size_t)(tg - 32768) * 1024;
  return p.out + (size_t)tg * 1024;
}

DI void phase_inproj(const Params& p, int l, int tok0, char* lds, int bid, int nb, int tid) {
  const int NT = 29, MT = T_SUB / 128;
  for (int it = 0;; it++) {
    int nt, mt;
    if (!xcd_tile(it, bid, nb, MT, NT, mt, nt)) break;
    int m0 = mt * 128, n0 = nt * 128;
    auto rowfn = [&](int r) -> const void* { return p.xb + (size_t)(tok0 + m0 + r) * 1024; };
    u16* z = p.z;
    auto epi = [&](f32x4(&acc)[4][4], int rbase, int cbase) {
      EPI_LOOP({
        int c = n0 + col;
        if (c < ZLD) st_bf4(z + (size_t)(m0 + row) * ZLD + c, v);
      })
    };
    gemm_tile<false>(rowfn, p.w_in_t + ((size_t)l * 3712 + n0) * 1024, 1024, epi, lds, tid);
  }
}

DI void phase_prep(const Params& p, int l, int N, int bid, int nb, int tid) {
  const int lane = tid & 63, wv = tid >> 6;
  const float* gq = p.mla_gq + l * 256;
  const float* gkv = p.mla_gkv + l * 128;
  const float* lb = p.lb + l * 512;
  const float* mu0 = p.rw_mu + (size_t)l * 2 * 1152;
  const float* mu1 = mu0 + 1152;
  const float* k_k = p.rw_kk + l * 256;
  const float* r_k = p.rw_rk + l * 256;
  for (int t = bid * 4 + wv; t < T_SUB; t += nb * 4) {
    u16* zr = p.z + (size_t)t * ZLD;
    const int n = t & (N - 1);
    {
      uint2 raw = *(const uint2*)(zr + lane * 4);
      float v0 = blo(raw.x), v1 = bhi(raw.x), v2 = blo(raw.y), v3 = bhi(raw.y);
      float ss = wave_sum(v0 * v0 + v1 * v1 + v2 * v2 + v3 * v3);
      float ri = rsqrtf(ss * (1.f / 256.f) + 1e-6f);
      const float* g = gq + lane * 4;
      *(uint2*)(p.cqn + (size_t)t * 256 + lane * 4) =
          make_uint2(pack2(v0 * ri * g[0], v1 * ri * g[1]), pack2(v2 * ri * g[2], v3 * ri * g[3]));
    }
    {
      unsigned raw = *(const unsigned*)(zr + 256 + lane * 2);
      float v0 = blo(raw), v1 = bhi(raw);
      float ss = wave_sum(v0 * v0 + v1 * v1);
      float ri = rsqrtf(ss * (1.f / 128.f) + 1e-6f);
      *(unsigned*)(p.ckvn + (size_t)t * 128 + lane * 2) = pack2(v0 * ri * gkv[lane * 2], v1 * ri * gkv[lane * 2 + 1]);
    }
    if (lane < 16) {
      float x1 = bf2f(zr[384 + lane]), x2 = bf2f(zr[400 + lane]);
      float c = p.ropec[n * 16 + lane], s = p.ropes[n * 16 + lane];
      u16 k1 = f2bf(x1 * c - x2 * s), k2 = f2bf(x1 * s + x2 * c);
      u16* kb = p.Kb + (size_t)t * 384;
#pragma unroll
      for (int h = 0; h < 4; h++) {
        kb[h * 96 + 64 + lane] = k1;
        kb[h * 96 + 80 + lane] = k2;
      }
    }
    {
      uint4* ptr = (uint4*)(zr + ZC_OFF + 256 + lane * 8);
      uint4 raw = *ptr;
      const float* lbp = lb + lane * 8;
      unsigned w[4] = {raw.x, raw.y, raw.z, raw.w};
#pragma unroll
      for (int j = 0; j < 4; j++) {
        float a = blo(w[j]), b = bhi(w[j]);
        float la = lbp[2 * j], lb2 = lbp[2 * j + 1];
        a = la + (1.f - la) * sigm(a);
        b = lb2 + (1.f - lb2) * sigm(b);
        w[j] = pack2(a, b);
      }
      *ptr = make_uint4(w[0], w[1], w[2], w[3]);
    }
    {
      const u16* zd = zr + ZD_OFF;
      const bool hp = n > 0, hn = n < N - 1;
      float rr[4], kx[4], vx[4];
#pragma unroll
      for (int part = 0; part < 3; part++) {
        int c = part * 256 + lane * 4;
        uint2 cur = *(const uint2*)(zd + c);
        uint2 prv = hp ? *(const uint2*)(zd - ZLD + c) : make_uint2(0, 0);
        uint2 nxt = hn ? *(const uint2*)(zd + ZLD + c) : make_uint2(0, 0);
        float cz[4] = {blo(cur.x), bhi(cur.x), blo(cur.y), bhi(cur.y)};
        float pz[4] = {blo(prv.x), bhi(prv.x), blo(prv.y), bhi(prv.y)};
        float nz[4] = {blo(nxt.x), bhi(nxt.x), blo(nxt.y), bhi(nxt.y)};
#pragma unroll
        for (int j = 0; j < 4; j++) {
          float o = cz[j] + mu0[c + j] * (pz[j] - cz[j]) + mu1[c + j] * (nz[j] - cz[j]);
          if (part == 0) rr[j] = o;
          if (part == 1) kx[j] = o;
          if (part == 2) vx[j] = o;
        }
      }
      int c4 = lane * 4;
      *(uint2*)(p.rs + (size_t)t * 256 + c4) = make_uint2(pack2(rr[0], rr[1]), pack2(rr[2], rr[3]));
      *(uint2*)(p.ks + (size_t)t * 256 + c4) = make_uint2(pack2(kx[0], kx[1]), pack2(kx[2], kx[3]));
      *(uint2*)(p.vs + (size_t)t * 256 + c4) = make_uint2(pack2(vx[0], vx[1]), pack2(vx[2], vx[3]));
      float kq[4], ss = 0.f, bo = 0.f;
#pragma unroll
      for (int j = 0; j < 4; j++) {
        kq[j] = kx[j] * k_k[c4 + j];
        ss += kq[j] * kq[j];
        bo += rr[j] * kx[j] * r_k[c4 + j];
      }
      ss = reduce16(ss);
      bo = reduce16(bo);
      float inv = 1.f / fmaxf(sqrtf(ss), 1e-12f);
      *(uint2*)(p.kk + (size_t)t * 256 + c4) = make_uint2(pack2(kq[0] * inv, kq[1] * inv), pack2(kq[2] * inv, kq[3] * inv));
      if ((lane & 15) == 0) p.bonus[(size_t)t * 4 + (lane >> 4)] = bo;
#pragma unroll
      for (int i = 0; i < 6; i++) {
        int c = 768 + lane + 64 * i;
        float cz = bf2f(zd[c]);
        float pz = hp ? bf2f(zd[c - ZLD]) : 0.f;
        float nz = hn ? bf2f(zd[c + ZLD]) : 0.f;
        float o = cz + mu0[c] * (pz - cz) + mu1[c] * (nz - cz);
        if (i < 2) o = tanh_(o);
        else if (i >= 4) o = sigm(o);
        p.S1[(size_t)t * 384 + lane + 64 * i] = f2bf(o);
      }
    }
  }
}

DI void phase_smallgemm(const Params& p, int l, int B, int N, char* lds, int bid, int nb, int tid) {
  TileIter it{bid, nb, 0};
  const int MT = T_SUB / 128;
  {
    const int NT = 3;
    for (int itx = 0;; itx++) {
      int nt, mt;
      if (!xcd_tile(itx, bid, nb, MT, NT, mt, nt)) break;
      int m0 = mt * 128, n0 = nt * 128;
      auto rowfn = [&](int r) -> const void* { return p.cqn + (size_t)(m0 + r) * 256; };
      u16* Q = p.Q;
      auto epi = [&](f32x4(&acc)[4][4], int rbase, int cbase) {
        const float SC = 0.10206207261596577f * LOG2E;
        EPI_LOOP({ st_bf4(Q + (size_t)(m0 + row) * 384 + n0 + col, v * SC); })
      };
      gemm_tile<false>(rowfn, p.wuq_t + ((size_t)l * 384 + n0) * 256, 256, epi, lds, tid);
    }
  }
  {
    const int NT = 4;
    for (int itx = 0;; itx++) {
      int nt, mt;
      if (!xcd_tile(itx, bid, nb, MT, NT, mt, nt)) break;
      int m0 = mt * 128, n0 = nt * 128;
      auto rowfn = [&](int r) -> const void* { return p.ckvn + (size_t)(m0 + r) * 128; };
      u16* Kb = p.Kb;
      u16* Vt = p.Vt;
      auto epi = [&](f32x4(&acc)[4][4], int rbase, int cbase) {
        EPI_LOOP({
          int c = n0 + col;
          int tk = m0 + row;
          if (c < 256) {
            int h = c >> 6, d = c & 63;
            st_bf4(Kb + (size_t)tk * 384 + h * 96 + d, v);
          } else {
            int cc = c - 256;
            int b = tk / N, nn = tk - b * N;
            u16* dst = Vt + ((size_t)(b * 256 + cc)) * N + nn;
            dst[0] = f2bf(v[0]);
            dst[(size_t)N] = f2bf(v[1]);
            dst[(size_t)2 * N] = f2bf(v[2]);
            dst[(size_t)3 * N] = f2bf(v[3]);
          }
        })
      };
      gemm_tile<false>(rowfn, p.wkv_t + ((size_t)l * 512 + n0) * 128, 128, epi, lds, tid);
    }
  }
  for (int d = 0; d < 2; d++) {
    const int NT = 2;
    for (int itx = 0;; itx++) {
      int nt, mt;
      if (!xcd_tile(itx, bid, nb, MT, NT, mt, nt)) break;
      int m0 = mt * 128, n0 = nt * 128;
      auto rowfn = [&](int r) -> const void* { return p.S1 + (size_t)(m0 + r) * 384 + d * 64; };
      u16* dst = p.dec + (size_t)d * T_SUB * 256;
      const float* w0 = p.rw_w0 + (l * 2 + d) * 256;
      auto epi = [&](f32x4(&acc)[4][4], int rbase, int cbase) {
        EPI_LOOP({
          f32x4 o;
          for (int j = 0; j < 4; j++) o[j] = __expf(-0.6065306597126334f * sigm(w0[n0 + col + j] + v[j]));
          st_bf4(dst + (size_t)(m0 + row) * 256 + n0 + col, o);
        })
      };
      gemm_tile<false>(rowfn, p.wup_t + ((size_t)(l * 2 + d) * 256 + n0) * 64, 64, epi, lds, tid);
    }
  }
  for (int d = 0; d < 2; d++) {
    const int NT = 2;
    for (int itx = 0;; itx++) {
      int nt, mt;
      if (!xcd_tile(itx, bid, nb, MT, NT, mt, nt)) break;
      int m0 = mt * 128, n0 = nt * 128;
      auto rowfn = [&](int r) -> const void* { return p.S1 + (size_t)(m0 + r) * 384 + 128 + d * 64; };
      u16* dka = p.kka + (size_t)d * T_SUB * 256;
      u16* dkt = p.kt + (size_t)d * T_SUB * 256;
      const float* a0 = p.rw_a0 + (l * 2 + d) * 256;
      const float* ka = p.rw_ka + l * 256;
      const u16* kkp = p.kk;
      const u16* ksp = p.ks;
      auto epi = [&](f32x4(&acc)[4][4], int rbase, int cbase) {
        EPI_LOOP({
          size_t o = (size_t)(m0 + row) * 256 + n0 + col;
          uint2 kkr = *(const uint2*)(kkp + o);
          uint2 ksr = *(const uint2*)(ksp + o);
          float kkv[4] = {blo(kkr.x), bhi(kkr.x), blo(kkr.y), bhi(kkr.y)};
          float ksv[4] = {blo(ksr.x), bhi(ksr.x), blo(ksr.y), bhi(ksr.y)};
          f32x4 o1, o2;
          for (int j = 0; j < 4; j++) {
            float a = sigm(a0[n0 + col + j] + v[j]);
            o1[j] = kkv[j] * a;
            o2[j] = ksv[j] * (1.f + (a - 1.f) * ka[n0 + col + j]);
          }
          st_bf4(dka + o, o1);
          st_bf4(dkt + o, o2);
        })
      };
      gemm_tile<false>(rowfn, p.aup_t + ((size_t)(l * 2 + d) * 256 + n0) * 64, 64, epi, lds, tid);
    }
  }
  {
    const int NT = 2;
    for (int itx = 0;; itx++) {
      int nt, mt;
      if (!xcd_tile(itx, bid, nb, MT, NT, mt, nt)) break;
      int m0 = mt * 128, n0 = nt * 128;
      auto rowfn = [&](int r) -> const void* { return p.S1 + (size_t)(m0 + r) * 384 + 256; };
      u16* dst = p.gD;
      auto epi = [&](f32x4(&acc)[4][4], int rbase, int cbase) {
        EPI_LOOP({ st_bf4(dst + (size_t)(m0 + row) * 256 + n0 + col, v); })
      };
      gemm_tile<false>(rowfn, p.gup_t + ((size_t)l * 256 + n0) * 128, 128, epi, lds, tid);
    }
  }
}

DI bf16x8 pack8(const f32x16& s, int o) {
  u32x4_t r = {pack2(s[o], s[o + 1]), pack2(s[o + 2], s[o + 3]), pack2(s[o + 4], s[o + 5]), pack2(s[o + 6], s[o + 7])};
  return __builtin_bit_cast(bf16x8, r);
}

constexpr int AT_KP = 208, AT_VP = 144, AT_BUF = 64 * AT_KP + 64 * AT_VP;
DI void attn_task(const Params& p, int task, int N, char* lds, int tid) {
  const int lane = tid & 63, wv = tid >> 6, r = lane & 31, hf = lane >> 5;
  const int nqb = N >> 7;
  {
    const int qb = task % nqb, bh = task / nqb, h = bh & 3, b = bh >> 2;
    const size_t tb = (size_t)b * N;
    const int q = qb * 128 + wv * 32 + r;
    bf16x8 qf[6];
    {
      const u16* qrow = p.Q + (tb + q) * 384 + h * 96;
#pragma unroll
      for (int ks = 0; ks < 4; ks++) qf[ks] = *(const bf16x8*)(qrow + ks * 16 + hf * 8);
      bf16x8 x1r = *(const bf16x8*)(qrow + 64 + hf * 8);
      bf16x8 x2r = *(const bf16x8*)(qrow + 80 + hf * 8);
      const float* cp = p.ropec + q * 16 + hf * 8;
      const float* sp = p.ropes + q * 16 + hf * 8;
      float ra[8], rb[8];
#pragma unroll
      for (int j = 0; j < 8; j++) {
        float xa = bf2f((u16)x1r[j]), ya = bf2f((u16)x2r[j]);
        float c0 = cp[j], s0 = sp[j];
        ra[j] = xa * c0 - ya * s0;
        rb[j] = xa * s0 + ya * c0;
      }
      u32x4_t o1 = {pack2(ra[0], ra[1]), pack2(ra[2], ra[3]), pack2(ra[4], ra[5]), pack2(ra[6], ra[7])};
      u32x4_t o2 = {pack2(rb[0], rb[1]), pack2(rb[2], rb[3]), pack2(rb[4], rb[5]), pack2(rb[6], rb[7])};
      qf[4] = __builtin_bit_cast(bf16x8, o1);
      qf[5] = __builtin_bit_cast(bf16x8, o2);
    }
    const u16* Kg = p.Kb + tb * 384 + h * 96;
    const u16* Vg = p.Vt + ((size_t)(b * 4 + h) * 64) * N;
    uint4 kr0, kr1, kr2, vr0, vr1;
    const int lkey = tid >> 2, lpart = tid & 3;
    const int lrow = swap23(lkey);
#define AT_GLOAD(kt_)                                                              \
  {                                                                                \
    const u16* kp_ = Kg + (size_t)((kt_) * 64 + lkey) * 384 + lpart * 24;          \
    kr0 = *(const uint4*)(kp_);                                                    \
    kr1 = *(const uint4*)(kp_ + 8);                                                \
    kr2 = *(const uint4*)(kp_ + 16);                                               \
    const u16* vp_ = Vg + (size_t)lkey * N + (kt_) * 64 + lpart * 16;              \
    vr0 = *(const uint4*)(vp_);                                                    \
    vr1 = *(const uint4*)(vp_ + 8);                                                \
  }
#define AT_LSTORE(buf_)                                                            \
  {                                                                                \
    char* Kl_ = lds + (buf_) * AT_BUF;                                             \
    char* Vl_ = Kl_ + 64 * AT_KP;                                                  \
    *(uint4*)(Kl_ + lrow * AT_KP + (lpart * 3 + 0) * 16) = kr0;                    \
    *(uint4*)(Kl_ + lrow * AT_KP + (lpart * 3 + 1) * 16) = kr1;                    \
    *(uint4*)(Kl_ + lrow * AT_KP + (lpart * 3 + 2) * 16) = kr2;                    \
    *(uint4*)(Vl_ + lkey * AT_VP + (lpart * 2 + 0) * 16) = vr0;                    \
    *(uint4*)(Vl_ + lkey * AT_VP + (lpart * 2 + 1) * 16) = vr1;                    \
  }
    f32x16 O0, O1;
#pragma unroll
    for (int i = 0; i < 16; i++) { O0[i] = 0.f; O1[i] = 0.f; }
    float mrun = -1e30f, lrun = 0.f;
    const int nt = N >> 6;
    __syncthreads();
    AT_GLOAD(0);
    AT_LSTORE(0);
    __syncthreads();
    for (int kt = 0; kt < nt; kt++) {
      if (kt + 1 < nt) AT_GLOAD(kt + 1);
      __builtin_amdgcn_sched_barrier(0);
      const char* Kl = lds + (kt & 1) * AT_BUF;
      const char* Vl = Kl + 64 * AT_KP;
      f32x16 S0, S1;
#pragma unroll
      for (int i = 0; i < 16; i++) { S0[i] = 0.f; S1[i] = 0.f; }
#pragma unroll
      for (int ks = 0; ks < 6; ks++) {
        bf16x8 a0 = *(const bf16x8*)(Kl + r * AT_KP + ks * 32 + hf * 16);
        bf16x8 a1 = *(const bf16x8*)(Kl + (32 + r) * AT_KP + ks * 32 + hf * 16);
        S0 = __builtin_amdgcn_mfma_f32_32x32x16_bf16(a0, qf[ks], S0, 0, 0, 0);
        S1 = __builtin_amdgcn_mfma_f32_32x32x16_bf16(a1, qf[ks], S1, 0, 0, 0);
      }
      float mx = S0[0];
#pragma unroll
      for (int i = 1; i < 16; i++) mx = fmaxf(mx, S0[i]);
#pragma unroll
      for (int i = 0; i < 16; i++) mx = fmaxf(mx, S1[i]);
      mx = fmaxf(mx, __shfl_xor(mx, 32));
      float mn = fmaxf(mrun, mx);
      float alpha = ex2(mrun - mn);
      mrun = mn;
      float ls = 0.f;
#pragma unroll
      for (int i = 0; i < 16; i++) {
        S0[i] = ex2(S0[i] - mn);
        S1[i] = ex2(S1[i] - mn);
        ls += S0[i] + S1[i];
      }
      lrun = lrun * alpha + ls;
#pragma unroll
      for (int i = 0; i < 16; i++) { O0[i] *= alpha; O1[i] *= alpha; }
#pragma unroll
      for (int sp = 0; sp < 4; sp++) {
        bf16x8 pb = (sp < 2) ? pack8(S0, (sp & 1) * 8) : pack8(S1, (sp & 1) * 8);
        bf16x8 v0 = *(const bf16x8*)(Vl + r * AT_VP + sp * 32 + hf * 16);
        bf16x8 v1 = *(const bf16x8*)(Vl + (32 + r) * AT_VP + sp * 32 + hf * 16);
        O0 = __builtin_amdgcn_mfma_f32_32x32x16_bf16(v0, pb, O0, 0, 0, 0);
        O1 = __builtin_amdgcn_mfma_f32_32x32x16_bf16(v1, pb, O1, 0, 0, 0);
      }
      __builtin_amdgcn_sched_barrier(0);
      if (kt + 1 < nt) AT_LSTORE((kt + 1) & 1);
      __syncthreads();
    }
    float lt = lrun + __shfl_xor(lrun, 32);
    float inv = 1.f / lt;
    u16* orow = p.cat + (tb + q) * 1024 + h * 64;
#pragma unroll
    for (int g = 0; g < 4; g++) {
      int d0 = 8 * g + 4 * hf;
      *(uint2*)(orow + d0) = make_uint2(pack2(O0[4 * g] * inv, O0[4 * g + 1] * inv), pack2(O0[4 * g + 2] * inv, O0[4 * g + 3] * inv));
      *(uint2*)(orow + 32 + d0) = make_uint2(pack2(O1[4 * g] * inv, O1[4 * g + 1] * inv), pack2(O1[4 * g + 2] * inv, O1[4 * g + 3] * inv));
    }
  }
}

DI void na_task(const Params& p, int l, int task, int N, int tid) {
  const int lane = tid & 63, head = tid >> 6, r = lane & 31, hf = lane >> 5;
  const int rows = N >> 6;
  const int nrb = rows >> 1;
  const float* bias = p.na_bias + (size_t)(l * 4 + head) * 15 * 31;
  {
    const int cb = task & 3, rb = (task >> 2) % nrb, b = (task >> 2) / nrb;
    const size_t tb = (size_t)b * N;
    const int qrow0 = rb * 2;
    const int rstart0 = clampi(qrow0 - 4, 0, rows - 8);
    const int k0 = clampi(rstart0, 0, rows - 9);
    const int kstart = clampi(cb * 16 - 8, 0, 32);
    const int iq = r >> 4, u = r & 15;
    const int qrow = qrow0 + iq, qcol = cb * 16 + u;
    const int rstart = clampi(qrow - 4, 0, rows - 8);
    const int cstart = clampi(qcol - 8, 0, 48);
    bf16x8 qf[4];
    {
      const u16* qp = p.z + (tb + qrow * 64 + qcol) * ZLD + ZB_OFF + head * 64;
#pragma unroll
      for (int ks = 0; ks < 4; ks++) qf[ks] = *(const bf16x8*)(qp + ks * 16 + hf * 8);
    }
    f32x16 O0, O1;
#pragma unroll
    for (int i = 0; i < 16; i++) { O0[i] = 0.f; O1[i] = 0.f; }
    float mrun = -1e30f, lrun = 0.f;
    const int wk = swap23(r);
    for (int j = 0; j < 9; j++) {
      const int krow = k0 + j;
      const u16* kp = p.z + (tb + krow * 64 + kstart + wk) * ZLD + ZB_OFF + 256 + head * 64;
      f32x16 S;
#pragma unroll
      for (int i = 0; i < 16; i++) S[i] = 0.f;
#pragma unroll
      for (int ks = 0; ks < 4; ks++) {
        bf16x8 a = *(const bf16x8*)(kp + ks * 16 + hf * 8);
        S = __builtin_amdgcn_mfma_f32_32x32x16_bf16(a, qf[ks], S, 0, 0, 0);
      }
      const bool rok = (krow >= rstart) && (krow < rstart + 8);
      const int drow = clampi(krow - qrow + 7, 0, 14);
      const float* brow = bias + drow * 31;
      float mx = -1e30f;
#pragma unroll
      for (int i = 0; i < 16; i++) {
        int w = 16 * (i >> 3) + 8 * hf + 4 * ((i >> 2) & 1) + (i & 3);
        int kcol = kstart + w;
        bool ok = rok && (kcol >= cstart) && (kcol < cstart + 16);
        int dcol = clampi(kcol - qcol + 15, 0, 30);
        float s = (S[i] * 0.125f + brow[dcol]) * LOG2E;
        S[i] = ok ? s : -1e30f;
        mx = fmaxf(mx, S[i]);
      }
      mx = fmaxf(mx, __shfl_xor(mx, 32));
      float mn = fmaxf(mrun, mx);
      float alpha = ex2(mrun - mn);
      mrun = mn;
      float ls = 0.f;
#pragma unroll
      for (int i = 0; i < 16; i++) {
        float pv = (S[i] > -1e29f) ? ex2(S[i] - mn) : 0.f;
        S[i] = pv;
        ls += pv;
      }
      lrun = lrun * alpha + ls;
#pragma unroll
      for (int i = 0; i < 16; i++) { O0[i] *= alpha; O1[i] *= alpha; }
      const u16* vbase = p.z + (tb + krow * 64 + kstart) * ZLD + ZB_OFF + 512 + head * 64 + r;
#pragma unroll
      for (int s = 0; s < 2; s++) {
        bf16x8 pb = pack8(S, s * 8);
        bf16x8 v0, v1;
#pragma unroll
        for (int jj = 0; jj < 8; jj++) {
          const u16* vp = vbase + (size_t)(16 * s + 8 * hf + jj) * ZLD;
          v0[jj] = (short)vp[0];
          v1[jj] = (short)vp[32];
        }
        O0 = __builtin_amdgcn_mfma_f32_32x32x16_bf16(v0, pb, O0, 0, 0, 0);
        O1 = __builtin_amdgcn_mfma_f32_32x32x16_bf16(v1, pb, O1, 0, 0, 0);
      }
    }
    float lt = lrun + __shfl_xor(lrun, 32);
    float inv = 1.f / lt;
    u16* orow = p.cat + (tb + qrow * 64 + qcol) * 1024 + 256 + head * 64;
#pragma unroll
    for (int g = 0; g < 4; g++) {
      int d0 = 8 * g + 4 * hf;
      *(uint2*)(orow + d0) = make_uint2(pack2(O0[4 * g] * inv, O0[4 * g + 1] * inv), pack2(O0[4 * g + 2] * inv, O0[4 * g + 3] * inv));
      *(uint2*)(orow + 32 + d0) = make_uint2(pack2(O1[4 * g] * inv, O1[4 * g + 1] * inv), pack2(O1[4 * g + 2] * inv, O1[4 * g + 3] * inv));
    }
  }
}

using f32x2 = __attribute__((ext_vector_type(2))) float;
constexpr int SC_STEPS = 16;

DI void sc_store(char* buf, int dst, uint4 R, bool hgw) {
  float4 lo = make_float4(blo(R.x), bhi(R.x), blo(R.y), bhi(R.y));
  float4 hi = make_float4(blo(R.z), bhi(R.z), blo(R.w), bhi(R.w));
  *(float4*)(buf + dst) = lo;
  *(float4*)(buf + dst + 16) = hi;
  if (hgw) {
    *(float4*)(buf + dst + 256) = make_float4(1.f - lo.x, 1.f - lo.y, 1.f - lo.z, 1.f - lo.w);
    *(float4*)(buf + dst + 272) = make_float4(1.f - hi.x, 1.f - hi.y, 1.f - hi.z, 1.f - hi.w);
  }
}

DI float reduce8(float v) {
  v += dpp_f<0xB1>(v);
  v += dpp_f<0x4E>(v);
  v += dpp_f<0x141>(v);
  return v;
}

template <bool RW>
DI void scan_task(const Params& p, int task, int N, char* lds, int tid) {
  constexpr int NA = RW ? 5 : 3;
  constexpr int VOFF = SC_STEPS * NA * 256;
  constexpr int BUF = VOFF + SC_STEPS * 128;
  const int lane = tid & 63, wv = tid >> 6, kq = lane & 7, rg = lane >> 3;
  const int rq = task & 1, hh = (task >> 1) & 3, dir = (task >> 3) & 1, b = task >> 4;
  const size_t tb = (size_t)b * N;
  const int sub = tid >> 7, lt = tid & 127, lstep = lt >> 3, lpart = lt & 7;
  const int vstep = lt >> 2, vq = lt & 3;
  const u16 *src0 = nullptr, *src1 = nullptr, *src2 = nullptr;
  int dst0 = 0, dst1 = 0, dst2 = 0, st0 = 0, st1 = 0, st2 = 0;
  bool act0 = false, act1 = false, act2 = false, hgw = false;
  int ld;
  const int acol = hh * 64 + lpart * 8;
  const int vcol = hh * 64 + rq * 32 + vq * 8;
  const int vdst = VOFF + vstep * 128 + vq * 32;
  if (RW) {
    ld = 256;
    act0 = true; st0 = lstep;
    src0 = sub ? (p.dec + (size_t)dir * T_SUB * 256 + acol) : (p.rs + acol);
    dst0 = (lstep * NA + (sub ? 1 : 0)) * 256 + lpart * 32;
    act1 = true; st1 = lstep;
    src1 = sub ? (p.kk + acol) : (p.kt + (size_t)dir * T_SUB * 256 + acol);
    dst1 = (lstep * NA + (sub ? 3 : 2)) * 256 + lpart * 32;
    if (sub == 0) { act2 = true; st2 = lstep; src2 = p.kka + (size_t)dir * T_SUB * 256 + acol; dst2 = (lstep * NA + 4) * 256 + lpart * 32; }
    else { act2 = lt < 64; st2 = vstep; src2 = p.vs + vcol; dst2 = vdst; }
  } else {
    ld = ZLD;
    act0 = true; st0 = lstep;
    src0 = sub ? (p.z + ZC_OFF + 256 * (1 + dir) + acol) : (p.z + ZC_OFF + acol);
    dst0 = (lstep * NA + (sub ? 1 : 0)) * 256 + lpart * 32;
    hgw = sub != 0;
    if (sub == 0) { act1 = lt < 64; st1 = vstep; src1 = p.z + ZC_OFF + 768 + vcol; dst1 = vdst; }
  }
  u16* pout = (RW ? p.oD : p.oC) + (size_t)dir * T_SUB * 256 + hh * 64 + rq * 32 + wv * 8 + rg;
  pout += (tb + (dir ? (N - 1) : 0)) * 256;
  const int ostride = dir ? -256 : 256;

#define SC_TOK(c_, st_) (tb + (size_t)(dir ? (N - 1 - ((c_) * SC_STEPS + (st_))) : ((c_) * SC_STEPS + (st_))))
#define SC_ISSUE(Ra, Rb, Rc, c_)                                               \
  {                                                                            \
    if (act0) Ra = *(const uint4*)(src0 + SC_TOK(c_, st0) * ld);               \
    if (act1) Rb = *(const uint4*)(src1 + SC_TOK(c_, st1) * ld);               \
    if (act2) Rc = *(const uint4*)(src2 + SC_TOK(c_, st2) * ld);               \
  }
#define SC_STORE(Ra, Rb, Rc, buf_)                                             \
  {                                                                            \
    if (act0) sc_store(buf_, dst0, Ra, hgw);                                   \
    if (act1) sc_store(buf_, dst1, Rb, false);                                 \
    if (act2) sc_store(buf_, dst2, Rc, false);                                 \
  }
  f32x2 S0 = {0.f, 0.f}, S1 = {0.f, 0.f}, S2 = {0.f, 0.f}, S3 = {0.f, 0.f};
#define SC_LD(buf_, s_, ra_, rb_, wa_, wb_, ta_, tb_, ka_, kb_, aa_, ab_, v_)                \
  {                                                                                          \
    const char* rowp_ = (buf_) + (s_) * NA * 256 + kq * 32;                                  \
    ra_ = *(const float4*)(rowp_);                                                           \
    rb_ = *(const float4*)(rowp_ + 16);                                                      \
    wa_ = *(const float4*)(rowp_ + 256);                                                     \
    wb_ = *(const float4*)(rowp_ + 272);                                                     \
    ta_ = *(const float4*)(rowp_ + 512);                                                     \
    tb_ = *(const float4*)(rowp_ + 528);                                                     \
    if (RW) {                                                                                \
      ka_ = *(const float4*)(rowp_ + 768);                                                   \
      kb_ = *(const float4*)(rowp_ + 784);                                                   \
      aa_ = *(const float4*)(rowp_ + 1024);                                                  \
      ab_ = *(const float4*)(rowp_ + 1040);                                                  \
    }                                                                                        \
    v_ = *(const float*)((buf_) + VOFF + (s_) * 128 + (wv * 8 + rg) * 4);                    \
  }
#define F2A(q_) f32x2{(q_).x, (q_).y}
#define F2B(q_) f32x2{(q_).z, (q_).w}
#define SC_COMPUTE(buf_)                                                                     \
  {                                                                                          \
    float oselA = 0.f, oselB = 0.f;                                                          \
    float4 ra, rb, wa, wb, ta, tb_, ka, kb, aa, ab, nra, nrb, nwa, nwb, nta, ntb, nka, nkb, naa, nab; \
    float vv, nvv;                                                                           \
    ka = kb = aa = ab = nka = nkb = naa = nab = make_float4(0.f, 0.f, 0.f, 0.f);             \
    SC_LD(buf_, 0, ra, rb, wa, wb, ta, tb_, ka, kb, aa, ab, vv);                             \
    _Pragma("unroll") for (int s = 0; s < SC_STEPS; s++) {                                   \
      if (s + 1 < SC_STEPS) SC_LD(buf_, s + 1, nra, nrb, nwa, nwb, nta, ntb, nka, nkb, naa, nab, nvv); \
      f32x2 u0 = F2A(ta) * vv, u1 = F2B(ta) * vv, u2 = F2A(tb_) * vv, u3 = F2B(tb_) * vv;     \
      if (RW) {                                                                              \
        f32x2 pa = S0 * F2A(ka), pb = S1 * F2B(ka);                                          \
        pa = S2 * F2A(kb) + pa;                                                              \
        pb = S3 * F2B(kb) + pb;                                                              \
        pa = pa + pb;                                                                        \
        const float sa = -reduce8(pa.x + pa.y);                                              \
        u0 = F2A(aa) * sa + u0;                                                              \
        u1 = F2B(aa) * sa + u1;                                                              \
        u2 = F2A(ab) * sa + u2;                                                              \
        u3 = F2B(ab) * sa + u3;                                                              \
      }                                                                                      \
      S0 = S0 * F2A(wa) + u0;                                                                \
      S1 = S1 * F2B(wa) + u1;                                                                \
      S2 = S2 * F2A(wb) + u2;                                                                \
      S3 = S3 * F2B(wb) + u3;                                                                \
      f32x2 qa = S0 * F2A(ra), qb = S1 * F2B(ra);                                            \
      qa = S2 * F2A(rb) + qa;                                                                \
      qb = S3 * F2B(rb) + qb;                                                                \
      qa = qa + qb;                                                                          \
      const float o = reduce8(qa.x + qa.y);                                                  \
      if (s < 8) oselA = (kq == s) ? o : oselA;                                              \
      else oselB = (kq == s - 8) ? o : oselB;                                                \
      ra = nra; rb = nrb; wa = nwa; wb = nwb; ta = nta; tb_ = ntb;                           \
      ka = nka; kb = nkb; aa = naa; ab = nab; vv = nvv;                                      \
    }                                                                                        \
    pout[kq * ostride] = f2bf(oselA);                                                        \
    pout[(kq + 8) * ostride] = f2bf(oselB);                                                  \
    pout += SC_STEPS * ostride;                                                              \
  }
  uint4 A0 = make_uint4(0, 0, 0, 0), A1 = A0, A2 = A0, B0 = A0, B1 = A0, B2 = A0;
  char* buf0 = lds;
  char* buf1 = lds + BUF;
  const int nch = N / SC_STEPS;
  __syncthreads();
  SC_ISSUE(A0, A1, A2, 0);
  SC_ISSUE(B0, B1, B2, 1);
  SC_STORE(A0, A1, A2, buf0);
  __syncthreads();
  for (int c = 0; c < nch; c += 2) {
    if (c + 2 < nch) SC_ISSUE(A0, A1, A2, c + 2);
    __builtin_amdgcn_sched_barrier(0);
    SC_COMPUTE(buf0);
    __builtin_amdgcn_sched_barrier(0);
    SC_STORE(B0, B1, B2, buf1);
    __syncthreads();
    if (c + 3 < nch) SC_ISSUE(B0, B1, B2, c + 3);
    __builtin_amdgcn_sched_barrier(0);
    SC_COMPUTE(buf1);
    __builtin_amdgcn_sched_barrier(0);
    if (c + 2 < nch) SC_STORE(A0, A1, A2, buf0);
    __syncthreads();
  }
}

DI void phase_mix(const Params& p, int l, int B, int N, unsigned* ctr, char* lds, int bid, int nb, int tid) {
  __shared__ int s_task[2];
  const int nper = B * 16;
  const int nscan = 2 * nper;
  const int nattn = B * 4 * (N >> 7);
  const int nna = B * (N >> 7) * 4;
  const bool prefer_scan = bid < (nb >> 1);
  bool scan_dry = false, attn_dry = false;
  for (;;) {
    if (tid == 0) {
      int kind = -1, task = 0;
      for (int attempt = 0; attempt < 2 && kind < 0; attempt++) {
        const bool try_scan = (attempt == 0) == prefer_scan;
        if (try_scan) {
          if (!scan_dry) {
            const int t = (int)atomicAdd(&ctr[0], 1u);
            if (t < nscan) { kind = 0; task = t; } else scan_dry = true;
          }
        } else {
          if (!attn_dry) {
            const int t = (int)atomicAdd(&ctr[64], 1u);
            if (t < nattn + nna) { kind = 1; task = t; } else attn_dry = true;
          }
        }
      }
      s_task[0] = kind;
      s_task[1] = task;
    }
    __syncthreads();
    const int kind = s_task[0], task = s_task[1];
    __syncthreads();
    if (kind < 0) break;
    if (kind == 0) {
      if (task < nper) scan_task<true>(p, task, N, lds, tid);
      else scan_task<false>(p, task - nper, N, lds, tid);
    } else {
      if (task < nattn) attn_task(p, task, N, lds, tid);
      else na_task(p, l, task - nattn, N, tid);
    }
  }
}

DI void phase_final(const Params& p, int l, int bid, int nb, int tid) {
  const int lane = tid & 63, wv = tid >> 6, c4 = lane * 4;
  const float* gn = p.hg_gnorm + l * 256 + c4;
  const float* lw = p.rw_ln_w + l * 256 + c4;
  const float* lbb = p.rw_ln_b + l * 256 + c4;
  for (int t = bid * 4 + wv; t < T_SUB; t += nb * 4) {
    {
      uint2 a = *(const uint2*)(p.oC + (size_t)t * 256 + c4);
      uint2 bq = *(const uint2*)(p.oC + (size_t)(T_SUB + t) * 256 + c4);
      float o[4] = {blo(a.x) + blo(bq.x), bhi(a.x) + bhi(bq.x), blo(a.y) + blo(bq.y), bhi(a.y) + bhi(bq.y)};
      float ss = reduce16(o[0] * o[0] + o[1] * o[1] + o[2] * o[2] + o[3] * o[3]);
      float ri = rsqrtf(ss * (1.f / 64.f) + 1e-6f);
      uint2 gr = *(const uint2*)(p.z + (size_t)t * ZLD + ZC_OFF + 1024 + c4);
      float g[4] = {blo(gr.x), bhi(gr.x), blo(gr.y), bhi(gr.y)};
      float y[4];
#pragma unroll
      for (int j = 0; j < 4; j++) y[j] = o[j] * ri * gn[j] * (g[j] * sigm(g[j]));
      *(uint2*)(p.cat + (size_t)t * 1024 + 512 + c4) = make_uint2(pack2(y[0], y[1]), pack2(y[2], y[3]));
    }
    {
      uint2 a = *(const uint2*)(p.oD + (size_t)t * 256 + c4);
      uint2 bq = *(const uint2*)(p.oD + (size_t)(T_SUB + t) * 256 + c4);
      float o[4] = {blo(a.x) + blo(bq.x), bhi(a.x) + bhi(bq.x), blo(a.y) + blo(bq.y), bhi(a.y) + bhi(bq.y)};
      float mu = reduce16(o[0] + o[1] + o[2] + o[3]) * (1.f / 64.f);
      float d0 = o[0] - mu, d1 = o[1] - mu, d2 = o[2] - mu, d3 = o[3] - mu;
      float var = reduce16(d0 * d0 + d1 * d1 + d2 * d2 + d3 * d3) * (1.f / 64.f);
      float ri = rsqrtf(var + 64e-5f);
      float bo = p.bonus[(size_t)t * 4 + (lane >> 4)];
      uint2 vr = *(const uint2*)(p.vs + (size_t)t * 256 + c4);
      uint2 gr = *(const uint2*)(p.gD + (size_t)t * 256 + c4);
      float vv[4] = {blo(vr.x), bhi(vr.x), blo(vr.y), bhi(vr.y)};
      float g[4] = {blo(gr.x), bhi(gr.x), blo(gr.y), bhi(gr.y)};
      float dd[4] = {d0, d1, d2, d3};
      float y[4];
#pragma unroll
      for (int j = 0; j < 4; j++) y[j] = (dd[j] * ri * lw[j] + lbb[j] + bo * vv[j]) * g[j];
      *(uint2*)(p.cat + (size_t)t * 1024 + 768 + c4) = make_uint2(pack2(y[0], y[1]), pack2(y[2], y[3]));
    }
  }
}

DI void phase_wout(const Params& p, int l, int tok0, char* lds, int bid, int nb, int tid) {
  const int NT = 8, MT = T_SUB / 128;
  for (int it = 0;; it++) {
    int nt, mt;
    if (!xcd_tile(it, bid, nb, MT, NT, mt, nt)) break;
    int m0 = mt * 128, n0 = nt * 128;
    auto rowfn = [&](int r) -> const void* { return p.cat + (size_t)(m0 + r) * 1024; };
    auto epi = [&](f32x4(&acc)[4][4], int rbase, int cbase) {
      EPI_LOOP({
        int tg = tok0 + m0 + row;
        float4 xv = *(const float4*)(xin_row(p, l, tg) + n0 + col);
        float4 o = make_float4(ALPHA_F * xv.x + v[0], ALPHA_F * xv.y + v[1], ALPHA_F * xv.z + v[2], ALPHA_F * xv.w + v[3]);
        *(float4*)(p.out + (size_t)tg * 1024 + n0 + col) = o;
      })
    };
    gemm_tile<false>(rowfn, p.wout_t + ((size_t)l * 1024 + n0) * 1024, 1024, epi, lds, tid);
  }
}

template <bool ROUTER>
DI void phase_ln(const Params& p, const float* g, const float* bta, const float* wrouter, int tok0, int ntok, char* lds,
                 int bid, int nb, int tid) {
  const int lane = tid & 63, wv = tid >> 6;
  float* wl = (float*)lds;
  if (ROUTER) {
    __syncthreads();
    for (int i = tid; i < 16384; i += NTHR) {
      int k = i >> 4, e = i & 15;
      wl[e * 1024 + k] = wrouter[i];
    }
    __syncthreads();
  }
  for (int t = bid * 4 + wv; t < ntok; t += nb * 4) {
    const int tg = tok0 + t;
    float* xr = p.out + (size_t)tg * 1024;
    float4 x[4];
    float s = 0.f;
#pragma unroll
    for (int i = 0; i < 4; i++) {
      x[i] = *(const float4*)(xr + i * 256 + lane * 4);
      s += x[i].x + x[i].y + x[i].z + x[i].w;
    }
    float mu = wave_sum(s) * (1.f / 1024.f);
    float vs = 0.f;
#pragma unroll
    for (int i = 0; i < 4; i++) {
      x[i].x -= mu; x[i].y -= mu; x[i].z -= mu; x[i].w -= mu;
      vs += x[i].x * x[i].x + x[i].y * x[i].y + x[i].z * x[i].z + x[i].w * x[i].w;
    }
    float ri = rsqrtf(wave_sum(vs) * (1.f / 1024.f) + 1e-5f);
#pragma unroll
    for (int i = 0; i < 4; i++) {
      float4 gg = *(const float4*)(g + i * 256 + lane * 4);
      float4 bb = *(const float4*)(bta + i * 256 + lane * 4);
      x[i].x = x[i].x * ri * gg.x + bb.x;
      x[i].y = x[i].y * ri * gg.y + bb.y;
      x[i].z = x[i].z * ri * gg.z + bb.z;
      x[i].w = x[i].w * ri * gg.w + bb.w;
      *(float4*)(xr + i * 256 + lane * 4) = x[i];
      *(uint2*)(p.xb + (size_t)tg * 1024 + i * 256 + lane * 4) = make_uint2(pack2(x[i].x, x[i].y), pack2(x[i].z, x[i].w));
    }
    if (ROUTER) {
      float mine = 0.f;
#pragma unroll 1
      for (int e = 0; e < 16; e++) {
        float a = 0.f;
#pragma unroll
        for (int i = 0; i < 4; i++) {
          float4 w = *(const float4*)(wl + e * 1024 + i * 256 + lane * 4);
          a += x[i].x * w.x + x[i].y * w.y + x[i].z * w.z + x[i].w * w.w;
        }
        a = wave_sum(a);
        mine = (lane == e) ? a : mine;
      }
      float mx = mine;
      mx = fmaxf(mx, dpp_f<0xB1>(mx));
      mx = fmaxf(mx, dpp_f<0x4E>(mx));
      mx = fmaxf(mx, dpp_f<0x141>(mx));
      mx = fmaxf(mx, dpp_f<0x140>(mx));
      float ex = __expf(mine - mx);
      float sum = reduce16(ex);
      mine = ex / sum;
      if (lane == 0) p.inv_cnt[tg] = 0;
      if (lane < 16) {
        if (tg < 32768) p.affT[(size_t)lane * 32768 + tg] = mine;
        else p.affT[(size_t)16 * 32768 + (size_t)lane * 65536 + (tg - 32768)] = mine;
      }
    }
  }
}

DI void phase_topk(const Params& p, char* lds, int bid, int nb, int tid) {
  if (bid < 32) {
    unsigned* hist = (unsigned*)lds;
    unsigned* sh = hist + 256;
    unsigned* eqc = sh + 8;
    const int g = bid >> 4, e = bid & 15;
    const int T = g ? 65536 : 32768, cap = T >> 3;
    const int tok0 = g ? 32768 : 0;
    const float* vals = p.affT + (g ? (size_t)16 * 32768 : 0) + (size_t)e * T;
    const float4* v4 = (const float4*)vals;
    const int n4 = T >> 2;
    int* oidx = p.idx + (g ? 65536 : 0) + e * cap;
    float* ogate = p.gate + (g ? 65536 : 0) + e * cap;
    const int slot0 = (g ? 65536 : 0) + e * cap;
    unsigned prefix = 0, mask = 0;
    int remaining = cap;
    for (int pass = 0; pass < 4; pass++) {
      const int shift = 24 - 8 * pass;
      hist[tid] = 0;
      __syncthreads();
      for (int base = 0; base < n4; base += 2048) {
        float4 x[8];
#pragma unroll
        for (int u = 0; u < 8; u++) x[u] = v4[base + u * 256 + tid];
#pragma unroll
        for (int u = 0; u < 8; u++) {
          const unsigned b0 = __float_as_uint(x[u].x), b1 = __float_as_uint(x[u].y), b2 = __float_as_uint(x[u].z), b3 = __float_as_uint(x[u].w);
          if ((b0 & mask) == prefix) atomicAdd(&hist[(b0 >> shift) & 255], 1u);
          if ((b1 & mask) == prefix) atomicAdd(&hist[(b1 >> shift) & 255], 1u);
          if ((b2 & mask) == prefix) atomicAdd(&hist[(b2 >> shift) & 255], 1u);
          if ((b3 & mask) == prefix) atomicAdd(&hist[(b3 >> shift) & 255], 1u);
        }
      }
      __syncthreads();
      if (tid == 0) {
        int cum = 0, sel = 0;
        for (int bq = 255; bq >= 0; bq--) {
          int hc = (int)hist[bq];
          if (cum + hc >= remaining) { sel = bq; break; }
          cum += hc;
        }
        sh[0] = (unsigned)sel;
        sh[1] = (unsigned)(remaining - cum);
        sh[3] = hist[sel];
      }
      __syncthreads();
      prefix |= sh[0] << shift;
      remaining = (int)sh[1];
      mask |= 0xFFu << shift;
      __syncthreads();
    }
    const unsigned thr = prefix;
    const int need = remaining;
    const bool fast = ((int)sh[3] == need);
    if (tid == 0) sh[2] = 0;
    __syncthreads();
    if (fast) {
      for (int base = 0; base < n4; base += 2048) {
        float4 x[8];
#pragma unroll
        for (int u = 0; u < 8; u++) x[u] = v4[base + u * 256 + tid];
#pragma unroll
        for (int u = 0; u < 8; u++) {
          const float xv[4] = {x[u].x, x[u].y, x[u].z, x[u].w};
#pragma unroll
          for (int c = 0; c < 4; c++) {
            if (__float_as_uint(xv[c]) >= thr) {
              const int pos = (int)atomicAdd(&sh[2], 1u);
              const int tok = tok0 + (base + u * 256 + tid) * 4 + c;
              oidx[pos] = tok;
              ogate[pos] = xv[c];
              const int kslot = atomicAdd(&p.inv_cnt[tok], 1);
              p.inv_slot[(size_t)tok * 16 + kslot] = slot0 + pos;
            }
          }
        }
      }
    } else {
      const int ch = T >> 8;
      const float* my = vals + tid * ch;
      int ec = 0;
      for (int i = 0; i < ch; i++) ec += (__float_as_uint(my[i]) == thr) ? 1 : 0;
      eqc[tid] = ec;
      __syncthreads();
      int eq_rank = 0;
      for (int i = 0; i < tid; i++) eq_rank += eqc[i];
      for (int i = 0; i < ch; i++) {
        float v = my[i];
        unsigned u = __float_as_uint(v);
        int pos = -1;
        if (u > thr) {
          pos = (int)atomicAdd(&sh[2], 1u);
        } else if (u == thr) {
          if (eq_rank < need) pos = cap - need + eq_rank;
          eq_rank++;
        }
        if (pos >= 0) {
          const int tok = tok0 + tid * ch + i;
          oidx[pos] = tok;
          ogate[pos] = v;
          const int kslot = atomicAdd(&p.inv_cnt[tok], 1);
          p.inv_slot[(size_t)tok * 16 + kslot] = slot0 + pos;
        }
      }
    }
    __syncthreads();
  }
}

DI void moe_rowinfo(int row0, int l, int& e, int& ioff) {
  if (row0 < 65536) { e = row0 >> 12; }
  else { e = (row0 - 65536) >> 13; }
  ioff = row0;
}

DI void phase_moe1(const Params& p, int l, char* lds, int bid, int nb, int tid) {
  const int NT = 8, MT = 196608 / 128;
  for (int it = 0;; it++) {
    int nt, mt;
    if (!xcd_tile(it, bid, nb, MT, NT, mt, nt)) break;
    int m0 = mt * 128, n0 = nt * 128;
    int e, ioff;
    moe_rowinfo(m0, l, e, ioff);
    const int* ip = p.idx + ioff;
    auto rowfn = [&](int r) -> const void* { return p.xb + (size_t)ip[r] * 1024; };
    u16* H = p.H;
    auto epi = [&](f32x4(&acc)[4][4], int rbase, int cbase) {
#pragma unroll
      for (int m = 0; m < 4; m++)
#pragma unroll
        for (int n = 0; n < 4; n += 2) {
          int row = rbase + m * 16;
          int col = cbase + n * 16;
          int blk = (n0 + (col & ~31)) >> 1;
          int hc = blk + (col & 15);
          f32x4 a = acc[m][n], bq = acc[m][n + 1];
          f32x4 o;
          for (int j = 0; j < 4; j++) o[j] = a[j] * sigm(a[j]) * bq[j];
          st_bf4(H + (size_t)(m0 + row) * 512 + hc, o);
        }
    };
    gemm_tile<false>(rowfn, p.w13_t + ((size_t)(l * 16 + e) * 1024 + n0) * 1024, 1024, epi, lds, tid);
  }
}

DI void phase_moe2(const Params& p, int l, char* lds, int bid, int nb, int tid) {
  TileIter it{bid, nb, 0};
  {
    const int NT = 8, MT = 196608 / 128;
    for (int itx = 0;; itx++) {
      int nt, mt;
      if (!xcd_tile(itx, bid, nb, MT, NT, mt, nt)) break;
      int m0 = mt * 128, n0 = nt * 128;
      int e, ioff;
      moe_rowinfo(m0, l, e, ioff);
      auto rowfn = [&](int r) -> const void* { return p.H + (size_t)(m0 + r) * 512; };
      u16* O = p.O;
      auto epi = [&](f32x4(&acc)[4][4], int rbase, int cbase) {
        EPI_LOOP({ st_bf4(O + (size_t)(m0 + row) * 1024 + n0 + col, v); })
      };
      gemm_tile<false>(rowfn, p.w2_t + ((size_t)(l * 16 + e) * 1024 + n0) * 512, 512, epi, lds, tid);
    }
  }
  {
    const int NT = 8, MT = T_ALL / 128;
    for (int itx = 0;; itx++) {
      int nt, mt;
      if (!xcd_tile(itx, bid, nb, MT, NT, mt, nt)) break;
      int m0 = mt * 128, n0 = nt * 128;
      auto rowfn = [&](int r) -> const void* {
        int tg = m0 + r;
        return tg < 32768 ? p.p_prompt + ((size_t)l * 32768 + tg) * 256 : p.p_sample + ((size_t)l * 65536 + (tg - 32768)) * 256;
      };
      auto epi = [&](f32x4(&acc)[4][4], int rbase, int cbase) {
        EPI_LOOP({ st_bf4(p.xb + (size_t)(m0 + row) * 1024 + n0 + col, v); })
      };
      gemm_tile<true>(rowfn, p.wp_t + ((size_t)l * 1024 + n0) * 256, 256, epi, lds, tid);
    }
  }
}

DI void phase_combine(const Params& p, int bid, int nb, int tid) {
  const int lane = tid & 63, wv = tid >> 6;
  u16* ub = p.H;
  for (int t = bid * 4 + wv; t < T_ALL; t += nb * 4) {
    float* xr = p.out + (size_t)t * 1024;
    float4 a[4];
#pragma unroll
    for (int i = 0; i < 4; i++) {
      float4 x = *(const float4*)(xr + i * 256 + lane * 4);
      a[i] = make_float4(x.x * ALPHA_F, x.y * ALPHA_F, x.z * ALPHA_F, x.w * ALPHA_F);
    }
    const int cnt = p.inv_cnt[t];
    for (int j = 0; j < cnt; j++) {
      const int slot = p.inv_slot[(size_t)t * 16 + j];
      const float g = p.gate[slot];
      const u16* orow = p.O + (size_t)slot * 1024;
#pragma unroll
      for (int i = 0; i < 4; i++) {
        uint2 r = *(const uint2*)(orow + i * 256 + lane * 4);
        a[i].x += g * blo(r.x);
        a[i].y += g * bhi(r.x);
        a[i].z += g * blo(r.y);
        a[i].w += g * bhi(r.y);
      }
    }
#pragma unroll
    for (int i = 0; i < 4; i++) {
      *(float4*)(xr + i * 256 + lane * 4) = a[i];
      *(uint2*)(ub + (size_t)t * 1024 + i * 256 + lane * 4) = make_uint2(pack2(a[i].x, a[i].y), pack2(a[i].z, a[i].w));
    }
  }
}

DI void phase_ple(const Params& p, int l, char* lds, int bid, int nb, int tid) {
  const int NT = 8, MT = T_ALL / 128;
  for (int it = 0;; it++) {
    int nt, mt;
    if (!xcd_tile(it, bid, nb, MT, NT, mt, nt)) break;
    int m0 = mt * 128, n0 = nt * 128;
    auto rowfn = [&](int r) -> const void* { return p.H + (size_t)(m0 + r) * 1024; };
    auto epi = [&](f32x4(&acc)[4][4], int rbase, int cbase) {
      EPI_LOOP({
        size_t o = (size_t)(m0 + row) * 1024 + n0 + col;
        float4 u = *(const float4*)(p.out + o);
        uint2 pr = *(const uint2*)(p.xb + o);
        *(float4*)(p.out + o) = make_float4(u.x + sigm(v[0]) * blo(pr.x), u.y + sigm(v[1]) * bhi(pr.x),
                                            u.z + sigm(v[2]) * blo(pr.y), u.w + sigm(v[3]) * bhi(pr.y));
      })
    };
    gemm_tile<false>(rowfn, p.wg_t + ((size_t)l * 1024 + n0) * 1024, 1024, epi, lds, tid);
  }
}

#define XB_TMO      128
#define XB_XCNT(j)  (256  + 64 * (j))
#define XB_XSUB(j)  (1280 + 64 * (j))
#define XB_XGEN(j)  (2304 + 64 * (j))
#define XB_TOP      3328
#define XB_TOPGEN   3392
#define XCD_BAR_WORDS 3456
#define XB_SPIN_CAP (1u << 22)
#define LAS __attribute__((address_space(3)))
DI unsigned xb_ld(unsigned* p) { return __hip_atomic_load(p, __ATOMIC_RELAXED, __HIP_MEMORY_SCOPE_AGENT); }
DI unsigned xb_add(unsigned* p, unsigned v) { return __hip_atomic_fetch_add(p, v, __ATOMIC_RELAXED, __HIP_MEMORY_SCOPE_AGENT); }
DI unsigned xb_xcc_id() { return (unsigned)__builtin_amdgcn_s_getreg((3 << 11) | 20) & 0xFu; }
#define XB_SPIN(cond, bar) do { unsigned _sp = 0; while (cond) { __builtin_amdgcn_s_sleep(1); \
    if ((++_sp & 255u) == 0u) { if (xb_ld(&(bar)[XB_TMO])) break; if (_sp > XB_SPIN_CAP) { atomicAdd(&(bar)[XB_TMO], 1u); break; } } } } while (0)
struct XcdBarrier { unsigned* bar; unsigned x; volatile LAS unsigned* st; };
DI XcdBarrier xcd_barrier_post(unsigned* bar, volatile LAS unsigned* st) {
  XcdBarrier b; b.bar = bar; b.x = xb_xcc_id(); b.st = st;
  if (threadIdx.x == 0) (void)xb_add(&bar[XB_XCNT(b.x)], 1u);
  return b;
}
DI void xcd_barrier_complete(unsigned* bar, unsigned x, unsigned& nloc, unsigned& nx) {
  const unsigned G = gridDim.x * gridDim.y * gridDim.z;
  unsigned sum, cnt, mine, sp = 0u;
  for (;;) {
    sum = 0u; cnt = 0u; mine = 0u;
#pragma unroll
    for (unsigned j = 0; j < 16; ++j) { const unsigned c = xb_ld(&bar[XB_XCNT(j)]); sum += c; cnt += (c > 0u) ? 1u : 0u; mine = (j == x) ? c : mine; }
    if (sum == G) break;
    __builtin_amdgcn_s_sleep(1);
    if ((++sp & 255u) == 0u) { if (xb_ld(&bar[XB_TMO])) break; if (sp > XB_SPIN_CAP) { atomicAdd(&bar[XB_TMO], 1u); break; } }
  }
  nloc = mine > 0u ? mine : 1u; nx = cnt > 0u ? cnt : 1u;
}
DI void xcd_barrier(const XcdBarrier& b) {
  asm volatile("s_waitcnt vmcnt(0)" ::: "memory");
  __syncthreads();
  if (threadIdx.x == 0) {
    unsigned* bar = b.bar;
    __builtin_amdgcn_s_waitcnt(0);
    unsigned nloc = b.st[0], nx = b.st[1];
    if (nloc == 0u) { xcd_barrier_complete(bar, b.x, nloc, nx); b.st[0] = nloc; b.st[1] = nx; }
    const unsigned old = xb_add(&bar[XB_XSUB(b.x)], 1u);
    const unsigned gen = old / nloc;
    if (old + 1u == (gen + 1u) * nloc) {
      __builtin_amdgcn_fence(__ATOMIC_RELEASE, "agent");
      asm volatile("s_waitcnt vmcnt(0)" ::: "memory");
      const unsigned og = xb_add(&bar[XB_TOP], 1u);
      const unsigned tg = og / nx;
      if (og + 1u == (tg + 1u) * nx) xb_add(&bar[XB_TOPGEN], 1u);
      else XB_SPIN(xb_ld(&bar[XB_TOPGEN]) == tg, bar);
      __builtin_amdgcn_fence(__ATOMIC_ACQUIRE, "agent");
      xb_add(&bar[XB_XGEN(b.x)], 1u);
      asm volatile("s_waitcnt vmcnt(0)" ::: "memory");
    } else {
      XB_SPIN(xb_ld(&bar[XB_XGEN(b.x)]) == gen, bar);
      __builtin_amdgcn_fence(__ATOMIC_ACQUIRE, "agent");
      asm volatile("s_waitcnt vmcnt(0)" ::: "memory");
    }
  }
  __syncthreads();
}

__global__ void __launch_bounds__(NTHR, 2) mega(Params p) {
  __shared__ __attribute__((aligned(16))) char lds[73728];
  cg::grid_group grid = cg::this_grid();
  const int tid0 = threadIdx.x, bid0 = blockIdx.x, nb = gridDim.x;
  __shared__ uint4 xb_words;
  if (tid0 == 0) xb_words = make_uint4(0u, 0u, 0u, 0u);
  __syncthreads();
  const XcdBarrier xb = xcd_barrier_post(p.bar, (volatile LAS unsigned*)&xb_words);
  int pc = 0;
#define PHASE(...)                                      \
  {                                                     \
    if (pc >= p.pb && pc < p.pe) {                      \
      if (pc == p.pb + 1) grid.sync();                  \
      else if (pc > p.pb + 1) xcd_barrier(xb);          \
      int tid = tid0, bid = bid0;                       \
      asm volatile("" : "+v"(tid), "+s"(bid));          \
      __VA_ARGS__;                                      \
    }                                                   \
    pc++;                                               \
  }
  PHASE(phase_convert(p, lds, bid, nb, tid));
  for (int i = 0; i < REP_SYNC; i++) PHASE((void)0);
  for (int l = 0; l < 2; l++) {
    for (int sg = 0; sg < 3; sg++) {
      const int tok0 = sg * T_SUB;
      const int B = sg == 0 ? 4 : 8, N = sg == 0 ? 8192 : 4096;
      PHASE(phase_inproj(p, l, tok0, lds, bid, nb, tid));
#if REP_INPROJ || REP_GEMMS
      PHASE(phase_inproj(p, l, tok0, lds, bid, nb, tid));
#endif
      PHASE(phase_prep(p, l, N, bid, nb, tid));
      PHASE(phase_smallgemm(p, l, B, N, lds, bid, nb, tid));
#if REP_GEMMS
      PHASE(phase_smallgemm(p, l, B, N, lds, bid, nb, tid));
#endif
      PHASE(phase_mix(p, l, B, N, p.bar + XCD_BAR_WORDS + (l * 3 + sg) * 128, lds, bid, nb, tid));
#if REP_MIX
      PHASE(phase_mix(p, l, B, N, p.bar + XCD_BAR_WORDS + (6 + l * 3 + sg) * 128, lds, bid, nb, tid));
#endif
      PHASE(phase_final(p, l, bid, nb, tid));
      PHASE(phase_wout(p, l, tok0, lds, bid, nb, tid));
      PHASE(phase_ln<true>(p, p.ln1_g + l * 1024, p.ln1_b + l * 1024, p.moe_router + (size_t)l * 16384, tok0, T_SUB, lds, bid, nb, tid));
    }
    PHASE(phase_topk(p, lds, bid, nb, tid));
    PHASE(phase_moe1(p, l, lds, bid, nb, tid));
#if REP_MOE1 || REP_GEMMS
    PHASE(phase_moe1(p, l, lds, bid, nb, tid));
#endif
    PHASE(phase_moe2(p, l, lds, bid, nb, tid));
#if REP_GEMMS
    PHASE(phase_moe2(p, l, lds, bid, nb, tid));
#endif
    PHASE(phase_combine(p, bid, nb, tid));
    PHASE(phase_ple(p, l, lds, bid, nb, tid));
    PHASE(phase_ln<false>(p, p.ln2_g + l * 1024, p.ln2_b + l * 1024, nullptr, 0, T_ALL, lds, bid, nb, tid));
  }
}

#define N_PHASES 1000
#ifndef FUSED
#define FUSED 1
#endif

extern "C" void kernel_launch(void* const* d_in, const int* in_sizes, int n_in, void* d_out, int out_size, void* d_ws,
                              size_t ws_size, hipStream_t stream) {
  static int grid_blocks = 0;
  if (!grid_blocks) {
    int dev = 0, cus = 0, per_cu = 0;
    (void)hipGetDevice(&dev);
    (void)hipDeviceGetAttribute(&cus, hipDeviceAttributeMultiprocessorCount, dev);
    (void)hipOccupancyMaxActiveBlocksPerMultiprocessor(&per_cu, mega, NTHR, 0);
    if (per_cu > 2) per_cu = 2;
    if (per_cu < 1) per_cu = 1;
    grid_blocks = cus * per_cu;
  }
  Params p;
  memset(&p, 0, sizeof(p));
  const float* const* in = (const float* const*)d_in;
  int k = 0;
  p.x_prompt = in[k++]; p.x_sample = in[k++]; p.p_prompt = in[k++]; p.p_sample = in[k++];
  p.w_in = in[k++]; p.mla_gq = in[k++]; p.mla_gkv = in[k++]; p.mla_wuq = in[k++]; p.mla_wuk = in[k++]; p.mla_wuv = in[k++];
  p.na_bias = in[k++]; p.hg_lb = in[k++]; p.hg_gnorm = in[k++];
  p.rw_mu = in[k++]; p.rw_w0 = in[k++]; p.rw_w_up = in[k++]; p.rw_a0 = in[k++]; p.rw_a_up = in[k++]; p.rw_g_up = in[k++];
  p.rw_kk = in[k++]; p.rw_ka = in[k++]; p.rw_rk = in[k++]; p.rw_ln_w = in[k++]; p.rw_ln_b = in[k++];
  p.w_out = in[k++]; p.ln1_g = in[k++]; p.ln1_b = in[k++]; p.moe_router = in[k++]; p.moe_w1 = in[k++]; p.moe_w3 = in[k++];
  p.moe_w2 = in[k++]; p.ln2_g = in[k++]; p.ln2_b = in[k++]; p.ple_gate = in[k++]; p.ple_proj = in[k++];
  p.out = (float*)d_out;
  char* ws = (char*)d_ws;
  size_t off = 0;
  auto take = [&](size_t bytes) { char* r = ws + off; off += (bytes + 255) & ~(size_t)255; return r; };
  p.w_in_t = (u16*)take((size_t)2 * 3712 * 1024 * 2);
  p.wuq_t = (u16*)take((size_t)2 * 384 * 256 * 2);
  p.wkv_t = (u16*)take((size_t)2 * 512 * 128 * 2);
  p.wup_t = (u16*)take((size_t)4 * 256 * 64 * 2);
  p.aup_t = (u16*)take((size_t)4 * 256 * 64 * 2);
  p.gup_t = (u16*)take((size_t)2 * 256 * 128 * 2);
  p.wout_t = (u16*)take((size_t)2 * 1024 * 1024 * 2);
  p.w13_t = (u16*)take((size_t)32 * 1024 * 1024 * 2);
  p.w2_t = (u16*)take((size_t)32 * 1024 * 512 * 2);
  p.wg_t = (u16*)take((size_t)2 * 1024 * 1024 * 2);
  p.wp_t = (u16*)take((size_t)2 * 1024 * 256 * 2);
  p.ropec = (float*)take((size_t)8192 * 16 * 4);
  p.ropes = (float*)take((size_t)8192 * 16 * 4);
  p.lb = (float*)take(1024 * 4);
  p.affT = (float*)take((size_t)16 * T_ALL * 4);
  p.gate = (float*)take((size_t)196608 * 4);
  p.idx = (int*)take((size_t)196608 * 4);
  p.bar = (unsigned*)take((size_t)(XCD_BAR_WORDS + 12 * 128) * 4);
  p.inv_cnt = (int*)take((size_t)T_ALL * 4);
  p.inv_slot = (int*)take((size_t)T_ALL * 16 * 4);
  p.xb = (u16*)take((size_t)T_ALL * 1024 * 2);
  const size_t stage0 = off;
  p.z = (u16*)take((size_t)T_SUB * ZLD * 2);
  p.cat = (u16*)take((size_t)T_SUB * 1024 * 2);
  p.Q = (u16*)take((size_t)T_SUB * 384 * 2);
  p.Kb = (u16*)take((size_t)T_SUB * 384 * 2);
  p.Vt = (u16*)take((size_t)T_SUB * 256 * 2);
  p.cqn = (u16*)take((size_t)T_SUB * 256 * 2);
  p.ckvn = (u16*)take((size_t)T_SUB * 128 * 2);
  p.S1 = (u16*)take((size_t)T_SUB * 384 * 2);
  p.rs = (u16*)take((size_t)T_SUB * 256 * 2);
  p.ks = (u16*)take((size_t)T_SUB * 256 * 2);
  p.vs = (u16*)take((size_t)T_SUB * 256 * 2);
  p.kk = (u16*)take((size_t)T_SUB * 256 * 2);
  p.gD = (u16*)take((size_t)T_SUB * 256 * 2);
  p.dec = (u16*)take((size_t)2 * T_SUB * 256 * 2);
  p.kka = (u16*)take((size_t)2 * T_SUB * 256 * 2);
  p.kt = (u16*)take((size_t)2 * T_SUB * 256 * 2);
  p.oC = (u16*)take((size_t)2 * T_SUB * 256 * 2);
  p.oD = (u16*)take((size_t)2 * T_SUB * 256 * 2);
  p.bonus = (float*)take((size_t)T_SUB * 4 * 4);
  off = stage0;
  p.O = (u16*)take((size_t)196608 * 1024 * 2);
  p.H = (u16*)take((size_t)196608 * 512 * 2);
  for (int i = 0; i < 16; i++) p.inv_freq[i] = pow(10000.0, -(double)i / 16.0);
  (void)hipMemsetAsync(p.bar, 0, (size_t)(XCD_BAR_WORDS + 12 * 128) * 4, stream);
#if FUSED
  p.pb = 0;
  p.pe = N_PHASES;
  {
    void* args[] = {&p};
    hipError_t e = hipLaunchCooperativeKernel((void*)mega, dim3(grid_blocks), dim3(NTHR), args, 0, stream);
    if (e != hipSuccess) fprintf(stderr, "cooperative launch failed: %s (grid %d)\n", hipGetErrorString(e), grid_blocks);
  }
#else
  for (int ph = 0; ph < N_PHASES; ph++) {
    p.pb = ph;
    p.pe = ph + 1;
    void* args[] = {&p};
    hipError_t e = hipLaunchCooperativeKernel((void*)mega, dim3(grid_blocks), dim3(NTHR), args, 0, stream);
    if (e != hipSuccess) fprintf(stderr, "cooperative launch failed: %s (grid %d)\n", hipGetErrorString(e), grid_blocks);
  }
#endif
}
```

```cpp
#include <hip/hip_runtime.h>
#include <hip/hip_cooperative_groups.h>
#include <cstdio>
#include <cmath>
#include <cstring>
namespace cg = cooperative_groups;

typedef unsigned short u16;
using bf16x8 = __attribute__((ext_vector_type(8))) short;
using f32x4 = __attribute__((ext_vector_type(4))) float;
using f32x16 = __attribute__((ext_vector_type(16))) float;

#define REP_INPROJ 0
#define REP_ATTN 0
#define REP_NA 0
#define REP_SCAN 0
#define REP_MOE1 0
#define REP_MOE2 0
#define REP_SYNC 0
#define REP_MIX 0
#define REP_GEMMS 0
#define DI __device__ __forceinline__
#define NTHR 256
#define T_ALL 98304
#define T_SUB 32768
#define ZLD 3616
#define ZB_OFF 416
#define ZC_OFF 1184
#define ZD_OFF 2464
#define LOG2E 1.4426950408889634f
#define ALPHA_F 1.4142135623730951f

struct Params {
  const float *x_prompt, *x_sample, *p_prompt, *p_sample;
  const float *w_in, *mla_gq, *mla_gkv, *mla_wuq, *mla_wuk, *mla_wuv, *na_bias, *hg_lb, *hg_gnorm;
  const float *rw_mu, *rw_w0, *rw_w_up, *rw_a0, *rw_a_up, *rw_g_up, *rw_kk, *rw_ka, *rw_rk, *rw_ln_w, *rw_ln_b;
  const float *w_out, *ln1_g, *ln1_b, *moe_router, *moe_w1, *moe_w3, *moe_w2, *ln2_g, *ln2_b, *ple_gate, *ple_proj;
  float* out;
  u16 *w_in_t, *wuq_t, *wkv_t, *wup_t, *aup_t, *gup_t, *wout_t, *w13_t, *w2_t, *wg_t, *wp_t;
  float *ropec, *ropes, *lb, *affT, *gate;
  int* idx;
  unsigned* bar;
  int *inv_cnt, *inv_slot;
  u16 *z, *cat, *Q, *Kb, *Vt, *cqn, *ckvn, *S1, *rs, *ks, *vs, *kk, *gD, *dec, *kka, *kt, *oC, *oD;
  float* bonus;
  u16* xb;
  u16* O;
  u16* H;
  double inv_freq[16];
  int pb, pe;
};

typedef __bf16 v2bf_t __attribute__((ext_vector_type(2)));
typedef float v2f_t __attribute__((ext_vector_type(2)));
typedef unsigned u32x4_t __attribute__((ext_vector_type(4)));
DI unsigned pack2(float a, float b) {
  v2f_t f = {a, b};
  v2bf_t h = __builtin_convertvector(f, v2bf_t);
  return __builtin_bit_cast(unsigned, h);
}
DI u16 f2bf(float f) { return (u16)(pack2(f, 0.f) & 0xffffu); }
DI float bf2f(u16 h) { return __uint_as_float(((unsigned)h) << 16); }
DI float blo(unsigned u) { return __uint_as_float(u << 16); }
DI float bhi(unsigned u) { return __uint_as_float(u & 0xffff0000u); }
DI float sigm(float x) { return 1.f / (1.f + __expf(-x)); }
DI float tanh_(float x) { return 1.f - 2.f / (__expf(2.f * x) + 1.f); }
DI float ex2(float x) { return __builtin_amdgcn_exp2f(x); }
DI int clampi(int v, int lo, int hi) { return v < lo ? lo : (v > hi ? hi : v); }
DI int swap23(int x) { return (x & ~12) | ((x & 4) << 1) | ((x & 8) >> 1); }

template <int CTRL> DI float dpp_f(float v) {
  return __int_as_float(__builtin_amdgcn_update_dpp(0, __float_as_int(v), CTRL, 0xF, 0xF, true));
}
DI float reduce16(float v) {
  v += dpp_f<0xB1>(v);
  v += dpp_f<0x4E>(v);
  v += dpp_f<0x141>(v);
  v += dpp_f<0x140>(v);
  return v;
}
DI float wave_sum(float v) {
  v = reduce16(v);
  v += __shfl_xor(v, 16);
  v += __shfl_xor(v, 32);
  return v;
}

struct TileIter {
  int bid, nb, off;
  DI int first(int n) { int f = bid - off; if (f < 0) f += nb; off = (off + n) % nb; return f; }
};

DI bool xcd_tile(int it, int bid, int nb, int MT, int NT, int& mt, int& nt) {
  const int x = bid & 7, slot = bid >> 3, nslots = nb >> 3;
  const int mper = MT >> 3;
  const int i = slot + it * nslots;
  if (i >= mper * NT) return false;
  const int mi = i & 7, rest = i >> 3;
  nt = rest % NT;
  mt = x * mper + (rest / NT) * 8 + mi;
  return true;
}

DI void convT_job(const float* __restrict__ W, int K, int N, int Npad, u16* __restrict__ Wt, int mode, char* lds,
                  TileIter& it, int tid) {
  float(*tile)[65] = (float(*)[65])lds;
  int tk = K >> 6, tn = Npad >> 6;
  int nt = tk * tn;
  for (int t = it.first(nt); t < nt; t += it.nb) {
    int k0 = (t % tk) << 6, n0 = (t / tk) << 6;
#pragma unroll
    for (int i = 0; i < 16; i++) {
      int kl = (tid >> 6) + 4 * i, nl = tid & 63;
      int n = n0 + nl;
      tile[kl][nl] = (n < N) ? W[(size_t)(k0 + kl) * N + n] : 0.f;
    }
    __syncthreads();
    {
      int nl = tid >> 2, ks = (tid & 3) * 16;
      int n = n0 + nl;
      int row = n;
      if (mode == 1) row = (n >> 4) * 32 + (n & 15);
      if (mode == 2) row = (n >> 4) * 32 + 16 + (n & 15);
      unsigned pk[8];
#pragma unroll
      for (int j = 0; j < 8; j++) pk[j] = pack2(tile[ks + 2 * j][nl], tile[ks + 2 * j + 1][nl]);
      uint4* dst = (uint4*)(Wt + (size_t)row * K + k0 + ks);
      dst[0] = make_uint4(pk[0], pk[1], pk[2], pk[3]);
      dst[1] = make_uint4(pk[4], pk[5], pk[6], pk[7]);
    }
    __syncthreads();
  }
}

DI void phase_convert(const Params& p, char* lds, int bid, int nb, int tid) {
  TileIter it{bid, nb, 0};
  for (int l = 0; l < 2; l++) {
    convT_job(p.w_in + (size_t)l * 1024 * 3616, 1024, 3616, 3712, p.w_in_t + (size_t)l * 3712 * 1024, 0, lds, it, tid);
    convT_job(p.mla_wuq + (size_t)l * 256 * 384, 256, 384, 384, p.wuq_t + (size_t)l * 384 * 256, 0, lds, it, tid);
    convT_job(p.mla_wuk + (size_t)l * 128 * 256, 128, 256, 256, p.wkv_t + (size_t)l * 512 * 128, 0, lds, it, tid);
    convT_job(p.mla_wuv + (size_t)l * 128 * 256, 128, 256, 256, p.wkv_t + (size_t)l * 512 * 128 + 256 * 128, 0, lds, it, tid);
    for (int d = 0; d < 2; d++) {
      convT_job(p.rw_w_up + (size_t)(l * 2 + d) * 64 * 256, 64, 256, 256, p.wup_t + (size_t)(l * 2 + d) * 256 * 64, 0, lds, it, tid);
      convT_job(p.rw_a_up + (size_t)(l * 2 + d) * 64 * 256, 64, 256, 256, p.aup_t + (size_t)(l * 2 + d) * 256 * 64, 0, lds, it, tid);
    }
    convT_job(p.rw_g_up + (size_t)l * 128 * 256, 128, 256, 256, p.gup_t + (size_t)l * 256 * 128, 0, lds, it, tid);
    convT_job(p.w_out + (size_t)l * 1024 * 1024, 1024, 1024, 1024, p.wout_t + (size_t)l * 1024 * 1024, 0, lds, it, tid);
    for (int e = 0; e < 16; e++) {
      size_t le = (size_t)(l * 16 + e);
      convT_job(p.moe_w1 + le * 1024 * 512, 1024, 512, 512, p.w13_t + le * 1024 * 1024, 1, lds, it, tid);
      convT_job(p.moe_w3 + le * 1024 * 512, 1024, 512, 512, p.w13_t + le * 1024 * 1024, 2, lds, it, tid);
      convT_job(p.moe_w2 + le * 512 * 1024, 512, 1024, 1024, p.w2_t + le * 1024 * 512, 0, lds, it, tid);
    }
    convT_job(p.ple_gate + (size_t)l * 1024 * 1024, 1024, 1024, 1024, p.wg_t + (size_t)l * 1024 * 1024, 0, lds, it, tid);
    convT_job(p.ple_proj + (size_t)l * 256 * 1024, 256, 1024, 1024, p.wp_t + (size_t)l * 1024 * 256, 0, lds, it, tid);
  }
  int gt = bid * NTHR + tid, ng = nb * NTHR;
  for (size_t i0 = gt; i0 < (size_t)T_ALL * 256; i0 += (size_t)ng * 8) {
    float4 v[8];
#pragma unroll
    for (int u = 0; u < 8; u++) {
      const size_t i = i0 + (size_t)u * ng;
      v[u] = make_float4(0.f, 0.f, 0.f, 0.f);
      if (i < (size_t)T_ALL * 256)
        v[u] = (i < (size_t)32768 * 256) ? ((const float4*)p.x_prompt)[i] : ((const float4*)p.x_sample)[i - (size_t)32768 * 256];
    }
#pragma unroll
    for (int u = 0; u < 8; u++) {
      const size_t i = i0 + (size_t)u * ng;
      if (i < (size_t)T_ALL * 256) ((uint2*)p.xb)[i] = make_uint2(pack2(v[u].x, v[u].y), pack2(v[u].z, v[u].w));
    }
  }
  for (int i = gt; i < 8192 * 16; i += ng) {
    int n = i >> 4, f = i & 15;
    double ifq = 0.0;
#pragma unroll
    for (int j = 0; j < 16; j++) ifq = (f == j) ? p.inv_freq[j] : ifq;
    double rev = (double)n * ifq * 0.15915494309189535;
    double fr = rev - rint(rev);
    float ff = (float)fr;
    p.ropec[i] = __builtin_amdgcn_cosf(ff);
    p.ropes[i] = __builtin_amdgcn_sinf(ff);
  }
  for (int i = gt; i < 512; i += ng) {
    float h0 = p.hg_lb[i], h1 = p.hg_lb[512 + i];
    p.lb[i] = 0.f;
    p.lb[512 + i] = 1.f / (1.f + __expf(h0 - h1));
  }
}

constexpr int G_STAGE = 32768;

template <bool AF32, class RowFn, class Epi>
DI void gemm_tile(RowFn rowfn, const u16* __restrict__ Bt, int K, Epi epi, char* lds, int tid) {
  const int lane = tid & 63, wid = tid >> 6, wr = wid >> 1, wc = wid & 1, fr = lane & 15, fq = lane >> 4;
  f32x4 acc[4][4];
#pragma unroll
  for (int m = 0; m < 4; m++)
#pragma unroll
    for (int n = 0; n < 4; n++) acc[m][n] = f32x4{0.f, 0.f, 0.f, 0.f};

  const int lrow = tid >> 3;
  const int lc = (tid & 7) ^ ((tid >> 4) & 7);
  const float* apf[8];
  const u16* aph[4];
  const u16* bp[4];
  if constexpr (AF32) {
#pragma unroll
    for (int i = 0; i < 8; i++) apf[i] = (const float*)rowfn(i * 16 + (tid >> 4)) + (tid & 15) * 4;
  } else {
#pragma unroll
    for (int i = 0; i < 4; i++) aph[i] = (const u16*)rowfn(lrow + i * 32) + lc * 8;
  }
#pragma unroll
  for (int i = 0; i < 4; i++) bp[i] = Bt + (size_t)(lrow + i * 32) * K + lc * 8;
  const int afoff = (tid >> 4) * 128 + ((((tid & 15) >> 1) ^ ((tid >> 5) & 7)) * 16) + (tid & 1) * 8;

  float4 raf[8];
  auto issue = [&](int buf, int k0) {
    char* A = lds + buf * G_STAGE;
    char* B = A + 16384;
#pragma unroll
    for (int i = 0; i < 4; i++)
      __builtin_amdgcn_global_load_lds((const unsigned*)(bp[i] + k0), (unsigned*)(B + wid * 1024 + i * 4096), 16, 0, 0);
    if constexpr (AF32) {
#pragma unroll
      for (int i = 0; i < 8; i++) raf[i] = *(const float4*)(apf[i] + k0);
    } else {
#pragma unroll
      for (int i = 0; i < 4; i++)
        __builtin_amdgcn_global_load_lds((const unsigned*)(aph[i] + k0), (unsigned*)(A + wid * 1024 + i * 4096), 16, 0, 0);
    }
  };
  auto astore = [&](int buf) {
    if constexpr (AF32) {
      char* A = lds + buf * G_STAGE;
#pragma unroll
      for (int i = 0; i < 8; i++) asm volatile("" : "+v"(raf[i].x), "+v"(raf[i].y), "+v"(raf[i].z), "+v"(raf[i].w));
#pragma unroll
      for (int i = 0; i < 8; i++)
        *(uint2*)(A + afoff + i * 2048) = make_uint2(pack2(raf[i].x, raf[i].y), pack2(raf[i].z, raf[i].w));
    }
  };
  const int abase = (wr * 64 + fr) * 128, bbase = 16384 + (wc * 64 + fr) * 128;
  const int sw0 = ((fq) ^ (fr >> 1)) * 16, sw1 = ((4 + fq) ^ (fr >> 1)) * 16;

  const int nk = K >> 6;
  issue(0, 0);
  astore(0);
  __syncthreads();
  for (int kt = 0; kt < nk; kt++) {
    if (kt + 1 < nk) issue((kt + 1) & 1, (kt + 1) << 6);
    __builtin_amdgcn_sched_barrier(0);
    const char* S = lds + (kt & 1) * G_STAGE;
    bf16x8 af[2][4], bfr[2][4];
#pragma unroll
    for (int kk = 0; kk < 2; kk++) {
      const int sw = kk ? sw1 : sw0;
#pragma unroll
      for (int m = 0; m < 4; m++) af[kk][m] = *(const bf16x8*)(S + abase + m * 2048 + sw);
#pragma unroll
      for (int n = 0; n < 4; n++) bfr[kk][n] = *(const bf16x8*)(S + bbase + n * 2048 + sw);
    }
    __builtin_amdgcn_sched_barrier(0);
#pragma unroll
    for (int kk = 0; kk < 2; kk++)
#pragma unroll
      for (int m = 0; m < 4; m++)
#pragma unroll
        for (int n = 0; n < 4; n++) acc[m][n] = __builtin_amdgcn_mfma_f32_16x16x32_bf16(bfr[kk][n], af[kk][m], acc[m][n], 0, 0, 0);
    __builtin_amdgcn_sched_barrier(0);
    if (kt + 1 < nk) astore((kt + 1) & 1);
    __syncthreads();
  }
  epi(acc, wr * 64 + fr, wc * 64 + fq * 4);
}

#define EPI_LOOP(...)                                    \
  _Pragma("unroll") for (int m = 0; m < 4; m++)          \
  _Pragma("unroll") for (int n = 0; n < 4; n++) {        \
    const int row = rbase + m * 16;                      \
    const int col = cbase + n * 16;                      \
    const f32x4 v = acc[m][n];                           \
    __VA_ARGS__                                          \
  }

DI void st_bf4(u16* dst, f32x4 v) { *(uint2*)dst = make_uint2(pack2(v[0], v[1]), pack2(v[2], v[3])); }

DI const float* xin_row(const Params& p, int l, int tg) {
  if (l == 0) return tg < 32768 ? p.x_prompt + (size_t)tg * 1024 : p.x_sample + (size_t)(tg - 32768) * 1024;
  return p.out + (size_t)tg * 1024;
}

DI void phase_inproj(const Params& p, int l, int tok0, char* lds, int bid, int nb, int tid) {
  const int NT = 29, MT = T_SUB / 128;
  for (int it = 0;; it++) {
    int nt, mt;
    if (!xcd_tile(it, bid, nb, MT, NT, mt, nt)) break;
    int m0 = mt * 128, n0 = nt * 128;
    auto rowfn = [&](int r) -> const void* { return p.xb + (size_t)(tok0 + m0 + r) * 1024; };
    u16* z = p.z;
    auto epi = [&](f32x4(&acc)[4][4], int rbase, int cbase) {
      EPI_LOOP({
        int c = n0 + col;
        if (c < ZLD) st_bf4(z + (size_t)(m0 + row) * ZLD + c, v);
      })
    };
    gemm_tile<false>(rowfn, p.w_in_t + ((size_t)l * 3712 + n0) * 1024, 1024, epi, lds, tid);
  }
}

DI void phase_prep(const Params& p, int l, int N, int bid, int nb, int tid) {
  const int lane = tid & 63, wv = tid >> 6, l15 = lane & 15, c4 = lane * 4;
  float gqv[4], gkvv[2], lbv[8], m0[12], m1[12], m0s[6], m1s[6], kkc[4], rkc[4];
  {
    const float* mu0 = p.rw_mu + (size_t)l * 2 * 1152;
    const float* mu1 = mu0 + 1152;
#pragma unroll
    for (int j = 0; j < 4; j++) {
      gqv[j] = p.mla_gq[l * 256 + c4 + j];
      kkc[j] = p.rw_kk[l * 256 + c4 + j];
      rkc[j] = p.rw_rk[l * 256 + c4 + j];
    }
    gkvv[0] = p.mla_gkv[l * 128 + lane * 2];
    gkvv[1] = p.mla_gkv[l * 128 + lane * 2 + 1];
#pragma unroll
    for (int j = 0; j < 8; j++) lbv[j] = p.lb[l * 512 + lane * 8 + j];
#pragma unroll
    for (int part = 0; part < 3; part++)
#pragma unroll
      for (int j = 0; j < 4; j++) {
        m0[part * 4 + j] = mu0[part * 256 + c4 + j];
        m1[part * 4 + j] = mu1[part * 256 + c4 + j];
      }
#pragma unroll
    for (int i = 0; i < 6; i++) {
      m0s[i] = mu0[768 + lane + 64 * i];
      m1s[i] = mu1[768 + lane + 64 * i];
    }
  }
  for (int t = bid * 4 + wv; t < T_SUB; t += nb * 4) {
    u16* zr = p.z + (size_t)t * ZLD;
    const int n = t & (N - 1);
    const bool hp = n > 0, hn = n < N - 1;
    const u16* zd = zr + ZD_OFF;
    const u16* zdp = zd - (hp ? ZLD : 0);
    const u16* zdn = zd + (hn ? ZLD : 0);
    const uint2 raw_cq = *(const uint2*)(zr + c4);
    const unsigned raw_ckv = *(const unsigned*)(zr + 256 + lane * 2);
    const u16 kr1 = zr[384 + l15], kr2 = zr[400 + l15];
    const float rc = p.ropec[n * 16 + l15], rsn = p.ropes[n * 16 + l15];
    uint4* fptr = (uint4*)(zr + ZC_OFF + 256 + lane * 8);
    const uint4 raw_f = *fptr;
    uint2 cur[3], prv[3], nxt[3];
#pragma unroll
    for (int part = 0; part < 3; part++) {
      cur[part] = *(const uint2*)(zd + part * 256 + c4);
      prv[part] = *(const uint2*)(zdp + part * 256 + c4);
      nxt[part] = *(const uint2*)(zdn + part * 256 + c4);
    }
    u16 sc[6], sp[6], sn[6];
#pragma unroll
    for (int i = 0; i < 6; i++) {
      sc[i] = zd[768 + lane + 64 * i];
      sp[i] = zdp[768 + lane + 64 * i];
      sn[i] = zdn[768 + lane + 64 * i];
    }
    {
      float v0 = blo(raw_cq.x), v1 = bhi(raw_cq.x), v2 = blo(raw_cq.y), v3 = bhi(raw_cq.y);
      float ss = wave_sum(v0 * v0 + v1 * v1 + v2 * v2 + v3 * v3);
      float ri = rsqrtf(ss * (1.f / 256.f) + 1e-6f);
      *(uint2*)(p.cqn + (size_t)t * 256 + c4) =
          make_uint2(pack2(v0 * ri * gqv[0], v1 * ri * gqv[1]), pack2(v2 * ri * gqv[2], v3 * ri * gqv[3]));
    }
    {
      float v0 = blo(raw_ckv), v1 = bhi(raw_ckv);
      float ss = wave_sum(v0 * v0 + v1 * v1);
      float ri = rsqrtf(ss * (1.f / 128.f) + 1e-6f);
      *(unsigned*)(p.ckvn + (size_t)t * 128 + lane * 2) = pack2(v0 * ri * gkvv[0], v1 * ri * gkvv[1]);
    }
    if (lane < 16) {
      float x1 = bf2f(kr1), x2 = bf2f(kr2);
      u16 k1 = f2bf(x1 * rc - x2 * rsn), k2 = f2bf(x1 * rsn + x2 * rc);
      u16* kb = p.Kb + (size_t)t * 384;
#pragma unroll
      for (int h = 0; h < 4; h++) {
        kb[h * 96 + 64 + lane] = k1;
        kb[h * 96 + 80 + lane] = k2;
      }
    }
    {
      unsigned w[4] = {raw_f.x, raw_f.y, raw_f.z, raw_f.w};
#pragma unroll
      for (int j = 0; j < 4; j++) {
        float a = blo(w[j]), bq = bhi(w[j]);
        float la = lbv[2 * j], lb2 = lbv[2 * j + 1];
        a = la + (1.f - la) * sigm(a);
        bq = lb2 + (1.f - lb2) * sigm(bq);
        w[j] = pack2(a, bq);
      }
      *fptr = make_uint4(w[0], w[1], w[2], w[3]);
    }
    {
      float rr[4], kx[4], vx[4];
#pragma unroll
      for (int part = 0; part < 3; part++) {
        float cz[4] = {blo(cur[part].x), bhi(cur[part].x), blo(cur[part].y), bhi(cur[part].y)};
        float pz[4] = {blo(prv[part].x), bhi(prv[part].x), blo(prv[part].y), bhi(prv[part].y)};
        float nz[4] = {blo(nxt[part].x), bhi(nxt[part].x), blo(nxt[part].y), bhi(nxt[part].y)};
#pragma unroll
        for (int j = 0; j < 4; j++) {
          float pzz = hp ? pz[j] : 0.f, nzz = hn ? nz[j] : 0.f;
          float o = cz[j] + m0[part * 4 + j] * (pzz - cz[j]) + m1[part * 4 + j] * (nzz - cz[j]);
          if (part == 0) rr[j] = o;
          if (part == 1) kx[j] = o;
          if (part == 2) vx[j] = o;
        }
      }
      *(uint2*)(p.rs + (size_t)t * 256 + c4) = make_uint2(pack2(rr[0], rr[1]), pack2(rr[2], rr[3]));
      *(uint2*)(p.ks + (size_t)t * 256 + c4) = make_uint2(pack2(kx[0], kx[1]), pack2(kx[2], kx[3]));
      *(uint2*)(p.vs + (size_t)t * 256 + c4) = make_uint2(pack2(vx[0], vx[1]), pack2(vx[2], vx[3]));
      float kq[4], ss = 0.f, bo = 0.f;
#pragma unroll
      for (int j = 0; j < 4; j++) {
        kq[j] = kx[j] * kkc[j];
        ss += kq[j] * kq[j];
        bo += rr[j] * kx[j] * rkc[j];
      }
      ss = reduce16(ss);
      bo = reduce16(bo);
      float inv = 1.f / fmaxf(sqrtf(ss), 1e-12f);
      *(uint2*)(p.kk + (size_t)t * 256 + c4) = make_uint2(pack2(kq[0] * inv, kq[1] * inv), pack2(kq[2] * inv, kq[3] * inv));
      if (l15 == 0) p.bonus[(size_t)t * 4 + (lane >> 4)] = bo;
#pragma unroll
      for (int i = 0; i < 6; i++) {
        float cz = bf2f(sc[i]);
        float pz = hp ? bf2f(sp[i]) : 0.f;
        float nz = hn ? bf2f(sn[i]) : 0.f;
        float o = cz + m0s[i] * (pz - cz) + m1s[i] * (nz - cz);
        if (i < 2) o = tanh_(o);
        else if (i >= 4) o = sigm(o);
        p.S1[(size_t)t * 384 + lane + 64 * i] = f2bf(o);
      }
    }
  }
}

DI void phase_smallgemm(const Params& p, int l, int B, int N, char* lds, int bid, int nb, int tid) {
  TileIter it{bid, nb, 0};
  const int MT = T_SUB / 128;
  {
    const int NT = 3;
    for (int itx = 0;; itx++) {
      int nt, mt;
      if (!xcd_tile(itx, bid, nb, MT, NT, mt, nt)) break;
      int m0 = mt * 128, n0 = nt * 128;
      auto rowfn = [&](int r) -> const void* { return p.cqn + (size_t)(m0 + r) * 256; };
      u16* Q = p.Q;
      auto epi = [&](f32x4(&acc)[4][4], int rbase, int cbase) {
        const float SC = 0.10206207261596577f * LOG2E;
        EPI_LOOP({ st_bf4(Q + (size_t)(m0 + row) * 384 + n0 + col, v * SC); })
      };
      gemm_tile<false>(rowfn, p.wuq_t + ((size_t)l * 384 + n0) * 256, 256, epi, lds, tid);
    }
  }
  {
    const int NT = 4;
    for (int itx = 0;; itx++) {
      int nt, mt;
      if (!xcd_tile(itx, bid, nb, MT, NT, mt, nt)) break;
      int m0 = mt * 128, n0 = nt * 128;
      auto rowfn = [&](int r) -> const void* { return p.ckvn + (size_t)(m0 + r) * 128; };
      u16* Kb = p.Kb;
      u16* Vt = p.Vt;
      auto epi = [&](f32x4(&acc)[4][4], int rbase, int cbase) {
        EPI_LOOP({
          int c = n0 + col;
          int tk = m0 + row;
          if (c < 256) {
            int h = c >> 6, d = c & 63;
            st_bf4(Kb + (size_t)tk * 384 + h * 96 + d, v);
          } else {
            int cc = c - 256;
            int b = tk / N, nn = tk - b * N;
            u16* dst = Vt + ((size_t)(b * 256 + cc)) * N + nn;
            dst[0] = f2bf(v[0]);
            dst[(size_t)N] = f2bf(v[1]);
            dst[(size_t)2 * N] = f2bf(v[2]);
            dst[(size_t)3 * N] = f2bf(v[3]);
          }
        })
      };
      gemm_tile<false>(rowfn, p.wkv_t + ((size_t)l * 512 + n0) * 128, 128, epi, lds, tid);
    }
  }
  for (int d = 0; d < 2; d++) {
    const int NT = 2;
    for (int itx = 0;; itx++) {
      int nt, mt;
      if (!xcd_tile(itx, bid, nb, MT, NT, mt, nt)) break;
      int m0 = mt * 128, n0 = nt * 128;
      auto rowfn = [&](int r) -> const void* { return p.S1 + (size_t)(m0 + r) * 384 + d * 64; };
      u16* dst = p.dec + (size_t)d * T_SUB * 256;
      const float* w0 = p.rw_w0 + (l * 2 + d) * 256;
      auto epi = [&](f32x4(&acc)[4][4], int rbase, int cbase) {
        EPI_LOOP({
          f32x4 o;
          for (int j = 0; j < 4; j++) o[j] = __expf(-0.6065306597126334f * sigm(w0[n0 + col + j] + v[j]));
          st_bf4(dst + (size_t)(m0 + row) * 256 + n0 + col, o);
        })
      };
      gemm_tile<false>(rowfn, p.wup_t + ((size_t)(l * 2 + d) * 256 + n0) * 64, 64, epi, lds, tid);
    }
  }
  for (int d = 0; d < 2; d++) {
    const int NT = 2;
    for (int itx = 0;; itx++) {
      int nt, mt;
      if (!xcd_tile(itx, bid, nb, MT, NT, mt, nt)) break;
      int m0 = mt * 128, n0 = nt * 128;
      auto rowfn = [&](int r) -> const void* { return p.S1 + (size_t)(m0 + r) * 384 + 128 + d * 64; };
      u16* dka = p.kka + (size_t)d * T_SUB * 256;
      u16* dkt = p.kt + (size_t)d * T_SUB * 256;
      const float* a0 = p.rw_a0 + (l * 2 + d) * 256;
      const float* ka = p.rw_ka + l * 256;
      const u16* kkp = p.kk;
      const u16* ksp = p.ks;
      auto epi = [&](f32x4(&acc)[4][4], int rbase, int cbase) {
        EPI_LOOP({
          size_t o = (size_t)(m0 + row) * 256 + n0 + col;
          uint2 kkr = *(const uint2*)(kkp + o);
          uint2 ksr = *(const uint2*)(ksp + o);
          float kkv[4] = {blo(kkr.x), bhi(kkr.x), blo(kkr.y), bhi(kkr.y)};
          float ksv[4] = {blo(ksr.x), bhi(ksr.x), blo(ksr.y), bhi(ksr.y)};
          f32x4 o1, o2;
          for (int j = 0; j < 4; j++) {
            float a = sigm(a0[n0 + col + j] + v[j]);
            o1[j] = kkv[j] * a;
            o2[j] = ksv[j] * (1.f + (a - 1.f) * ka[n0 + col + j]);
          }
          st_bf4(dka + o, o1);
          st_bf4(dkt + o, o2);
        })
      };
      gemm_tile<false>(rowfn, p.aup_t + ((size_t)(l * 2 + d) * 256 + n0) * 64, 64, epi, lds, tid);
    }
  }
  {
    const int NT = 2;
    for (int itx = 0;; itx++) {
      int nt, mt;
      if (!xcd_tile(itx, bid, nb, MT, NT, mt, nt)) break;
      int m0 = mt * 128, n0 = nt * 128;
      auto rowfn = [&](int r) -> const void* { return p.S1 + (size_t)(m0 + r) * 384 + 256; };
      u16* dst = p.gD;
      auto epi = [&](f32x4(&acc)[4][4], int rbase, int cbase) {
        EPI_LOOP({ st_bf4(dst + (size_t)(m0 + row) * 256 + n0 + col, v); })
      };
      gemm_tile<false>(rowfn, p.gup_t + ((size_t)l * 256 + n0) * 128, 128, epi, lds, tid);
    }
  }
}

DI bf16x8 pack8(const f32x16& s, int o) {
  u32x4_t r = {pack2(s[o], s[o + 1]), pack2(s[o + 2], s[o + 3]), pack2(s[o + 4], s[o + 5]), pack2(s[o + 6], s[o + 7])};
  return __builtin_bit_cast(bf16x8, r);
}

constexpr int AT_KP = 208, AT_VP = 144, AT_BUF = 64 * AT_KP + 64 * AT_VP;
DI void attn_task(const Params& p, int task, int N, char* lds, int tid) {
  const int lane = tid & 63, wv = tid >> 6, r = lane & 31, hf = lane >> 5;
  const int nqb = N >> 7;
  {
    const int qb = task % nqb, bh = task / nqb, h = bh & 3, b = bh >> 2;
    const size_t tb = (size_t)b * N;
    const int q = qb * 128 + wv * 32 + r;
    bf16x8 qf[6];
    {
      const u16* qrow = p.Q + (tb + q) * 384 + h * 96;
#pragma unroll
      for (int ks = 0; ks < 4; ks++) qf[ks] = *(const bf16x8*)(qrow + ks * 16 + hf * 8);
      bf16x8 x1r = *(const bf16x8*)(qrow + 64 + hf * 8);
      bf16x8 x2r = *(const bf16x8*)(qrow + 80 + hf * 8);
      const float* cp = p.ropec + q * 16 + hf * 8;
      const float* sp = p.ropes + q * 16 + hf * 8;
      float ra[8], rb[8];
#pragma unroll
      for (int j = 0; j < 8; j++) {
        float xa = bf2f((u16)x1r[j]), ya = bf2f((u16)x2r[j]);
        float c0 = cp[j], s0 = sp[j];
        ra[j] = xa * c0 - ya * s0;
        rb[j] = xa * s0 + ya * c0;
      }
      u32x4_t o1 = {pack2(ra[0], ra[1]), pack2(ra[2], ra[3]), pack2(ra[4], ra[5]), pack2(ra[6], ra[7])};
      u32x4_t o2 = {pack2(rb[0], rb[1]), pack2(rb[2], rb[3]), pack2(rb[4], rb[5]), pack2(rb[6], rb[7])};
      qf[4] = __builtin_bit_cast(bf16x8, o1);
      qf[5] = __builtin_bit_cast(bf16x8, o2);
    }
    const u16* Kg = p.Kb + tb * 384 + h * 96;
    const u16* Vg = p.Vt + ((size_t)(b * 4 + h) * 64) * N;
    uint4 kr0, kr1, kr2, vr0, vr1;
    const int lkey = tid >> 2, lpart = tid & 3;
    const int lrow = swap23(lkey);
#define AT_GLOAD(kt_)                                                              \
  {                                                                                \
    const u16* kp_ = Kg + (size_t)((kt_) * 64 + lkey) * 384 + lpart * 24;          \
    kr0 = *(const uint4*)(kp_);                                                    \
    kr1 = *(const uint4*)(kp_ + 8);                                                \
    kr2 = *(const uint4*)(kp_ + 16);                                               \
    const u16* vp_ = Vg + (size_t)lkey * N + (kt_) * 64 + lpart * 16;              \
    vr0 = *(const uint4*)(vp_);                                                    \
    vr1 = *(const uint4*)(vp_ + 8);                                                \
  }
#define AT_LSTORE(buf_)                                                            \
  {                                                                                \
    char* Kl_ = lds + (buf_) * AT_BUF;                                             \
    char* Vl_ = Kl_ + 64 * AT_KP;                                                  \
    *(uint4*)(Kl_ + lrow * AT_KP + (lpart * 3 + 0) * 16) = kr0;                    \
    *(uint4*)(Kl_ + lrow * AT_KP + (lpart * 3 + 1) * 16) = kr1;                    \
    *(uint4*)(Kl_ + lrow * AT_KP + (lpart * 3 + 2) * 16) = kr2;                    \
    *(uint4*)(Vl_ + lkey * AT_VP + (lpart * 2 + 0) * 16) = vr0;                    \
    *(uint4*)(Vl_ + lkey * AT_VP + (lpart * 2 + 1) * 16) = vr1;                    \
  }
    f32x16 O0, O1;
#pragma unroll
    for (int i = 0; i < 16; i++) { O0[i] = 0.f; O1[i] = 0.f; }
    float mrun = 0.f, lrun = 0.f;
    const int nt = N >> 6;
    __syncthreads();
    AT_GLOAD(0);
    AT_LSTORE(0);
    __syncthreads();
    for (int kt = 0; kt < nt; kt++) {
      if (kt + 1 < nt) AT_GLOAD(kt + 1);
      __builtin_amdgcn_sched_barrier(0);
      const char* Kl = lds + (kt & 1) * AT_BUF;
      const char* Vl = Kl + 64 * AT_KP;
      f32x16 S0, S1;
      {
        const float nm = -mrun;
#pragma unroll
        for (int i = 0; i < 16; i++) { S0[i] = nm; S1[i] = nm; }
      }
#pragma unroll
      for (int ks = 0; ks < 6; ks++) {
        bf16x8 a0 = *(const bf16x8*)(Kl + r * AT_KP + ks * 32 + hf * 16);
        bf16x8 a1 = *(const bf16x8*)(Kl + (32 + r) * AT_KP + ks * 32 + hf * 16);
        S0 = __builtin_amdgcn_mfma_f32_32x32x16_bf16(a0, qf[ks], S0, 0, 0, 0);
        S1 = __builtin_amdgcn_mfma_f32_32x32x16_bf16(a1, qf[ks], S1, 0, 0, 0);
      }
      float mx = fmaxf(S0[0], S1[0]);
#pragma unroll
      for (int i = 1; i < 16; i++) mx = fmaxf(mx, fmaxf(S0[i], S1[i]));
      if (__any((mx > 12.f) || (kt == 0))) {
        const float mq = fmaxf(mx, __shfl_xor(mx, 32));
        const float shift = (kt == 0) ? mq : ((mq > 12.f) ? mq : 0.f);
        const float sc = (kt == 0) ? 1.f : ex2(-shift);
        mrun += shift;
        lrun *= sc;
#pragma unroll
        for (int i = 0; i < 16; i++) {
          S0[i] -= shift;
          S1[i] -= shift;
          O0[i] *= sc;
          O1[i] *= sc;
        }
      }
      float ls = 0.f;
#pragma unroll
      for (int i = 0; i < 16; i++) {
        S0[i] = ex2(S0[i]);
        S1[i] = ex2(S1[i]);
        ls += S0[i] + S1[i];
      }
      lrun += ls;
#pragma unroll
      for (int sp = 0; sp < 4; sp++) {
        bf16x8 pb = (sp < 2) ? pack8(S0, (sp & 1) * 8) : pack8(S1, (sp & 1) * 8);
        bf16x8 v0 = *(const bf16x8*)(Vl + r * AT_VP + sp * 32 + hf * 16);
        bf16x8 v1 = *(const bf16x8*)(Vl + (32 + r) * AT_VP + sp * 32 + hf * 16);
        O0 = __builtin_amdgcn_mfma_f32_32x32x16_bf16(v0, pb, O0, 0, 0, 0);
        O1 = __builtin_amdgcn_mfma_f32_32x32x16_bf16(v1, pb, O1, 0, 0, 0);
      }
      __builtin_amdgcn_sched_barrier(0);
      if (kt + 1 < nt) AT_LSTORE((kt + 1) & 1);
      __syncthreads();
    }
    float lt = lrun + __shfl_xor(lrun, 32);
    float inv = 1.f / lt;
    u16* orow = p.cat + (tb + q) * 1024 + h * 64;
#pragma unroll
    for (int g = 0; g < 4; g++) {
      int d0 = 8 * g + 4 * hf;
      *(uint2*)(orow + d0) = make_uint2(pack2(O0[4 * g] * inv, O0[4 * g + 1] * inv), pack2(O0[4 * g + 2] * inv, O0[4 * g + 3] * inv));
      *(uint2*)(orow + 32 + d0) = make_uint2(pack2(O1[4 * g] * inv, O1[4 * g + 1] * inv), pack2(O1[4 * g + 2] * inv, O1[4 * g + 3] * inv));
    }
  }
}

DI void na_task(const Params& p, int l, int task, int N, int tid) {
  const int lane = tid & 63, head = tid >> 6, r = lane & 31, hf = lane >> 5;
  const int rows = N >> 6;
  const int nrb = rows >> 1;
  const float* bias = p.na_bias + (size_t)(l * 4 + head) * 15 * 31;
  {
    const int cb = task & 3, rb = (task >> 2) % nrb, b = (task >> 2) / nrb;
    const size_t tb = (size_t)b * N;
    const int qrow0 = rb * 2;
    const int rstart0 = clampi(qrow0 - 4, 0, rows - 8);
    const int k0 = clampi(rstart0, 0, rows - 9);
    const int kstart = clampi(cb * 16 - 8, 0, 32);
    const int iq = r >> 4, u = r & 15;
    const int qrow = qrow0 + iq, qcol = cb * 16 + u;
    const int rstart = clampi(qrow - 4, 0, rows - 8);
    const int cstart = clampi(qcol - 8, 0, 48);
    bf16x8 qf[4];
    {
      const u16* qp = p.z + (tb + qrow * 64 + qcol) * ZLD + ZB_OFF + head * 64;
#pragma unroll
      for (int ks = 0; ks < 4; ks++) qf[ks] = *(const bf16x8*)(qp + ks * 16 + hf * 8);
    }
    f32x16 O0, O1;
#pragma unroll
    for (int i = 0; i < 16; i++) { O0[i] = 0.f; O1[i] = 0.f; }
    float mrun = -1e30f, lrun = 0.f;
    const int wk = swap23(r);
    for (int j = 0; j < 9; j++) {
      const int krow = k0 + j;
      const u16* kp = p.z + (tb + krow * 64 + kstart + wk) * ZLD + ZB_OFF + 256 + head * 64;
      f32x16 S;
#pragma unroll
      for (int i = 0; i < 16; i++) S[i] = 0.f;
#pragma unroll
      for (int ks = 0; ks < 4; ks++) {
        bf16x8 a = *(const bf16x8*)(kp + ks * 16 + hf * 8);
        S = __builtin_amdgcn_mfma_f32_32x32x16_bf16(a, qf[ks], S, 0, 0, 0);
      }
      const bool rok = (krow >= rstart) && (krow < rstart + 8);
      const int drow = clampi(krow - qrow + 7, 0, 14);
      const float* brow = bias + drow * 31;
      float mx = -1e30f;
#pragma unroll
      for (int i = 0; i < 16; i++) {
        int w = 16 * (i >> 3) + 8 * hf + 4 * ((i >> 2) & 1) + (i & 3);
        int kcol = kstart + w;
        bool ok = rok && (kcol >= cstart) && (kcol < cstart + 16);
        int dcol = clampi(kcol - qcol + 15, 0, 30);
        float s = (S[i] * 0.125f + brow[dcol]) * LOG2E;
        S[i] = ok ? s : -1e30f;
        mx = fmaxf(mx, S[i]);
      }
      mx = fmaxf(mx, __shfl_xor(mx, 32));
      float mn = fmaxf(mrun, mx);
      float alpha = ex2(mrun - mn);
      mrun = mn;
      float ls = 0.f;
#pragma unroll
      for (int i = 0; i < 16; i++) {
        float pv = (S[i] > -1e29f) ? ex2(S[i] - mn) : 0.f;
        S[i] = pv;
        ls += pv;
      }
      lrun = lrun * alpha + ls;
#pragma unroll
      for (int i = 0; i < 16; i++) { O0[i] *= alpha; O1[i] *= alpha; }
      const u16* vbase = p.z + (tb + krow * 64 + kstart) * ZLD + ZB_OFF + 512 + head * 64 + r;
#pragma unroll
      for (int s = 0; s < 2; s++) {
        bf16x8 pb = pack8(S, s * 8);
        bf16x8 v0, v1;
#pragma unroll
        for (int jj = 0; jj < 8; jj++) {
          const u16* vp = vbase + (size_t)(16 * s + 8 * hf + jj) * ZLD;
          v0[jj] = (short)vp[0];
          v1[jj] = (short)vp[32];
        }
        O0 = __builtin_amdgcn_mfma_f32_32x32x16_bf16(v0, pb, O0, 0, 0, 0);
        O1 = __builtin_amdgcn_mfma_f32_32x32x16_bf16(v1, pb, O1, 0, 0, 0);
      }
    }
    float lt = lrun + __shfl_xor(lrun, 32);
    float inv = 1.f / lt;
    u16* orow = p.cat + (tb + qrow * 64 + qcol) * 1024 + 256 + head * 64;
#pragma unroll
    for (int g = 0; g < 4; g++) {
      int d0 = 8 * g + 4 * hf;
      *(uint2*)(orow + d0) = make_uint2(pack2(O0[4 * g] * inv, O0[4 * g + 1] * inv), pack2(O0[4 * g + 2] * inv, O0[4 * g + 3] * inv));
      *(uint2*)(orow + 32 + d0) = make_uint2(pack2(O1[4 * g] * inv, O1[4 * g + 1] * inv), pack2(O1[4 * g + 2] * inv, O1[4 * g + 3] * inv));
    }
  }
}

using f32x2 = __attribute__((ext_vector_type(2))) float;
constexpr int SC_STEPS = 16;

DI void sc_store(char* buf, int dst, uint4 R, bool hgw) {
  float4 lo = make_float4(blo(R.x), bhi(R.x), blo(R.y), bhi(R.y));
  float4 hi = make_float4(blo(R.z), bhi(R.z), blo(R.w), bhi(R.w));
  *(float4*)(buf + dst) = lo;
  *(float4*)(buf + dst + 16) = hi;
  if (hgw) {
    *(float4*)(buf + dst + 256) = make_float4(1.f - lo.x, 1.f - lo.y, 1.f - lo.z, 1.f - lo.w);
    *(float4*)(buf + dst + 272) = make_float4(1.f - hi.x, 1.f - hi.y, 1.f - hi.z, 1.f - hi.w);
  }
}

DI float reduce8(float v) {
  v += dpp_f<0xB1>(v);
  v += dpp_f<0x4E>(v);
  v += dpp_f<0x141>(v);
  return v;
}

template <bool RW>
DI void scan_task(const Params& p, int task, int N, char* lds, int tid) {
  constexpr int NA = RW ? 5 : 3;
  constexpr int VOFF = SC_STEPS * NA * 256;
  constexpr int BUF = VOFF + SC_STEPS * 128;
  const int lane = tid & 63, wv = tid >> 6, kq = lane & 7, rg = lane >> 3;
  const int rq = task & 1, hh = (task >> 1) & 3, dir = (task >> 3) & 1, b = task >> 4;
  const size_t tb = (size_t)b * N;
  const int sub = tid >> 7, lt = tid & 127, lstep = lt >> 3, lpart = lt & 7;
  const int vstep = lt >> 2, vq = lt & 3;
  const u16 *src0 = nullptr, *src1 = nullptr, *src2 = nullptr;
  int dst0 = 0, dst1 = 0, dst2 = 0, st0 = 0, st1 = 0, st2 = 0;
  bool act0 = false, act1 = false, act2 = false, hgw = false;
  int ld;
  const int acol = hh * 64 + lpart * 8;
  const int vcol = hh * 64 + rq * 32 + vq * 8;
  const int vdst = VOFF + vstep * 128 + vq * 32;
  if (RW) {
    ld = 256;
    act0 = true; st0 = lstep;
    src0 = sub ? (p.dec + (size_t)dir * T_SUB * 256 + acol) : (p.rs + acol);
    dst0 = (lstep * NA + (sub ? 1 : 0)) * 256 + lpart * 32;
    act1 = true; st1 = lstep;
    src1 = sub ? (p.kk + acol) : (p.kt + (size_t)dir * T_SUB * 256 + acol);
    dst1 = (lstep * NA + (sub ? 3 : 2)) * 256 + lpart * 32;
    if (sub == 0) { act2 = true; st2 = lstep; src2 = p.kka + (size_t)dir * T_SUB * 256 + acol; dst2 = (lstep * NA + 4) * 256 + lpart * 32; }
    else { act2 = lt < 64; st2 = vstep; src2 = p.vs + vcol; dst2 = vdst; }
  } else {
    ld = ZLD;
    act0 = true; st0 = lstep;
    src0 = sub ? (p.z + ZC_OFF + 256 * (1 + dir) + acol) : (p.z + ZC_OFF + acol);
    dst0 = (lstep * NA + (sub ? 1 : 0)) * 256 + lpart * 32;
    hgw = sub != 0;
    if (sub == 0) { act1 = lt < 64; st1 = vstep; src1 = p.z + ZC_OFF + 768 + vcol; dst1 = vdst; }
  }
  u16* pout = (RW ? p.oD : p.oC) + (size_t)dir * T_SUB * 256 + hh * 64 + rq * 32 + wv * 8 + rg;
  pout += (tb + (dir ? (N - 1) : 0)) * 256;
  const int ostride = dir ? -256 : 256;

#define SC_TOK(c_, st_) (tb + (size_t)(dir ? (N - 1 - ((c_) * SC_STEPS + (st_))) : ((c_) * SC_STEPS + (st_))))
#define SC_ISSUE(Ra, Rb, Rc, c_)                                               \
  {                                                                            \
    if (act0) Ra = *(const uint4*)(src0 + SC_TOK(c_, st0) * ld);               \
    if (act1) Rb = *(const uint4*)(src1 + SC_TOK(c_, st1) * ld);               \
    if (act2) Rc = *(const uint4*)(src2 + SC_TOK(c_, st2) * ld);               \
  }
#define SC_STORE(Ra, Rb, Rc, buf_)                                             \
  {                                                                            \
    if (act0) sc_store(buf_, dst0, Ra, hgw);                                   \
    if (act1) sc_store(buf_, dst1, Rb, false);                                 \
    if (act2) sc_store(buf_, dst2, Rc, false);                                 \
  }
  f32x2 S0 = {0.f, 0.f}, S1 = {0.f, 0.f}, S2 = {0.f, 0.f}, S3 = {0.f, 0.f};
#define SC_LD(buf_, s_, ra_, rb_, wa_, wb_, ta_, tb_, ka_, kb_, aa_, ab_, v_)                \
  {                                                                                          \
    const char* rowp_ = (buf_) + (s_) * NA * 256 + kq * 32;                                  \
    ra_ = *(const float4*)(rowp_);                                                           \
    rb_ = *(const float4*)(rowp_ + 16);                                                      \
    wa_ = *(const float4*)(rowp_ + 256);                                                     \
    wb_ = *(const float4*)(rowp_ + 272);                                                     \
    ta_ = *(const float4*)(rowp_ + 512);                                                     \
    tb_ = *(const float4*)(rowp_ + 528);                                                     \
    if (RW) {                                                                                \
      ka_ = *(const float4*)(rowp_ + 768);                                                   \
      kb_ = *(const float4*)(rowp_ + 784);                                                   \
      aa_ = *(const float4*)(rowp_ + 1024);                                                  \
      ab_ = *(const float4*)(rowp_ + 1040);                                                  \
    }                                                                                        \
    v_ = *(const float*)((buf_) + VOFF + (s_) * 128 + (wv * 8 + rg) * 4);                    \
  }
#define F2A(q_) f32x2{(q_).x, (q_).y}
#define F2B(q_) f32x2{(q_).z, (q_).w}
#define SC_COMPUTE(buf_)                                                                     \
  {                                                                                          \
    float oselA = 0.f, oselB = 0.f;                                                          \
    float4 ra, rb, wa, wb, ta, tb_, ka, kb, aa, ab, nra, nrb, nwa, nwb, nta, ntb, nka, nkb, naa, nab; \
    float vv, nvv;                                                                           \
    ka = kb = aa = ab = nka = nkb = naa = nab = make_float4(0.f, 0.f, 0.f, 0.f);             \
    SC_LD(buf_, 0, ra, rb, wa, wb, ta, tb_, ka, kb, aa, ab, vv);                             \
    _Pragma("unroll") for (int s = 0; s < SC_STEPS; s++) {                                   \
      if (s + 1 < SC_STEPS) SC_LD(buf_, s + 1, nra, nrb, nwa, nwb, nta, ntb, nka, nkb, naa, nab, nvv); \
      f32x2 u0 = F2A(ta) * vv, u1 = F2B(ta) * vv, u2 = F2A(tb_) * vv, u3 = F2B(tb_) * vv;     \
      if (RW) {                                                                              \
        f32x2 pa = S0 * F2A(ka), pb = S1 * F2B(ka);                                          \
        pa = S2 * F2A(kb) + pa;                                                              \
        pb = S3 * F2B(kb) + pb;                                                              \
        pa = pa + pb;                                                                        \
        const float sa = -reduce8(pa.x + pa.y);                                              \
        u0 = F2A(aa) * sa + u0;                                                              \
        u1 = F2B(aa) * sa + u1;                                                              \
        u2 = F2A(ab) * sa + u2;                                                              \
        u3 = F2B(ab) * sa + u3;                                                              \
      }                                                                                      \
      S0 = S0 * F2A(wa) + u0;                                                                \
      S1 = S1 * F2B(wa) + u1;                                                                \
      S2 = S2 * F2A(wb) + u2;                                                                \
      S3 = S3 * F2B(wb) + u3;                                                                \
      f32x2 qa = S0 * F2A(ra), qb = S1 * F2B(ra);                                            \
      qa = S2 * F2A(rb) + qa;                                                                \
      qb = S3 * F2B(rb) + qb;                                                                \
      qa = qa + qb;                                                                          \
      const float o = reduce8(qa.x + qa.y);                                                  \
      if (s < 8) oselA = (kq == s) ? o : oselA;                                              \
      else oselB = (kq == s - 8) ? o : oselB;                                                \
      ra = nra; rb = nrb; wa = nwa; wb = nwb; ta = nta; tb_ = ntb;                           \
      ka = nka; kb = nkb; aa = naa; ab = nab; vv = nvv;                                      \
    }                                                                                        \
    pout[kq * ostride] = f2bf(oselA);                                                        \
    pout[(kq + 8) * ostride] = f2bf(oselB);                                                  \
    pout += SC_STEPS * ostride;                                                              \
  }
  uint4 A0 = make_uint4(0, 0, 0, 0), A1 = A0, A2 = A0, B0 = A0, B1 = A0, B2 = A0;
  char* buf0 = lds;
  char* buf1 = lds + BUF;
  const int nch = N / SC_STEPS;
  __syncthreads();
  SC_ISSUE(A0, A1, A2, 0);
  SC_ISSUE(B0, B1, B2, 1);
  SC_STORE(A0, A1, A2, buf0);
  __syncthreads();
  for (int c = 0; c < nch; c += 2) {
    if (c + 2 < nch) SC_ISSUE(A0, A1, A2, c + 2);
    __builtin_amdgcn_sched_barrier(0);
    SC_COMPUTE(buf0);
    __builtin_amdgcn_sched_barrier(0);
    SC_STORE(B0, B1, B2, buf1);
    __syncthreads();
    if (c + 3 < nch) SC_ISSUE(B0, B1, B2, c + 3);
    __builtin_amdgcn_sched_barrier(0);
    SC_COMPUTE(buf1);
    __builtin_amdgcn_sched_barrier(0);
    if (c + 2 < nch) SC_STORE(A0, A1, A2, buf0);
    __syncthreads();
  }
}

DI void phase_mix(const Params& p, int l, int B, int N, unsigned* ctr, char* lds, int bid, int nb, int tid) {
  __shared__ int s_task[2];
  const int nper = B * 16;
  const int nscan = 2 * nper;
  const int nattn = B * 4 * (N >> 7);
  const int nna = B * (N >> 7) * 4;
  const bool prefer_scan = bid < (nb >> 1);
  bool scan_dry = false, attn_dry = false;
  for (;;) {
    if (tid == 0) {
      int kind = -1, task = 0;
      for (int attempt = 0; attempt < 2 && kind < 0; attempt++) {
        const bool try_scan = (attempt == 0) == prefer_scan;
        if (try_scan) {
          if (!scan_dry) {
            const int t = (int)atomicAdd(&ctr[0], 1u);
            if (t < nscan) { kind = 0; task = t; } else scan_dry = true;
          }
        } else {
          if (!attn_dry) {
            const int t = (int)atomicAdd(&ctr[64], 1u);
            if (t < nattn + nna) { kind = 1; task = t; } else attn_dry = true;
          }
        }
      }
      s_task[0] = kind;
      s_task[1] = task;
    }
    __syncthreads();
    const int kind = s_task[0], task = s_task[1];
    __syncthreads();
    if (kind < 0) break;
    if (kind == 0) {
      if (task < nper) scan_task<true>(p, task, N, lds, tid);
      else scan_task<false>(p, task - nper, N, lds, tid);
    } else {
      if (task < nattn) attn_task(p, task, N, lds, tid);
      else na_task(p, l, task - nattn, N, tid);
    }
  }
}

DI void phase_final(const Params& p, int l, int bid, int nb, int tid) {
  const int lane = tid & 63, wv = tid >> 6, c4 = lane * 4;
  float gn[4], lw[4], lbb[4];
#pragma unroll
  for (int j = 0; j < 4; j++) {
    gn[j] = p.hg_gnorm[l * 256 + c4 + j];
    lw[j] = p.rw_ln_w[l * 256 + c4 + j];
    lbb[j] = p.rw_ln_b[l * 256 + c4 + j];
  }
  for (int t = bid * 4 + wv; t < T_SUB; t += nb * 4) {
    const uint2 ca = *(const uint2*)(p.oC + (size_t)t * 256 + c4);
    const uint2 cb = *(const uint2*)(p.oC + (size_t)(T_SUB + t) * 256 + c4);
    const uint2 cg = *(const uint2*)(p.z + (size_t)t * ZLD + ZC_OFF + 1024 + c4);
    const uint2 da = *(const uint2*)(p.oD + (size_t)t * 256 + c4);
    const uint2 db = *(const uint2*)(p.oD + (size_t)(T_SUB + t) * 256 + c4);
    const float bo = p.bonus[(size_t)t * 4 + (lane >> 4)];
    const uint2 vr = *(const uint2*)(p.vs + (size_t)t * 256 + c4);
    const uint2 gr = *(const uint2*)(p.gD + (size_t)t * 256 + c4);
    {
      float o[4] = {blo(ca.x) + blo(cb.x), bhi(ca.x) + bhi(cb.x), blo(ca.y) + blo(cb.y), bhi(ca.y) + bhi(cb.y)};
      float ss = reduce16(o[0] * o[0] + o[1] * o[1] + o[2] * o[2] + o[3] * o[3]);
      float ri = rsqrtf(ss * (1.f / 64.f) + 1e-6f);
      float g[4] = {blo(cg.x), bhi(cg.x), blo(cg.y), bhi(cg.y)};
      float y[4];
#pragma unroll
      for (int j = 0; j < 4; j++) y[j] = o[j] * ri * gn[j] * (g[j] * sigm(g[j]));
      *(uint2*)(p.cat + (size_t)t * 1024 + 512 + c4) = make_uint2(pack2(y[0], y[1]), pack2(y[2], y[3]));
    }
    {
      float o[4] = {blo(da.x) + blo(db.x), bhi(da.x) + bhi(db.x), blo(da.y) + blo(db.y), bhi(da.y) + bhi(db.y)};
      float mu = reduce16(o[0] + o[1] + o[2] + o[3]) * (1.f / 64.f);
      float d0 = o[0] - mu, d1 = o[1] - mu, d2 = o[2] - mu, d3 = o[3] - mu;
      float var = reduce16(d0 * d0 + d1 * d1 + d2 * d2 + d3 * d3) * (1.f / 64.f);
      float ri = rsqrtf(var + 64e-5f);
      float vv[4] = {blo(vr.x), bhi(vr.x), blo(vr.y), bhi(vr.y)};
      float g[4] = {blo(gr.x), bhi(gr.x), blo(gr.y), bhi(gr.y)};
      float dd[4] = {d0, d1, d2, d3};
      float y[4];
#pragma unroll
      for (int j = 0; j < 4; j++) y[j] = (dd[j] * ri * lw[j] + lbb[j] + bo * vv[j]) * g[j];
      *(uint2*)(p.cat + (size_t)t * 1024 + 768 + c4) = make_uint2(pack2(y[0], y[1]), pack2(y[2], y[3]));
    }
  }
}

DI void phase_wout(const Params& p, int l, int tok0, char* lds, int bid, int nb, int tid) {
  const int NT = 8, MT = T_SUB / 128;
  for (int it = 0;; it++) {
    int nt, mt;
    if (!xcd_tile(it, bid, nb, MT, NT, mt, nt)) break;
    int m0 = mt * 128, n0 = nt * 128;
    auto rowfn = [&](int r) -> const void* { return p.cat + (size_t)(m0 + r) * 1024; };
    auto epi = [&](f32x4(&acc)[4][4], int rbase, int cbase) {
      EPI_LOOP({
        int tg = tok0 + m0 + row;
        float4 xv = *(const float4*)(xin_row(p, l, tg) + n0 + col);
        float4 o = make_float4(ALPHA_F * xv.x + v[0], ALPHA_F * xv.y + v[1], ALPHA_F * xv.z + v[2], ALPHA_F * xv.w + v[3]);
        *(float4*)(p.out + (size_t)tg * 1024 + n0 + col) = o;
      })
    };
    gemm_tile<false>(rowfn, p.wout_t + ((size_t)l * 1024 + n0) * 1024, 1024, epi, lds, tid);
  }
}

template <bool ROUTER>
DI void phase_ln(const Params& p, const float* g, const float* bta, const float* wrouter, int tok0, int ntok, char* lds,
                 int bid, int nb, int tid) {
  const int lane = tid & 63, wv = tid >> 6;
  float* wl = (float*)lds;
  if (ROUTER) {
    __syncthreads();
    for (int i = tid; i < 16384; i += NTHR) {
      int k = i >> 4, e = i & 15;
      wl[e * 1024 + k] = wrouter[i];
    }
    __syncthreads();
  }
  float4 x[4], xn[4];
  {
    const int t0 = bid * 4 + wv;
#pragma unroll
    for (int i = 0; i < 4; i++)
      x[i] = (t0 < ntok) ? *(const float4*)(p.out + (size_t)(tok0 + t0) * 1024 + i * 256 + lane * 4) : make_float4(0.f, 0.f, 0.f, 0.f);
  }
  for (int t = bid * 4 + wv; t < ntok; t += nb * 4) {
    const int tg = tok0 + t;
    float* xr = p.out + (size_t)tg * 1024;
    {
      const int tn = t + nb * 4;
#pragma unroll
      for (int i = 0; i < 4; i++)
        xn[i] = (tn < ntok) ? *(const float4*)(p.out + (size_t)(tok0 + tn) * 1024 + i * 256 + lane * 4) : make_float4(0.f, 0.f, 0.f, 0.f);
    }
    float s = 0.f;
#pragma unroll
    for (int i = 0; i < 4; i++) s += x[i].x + x[i].y + x[i].z + x[i].w;
    float mu = wave_sum(s) * (1.f / 1024.f);
    float vs = 0.f;
#pragma unroll
    for (int i = 0; i < 4; i++) {
      x[i].x -= mu; x[i].y -= mu; x[i].z -= mu; x[i].w -= mu;
      vs += x[i].x * x[i].x + x[i].y * x[i].y + x[i].z * x[i].z + x[i].w * x[i].w;
    }
    float ri = rsqrtf(wave_sum(vs) * (1.f / 1024.f) + 1e-5f);
#pragma unroll
    for (int i = 0; i < 4; i++) {
      float4 gg = *(const float4*)(g + i * 256 + lane * 4);
      float4 bb = *(const float4*)(bta + i * 256 + lane * 4);
      x[i].x = x[i].x * ri * gg.x + bb.x;
      x[i].y = x[i].y * ri * gg.y + bb.y;
      x[i].z = x[i].z * ri * gg.z + bb.z;
      x[i].w = x[i].w * ri * gg.w + bb.w;
      *(float4*)(xr + i * 256 + lane * 4) = x[i];
      *(uint2*)(p.xb + (size_t)tg * 1024 + i * 256 + lane * 4) = make_uint2(pack2(x[i].x, x[i].y), pack2(x[i].z, x[i].w));
    }
    if (ROUTER) {
      float mine = 0.f;
#pragma unroll 1
      for (int e = 0; e < 16; e++) {
        float a = 0.f;
#pragma unroll
        for (int i = 0; i < 4; i++) {
          float4 w = *(const float4*)(wl + e * 1024 + i * 256 + lane * 4);
          a += x[i].x * w.x + x[i].y * w.y + x[i].z * w.z + x[i].w * w.w;
        }
        a = wave_sum(a);
        mine = (lane == e) ? a : mine;
      }
      float mx = mine;
      mx = fmaxf(mx, dpp_f<0xB1>(mx));
      mx = fmaxf(mx, dpp_f<0x4E>(mx));
      mx = fmaxf(mx, dpp_f<0x141>(mx));
      mx = fmaxf(mx, dpp_f<0x140>(mx));
      float ex = __expf(mine - mx);
      float sum = reduce16(ex);
      mine = ex / sum;
      if (lane == 0) p.inv_cnt[tg] = 0;
      if (lane < 16) {
        if (tg < 32768) p.affT[(size_t)lane * 32768 + tg] = mine;
        else p.affT[(size_t)16 * 32768 + (size_t)lane * 65536 + (tg - 32768)] = mine;
      }
    }
#pragma unroll
    for (int i = 0; i < 4; i++) x[i] = xn[i];
  }
}

DI void phase_topk(const Params& p, char* lds, int bid, int nb, int tid) {
  if (bid < 32) {
    unsigned* hist = (unsigned*)lds;
    unsigned* sh = hist + 256;
    unsigned* eqc = sh + 8;
    const int g = bid >> 4, e = bid & 15;
    const int T = g ? 65536 : 32768, cap = T >> 3;
    const int tok0 = g ? 32768 : 0;
    const float* vals = p.affT + (g ? (size_t)16 * 32768 : 0) + (size_t)e * T;
    const float4* v4 = (const float4*)vals;
    const int n4 = T >> 2;
    int* oidx = p.idx + (g ? 65536 : 0) + e * cap;
    float* ogate = p.gate + (g ? 65536 : 0) + e * cap;
    const int slot0 = (g ? 65536 : 0) + e * cap;
    unsigned prefix = 0, mask = 0;
    int remaining = cap;
    for (int pass = 0; pass < 4; pass++) {
      const int shift = 24 - 8 * pass;
      hist[tid] = 0;
      __syncthreads();
      for (int base = 0; base < n4; base += 2048) {
        float4 x[8];
#pragma unroll
        for (int u = 0; u < 8; u++) x[u] = v4[base + u * 256 + tid];
#pragma unroll
        for (int u = 0; u < 8; u++) {
          const unsigned b0 = __float_as_uint(x[u].x), b1 = __float_as_uint(x[u].y), b2 = __float_as_uint(x[u].z), b3 = __float_as_uint(x[u].w);
          if ((b0 & mask) == prefix) atomicAdd(&hist[(b0 >> shift) & 255], 1u);
          if ((b1 & mask) == prefix) atomicAdd(&hist[(b1 >> shift) & 255], 1u);
          if ((b2 & mask) == prefix) atomicAdd(&hist[(b2 >> shift) & 255], 1u);
          if ((b3 & mask) == prefix) atomicAdd(&hist[(b3 >> shift) & 255], 1u);
        }
      }
      __syncthreads();
      if (tid == 0) {
        int cum = 0, sel = 0;
        for (int bq = 255; bq >= 0; bq--) {
          int hc = (int)hist[bq];
          if (cum + hc >= remaining) { sel = bq; break; }
          cum += hc;
        }
        sh[0] = (unsigned)sel;
        sh[1] = (unsigned)(remaining - cum);
        sh[3] = hist[sel];
      }
      __syncthreads();
      prefix |= sh[0] << shift;
      remaining = (int)sh[1];
      mask |= 0xFFu << shift;
      __syncthreads();
    }
    const unsigned thr = prefix;
    const int need = remaining;
    const bool fast = ((int)sh[3] == need);
    if (tid == 0) sh[2] = 0;
    __syncthreads();
    if (fast) {
      for (int base = 0; base < n4; base += 2048) {
        float4 x[8];
#pragma unroll
        for (int u = 0; u < 8; u++) x[u] = v4[base + u * 256 + tid];
#pragma unroll
        for (int u = 0; u < 8; u++) {
          const float xv[4] = {x[u].x, x[u].y, x[u].z, x[u].w};
#pragma unroll
          for (int c = 0; c < 4; c++) {
            if (__float_as_uint(xv[c]) >= thr) {
              const int pos = (int)atomicAdd(&sh[2], 1u);
              const int tok = tok0 + (base + u * 256 + tid) * 4 + c;
              oidx[pos] = tok;
              ogate[pos] = xv[c];
              const int kslot = atomicAdd(&p.inv_cnt[tok], 1);
              p.inv_slot[(size_t)tok * 16 + kslot] = slot0 + pos;
            }
          }
        }
      }
    } else {
      const int ch = T >> 8;
      const float* my = vals + tid * ch;
      int ec = 0;
      for (int i = 0; i < ch; i++) ec += (__float_as_uint(my[i]) == thr) ? 1 : 0;
      eqc[tid] = ec;
      __syncthreads();
      int eq_rank = 0;
      for (int i = 0; i < tid; i++) eq_rank += eqc[i];
      for (int i = 0; i < ch; i++) {
        float v = my[i];
        unsigned u = __float_as_uint(v);
        int pos = -1;
        if (u > thr) {
          pos = (int)atomicAdd(&sh[2], 1u);
        } else if (u == thr) {
          if (eq_rank < need) pos = cap - need + eq_rank;
          eq_rank++;
        }
        if (pos >= 0) {
          const int tok = tok0 + tid * ch + i;
          oidx[pos] = tok;
          ogate[pos] = v;
          const int kslot = atomicAdd(&p.inv_cnt[tok], 1);
          p.inv_slot[(size_t)tok * 16 + kslot] = slot0 + pos;
        }
      }
    }
    __syncthreads();
  }
}

DI void moe_rowinfo(int row0, int l, int& e, int& ioff) {
  if (row0 < 65536) { e = row0 >> 12; }
  else { e = (row0 - 65536) >> 13; }
  ioff = row0;
}

DI void phase_moe1(const Params& p, int l, char* lds, int bid, int nb, int tid) {
  const int NT = 8, MT = 196608 / 128;
  for (int it = 0;; it++) {
    int nt, mt;
    if (!xcd_tile(it, bid, nb, MT, NT, mt, nt)) break;
    int m0 = mt * 128, n0 = nt * 128;
    int e, ioff;
    moe_rowinfo(m0, l, e, ioff);
    const int* ip = p.idx + ioff;
    auto rowfn = [&](int r) -> const void* { return p.xb + (size_t)ip[r] * 1024; };
    u16* H = p.H;
    auto epi = [&](f32x4(&acc)[4][4], int rbase, int cbase) {
#pragma unroll
      for (int m = 0; m < 4; m++)
#pragma unroll
        for (int n = 0; n < 4; n += 2) {
          int row = rbase + m * 16;
          int col = cbase + n * 16;
          int blk = (n0 + (col & ~31)) >> 1;
          int hc = blk + (col & 15);
          f32x4 a = acc[m][n], bq = acc[m][n + 1];
          f32x4 o;
          for (int j = 0; j < 4; j++) o[j] = a[j] * sigm(a[j]) * bq[j];
          st_bf4(H + (size_t)(m0 + row) * 512 + hc, o);
        }
    };
    gemm_tile<false>(rowfn, p.w13_t + ((size_t)(l * 16 + e) * 1024 + n0) * 1024, 1024, epi, lds, tid);
  }
}

DI void phase_moe2(const Params& p, int l, char* lds, int bid, int nb, int tid) {
  TileIter it{bid, nb, 0};
  {
    const int NT = 8, MT = 196608 / 128;
    for (int itx = 0;; itx++) {
      int nt, mt;
      if (!xcd_tile(itx, bid, nb, MT, NT, mt, nt)) break;
      int m0 = mt * 128, n0 = nt * 128;
      int e, ioff;
      moe_rowinfo(m0, l, e, ioff);
      auto rowfn = [&](int r) -> const void* { return p.H + (size_t)(m0 + r) * 512; };
      u16* O = p.O;
      auto epi = [&](f32x4(&acc)[4][4], int rbase, int cbase) {
        EPI_LOOP({ st_bf4(O + (size_t)(m0 + row) * 1024 + n0 + col, v); })
      };
      gemm_tile<false>(rowfn, p.w2_t + ((size_t)(l * 16 + e) * 1024 + n0) * 512, 512, epi, lds, tid);
    }
  }
  {
    const int NT = 8, MT = T_ALL / 128;
    for (int itx = 0;; itx++) {
      int nt, mt;
      if (!xcd_tile(itx, bid, nb, MT, NT, mt, nt)) break;
      int m0 = mt * 128, n0 = nt * 128;
      auto rowfn = [&](int r) -> const void* {
        int tg = m0 + r;
        return tg < 32768 ? p.p_prompt + ((size_t)l * 32768 + tg) * 256 : p.p_sample + ((size_t)l * 65536 + (tg - 32768)) * 256;
      };
      auto epi = [&](f32x4(&acc)[4][4], int rbase, int cbase) {
        EPI_LOOP({ st_bf4(p.xb + (size_t)(m0 + row) * 1024 + n0 + col, v); })
      };
      gemm_tile<true>(rowfn, p.wp_t + ((size_t)l * 1024 + n0) * 256, 256, epi, lds, tid);
    }
  }
}

DI void phase_combine(const Params& p, int bid, int nb, int tid) {
  const int lane = tid & 63, wv = tid >> 6;
  u16* ub = p.H;
  for (int t = bid * 4 + wv; t < T_ALL; t += nb * 4) {
    float* xr = p.out + (size_t)t * 1024;
    float4 a[4];
#pragma unroll
    for (int i = 0; i < 4; i++) a[i] = *(const float4*)(xr + i * 256 + lane * 4);
    const int cnt = p.inv_cnt[t];
    const int myslot = p.inv_slot[(size_t)t * 16 + (lane & 15)];
    const float mygate = ((lane & 15) < cnt) ? p.gate[myslot] : 0.f;
#pragma unroll
    for (int i = 0; i < 4; i++) a[i] = make_float4(a[i].x * ALPHA_F, a[i].y * ALPHA_F, a[i].z * ALPHA_F, a[i].w * ALPHA_F);
    for (int j0 = 0; j0 < cnt; j0 += 4) {
      uint2 r[4][4];
      float g[4];
#pragma unroll
      for (int jj = 0; jj < 4; jj++) {
        const int j = (j0 + jj < cnt) ? (j0 + jj) : j0;
        const int slot = __shfl(myslot, j);
        g[jj] = (j0 + jj < cnt) ? __shfl(mygate, j) : 0.f;
        const u16* orow = p.O + (size_t)slot * 1024 + lane * 4;
#pragma unroll
        for (int i = 0; i < 4; i++) r[jj][i] = *(const uint2*)(orow + i * 256);
      }
#pragma unroll
      for (int jj = 0; jj < 4; jj++)
#pragma unroll
        for (int i = 0; i < 4; i++) {
          a[i].x += g[jj] * blo(r[jj][i].x);
          a[i].y += g[jj] * bhi(r[jj][i].x);
          a[i].z += g[jj] * blo(r[jj][i].y);
          a[i].w += g[jj] * bhi(r[jj][i].y);
        }
    }
#pragma unroll
    for (int i = 0; i < 4; i++) {
      *(float4*)(xr + i * 256 + lane * 4) = a[i];
      *(uint2*)(ub + (size_t)t * 1024 + i * 256 + lane * 4) = make_uint2(pack2(a[i].x, a[i].y), pack2(a[i].z, a[i].w));
    }
  }
}

DI void phase_ple(const Params& p, int l, char* lds, int bid, int nb, int tid) {
  const int NT = 8, MT = T_ALL / 128;
  for (int it = 0;; it++) {
    int nt, mt;
    if (!xcd_tile(it, bid, nb, MT, NT, mt, nt)) break;
    int m0 = mt * 128, n0 = nt * 128;
    auto rowfn = [&](int r) -> const void* { return p.H + (size_t)(m0 + r) * 1024; };
    auto epi = [&](f32x4(&acc)[4][4], int rbase, int cbase) {
      EPI_LOOP({
        size_t o = (size_t)(m0 + row) * 1024 + n0 + col;
        float4 u = *(const float4*)(p.out + o);
        uint2 pr = *(const uint2*)(p.xb + o);
        *(float4*)(p.out + o) = make_float4(u.x + sigm(v[0]) * blo(pr.x), u.y + sigm(v[1]) * bhi(pr.x),
                                            u.z + sigm(v[2]) * blo(pr.y), u.w + sigm(v[3]) * bhi(pr.y));
      })
    };
    gemm_tile<false>(rowfn, p.wg_t + ((size_t)l * 1024 + n0) * 1024, 1024, epi, lds, tid);
  }
}

#define XB_TMO      128
#define XB_XCNT(j)  (256  + 64 * (j))
#define XB_XSUB(j)  (1280 + 64 * (j))
#define XB_XGEN(j)  (2304 + 64 * (j))
#define XB_TOP      3328
#define XB_TOPGEN   3392
#define XCD_BAR_WORDS 3456
#define XB_SPIN_CAP (1u << 22)
#define LAS __attribute__((address_space(3)))
DI unsigned xb_ld(unsigned* p) { return __hip_atomic_load(p, __ATOMIC_RELAXED, __HIP_MEMORY_SCOPE_AGENT); }
DI unsigned xb_add(unsigned* p, unsigned v) { return __hip_atomic_fetch_add(p, v, __ATOMIC_RELAXED, __HIP_MEMORY_SCOPE_AGENT); }
DI unsigned xb_xcc_id() { return (unsigned)__builtin_amdgcn_s_getreg((3 << 11) | 20) & 0xFu; }
#define XB_SPIN(cond, bar) do { unsigned _sp = 0; while (cond) { __builtin_amdgcn_s_sleep(1); \
    if ((++_sp & 255u) == 0u) { if (xb_ld(&(bar)[XB_TMO])) break; if (_sp > XB_SPIN_CAP) { atomicAdd(&(bar)[XB_TMO], 1u); break; } } } } while (0)
struct XcdBarrier { unsigned* bar; unsigned x; volatile LAS unsigned* st; };
DI XcdBarrier xcd_barrier_post(unsigned* bar, volatile LAS unsigned* st) {
  XcdBarrier b; b.bar = bar; b.x = xb_xcc_id(); b.st = st;
  if (threadIdx.x == 0) (void)xb_add(&bar[XB_XCNT(b.x)], 1u);
  return b;
}
DI void xcd_barrier_complete(unsigned* bar, unsigned x, unsigned& nloc, unsigned& nx) {
  const unsigned G = gridDim.x * gridDim.y * gridDim.z;
  unsigned sum, cnt, mine, sp = 0u;
  for (;;) {
    sum = 0u; cnt = 0u; mine = 0u;
#pragma unroll
    for (unsigned j = 0; j < 16; ++j) { const unsigned c = xb_ld(&bar[XB_XCNT(j)]); sum += c; cnt += (c > 0u) ? 1u : 0u; mine = (j == x) ? c : mine; }
    if (sum == G) break;
    __builtin_amdgcn_s_sleep(1);
    if ((++sp & 255u) == 0u) { if (xb_ld(&bar[XB_TMO])) break; if (sp > XB_SPIN_CAP) { atomicAdd(&bar[XB_TMO], 1u); break; } }
  }
  nloc = mine > 0u ? mine : 1u; nx = cnt > 0u ? cnt : 1u;
}
DI void xcd_barrier(const XcdBarrier& b) {
  asm volatile("s_waitcnt vmcnt(0)" ::: "memory");
  __syncthreads();
  if (threadIdx.x == 0) {
    unsigned* bar = b.bar;
    __builtin_amdgcn_s_waitcnt(0);
    unsigned nloc = b.st[0], nx = b.st[1];
    if (nloc == 0u) { xcd_barrier_complete(bar, b.x, nloc, nx); b.st[0] = nloc; b.st[1] = nx; }
    const unsigned old = xb_add(&bar[XB_XSUB(b.x)], 1u);
    const unsigned gen = old / nloc;
    if (old + 1u == (gen + 1u) * nloc) {
      __builtin_amdgcn_fence(__ATOMIC_RELEASE, "agent");
      asm volatile("s_waitcnt vmcnt(0)" ::: "memory");
      const unsigned og = xb_add(&bar[XB_TOP], 1u);
      const unsigned tg = og / nx;
      if (og + 1u == (tg + 1u) * nx) xb_add(&bar[XB_TOPGEN], 1u);
      else XB_SPIN(xb_ld(&bar[XB_TOPGEN]) == tg, bar);
      __builtin_amdgcn_fence(__ATOMIC_ACQUIRE, "agent");
      xb_add(&bar[XB_XGEN(b.x)], 1u);
      asm volatile("s_waitcnt vmcnt(0)" ::: "memory");
    } else {
      XB_SPIN(xb_ld(&bar[XB_XGEN(b.x)]) == gen, bar);
      __builtin_amdgcn_fence(__ATOMIC_ACQUIRE, "agent");
      asm volatile("s_waitcnt vmcnt(0)" ::: "memory");
    }
  }
  __syncthreads();
}

__global__ void __launch_bounds__(NTHR, 2) mega(Params p) {
  __shared__ __attribute__((aligned(16))) char lds[73728];
  cg::grid_group grid = cg::this_grid();
  const int tid0 = threadIdx.x, bid0 = blockIdx.x, nb = gridDim.x;
  __shared__ uint4 xb_words;
  if (tid0 == 0) xb_words = make_uint4(0u, 0u, 0u, 0u);
  __syncthreads();
  const XcdBarrier xb = xcd_barrier_post(p.bar, (volatile LAS unsigned*)&xb_words);
  int pc = 0;
#define PHASE(...)                                      \
  {                                                     \
    if (pc >= p.pb && pc < p.pe) {                      \
      if (pc == p.pb + 1) grid.sync();                  \
      else if (pc > p.pb + 1) xcd_barrier(xb);          \
      int tid = tid0, bid = bid0;                       \
      asm volatile("" : "+v"(tid), "+s"(bid));          \
      __VA_ARGS__;                                      \
    }                                                   \
    pc++;                                               \
  }
  PHASE(phase_convert(p, lds, bid, nb, tid));
  for (int i = 0; i < REP_SYNC; i++) PHASE((void)0);
  for (int l = 0; l < 2; l++) {
    for (int sg = 0; sg < 3; sg++) {
      const int tok0 = sg * T_SUB;
      const int B = sg == 0 ? 4 : 8, N = sg == 0 ? 8192 : 4096;
      PHASE(phase_inproj(p, l, tok0, lds, bid, nb, tid));
#if REP_INPROJ || REP_GEMMS
      PHASE(phase_inproj(p, l, tok0, lds, bid, nb, tid));
#endif
      PHASE(phase_prep(p, l, N, bid, nb, tid));
      PHASE(phase_smallgemm(p, l, B, N, lds, bid, nb, tid));
#if REP_GEMMS
      PHASE(phase_smallgemm(p, l, B, N, lds, bid, nb, tid));
#endif
      PHASE(phase_mix(p, l, B, N, p.bar + XCD_BAR_WORDS + (l * 3 + sg) * 128, lds, bid, nb, tid));
#if REP_MIX
      PHASE(phase_mix(p, l, B, N, p.bar + XCD_BAR_WORDS + (6 + l * 3 + sg) * 128, lds, bid, nb, tid));
#endif
      PHASE(phase_final(p, l, bid, nb, tid));
      PHASE(phase_wout(p, l, tok0, lds, bid, nb, tid));
      PHASE(phase_ln<true>(p, p.ln1_g + l * 1024, p.ln1_b + l * 1024, p.moe_router + (size_t)l * 16384, tok0, T_SUB, lds, bid, nb, tid));
    }
    PHASE(phase_topk(p, lds, bid, nb, tid));
    PHASE(phase_moe1(p, l, lds, bid, nb, tid));
#if REP_MOE1 || REP_GEMMS
    PHASE(phase_moe1(p, l, lds, bid, nb, tid));
#endif
    PHASE(phase_moe2(p, l, lds, bid, nb, tid));
#if REP_GEMMS
    PHASE(phase_moe2(p, l, lds, bid, nb, tid));
#endif
    PHASE(phase_combine(p, bid, nb, tid));
    PHASE(phase_ple(p, l, lds, bid, nb, tid));
    PHASE(phase_ln<false>(p, p.ln2_g + l * 1024, p.ln2_b + l * 1024, nullptr, 0, T_ALL, lds, bid, nb, tid));
  }
}

#define N_PHASES 1000
#ifndef FUSED
#define FUSED 1
#endif

extern "C" void kernel_launch(void* const* d_in, const int* in_sizes, int n_in, void* d_out, int out_size, void* d_ws,
                              size_t ws_size, hipStream_t stream) {
  static int grid_blocks = 0;
  if (!grid_blocks) {
    int dev = 0, cus = 0, per_cu = 0;
    (void)hipGetDevice(&dev);
    (void)hipDeviceGetAttribute(&cus, hipDeviceAttributeMultiprocessorCount, dev);
    (void)hipOccupancyMaxActiveBlocksPerMultiprocessor(&per_cu, mega, NTHR, 0);
    if (per_cu > 2) per_cu = 2;
    if (per_cu < 1) per_cu = 1;
    grid_blocks = cus * per_cu;
  }
  Params p;
  memset(&p, 0, sizeof(p));
  const float* const* in = (const float* const*)d_in;
  int k = 0;
  p.x_prompt = in[k++]; p.x_sample = in[k++]; p.p_prompt = in[k++]; p.p_sample = in[k++];
  p.w_in = in[k++]; p.mla_gq = in[k++]; p.mla_gkv = in[k++]; p.mla_wuq = in[k++]; p.mla_wuk = in[k++]; p.mla_wuv = in[k++];
  p.na_bias = in[k++]; p.hg_lb = in[k++]; p.hg_gnorm = in[k++];
  p.rw_mu = in[k++]; p.rw_w0 = in[k++]; p.rw_w_up = in[k++]; p.rw_a0 = in[k++]; p.rw_a_up = in[k++]; p.rw_g_up = in[k++];
  p.rw_kk = in[k++]; p.rw_ka = in[k++]; p.rw_rk = in[k++]; p.rw_ln_w = in[k++]; p.rw_ln_b = in[k++];
  p.w_out = in[k++]; p.ln1_g = in[k++]; p.ln1_b = in[k++]; p.moe_router = in[k++]; p.moe_w1 = in[k++]; p.moe_w3 = in[k++];
  p.moe_w2 = in[k++]; p.ln2_g = in[k++]; p.ln2_b = in[k++]; p.ple_gate = in[k++]; p.ple_proj = in[k++];
  p.out = (float*)d_out;
  char* ws = (char*)d_ws;
  size_t off = 0;
  auto take = [&](size_t bytes) { char* r = ws + off; off += (bytes + 255) & ~(size_t)255; return r; };
  p.w_in_t = (u16*)take((size_t)2 * 3712 * 1024 * 2);
  p.wuq_t = (u16*)take((size_t)2 * 384 * 256 * 2);
  p.wkv_t = (u16*)take((size_t)2 * 512 * 128 * 2);
  p.wup_t = (u16*)take((size_t)4 * 256 * 64 * 2);
  p.aup_t = (u16*)take((size_t)4 * 256 * 64 * 2);
  p.gup_t = (u16*)take((size_t)2 * 256 * 128 * 2);
  p.wout_t = (u16*)take((size_t)2 * 1024 * 1024 * 2);
  p.w13_t = (u16*)take((size_t)32 * 1024 * 1024 * 2);
  p.w2_t = (u16*)take((size_t)32 * 1024 * 512 * 2);
  p.wg_t = (u16*)take((size_t)2 * 1024 * 1024 * 2);
  p.wp_t = (u16*)take((size_t)2 * 1024 * 256 * 2);
  p.ropec = (float*)take((size_t)8192 * 16 * 4);
  p.ropes = (float*)take((size_t)8192 * 16 * 4);
  p.lb = (float*)take(1024 * 4);
  p.affT = (float*)take((size_t)16 * T_ALL * 4);
  p.gate = (float*)take((size_t)196608 * 4);
  p.idx = (int*)take((size_t)196608 * 4);
  p.bar = (unsigned*)take((size_t)(XCD_BAR_WORDS + 12 * 128) * 4);
  p.inv_cnt = (int*)take((size_t)T_ALL * 4);
  p.inv_slot = (int*)take((size_t)T_ALL * 16 * 4);
  p.xb = (u16*)take((size_t)T_ALL * 1024 * 2);
  const size_t stage0 = off;
  p.z = (u16*)take((size_t)T_SUB * ZLD * 2);
  p.cat = (u16*)take((size_t)T_SUB * 1024 * 2);
  p.Q = (u16*)take((size_t)T_SUB * 384 * 2);
  p.Kb = (u16*)take((size_t)T_SUB * 384 * 2);
  p.Vt = (u16*)take((size_t)T_SUB * 256 * 2);
  p.cqn = (u16*)take((size_t)T_SUB * 256 * 2);
  p.ckvn = (u16*)take((size_t)T_SUB * 128 * 2);
  p.S1 = (u16*)take((size_t)T_SUB * 384 * 2);
  p.rs = (u16*)take((size_t)T_SUB * 256 * 2);
  p.ks = (u16*)take((size_t)T_SUB * 256 * 2);
  p.vs = (u16*)take((size_t)T_SUB * 256 * 2);
  p.kk = (u16*)take((size_t)T_SUB * 256 * 2);
  p.gD = (u16*)take((size_t)T_SUB * 256 * 2);
  p.dec = (u16*)take((size_t)2 * T_SUB * 256 * 2);
  p.kka = (u16*)take((size_t)2 * T_SUB * 256 * 2);
  p.kt = (u16*)take((size_t)2 * T_SUB * 256 * 2);
  p.oC = (u16*)take((size_t)2 * T_SUB * 256 * 2);
  p.oD = (u16*)take((size_t)2 * T_SUB * 256 * 2);
  p.bonus = (float*)take((size_t)T_SUB * 4 * 4);
  off = stage0;
  p.O = (u16*)take((size_t)196608 * 1024 * 2);
  p.H = (u16*)take((size_t)196608 * 512 * 2);
  for (int i = 0; i < 16; i++) p.inv_freq[i] = pow(10000.0, -(double)i / 16.0);
  (void)hipMemsetAsync(p.bar, 0, (size_t)(XCD_BAR_WORDS + 12 * 128) * 4, stream);
#if FUSED
  p.pb = 0;
  p.pe = N_PHASES;
  {
    void* args[] = {&p};
    hipError_t e = hipLaunchCooperativeKernel((void*)mega, dim3(grid_blocks), dim3(NTHR), args, 0, stream);
    if (e != hipSuccess) fprintf(stderr, "cooperative launch failed: %s (grid %d)\n", hipGetErrorString(e), grid_blocks);
  }
#else
  for (int ph = 0; ph < N_PHASES; ph++) {
    p.pb = ph;
    p.pe = ph + 1;
    void* args[] = {&p};
    hipError_t e = hipLaunchCooperativeKernel((void*)mega, dim3(grid_blocks), dim3(NTHR), args, 0, stream);
    if (e != hipSuccess) fprintf(stderr, "cooperative launch failed: %s (grid %d)\n", hipGetErrorString(e), grid_blocks);
  }
#endif
}
```

```cpp
#include <hip/hip_runtime.h>
#include <hip/hip_cooperative_groups.h>
#include <cstdio>
#include <cmath>
#include <cstring>
namespace cg = cooperative_groups;

typedef unsigned short u16;
using bf16x8 = __attribute__((ext_vector_type(8))) short;
using f32x4 = __attribute__((ext_vector_type(4))) float;
using f32x16 = __attribute__((ext_vector_type(16))) float;

#define REP_INPROJ 0
#define REP_ATTN 0
#define REP_NA 0
#define REP_SCAN 0
#define REP_MOE1 0
#define REP_MOE2 0
#define REP_SYNC 0
#define REP_MIX 0
#define REP_GEMMS 0
#define DI __device__ __forceinline__
#define NTHR 256
#define T_ALL 98304
#define T_SUB 32768
#define ZLD 3616
#define ZB_OFF 416
#define ZC_OFF 1184
#define ZD_OFF 2464
#define LOG2E 1.4426950408889634f
#define ALPHA_F 1.4142135623730951f

struct Params {
  const float *x_prompt, *x_sample, *p_prompt, *p_sample;
  const float *w_in, *mla_gq, *mla_gkv, *mla_wuq, *mla_wuk, *mla_wuv, *na_bias, *hg_lb, *hg_gnorm;
  const float *rw_mu, *rw_w0, *rw_w_up, *rw_a0, *rw_a_up, *rw_g_up, *rw_kk, *rw_ka, *rw_rk, *rw_ln_w, *rw_ln_b;
  const float *w_out, *ln1_g, *ln1_b, *moe_router, *moe_w1, *moe_w3, *moe_w2, *ln2_g, *ln2_b, *ple_gate, *ple_proj;
  float* out;
  u16 *w_in_t, *wuq_t, *wkv_t, *wup_t, *aup_t, *gup_t, *wout_t, *w13_t, *w2_t, *wg_t, *wp_t;
  float *ropec, *ropes, *lb, *affT, *gate;
  int* idx;
  unsigned* bar;
  int *inv_cnt, *inv_slot;
  u16 *z, *cat, *Q, *Kb, *Vt, *cqn, *ckvn, *S1, *rs, *ks, *vs, *kk, *gD, *dec, *kka, *kt, *oC, *oD;
  float* bonus;
  u16* xb;
  u16* O;
  u16* H;
  double inv_freq[16];
  int pb, pe;
};

typedef __bf16 v2bf_t __attribute__((ext_vector_type(2)));
typedef float v2f_t __attribute__((ext_vector_type(2)));
typedef unsigned u32x4_t __attribute__((ext_vector_type(4)));
DI unsigned pack2(float a, float b) {
  v2f_t f = {a, b};
  v2bf_t h = __builtin_convertvector(f, v2bf_t);
  return __builtin_bit_cast(unsigned, h);
}
DI u16 f2bf(float f) { return (u16)(pack2(f, 0.f) & 0xffffu); }
DI float bf2f(u16 h) { return __uint_as_float(((unsigned)h) << 16); }
DI float blo(unsigned u) { return __uint_as_float(u << 16); }
DI float bhi(unsigned u) { return __uint_as_float(u & 0xffff0000u); }
DI float sigm(float x) { return 1.f / (1.f + __expf(-x)); }
DI float tanh_(float x) { return 1.f - 2.f / (__expf(2.f * x) + 1.f); }
DI float ex2(float x) { return __builtin_amdgcn_exp2f(x); }
DI int clampi(int v, int lo, int hi) { return v < lo ? lo : (v > hi ? hi : v); }
DI int swap23(int x) { return (x & ~12) | ((x & 4) << 1) | ((x & 8) >> 1); }

template <int CTRL> DI float dpp_f(float v) {
  return __int_as_float(__builtin_amdgcn_update_dpp(0, __float_as_int(v), CTRL, 0xF, 0xF, true));
}
DI float reduce16(float v) {
  v += dpp_f<0xB1>(v);
  v += dpp_f<0x4E>(v);
  v += dpp_f<0x141>(v);
  v += dpp_f<0x140>(v);
  return v;
}
DI float wave_sum(float v) {
  v = reduce16(v);
  v += __shfl_xor(v, 16);
  v += __shfl_xor(v, 32);
  return v;
}

struct TileIter {
  int bid, nb, off;
  DI int first(int n) { int f = bid - off; if (f < 0) f += nb; off = (off + n) % nb; return f; }
};

DI bool xcd_tile(int it, int bid, int nb, int MT, int NT, int& mt, int& nt) {
  const int x = bid & 7, slot = bid >> 3, nslots = nb >> 3;
  const int mper = MT >> 3;
  const int i = slot + it * nslots;
  if (i >= mper * NT) return false;
  const int mi = i & 7, rest = i >> 3;
  nt = rest % NT;
  mt = x * mper + (rest / NT) * 8 + mi;
  return true;
}

DI void convT_job(const float* __restrict__ W, int K, int N, int Npad, u16* __restrict__ Wt, int mode, char* lds,
                  TileIter& it, int tid) {
  float(*tile)[65] = (float(*)[65])lds;
  int tk = K >> 6, tn = Npad >> 6;
  int nt = tk * tn;
  for (int t = it.first(nt); t < nt; t += it.nb) {
    int k0 = (t % tk) << 6, n0 = (t / tk) << 6;
#pragma unroll
    for (int i = 0; i < 16; i++) {
      int kl = (tid >> 6) + 4 * i, nl = tid & 63;
      int n = n0 + nl;
      tile[kl][nl] = (n < N) ? W[(size_t)(k0 + kl) * N + n] : 0.f;
    }
    __syncthreads();
    {
      int nl = tid >> 2, ks = (tid & 3) * 16;
      int n = n0 + nl;
      int row = n;
      if (mode == 1) row = (n >> 4) * 32 + (n & 15);
      if (mode == 2) row = (n >> 4) * 32 + 16 + (n & 15);
      unsigned pk[8];
#pragma unroll
      for (int j = 0; j < 8; j++) pk[j] = pack2(tile[ks + 2 * j][nl], tile[ks + 2 * j + 1][nl]);
      uint4* dst = (uint4*)(Wt + (size_t)row * K + k0 + ks);
      dst[0] = make_uint4(pk[0], pk[1], pk[2], pk[3]);
      dst[1] = make_uint4(pk[4], pk[5], pk[6], pk[7]);
    }
    __syncthreads();
  }
}

DI void phase_convert(const Params& p, char* lds, int bid, int nb, int tid) {
  TileIter it{bid, nb, 0};
  for (int l = 0; l < 2; l++) {
    convT_job(p.w_in + (size_t)l * 1024 * 3616, 1024, 3616, 3712, p.w_in_t + (size_t)l * 3712 * 1024, 0, lds, it, tid);
    convT_job(p.mla_wuq + (size_t)l * 256 * 384, 256, 384, 384, p.wuq_t + (size_t)l * 384 * 256, 0, lds, it, tid);
    convT_job(p.mla_wuk + (size_t)l * 128 * 256, 128, 256, 256, p.wkv_t + (size_t)l * 512 * 128, 0, lds, it, tid);
    convT_job(p.mla_wuv + (size_t)l * 128 * 256, 128, 256, 256, p.wkv_t + (size_t)l * 512 * 128 + 256 * 128, 0, lds, it, tid);
    for (int d = 0; d < 2; d++) {
      convT_job(p.rw_w_up + (size_t)(l * 2 + d) * 64 * 256, 64, 256, 256, p.wup_t + (size_t)(l * 2 + d) * 256 * 64, 0, lds, it, tid);
      convT_job(p.rw_a_up + (size_t)(l * 2 + d) * 64 * 256, 64, 256, 256, p.aup_t + (size_t)(l * 2 + d) * 256 * 64, 0, lds, it, tid);
    }
    convT_job(p.rw_g_up + (size_t)l * 128 * 256, 128, 256, 256, p.gup_t + (size_t)l * 256 * 128, 0, lds, it, tid);
    convT_job(p.w_out + (size_t)l * 1024 * 1024, 1024, 1024, 1024, p.wout_t + (size_t)l * 1024 * 1024, 0, lds, it, tid);
    for (int e = 0; e < 16; e++) {
      size_t le = (size_t)(l * 16 + e);
      convT_job(p.moe_w1 + le * 1024 * 512, 1024, 512, 512, p.w13_t + le * 1024 * 1024, 1, lds, it, tid);
      convT_job(p.moe_w3 + le * 1024 * 512, 1024, 512, 512, p.w13_t + le * 1024 * 1024, 2, lds, it, tid);
      convT_job(p.moe_w2 + le * 512 * 1024, 512, 1024, 1024, p.w2_t + le * 1024 * 512, 0, lds, it, tid);
    }
    convT_job(p.ple_gate + (size_t)l * 1024 * 1024, 1024, 1024, 1024, p.wg_t + (size_t)l * 1024 * 1024, 0, lds, it, tid);
    convT_job(p.ple_proj + (size_t)l * 256 * 1024, 256, 1024, 1024, p.wp_t + (size_t)l * 1024 * 256, 0, lds, it, tid);
  }
  int gt = bid * NTHR + tid, ng = nb * NTHR;
  for (size_t i0 = gt; i0 < (size_t)T_ALL * 256; i0 += (size_t)ng * 8) {
    float4 v[8];
#pragma unroll
    for (int u = 0; u < 8; u++) {
      const size_t i = i0 + (size_t)u * ng;
      v[u] = make_float4(0.f, 0.f, 0.f, 0.f);
      if (i < (size_t)T_ALL * 256)
        v[u] = (i < (size_t)32768 * 256) ? ((const float4*)p.x_prompt)[i] : ((const float4*)p.x_sample)[i - (size_t)32768 * 256];
    }
#pragma unroll
    for (int u = 0; u < 8; u++) {
      const size_t i = i0 + (size_t)u * ng;
      if (i < (size_t)T_ALL * 256) ((uint2*)p.xb)[i] = make_uint2(pack2(v[u].x, v[u].y), pack2(v[u].z, v[u].w));
    }
  }
  for (int i = gt; i < 8192 * 16; i += ng) {
    int n = i >> 4, f = i & 15;
    double ifq = 0.0;
#pragma unroll
    for (int j = 0; j < 16; j++) ifq = (f == j) ? p.inv_freq[j] : ifq;
    double rev = (double)n * ifq * 0.15915494309189535;
    double fr = rev - rint(rev);
    float ff = (float)fr;
    p.ropec[i] = __builtin_amdgcn_cosf(ff);
    p.ropes[i] = __builtin_amdgcn_sinf(ff);
  }
  for (int i = gt; i < 512; i += ng) {
    float h0 = p.hg_lb[i], h1 = p.hg_lb[512 + i];
    p.lb[i] = 0.f;
    p.lb[512 + i] = 1.f / (1.f + __expf(h0 - h1));
  }
}

constexpr int G_STAGE = 32768;

template <bool AF32, class RowFn, class Epi>
DI void gemm_tile(RowFn rowfn, const u16* __restrict__ Bt, int K, Epi epi, char* lds, int tid) {
  const int lane = tid & 63, wid = tid >> 6, wr = wid >> 1, wc = wid & 1, fr = lane & 15, fq = lane >> 4;
  f32x4 acc[4][4];
#pragma unroll
  for (int m = 0; m < 4; m++)
#pragma unroll
    for (int n = 0; n < 4; n++) acc[m][n] = f32x4{0.f, 0.f, 0.f, 0.f};

  const int lrow = tid >> 3;
  const int lc = (tid & 7) ^ ((tid >> 4) & 7);
  const float* apf[8];
  const u16* aph[4];
  const u16* bp[4];
  if constexpr (AF32) {
#pragma unroll
    for (int i = 0; i < 8; i++) apf[i] = (const float*)rowfn(i * 16 + (tid >> 4)) + (tid & 15) * 4;
  } else {
#pragma unroll
    for (int i = 0; i < 4; i++) aph[i] = (const u16*)rowfn(lrow + i * 32) + lc * 8;
  }
#pragma unroll
  for (int i = 0; i < 4; i++) bp[i] = Bt + (size_t)(lrow + i * 32) * K + lc * 8;
  const int afoff = (tid >> 4) * 128 + ((((tid & 15) >> 1) ^ ((tid >> 5) & 7)) * 16) + (tid & 1) * 8;

  float4 raf[8];
  auto issue = [&](int buf, int k0) {
    char* A = lds + buf * G_STAGE;
    char* B = A + 16384;
#pragma unroll
    for (int i = 0; i < 4; i++)
      __builtin_amdgcn_global_load_lds((const unsigned*)(bp[i] + k0), (unsigned*)(B + wid * 1024 + i * 4096), 16, 0, 0);
    if constexpr (AF32) {
#pragma unroll
      for (int i = 0; i < 8; i++) raf[i] = *(const float4*)(apf[i] + k0);
    } else {
#pragma unroll
      for (int i = 0; i < 4; i++)
        __builtin_amdgcn_global_load_lds((const unsigned*)(aph[i] + k0), (unsigned*)(A + wid * 1024 + i * 4096), 16, 0, 0);
    }
  };
  auto astore = [&](int buf) {
    if constexpr (AF32) {
      char* A = lds + buf * G_STAGE;
#pragma unroll
      for (int i = 0; i < 8; i++) asm volatile("" : "+v"(raf[i].x), "+v"(raf[i].y), "+v"(raf[i].z), "+v"(raf[i].w));
#pragma unroll
      for (int i = 0; i < 8; i++)
        *(uint2*)(A + afoff + i * 2048) = make_uint2(pack2(raf[i].x, raf[i].y), pack2(raf[i].z, raf[i].w));
    }
  };
  const int abase = (wr * 64 + fr) * 128, bbase = 16384 + (wc * 64 + fr) * 128;
  const int sw0 = ((fq) ^ (fr >> 1)) * 16, sw1 = ((4 + fq) ^ (fr >> 1)) * 16;

  const int nk = K >> 6;
  issue(0, 0);
  astore(0);
  __syncthreads();
  for (int kt = 0; kt < nk; kt++) {
    if (kt + 1 < nk) issue((kt + 1) & 1, (kt + 1) << 6);
    __builtin_amdgcn_sched_barrier(0);
    const char* S = lds + (kt & 1) * G_STAGE;
    bf16x8 af[2][4], bfr[2][4];
#pragma unroll
    for (int kk = 0; kk < 2; kk++) {
      const int sw = kk ? sw1 : sw0;
#pragma unroll
      for (int m = 0; m < 4; m++) af[kk][m] = *(const bf16x8*)(S + abase + m * 2048 + sw);
#pragma unroll
      for (int n = 0; n < 4; n++) bfr[kk][n] = *(const bf16x8*)(S + bbase + n * 2048 + sw);
    }
    __builtin_amdgcn_sched_barrier(0);
#pragma unroll
    for (int kk = 0; kk < 2; kk++)
#pragma unroll
      for (int m = 0; m < 4; m++)
#pragma unroll
        for (int n = 0; n < 4; n++) acc[m][n] = __builtin_amdgcn_mfma_f32_16x16x32_bf16(bfr[kk][n], af[kk][m], acc[m][n], 0, 0, 0);
    __builtin_amdgcn_sched_barrier(0);
    if (kt + 1 < nk) astore((kt + 1) & 1);
    __syncthreads();
  }
  epi(acc, wr * 64 + fr, wc * 64 + fq * 4);
}

#define EPI_LOOP(...)                                    \
  _Pragma("unroll") for (int m = 0; m < 4; m++)          \
  _Pragma("unroll") for (int n = 0; n < 4; n++) {        \
    const int row = rbase + m * 16;                      \
    const int col = cbase + n * 16;                      \
    const f32x4 v = acc[m][n];                           \
    __VA_ARGS__                                          \
  }

DI void st_bf4(u16* dst, f32x4 v) { *(uint2*)dst = make_uint2(pack2(v[0], v[1]), pack2(v[2], v[3])); }

DI const float* xin_row(const Params& p, int l, int tg) {
  if (l == 0) return tg < 32768 ? p.x_prompt + (size_t)tg * 1024 : p.x_sample + (size_t)(tg - 32768) * 1024;
  return p.out + (size_t)tg * 1024;
}

DI void phase_inproj(const Params& p, int l, int tok0, char* lds, int bid, int nb, int tid) {
  const int NT = 29, MT = T_SUB / 128;
  for (int it = 0;; it++) {
    int nt, mt;
    if (!xcd_tile(it, bid, nb, MT, NT, mt, nt)) break;
    int m0 = mt * 128, n0 = nt * 128;
    auto rowfn = [&](int r) -> const void* { return p.xb + (size_t)(tok0 + m0 + r) * 1024; };
    u16* z = p.z;
    auto epi = [&](f32x4(&acc)[4][4], int rbase, int cbase) {
      EPI_LOOP({
        int c = n0 + col;
        if (c < ZLD) st_bf4(z + (size_t)(m0 + row) * ZLD + c, v);
      })
    };
    gemm_tile<false>(rowfn, p.w_in_t + ((size_t)l * 3712 + n0) * 1024, 1024, epi, lds, tid);
  }
}

DI void phase_prep(const Params& p, int l, int N, int bid, int nb, int tid) {
  const int lane = tid & 63, wv = tid >> 6, l15 = lane & 15, c4 = lane * 4;
  float gqv[4], gkvv[2], lbv[8], m0[12], m1[12], m0s[6], m1s[6], kkc[4], rkc[4];
  {
    const float* mu0 = p.rw_mu + (size_t)l * 2 * 1152;
    const float* mu1 = mu0 + 1152;
#pragma unroll
    for (int j = 0; j < 4; j++) {
      gqv[j] = p.mla_gq[l * 256 + c4 + j];
      kkc[j] = p.rw_kk[l * 256 + c4 + j];
      rkc[j] = p.rw_rk[l * 256 + c4 + j];
    }
    gkvv[0] = p.mla_gkv[l * 128 + lane * 2];
    gkvv[1] = p.mla_gkv[l * 128 + lane * 2 + 1];
#pragma unroll
    for (int j = 0; j < 8; j++) lbv[j] = p.lb[l * 512 + lane * 8 + j];
#pragma unroll
    for (int part = 0; part < 3; part++)
#pragma unroll
      for (int j = 0; j < 4; j++) {
        m0[part * 4 + j] = mu0[part * 256 + c4 + j];
        m1[part * 4 + j] = mu1[part * 256 + c4 + j];
      }
#pragma unroll
    for (int i = 0; i < 6; i++) {
      m0s[i] = mu0[768 + lane + 64 * i];
      m1s[i] = mu1[768 + lane + 64 * i];
    }
  }
  for (int t = bid * 4 + wv; t < T_SUB; t += nb * 4) {
    u16* zr = p.z + (size_t)t * ZLD;
    const int n = t & (N - 1);
    const bool hp = n > 0, hn = n < N - 1;
    const u16* zd = zr + ZD_OFF;
    const u16* zdp = zd - (hp ? ZLD : 0);
    const u16* zdn = zd + (hn ? ZLD : 0);
    const uint2 raw_cq = *(const uint2*)(zr + c4);
    const unsigned raw_ckv = *(const unsigned*)(zr + 256 + lane * 2);
    const u16 kr1 = zr[384 + l15], kr2 = zr[400 + l15];
    const float rc = p.ropec[n * 16 + l15], rsn = p.ropes[n * 16 + l15];
    uint4* fptr = (uint4*)(zr + ZC_OFF + 256 + lane * 8);
    const uint4 raw_f = *fptr;
    uint2 cur[3], prv[3], nxt[3];
#pragma unroll
    for (int part = 0; part < 3; part++) {
      cur[part] = *(const uint2*)(zd + part * 256 + c4);
      prv[part] = *(const uint2*)(zdp + part * 256 + c4);
      nxt[part] = *(const uint2*)(zdn + part * 256 + c4);
    }
    u16 sc[6], sp[6], sn[6];
#pragma unroll
    for (int i = 0; i < 6; i++) {
      sc[i] = zd[768 + lane + 64 * i];
      sp[i] = zdp[768 + lane + 64 * i];
      sn[i] = zdn[768 + lane + 64 * i];
    }
    {
      float v0 = blo(raw_cq.x), v1 = bhi(raw_cq.x), v2 = blo(raw_cq.y), v3 = bhi(raw_cq.y);
      float ss = wave_sum(v0 * v0 + v1 * v1 + v2 * v2 + v3 * v3);
      float ri = rsqrtf(ss * (1.f / 256.f) + 1e-6f);
      *(uint2*)(p.cqn + (size_t)t * 256 + c4) =
          make_uint2(pack2(v0 * ri * gqv[0], v1 * ri * gqv[1]), pack2(v2 * ri * gqv[2], v3 * ri * gqv[3]));
    }
    {
      float v0 = blo(raw_ckv), v1 = bhi(raw_ckv);
      float ss = wave_sum(v0 * v0 + v1 * v1);
      float ri = rsqrtf(ss * (1.f / 128.f) + 1e-6f);
      *(unsigned*)(p.ckvn + (size_t)t * 128 + lane * 2) = pack2(v0 * ri * gkvv[0], v1 * ri * gkvv[1]);
    }
    if (lane < 16) {
      float x1 = bf2f(kr1), x2 = bf2f(kr2);
      u16 k1 = f2bf(x1 * rc - x2 * rsn), k2 = f2bf(x1 * rsn + x2 * rc);
      u16* kb = p.Kb + (size_t)t * 384;
#pragma unroll
      for (int h = 0; h < 4; h++) {
        kb[h * 96 + 64 + lane] = k1;
        kb[h * 96 + 80 + lane] = k2;
      }
    }
    {
      unsigned w[4] = {raw_f.x, raw_f.y, raw_f.z, raw_f.w};
#pragma unroll
      for (int j = 0; j < 4; j++) {
        float a = blo(w[j]), bq = bhi(w[j]);
        float la = lbv[2 * j], lb2 = lbv[2 * j + 1];
        a = la + (1.f - la) * sigm(a);
        bq = lb2 + (1.f - lb2) * sigm(bq);
        w[j] = pack2(a, bq);
      }
      *fptr = make_uint4(w[0], w[1], w[2], w[3]);
    }
    {
      float rr[4], kx[4], vx[4];
#pragma unroll
      for (int part = 0; part < 3; part++) {
        float cz[4] = {blo(cur[part].x), bhi(cur[part].x), blo(cur[part].y), bhi(cur[part].y)};
        float pz[4] = {blo(prv[part].x), bhi(prv[part].x), blo(prv[part].y), bhi(prv[part].y)};
        float nz[4] = {blo(nxt[part].x), bhi(nxt[part].x), blo(nxt[part].y), bhi(nxt[part].y)};
#pragma unroll
        for (int j = 0; j < 4; j++) {
          float pzz = hp ? pz[j] : 0.f, nzz = hn ? nz[j] : 0.f;
          float o = cz[j] + m0[part * 4 + j] * (pzz - cz[j]) + m1[part * 4 + j] * (nzz - cz[j]);
          if (part == 0) rr[j] = o;
          if (part == 1) kx[j] = o;
          if (part == 2) vx[j] = o;
        }
      }
      *(uint2*)(p.rs + (size_t)t * 256 + c4) = make_uint2(pack2(rr[0], rr[1]), pack2(rr[2], rr[3]));
      *(uint2*)(p.ks + (size_t)t * 256 + c4) = make_uint2(pack2(kx[0], kx[1]), pack2(kx[2], kx[3]));
      *(uint2*)(p.vs + (size_t)t * 256 + c4) = make_uint2(pack2(vx[0], vx[1]), pack2(vx[2], vx[3]));
      float kq[4], ss = 0.f, bo = 0.f;
#pragma unroll
      for (int j = 0; j < 4; j++) {
        kq[j] = kx[j] * kkc[j];
        ss += kq[j] * kq[j];
        bo += rr[j] * kx[j] * rkc[j];
      }
      ss = reduce16(ss);
      bo = reduce16(bo);
      float inv = 1.f / fmaxf(sqrtf(ss), 1e-12f);
      *(uint2*)(p.kk + (size_t)t * 256 + c4) = make_uint2(pack2(kq[0] * inv, kq[1] * inv), pack2(kq[2] * inv, kq[3] * inv));
      if (l15 == 0) p.bonus[(size_t)t * 4 + (lane >> 4)] = bo;
#pragma unroll
      for (int i = 0; i < 6; i++) {
        float cz = bf2f(sc[i]);
        float pz = hp ? bf2f(sp[i]) : 0.f;
        float nz = hn ? bf2f(sn[i]) : 0.f;
        float o = cz + m0s[i] * (pz - cz) + m1s[i] * (nz - cz);
        if (i < 2) o = tanh_(o);
        else if (i >= 4) o = sigm(o);
        p.S1[(size_t)t * 384 + lane + 64 * i] = f2bf(o);
      }
    }
  }
}

DI void phase_smallgemm(const Params& p, int l, int B, int N, char* lds, int bid, int nb, int tid) {
  TileIter it{bid, nb, 0};
  const int MT = T_SUB / 128;
  {
    const int NT = 3;
    for (int itx = 0;; itx++) {
      int nt, mt;
      if (!xcd_tile(itx, bid, nb, MT, NT, mt, nt)) break;
      int m0 = mt * 128, n0 = nt * 128;
      auto rowfn = [&](int r) -> const void* { return p.cqn + (size_t)(m0 + r) * 256; };
      u16* Q = p.Q;
      auto epi = [&](f32x4(&acc)[4][4], int rbase, int cbase) {
        const float SC = 0.10206207261596577f * LOG2E;
        EPI_LOOP({ st_bf4(Q + (size_t)(m0 + row) * 384 + n0 + col, v * SC); })
      };
      gemm_tile<false>(rowfn, p.wuq_t + ((size_t)l * 384 + n0) * 256, 256, epi, lds, tid);
    }
  }
  {
    const int NT = 4;
    for (int itx = 0;; itx++) {
      int nt, mt;
      if (!xcd_tile(itx, bid, nb, MT, NT, mt, nt)) break;
      int m0 = mt * 128, n0 = nt * 128;
      auto rowfn = [&](int r) -> const void* { return p.ckvn + (size_t)(m0 + r) * 128; };
      u16* Kb = p.Kb;
      u16* Vt = p.Vt;
      auto epi = [&](f32x4(&acc)[4][4], int rbase, int cbase) {
        EPI_LOOP({
          int c = n0 + col;
          int tk = m0 + row;
          if (c < 256) {
            int h = c >> 6, d = c & 63;
            st_bf4(Kb + (size_t)tk * 384 + h * 96 + d, v);
          } else {
            int cc = c - 256;
            int b = tk / N, nn = tk - b * N;
            u16* dst = Vt + ((size_t)(b * 256 + cc)) * N + nn;
            dst[0] = f2bf(v[0]);
            dst[(size_t)N] = f2bf(v[1]);
            dst[(size_t)2 * N] = f2bf(v[2]);
            dst[(size_t)3 * N] = f2bf(v[3]);
          }
        })
      };
      gemm_tile<false>(rowfn, p.wkv_t + ((size_t)l * 512 + n0) * 128, 128, epi, lds, tid);
    }
  }
  for (int d = 0; d < 2; d++) {
    const int NT = 2;
    for (int itx = 0;; itx++) {
      int nt, mt;
      if (!xcd_tile(itx, bid, nb, MT, NT, mt, nt)) break;
      int m0 = mt * 128, n0 = nt * 128;
      auto rowfn = [&](int r) -> const void* { return p.S1 + (size_t)(m0 + r) * 384 + d * 64; };
      u16* dst = p.dec + (size_t)d * T_SUB * 256;
      const float* w0 = p.rw_w0 + (l * 2 + d) * 256;
      auto epi = [&](f32x4(&acc)[4][4], int rbase, int cbase) {
        EPI_LOOP({
          f32x4 o;
          for (int j = 0; j < 4; j++) o[j] = __expf(-0.6065306597126334f * sigm(w0[n0 + col + j] + v[j]));
          st_bf4(dst + (size_t)(m0 + row) * 256 + n0 + col, o);
        })
      };
      gemm_tile<false>(rowfn, p.wup_t + ((size_t)(l * 2 + d) * 256 + n0) * 64, 64, epi, lds, tid);
    }
  }
  for (int d = 0; d < 2; d++) {
    const int NT = 2;
    for (int itx = 0;; itx++) {
      int nt, mt;
      if (!xcd_tile(itx, bid, nb, MT, NT, mt, nt)) break;
      int m0 = mt * 128, n0 = nt * 128;
      auto rowfn = [&](int r) -> const void* { return p.S1 + (size_t)(m0 + r) * 384 + 128 + d * 64; };
      u16* dka = p.kka + (size_t)d * T_SUB * 256;
      u16* dkt = p.kt + (size_t)d * T_SUB * 256;
      const float* a0 = p.rw_a0 + (l * 2 + d) * 256;
      const float* ka = p.rw_ka + l * 256;
      const u16* kkp = p.kk;
      const u16* ksp = p.ks;
      auto epi = [&](f32x4(&acc)[4][4], int rbase, int cbase) {
        EPI_LOOP({
          size_t o = (size_t)(m0 + row) * 256 + n0 + col;
          uint2 kkr = *(const uint2*)(kkp + o);
          uint2 ksr = *(const uint2*)(ksp + o);
          float kkv[4] = {blo(kkr.x), bhi(kkr.x), blo(kkr.y), bhi(kkr.y)};
          float ksv[4] = {blo(ksr.x), bhi(ksr.x), blo(ksr.y), bhi(ksr.y)};
          f32x4 o1, o2;
          for (int j = 0; j < 4; j++) {
            float a = sigm(a0[n0 + col + j] + v[j]);
            o1[j] = kkv[j] * a;
            o2[j] = ksv[j] * (1.f + (a - 1.f) * ka[n0 + col + j]);
          }
          st_bf4(dka + o, o1);
          st_bf4(dkt + o, o2);
        })
      };
      gemm_tile<false>(rowfn, p.aup_t + ((size_t)(l * 2 + d) * 256 + n0) * 64, 64, epi, lds, tid);
    }
  }
  {
    const int NT = 2;
    for (int itx = 0;; itx++) {
      int nt, mt;
      if (!xcd_tile(itx, bid, nb, MT, NT, mt, nt)) break;
      int m0 = mt * 128, n0 = nt * 128;
      auto rowfn = [&](int r) -> const void* { return p.S1 + (size_t)(m0 + r) * 384 + 256; };
      u16* dst = p.gD;
      auto epi = [&](f32x4(&acc)[4][4], int rbase, int cbase) {
        EPI_LOOP({ st_bf4(dst + (size_t)(m0 + row) * 256 + n0 + col, v); })
      };
      gemm_tile<false>(rowfn, p.gup_t + ((size_t)l * 256 + n0) * 128, 128, epi, lds, tid);
    }
  }
}

DI bf16x8 pack8(const f32x16& s, int o) {
  u32x4_t r = {pack2(s[o], s[o + 1]), pack2(s[o + 2], s[o + 3]), pack2(s[o + 4], s[o + 5]), pack2(s[o + 6], s[o + 7])};
  return __builtin_bit_cast(bf16x8, r);
}

constexpr int AT_KP = 208, AT_VP = 144, AT_BUF = 64 * AT_KP + 64 * AT_VP;
DI void attn_task(const Params& p, int task, int N, char* lds, int tid) {
  const int lane = tid & 63, wv = tid >> 6, r = lane & 31, hf = lane >> 5;
  const int nqb = N >> 7;
  {
    const int qb = task % nqb, bh = task / nqb, h = bh & 3, b = bh >> 2;
    const size_t tb = (size_t)b * N;
    const int q = qb * 128 + wv * 32 + r;
    bf16x8 qf[6];
    {
      const u16* qrow = p.Q + (tb + q) * 384 + h * 96;
#pragma unroll
      for (int ks = 0; ks < 4; ks++) qf[ks] = *(const bf16x8*)(qrow + ks * 16 + hf * 8);
      bf16x8 x1r = *(const bf16x8*)(qrow + 64 + hf * 8);
      bf16x8 x2r = *(const bf16x8*)(qrow + 80 + hf * 8);
      const float* cp = p.ropec + q * 16 + hf * 8;
      const float* sp = p.ropes + q * 16 + hf * 8;
      float ra[8], rb[8];
#pragma unroll
      for (int j = 0; j < 8; j++) {
        float xa = bf2f((u16)x1r[j]), ya = bf2f((u16)x2r[j]);
        float c0 = cp[j], s0 = sp[j];
        ra[j] = xa * c0 - ya * s0;
        rb[j] = xa * s0 + ya * c0;
      }
      u32x4_t o1 = {pack2(ra[0], ra[1]), pack2(ra[2], ra[3]), pack2(ra[4], ra[5]), pack2(ra[6], ra[7])};
      u32x4_t o2 = {pack2(rb[0], rb[1]), pack2(rb[2], rb[3]), pack2(rb[4], rb[5]), pack2(rb[6], rb[7])};
      qf[4] = __builtin_bit_cast(bf16x8, o1);
      qf[5] = __builtin_bit_cast(bf16x8, o2);
    }
    const u16* Kg = p.Kb + tb * 384 + h * 96;
    const u16* Vg = p.Vt + ((size_t)(b * 4 + h) * 64) * N;
    uint4 kr0, kr1, kr2, vr0, vr1;
    const int lkey = tid >> 2, lpart = tid & 3;
    const int lrow = swap23(lkey);
#define AT_GLOAD(kt_)                                                              \
  {                                                                                \
    const u16* kp_ = Kg + (size_t)((kt_) * 64 + lkey) * 384 + lpart * 24;          \
    kr0 = *(const uint4*)(kp_);                                                    \
    kr1 = *(const uint4*)(kp_ + 8);                                                \
    kr2 = *(const uint4*)(kp_ + 16);                                               \
    const u16* vp_ = Vg + (size_t)lkey * N + (kt_) * 64 + lpart * 16;              \
    vr0 = *(const uint4*)(vp_);                                                    \
    vr1 = *(const uint4*)(vp_ + 8);                                                \
  }
#define AT_LSTORE(buf_)                                                            \
  {                                                                                \
    char* Kl_ = lds + (buf_) * AT_BUF;                                             \
    char* Vl_ = Kl_ + 64 * AT_KP;                                                  \
    *(uint4*)(Kl_ + lrow * AT_KP + (lpart * 3 + 0) * 16) = kr0;                    \
    *(uint4*)(Kl_ + lrow * AT_KP + (lpart * 3 + 1) * 16) = kr1;                    \
    *(uint4*)(Kl_ + lrow * AT_KP + (lpart * 3 + 2) * 16) = kr2;                    \
    *(uint4*)(Vl_ + lkey * AT_VP + (lpart * 2 + 0) * 16) = vr0;                    \
    *(uint4*)(Vl_ + lkey * AT_VP + (lpart * 2 + 1) * 16) = vr1;                    \
  }
    f32x16 O0, O1;
#pragma unroll
    for (int i = 0; i < 16; i++) { O0[i] = 0.f; O1[i] = 0.f; }
    float mrun = 0.f, lrun = 0.f;
    const int nt = N >> 6;
    __syncthreads();
    AT_GLOAD(0);
    AT_LSTORE(0);
    __syncthreads();
    for (int kt = 0; kt < nt; kt++) {
      if (kt + 1 < nt) AT_GLOAD(kt + 1);
      __builtin_amdgcn_sched_barrier(0);
      const char* Kl = lds + (kt & 1) * AT_BUF;
      const char* Vl = Kl + 64 * AT_KP;
      f32x16 S0, S1;
      {
        const float nm = -mrun;
#pragma unroll
        for (int i = 0; i < 16; i++) { S0[i] = nm; S1[i] = nm; }
      }
#pragma unroll
      for (int ks = 0; ks < 6; ks++) {
        bf16x8 a0 = *(const bf16x8*)(Kl + r * AT_KP + ks * 32 + hf * 16);
        bf16x8 a1 = *(const bf16x8*)(Kl + (32 + r) * AT_KP + ks * 32 + hf * 16);
        S0 = __builtin_amdgcn_mfma_f32_32x32x16_bf16(a0, qf[ks], S0, 0, 0, 0);
        S1 = __builtin_amdgcn_mfma_f32_32x32x16_bf16(a1, qf[ks], S1, 0, 0, 0);
      }
      float mx = fmaxf(S0[0], S1[0]);
#pragma unroll
      for (int i = 1; i < 16; i++) mx = fmaxf(mx, fmaxf(S0[i], S1[i]));
      if (__any((mx > 12.f) || (kt == 0))) {
        const float mq = fmaxf(mx, __shfl_xor(mx, 32));
        const float shift = (kt == 0) ? mq : ((mq > 12.f) ? mq : 0.f);
        const float sc = (kt == 0) ? 1.f : ex2(-shift);
        mrun += shift;
        lrun *= sc;
#pragma unroll
        for (int i = 0; i < 16; i++) {
          S0[i] -= shift;
          S1[i] -= shift;
          O0[i] *= sc;
          O1[i] *= sc;
        }
      }
      float ls = 0.f;
#pragma unroll
      for (int i = 0; i < 16; i++) {
        S0[i] = ex2(S0[i]);
        S1[i] = ex2(S1[i]);
        ls += S0[i] + S1[i];
      }
      lrun += ls;
#pragma unroll
      for (int sp = 0; sp < 4; sp++) {
        bf16x8 pb = (sp < 2) ? pack8(S0, (sp & 1) * 8) : pack8(S1, (sp & 1) * 8);
        bf16x8 v0 = *(const bf16x8*)(Vl + r * AT_VP + sp * 32 + hf * 16);
        bf16x8 v1 = *(const bf16x8*)(Vl + (32 + r) * AT_VP + sp * 32 + hf * 16);
        O0 = __builtin_amdgcn_mfma_f32_32x32x16_bf16(v0, pb, O0, 0, 0, 0);
        O1 = __builtin_amdgcn_mfma_f32_32x32x16_bf16(v1, pb, O1, 0, 0, 0);
      }
      __builtin_amdgcn_sched_barrier(0);
      if (kt + 1 < nt) AT_LSTORE((kt + 1) & 1);
      __syncthreads();
    }
    float lt = lrun + __shfl_xor(lrun, 32);
    float inv = 1.f / lt;
    u16* orow = p.cat + (tb + q) * 1024 + h * 64;
#pragma unroll
    for (int g = 0; g < 4; g++) {
      int d0 = 8 * g + 4 * hf;
      *(uint2*)(orow + d0) = make_uint2(pack2(O0[4 * g] * inv, O0[4 * g + 1] * inv), pack2(O0[4 * g + 2] * inv, O0[4 * g + 3] * inv));
      *(uint2*)(orow + 32 + d0) = make_uint2(pack2(O1[4 * g] * inv, O1[4 * g + 1] * inv), pack2(O1[4 * g + 2] * inv, O1[4 * g + 3] * inv));
    }
  }
}

DI void na_task(const Params& p, int l, int task, int N, int tid) {
  const int lane = tid & 63, head = tid >> 6, r = lane & 31, hf = lane >> 5;
  const int rows = N >> 6;
  const int nrb = rows >> 1;
  const float* bias = p.na_bias + (size_t)(l * 4 + head) * 15 * 31;
  {
    const int cb = task & 3, rb = (task >> 2) % nrb, b = (task >> 2) / nrb;
    const size_t tb = (size_t)b * N;
    const int qrow0 = rb * 2;
    const int rstart0 = clampi(qrow0 - 4, 0, rows - 8);
    const int k0 = clampi(rstart0, 0, rows - 9);
    const int kstart = clampi(cb * 16 - 8, 0, 32);
    const int iq = r >> 4, u = r & 15;
    const int qrow = qrow0 + iq, qcol = cb * 16 + u;
    const int rstart = clampi(qrow - 4, 0, rows - 8);
    const int cstart = clampi(qcol - 8, 0, 48);
    bf16x8 qf[4];
    {
      const u16* qp = p.z + (tb + qrow * 64 + qcol) * ZLD + ZB_OFF + head * 64;
#pragma unroll
      for (int ks = 0; ks < 4; ks++) qf[ks] = *(const bf16x8*)(qp + ks * 16 + hf * 8);
    }
    f32x16 O0, O1;
#pragma unroll
    for (int i = 0; i < 16; i++) { O0[i] = 0.f; O1[i] = 0.f; }
    float mrun = -1e30f, lrun = 0.f;
    const int wk = swap23(r);
    for (int j = 0; j < 9; j++) {
      const int krow = k0 + j;
      const u16* kp = p.z + (tb + krow * 64 + kstart + wk) * ZLD + ZB_OFF + 256 + head * 64;
      f32x16 S;
#pragma unroll
      for (int i = 0; i < 16; i++) S[i] = 0.f;
#pragma unroll
      for (int ks = 0; ks < 4; ks++) {
        bf16x8 a = *(const bf16x8*)(kp + ks * 16 + hf * 8);
        S = __builtin_amdgcn_mfma_f32_32x32x16_bf16(a, qf[ks], S, 0, 0, 0);
      }
      const bool rok = (krow >= rstart) && (krow < rstart + 8);
      const int drow = clampi(krow - qrow + 7, 0, 14);
      const float* brow = bias + drow * 31;
      float mx = -1e30f;
#pragma unroll
      for (int i = 0; i < 16; i++) {
        int w = 16 * (i >> 3) + 8 * hf + 4 * ((i >> 2) & 1) + (i & 3);
        int kcol = kstart + w;
        bool ok = rok && (kcol >= cstart) && (kcol < cstart + 16);
        int dcol = clampi(kcol - qcol + 15, 0, 30);
        float s = (S[i] * 0.125f + brow[dcol]) * LOG2E;
        S[i] = ok ? s : -1e30f;
        mx = fmaxf(mx, S[i]);
      }
      mx = fmaxf(mx, __shfl_xor(mx, 32));
      float mn = fmaxf(mrun, mx);
      float alpha = ex2(mrun - mn);
      mrun = mn;
      float ls = 0.f;
#pragma unroll
      for (int i = 0; i < 16; i++) {
        float pv = (S[i] > -1e29f) ? ex2(S[i] - mn) : 0.f;
        S[i] = pv;
        ls += pv;
      }
      lrun = lrun * alpha + ls;
#pragma unroll
      for (int i = 0; i < 16; i++) { O0[i] *= alpha; O1[i] *= alpha; }
      const u16* vbase = p.z + (tb + krow * 64 + kstart) * ZLD + ZB_OFF + 512 + head * 64 + r;
#pragma unroll
      for (int s = 0; s < 2; s++) {
        bf16x8 pb = pack8(S, s * 8);
        bf16x8 v0, v1;
#pragma unroll
        for (int jj = 0; jj < 8; jj++) {
          const u16* vp = vbase + (size_t)(16 * s + 8 * hf + jj) * ZLD;
          v0[jj] = (short)vp[0];
          v1[jj] = (short)vp[32];
        }
        O0 = __builtin_amdgcn_mfma_f32_32x32x16_bf16(v0, pb, O0, 0, 0, 0);
        O1 = __builtin_amdgcn_mfma_f32_32x32x16_bf16(v1, pb, O1, 0, 0, 0);
      }
    }
    float lt = lrun + __shfl_xor(lrun, 32);
    float inv = 1.f / lt;
    u16* orow = p.cat + (tb + qrow * 64 + qcol) * 1024 + 256 + head * 64;
#pragma unroll
    for (int g = 0; g < 4; g++) {
      int d0 = 8 * g + 4 * hf;
      *(uint2*)(orow + d0) = make_uint2(pack2(O0[4 * g] * inv, O0[4 * g + 1] * inv), pack2(O0[4 * g + 2] * inv, O0[4 * g + 3] * inv));
      *(uint2*)(orow + 32 + d0) = make_uint2(pack2(O1[4 * g] * inv, O1[4 * g + 1] * inv), pack2(O1[4 * g + 2] * inv, O1[4 * g + 3] * inv));
    }
  }
}

using f32x2 = __attribute__((ext_vector_type(2))) float;
constexpr int SC_STEPS = 16;

DI void sc_store(char* buf, int dst, uint4 R, bool hgw) {
  float4 lo = make_float4(blo(R.x), bhi(R.x), blo(R.y), bhi(R.y));
  float4 hi = make_float4(blo(R.z), bhi(R.z), blo(R.w), bhi(R.w));
  *(float4*)(buf + dst) = lo;
  *(float4*)(buf + dst + 16) = hi;
  if (hgw) {
    *(float4*)(buf + dst + 256) = make_float4(1.f - lo.x, 1.f - lo.y, 1.f - lo.z, 1.f - lo.w);
    *(float4*)(buf + dst + 272) = make_float4(1.f - hi.x, 1.f - hi.y, 1.f - hi.z, 1.f - hi.w);
  }
}

DI float reduce8(float v) {
  v += dpp_f<0xB1>(v);
  v += dpp_f<0x4E>(v);
  v += dpp_f<0x141>(v);
  return v;
}

template <bool RW>
DI void scan_task(const Params& p, int task, int N, char* lds, int tid) {
  constexpr int NA = RW ? 5 : 3;
  constexpr int VOFF = SC_STEPS * NA * 256;
  constexpr int BUF = VOFF + SC_STEPS * 128;
  const int lane = tid & 63, wv = tid >> 6, kq = lane & 7, rg = lane >> 3;
  const int rq = task & 1, hh = (task >> 1) & 3, dir = (task >> 3) & 1, b = task >> 4;
  const size_t tb = (size_t)b * N;
  const int sub = tid >> 7, lt = tid & 127, lstep = lt >> 3, lpart = lt & 7;
  const int vstep = lt >> 2, vq = lt & 3;
  const u16 *src0 = nullptr, *src1 = nullptr, *src2 = nullptr;
  int dst0 = 0, dst1 = 0, dst2 = 0, st0 = 0, st1 = 0, st2 = 0;
  bool act0 = false, act1 = false, act2 = false, hgw = false;
  int ld;
  const int acol = hh * 64 + lpart * 8;
  const int vcol = hh * 64 + rq * 32 + vq * 8;
  const int vdst = VOFF + vstep * 128 + vq * 32;
  if (RW) {
    ld = 256;
    act0 = true; st0 = lstep;
    src0 = sub ? (p.dec + (size_t)dir * T_SUB * 256 + acol) : (p.rs + acol);
    dst0 = (lstep * NA + (sub ? 1 : 0)) * 256 + lpart * 32;
    act1 = true; st1 = lstep;
    src1 = sub ? (p.kk + acol) : (p.kt + (size_t)dir * T_SUB * 256 + acol);
    dst1 = (lstep * NA + (sub ? 3 : 2)) * 256 + lpart * 32;
    if (sub == 0) { act2 = true; st2 = lstep; src2 = p.kka + (size_t)dir * T_SUB * 256 + acol; dst2 = (lstep * NA + 4) * 256 + lpart * 32; }
    else { act2 = lt < 64; st2 = vstep; src2 = p.vs + vcol; dst2 = vdst; }
  } else {
    ld = ZLD;
    act0 = true; st0 = lstep;
    src0 = sub ? (p.z + ZC_OFF + 256 * (1 + dir) + acol) : (p.z + ZC_OFF + acol);
    dst0 = (lstep * NA + (sub ? 1 : 0)) * 256 + lpart * 32;
    hgw = sub != 0;
    if (sub == 0) { act1 = lt < 64; st1 = vstep; src1 = p.z + ZC_OFF + 768 + vcol; dst1 = vdst; }
  }
  u16* pout = (RW ? p.oD : p.oC) + (size_t)dir * T_SUB * 256 + hh * 64 + rq * 32 + wv * 8 + rg;
  pout += (tb + (dir ? (N - 1) : 0)) * 256;
  const int ostride = dir ? -256 : 256;

#define SC_TOK(c_, st_) (tb + (size_t)(dir ? (N - 1 - ((c_) * SC_STEPS + (st_))) : ((c_) * SC_STEPS + (st_))))
#define SC_ISSUE(Ra, Rb, Rc, c_)                                               \
  {                                                                            \
    if (act0) Ra = *(const uint4*)(src0 + SC_TOK(c_, st0) * ld);               \
    if (act1) Rb = *(const uint4*)(src1 + SC_TOK(c_, st1) * ld);               \
    if (act2) Rc = *(const uint4*)(src2 + SC_TOK(c_, st2) * ld);               \
  }
#define SC_STORE(Ra, Rb, Rc, buf_)                                             \
  {                                                                            \
    if (act0) sc_store(buf_, dst0, Ra, hgw);                                   \
    if (act1) sc_store(buf_, dst1, Rb, false);                                 \
    if (act2) sc_store(buf_, dst2, Rc, false);                                 \
  }
  f32x2 S0 = {0.f, 0.f}, S1 = {0.f, 0.f}, S2 = {0.f, 0.f}, S3 = {0.f, 0.f};
#define SC_LD(buf_, s_, ra_, rb_, wa_, wb_, ta_, tb_, ka_, kb_, aa_, ab_, v_)                \
  {                                                                                          \
    const char* rowp_ = (buf_) + (s_) * NA * 256 + kq * 32;                                  \
    ra_ = *(const float4*)(rowp_);                                                           \
    rb_ = *(const float4*)(rowp_ + 16);                                                      \
    wa_ = *(const float4*)(rowp_ + 256);                                                     \
    wb_ = *(const float4*)(rowp_ + 272);                                                     \
    ta_ = *(const float4*)(rowp_ + 512);                                                     \
    tb_ = *(const float4*)(rowp_ + 528);                                                     \
    if (RW) {                                                                                \
      ka_ = *(const float4*)(rowp_ + 768);                                                   \
      kb_ = *(const float4*)(rowp_ + 784);                                                   \
      aa_ = *(const float4*)(rowp_ + 1024);                                                  \
      ab_ = *(const float4*)(rowp_ + 1040);                                                  \
    }                                                                                        \
    v_ = *(const float*)((buf_) + VOFF + (s_) * 128 + (wv * 8 + rg) * 4);                    \
  }
#define F2A(q_) f32x2{(q_).x, (q_).y}
#define F2B(q_) f32x2{(q_).z, (q_).w}
#define SC_COMPUTE(buf_)                                                                     \
  {                                                                                          \
    float oselA = 0.f, oselB = 0.f;                                                          \
    float4 ra, rb, wa, wb, ta, tb_, ka, kb, aa, ab, nra, nrb, nwa, nwb, nta, ntb, nka, nkb, naa, nab; \
    float vv, nvv;                                                                           \
    ka = kb = aa = ab = nka = nkb = naa = nab = make_float4(0.f, 0.f, 0.f, 0.f);             \
    SC_LD(buf_, 0, ra, rb, wa, wb, ta, tb_, ka, kb, aa, ab, vv);                             \
    _Pragma("unroll") for (int s = 0; s < SC_STEPS; s++) {                                   \
      if (s + 1 < SC_STEPS) SC_LD(buf_, s + 1, nra, nrb, nwa, nwb, nta, ntb, nka, nkb, naa, nab, nvv); \
      f32x2 u0 = F2A(ta) * vv, u1 = F2B(ta) * vv, u2 = F2A(tb_) * vv, u3 = F2B(tb_) * vv;     \
      if (RW) {                                                                              \
        f32x2 pa = S0 * F2A(ka), pb = S1 * F2B(ka);                                          \
        pa = S2 * F2A(kb) + pa;                                                              \
        pb = S3 * F2B(kb) + pb;                                                              \
        pa = pa + pb;                                                                        \
        const float sa = -reduce8(pa.x + pa.y);                                              \
        u0 = F2A(aa) * sa + u0;                                                              \
        u1 = F2B(aa) * sa + u1;                                                              \
        u2 = F2A(ab) * sa + u2;                                                              \
        u3 = F2B(ab) * sa + u3;                                                              \
      }                                                                                      \
      S0 = S0 * F2A(wa) + u0;                                                                \
      S1 = S1 * F2B(wa) + u1;                                                                \
      S2 = S2 * F2A(wb) + u2;                                                                \
      S3 = S3 * F2B(wb) + u3;                                                                \
      f32x2 qa = S0 * F2A(ra), qb = S1 * F2B(ra);                                            \
      qa = S2 * F2A(rb) + qa;                                                                \
      qb = S3 * F2B(rb) + qb;                                                                \
      qa = qa + qb;                                                                          \
      const float o = reduce8(qa.x + qa.y);                                                  \
      if (s < 8) oselA = (kq == s) ? o : oselA;                                              \
      else oselB = (kq == s - 8) ? o : oselB;                                                \
      ra = nra; rb = nrb; wa = nwa; wb = nwb; ta = nta; tb_ = ntb;                           \
      ka = nka; kb = nkb; aa = naa; ab = nab; vv = nvv;                                      \
    }                                                                                        \
    pout[kq * ostride] = f2bf(oselA);                                                        \
    pout[(kq + 8) * ostride] = f2bf(oselB);                                                  \
    pout += SC_STEPS * ostride;                                                              \
  }
  uint4 A0 = make_uint4(0, 0, 0, 0), A1 = A0, A2 = A0, B0 = A0, B1 = A0, B2 = A0;
  char* buf0 = lds;
  char* buf1 = lds + BUF;
  const int nch = N / SC_STEPS;
  __syncthreads();
  SC_ISSUE(A0, A1, A2, 0);
  SC_ISSUE(B0, B1, B2, 1);
  SC_STORE(A0, A1, A2, buf0);
  __syncthreads();
  for (int c = 0; c < nch; c += 2) {
    if (c + 2 < nch) SC_ISSUE(A0, A1, A2, c + 2);
    __builtin_amdgcn_sched_barrier(0);
    SC_COMPUTE(buf0);
    __builtin_amdgcn_sched_barrier(0);
    SC_STORE(B0, B1, B2, buf1);
    __syncthreads();
    if (c + 3 < nch) SC_ISSUE(B0, B1, B2, c + 3);
    __builtin_amdgcn_sched_barrier(0);
    SC_COMPUTE(buf1);
    __builtin_amdgcn_sched_barrier(0);
    if (c + 2 < nch) SC_STORE(A0, A1, A2, buf0);
    __syncthreads();
  }
}

template <bool RW>
DI void scan_task16(const Params& p, int task, int N, char* lds, int tid) {
  constexpr int NA = RW ? 5 : 3;
  constexpr int VOFF = SC_STEPS * NA * 256;
  constexpr int BUF = VOFF + SC_STEPS * 64;
  const int lane = tid & 63, wv = tid >> 6, kq = lane & 15, rg = lane >> 4;
  const int rq = task & 3, hh = (task >> 2) & 3, dir = (task >> 4) & 1, b = task >> 5;
  const size_t tb = (size_t)b * N;
  const int sub = tid >> 7, lt = tid & 127, lstep = lt >> 3, lpart = lt & 7;
  const int vstep = lt >> 1, vhalf = lt & 1;
  const u16 *src0 = nullptr, *src1 = nullptr, *src2 = nullptr;
  int dst0 = 0, dst1 = 0, dst2 = 0, st0 = 0, st1 = 0, st2 = 0;
  bool act0 = false, act1 = false, act2 = false, hgw = false;
  int ld;
  const int acol = hh * 64 + lpart * 8;
  const int vcol = hh * 64 + rq * 16 + vhalf * 8;
  const int vdst = VOFF + vstep * 64 + vhalf * 32;
  if (RW) {
    ld = 256;
    act0 = true; st0 = lstep;
    src0 = sub ? (p.dec + (size_t)dir * T_SUB * 256 + acol) : (p.rs + acol);
    dst0 = (lstep * NA + (sub ? 1 : 0)) * 256 + lpart * 32;
    act1 = true; st1 = lstep;
    src1 = sub ? (p.kk + acol) : (p.kt + (size_t)dir * T_SUB * 256 + acol);
    dst1 = (lstep * NA + (sub ? 3 : 2)) * 256 + lpart * 32;
    if (sub == 0) { act2 = true; st2 = lstep; src2 = p.kka + (size_t)dir * T_SUB * 256 + acol; dst2 = (lstep * NA + 4) * 256 + lpart * 32; }
    else { act2 = lt < 32; st2 = vstep; src2 = p.vs + vcol; dst2 = vdst; }
  } else {
    ld = ZLD;
    act0 = true; st0 = lstep;
    src0 = sub ? (p.z + ZC_OFF + 256 * (1 + dir) + acol) : (p.z + ZC_OFF + acol);
    dst0 = (lstep * NA + (sub ? 1 : 0)) * 256 + lpart * 32;
    hgw = sub != 0;
    if (sub == 0) { act1 = lt < 32; st1 = vstep; src1 = p.z + ZC_OFF + 768 + vcol; dst1 = vdst; }
  }
  u16* pout = (RW ? p.oD : p.oC) + (size_t)dir * T_SUB * 256 + hh * 64 + rq * 16 + wv * 4 + rg;
  pout += (tb + (dir ? (N - 1) : 0)) * 256;
  const int ostride = dir ? -256 : 256;

#define SC16_TOK(c_, st_) (tb + (size_t)(dir ? (N - 1 - ((c_) * SC_STEPS + (st_))) : ((c_) * SC_STEPS + (st_))))
#define SC16_ISSUE(Ra, Rb, Rc, c_)                                               \
  {                                                                            \
    if (act0) Ra = *(const uint4*)(src0 + SC16_TOK(c_, st0) * ld);               \
    if (act1) Rb = *(const uint4*)(src1 + SC16_TOK(c_, st1) * ld);               \
    if (act2) Rc = *(const uint4*)(src2 + SC16_TOK(c_, st2) * ld);               \
  }
#define SC16_STORE(Ra, Rb, Rc, buf_)                                             \
  {                                                                            \
    if (act0) sc_store(buf_, dst0, Ra, hgw);                                   \
    if (act1) sc_store(buf_, dst1, Rb, false);                                 \
    if (act2) sc_store(buf_, dst2, Rc, false);                                 \
  }
  f32x2 S01 = {0.f, 0.f}, S23 = {0.f, 0.f};
#define SC16_LD(buf_, s_, r_, w_, t_, k_, a_, v_)                                              \
  {                                                                                          \
    const char* rowp_ = (buf_) + (s_) * NA * 256 + kq * 16;                                  \
    r_ = *(const float4*)(rowp_);                                                            \
    w_ = *(const float4*)(rowp_ + 256);                                                      \
    t_ = *(const float4*)(rowp_ + 512);                                                      \
    if (RW) {                                                                                \
      k_ = *(const float4*)(rowp_ + 768);                                                    \
      a_ = *(const float4*)(rowp_ + 1024);                                                   \
    }                                                                                        \
    v_ = *(const float*)((buf_) + VOFF + (s_) * 64 + (wv * 4 + rg) * 4);                     \
  }
#define SC16_COMPUTE(buf_)                                                                     \
  {                                                                                          \
    float osel = 0.f;                                                                        \
    float4 r4, w4, t4, k4, a4, nr4, nw4, nt4, nk4, na4;                                      \
    float vv, nvv;                                                                           \
    k4 = a4 = nk4 = na4 = make_float4(0.f, 0.f, 0.f, 0.f);                                   \
    SC16_LD(buf_, 0, r4, w4, t4, k4, a4, vv);                                                  \
    _Pragma("unroll") for (int s = 0; s < SC_STEPS; s++) {                                   \
      if (s + 1 < SC_STEPS) SC16_LD(buf_, s + 1, nr4, nw4, nt4, nk4, na4, nvv);                \
      f32x2 ta = f32x2{t4.x, t4.y} * vv, tb2 = f32x2{t4.z, t4.w} * vv;                       \
      if (RW) {                                                                              \
        f32x2 pp = S01 * f32x2{k4.x, k4.y};                                                  \
        pp = S23 * f32x2{k4.z, k4.w} + pp;                                                   \
        const float sa = -reduce16(pp.x + pp.y);                                             \
        ta = f32x2{a4.x, a4.y} * sa + ta;                                                    \
        tb2 = f32x2{a4.z, a4.w} * sa + tb2;                                                  \
      }                                                                                      \
      S01 = S01 * f32x2{w4.x, w4.y} + ta;                                                    \
      S23 = S23 * f32x2{w4.z, w4.w} + tb2;                                                   \
      f32x2 qq = S01 * f32x2{r4.x, r4.y};                                                    \
      qq = S23 * f32x2{r4.z, r4.w} + qq;                                                     \
      const float o = reduce16(qq.x + qq.y);                                                 \
      osel = (kq == s) ? o : osel;                                                           \
      r4 = nr4; w4 = nw4; t4 = nt4; k4 = nk4; a4 = na4; vv = nvv;                            \
    }                                                                                        \
    pout[kq * ostride] = f2bf(osel);                                                         \
    pout += SC_STEPS * ostride;                                                              \
  }
  uint4 A0 = make_uint4(0, 0, 0, 0), A1 = A0, A2 = A0, B0 = A0, B1 = A0, B2 = A0;
  char* buf0 = lds;
  char* buf1 = lds + BUF;
  const int nch = N / SC_STEPS;
  __syncthreads();
  SC16_ISSUE(A0, A1, A2, 0);
  SC16_ISSUE(B0, B1, B2, 1);
  SC16_STORE(A0, A1, A2, buf0);
  __syncthreads();
  for (int c = 0; c < nch; c += 2) {
    if (c + 2 < nch) SC16_ISSUE(A0, A1, A2, c + 2);
    __builtin_amdgcn_sched_barrier(0);
    SC16_COMPUTE(buf0);
    __builtin_amdgcn_sched_barrier(0);
    SC16_STORE(B0, B1, B2, buf1);
    __syncthreads();
    if (c + 3 < nch) SC16_ISSUE(B0, B1, B2, c + 3);
    __builtin_amdgcn_sched_barrier(0);
    SC16_COMPUTE(buf1);
    __builtin_amdgcn_sched_barrier(0);
    if (c + 2 < nch) SC16_STORE(A0, A1, A2, buf0);
    __syncthreads();
  }
}


DI void phase_mix(const Params& p, int l, int B, int N, unsigned* ctr, char* lds, int bid, int nb, int tid) {
  __shared__ int s_task[2];
  const bool wide = (N > 4096);
  const int nper = wide ? B * 32 : B * 16;
  const int nscan = 2 * nper;
  const int nattn = B * 4 * (N >> 7);
  const int nna = B * (N >> 7) * 4;
  const bool prefer_scan = bid < (nb >> 1);
  bool scan_dry = false, attn_dry = false;
  for (;;) {
    if (tid == 0) {
      int kind = -1, task = 0;
      for (int attempt = 0; attempt < 2 && kind < 0; attempt++) {
        const bool try_scan = (attempt == 0) == prefer_scan;
        if (try_scan) {
          if (!scan_dry) {
            const int t = (int)atomicAdd(&ctr[0], 1u);
            if (t < nscan) { kind = 0; task = t; } else scan_dry = true;
          }
        } else {
          if (!attn_dry) {
            const int t = (int)atomicAdd(&ctr[64], 1u);
            if (t < nattn + nna) { kind = 1; task = t; } else attn_dry = true;
          }
        }
      }
      s_task[0] = kind;
      s_task[1] = task;
    }
    __syncthreads();
    const int kind = s_task[0], task = s_task[1];
    __syncthreads();
    if (kind < 0) break;
    if (kind == 0) {
      if (wide) {
        if (task < nper) scan_task16<true>(p, task, N, lds, tid);
        else scan_task16<false>(p, task - nper, N, lds, tid);
      } else {
        if (task < nper) scan_task<true>(p, task, N, lds, tid);
        else scan_task<false>(p, task - nper, N, lds, tid);
      }
    } else {
      if (task < nattn) attn_task(p, task, N, lds, tid);
      else na_task(p, l, task - nattn, N, tid);
    }
  }
}

DI void phase_final(const Params& p, int l, int bid, int nb, int tid) {
  const int lane = tid & 63, wv = tid >> 6, c4 = lane * 4;
  float gn[4], lw[4], lbb[4];
#pragma unroll
  for (int j = 0; j < 4; j++) {
    gn[j] = p.hg_gnorm[l * 256 + c4 + j];
    lw[j] = p.rw_ln_w[l * 256 + c4 + j];
    lbb[j] = p.rw_ln_b[l * 256 + c4 + j];
  }
  for (int t = bid * 4 + wv; t < T_SUB; t += nb * 4) {
    const uint2 ca = *(const uint2*)(p.oC + (size_t)t * 256 + c4);
    const uint2 cb = *(const uint2*)(p.oC + (size_t)(T_SUB + t) * 256 + c4);
    const uint2 cg = *(const uint2*)(p.z + (size_t)t * ZLD + ZC_OFF + 1024 + c4);
    const uint2 da = *(const uint2*)(p.oD + (size_t)t * 256 + c4);
    const uint2 db = *(const uint2*)(p.oD + (size_t)(T_SUB + t) * 256 + c4);
    const float bo = p.bonus[(size_t)t * 4 + (lane >> 4)];
    const uint2 vr = *(const uint2*)(p.vs + (size_t)t * 256 + c4);
    const uint2 gr = *(const uint2*)(p.gD + (size_t)t * 256 + c4);
    {
      float o[4] = {blo(ca.x) + blo(cb.x), bhi(ca.x) + bhi(cb.x), blo(ca.y) + blo(cb.y), bhi(ca.y) + bhi(cb.y)};
      float ss = reduce16(o[0] * o[0] + o[1] * o[1] + o[2] * o[2] + o[3] * o[3]);
      float ri = rsqrtf(ss * (1.f / 64.f) + 1e-6f);
      float g[4] = {blo(cg.x), bhi(cg.x), blo(cg.y), bhi(cg.y)};
      float y[4];
#pragma unroll
      for (int j = 0; j < 4; j++) y[j] = o[j] * ri * gn[j] * (g[j] * sigm(g[j]));
      *(uint2*)(p.cat + (size_t)t * 1024 + 512 + c4) = make_uint2(pack2(y[0], y[1]), pack2(y[2], y[3]));
    }
    {
      float o[4] = {blo(da.x) + blo(db.x), bhi(da.x) + bhi(db.x), blo(da.y) + blo(db.y), bhi(da.y) + bhi(db.y)};
      float mu = reduce16(o[0] + o[1] + o[2] + o[3]) * (1.f / 64.f);
      float d0 = o[0] - mu, d1 = o[1] - mu, d2 = o[2] - mu, d3 = o[3] - mu;
      float var = reduce16(d0 * d0 + d1 * d1 + d2 * d2 + d3 * d3) * (1.f / 64.f);
      float ri = rsqrtf(var + 64e-5f);
      float vv[4] = {blo(vr.x), bhi(vr.x), blo(vr.y), bhi(vr.y)};
      float g[4] = {blo(gr.x), bhi(gr.x), blo(gr.y), bhi(gr.y)};
      float dd[4] = {d0, d1, d2, d3};
      float y[4];
#pragma unroll
      for (int j = 0; j < 4; j++) y[j] = (dd[j] * ri * lw[j] + lbb[j] + bo * vv[j]) * g[j];
      *(uint2*)(p.cat + (size_t)t * 1024 + 768 + c4) = make_uint2(pack2(y[0], y[1]), pack2(y[2], y[3]));
    }
  }
}

DI void phase_wout(const Params& p, int l, int tok0, char* lds, int bid, int nb, int tid) {
  const int NT = 8, MT = T_SUB / 128;
  for (int it = 0;; it++) {
    int nt, mt;
    if (!xcd_tile(it, bid, nb, MT, NT, mt, nt)) break;
    int m0 = mt * 128, n0 = nt * 128;
    auto rowfn = [&](int r) -> const void* { return p.cat + (size_t)(m0 + r) * 1024; };
    auto epi = [&](f32x4(&acc)[4][4], int rbase, int cbase) {
      EPI_LOOP({
        int tg = tok0 + m0 + row;
        float4 xv = *(const float4*)(xin_row(p, l, tg) + n0 + col);
        float4 o = make_float4(ALPHA_F * xv.x + v[0], ALPHA_F * xv.y + v[1], ALPHA_F * xv.z + v[2], ALPHA_F * xv.w + v[3]);
        *(float4*)(p.out + (size_t)tg * 1024 + n0 + col) = o;
      })
    };
    gemm_tile<false>(rowfn, p.wout_t + ((size_t)l * 1024 + n0) * 1024, 1024, epi, lds, tid);
  }
}

template <bool ROUTER>
DI void phase_ln(const Params& p, const float* g, const float* bta, const float* wrouter, int tok0, int ntok, char* lds,
                 int bid, int nb, int tid) {
  const int lane = tid & 63, wv = tid >> 6;
  float* wl = (float*)lds;
  if (ROUTER) {
    __syncthreads();
    for (int i = tid; i < 16384; i += NTHR) {
      int k = i >> 4, e = i & 15;
      wl[e * 1024 + k] = wrouter[i];
    }
    __syncthreads();
  }
  float4 x[4], xn[4];
  {
    const int t0 = bid * 4 + wv;
#pragma unroll
    for (int i = 0; i < 4; i++)
      x[i] = (t0 < ntok) ? *(const float4*)(p.out + (size_t)(tok0 + t0) * 1024 + i * 256 + lane * 4) : make_float4(0.f, 0.f, 0.f, 0.f);
  }
  for (int t = bid * 4 + wv; t < ntok; t += nb * 4) {
    const int tg = tok0 + t;
    float* xr = p.out + (size_t)tg * 1024;
    {
      const int tn = t + nb * 4;
#pragma unroll
      for (int i = 0; i < 4; i++)
        xn[i] = (tn < ntok) ? *(const float4*)(p.out + (size_t)(tok0 + tn) * 1024 + i * 256 + lane * 4) : make_float4(0.f, 0.f, 0.f, 0.f);
    }
    float s = 0.f;
#pragma unroll
    for (int i = 0; i < 4; i++) s += x[i].x + x[i].y + x[i].z + x[i].w;
    float mu = wave_sum(s) * (1.f / 1024.f);
    float vs = 0.f;
#pragma unroll
    for (int i = 0; i < 4; i++) {
      x[i].x -= mu; x[i].y -= mu; x[i].z -= mu; x[i].w -= mu;
      vs += x[i].x * x[i].x + x[i].y * x[i].y + x[i].z * x[i].z + x[i].w * x[i].w;
    }
    float ri = rsqrtf(wave_sum(vs) * (1.f / 1024.f) + 1e-5f);
#pragma unroll
    for (int i = 0; i < 4; i++) {
      float4 gg = *(const float4*)(g + i * 256 + lane * 4);
      float4 bb = *(const float4*)(bta + i * 256 + lane * 4);
      x[i].x = x[i].x * ri * gg.x + bb.x;
      x[i].y = x[i].y * ri * gg.y + bb.y;
      x[i].z = x[i].z * ri * gg.z + bb.z;
      x[i].w = x[i].w * ri * gg.w + bb.w;
      *(float4*)(xr + i * 256 + lane * 4) = x[i];
      *(uint2*)(p.xb + (size_t)tg * 1024 + i * 256 + lane * 4) = make_uint2(pack2(x[i].x, x[i].y), pack2(x[i].z, x[i].w));
    }
    if (ROUTER) {
      float mine = 0.f;
#pragma unroll 1
      for (int e = 0; e < 16; e++) {
        float a = 0.f;
#pragma unroll
        for (int i = 0; i < 4; i++) {
          float4 w = *(const float4*)(wl + e * 1024 + i * 256 + lane * 4);
          a += x[i].x * w.x + x[i].y * w.y + x[i].z * w.z + x[i].w * w.w;
        }
        a = wave_sum(a);
        mine = (lane == e) ? a : mine;
      }
      float mx = mine;
      mx = fmaxf(mx, dpp_f<0xB1>(mx));
      mx = fmaxf(mx, dpp_f<0x4E>(mx));
      mx = fmaxf(mx, dpp_f<0x141>(mx));
      mx = fmaxf(mx, dpp_f<0x140>(mx));
      float ex = __expf(mine - mx);
      float sum = reduce16(ex);
      mine = ex / sum;
      if (lane == 0) p.inv_cnt[tg] = 0;
      if (lane < 16) {
        if (tg < 32768) p.affT[(size_t)lane * 32768 + tg] = mine;
        else p.affT[(size_t)16 * 32768 + (size_t)lane * 65536 + (tg - 32768)] = mine;
      }
    }
#pragma unroll
    for (int i = 0; i < 4; i++) x[i] = xn[i];
  }
}

DI void phase_topk(const Params& p, char* lds, int bid, int nb, int tid) {
  if (bid < 32) {
    unsigned* hist = (unsigned*)lds;
    unsigned* sh = hist + 256;
    unsigned* eqc = sh + 8;
    const int g = bid >> 4, e = bid & 15;
    const int T = g ? 65536 : 32768, cap = T >> 3;
    const int tok0 = g ? 32768 : 0;
    const float* vals = p.affT + (g ? (size_t)16 * 32768 : 0) + (size_t)e * T;
    const float4* v4 = (const float4*)vals;
    const int n4 = T >> 2;
    int* oidx = p.idx + (g ? 65536 : 0) + e * cap;
    float* ogate = p.gate + (g ? 65536 : 0) + e * cap;
    const int slot0 = (g ? 65536 : 0) + e * cap;
    unsigned prefix = 0, mask = 0;
    int remaining = cap;
    for (int pass = 0; pass < 4; pass++) {
      const int shift = 24 - 8 * pass;
      hist[tid] = 0;
      __syncthreads();
      for (int base = 0; base < n4; base += 2048) {
        float4 x[8];
#pragma unroll
        for (int u = 0; u < 8; u++) x[u] = v4[base + u * 256 + tid];
#pragma unroll
        for (int u = 0; u < 8; u++) {
          const unsigned b0 = __float_as_uint(x[u].x), b1 = __float_as_uint(x[u].y), b2 = __float_as_uint(x[u].z), b3 = __float_as_uint(x[u].w);
          if ((b0 & mask) == prefix) atomicAdd(&hist[(b0 >> shift) & 255], 1u);
          if ((b1 & mask) == prefix) atomicAdd(&hist[(b1 >> shift) & 255], 1u);
          if ((b2 & mask) == prefix) atomicAdd(&hist[(b2 >> shift) & 255], 1u);
          if ((b3 & mask) == prefix) atomicAdd(&hist[(b3 >> shift) & 255], 1u);
        }
      }
      __syncthreads();
      if (tid == 0) {
        int cum = 0, sel = 0;
        for (int bq = 255; bq >= 0; bq--) {
          int hc = (int)hist[bq];
          if (cum + hc >= remaining) { sel = bq; break; }
          cum += hc;
        }
        sh[0] = (unsigned)sel;
        sh[1] = (unsigned)(remaining - cum);
        sh[3] = hist[sel];
      }
      __syncthreads();
      prefix |= sh[0] << shift;
      remaining = (int)sh[1];
      mask |= 0xFFu << shift;
      __syncthreads();
    }
    const unsigned thr = prefix;
    const int need = remaining;
    const bool fast = ((int)sh[3] == need);
    if (tid == 0) sh[2] = 0;
    __syncthreads();
    if (fast) {
      for (int base = 0; base < n4; base += 2048) {
        float4 x[8];
#pragma unroll
        for (int u = 0; u < 8; u++) x[u] = v4[base + u * 256 + tid];
#pragma unroll
        for (int u = 0; u < 8; u++) {
          const float xv[4] = {x[u].x, x[u].y, x[u].z, x[u].w};
#pragma unroll
          for (int c = 0; c < 4; c++) {
            if (__float_as_uint(xv[c]) >= thr) {
              const int pos = (int)atomicAdd(&sh[2], 1u);
              const int tok = tok0 + (base + u * 256 + tid) * 4 + c;
              oidx[pos] = tok;
              ogate[pos] = xv[c];
              const int kslot = atomicAdd(&p.inv_cnt[tok], 1);
              p.inv_slot[(size_t)tok * 16 + kslot] = slot0 + pos;
            }
          }
        }
      }
    } else {
      const int ch = T >> 8;
      const float* my = vals + tid * ch;
      int ec = 0;
      for (int i = 0; i < ch; i++) ec += (__float_as_uint(my[i]) == thr) ? 1 : 0;
      eqc[tid] = ec;
      __syncthreads();
      int eq_rank = 0;
      for (int i = 0; i < tid; i++) eq_rank += eqc[i];
      for (int i = 0; i < ch; i++) {
        float v = my[i];
        unsigned u = __float_as_uint(v);
        int pos = -1;
        if (u > thr) {
          pos = (int)atomicAdd(&sh[2], 1u);
        } else if (u == thr) {
          if (eq_rank < need) pos = cap - need + eq_rank;
          eq_rank++;
        }
        if (pos >= 0) {
          const int tok = tok0 + tid * ch + i;
          oidx[pos] = tok;
          ogate[pos] = v;
          const int kslot = atomicAdd(&p.inv_cnt[tok], 1);
          p.inv_slot[(size_t)tok * 16 + kslot] = slot0 + pos;
        }
      }
    }
    __syncthreads();
  }
}

DI void moe_rowinfo(int row0, int l, int& e, int& ioff) {
  if (row0 < 65536) { e = row0 >> 12; }
  else { e = (row0 - 65536) >> 13; }
  ioff = row0;
}

DI void phase_moe1(const Params& p, int l, char* lds, int bid, int nb, int tid) {
  const int NT = 8, MT = 196608 / 128;
  for (int it = 0;; it++) {
    int nt, mt;
    if (!xcd_tile(it, bid, nb, MT, NT, mt, nt)) break;
    int m0 = mt * 128, n0 = nt * 128;
    int e, ioff;
    moe_rowinfo(m0, l, e, ioff);
    const int* ip = p.idx + ioff;
    auto rowfn = [&](int r) -> const void* { return p.xb + (size_t)ip[r] * 1024; };
    u16* H = p.H;
    auto epi = [&](f32x4(&acc)[4][4], int rbase, int cbase) {
#pragma unroll
      for (int m = 0; m < 4; m++)
#pragma unroll
        for (int n = 0; n < 4; n += 2) {
          int row = rbase + m * 16;
          int col = cbase + n * 16;
          int blk = (n0 + (col & ~31)) >> 1;
          int hc = blk + (col & 15);
          f32x4 a = acc[m][n], bq = acc[m][n + 1];
          f32x4 o;
          for (int j = 0; j < 4; j++) o[j] = a[j] * sigm(a[j]) * bq[j];
          st_bf4(H + (size_t)(m0 + row) * 512 + hc, o);
        }
    };
    gemm_tile<false>(rowfn, p.w13_t + ((size_t)(l * 16 + e) * 1024 + n0) * 1024, 1024, epi, lds, tid);
  }
}

DI void phase_moe2(const Params& p, int l, char* lds, int bid, int nb, int tid) {
  TileIter it{bid, nb, 0};
  {
    const int NT = 8, MT = 196608 / 128;
    for (int itx = 0;; itx++) {
      int nt, mt;
      if (!xcd_tile(itx, bid, nb, MT, NT, mt, nt)) break;
      int m0 = mt * 128, n0 = nt * 128;
      int e, ioff;
      moe_rowinfo(m0, l, e, ioff);
      auto rowfn = [&](int r) -> const void* { return p.H + (size_t)(m0 + r) * 512; };
      u16* O = p.O;
      auto epi = [&](f32x4(&acc)[4][4], int rbase, int cbase) {
        EPI_LOOP({ st_bf4(O + (size_t)(m0 + row) * 1024 + n0 + col, v); })
      };
      gemm_tile<false>(rowfn, p.w2_t + ((size_t)(l * 16 + e) * 1024 + n0) * 512, 512, epi, lds, tid);
    }
  }
  {
    const int NT = 8, MT = T_ALL / 128;
    for (int itx = 0;; itx++) {
      int nt, mt;
      if (!xcd_tile(itx, bid, nb, MT, NT, mt, nt)) break;
      int m0 = mt * 128, n0 = nt * 128;
      auto rowfn = [&](int r) -> const void* {
        int tg = m0 + r;
        return tg < 32768 ? p.p_prompt + ((size_t)l * 32768 + tg) * 256 : p.p_sample + ((size_t)l * 65536 + (tg - 32768)) * 256;
      };
      auto epi = [&](f32x4(&acc)[4][4], int rbase, int cbase) {
        EPI_LOOP({ st_bf4(p.xb + (size_t)(m0 + row) * 1024 + n0 + col, v); })
      };
      gemm_tile<true>(rowfn, p.wp_t + ((size_t)l * 1024 + n0) * 256, 256, epi, lds, tid);
    }
  }
}

DI void phase_combine(const Params& p, int bid, int nb, int tid) {
  const int lane = tid & 63, wv = tid >> 6;
  u16* ub = p.H;
  for (int t = bid * 4 + wv; t < T_ALL; t += nb * 4) {
    float* xr = p.out + (size_t)t * 1024;
    float4 a[4];
#pragma unroll
    for (int i = 0; i < 4; i++) a[i] = *(const float4*)(xr + i * 256 + lane * 4);
    const int cnt = p.inv_cnt[t];
    const int myslot = p.inv_slot[(size_t)t * 16 + (lane & 15)];
    const float mygate = ((lane & 15) < cnt) ? p.gate[myslot] : 0.f;
#pragma unroll
    for (int i = 0; i < 4; i++) a[i] = make_float4(a[i].x * ALPHA_F, a[i].y * ALPHA_F, a[i].z * ALPHA_F, a[i].w * ALPHA_F);
    for (int j0 = 0; j0 < cnt; j0 += 4) {
      uint2 r[4][4];
      float g[4];
#pragma unroll
      for (int jj = 0; jj < 4; jj++) {
        const int j = (j0 + jj < cnt) ? (j0 + jj) : j0;
        const int slot = __shfl(myslot, j);
        g[jj] = (j0 + jj < cnt) ? __shfl(mygate, j) : 0.f;
        const u16* orow = p.O + (size_t)slot * 1024 + lane * 4;
#pragma unroll
        for (int i = 0; i < 4; i++) r[jj][i] = *(const uint2*)(orow + i * 256);
      }
#pragma unroll
      for (int jj = 0; jj < 4; jj++)
#pragma unroll
        for (int i = 0; i < 4; i++) {
          a[i].x += g[jj] * blo(r[jj][i].x);
          a[i].y += g[jj] * bhi(r[jj][i].x);
          a[i].z += g[jj] * blo(r[jj][i].y);
          a[i].w += g[jj] * bhi(r[jj][i].y);
        }
    }
#pragma unroll
    for (int i = 0; i < 4; i++) {
      *(float4*)(xr + i * 256 + lane * 4) = a[i];
      *(uint2*)(ub + (size_t)t * 1024 + i * 256 + lane * 4) = make_uint2(pack2(a[i].x, a[i].y), pack2(a[i].z, a[i].w));
    }
  }
}

DI void phase_ple(const Params& p, int l, char* lds, int bid, int nb, int tid) {
  const int NT = 8, MT = T_ALL / 128;
  for (int it = 0;; it++) {
    int nt, mt;
    if (!xcd_tile(it, bid, nb, MT, NT, mt, nt)) break;
    int m0 = mt * 128, n0 = nt * 128;
    auto rowfn = [&](int r) -> const void* { return p.H + (size_t)(m0 + r) * 1024; };
    auto epi = [&](f32x4(&acc)[4][4], int rbase, int cbase) {
      EPI_LOOP({
        size_t o = (size_t)(m0 + row) * 1024 + n0 + col;
        float4 u = *(const float4*)(p.out + o);
        uint2 pr = *(const uint2*)(p.xb + o);
        *(float4*)(p.out + o) = make_float4(u.x + sigm(v[0]) * blo(pr.x), u.y + sigm(v[1]) * bhi(pr.x),
                                            u.z + sigm(v[2]) * blo(pr.y), u.w + sigm(v[3]) * bhi(pr.y));
      })
    };
    gemm_tile<false>(rowfn, p.wg_t + ((size_t)l * 1024 + n0) * 1024, 1024, epi, lds, tid);
  }
}

#define XB_TMO      128
#define XB_XCNT(j)  (256  + 64 * (j))
#define XB_XSUB(j)  (1280 + 64 * (j))
#define XB_XGEN(j)  (2304 + 64 * (j))
#define XB_TOP      3328
#define XB_TOPGEN   3392
#define XCD_BAR_WORDS 3456
#define XB_SPIN_CAP (1u << 22)
#define LAS __attribute__((address_space(3)))
DI unsigned xb_ld(unsigned* p) { return __hip_atomic_load(p, __ATOMIC_RELAXED, __HIP_MEMORY_SCOPE_AGENT); }
DI unsigned xb_add(unsigned* p, unsigned v) { return __hip_atomic_fetch_add(p, v, __ATOMIC_RELAXED, __HIP_MEMORY_SCOPE_AGENT); }
DI unsigned xb_xcc_id() { return (unsigned)__builtin_amdgcn_s_getreg((3 << 11) | 20) & 0xFu; }
#define XB_SPIN(cond, bar) do { unsigned _sp = 0; while (cond) { __builtin_amdgcn_s_sleep(1); \
    if ((++_sp & 255u) == 0u) { if (xb_ld(&(bar)[XB_TMO])) break; if (_sp > XB_SPIN_CAP) { atomicAdd(&(bar)[XB_TMO], 1u); break; } } } } while (0)
struct XcdBarrier { unsigned* bar; unsigned x; volatile LAS unsigned* st; };
DI XcdBarrier xcd_barrier_post(unsigned* bar, volatile LAS unsigned* st) {
  XcdBarrier b; b.bar = bar; b.x = xb_xcc_id(); b.st = st;
  if (threadIdx.x == 0) (void)xb_add(&bar[XB_XCNT(b.x)], 1u);
  return b;
}
DI void xcd_barrier_complete(unsigned* bar, unsigned x, unsigned& nloc, unsigned& nx) {
  const unsigned G = gridDim.x * gridDim.y * gridDim.z;
  unsigned sum, cnt, mine, sp = 0u;
  for (;;) {
    sum = 0u; cnt = 0u; mine = 0u;
#pragma unroll
    for (unsigned j = 0; j < 16; ++j) { const unsigned c = xb_ld(&bar[XB_XCNT(j)]); sum += c; cnt += (c > 0u) ? 1u : 0u; mine = (j == x) ? c : mine; }
    if (sum == G) break;
    __builtin_amdgcn_s_sleep(1);
    if ((++sp & 255u) == 0u) { if (xb_ld(&bar[XB_TMO])) break; if (sp > XB_SPIN_CAP) { atomicAdd(&bar[XB_TMO], 1u); break; } }
  }
  nloc = mine > 0u ? mine : 1u; nx = cnt > 0u ? cnt : 1u;
}
DI void xcd_barrier(const XcdBarrier& b) {
  asm volatile("s_waitcnt vmcnt(0)" ::: "memory");
  __syncthreads();
  if (threadIdx.x == 0) {
    unsigned* bar = b.bar;
    __builtin_amdgcn_s_waitcnt(0);
    unsigned nloc = b.st[0], nx = b.st[1];
    if (nloc == 0u) { xcd_barrier_complete(bar, b.x, nloc, nx); b.st[0] = nloc; b.st[1] = nx; }
    const unsigned old = xb_add(&bar[XB_XSUB(b.x)], 1u);
    const unsigned gen = old / nloc;
    if (old + 1u == (gen + 1u) * nloc) {
      __builtin_amdgcn_fence(__ATOMIC_RELEASE, "agent");
      asm volatile("s_waitcnt vmcnt(0)" ::: "memory");
      const unsigned og = xb_add(&bar[XB_TOP], 1u);
      const unsigned tg = og / nx;
      if (og + 1u == (tg + 1u) * nx) xb_add(&bar[XB_TOPGEN], 1u);
      else XB_SPIN(xb_ld(&bar[XB_TOPGEN]) == tg, bar);
      __builtin_amdgcn_fence(__ATOMIC_ACQUIRE, "agent");
      xb_add(&bar[XB_XGEN(b.x)], 1u);
      asm volatile("s_waitcnt vmcnt(0)" ::: "memory");
    } else {
      XB_SPIN(xb_ld(&bar[XB_XGEN(b.x)]) == gen, bar);
      __builtin_amdgcn_fence(__ATOMIC_ACQUIRE, "agent");
      asm volatile("s_waitcnt vmcnt(0)" ::: "memory");
    }
  }
  __syncthreads();
}

__global__ void __launch_bounds__(NTHR, 2) mega(Params p) {
  __shared__ __attribute__((aligned(16))) char lds[73728];
  cg::grid_group grid = cg::this_grid();
  const int tid0 = threadIdx.x, bid0 = blockIdx.x, nb = gridDim.x;
  __shared__ uint4 xb_words;
  if (tid0 == 0) xb_words = make_uint4(0u, 0u, 0u, 0u);
  __syncthreads();
  const XcdBarrier xb = xcd_barrier_post(p.bar, (volatile LAS unsigned*)&xb_words);
  int pc = 0;
#define PHASE(...)                                      \
  {                                                     \
    if (pc >= p.pb && pc < p.pe) {                      \
      if (pc == p.pb + 1) grid.sync();                  \
      else if (pc > p.pb + 1) xcd_barrier(xb);          \
      int tid = tid0, bid = bid0;                       \
      asm volatile("" : "+v"(tid), "+s"(bid));          \
      __VA_ARGS__;                                      \
    }                                                   \
    pc++;                                               \
  }
  PHASE(phase_convert(p, lds, bid, nb, tid));
  for (int i = 0; i < REP_SYNC; i++) PHASE((void)0);
  for (int l = 0; l < 2; l++) {
    for (int sg = 0; sg < 3; sg++) {
      const int tok0 = sg * T_SUB;
      const int B = sg == 0 ? 4 : 8, N = sg == 0 ? 8192 : 4096;
      PHASE(phase_inproj(p, l, tok0, lds, bid, nb, tid));
#if REP_INPROJ || REP_GEMMS
      PHASE(phase_inproj(p, l, tok0, lds, bid, nb, tid));
#endif
      PHASE(phase_prep(p, l, N, bid, nb, tid));
      PHASE(phase_smallgemm(p, l, B, N, lds, bid, nb, tid));
#if REP_GEMMS
      PHASE(phase_smallgemm(p, l, B, N, lds, bid, nb, tid));
#endif
      PHASE(phase_mix(p, l, B, N, p.bar + XCD_BAR_WORDS + (l * 3 + sg) * 128, lds, bid, nb, tid));
#if REP_MIX
      PHASE(phase_mix(p, l, B, N, p.bar + XCD_BAR_WORDS + (6 + l * 3 + sg) * 128, lds, bid, nb, tid));
#endif
      PHASE(phase_final(p, l, bid, nb, tid));
      PHASE(phase_wout(p, l, tok0, lds, bid, nb, tid));
      PHASE(phase_ln<true>(p, p.ln1_g + l * 1024, p.ln1_b + l * 1024, p.moe_router + (size_t)l * 16384, tok0, T_SUB, lds, bid, nb, tid));
    }
    PHASE(phase_topk(p, lds, bid, nb, tid));
    PHASE(phase_moe1(p, l, lds, bid, nb, tid));
#if REP_MOE1 || REP_GEMMS
    PHASE(phase_moe1(p, l, lds, bid, nb, tid));
#endif
    PHASE(phase_moe2(p, l, lds, bid, nb, tid));
#if REP_GEMMS
    PHASE(phase_moe2(p, l, lds, bid, nb, tid));
#endif
    PHASE(phase_combine(p, bid, nb, tid));
    PHASE(phase_ple(p, l, lds, bid, nb, tid));
    PHASE(phase_ln<false>(p, p.ln2_g + l * 1024, p.ln2_b + l * 1024, nullptr, 0, T_ALL, lds, bid, nb, tid));
  }
}

#define N_PHASES 1000
#ifndef FUSED
#define FUSED 1
#endif

extern "C" void kernel_launch(void* const* d_in, const int* in_sizes, int n_in, void* d_out, int out_size, void* d_ws,
                              size_t ws_size, hipStream_t stream) {
  static int grid_blocks = 0;
  if (!grid_blocks) {
    int dev = 0, cus = 0, per_cu = 0;
    (void)hipGetDevice(&dev);
    (void)hipDeviceGetAttribute(&cus, hipDeviceAttributeMultiprocessorCount, dev);
    (void)hipOccupancyMaxActiveBlocksPerMultiprocessor(&per_cu, mega, NTHR, 0);
    if (per_cu > 2) per_cu = 2;
    if (per_cu < 1) per_cu = 1;
    grid_blocks = cus * per_cu;
  }
  Params p;
  memset(&p, 0, sizeof(p));
  const float* const* in = (const float* const*)d_in;
  int k = 0;
  p.x_prompt = in[k++]; p.x_sample = in[k++]; p.p_prompt = in[k++]; p.p_sample = in[k++];
  p.w_in = in[k++]; p.mla_gq = in[k++]; p.mla_gkv = in[k++]; p.mla_wuq = in[k++]; p.mla_wuk = in[k++]; p.mla_wuv = in[k++];
  p.na_bias = in[k++]; p.hg_lb = in[k++]; p.hg_gnorm = in[k++];
  p.rw_mu = in[k++]; p.rw_w0 = in[k++]; p.rw_w_up = in[k++]; p.rw_a0 = in[k++]; p.rw_a_up = in[k++]; p.rw_g_up = in[k++];
  p.rw_kk = in[k++]; p.rw_ka = in[k++]; p.rw_rk = in[k++]; p.rw_ln_w = in[k++]; p.rw_ln_b = in[k++];
  p.w_out = in[k++]; p.ln1_g = in[k++]; p.ln1_b = in[k++]; p.moe_router = in[k++]; p.moe_w1 = in[k++]; p.moe_w3 = in[k++];
  p.moe_w2 = in[k++]; p.ln2_g = in[k++]; p.ln2_b = in[k++]; p.ple_gate = in[k++]; p.ple_proj = in[k++];
  p.out = (float*)d_out;
  char* ws = (char*)d_ws;
  size_t off = 0;
  auto take = [&](size_t bytes) { char* r = ws + off; off += (bytes + 255) & ~(size_t)255; return r; };
  p.w_in_t = (u16*)take((size_t)2 * 3712 * 1024 * 2);
  p.wuq_t = (u16*)take((size_t)2 * 384 * 256 * 2);
  p.wkv_t = (u16*)take((size_t)2 * 512 * 128 * 2);
  p.wup_t = (u16*)take((size_t)4 * 256 * 64 * 2);
  p.aup_t = (u16*)take((size_t)4 * 256 * 64 * 2);
  p.gup_t = (u16*)take((size_t)2 * 256 * 128 * 2);
  p.wout_t = (u16*)take((size_t)2 * 1024 * 1024 * 2);
  p.w13_t = (u16*)take((size_t)32 * 1024 * 1024 * 2);
  p.w2_t = (u16*)take((size_t)32 * 1024 * 512 * 2);
  p.wg_t = (u16*)take((size_t)2 * 1024 * 1024 * 2);
  p.wp_t = (u16*)take((size_t)2 * 1024 * 256 * 2);
  p.ropec = (float*)take((size_t)8192 * 16 * 4);
  p.ropes = (float*)take((size_t)8192 * 16 * 4);
  p.lb = (float*)take(1024 * 4);
  p.affT = (float*)take((size_t)16 * T_ALL * 4);
  p.gate = (float*)take((size_t)196608 * 4);
  p.idx = (int*)take((size_t)196608 * 4);
  p.bar = (unsigned*)take((size_t)(XCD_BAR_WORDS + 12 * 128) * 4);
  p.inv_cnt = (int*)take((size_t)T_ALL * 4);
  p.inv_slot = (int*)take((size_t)T_ALL * 16 * 4);
  p.xb = (u16*)take((size_t)T_ALL * 1024 * 2);
  const size_t stage0 = off;
  p.z = (u16*)take((size_t)T_SUB * ZLD * 2);
  p.cat = (u16*)take((size_t)T_SUB * 1024 * 2);
  p.Q = (u16*)take((size_t)T_SUB * 384 * 2);
  p.Kb = (u16*)take((size_t)T_SUB * 384 * 2);
  p.Vt = (u16*)take((size_t)T_SUB * 256 * 2);
  p.cqn = (u16*)take((size_t)T_SUB * 256 * 2);
  p.ckvn = (u16*)take((size_t)T_SUB * 128 * 2);
  p.S1 = (u16*)take((size_t)T_SUB * 384 * 2);
  p.rs = (u16*)take((size_t)T_SUB * 256 * 2);
  p.ks = (u16*)take((size_t)T_SUB * 256 * 2);
  p.vs = (u16*)take((size_t)T_SUB * 256 * 2);
  p.kk = (u16*)take((size_t)T_SUB * 256 * 2);
  p.gD = (u16*)take((size_t)T_SUB * 256 * 2);
  p.dec = (u16*)take((size_t)2 * T_SUB * 256 * 2);
  p.kka = (u16*)take((size_t)2 * T_SUB * 256 * 2);
  p.kt = (u16*)take((size_t)2 * T_SUB * 256 * 2);
  p.oC = (u16*)take((size_t)2 * T_SUB * 256 * 2);
  p.oD = (u16*)take((size_t)2 * T_SUB * 256 * 2);
  p.bonus = (float*)take((size_t)T_SUB * 4 * 4);
  off = stage0;
  p.O = (u16*)take((size_t)196608 * 1024 * 2);
  p.H = (u16*)take((size_t)196608 * 512 * 2);
  for (int i = 0; i < 16; i++) p.inv_freq[i] = pow(10000.0, -(double)i / 16.0);
  (void)hipMemsetAsync(p.bar, 0, (size_t)(XCD_BAR_WORDS + 12 * 128) * 4, stream);
#if FUSED
  p.pb = 0;
  p.pe = N_PHASES;
  {
    void* args[] = {&p};
    hipError_t e = hipLaunchCooperativeKernel((void*)mega, dim3(grid_blocks), dim3(NTHR), args, 0, stream);
    if (e != hipSuccess) fprintf(stderr, "cooperative launch failed: %s (grid %d)\n", hipGetErrorString(e), grid_blocks);
  }
#else
  for (int ph = 0; ph < N_PHASES; ph++) {
    p.pb = ph;
    p.pe = ph + 1;
    void* args[] = {&p};
    hipError_t e = hipLaunchCooperativeKernel((void*)mega, dim3(grid_blocks), dim3(NTHR), args, 0, stream);
    if (e != hipSuccess) fprintf(stderr, "cooperative launch failed: %s (grid %d)\n", hipGetErrorString(e), grid_blocks);
  }
#endif
}
```

```cpp
#include <hip/hip_runtime.h>
#include <hip/hip_cooperative_groups.h>
#include <cstdio>
#include <cmath>
#include <cstring>
namespace cg = cooperative_groups;

typedef unsigned short u16;
using bf16x8 = __attribute__((ext_vector_type(8))) short;
using f32x4 = __attribute__((ext_vector_type(4))) float;
using f32x16 = __attribute__((ext_vector_type(16))) float;

#define REP_INPROJ 0
#define REP_ATTN 0
#define REP_NA 0
#define REP_SCAN 0
#define REP_MOE1 0
#define REP_MOE2 0
#define REP_SYNC 0
#define REP_MIX 0
#define REP_GEMMS 0
#define DI __device__ __forceinline__
#define NTHR 256
#define T_ALL 98304
#define T_SUB 32768
#define ZLD 3616
#define ZB_OFF 416
#define ZC_OFF 1184
#define ZD_OFF 2464
#define LOG2E 1.4426950408889634f
#define ALPHA_F 1.4142135623730951f

struct Params {
  const float *x_prompt, *x_sample, *p_prompt, *p_sample;
  const float *w_in, *mla_gq, *mla_gkv, *mla_wuq, *mla_wuk, *mla_wuv, *na_bias, *hg_lb, *hg_gnorm;
  const float *rw_mu, *rw_w0, *rw_w_up, *rw_a0, *rw_a_up, *rw_g_up, *rw_kk, *rw_ka, *rw_rk, *rw_ln_w, *rw_ln_b;
  const float *w_out, *ln1_g, *ln1_b, *moe_router, *moe_w1, *moe_w3, *moe_w2, *ln2_g, *ln2_b, *ple_gate, *ple_proj;
  float* out;
  u16 *w_in_t, *wuq_t, *wkv_t, *wup_t, *aup_t, *gup_t, *wout_t, *w13_t, *w2_t, *wg_t, *wp_t;
  float *ropec, *ropes, *lb, *affT, *gate;
  int* idx;
  unsigned* bar;
  int *inv_cnt, *inv_slot;
  u16 *z, *cat, *Q, *Kb, *Vt, *cqn, *ckvn, *S1, *rs, *ks, *vs, *kk, *gD, *dec, *kka, *kt, *oC, *oD;
  float* bonus;
  u16* xb;
  u16* O;
  u16* H;
  double inv_freq[16];
  int pb, pe;
};

typedef __bf16 v2bf_t __attribute__((ext_vector_type(2)));
typedef float v2f_t __attribute__((ext_vector_type(2)));
typedef unsigned u32x4_t __attribute__((ext_vector_type(4)));
DI unsigned pack2(float a, float b) {
  v2f_t f = {a, b};
  v2bf_t h = __builtin_convertvector(f, v2bf_t);
  return __builtin_bit_cast(unsigned, h);
}
DI u16 f2bf(float f) { return (u16)(pack2(f, 0.f) & 0xffffu); }
DI float bf2f(u16 h) { return __uint_as_float(((unsigned)h) << 16); }
DI float blo(unsigned u) { return __uint_as_float(u << 16); }
DI float bhi(unsigned u) { return __uint_as_float(u & 0xffff0000u); }
DI float sigm(float x) { return 1.f / (1.f + __expf(-x)); }
DI float tanh_(float x) { return 1.f - 2.f / (__expf(2.f * x) + 1.f); }
DI float ex2(float x) { return __builtin_amdgcn_exp2f(x); }
DI int clampi(int v, int lo, int hi) { return v < lo ? lo : (v > hi ? hi : v); }
DI int swap23(int x) { return (x & ~12) | ((x & 4) << 1) | ((x & 8) >> 1); }

template <int CTRL> DI float dpp_f(float v) {
  return __int_as_float(__builtin_amdgcn_update_dpp(0, __float_as_int(v), CTRL, 0xF, 0xF, true));
}
DI float reduce16(float v) {
  v += dpp_f<0xB1>(v);
  v += dpp_f<0x4E>(v);
  v += dpp_f<0x141>(v);
  v += dpp_f<0x140>(v);
  return v;
}
DI float wave_sum(float v) {
  v = reduce16(v);
  v += __shfl_xor(v, 16);
  v += __shfl_xor(v, 32);
  return v;
}

struct TileIter {
  int bid, nb, off;
  DI int first(int n) { int f = bid - off; if (f < 0) f += nb; off = (off + n) % nb; return f; }
};

DI bool xcd_tile(int it, int bid, int nb, int MT, int NT, int& mt, int& nt) {
  const int x = bid & 7, slot = bid >> 3, nslots = nb >> 3;
  const int mper = MT >> 3;
  const int i = slot + it * nslots;
  if (i >= mper * NT) return false;
  const int mi = i & 7, rest = i >> 3;
  nt = rest % NT;
  mt = x * mper + (rest / NT) * 8 + mi;
  return true;
}

DI void convT_job(const float* __restrict__ W, int K, int N, int Npad, u16* __restrict__ Wt, int mode, char* lds,
                  TileIter& it, int tid) {
  float(*tile)[65] = (float(*)[65])lds;
  int tk = K >> 6, tn = Npad >> 6;
  int nt = tk * tn;
  for (int t = it.first(nt); t < nt; t += it.nb) {
    int k0 = (t % tk) << 6, n0 = (t / tk) << 6;
#pragma unroll
    for (int i = 0; i < 16; i++) {
      int kl = (tid >> 6) + 4 * i, nl = tid & 63;
      int n = n0 + nl;
      tile[kl][nl] = (n < N) ? W[(size_t)(k0 + kl) * N + n] : 0.f;
    }
    __syncthreads();
    {
      int nl = tid >> 2, ks = (tid & 3) * 16;
      int n = n0 + nl;
      int row = n;
      if (mode == 1) row = (n >> 4) * 32 + (n & 15);
      if (mode == 2) row = (n >> 4) * 32 + 16 + (n & 15);
      unsigned pk[8];
#pragma unroll
      for (int j = 0; j < 8; j++) pk[j] = pack2(tile[ks + 2 * j][nl], tile[ks + 2 * j + 1][nl]);
      uint4* dst = (uint4*)(Wt + (size_t)row * K + k0 + ks);
      dst[0] = make_uint4(pk[0], pk[1], pk[2], pk[3]);
      dst[1] = make_uint4(pk[4], pk[5], pk[6], pk[7]);
    }
    __syncthreads();
  }
}

DI void phase_convert(const Params& p, char* lds, int bid, int nb, int tid) {
  TileIter it{bid, nb, 0};
  for (int l = 0; l < 2; l++) {
    convT_job(p.w_in + (size_t)l * 1024 * 3616, 1024, 3616, 3712, p.w_in_t + (size_t)l * 3712 * 1024, 0, lds, it, tid);
    convT_job(p.mla_wuq + (size_t)l * 256 * 384, 256, 384, 384, p.wuq_t + (size_t)l * 384 * 256, 0, lds, it, tid);
    convT_job(p.mla_wuk + (size_t)l * 128 * 256, 128, 256, 256, p.wkv_t + (size_t)l * 512 * 128, 0, lds, it, tid);
    convT_job(p.mla_wuv + (size_t)l * 128 * 256, 128, 256, 256, p.wkv_t + (size_t)l * 512 * 128 + 256 * 128, 0, lds, it, tid);
    for (int d = 0; d < 2; d++) {
      convT_job(p.rw_w_up + (size_t)(l * 2 + d) * 64 * 256, 64, 256, 256, p.wup_t + (size_t)(l * 2 + d) * 256 * 64, 0, lds, it, tid);
      convT_job(p.rw_a_up + (size_t)(l * 2 + d) * 64 * 256, 64, 256, 256, p.aup_t + (size_t)(l * 2 + d) * 256 * 64, 0, lds, it, tid);
    }
    convT_job(p.rw_g_up + (size_t)l * 128 * 256, 128, 256, 256, p.gup_t + (size_t)l * 256 * 128, 0, lds, it, tid);
    convT_job(p.w_out + (size_t)l * 1024 * 1024, 1024, 1024, 1024, p.wout_t + (size_t)l * 1024 * 1024, 0, lds, it, tid);
    for (int e = 0; e < 16; e++) {
      size_t le = (size_t)(l * 16 + e);
      convT_job(p.moe_w1 + le * 1024 * 512, 1024, 512, 512, p.w13_t + le * 1024 * 1024, 1, lds, it, tid);
      convT_job(p.moe_w3 + le * 1024 * 512, 1024, 512, 512, p.w13_t + le * 1024 * 1024, 2, lds, it, tid);
      convT_job(p.moe_w2 + le * 512 * 1024, 512, 1024, 1024, p.w2_t + le * 1024 * 512, 0, lds, it, tid);
    }
    convT_job(p.ple_gate + (size_t)l * 1024 * 1024, 1024, 1024, 1024, p.wg_t + (size_t)l * 1024 * 1024, 0, lds, it, tid);
    convT_job(p.ple_proj + (size_t)l * 256 * 1024, 256, 1024, 1024, p.wp_t + (size_t)l * 1024 * 256, 0, lds, it, tid);
  }
  int gt = bid * NTHR + tid, ng = nb * NTHR;
  for (size_t i0 = gt; i0 < (size_t)T_ALL * 256; i0 += (size_t)ng * 8) {
    float4 v[8];
#pragma unroll
    for (int u = 0; u < 8; u++) {
      const size_t i = i0 + (size_t)u * ng;
      v[u] = make_float4(0.f, 0.f, 0.f, 0.f);
      if (i < (size_t)T_ALL * 256)
        v[u] = (i < (size_t)32768 * 256) ? ((const float4*)p.x_prompt)[i] : ((const float4*)p.x_sample)[i - (size_t)32768 * 256];
    }
#pragma unroll
    for (int u = 0; u < 8; u++) {
      const size_t i = i0 + (size_t)u * ng;
      if (i < (size_t)T_ALL * 256) ((uint2*)p.xb)[i] = make_uint2(pack2(v[u].x, v[u].y), pack2(v[u].z, v[u].w));
    }
  }
  for (int i = gt; i < 8192 * 16; i += ng) {
    int n = i >> 4, f = i & 15;
    double ifq = 0.0;
#pragma unroll
    for (int j = 0; j < 16; j++) ifq = (f == j) ? p.inv_freq[j] : ifq;
    double rev = (double)n * ifq * 0.15915494309189535;
    double fr = rev - rint(rev);
    float ff = (float)fr;
    p.ropec[i] = __builtin_amdgcn_cosf(ff);
    p.ropes[i] = __builtin_amdgcn_sinf(ff);
  }
  for (int i = gt; i < 512; i += ng) {
    float h0 = p.hg_lb[i], h1 = p.hg_lb[512 + i];
    p.lb[i] = 0.f;
    p.lb[512 + i] = 1.f / (1.f + __expf(h0 - h1));
  }
}

constexpr int G_STAGE = 32768;

template <bool AF32, class RowFn, class Epi>
DI void gemm_tile(RowFn rowfn, const u16* __restrict__ Bt, int K, Epi epi, char* lds, int tid) {
  const int lane = tid & 63, wid = tid >> 6, wr = wid >> 1, wc = wid & 1, fr = lane & 15, fq = lane >> 4;
  f32x4 acc[4][4];
#pragma unroll
  for (int m = 0; m < 4; m++)
#pragma unroll
    for (int n = 0; n < 4; n++) acc[m][n] = f32x4{0.f, 0.f, 0.f, 0.f};

  const int lrow = tid >> 3;
  const int lc = (tid & 7) ^ ((tid >> 4) & 7);
  const float* apf[8];
  const u16* aph[4];
  const u16* bp[4];
  if constexpr (AF32) {
#pragma unroll
    for (int i = 0; i < 8; i++) apf[i] = (const float*)rowfn(i * 16 + (tid >> 4)) + (tid & 15) * 4;
  } else {
#pragma unroll
    for (int i = 0; i < 4; i++) aph[i] = (const u16*)rowfn(lrow + i * 32) + lc * 8;
  }
#pragma unroll
  for (int i = 0; i < 4; i++) bp[i] = Bt + (size_t)(lrow + i * 32) * K + lc * 8;
  const int afoff = (tid >> 4) * 128 + ((((tid & 15) >> 1) ^ ((tid >> 5) & 7)) * 16) + (tid & 1) * 8;

  float4 raf[8];
  auto issue = [&](int buf, int k0) {
    char* A = lds + buf * G_STAGE;
    char* B = A + 16384;
#pragma unroll
    for (int i = 0; i < 4; i++)
      __builtin_amdgcn_global_load_lds((const unsigned*)(bp[i] + k0), (unsigned*)(B + wid * 1024 + i * 4096), 16, 0, 0);
    if constexpr (AF32) {
#pragma unroll
      for (int i = 0; i < 8; i++) raf[i] = *(const float4*)(apf[i] + k0);
    } else {
#pragma unroll
      for (int i = 0; i < 4; i++)
        __builtin_amdgcn_global_load_lds((const unsigned*)(aph[i] + k0), (unsigned*)(A + wid * 1024 + i * 4096), 16, 0, 0);
    }
  };
  auto astore = [&](int buf) {
    if constexpr (AF32) {
      char* A = lds + buf * G_STAGE;
#pragma unroll
      for (int i = 0; i < 8; i++) asm volatile("" : "+v"(raf[i].x), "+v"(raf[i].y), "+v"(raf[i].z), "+v"(raf[i].w));
#pragma unroll
      for (int i = 0; i < 8; i++)
        *(uint2*)(A + afoff + i * 2048) = make_uint2(pack2(raf[i].x, raf[i].y), pack2(raf[i].z, raf[i].w));
    }
  };
  const int abase = (wr * 64 + fr) * 128, bbase = 16384 + (wc * 64 + fr) * 128;
  const int sw0 = ((fq) ^ (fr >> 1)) * 16, sw1 = ((4 + fq) ^ (fr >> 1)) * 16;

  const int nk = K >> 6;
  issue(0, 0);
  astore(0);
  __syncthreads();
  for (int kt = 0; kt < nk; kt++) {
    if (kt + 1 < nk) issue((kt + 1) & 1, (kt + 1) << 6);
    __builtin_amdgcn_sched_barrier(0);
    const char* S = lds + (kt & 1) * G_STAGE;
    bf16x8 af[2][4], bfr[2][4];
#pragma unroll
    for (int kk = 0; kk < 2; kk++) {
      const int sw = kk ? sw1 : sw0;
#pragma unroll
      for (int m = 0; m < 4; m++) af[kk][m] = *(const bf16x8*)(S + abase + m * 2048 + sw);
#pragma unroll
      for (int n = 0; n < 4; n++) bfr[kk][n] = *(const bf16x8*)(S + bbase + n * 2048 + sw);
    }
    __builtin_amdgcn_sched_barrier(0);
#pragma unroll
    for (int kk = 0; kk < 2; kk++)
#pragma unroll
      for (int m = 0; m < 4; m++)
#pragma unroll
        for (int n = 0; n < 4; n++) acc[m][n] = __builtin_amdgcn_mfma_f32_16x16x32_bf16(bfr[kk][n], af[kk][m], acc[m][n], 0, 0, 0);
    __builtin_amdgcn_sched_barrier(0);
    if (kt + 1 < nk) astore((kt + 1) & 1);
    __syncthreads();
  }
  epi(acc, wr * 64 + fr, wc * 64 + fq * 4);
}

#define EPI_LOOP(...)                                    \
  _Pragma("unroll") for (int m = 0; m < 4; m++)          \
  _Pragma("unroll") for (int n = 0; n < 4; n++) {        \
    const int row = rbase + m * 16;                      \
    const int col = cbase + n * 16;                      \
    const f32x4 v = acc[m][n];                           \
    __VA_ARGS__                                          \
  }

DI void st_bf4(u16* dst, f32x4 v) { *(uint2*)dst = make_uint2(pack2(v[0], v[1]), pack2(v[2], v[3])); }

DI const float* xin_row(const Params& p, int l, int tg) {
  if (l == 0) return tg < 32768 ? p.x_prompt + (size_t)tg * 1024 : p.x_sample + (size_t)(tg - 32768) * 1024;
  return p.out + (size_t)tg * 1024;
}

DI void phase_inproj(const Params& p, int l, int tok0, char* lds, int bid, int nb, int tid) {
  const int NT = 29, MT = T_SUB / 128;
  for (int it = 0;; it++) {
    int nt, mt;
    if (!xcd_tile(it, bid, nb, MT, NT, mt, nt)) break;
    int m0 = mt * 128, n0 = nt * 128;
    auto rowfn = [&](int r) -> const void* { return p.xb + (size_t)(tok0 + m0 + r) * 1024; };
    u16* z = p.z;
    auto epi = [&](f32x4(&acc)[4][4], int rbase, int cbase) {
      EPI_LOOP({
        int c = n0 + col;
        if (c < ZLD) st_bf4(z + (size_t)(m0 + row) * ZLD + c, v);
      })
    };
    gemm_tile<false>(rowfn, p.w_in_t + ((size_t)l * 3712 + n0) * 1024, 1024, epi, lds, tid);
  }
}

struct PrepIn {
  uint2 cq;
  unsigned ckv;
  u16 kr1, kr2;
  float rc, rsn;
  uint4 f;
  uint2 cur[3], prv[3], nxt[3];
  u16 sc[6], sp[6], sn[6];
};
DI void prep_load(PrepIn& in, const Params& p, int t, int N, int lane) {
  const int l15 = lane & 15, c4 = lane * 4;
  const u16* zr = p.z + (size_t)t * ZLD;
  const int n = t & (N - 1);
  const bool hp = n > 0, hn = n < N - 1;
  const u16* zd = zr + ZD_OFF;
  const u16* zdp = zd - (hp ? ZLD : 0);
  const u16* zdn = zd + (hn ? ZLD : 0);
  in.cq = *(const uint2*)(zr + c4);
  in.ckv = *(const unsigned*)(zr + 256 + lane * 2);
  in.kr1 = zr[384 + l15];
  in.kr2 = zr[400 + l15];
  in.rc = p.ropec[n * 16 + l15];
  in.rsn = p.ropes[n * 16 + l15];
  in.f = *(const uint4*)(zr + ZC_OFF + 256 + lane * 8);
#pragma unroll
  for (int part = 0; part < 3; part++) {
    in.cur[part] = *(const uint2*)(zd + part * 256 + c4);
    in.prv[part] = *(const uint2*)(zdp + part * 256 + c4);
    in.nxt[part] = *(const uint2*)(zdn + part * 256 + c4);
  }
#pragma unroll
  for (int i = 0; i < 6; i++) {
    in.sc[i] = zd[768 + lane + 64 * i];
    in.sp[i] = zdp[768 + lane + 64 * i];
    in.sn[i] = zdn[768 + lane + 64 * i];
  }
}

DI void phase_prep(const Params& p, int l, int N, int bid, int nb, int tid) {
  const int lane = tid & 63, wv = tid >> 6, l15 = lane & 15, c4 = lane * 4;
  float gqv[4], gkvv[2], lbv[8], m0[12], m1[12], m0s[6], m1s[6], kkc[4], rkc[4];
  {
    const float* mu0 = p.rw_mu + (size_t)l * 2 * 1152;
    const float* mu1 = mu0 + 1152;
#pragma unroll
    for (int j = 0; j < 4; j++) {
      gqv[j] = p.mla_gq[l * 256 + c4 + j];
      kkc[j] = p.rw_kk[l * 256 + c4 + j];
      rkc[j] = p.rw_rk[l * 256 + c4 + j];
    }
    gkvv[0] = p.mla_gkv[l * 128 + lane * 2];
    gkvv[1] = p.mla_gkv[l * 128 + lane * 2 + 1];
#pragma unroll
    for (int j = 0; j < 8; j++) lbv[j] = p.lb[l * 512 + lane * 8 + j];
#pragma unroll
    for (int part = 0; part < 3; part++)
#pragma unroll
      for (int j = 0; j < 4; j++) {
        m0[part * 4 + j] = mu0[part * 256 + c4 + j];
        m1[part * 4 + j] = mu1[part * 256 + c4 + j];
      }
#pragma unroll
    for (int i = 0; i < 6; i++) {
      m0s[i] = mu0[768 + lane + 64 * i];
      m1s[i] = mu1[768 + lane + 64 * i];
    }
  }
  PrepIn in, inn;
  {
    const int t0 = bid * 4 + wv;
    if (t0 < T_SUB) prep_load(in, p, t0, N, lane);
  }
  for (int t = bid * 4 + wv; t < T_SUB; t += nb * 4) {
    u16* zr = p.z + (size_t)t * ZLD;
    const int n = t & (N - 1);
    const bool hp = n > 0, hn = n < N - 1;
    {
      const int tn = t + nb * 4;
      if (tn < T_SUB) prep_load(inn, p, tn, N, lane);
      else inn = in;
    }
    const uint2 raw_cq = in.cq;
    const unsigned raw_ckv = in.ckv;
    const u16 kr1 = in.kr1, kr2 = in.kr2;
    const float rc = in.rc, rsn = in.rsn;
    uint4* fptr = (uint4*)(zr + ZC_OFF + 256 + lane * 8);
    const uint4 raw_f = in.f;
    uint2 cur[3], prv[3], nxt[3];
    u16 sc[6], sp[6], sn[6];
#pragma unroll
    for (int part = 0; part < 3; part++) { cur[part] = in.cur[part]; prv[part] = in.prv[part]; nxt[part] = in.nxt[part]; }
#pragma unroll
    for (int i = 0; i < 6; i++) { sc[i] = in.sc[i]; sp[i] = in.sp[i]; sn[i] = in.sn[i]; }
    {
      float v0 = blo(raw_cq.x), v1 = bhi(raw_cq.x), v2 = blo(raw_cq.y), v3 = bhi(raw_cq.y);
      float ss = wave_sum(v0 * v0 + v1 * v1 + v2 * v2 + v3 * v3);
      float ri = rsqrtf(ss * (1.f / 256.f) + 1e-6f);
      *(uint2*)(p.cqn + (size_t)t * 256 + c4) =
          make_uint2(pack2(v0 * ri * gqv[0], v1 * ri * gqv[1]), pack2(v2 * ri * gqv[2], v3 * ri * gqv[3]));
    }
    {
      float v0 = blo(raw_ckv), v1 = bhi(raw_ckv);
      float ss = wave_sum(v0 * v0 + v1 * v1);
      float ri = rsqrtf(ss * (1.f / 128.f) + 1e-6f);
      *(unsigned*)(p.ckvn + (size_t)t * 128 + lane * 2) = pack2(v0 * ri * gkvv[0], v1 * ri * gkvv[1]);
    }
    if (lane < 16) {
      float x1 = bf2f(kr1), x2 = bf2f(kr2);
      u16 k1 = f2bf(x1 * rc - x2 * rsn), k2 = f2bf(x1 * rsn + x2 * rc);
      u16* kb = p.Kb + (size_t)t * 384;
#pragma unroll
      for (int h = 0; h < 4; h++) {
        kb[h * 96 + 64 + lane] = k1;
        kb[h * 96 + 80 + lane] = k2;
      }
    }
    {
      unsigned w[4] = {raw_f.x, raw_f.y, raw_f.z, raw_f.w};
#pragma unroll
      for (int j = 0; j < 4; j++) {
        float a = blo(w[j]), bq = bhi(w[j]);
        float la = lbv[2 * j], lb2 = lbv[2 * j + 1];
        a = la + (1.f - la) * sigm(a);
        bq = lb2 + (1.f - lb2) * sigm(bq);
        w[j] = pack2(a, bq);
      }
      *fptr = make_uint4(w[0], w[1], w[2], w[3]);
    }
    {
      float rr[4], kx[4], vx[4];
#pragma unroll
      for (int part = 0; part < 3; part++) {
        float cz[4] = {blo(cur[part].x), bhi(cur[part].x), blo(cur[part].y), bhi(cur[part].y)};
        float pz[4] = {blo(prv[part].x), bhi(prv[part].x), blo(prv[part].y), bhi(prv[part].y)};
        float nz[4] = {blo(nxt[part].x), bhi(nxt[part].x), blo(nxt[part].y), bhi(nxt[part].y)};
#pragma unroll
        for (int j = 0; j < 4; j++) {
          float pzz = hp ? pz[j] : 0.f, nzz = hn ? nz[j] : 0.f;
          float o = cz[j] + m0[part * 4 + j] * (pzz - cz[j]) + m1[part * 4 + j] * (nzz - cz[j]);
          if (part == 0) rr[j] = o;
          if (part == 1) kx[j] = o;
          if (part == 2) vx[j] = o;
        }
      }
      *(uint2*)(p.rs + (size_t)t * 256 + c4) = make_uint2(pack2(rr[0], rr[1]), pack2(rr[2], rr[3]));
      *(uint2*)(p.ks + (size_t)t * 256 + c4) = make_uint2(pack2(kx[0], kx[1]), pack2(kx[2], kx[3]));
      *(uint2*)(p.vs + (size_t)t * 256 + c4) = make_uint2(pack2(vx[0], vx[1]), pack2(vx[2], vx[3]));
      float kq[4], ss = 0.f, bo = 0.f;
#pragma unroll
      for (int j = 0; j < 4; j++) {
        kq[j] = kx[j] * kkc[j];
        ss += kq[j] * kq[j];
        bo += rr[j] * kx[j] * rkc[j];
      }
      ss = reduce16(ss);
      bo = reduce16(bo);
      float inv = 1.f / fmaxf(sqrtf(ss), 1e-12f);
      *(uint2*)(p.kk + (size_t)t * 256 + c4) = make_uint2(pack2(kq[0] * inv, kq[1] * inv), pack2(kq[2] * inv, kq[3] * inv));
      if (l15 == 0) p.bonus[(size_t)t * 4 + (lane >> 4)] = bo;
#pragma unroll
      for (int i = 0; i < 6; i++) {
        float cz = bf2f(sc[i]);
        float pz = hp ? bf2f(sp[i]) : 0.f;
        float nz = hn ? bf2f(sn[i]) : 0.f;
        float o = cz + m0s[i] * (pz - cz) + m1s[i] * (nz - cz);
        if (i < 2) o = tanh_(o);
        else if (i >= 4) o = sigm(o);
        p.S1[(size_t)t * 384 + lane + 64 * i] = f2bf(o);
      }
    }
    in = inn;
  }
}

DI void phase_smallgemm(const Params& p, int l, int B, int N, char* lds, int bid, int nb, int tid) {
  TileIter it{bid, nb, 0};
  const int MT = T_SUB / 128;
  {
    const int NT = 3;
    for (int itx = 0;; itx++) {
      int nt, mt;
      if (!xcd_tile(itx, bid, nb, MT, NT, mt, nt)) break;
      int m0 = mt * 128, n0 = nt * 128;
      auto rowfn = [&](int r) -> const void* { return p.cqn + (size_t)(m0 + r) * 256; };
      u16* Q = p.Q;
      auto epi = [&](f32x4(&acc)[4][4], int rbase, int cbase) {
        const float SC = 0.10206207261596577f * LOG2E;
        EPI_LOOP({ st_bf4(Q + (size_t)(m0 + row) * 384 + n0 + col, v * SC); })
      };
      gemm_tile<false>(rowfn, p.wuq_t + ((size_t)l * 384 + n0) * 256, 256, epi, lds, tid);
    }
  }
  {
    const int NT = 4;
    for (int itx = 0;; itx++) {
      int nt, mt;
      if (!xcd_tile(itx, bid, nb, MT, NT, mt, nt)) break;
      int m0 = mt * 128, n0 = nt * 128;
      auto rowfn = [&](int r) -> const void* { return p.ckvn + (size_t)(m0 + r) * 128; };
      u16* Kb = p.Kb;
      u16* Vt = p.Vt;
      auto epi = [&](f32x4(&acc)[4][4], int rbase, int cbase) {
        EPI_LOOP({
          int c = n0 + col;
          int tk = m0 + row;
          if (c < 256) {
            int h = c >> 6, d = c & 63;
            st_bf4(Kb + (size_t)tk * 384 + h * 96 + d, v);
          } else {
            int cc = c - 256;
            int b = tk / N, nn = tk - b * N;
            u16* dst = Vt + ((size_t)(b * 256 + cc)) * N + nn;
            dst[0] = f2bf(v[0]);
            dst[(size_t)N] = f2bf(v[1]);
            dst[(size_t)2 * N] = f2bf(v[2]);
            dst[(size_t)3 * N] = f2bf(v[3]);
          }
        })
      };
      gemm_tile<false>(rowfn, p.wkv_t + ((size_t)l * 512 + n0) * 128, 128, epi, lds, tid);
    }
  }
  for (int d = 0; d < 2; d++) {
    const int NT = 2;
    for (int itx = 0;; itx++) {
      int nt, mt;
      if (!xcd_tile(itx, bid, nb, MT, NT, mt, nt)) break;
      int m0 = mt * 128, n0 = nt * 128;
      auto rowfn = [&](int r) -> const void* { return p.S1 + (size_t)(m0 + r) * 384 + d * 64; };
      u16* dst = p.dec + (size_t)d * T_SUB * 256;
      const float* w0 = p.rw_w0 + (l * 2 + d) * 256;
      auto epi = [&](f32x4(&acc)[4][4], int rbase, int cbase) {
        EPI_LOOP({
          f32x4 o;
          for (int j = 0; j < 4; j++) o[j] = __expf(-0.6065306597126334f * sigm(w0[n0 + col + j] + v[j]));
          st_bf4(dst + (size_t)(m0 + row) * 256 + n0 + col, o);
        })
      };
      gemm_tile<false>(rowfn, p.wup_t + ((size_t)(l * 2 + d) * 256 + n0) * 64, 64, epi, lds, tid);
    }
  }
  for (int d = 0; d < 2; d++) {
    const int NT = 2;
    for (int itx = 0;; itx++) {
      int nt, mt;
      if (!xcd_tile(itx, bid, nb, MT, NT, mt, nt)) break;
      int m0 = mt * 128, n0 = nt * 128;
      auto rowfn = [&](int r) -> const void* { return p.S1 + (size_t)(m0 + r) * 384 + 128 + d * 64; };
      u16* dka = p.kka + (size_t)d * T_SUB * 256;
      u16* dkt = p.kt + (size_t)d * T_SUB * 256;
      const float* a0 = p.rw_a0 + (l * 2 + d) * 256;
      const float* ka = p.rw_ka + l * 256;
      const u16* kkp = p.kk;
      const u16* ksp = p.ks;
      auto epi = [&](f32x4(&acc)[4][4], int rbase, int cbase) {
        EPI_LOOP({
          size_t o = (size_t)(m0 + row) * 256 + n0 + col;
          uint2 kkr = *(const uint2*)(kkp + o);
          uint2 ksr = *(const uint2*)(ksp + o);
          float kkv[4] = {blo(kkr.x), bhi(kkr.x), blo(kkr.y), bhi(kkr.y)};
          float ksv[4] = {blo(ksr.x), bhi(ksr.x), blo(ksr.y), bhi(ksr.y)};
          f32x4 o1, o2;
          for (int j = 0; j < 4; j++) {
            float a = sigm(a0[n0 + col + j] + v[j]);
            o1[j] = kkv[j] * a;
            o2[j] = ksv[j] * (1.f + (a - 1.f) * ka[n0 + col + j]);
          }
          st_bf4(dka + o, o1);
          st_bf4(dkt + o, o2);
        })
      };
      gemm_tile<false>(rowfn, p.aup_t + ((size_t)(l * 2 + d) * 256 + n0) * 64, 64, epi, lds, tid);
    }
  }
  {
    const int NT = 2;
    for (int itx = 0;; itx++) {
      int nt, mt;
      if (!xcd_tile(itx, bid, nb, MT, NT, mt, nt)) break;
      int m0 = mt * 128, n0 = nt * 128;
      auto rowfn = [&](int r) -> const void* { return p.S1 + (size_t)(m0 + r) * 384 + 256; };
      u16* dst = p.gD;
      auto epi = [&](f32x4(&acc)[4][4], int rbase, int cbase) {
        EPI_LOOP({ st_bf4(dst + (size_t)(m0 + row) * 256 + n0 + col, v); })
      };
      gemm_tile<false>(rowfn, p.gup_t + ((size_t)l * 256 + n0) * 128, 128, epi, lds, tid);
    }
  }
}

DI bf16x8 pack8(const f32x16& s, int o) {
  u32x4_t r = {pack2(s[o], s[o + 1]), pack2(s[o + 2], s[o + 3]), pack2(s[o + 4], s[o + 5]), pack2(s[o + 6], s[o + 7])};
  return __builtin_bit_cast(bf16x8, r);
}

constexpr int AT_KP = 208, AT_VP = 144, AT_BUF = 64 * AT_KP + 64 * AT_VP;
DI void attn_task(const Params& p, int task, int N, char* lds, int tid) {
  const int lane = tid & 63, wv = tid >> 6, r = lane & 31, hf = lane >> 5;
  const int nqb = N >> 7;
  {
    const int qb = task % nqb, bh = task / nqb, h = bh & 3, b = bh >> 2;
    const size_t tb = (size_t)b * N;
    const int q = qb * 128 + wv * 32 + r;
    bf16x8 qf[6];
    {
      const u16* qrow = p.Q + (tb + q) * 384 + h * 96;
#pragma unroll
      for (int ks = 0; ks < 4; ks++) qf[ks] = *(const bf16x8*)(qrow + ks * 16 + hf * 8);
      bf16x8 x1r = *(const bf16x8*)(qrow + 64 + hf * 8);
      bf16x8 x2r = *(const bf16x8*)(qrow + 80 + hf * 8);
      const float* cp = p.ropec + q * 16 + hf * 8;
      const float* sp = p.ropes + q * 16 + hf * 8;
      float ra[8], rb[8];
#pragma unroll
      for (int j = 0; j < 8; j++) {
        float xa = bf2f((u16)x1r[j]), ya = bf2f((u16)x2r[j]);
        float c0 = cp[j], s0 = sp[j];
        ra[j] = xa * c0 - ya * s0;
        rb[j] = xa * s0 + ya * c0;
      }
      u32x4_t o1 = {pack2(ra[0], ra[1]), pack2(ra[2], ra[3]), pack2(ra[4], ra[5]), pack2(ra[6], ra[7])};
      u32x4_t o2 = {pack2(rb[0], rb[1]), pack2(rb[2], rb[3]), pack2(rb[4], rb[5]), pack2(rb[6], rb[7])};
      qf[4] = __builtin_bit_cast(bf16x8, o1);
      qf[5] = __builtin_bit_cast(bf16x8, o2);
    }
    const u16* Kg = p.Kb + tb * 384 + h * 96;
    const u16* Vg = p.Vt + ((size_t)(b * 4 + h) * 64) * N;
    uint4 kr0, kr1, kr2, vr0, vr1;
    const int lkey = tid >> 2, lpart = tid & 3;
    const int lrow = swap23(lkey);
#define AT_GLOAD(kt_)                                                              \
  {                                                                                \
    const u16* kp_ = Kg + (size_t)((kt_) * 64 + lkey) * 384 + lpart * 24;          \
    kr0 = *(const uint4*)(kp_);                                                    \
    kr1 = *(const uint4*)(kp_ + 8);                                                \
    kr2 = *(const uint4*)(kp_ + 16);                                               \
    const u16* vp_ = Vg + (size_t)lkey * N + (kt_) * 64 + lpart * 16;              \
    vr0 = *(const uint4*)(vp_);                                                    \
    vr1 = *(const uint4*)(vp_ + 8);                                                \
  }
#define AT_LSTORE(buf_)                                                            \
  {                                                                                \
    char* Kl_ = lds + (buf_) * AT_BUF;                                             \
    char* Vl_ = Kl_ + 64 * AT_KP;                                                  \
    *(uint4*)(Kl_ + lrow * AT_KP + (lpart * 3 + 0) * 16) = kr0;                    \
    *(uint4*)(Kl_ + lrow * AT_KP + (lpart * 3 + 1) * 16) = kr1;                    \
    *(uint4*)(Kl_ + lrow * AT_KP + (lpart * 3 + 2) * 16) = kr2;                    \
    *(uint4*)(Vl_ + lkey * AT_VP + (lpart * 2 + 0) * 16) = vr0;                    \
    *(uint4*)(Vl_ + lkey * AT_VP + (lpart * 2 + 1) * 16) = vr1;                    \
  }
    f32x16 O0, O1;
#pragma unroll
    for (int i = 0; i < 16; i++) { O0[i] = 0.f; O1[i] = 0.f; }
    float mrun = 0.f, lrun = 0.f;
    const int nt = N >> 6;
    __syncthreads();
    AT_GLOAD(0);
    AT_LSTORE(0);
    __syncthreads();
    for (int kt = 0; kt < nt; kt++) {
      if (kt + 1 < nt) AT_GLOAD(kt + 1);
      __builtin_amdgcn_sched_barrier(0);
      const char* Kl = lds + (kt & 1) * AT_BUF;
      const char* Vl = Kl + 64 * AT_KP;
      f32x16 S0, S1;
      {
        const float nm = -mrun;
#pragma unroll
        for (int i = 0; i < 16; i++) { S0[i] = nm; S1[i] = nm; }
      }
#pragma unroll
      for (int ks = 0; ks < 6; ks++) {
        bf16x8 a0 = *(const bf16x8*)(Kl + r * AT_KP + ks * 32 + hf * 16);
        bf16x8 a1 = *(const bf16x8*)(Kl + (32 + r) * AT_KP + ks * 32 + hf * 16);
        S0 = __builtin_amdgcn_mfma_f32_32x32x16_bf16(a0, qf[ks], S0, 0, 0, 0);
        S1 = __builtin_amdgcn_mfma_f32_32x32x16_bf16(a1, qf[ks], S1, 0, 0, 0);
      }
      float mx = fmaxf(S0[0], S1[0]);
#pragma unroll
      for (int i = 1; i < 16; i++) mx = fmaxf(mx, fmaxf(S0[i], S1[i]));
      if (__any((mx > 12.f) || (kt == 0))) {
        const float mq = fmaxf(mx, __shfl_xor(mx, 32));
        const float shift = (kt == 0) ? mq : ((mq > 12.f) ? mq : 0.f);
        const float sc = (kt == 0) ? 1.f : ex2(-shift);
        mrun += shift;
        lrun *= sc;
#pragma unroll
        for (int i = 0; i < 16; i++) {
          S0[i] -= shift;
          S1[i] -= shift;
          O0[i] *= sc;
          O1[i] *= sc;
        }
      }
      float ls = 0.f;
#pragma unroll
      for (int i = 0; i < 16; i++) {
        S0[i] = ex2(S0[i]);
        S1[i] = ex2(S1[i]);
        ls += S0[i] + S1[i];
      }
      lrun += ls;
#pragma unroll
      for (int sp = 0; sp < 4; sp++) {
        bf16x8 pb = (sp < 2) ? pack8(S0, (sp & 1) * 8) : pack8(S1, (sp & 1) * 8);
        bf16x8 v0 = *(const bf16x8*)(Vl + r * AT_VP + sp * 32 + hf * 16);
        bf16x8 v1 = *(const bf16x8*)(Vl + (32 + r) * AT_VP + sp * 32 + hf * 16);
        O0 = __builtin_amdgcn_mfma_f32_32x32x16_bf16(v0, pb, O0, 0, 0, 0);
        O1 = __builtin_amdgcn_mfma_f32_32x32x16_bf16(v1, pb, O1, 0, 0, 0);
      }
      __builtin_amdgcn_sched_barrier(0);
      if (kt + 1 < nt) AT_LSTORE((kt + 1) & 1);
      __syncthreads();
    }
    float lt = lrun + __shfl_xor(lrun, 32);
    float inv = 1.f / lt;
    u16* orow = p.cat + (tb + q) * 1024 + h * 64;
#pragma unroll
    for (int g = 0; g < 4; g++) {
      int d0 = 8 * g + 4 * hf;
      *(uint2*)(orow + d0) = make_uint2(pack2(O0[4 * g] * inv, O0[4 * g + 1] * inv), pack2(O0[4 * g + 2] * inv, O0[4 * g + 3] * inv));
      *(uint2*)(orow + 32 + d0) = make_uint2(pack2(O1[4 * g] * inv, O1[4 * g + 1] * inv), pack2(O1[4 * g + 2] * inv, O1[4 * g + 3] * inv));
    }
  }
}

DI void na_task(const Params& p, int l, int task, int N, int tid) {
  const int lane = tid & 63, head = tid >> 6, r = lane & 31, hf = lane >> 5;
  const int rows = N >> 6;
  const int nrb = rows >> 1;
  const float* bias = p.na_bias + (size_t)(l * 4 + head) * 15 * 31;
  {
    const int cb = task & 3, rb = (task >> 2) % nrb, b = (task >> 2) / nrb;
    const size_t tb = (size_t)b * N;
    const int qrow0 = rb * 2;
    const int rstart0 = clampi(qrow0 - 4, 0, rows - 8);
    const int k0 = clampi(rstart0, 0, rows - 9);
    const int kstart = clampi(cb * 16 - 8, 0, 32);
    const int iq = r >> 4, u = r & 15;
    const int qrow = qrow0 + iq, qcol = cb * 16 + u;
    const int rstart = clampi(qrow - 4, 0, rows - 8);
    const int cstart = clampi(qcol - 8, 0, 48);
    bf16x8 qf[4];
    {
      const u16* qp = p.z + (tb + qrow * 64 + qcol) * ZLD + ZB_OFF + head * 64;
#pragma unroll
      for (int ks = 0; ks < 4; ks++) qf[ks] = *(const bf16x8*)(qp + ks * 16 + hf * 8);
    }
    f32x16 O0, O1;
#pragma unroll
    for (int i = 0; i < 16; i++) { O0[i] = 0.f; O1[i] = 0.f; }
    float mrun = -1e30f, lrun = 0.f;
    const int wk = swap23(r);
    for (int j = 0; j < 9; j++) {
      const int krow = k0 + j;
      const u16* kp = p.z + (tb + krow * 64 + kstart + wk) * ZLD + ZB_OFF + 256 + head * 64;
      f32x16 S;
#pragma unroll
      for (int i = 0; i < 16; i++) S[i] = 0.f;
#pragma unroll
      for (int ks = 0; ks < 4; ks++) {
        bf16x8 a = *(const bf16x8*)(kp + ks * 16 + hf * 8);
        S = __builtin_amdgcn_mfma_f32_32x32x16_bf16(a, qf[ks], S, 0, 0, 0);
      }
      const bool rok = (krow >= rstart) && (krow < rstart + 8);
      const int drow = clampi(krow - qrow + 7, 0, 14);
      const float* brow = bias + drow * 31;
      float mx = -1e30f;
#pragma unroll
      for (int i = 0; i < 16; i++) {
        int w = 16 * (i >> 3) + 8 * hf + 4 * ((i >> 2) & 1) + (i & 3);
        int kcol = kstart + w;
        bool ok = rok && (kcol >= cstart) && (kcol < cstart + 16);
        int dcol = clampi(kcol - qcol + 15, 0, 30);
        float s = (S[i] * 0.125f + brow[dcol]) * LOG2E;
        S[i] = ok ? s : -1e30f;
        mx = fmaxf(mx, S[i]);
      }
      mx = fmaxf(mx, __shfl_xor(mx, 32));
      float mn = fmaxf(mrun, mx);
      float alpha = ex2(mrun - mn);
      mrun = mn;
      float ls = 0.f;
#pragma unroll
      for (int i = 0; i < 16; i++) {
        float pv = (S[i] > -1e29f) ? ex2(S[i] - mn) : 0.f;
        S[i] = pv;
        ls += pv;
      }
      lrun = lrun * alpha + ls;
#pragma unroll
      for (int i = 0; i < 16; i++) { O0[i] *= alpha; O1[i] *= alpha; }
      const u16* vbase = p.z + (tb + krow * 64 + kstart) * ZLD + ZB_OFF + 512 + head * 64 + r;
#pragma unroll
      for (int s = 0; s < 2; s++) {
        bf16x8 pb = pack8(S, s * 8);
        bf16x8 v0, v1;
#pragma unroll
        for (int jj = 0; jj < 8; jj++) {
          const u16* vp = vbase + (size_t)(16 * s + 8 * hf + jj) * ZLD;
          v0[jj] = (short)vp[0];
          v1[jj] = (short)vp[32];
        }
        O0 = __builtin_amdgcn_mfma_f32_32x32x16_bf16(v0, pb, O0, 0, 0, 0);
        O1 = __builtin_amdgcn_mfma_f32_32x32x16_bf16(v1, pb, O1, 0, 0, 0);
      }
    }
    float lt = lrun + __shfl_xor(lrun, 32);
    float inv = 1.f / lt;
    u16* orow = p.cat + (tb + qrow * 64 + qcol) * 1024 + 256 + head * 64;
#pragma unroll
    for (int g = 0; g < 4; g++) {
      int d0 = 8 * g + 4 * hf;
      *(uint2*)(orow + d0) = make_uint2(pack2(O0[4 * g] * inv, O0[4 * g + 1] * inv), pack2(O0[4 * g + 2] * inv, O0[4 * g + 3] * inv));
      *(uint2*)(orow + 32 + d0) = make_uint2(pack2(O1[4 * g] * inv, O1[4 * g + 1] * inv), pack2(O1[4 * g + 2] * inv, O1[4 * g + 3] * inv));
    }
  }
}

using f32x2 = __attribute__((ext_vector_type(2))) float;
constexpr int SC_STEPS = 16;

DI void sc_store(char* buf, int dst, uint4 R, bool hgw) {
  float4 lo = make_float4(blo(R.x), bhi(R.x), blo(R.y), bhi(R.y));
  float4 hi = make_float4(blo(R.z), bhi(R.z), blo(R.w), bhi(R.w));
  *(float4*)(buf + dst) = lo;
  *(float4*)(buf + dst + 16) = hi;
  if (hgw) {
    *(float4*)(buf + dst + 256) = make_float4(1.f - lo.x, 1.f - lo.y, 1.f - lo.z, 1.f - lo.w);
    *(float4*)(buf + dst + 272) = make_float4(1.f - hi.x, 1.f - hi.y, 1.f - hi.z, 1.f - hi.w);
  }
}

DI float reduce8(float v) {
  v += dpp_f<0xB1>(v);
  v += dpp_f<0x4E>(v);
  v += dpp_f<0x141>(v);
  return v;
}

template <bool RW>
DI void scan_task(const Params& p, int task, int N, char* lds, int tid) {
  constexpr int NA = RW ? 5 : 3;
  constexpr int VOFF = SC_STEPS * NA * 256;
  constexpr int BUF = VOFF + SC_STEPS * 128;
  const int lane = tid & 63, wv = tid >> 6, kq = lane & 7, rg = lane >> 3;
  const int rq = task & 1, hh = (task >> 1) & 3, dir = (task >> 3) & 1, b = task >> 4;
  const size_t tb = (size_t)b * N;
  const int sub = tid >> 7, lt = tid & 127, lstep = lt >> 3, lpart = lt & 7;
  const int vstep = lt >> 2, vq = lt & 3;
  const u16 *src0 = nullptr, *src1 = nullptr, *src2 = nullptr;
  int dst0 = 0, dst1 = 0, dst2 = 0, st0 = 0, st1 = 0, st2 = 0;
  bool act0 = false, act1 = false, act2 = false, hgw = false;
  int ld;
  const int acol = hh * 64 + lpart * 8;
  const int vcol = hh * 64 + rq * 32 + vq * 8;
  const int vdst = VOFF + vstep * 128 + vq * 32;
  if (RW) {
    ld = 256;
    act0 = true; st0 = lstep;
    src0 = sub ? (p.dec + (size_t)dir * T_SUB * 256 + acol) : (p.rs + acol);
    dst0 = (lstep * NA + (sub ? 1 : 0)) * 256 + lpart * 32;
    act1 = true; st1 = lstep;
    src1 = sub ? (p.kk + acol) : (p.kt + (size_t)dir * T_SUB * 256 + acol);
    dst1 = (lstep * NA + (sub ? 3 : 2)) * 256 + lpart * 32;
    if (sub == 0) { act2 = true; st2 = lstep; src2 = p.kka + (size_t)dir * T_SUB * 256 + acol; dst2 = (lstep * NA + 4) * 256 + lpart * 32; }
    else { act2 = lt < 64; st2 = vstep; src2 = p.vs + vcol; dst2 = vdst; }
  } else {
    ld = ZLD;
    act0 = true; st0 = lstep;
    src0 = sub ? (p.z + ZC_OFF + 256 * (1 + dir) + acol) : (p.z + ZC_OFF + acol);
    dst0 = (lstep * NA + (sub ? 1 : 0)) * 256 + lpart * 32;
    hgw = sub != 0;
    if (sub == 0) { act1 = lt < 64; st1 = vstep; src1 = p.z + ZC_OFF + 768 + vcol; dst1 = vdst; }
  }
  u16* pout = (RW ? p.oD : p.oC) + (size_t)dir * T_SUB * 256 + hh * 64 + rq * 32 + wv * 8 + rg;
  pout += (tb + (dir ? (N - 1) : 0)) * 256;
  const int ostride = dir ? -256 : 256;

#define SC_TOK(c_, st_) (tb + (size_t)(dir ? (N - 1 - ((c_) * SC_STEPS + (st_))) : ((c_) * SC_STEPS + (st_))))
#define SC_ISSUE(Ra, Rb, Rc, c_)                                               \
  {                                                                            \
    if (act0) Ra = *(const uint4*)(src0 + SC_TOK(c_, st0) * ld);               \
    if (act1) Rb = *(const uint4*)(src1 + SC_TOK(c_, st1) * ld);               \
    if (act2) Rc = *(const uint4*)(src2 + SC_TOK(c_, st2) * ld);               \
  }
#define SC_STORE(Ra, Rb, Rc, buf_)                                             \
  {                                                                            \
    if (act0) sc_store(buf_, dst0, Ra, hgw);                                   \
    if (act1) sc_store(buf_, dst1, Rb, false);                                 \
    if (act2) sc_store(buf_, dst2, Rc, false);                                 \
  }
  f32x2 S0 = {0.f, 0.f}, S1 = {0.f, 0.f}, S2 = {0.f, 0.f}, S3 = {0.f, 0.f};
#define SC_LD(buf_, s_, ra_, rb_, wa_, wb_, ta_, tb_, ka_, kb_, aa_, ab_, v_)                \
  {                                                                                          \
    const char* rowp_ = (buf_) + (s_) * NA * 256 + kq * 32;                                  \
    ra_ = *(const float4*)(rowp_);                                                           \
    rb_ = *(const float4*)(rowp_ + 16);                                                      \
    wa_ = *(const float4*)(rowp_ + 256);                                                     \
    wb_ = *(const float4*)(rowp_ + 272);                                                     \
    ta_ = *(const float4*)(rowp_ + 512);                                                     \
    tb_ = *(const float4*)(rowp_ + 528);                                                     \
    if (RW) {                                                                                \
      ka_ = *(const float4*)(rowp_ + 768);                                                   \
      kb_ = *(const float4*)(rowp_ + 784);                                                   \
      aa_ = *(const float4*)(rowp_ + 1024);                                                  \
      ab_ = *(const float4*)(rowp_ + 1040);                                                  \
    }                                                                                        \
    v_ = *(const float*)((buf_) + VOFF + (s_) * 128 + (wv * 8 + rg) * 4);                    \
  }
#define F2A(q_) f32x2{(q_).x, (q_).y}
#define F2B(q_) f32x2{(q_).z, (q_).w}
#define SC_COMPUTE(buf_)                                                                     \
  {                                                                                          \
    float oselA = 0.f, oselB = 0.f;                                                          \
    float4 ra, rb, wa, wb, ta, tb_, ka, kb, aa, ab, nra, nrb, nwa, nwb, nta, ntb, nka, nkb, naa, nab; \
    float vv, nvv;                                                                           \
    ka = kb = aa = ab = nka = nkb = naa = nab = make_float4(0.f, 0.f, 0.f, 0.f);             \
    SC_LD(buf_, 0, ra, rb, wa, wb, ta, tb_, ka, kb, aa, ab, vv);                             \
    _Pragma("unroll") for (int s = 0; s < SC_STEPS; s++) {                                   \
      if (s + 1 < SC_STEPS) SC_LD(buf_, s + 1, nra, nrb, nwa, nwb, nta, ntb, nka, nkb, naa, nab, nvv); \
      f32x2 u0 = F2A(ta) * vv, u1 = F2B(ta) * vv, u2 = F2A(tb_) * vv, u3 = F2B(tb_) * vv;     \
      if (RW) {                                                                              \
        f32x2 pa = S0 * F2A(ka), pb = S1 * F2B(ka);                                          \
        pa = S2 * F2A(kb) + pa;                                                              \
        pb = S3 * F2B(kb) + pb;                                                              \
        pa = pa + pb;                                                                        \
        const float sa = -reduce8(pa.x + pa.y);                                              \
        u0 = F2A(aa) * sa + u0;                                                              \
        u1 = F2B(aa) * sa + u1;                                                              \
        u2 = F2A(ab) * sa + u2;                                                              \
        u3 = F2B(ab) * sa + u3;                                                              \
      }                                                                                      \
      S0 = S0 * F2A(wa) + u0;                                                                \
      S1 = S1 * F2B(wa) + u1;                                                                \
      S2 = S2 * F2A(wb) + u2;                                                                \
      S3 = S3 * F2B(wb) + u3;                                                                \
      f32x2 qa = S0 * F2A(ra), qb = S1 * F2B(ra);                                            \
      qa = S2 * F2A(rb) + qa;                                                                \
      qb = S3 * F2B(rb) + qb;                                                                \
      qa = qa + qb;                                                                          \
      const float o = reduce8(qa.x + qa.y);                                                  \
      if (s < 8) oselA = (kq == s) ? o : oselA;                                              \
      else oselB = (kq == s - 8) ? o : oselB;                                                \
      ra = nra; rb = nrb; wa = nwa; wb = nwb; ta = nta; tb_ = ntb;                           \
      ka = nka; kb = nkb; aa = naa; ab = nab; vv = nvv;                                      \
    }                                                                                        \
    pout[kq * ostride] = f2bf(oselA);                                                        \
    pout[(kq + 8) * ostride] = f2bf(oselB);                                                  \
    pout += SC_STEPS * ostride;                                                              \
  }
  uint4 A0 = make_uint4(0, 0, 0, 0), A1 = A0, A2 = A0, B0 = A0, B1 = A0, B2 = A0;
  char* buf0 = lds;
  char* buf1 = lds + BUF;
  const int nch = N / SC_STEPS;
  __syncthreads();
  SC_ISSUE(A0, A1, A2, 0);
  SC_ISSUE(B0, B1, B2, 1);
  SC_STORE(A0, A1, A2, buf0);
  __syncthreads();
  for (int c = 0; c < nch; c += 2) {
    if (c + 2 < nch) SC_ISSUE(A0, A1, A2, c + 2);
    __builtin_amdgcn_sched_barrier(0);
    SC_COMPUTE(buf0);
    __builtin_amdgcn_sched_barrier(0);
    SC_STORE(B0, B1, B2, buf1);
    __syncthreads();
    if (c + 3 < nch) SC_ISSUE(B0, B1, B2, c + 3);
    __builtin_amdgcn_sched_barrier(0);
    SC_COMPUTE(buf1);
    __builtin_amdgcn_sched_barrier(0);
    if (c + 2 < nch) SC_STORE(A0, A1, A2, buf0);
    __syncthreads();
  }
}

template <bool RW>
DI void scan_task16(const Params& p, int task, int N, char* lds, int tid) {
  constexpr int NA = RW ? 5 : 3;
  constexpr int VOFF = SC_STEPS * NA * 256;
  constexpr int BUF = VOFF + SC_STEPS * 64;
  const int lane = tid & 63, wv = tid >> 6, kq = lane & 15, rg = lane >> 4;
  const int rq = task & 3, hh = (task >> 2) & 3, dir = (task >> 4) & 1, b = task >> 5;
  const size_t tb = (size_t)b * N;
  const int sub = tid >> 7, lt = tid & 127, lstep = lt >> 3, lpart = lt & 7;
  const int vstep = lt >> 1, vhalf = lt & 1;
  const u16 *src0 = nullptr, *src1 = nullptr, *src2 = nullptr;
  int dst0 = 0, dst1 = 0, dst2 = 0, st0 = 0, st1 = 0, st2 = 0;
  bool act0 = false, act1 = false, act2 = false, hgw = false;
  int ld;
  const int acol = hh * 64 + lpart * 8;
  const int vcol = hh * 64 + rq * 16 + vhalf * 8;
  const int vdst = VOFF + vstep * 64 + vhalf * 32;
  if (RW) {
    ld = 256;
    act0 = true; st0 = lstep;
    src0 = sub ? (p.dec + (size_t)dir * T_SUB * 256 + acol) : (p.rs + acol);
    dst0 = (lstep * NA + (sub ? 1 : 0)) * 256 + lpart * 32;
    act1 = true; st1 = lstep;
    src1 = sub ? (p.kk + acol) : (p.kt + (size_t)dir * T_SUB * 256 + acol);
    dst1 = (lstep * NA + (sub ? 3 : 2)) * 256 + lpart * 32;
    if (sub == 0) { act2 = true; st2 = lstep; src2 = p.kka + (size_t)dir * T_SUB * 256 + acol; dst2 = (lstep * NA + 4) * 256 + lpart * 32; }
    else { act2 = lt < 32; st2 = vstep; src2 = p.vs + vcol; dst2 = vdst; }
  } else {
    ld = ZLD;
    act0 = true; st0 = lstep;
    src0 = sub ? (p.z + ZC_OFF + 256 * (1 + dir) + acol) : (p.z + ZC_OFF + acol);
    dst0 = (lstep * NA + (sub ? 1 : 0)) * 256 + lpart * 32;
    hgw = sub != 0;
    if (sub == 0) { act1 = lt < 32; st1 = vstep; src1 = p.z + ZC_OFF + 768 + vcol; dst1 = vdst; }
  }
  u16* pout = (RW ? p.oD : p.oC) + (size_t)dir * T_SUB * 256 + hh * 64 + rq * 16 + wv * 4 + rg;
  pout += (tb + (dir ? (N - 1) : 0)) * 256;
  const int ostride = dir ? -256 : 256;

#define SC16_TOK(c_, st_) (tb + (size_t)(dir ? (N - 1 - ((c_) * SC_STEPS + (st_))) : ((c_) * SC_STEPS + (st_))))
#define SC16_ISSUE(Ra, Rb, Rc, c_)                                               \
  {                                                                            \
    if (act0) Ra = *(const uint4*)(src0 + SC16_TOK(c_, st0) * ld);               \
    if (act1) Rb = *(const uint4*)(src1 + SC16_TOK(c_, st1) * ld);               \
    if (act2) Rc = *(const uint4*)(src2 + SC16_TOK(c_, st2) * ld);               \
  }
#define SC16_STORE(Ra, Rb, Rc, buf_)                                             \
  {                                                                            \
    if (act0) sc_store(buf_, dst0, Ra, hgw);                                   \
    if (act1) sc_store(buf_, dst1, Rb, false);                                 \
    if (act2) sc_store(buf_, dst2, Rc, false);                                 \
  }
  f32x2 S01 = {0.f, 0.f}, S23 = {0.f, 0.f};
#define SC16_LD(buf_, s_, r_, w_, t_, k_, a_, v_)                                              \
  {                                                                                          \
    const char* rowp_ = (buf_) + (s_) * NA * 256 + kq * 16;                                  \
    r_ = *(const float4*)(rowp_);                                                            \
    w_ = *(const float4*)(rowp_ + 256);                                                      \
    t_ = *(const float4*)(rowp_ + 512);                                                      \
    if (RW) {                                                                                \
      k_ = *(const float4*)(rowp_ + 768);                                                    \
      a_ = *(const float4*)(rowp_ + 1024);                                                   \
    }                                                                                        \
    v_ = *(const float*)((buf_) + VOFF + (s_) * 64 + (wv * 4 + rg) * 4);                     \
  }
#define SC16_COMPUTE(buf_)                                                                     \
  {                                                                                          \
    float osel = 0.f;                                                                        \
    float4 r4, w4, t4, k4, a4, nr4, nw4, nt4, nk4, na4;                                      \
    float vv, nvv;                                                                           \
    k4 = a4 = nk4 = na4 = make_float4(0.f, 0.f, 0.f, 0.f);                                   \
    SC16_LD(buf_, 0, r4, w4, t4, k4, a4, vv);                                                  \
    _Pragma("unroll") for (int s = 0; s < SC_STEPS; s++) {                                   \
      if (s + 1 < SC_STEPS) SC16_LD(buf_, s + 1, nr4, nw4, nt4, nk4, na4, nvv);                \
      f32x2 ta = f32x2{t4.x, t4.y} * vv, tb2 = f32x2{t4.z, t4.w} * vv;                       \
      if (RW) {                                                                              \
        f32x2 pp = S01 * f32x2{k4.x, k4.y};                                                  \
        pp = S23 * f32x2{k4.z, k4.w} + pp;                                                   \
        const float sa = -reduce16(pp.x + pp.y);                                             \
        ta = f32x2{a4.x, a4.y} * sa + ta;                                                    \
        tb2 = f32x2{a4.z, a4.w} * sa + tb2;                                                  \
      }                                                                                      \
      S01 = S01 * f32x2{w4.x, w4.y} + ta;                                                    \
      S23 = S23 * f32x2{w4.z, w4.w} + tb2;                                                   \
      f32x2 qq = S01 * f32x2{r4.x, r4.y};                                                    \
      qq = S23 * f32x2{r4.z, r4.w} + qq;                                                     \
      const float o = reduce16(qq.x + qq.y);                                                 \
      osel = (kq == s) ? o : osel;                                                           \
      r4 = nr4; w4 = nw4; t4 = nt4; k4 = nk4; a4 = na4; vv = nvv;                            \
    }                                                                                        \
    pout[kq * ostride] = f2bf(osel);                                                         \
    pout += SC_STEPS * ostride;                                                              \
  }
  uint4 A0 = make_uint4(0, 0, 0, 0), A1 = A0, A2 = A0, B0 = A0, B1 = A0, B2 = A0;
  char* buf0 = lds;
  char* buf1 = lds + BUF;
  const int nch = N / SC_STEPS;
  __syncthreads();
  SC16_ISSUE(A0, A1, A2, 0);
  SC16_ISSUE(B0, B1, B2, 1);
  SC16_STORE(A0, A1, A2, buf0);
  __syncthreads();
  for (int c = 0; c < nch; c += 2) {
    if (c + 2 < nch) SC16_ISSUE(A0, A1, A2, c + 2);
    __builtin_amdgcn_sched_barrier(0);
    SC16_COMPUTE(buf0);
    __builtin_amdgcn_sched_barrier(0);
    SC16_STORE(B0, B1, B2, buf1);
    __syncthreads();
    if (c + 3 < nch) SC16_ISSUE(B0, B1, B2, c + 3);
    __builtin_amdgcn_sched_barrier(0);
    SC16_COMPUTE(buf1);
    __builtin_amdgcn_sched_barrier(0);
    if (c + 2 < nch) SC16_STORE(A0, A1, A2, buf0);
    __syncthreads();
  }
}


DI void phase_mix(const Params& p, int l, int B, int N, unsigned* ctr, char* lds, int bid, int nb, int tid) {
  __shared__ int s_task[2];
  const bool wide = (N > 4096);
  const int nper = wide ? B * 32 : B * 16;
  const int nscan = 2 * nper;
  const int nattn = B * 4 * (N >> 7);
  const int nna = B * (N >> 7) * 4;
  const bool prefer_scan = bid < (nb >> 1);
  bool scan_dry = false, attn_dry = false;
  for (;;) {
    if (tid == 0) {
      int kind = -1, task = 0;
      for (int attempt = 0; attempt < 2 && kind < 0; attempt++) {
        const bool try_scan = (attempt == 0) == prefer_scan;
        if (try_scan) {
          if (!scan_dry) {
            const int t = (int)atomicAdd(&ctr[0], 1u);
            if (t < nscan) { kind = 0; task = t; } else scan_dry = true;
          }
        } else {
          if (!attn_dry) {
            const int t = (int)atomicAdd(&ctr[64], 1u);
            if (t < nattn + nna) { kind = 1; task = t; } else attn_dry = true;
          }
        }
      }
      s_task[0] = kind;
      s_task[1] = task;
    }
    __syncthreads();
    const int kind = s_task[0], task = s_task[1];
    __syncthreads();
    if (kind < 0) break;
    if (kind == 0) {
      if (wide) {
        if (task < nper) scan_task16<true>(p, task, N, lds, tid);
        else scan_task16<false>(p, task - nper, N, lds, tid);
      } else {
        if (task < nper) scan_task<true>(p, task, N, lds, tid);
        else scan_task<false>(p, task - nper, N, lds, tid);
      }
    } else {
      if (task < nattn) attn_task(p, task, N, lds, tid);
      else na_task(p, l, task - nattn, N, tid);
    }
  }
}

DI void phase_final(const Params& p, int l, int bid, int nb, int tid) {
  const int lane = tid & 63, wv = tid >> 6, c4 = lane * 4;
  float gn[4], lw[4], lbb[4];
#pragma unroll
  for (int j = 0; j < 4; j++) {
    gn[j] = p.hg_gnorm[l * 256 + c4 + j];
    lw[j] = p.rw_ln_w[l * 256 + c4 + j];
    lbb[j] = p.rw_ln_b[l * 256 + c4 + j];
  }
  for (int t = bid * 4 + wv; t < T_SUB; t += nb * 4) {
    const uint2 ca = *(const uint2*)(p.oC + (size_t)t * 256 + c4);
    const uint2 cb = *(const uint2*)(p.oC + (size_t)(T_SUB + t) * 256 + c4);
    const uint2 cg = *(const uint2*)(p.z + (size_t)t * ZLD + ZC_OFF + 1024 + c4);
    const uint2 da = *(const uint2*)(p.oD + (size_t)t * 256 + c4);
    const uint2 db = *(const uint2*)(p.oD + (size_t)(T_SUB + t) * 256 + c4);
    const float bo = p.bonus[(size_t)t * 4 + (lane >> 4)];
    const uint2 vr = *(const uint2*)(p.vs + (size_t)t * 256 + c4);
    const uint2 gr = *(const uint2*)(p.gD + (size_t)t * 256 + c4);
    {
      float o[4] = {blo(ca.x) + blo(cb.x), bhi(ca.x) + bhi(cb.x), blo(ca.y) + blo(cb.y), bhi(ca.y) + bhi(cb.y)};
      float ss = reduce16(o[0] * o[0] + o[1] * o[1] + o[2] * o[2] + o[3] * o[3]);
      float ri = rsqrtf(ss * (1.f / 64.f) + 1e-6f);
      float g[4] = {blo(cg.x), bhi(cg.x), blo(cg.y), bhi(cg.y)};
      float y[4];
#pragma unroll
      for (int j = 0; j < 4; j++) y[j] = o[j] * ri * gn[j] * (g[j] * sigm(g[j]));
      *(uint2*)(p.cat + (size_t)t * 1024 + 512 + c4) = make_uint2(pack2(y[0], y[1]), pack2(y[2], y[3]));
    }
    {
      float o[4] = {blo(da.x) + blo(db.x), bhi(da.x) + bhi(db.x), blo(da.y) + blo(db.y), bhi(da.y) + bhi(db.y)};
      float mu = reduce16(o[0] + o[1] + o[2] + o[3]) * (1.f / 64.f);
      float d0 = o[0] - mu, d1 = o[1] - mu, d2 = o[2] - mu, d3 = o[3] - mu;
      float var = reduce16(d0 * d0 + d1 * d1 + d2 * d2 + d3 * d3) * (1.f / 64.f);
      float ri = rsqrtf(var + 64e-5f);
      float vv[4] = {blo(vr.x), bhi(vr.x), blo(vr.y), bhi(vr.y)};
      float g[4] = {blo(gr.x), bhi(gr.x), blo(gr.y), bhi(gr.y)};
      float dd[4] = {d0, d1, d2, d3};
      float y[4];
#pragma unroll
      for (int j = 0; j < 4; j++) y[j] = (dd[j] * ri * lw[j] + lbb[j] + bo * vv[j]) * g[j];
      *(uint2*)(p.cat + (size_t)t * 1024 + 768 + c4) = make_uint2(pack2(y[0], y[1]), pack2(y[2], y[3]));
    }
  }
}

DI void phase_wout(const Params& p, int l, int tok0, char* lds, int bid, int nb, int tid) {
  const int NT = 8, MT = T_SUB / 128;
  for (int it = 0;; it++) {
    int nt, mt;
    if (!xcd_tile(it, bid, nb, MT, NT, mt, nt)) break;
    int m0 = mt * 128, n0 = nt * 128;
    auto rowfn = [&](int r) -> const void* { return p.cat + (size_t)(m0 + r) * 1024; };
    auto epi = [&](f32x4(&acc)[4][4], int rbase, int cbase) {
      EPI_LOOP({
        int tg = tok0 + m0 + row;
        float4 xv = *(const float4*)(xin_row(p, l, tg) + n0 + col);
        float4 o = make_float4(ALPHA_F * xv.x + v[0], ALPHA_F * xv.y + v[1], ALPHA_F * xv.z + v[2], ALPHA_F * xv.w + v[3]);
        *(float4*)(p.out + (size_t)tg * 1024 + n0 + col) = o;
      })
    };
    gemm_tile<false>(rowfn, p.wout_t + ((size_t)l * 1024 + n0) * 1024, 1024, epi, lds, tid);
  }
}

template <bool ROUTER>
DI void phase_ln(const Params& p, const float* g, const float* bta, const float* wrouter, int tok0, int ntok, char* lds,
                 int bid, int nb, int tid) {
  const int lane = tid & 63, wv = tid >> 6;
  float* wl = (float*)lds;
  if (ROUTER) {
    __syncthreads();
    for (int i = tid; i < 16384; i += NTHR) {
      int k = i >> 4, e = i & 15;
      wl[e * 1024 + k] = wrouter[i];
    }
    __syncthreads();
  }
  float4 x[4], xn[4];
  {
    const int t0 = bid * 4 + wv;
#pragma unroll
    for (int i = 0; i < 4; i++)
      x[i] = (t0 < ntok) ? *(const float4*)(p.out + (size_t)(tok0 + t0) * 1024 + i * 256 + lane * 4) : make_float4(0.f, 0.f, 0.f, 0.f);
  }
  for (int t = bid * 4 + wv; t < ntok; t += nb * 4) {
    const int tg = tok0 + t;
    float* xr = p.out + (size_t)tg * 1024;
    {
      const int tn = t + nb * 4;
#pragma unroll
      for (int i = 0; i < 4; i++)
        xn[i] = (tn < ntok) ? *(const float4*)(p.out + (size_t)(tok0 + tn) * 1024 + i * 256 + lane * 4) : make_float4(0.f, 0.f, 0.f, 0.f);
    }
    float s = 0.f;
#pragma unroll
    for (int i = 0; i < 4; i++) s += x[i].x + x[i].y + x[i].z + x[i].w;
    float mu = wave_sum(s) * (1.f / 1024.f);
    float vs = 0.f;
#pragma unroll
    for (int i = 0; i < 4; i++) {
      x[i].x -= mu; x[i].y -= mu; x[i].z -= mu; x[i].w -= mu;
      vs += x[i].x * x[i].x + x[i].y * x[i].y + x[i].z * x[i].z + x[i].w * x[i].w;
    }
    float ri = rsqrtf(wave_sum(vs) * (1.f / 1024.f) + 1e-5f);
#pragma unroll
    for (int i = 0; i < 4; i++) {
      float4 gg = *(const float4*)(g + i * 256 + lane * 4);
      float4 bb = *(const float4*)(bta + i * 256 + lane * 4);
      x[i].x = x[i].x * ri * gg.x + bb.x;
      x[i].y = x[i].y * ri * gg.y + bb.y;
      x[i].z = x[i].z * ri * gg.z + bb.z;
      x[i].w = x[i].w * ri * gg.w + bb.w;
      *(float4*)(xr + i * 256 + lane * 4) = x[i];
      *(uint2*)(p.xb + (size_t)tg * 1024 + i * 256 + lane * 4) = make_uint2(pack2(x[i].x, x[i].y), pack2(x[i].z, x[i].w));
    }
    if (ROUTER) {
      float mine = 0.f;
#pragma unroll 1
      for (int e = 0; e < 16; e++) {
        float a = 0.f;
#pragma unroll
        for (int i = 0; i < 4; i++) {
          float4 w = *(const float4*)(wl + e * 1024 + i * 256 + lane * 4);
          a += x[i].x * w.x + x[i].y * w.y + x[i].z * w.z + x[i].w * w.w;
        }
        a = wave_sum(a);
        mine = (lane == e) ? a : mine;
      }
      float mx = mine;
      mx = fmaxf(mx, dpp_f<0xB1>(mx));
      mx = fmaxf(mx, dpp_f<0x4E>(mx));
      mx = fmaxf(mx, dpp_f<0x141>(mx));
      mx = fmaxf(mx, dpp_f<0x140>(mx));
      float ex = __expf(mine - mx);
      float sum = reduce16(ex);
      mine = ex / sum;
      if (lane == 0) p.inv_cnt[tg] = 0;
      if (lane < 16) {
        if (tg < 32768) p.affT[(size_t)lane * 32768 + tg] = mine;
        else p.affT[(size_t)16 * 32768 + (size_t)lane * 65536 + (tg - 32768)] = mine;
      }
    }
#pragma unroll
    for (int i = 0; i < 4; i++) x[i] = xn[i];
  }
}

DI void phase_topk(const Params& p, char* lds, int bid, int nb, int tid) {
  if (bid < 32) {
    unsigned* hist = (unsigned*)lds;
    unsigned* sh = hist + 256;
    unsigned* eqc = sh + 8;
    const int g = bid >> 4, e = bid & 15;
    const int T = g ? 65536 : 32768, cap = T >> 3;
    const int tok0 = g ? 32768 : 0;
    const float* vals = p.affT + (g ? (size_t)16 * 32768 : 0) + (size_t)e * T;
    const float4* v4 = (const float4*)vals;
    const int n4 = T >> 2;
    int* oidx = p.idx + (g ? 65536 : 0) + e * cap;
    float* ogate = p.gate + (g ? 65536 : 0) + e * cap;
    const int slot0 = (g ? 65536 : 0) + e * cap;
    unsigned prefix = 0, mask = 0;
    int remaining = cap;
    for (int pass = 0; pass < 4; pass++) {
      const int shift = 24 - 8 * pass;
      hist[tid] = 0;
      __syncthreads();
      for (int base = 0; base < n4; base += 2048) {
        float4 x[8];
#pragma unroll
        for (int u = 0; u < 8; u++) x[u] = v4[base + u * 256 + tid];
#pragma unroll
        for (int u = 0; u < 8; u++) {
          const unsigned b0 = __float_as_uint(x[u].x), b1 = __float_as_uint(x[u].y), b2 = __float_as_uint(x[u].z), b3 = __float_as_uint(x[u].w);
          if ((b0 & mask) == prefix) atomicAdd(&hist[(b0 >> shift) & 255], 1u);
          if ((b1 & mask) == prefix) atomicAdd(&hist[(b1 >> shift) & 255], 1u);
          if ((b2 & mask) == prefix) atomicAdd(&hist[(b2 >> shift) & 255], 1u);
          if ((b3 & mask) == prefix) atomicAdd(&hist[(b3 >> shift) & 255], 1u);
        }
      }
      __syncthreads();
      if (tid == 0) {
        int cum = 0, sel = 0;
        for (int bq = 255; bq >= 0; bq--) {
          int hc = (int)hist[bq];
          if (cum + hc >= remaining) { sel = bq; break; }
          cum += hc;
        }
        sh[0] = (unsigned)sel;
        sh[1] = (unsigned)(remaining - cum);
        sh[3] = hist[sel];
      }
      __syncthreads();
      prefix |= sh[0] << shift;
      remaining = (int)sh[1];
      mask |= 0xFFu << shift;
      __syncthreads();
    }
    const unsigned thr = prefix;
    const int need = remaining;
    const bool fast = ((int)sh[3] == need);
    if (tid == 0) sh[2] = 0;
    __syncthreads();
    if (fast) {
      for (int base = 0; base < n4; base += 2048) {
        float4 x[8];
#pragma unroll
        for (int u = 0; u < 8; u++) x[u] = v4[base + u * 256 + tid];
#pragma unroll
        for (int u = 0; u < 8; u++) {
          const float xv[4] = {x[u].x, x[u].y, x[u].z, x[u].w};
#pragma unroll
          for (int c = 0; c < 4; c++) {
            if (__float_as_uint(xv[c]) >= thr) {
              const int pos = (int)atomicAdd(&sh[2], 1u);
              const int tok = tok0 + (base + u * 256 + tid) * 4 + c;
              oidx[pos] = tok;
              ogate[pos] = xv[c];
              const int kslot = atomicAdd(&p.inv_cnt[tok], 1);
              p.inv_slot[(size_t)tok * 16 + kslot] = slot0 + pos;
            }
          }
        }
      }
    } else {
      const int ch = T >> 8;
      const float* my = vals + tid * ch;
      int ec = 0;
      for (int i = 0; i < ch; i++) ec += (__float_as_uint(my[i]) == thr) ? 1 : 0;
      eqc[tid] = ec;
      __syncthreads();
      int eq_rank = 0;
      for (int i = 0; i < tid; i++) eq_rank += eqc[i];
      for (int i = 0; i < ch; i++) {
        float v = my[i];
        unsigned u = __float_as_uint(v);
        int pos = -1;
        if (u > thr) {
          pos = (int)atomicAdd(&sh[2], 1u);
        } else if (u == thr) {
          if (eq_rank < need) pos = cap - need + eq_rank;
          eq_rank++;
        }
        if (pos >= 0) {
          const int tok = tok0 + tid * ch + i;
          oidx[pos] = tok;
          ogate[pos] = v;
          const int kslot = atomicAdd(&p.inv_cnt[tok], 1);
          p.inv_slot[(size_t)tok * 16 + kslot] = slot0 + pos;
        }
      }
    }
    __syncthreads();
  }
}

DI void moe_rowinfo(int row0, int l, int& e, int& ioff) {
  if (row0 < 65536) { e = row0 >> 12; }
  else { e = (row0 - 65536) >> 13; }
  ioff = row0;
}

DI void phase_moe1(const Params& p, int l, char* lds, int bid, int nb, int tid) {
  const int NT = 8, MT = 196608 / 128;
  for (int it = 0;; it++) {
    int nt, mt;
    if (!xcd_tile(it, bid, nb, MT, NT, mt, nt)) break;
    int m0 = mt * 128, n0 = nt * 128;
    int e, ioff;
    moe_rowinfo(m0, l, e, ioff);
    const int* ip = p.idx + ioff;
    auto rowfn = [&](int r) -> const void* { return p.xb + (size_t)ip[r] * 1024; };
    u16* H = p.H;
    auto epi = [&](f32x4(&acc)[4][4], int rbase, int cbase) {
#pragma unroll
      for (int m = 0; m < 4; m++)
#pragma unroll
        for (int n = 0; n < 4; n += 2) {
          int row = rbase + m * 16;
          int col = cbase + n * 16;
          int blk = (n0 + (col & ~31)) >> 1;
          int hc = blk + (col & 15);
          f32x4 a = acc[m][n], bq = acc[m][n + 1];
          f32x4 o;
          for (int j = 0; j < 4; j++) o[j] = a[j] * sigm(a[j]) * bq[j];
          st_bf4(H + (size_t)(m0 + row) * 512 + hc, o);
        }
    };
    gemm_tile<false>(rowfn, p.w13_t + ((size_t)(l * 16 + e) * 1024 + n0) * 1024, 1024, epi, lds, tid);
  }
}

DI void phase_moe2(const Params& p, int l, char* lds, int bid, int nb, int tid) {
  TileIter it{bid, nb, 0};
  {
    const int NT = 8, MT = 196608 / 128;
    for (int itx = 0;; itx++) {
      int nt, mt;
      if (!xcd_tile(itx, bid, nb, MT, NT, mt, nt)) break;
      int m0 = mt * 128, n0 = nt * 128;
      int e, ioff;
      moe_rowinfo(m0, l, e, ioff);
      auto rowfn = [&](int r) -> const void* { return p.H + (size_t)(m0 + r) * 512; };
      u16* O = p.O;
      auto epi = [&](f32x4(&acc)[4][4], int rbase, int cbase) {
        EPI_LOOP({ st_bf4(O + (size_t)(m0 + row) * 1024 + n0 + col, v); })
      };
      gemm_tile<false>(rowfn, p.w2_t + ((size_t)(l * 16 + e) * 1024 + n0) * 512, 512, epi, lds, tid);
    }
  }
  {
    const int NT = 8, MT = T_ALL / 128;
    for (int itx = 0;; itx++) {
      int nt, mt;
      if (!xcd_tile(itx, bid, nb, MT, NT, mt, nt)) break;
      int m0 = mt * 128, n0 = nt * 128;
      auto rowfn = [&](int r) -> const void* {
        int tg = m0 + r;
        return tg < 32768 ? p.p_prompt + ((size_t)l * 32768 + tg) * 256 : p.p_sample + ((size_t)l * 65536 + (tg - 32768)) * 256;
      };
      auto epi = [&](f32x4(&acc)[4][4], int rbase, int cbase) {
        EPI_LOOP({ st_bf4(p.xb + (size_t)(m0 + row) * 1024 + n0 + col, v); })
      };
      gemm_tile<true>(rowfn, p.wp_t + ((size_t)l * 1024 + n0) * 256, 256, epi, lds, tid);
    }
  }
}

DI void phase_combine(const Params& p, int bid, int nb, int tid) {
  const int lane = tid & 63, wv = tid >> 6;
  u16* ub = p.H;
  const int stride = nb * 4;
  int t = bid * 4 + wv;
  float4 a[4], an[4];
  int cnt = 0, myslot = 0, cntn = 0, myslotn = 0;
  if (t < T_ALL) {
#pragma unroll
    for (int i = 0; i < 4; i++) a[i] = *(const float4*)(p.out + (size_t)t * 1024 + i * 256 + lane * 4);
    cnt = p.inv_cnt[t];
    myslot = p.inv_slot[(size_t)t * 16 + (lane & 15)];
  }
  for (; t < T_ALL; t += stride) {
    float* xr = p.out + (size_t)t * 1024;
    const int tn = t + stride;
    if (tn < T_ALL) {
#pragma unroll
      for (int i = 0; i < 4; i++) an[i] = *(const float4*)(p.out + (size_t)tn * 1024 + i * 256 + lane * 4);
      cntn = p.inv_cnt[tn];
      myslotn = p.inv_slot[(size_t)tn * 16 + (lane & 15)];
    }
    const float mygate = ((lane & 15) < cnt) ? p.gate[myslot] : 0.f;
#pragma unroll
    for (int i = 0; i < 4; i++) a[i] = make_float4(a[i].x * ALPHA_F, a[i].y * ALPHA_F, a[i].z * ALPHA_F, a[i].w * ALPHA_F);
    for (int j0 = 0; j0 < cnt; j0 += 4) {
      uint2 r[4][4];
      float g[4];
#pragma unroll
      for (int jj = 0; jj < 4; jj++) {
        const int j = (j0 + jj < cnt) ? (j0 + jj) : j0;
        const int slot = __shfl(myslot, j);
        g[jj] = (j0 + jj < cnt) ? __shfl(mygate, j) : 0.f;
        const u16* orow = p.O + (size_t)slot * 1024 + lane * 4;
#pragma unroll
        for (int i = 0; i < 4; i++) r[jj][i] = *(const uint2*)(orow + i * 256);
      }
#pragma unroll
      for (int jj = 0; jj < 4; jj++)
#pragma unroll
        for (int i = 0; i < 4; i++) {
          a[i].x += g[jj] * blo(r[jj][i].x);
          a[i].y += g[jj] * bhi(r[jj][i].x);
          a[i].z += g[jj] * blo(r[jj][i].y);
          a[i].w += g[jj] * bhi(r[jj][i].y);
        }
    }
#pragma unroll
    for (int i = 0; i < 4; i++) {
      *(float4*)(xr + i * 256 + lane * 4) = a[i];
      *(uint2*)(ub + (size_t)t * 1024 + i * 256 + lane * 4) = make_uint2(pack2(a[i].x, a[i].y), pack2(a[i].z, a[i].w));
    }
#pragma unroll
    for (int i = 0; i < 4; i++) a[i] = an[i];
    cnt = cntn;
    myslot = myslotn;
  }
}

DI void phase_ple(const Params& p, int l, char* lds, int bid, int nb, int tid) {
  const int NT = 8, MT = T_ALL / 128;
  for (int it = 0;; it++) {
    int nt, mt;
    if (!xcd_tile(it, bid, nb, MT, NT, mt, nt)) break;
    int m0 = mt * 128, n0 = nt * 128;
    auto rowfn = [&](int r) -> const void* { return p.H + (size_t)(m0 + r) * 1024; };
    auto epi = [&](f32x4(&acc)[4][4], int rbase, int cbase) {
      EPI_LOOP({
        size_t o = (size_t)(m0 + row) * 1024 + n0 + col;
        float4 u = *(const float4*)(p.out + o);
        uint2 pr = *(const uint2*)(p.xb + o);
        *(float4*)(p.out + o) = make_float4(u.x + sigm(v[0]) * blo(pr.x), u.y + sigm(v[1]) * bhi(pr.x),
                                            u.z + sigm(v[2]) * blo(pr.y), u.w + sigm(v[3]) * bhi(pr.y));
      })
    };
    gemm_tile<false>(rowfn, p.wg_t + ((size_t)l * 1024 + n0) * 1024, 1024, epi, lds, tid);
  }
}

#define XB_TMO      128
#define XB_XCNT(j)  (256  + 64 * (j))
#define XB_XSUB(j)  (1280 + 64 * (j))
#define XB_XGEN(j)  (2304 + 64 * (j))
#define XB_TOP      3328
#define XB_TOPGEN   3392
#define XCD_BAR_WORDS 3456
#define XB_SPIN_CAP (1u << 22)
#define LAS __attribute__((address_space(3)))
DI unsigned xb_ld(unsigned* p) { return __hip_atomic_load(p, __ATOMIC_RELAXED, __HIP_MEMORY_SCOPE_AGENT); }
DI unsigned xb_add(unsigned* p, unsigned v) { return __hip_atomic_fetch_add(p, v, __ATOMIC_RELAXED, __HIP_MEMORY_SCOPE_AGENT); }
DI unsigned xb_xcc_id() { return (unsigned)__builtin_amdgcn_s_getreg((3 << 11) | 20) & 0xFu; }
#define XB_SPIN(cond, bar) do { unsigned _sp = 0; while (cond) { __builtin_amdgcn_s_sleep(1); \
    if ((++_sp & 255u) == 0u) { if (xb_ld(&(bar)[XB_TMO])) break; if (_sp > XB_SPIN_CAP) { atomicAdd(&(bar)[XB_TMO], 1u); break; } } } } while (0)
struct XcdBarrier { unsigned* bar; unsigned x; volatile LAS unsigned* st; };
DI XcdBarrier xcd_barrier_post(unsigned* bar, volatile LAS unsigned* st) {
  XcdBarrier b; b.bar = bar; b.x = xb_xcc_id(); b.st = st;
  if (threadIdx.x == 0) (void)xb_add(&bar[XB_XCNT(b.x)], 1u);
  return b;
}
DI void xcd_barrier_complete(unsigned* bar, unsigned x, unsigned& nloc, unsigned& nx) {
  const unsigned G = gridDim.x * gridDim.y * gridDim.z;
  unsigned sum, cnt, mine, sp = 0u;
  for (;;) {
    sum = 0u; cnt = 0u; mine = 0u;
#pragma unroll
    for (unsigned j = 0; j < 16; ++j) { const unsigned c = xb_ld(&bar[XB_XCNT(j)]); sum += c; cnt += (c > 0u) ? 1u : 0u; mine = (j == x) ? c : mine; }
    if (sum == G) break;
    __builtin_amdgcn_s_sleep(1);
    if ((++sp & 255u) == 0u) { if (xb_ld(&bar[XB_TMO])) break; if (sp > XB_SPIN_CAP) { atomicAdd(&bar[XB_TMO], 1u); break; } }
  }
  nloc = mine > 0u ? mine : 1u; nx = cnt > 0u ? cnt : 1u;
}
DI void xcd_barrier(const XcdBarrier& b) {
  asm volatile("s_waitcnt vmcnt(0)" ::: "memory");
  __syncthreads();
  if (threadIdx.x == 0) {
    unsigned* bar = b.bar;
    __builtin_amdgcn_s_waitcnt(0);
    unsigned nloc = b.st[0], nx = b.st[1];
    if (nloc == 0u) { xcd_barrier_complete(bar, b.x, nloc, nx); b.st[0] = nloc; b.st[1] = nx; }
    const unsigned old = xb_add(&bar[XB_XSUB(b.x)], 1u);
    const unsigned gen = old / nloc;
    if (old + 1u == (gen + 1u) * nloc) {
      __builtin_amdgcn_fence(__ATOMIC_RELEASE, "agent");
      asm volatile("s_waitcnt vmcnt(0)" ::: "memory");
      const unsigned og = xb_add(&bar[XB_TOP], 1u);
      const unsigned tg = og / nx;
      if (og + 1u == (tg + 1u) * nx) xb_add(&bar[XB_TOPGEN], 1u);
      else XB_SPIN(xb_ld(&bar[XB_TOPGEN]) == tg, bar);
      __builtin_amdgcn_fence(__ATOMIC_ACQUIRE, "agent");
      xb_add(&bar[XB_XGEN(b.x)], 1u);
      asm volatile("s_waitcnt vmcnt(0)" ::: "memory");
    } else {
      XB_SPIN(xb_ld(&bar[XB_XGEN(b.x)]) == gen, bar);
      __builtin_amdgcn_fence(__ATOMIC_ACQUIRE, "agent");
      asm volatile("s_waitcnt vmcnt(0)" ::: "memory");
    }
  }
  __syncthreads();
}

__global__ void __launch_bounds__(NTHR, 2) mega(Params p) {
  __shared__ __attribute__((aligned(16))) char lds[73728];
  cg::grid_group grid = cg::this_grid();
  const int tid0 = threadIdx.x, bid0 = blockIdx.x, nb = gridDim.x;
  __shared__ uint4 xb_words;
  if (tid0 == 0) xb_words = make_uint4(0u, 0u, 0u, 0u);
  __syncthreads();
  const XcdBarrier xb = xcd_barrier_post(p.bar, (volatile LAS unsigned*)&xb_words);
  int pc = 0;
#define PHASE(...)                                      \
  {                                                     \
    if (pc >= p.pb && pc < p.pe) {                      \
      if (pc == p.pb + 1) grid.sync();                  \
      else if (pc > p.pb + 1) xcd_barrier(xb);          \
      int tid = tid0, bid = bid0;                       \
      asm volatile("" : "+v"(tid), "+s"(bid));          \
      __VA_ARGS__;                                      \
    }                                                   \
    pc++;                                               \
  }
  PHASE(phase_convert(p, lds, bid, nb, tid));
  for (int i = 0; i < REP_SYNC; i++) PHASE((void)0);
  for (int l = 0; l < 2; l++) {
    for (int sg = 0; sg < 3; sg++) {
      const int tok0 = sg * T_SUB;
      const int B = sg == 0 ? 4 : 8, N = sg == 0 ? 8192 : 4096;
      PHASE(phase_inproj(p, l, tok0, lds, bid, nb, tid));
#if REP_INPROJ || REP_GEMMS
      PHASE(phase_inproj(p, l, tok0, lds, bid, nb, tid));
#endif
      PHASE(phase_prep(p, l, N, bid, nb, tid));
      PHASE(phase_smallgemm(p, l, B, N, lds, bid, nb, tid));
#if REP_GEMMS
      PHASE(phase_smallgemm(p, l, B, N, lds, bid, nb, tid));
#endif
      PHASE(phase_mix(p, l, B, N, p.bar + XCD_BAR_WORDS + (l * 3 + sg) * 128, lds, bid, nb, tid));
#if REP_MIX
      PHASE(phase_mix(p, l, B, N, p.bar + XCD_BAR_WORDS + (6 + l * 3 + sg) * 128, lds, bid, nb, tid));
#endif
      PHASE(phase_final(p, l, bid, nb, tid));
      PHASE(phase_wout(p, l, tok0, lds, bid, nb, tid));
      PHASE(phase_ln<true>(p, p.ln1_g + l * 1024, p.ln1_b + l * 1024, p.moe_router + (size_t)l * 16384, tok0, T_SUB, lds, bid, nb, tid));
    }
    PHASE(phase_topk(p, lds, bid, nb, tid));
    PHASE(phase_moe1(p, l, lds, bid, nb, tid));
#if REP_MOE1 || REP_GEMMS
    PHASE(phase_moe1(p, l, lds, bid, nb, tid));
#endif
    PHASE(phase_moe2(p, l, lds, bid, nb, tid));
#if REP_GEMMS
    PHASE(phase_moe2(p, l, lds, bid, nb, tid));
#endif
    PHASE(phase_combine(p, bid, nb, tid));
    PHASE(phase_ple(p, l, lds, bid, nb, tid));
    PHASE(phase_ln<false>(p, p.ln2_g + l * 1024, p.ln2_b + l * 1024, nullptr, 0, T_ALL, lds, bid, nb, tid));
  }
}

#define N_PHASES 1000
#ifndef FUSED
#define FUSED 1
#endif

extern "C" void kernel_launch(void* const* d_in, const int* in_sizes, int n_in, void* d_out, int out_size, void* d_ws,
                              size_t ws_size, hipStream_t stream) {
  static int grid_blocks = 0;
  if (!grid_blocks) {
    int dev = 0, cus = 0, per_cu = 0;
    (void)hipGetDevice(&dev);
    (void)hipDeviceGetAttribute(&cus, hipDeviceAttributeMultiprocessorCount, dev);
    (void)hipOccupancyMaxActiveBlocksPerMultiprocessor(&per_cu, mega, NTHR, 0);
    if (per_cu > 2) per_cu = 2;
    if (per_cu < 1) per_cu = 1;
    grid_blocks = cus * per_cu;
  }
  Params p;
  memset(&p, 0, sizeof(p));
  const float* const* in = (const float* const*)d_in;
  int k = 0;
  p.x_prompt = in[k++]; p.x_sample = in[k++]; p.p_prompt = in[k++]; p.p_sample = in[k++];
  p.w_in = in[k++]; p.mla_gq = in[k++]; p.mla_gkv = in[k++]; p.mla_wuq = in[k++]; p.mla_wuk = in[k++]; p.mla_wuv = in[k++];
  p.na_bias = in[k++]; p.hg_lb = in[k++]; p.hg_gnorm = in[k++];
  p.rw_mu = in[k++]; p.rw_w0 = in[k++]; p.rw_w_up = in[k++]; p.rw_a0 = in[k++]; p.rw_a_up = in[k++]; p.rw_g_up = in[k++];
  p.rw_kk = in[k++]; p.rw_ka = in[k++]; p.rw_rk = in[k++]; p.rw_ln_w = in[k++]; p.rw_ln_b = in[k++];
  p.w_out = in[k++]; p.ln1_g = in[k++]; p.ln1_b = in[k++]; p.moe_router = in[k++]; p.moe_w1 = in[k++]; p.moe_w3 = in[k++];
  p.moe_w2 = in[k++]; p.ln2_g = in[k++]; p.ln2_b = in[k++]; p.ple_gate = in[k++]; p.ple_proj = in[k++];
  p.out = (float*)d_out;
  char* ws = (char*)d_ws;
  size_t off = 0;
  auto take = [&](size_t bytes) { char* r = ws + off; off += (bytes + 255) & ~(size_t)255; return r; };
  p.w_in_t = (u16*)take((size_t)2 * 3712 * 1024 * 2);
  p.wuq_t = (u16*)take((size_t)2 * 384 * 256 * 2);
  p.wkv_t = (u16*)take((size_t)2 * 512 * 128 * 2);
  p.wup_t = (u16*)take((size_t)4 * 256 * 64 * 2);
  p.aup_t = (u16*)take((size_t)4 * 256 * 64 * 2);
  p.gup_t = (u16*)take((size_t)2 * 256 * 128 * 2);
  p.wout_t = (u16*)take((size_t)2 * 1024 * 1024 * 2);
  p.w13_t = (u16*)take((size_t)32 * 1024 * 1024 * 2);
  p.w2_t = (u16*)take((size_t)32 * 1024 * 512 * 2);
  p.wg_t = (u16*)take((size_t)2 * 1024 * 1024 * 2);
  p.wp_t = (u16*)take((size_t)2 * 1024 * 256 * 2);
  p.ropec = (float*)take((size_t)8192 * 16 * 4);
  p.ropes = (float*)take((size_t)8192 * 16 * 4);
  p.lb = (float*)take(1024 * 4);
  p.affT = (float*)take((size_t)16 * T_ALL * 4);
  p.gate = (float*)take((size_t)196608 * 4);
  p.idx = (int*)take((size_t)196608 * 4);
  p.bar = (unsigned*)take((size_t)(XCD_BAR_WORDS + 12 * 128) * 4);
  p.inv_cnt = (int*)take((size_t)T_ALL * 4);
  p.inv_slot = (int*)take((size_t)T_ALL * 16 * 4);
  p.xb = (u16*)take((size_t)T_ALL * 1024 * 2);
  const size_t stage0 = off;
  p.z = (u16*)take((size_t)T_SUB * ZLD * 2);
  p.cat = (u16*)take((size_t)T_SUB * 1024 * 2);
  p.Q = (u16*)take((size_t)T_SUB * 384 * 2);
  p.Kb = (u16*)take((size_t)T_SUB * 384 * 2);
  p.Vt = (u16*)take((size_t)T_SUB * 256 * 2);
  p.cqn = (u16*)take((size_t)T_SUB * 256 * 2);
  p.ckvn = (u16*)take((size_t)T_SUB * 128 * 2);
  p.S1 = (u16*)take((size_t)T_SUB * 384 * 2);
  p.rs = (u16*)take((size_t)T_SUB * 256 * 2);
  p.ks = (u16*)take((size_t)T_SUB * 256 * 2);
  p.vs = (u16*)take((size_t)T_SUB * 256 * 2);
  p.kk = (u16*)take((size_t)T_SUB * 256 * 2);
  p.gD = (u16*)take((size_t)T_SUB * 256 * 2);
  p.dec = (u16*)take((size_t)2 * T_SUB * 256 * 2);
  p.kka = (u16*)take((size_t)2 * T_SUB * 256 * 2);
  p.kt = (u16*)take((size_t)2 * T_SUB * 256 * 2);
  p.oC = (u16*)take((size_t)2 * T_SUB * 256 * 2);
  p.oD = (u16*)take((size_t)2 * T_SUB * 256 * 2);
  p.bonus = (float*)take((size_t)T_SUB * 4 * 4);
  off = stage0;
  p.O = (u16*)take((size_t)196608 * 1024 * 2);
  p.H = (u16*)take((size_t)196608 * 512 * 2);
  for (int i = 0; i < 16; i++) p.inv_freq[i] = pow(10000.0, -(double)i / 16.0);
  (void)hipMemsetAsync(p.bar, 0, (size_t)(XCD_BAR_WORDS + 12 * 128) * 4, stream);
#if FUSED
  p.pb = 0;
  p.pe = N_PHASES;
  {
    void* args[] = {&p};
    hipError_t e = hipLaunchCooperativeKernel((void*)mega, dim3(grid_blocks), dim3(NTHR), args, 0, stream);
    if (e != hipSuccess) fprintf(stderr, "cooperative launch failed: %s (grid %d)\n", hipGetErrorString(e), grid_blocks);
  }
#else
  for (int ph = 0; ph < N_PHASES; ph++) {
    p.pb = ph;
    p.pe = ph + 1;
    void* args[] = {&p};
    hipError_t e = hipLaunchCooperativeKernel((void*)mega, dim3(grid_blocks), dim3(NTHR), args, 0, stream);
    if (e != hipSuccess) fprintf(stderr, "cooperative launch failed: %s (grid %d)\n", hipGetErrorString(e), grid_blocks);
  }
#endif
}
```

```cpp
#include <hip/hip_runtime.h>
#include <hip/hip_cooperative_groups.h>
#include <cstdio>
#include <cmath>
#include <cstring>
namespace cg = cooperative_groups;

typedef unsigned short u16;
using bf16x8 = __attribute__((ext_vector_type(8))) short;
using f32x4 = __attribute__((ext_vector_type(4))) float;
using f32x16 = __attribute__((ext_vector_type(16))) float;

#define REP_INPROJ 0
#define REP_ATTN 0
#define REP_NA 0
#define REP_SCAN 0
#define REP_MOE1 0
#define REP_MOE2 0
#define REP_SYNC 0
#define REP_MIX 0
#define REP_GEMMS 0
#define DI __device__ __forceinline__
#define NTHR 256
#define T_ALL 98304
#define T_SUB 32768
#define ZLD 3616
#define ZB_OFF 416
#define ZC_OFF 1184
#define ZD_OFF 2464
#define LOG2E 1.4426950408889634f
#define ALPHA_F 1.4142135623730951f

struct Params {
  const float *x_prompt, *x_sample, *p_prompt, *p_sample;
  const float *w_in, *mla_gq, *mla_gkv, *mla_wuq, *mla_wuk, *mla_wuv, *na_bias, *hg_lb, *hg_gnorm;
  const float *rw_mu, *rw_w0, *rw_w_up, *rw_a0, *rw_a_up, *rw_g_up, *rw_kk, *rw_ka, *rw_rk, *rw_ln_w, *rw_ln_b;
  const float *w_out, *ln1_g, *ln1_b, *moe_router, *moe_w1, *moe_w3, *moe_w2, *ln2_g, *ln2_b, *ple_gate, *ple_proj;
  float* out;
  u16 *w_in_t, *wuq_t, *wkv_t, *wup_t, *aup_t, *gup_t, *wout_t, *w13_t, *w2_t, *wg_t, *wp_t;
  float *ropec, *ropes, *lb, *affT, *gate;
  int* idx;
  unsigned* bar;
  int *inv_cnt, *inv_slot;
  u16 *z, *cat, *Q, *Kb, *Vt, *cqn, *ckvn, *S1, *rs, *ks, *vs, *kk, *gD, *dec, *kka, *kt, *oC, *oD;
  float* bonus;
  u16* xb;
  u16* O;
  u16* H;
  double inv_freq[16];
  int pb, pe;
};

typedef __bf16 v2bf_t __attribute__((ext_vector_type(2)));
typedef float v2f_t __attribute__((ext_vector_type(2)));
typedef unsigned u32x4_t __attribute__((ext_vector_type(4)));
DI unsigned pack2(float a, float b) {
  v2f_t f = {a, b};
  v2bf_t h = __builtin_convertvector(f, v2bf_t);
  return __builtin_bit_cast(unsigned, h);
}
DI u16 f2bf(float f) { return (u16)(pack2(f, 0.f) & 0xffffu); }
DI float bf2f(u16 h) { return __uint_as_float(((unsigned)h) << 16); }
DI float blo(unsigned u) { return __uint_as_float(u << 16); }
DI float bhi(unsigned u) { return __uint_as_float(u & 0xffff0000u); }
DI float sigm(float x) { return 1.f / (1.f + __expf(-x)); }
DI float tanh_(float x) { return 1.f - 2.f / (__expf(2.f * x) + 1.f); }
DI float ex2(float x) { return __builtin_amdgcn_exp2f(x); }
DI int clampi(int v, int lo, int hi) { return v < lo ? lo : (v > hi ? hi : v); }
DI int swap23(int x) { return (x & ~12) | ((x & 4) << 1) | ((x & 8) >> 1); }

template <int CTRL> DI float dpp_f(float v) {
  return __int_as_float(__builtin_amdgcn_update_dpp(0, __float_as_int(v), CTRL, 0xF, 0xF, true));
}
DI float reduce16(float v) {
  v += dpp_f<0xB1>(v);
  v += dpp_f<0x4E>(v);
  v += dpp_f<0x141>(v);
  v += dpp_f<0x140>(v);
  return v;
}
DI float wave_sum(float v) {
  v = reduce16(v);
  v += __shfl_xor(v, 16);
  v += __shfl_xor(v, 32);
  return v;
}

struct TileIter {
  int bid, nb, off;
  DI int first(int n) { int f = bid - off; if (f < 0) f += nb; off = (off + n) % nb; return f; }
};

DI bool xcd_tile(int it, int bid, int nb, int MT, int NT, int& mt, int& nt) {
  const int x = bid & 7, slot = bid >> 3, nslots = nb >> 3;
  const int mper = MT >> 3;
  const int i = slot + it * nslots;
  if (i >= mper * NT) return false;
  const int mi = i & 7, rest = i >> 3;
  nt = rest % NT;
  mt = x * mper + (rest / NT) * 8 + mi;
  return true;
}

DI void convT_job(const float* __restrict__ W, int K, int N, int Npad, u16* __restrict__ Wt, int mode, char* lds,
                  TileIter& it, int tid) {
  float(*tile)[65] = (float(*)[65])lds;
  int tk = K >> 6, tn = Npad >> 6;
  int nt = tk * tn;
  for (int t = it.first(nt); t < nt; t += it.nb) {
    int k0 = (t % tk) << 6, n0 = (t / tk) << 6;
#pragma unroll
    for (int i = 0; i < 16; i++) {
      int kl = (tid >> 6) + 4 * i, nl = tid & 63;
      int n = n0 + nl;
      tile[kl][nl] = (n < N) ? W[(size_t)(k0 + kl) * N + n] : 0.f;
    }
    __syncthreads();
    {
      int nl = tid >> 2, ks = (tid & 3) * 16;
      int n = n0 + nl;
      int row = n;
      if (mode == 1) row = (n >> 4) * 32 + (n & 15);
      if (mode == 2) row = (n >> 4) * 32 + 16 + (n & 15);
      unsigned pk[8];
#pragma unroll
      for (int j = 0; j < 8; j++) pk[j] = pack2(tile[ks + 2 * j][nl], tile[ks + 2 * j + 1][nl]);
      uint4* dst = (uint4*)(Wt + (size_t)row * K + k0 + ks);
      dst[0] = make_uint4(pk[0], pk[1], pk[2], pk[3]);
      dst[1] = make_uint4(pk[4], pk[5], pk[6], pk[7]);
    }
    __syncthreads();
  }
}

DI void phase_convert(const Params& p, char* lds, int bid, int nb, int tid) {
  TileIter it{bid, nb, 0};
  for (int l = 0; l < 2; l++) {
    convT_job(p.w_in + (size_t)l * 1024 * 3616, 1024, 3616, 3712, p.w_in_t + (size_t)l * 3712 * 1024, 0, lds, it, tid);
    convT_job(p.mla_wuq + (size_t)l * 256 * 384, 256, 384, 384, p.wuq_t + (size_t)l * 384 * 256, 0, lds, it, tid);
    convT_job(p.mla_wuk + (size_t)l * 128 * 256, 128, 256, 256, p.wkv_t + (size_t)l * 512 * 128, 0, lds, it, tid);
    convT_job(p.mla_wuv + (size_t)l * 128 * 256, 128, 256, 256, p.wkv_t + (size_t)l * 512 * 128 + 256 * 128, 0, lds, it, tid);
    for (int d = 0; d < 2; d++) {
      convT_job(p.rw_w_up + (size_t)(l * 2 + d) * 64 * 256, 64, 256, 256, p.wup_t + (size_t)(l * 2 + d) * 256 * 64, 0, lds, it, tid);
      convT_job(p.rw_a_up + (size_t)(l * 2 + d) * 64 * 256, 64, 256, 256, p.aup_t + (size_t)(l * 2 + d) * 256 * 64, 0, lds, it, tid);
    }
    convT_job(p.rw_g_up + (size_t)l * 128 * 256, 128, 256, 256, p.gup_t + (size_t)l * 256 * 128, 0, lds, it, tid);
    convT_job(p.w_out + (size_t)l * 1024 * 1024, 1024, 1024, 1024, p.wout_t + (size_t)l * 1024 * 1024, 0, lds, it, tid);
    for (int e = 0; e < 16; e++) {
      size_t le = (size_t)(l * 16 + e);
      convT_job(p.moe_w1 + le * 1024 * 512, 1024, 512, 512, p.w13_t + le * 1024 * 1024, 1, lds, it, tid);
      convT_job(p.moe_w3 + le * 1024 * 512, 1024, 512, 512, p.w13_t + le * 1024 * 1024, 2, lds, it, tid);
      convT_job(p.moe_w2 + le * 512 * 1024, 512, 1024, 1024, p.w2_t + le * 1024 * 512, 0, lds, it, tid);
    }
    convT_job(p.ple_gate + (size_t)l * 1024 * 1024, 1024, 1024, 1024, p.wg_t + (size_t)l * 1024 * 1024, 0, lds, it, tid);
    convT_job(p.ple_proj + (size_t)l * 256 * 1024, 256, 1024, 1024, p.wp_t + (size_t)l * 1024 * 256, 0, lds, it, tid);
  }
  int gt = bid * NTHR + tid, ng = nb * NTHR;
  for (size_t i0 = gt; i0 < (size_t)T_ALL * 256; i0 += (size_t)ng * 8) {
    float4 v[8];
#pragma unroll
    for (int u = 0; u < 8; u++) {
      const size_t i = i0 + (size_t)u * ng;
      v[u] = make_float4(0.f, 0.f, 0.f, 0.f);
      if (i < (size_t)T_ALL * 256)
        v[u] = (i < (size_t)32768 * 256) ? ((const float4*)p.x_prompt)[i] : ((const float4*)p.x_sample)[i - (size_t)32768 * 256];
    }
#pragma unroll
    for (int u = 0; u < 8; u++) {
      const size_t i = i0 + (size_t)u * ng;
      if (i < (size_t)T_ALL * 256) ((uint2*)p.xb)[i] = make_uint2(pack2(v[u].x, v[u].y), pack2(v[u].z, v[u].w));
    }
  }
  for (int i = gt; i < 8192 * 16; i += ng) {
    int n = i >> 4, f = i & 15;
    double ifq = 0.0;
#pragma unroll
    for (int j = 0; j < 16; j++) ifq = (f == j) ? p.inv_freq[j] : ifq;
    double rev = (double)n * ifq * 0.15915494309189535;
    double fr = rev - rint(rev);
    float ff = (float)fr;
    p.ropec[i] = __builtin_amdgcn_cosf(ff);
    p.ropes[i] = __builtin_amdgcn_sinf(ff);
  }
  for (int i = gt; i < 512; i += ng) {
    float h0 = p.hg_lb[i], h1 = p.hg_lb[512 + i];
    p.lb[i] = 0.f;
    p.lb[512 + i] = 1.f / (1.f + __expf(h0 - h1));
  }
}

constexpr int G_STAGE = 32768;

template <bool AF32, class RowFn, class Epi>
DI void gemm_tile(RowFn rowfn, const u16* __restrict__ Bt, int K, Epi epi, char* lds, int tid) {
  const int lane = tid & 63, wid = tid >> 6, wr = wid >> 1, wc = wid & 1, fr = lane & 15, fq = lane >> 4;
  f32x4 acc[4][4];
#pragma unroll
  for (int m = 0; m < 4; m++)
#pragma unroll
    for (int n = 0; n < 4; n++) acc[m][n] = f32x4{0.f, 0.f, 0.f, 0.f};

  const int lrow = tid >> 3;
  const int lc = (tid & 7) ^ ((tid >> 4) & 7);
  const float* apf[8];
  const u16* aph[4];
  const u16* bp[4];
  if constexpr (AF32) {
#pragma unroll
    for (int i = 0; i < 8; i++) apf[i] = (const float*)rowfn(i * 16 + (tid >> 4)) + (tid & 15) * 4;
  } else {
#pragma unroll
    for (int i = 0; i < 4; i++) aph[i] = (const u16*)rowfn(lrow + i * 32) + lc * 8;
  }
#pragma unroll
  for (int i = 0; i < 4; i++) bp[i] = Bt + (size_t)(lrow + i * 32) * K + lc * 8;
  const int afoff = (tid >> 4) * 128 + ((((tid & 15) >> 1) ^ ((tid >> 5) & 7)) * 16) + (tid & 1) * 8;

  float4 raf[8];
  auto issue = [&](int buf, int k0) {
    char* A = lds + buf * G_STAGE;
    char* B = A + 16384;
#pragma unroll
    for (int i = 0; i < 4; i++)
      __builtin_amdgcn_global_load_lds((const unsigned*)(bp[i] + k0), (unsigned*)(B + wid * 1024 + i * 4096), 16, 0, 0);
    if constexpr (AF32) {
#pragma unroll
      for (int i = 0; i < 8; i++) raf[i] = *(const float4*)(apf[i] + k0);
    } else {
#pragma unroll
      for (int i = 0; i < 4; i++)
        __builtin_amdgcn_global_load_lds((const unsigned*)(aph[i] + k0), (unsigned*)(A + wid * 1024 + i * 4096), 16, 0, 0);
    }
  };
  auto astore = [&](int buf) {
    if constexpr (AF32) {
      char* A = lds + buf * G_STAGE;
#pragma unroll
      for (int i = 0; i < 8; i++) asm volatile("" : "+v"(raf[i].x), "+v"(raf[i].y), "+v"(raf[i].z), "+v"(raf[i].w));
#pragma unroll
      for (int i = 0; i < 8; i++)
        *(uint2*)(A + afoff + i * 2048) = make_uint2(pack2(raf[i].x, raf[i].y), pack2(raf[i].z, raf[i].w));
    }
  };
  const int abase = (wr * 64 + fr) * 128, bbase = 16384 + (wc * 64 + fr) * 128;
  const int sw0 = ((fq) ^ (fr >> 1)) * 16, sw1 = ((4 + fq) ^ (fr >> 1)) * 16;

  const int nk = K >> 6;
  issue(0, 0);
  astore(0);
  __syncthreads();
  for (int kt = 0; kt < nk; kt++) {
    if (kt + 1 < nk) issue((kt + 1) & 1, (kt + 1) << 6);
    __builtin_amdgcn_sched_barrier(0);
    const char* S = lds + (kt & 1) * G_STAGE;
    bf16x8 af[2][4], bfr[2][4];
#pragma unroll
    for (int kk = 0; kk < 2; kk++) {
      const int sw = kk ? sw1 : sw0;
#pragma unroll
      for (int m = 0; m < 4; m++) af[kk][m] = *(const bf16x8*)(S + abase + m * 2048 + sw);
#pragma unroll
      for (int n = 0; n < 4; n++) bfr[kk][n] = *(const bf16x8*)(S + bbase + n * 2048 + sw);
    }
    __builtin_amdgcn_sched_barrier(0);
#pragma unroll
    for (int kk = 0; kk < 2; kk++)
#pragma unroll
      for (int m = 0; m < 4; m++)
#pragma unroll
        for (int n = 0; n < 4; n++) acc[m][n] = __builtin_amdgcn_mfma_f32_16x16x32_bf16(bfr[kk][n], af[kk][m], acc[m][n], 0, 0, 0);
    __builtin_amdgcn_sched_barrier(0);
    if (kt + 1 < nk) astore((kt + 1) & 1);
    __syncthreads();
  }
  epi(acc, wr * 64 + fr, wc * 64 + fq * 4);
}

#define EPI_LOOP(...)                                    \
  _Pragma("unroll") for (int m = 0; m < 4; m++)          \
  _Pragma("unroll") for (int n = 0; n < 4; n++) {        \
    const int row = rbase + m * 16;                      \
    const int col = cbase + n * 16;                      \
    const f32x4 v = acc[m][n];                           \
    __VA_ARGS__                                          \
  }

DI void st_bf4(u16* dst, f32x4 v) { *(uint2*)dst = make_uint2(pack2(v[0], v[1]), pack2(v[2], v[3])); }

DI const float* xin_row(const Params& p, int l, int tg) {
  if (l == 0) return tg < 32768 ? p.x_prompt + (size_t)tg * 1024 : p.x_sample + (size_t)(tg - 32768) * 1024;
  return p.out + (size_t)tg * 1024;
}

DI void phase_inproj(const Params& p, int l, int tok0, char* lds, int bid, int nb, int tid) {
  const int NT = 29, MT = T_SUB / 128;
  for (int it = 0;; it++) {
    int nt, mt;
    if (!xcd_tile(it, bid, nb, MT, NT, mt, nt)) break;
    int m0 = mt * 128, n0 = nt * 128;
    auto rowfn = [&](int r) -> const void* { return p.xb + (size_t)(tok0 + m0 + r) * 1024; };
    u16* z = p.z;
    auto epi = [&](f32x4(&acc)[4][4], int rbase, int cbase) {
      EPI_LOOP({
        int c = n0 + col;
        if (c < ZLD) st_bf4(z + (size_t)(m0 + row) * ZLD + c, v);
      })
    };
    gemm_tile<false>(rowfn, p.w_in_t + ((size_t)l * 3712 + n0) * 1024, 1024, epi, lds, tid);
  }
}

struct PrepIn {
  uint2 cq;
  unsigned ckv;
  u16 kr1, kr2;
  float rc, rsn;
  uint4 f;
  uint2 cur[3], prv[3], nxt[3];
  u16 sc[6], sp[6], sn[6];
};
DI void prep_load(PrepIn& in, const Params& p, int t, int N, int lane) {
  const int l15 = lane & 15, c4 = lane * 4;
  const u16* zr = p.z + (size_t)t * ZLD;
  const int n = t & (N - 1);
  const bool hp = n > 0, hn = n < N - 1;
  const u16* zd = zr + ZD_OFF;
  const u16* zdp = zd - (hp ? ZLD : 0);
  const u16* zdn = zd + (hn ? ZLD : 0);
  in.cq = *(const uint2*)(zr + c4);
  in.ckv = *(const unsigned*)(zr + 256 + lane * 2);
  in.kr1 = zr[384 + l15];
  in.kr2 = zr[400 + l15];
  in.rc = p.ropec[n * 16 + l15];
  in.rsn = p.ropes[n * 16 + l15];
  in.f = *(const uint4*)(zr + ZC_OFF + 256 + lane * 8);
#pragma unroll
  for (int part = 0; part < 3; part++) {
    in.cur[part] = *(const uint2*)(zd + part * 256 + c4);
    in.prv[part] = *(const uint2*)(zdp + part * 256 + c4);
    in.nxt[part] = *(const uint2*)(zdn + part * 256 + c4);
  }
#pragma unroll
  for (int i = 0; i < 6; i++) {
    in.sc[i] = zd[768 + lane + 64 * i];
    in.sp[i] = zdp[768 + lane + 64 * i];
    in.sn[i] = zdn[768 + lane + 64 * i];
  }
}

DI void phase_prep(const Params& p, int l, int N, int bid, int nb, int tid) {
  const int lane = tid & 63, wv = tid >> 6, l15 = lane & 15, c4 = lane * 4;
  float gqv[4], gkvv[2], lbv[8], m0[12], m1[12], m0s[6], m1s[6], kkc[4], rkc[4];
  {
    const float* mu0 = p.rw_mu + (size_t)l * 2 * 1152;
    const float* mu1 = mu0 + 1152;
#pragma unroll
    for (int j = 0; j < 4; j++) {
      gqv[j] = p.mla_gq[l * 256 + c4 + j];
      kkc[j] = p.rw_kk[l * 256 + c4 + j];
      rkc[j] = p.rw_rk[l * 256 + c4 + j];
    }
    gkvv[0] = p.mla_gkv[l * 128 + lane * 2];
    gkvv[1] = p.mla_gkv[l * 128 + lane * 2 + 1];
#pragma unroll
    for (int j = 0; j < 8; j++) lbv[j] = p.lb[l * 512 + lane * 8 + j];
#pragma unroll
    for (int part = 0; part < 3; part++)
#pragma unroll
      for (int j = 0; j < 4; j++) {
        m0[part * 4 + j] = mu0[part * 256 + c4 + j];
        m1[part * 4 + j] = mu1[part * 256 + c4 + j];
      }
#pragma unroll
    for (int i = 0; i < 6; i++) {
      m0s[i] = mu0[768 + lane + 64 * i];
      m1s[i] = mu1[768 + lane + 64 * i];
    }
  }
  PrepIn in, inn;
  {
    const int t0 = bid * 4 + wv;
    if (t0 < T_SUB) prep_load(in, p, t0, N, lane);
  }
  for (int t = bid * 4 + wv; t < T_SUB; t += nb * 4) {
    u16* zr = p.z + (size_t)t * ZLD;
    const int n = t & (N - 1);
    const bool hp = n > 0, hn = n < N - 1;
    {
      const int tn = t + nb * 4;
      if (tn < T_SUB) prep_load(inn, p, tn, N, lane);
      else inn = in;
    }
    const uint2 raw_cq = in.cq;
    const unsigned raw_ckv = in.ckv;
    const u16 kr1 = in.kr1, kr2 = in.kr2;
    const float rc = in.rc, rsn = in.rsn;
    uint4* fptr = (uint4*)(zr + ZC_OFF + 256 + lane * 8);
    const uint4 raw_f = in.f;
    uint2 cur[3], prv[3], nxt[3];
    u16 sc[6], sp[6], sn[6];
#pragma unroll
    for (int part = 0; part < 3; part++) { cur[part] = in.cur[part]; prv[part] = in.prv[part]; nxt[part] = in.nxt[part]; }
#pragma unroll
    for (int i = 0; i < 6; i++) { sc[i] = in.sc[i]; sp[i] = in.sp[i]; sn[i] = in.sn[i]; }
    {
      float v0 = blo(raw_cq.x), v1 = bhi(raw_cq.x), v2 = blo(raw_cq.y), v3 = bhi(raw_cq.y);
      float ss = wave_sum(v0 * v0 + v1 * v1 + v2 * v2 + v3 * v3);
      float ri = rsqrtf(ss * (1.f / 256.f) + 1e-6f);
      *(uint2*)(p.cqn + (size_t)t * 256 + c4) =
          make_uint2(pack2(v0 * ri * gqv[0], v1 * ri * gqv[1]), pack2(v2 * ri * gqv[2], v3 * ri * gqv[3]));
    }
    {
      float v0 = blo(raw_ckv), v1 = bhi(raw_ckv);
      float ss = wave_sum(v0 * v0 + v1 * v1);
      float ri = rsqrtf(ss * (1.f / 128.f) + 1e-6f);
      *(unsigned*)(p.ckvn + (size_t)t * 128 + lane * 2) = pack2(v0 * ri * gkvv[0], v1 * ri * gkvv[1]);
    }
    if (lane < 16) {
      float x1 = bf2f(kr1), x2 = bf2f(kr2);
      u16 k1 = f2bf(x1 * rc - x2 * rsn), k2 = f2bf(x1 * rsn + x2 * rc);
      u16* kb = p.Kb + (size_t)t * 384;
#pragma unroll
      for (int h = 0; h < 4; h++) {
        kb[h * 96 + 64 + lane] = k1;
        kb[h * 96 + 80 + lane] = k2;
      }
    }
    {
      unsigned w[4] = {raw_f.x, raw_f.y, raw_f.z, raw_f.w};
#pragma unroll
      for (int j = 0; j < 4; j++) {
        float a = blo(w[j]), bq = bhi(w[j]);
        float la = lbv[2 * j], lb2 = lbv[2 * j + 1];
        a = la + (1.f - la) * sigm(a);
        bq = lb2 + (1.f - lb2) * sigm(bq);
        w[j] = pack2(a, bq);
      }
      *fptr = make_uint4(w[0], w[1], w[2], w[3]);
    }
    {
      float rr[4], kx[4], vx[4];
#pragma unroll
      for (int part = 0; part < 3; part++) {
        float cz[4] = {blo(cur[part].x), bhi(cur[part].x), blo(cur[part].y), bhi(cur[part].y)};
        float pz[4] = {blo(prv[part].x), bhi(prv[part].x), blo(prv[part].y), bhi(prv[part].y)};
        float nz[4] = {blo(nxt[part].x), bhi(nxt[part].x), blo(nxt[part].y), bhi(nxt[part].y)};
#pragma unroll
        for (int j = 0; j < 4; j++) {
          float pzz = hp ? pz[j] : 0.f, nzz = hn ? nz[j] : 0.f;
          float o = cz[j] + m0[part * 4 + j] * (pzz - cz[j]) + m1[part * 4 + j] * (nzz - cz[j]);
          if (part == 0) rr[j] = o;
          if (part == 1) kx[j] = o;
          if (part == 2) vx[j] = o;
        }
      }
      *(uint2*)(p.rs + (size_t)t * 256 + c4) = make_uint2(pack2(rr[0], rr[1]), pack2(rr[2], rr[3]));
      *(uint2*)(p.ks + (size_t)t * 256 + c4) = make_uint2(pack2(kx[0], kx[1]), pack2(kx[2], kx[3]));
      *(uint2*)(p.vs + (size_t)t * 256 + c4) = make_uint2(pack2(vx[0], vx[1]), pack2(vx[2], vx[3]));
      float kq[4], ss = 0.f, bo = 0.f;
#pragma unroll
      for (int j = 0; j < 4; j++) {
        kq[j] = kx[j] * kkc[j];
        ss += kq[j] * kq[j];
        bo += rr[j] * kx[j] * rkc[j];
      }
      ss = reduce16(ss);
      bo = reduce16(bo);
      float inv = 1.f / fmaxf(sqrtf(ss), 1e-12f);
      *(uint2*)(p.kk + (size_t)t * 256 + c4) = make_uint2(pack2(kq[0] * inv, kq[1] * inv), pack2(kq[2] * inv, kq[3] * inv));
      if (l15 == 0) p.bonus[(size_t)t * 4 + (lane >> 4)] = bo;
#pragma unroll
      for (int i = 0; i < 6; i++) {
        float cz = bf2f(sc[i]);
        float pz = hp ? bf2f(sp[i]) : 0.f;
        float nz = hn ? bf2f(sn[i]) : 0.f;
        float o = cz + m0s[i] * (pz - cz) + m1s[i] * (nz - cz);
        if (i < 2) o = tanh_(o);
        else if (i >= 4) o = sigm(o);
        p.S1[(size_t)t * 384 + lane + 64 * i] = f2bf(o);
      }
    }
    in = inn;
  }
}

DI void phase_smallgemm(const Params& p, int l, int B, int N, char* lds, int bid, int nb, int tid) {
  TileIter it{bid, nb, 0};
  const int MT = T_SUB / 128;
  {
    const int NT = 3;
    for (int itx = 0;; itx++) {
      int nt, mt;
      if (!xcd_tile(itx, bid, nb, MT, NT, mt, nt)) break;
      int m0 = mt * 128, n0 = nt * 128;
      auto rowfn = [&](int r) -> const void* { return p.cqn + (size_t)(m0 + r) * 256; };
      u16* Q = p.Q;
      auto epi = [&](f32x4(&acc)[4][4], int rbase, int cbase) {
        const float SC = 0.10206207261596577f * LOG2E;
        EPI_LOOP({ st_bf4(Q + (size_t)(m0 + row) * 384 + n0 + col, v * SC); })
      };
      gemm_tile<false>(rowfn, p.wuq_t + ((size_t)l * 384 + n0) * 256, 256, epi, lds, tid);
    }
  }
  {
    const int NT = 4;
    for (int itx = 0;; itx++) {
      int nt, mt;
      if (!xcd_tile(itx, bid, nb, MT, NT, mt, nt)) break;
      int m0 = mt * 128, n0 = nt * 128;
      auto rowfn = [&](int r) -> const void* { return p.ckvn + (size_t)(m0 + r) * 128; };
      u16* Kb = p.Kb;
      u16* Vt = p.Vt;
      auto epi = [&](f32x4(&acc)[4][4], int rbase, int cbase) {
        EPI_LOOP({
          int c = n0 + col;
          int tk = m0 + row;
          if (c < 256) {
            int h = c >> 6, d = c & 63;
            st_bf4(Kb + (size_t)tk * 384 + h * 96 + d, v);
          } else {
            int cc = c - 256;
            int b = tk / N, nn = tk - b * N;
            u16* dst = Vt + ((size_t)(b * 256 + cc)) * N + nn;
            dst[0] = f2bf(v[0]);
            dst[(size_t)N] = f2bf(v[1]);
            dst[(size_t)2 * N] = f2bf(v[2]);
            dst[(size_t)3 * N] = f2bf(v[3]);
          }
        })
      };
      gemm_tile<false>(rowfn, p.wkv_t + ((size_t)l * 512 + n0) * 128, 128, epi, lds, tid);
    }
  }
  for (int d = 0; d < 2; d++) {
    const int NT = 2;
    for (int itx = 0;; itx++) {
      int nt, mt;
      if (!xcd_tile(itx, bid, nb, MT, NT, mt, nt)) break;
      int m0 = mt * 128, n0 = nt * 128;
      auto rowfn = [&](int r) -> const void* { return p.S1 + (size_t)(m0 + r) * 384 + d * 64; };
      u16* dst = p.dec + (size_t)d * T_SUB * 256;
      const float* w0 = p.rw_w0 + (l * 2 + d) * 256;
      auto epi = [&](f32x4(&acc)[4][4], int rbase, int cbase) {
        EPI_LOOP({
          f32x4 o;
          for (int j = 0; j < 4; j++) o[j] = __expf(-0.6065306597126334f * sigm(w0[n0 + col + j] + v[j]));
          st_bf4(dst + (size_t)(m0 + row) * 256 + n0 + col, o);
        })
      };
      gemm_tile<false>(rowfn, p.wup_t + ((size_t)(l * 2 + d) * 256 + n0) * 64, 64, epi, lds, tid);
    }
  }
  for (int d = 0; d < 2; d++) {
    const int NT = 2;
    for (int itx = 0;; itx++) {
      int nt, mt;
      if (!xcd_tile(itx, bid, nb, MT, NT, mt, nt)) break;
      int m0 = mt * 128, n0 = nt * 128;
      auto rowfn = [&](int r) -> const void* { return p.S1 + (size_t)(m0 + r) * 384 + 128 + d * 64; };
      u16* dka = p.kka + (size_t)d * T_SUB * 256;
      u16* dkt = p.kt + (size_t)d * T_SUB * 256;
      const float* a0 = p.rw_a0 + (l * 2 + d) * 256;
      const float* ka = p.rw_ka + l * 256;
      const u16* kkp = p.kk;
      const u16* ksp = p.ks;
      auto epi = [&](f32x4(&acc)[4][4], int rbase, int cbase) {
        EPI_LOOP({
          size_t o = (size_t)(m0 + row) * 256 + n0 + col;
          uint2 kkr = *(const uint2*)(kkp + o);
          uint2 ksr = *(const uint2*)(ksp + o);
          float kkv[4] = {blo(kkr.x), bhi(kkr.x), blo(kkr.y), bhi(kkr.y)};
          float ksv[4] = {blo(ksr.x), bhi(ksr.x), blo(ksr.y), bhi(ksr.y)};
          f32x4 o1, o2;
          for (int j = 0; j < 4; j++) {
            float a = sigm(a0[n0 + col + j] + v[j]);
            o1[j] = kkv[j] * a;
            o2[j] = ksv[j] * (1.f + (a - 1.f) * ka[n0 + col + j]);
          }
          st_bf4(dka + o, o1);
          st_bf4(dkt + o, o2);
        })
      };
      gemm_tile<false>(rowfn, p.aup_t + ((size_t)(l * 2 + d) * 256 + n0) * 64, 64, epi, lds, tid);
    }
  }
  {
    const int NT = 2;
    for (int itx = 0;; itx++) {
      int nt, mt;
      if (!xcd_tile(itx, bid, nb, MT, NT, mt, nt)) break;
      int m0 = mt * 128, n0 = nt * 128;
      auto rowfn = [&](int r) -> const void* { return p.S1 + (size_t)(m0 + r) * 384 + 256; };
      u16* dst = p.gD;
      auto epi = [&](f32x4(&acc)[4][4], int rbase, int cbase) {
        EPI_LOOP({ st_bf4(dst + (size_t)(m0 + row) * 256 + n0 + col, v); })
      };
      gemm_tile<false>(rowfn, p.gup_t + ((size_t)l * 256 + n0) * 128, 128, epi, lds, tid);
    }
  }
}

DI bf16x8 pack8(const f32x16& s, int o) {
  u32x4_t r = {pack2(s[o], s[o + 1]), pack2(s[o + 2], s[o + 3]), pack2(s[o + 4], s[o + 5]), pack2(s[o + 6], s[o + 7])};
  return __builtin_bit_cast(bf16x8, r);
}

constexpr int AT_KP = 208, AT_VP = 144, AT_BUF = 64 * AT_KP + 64 * AT_VP;
DI void attn_task(const Params& p, int task, int N, char* lds, int tid) {
  const int lane = tid & 63, wv = tid >> 6, r = lane & 31, hf = lane >> 5;
  const int nqb = N >> 7;
  {
    const int qb = task % nqb, bh = task / nqb, h = bh & 3, b = bh >> 2;
    const size_t tb = (size_t)b * N;
    const int q = qb * 128 + wv * 32 + r;
    bf16x8 qf[6];
    {
      const u16* qrow = p.Q + (tb + q) * 384 + h * 96;
#pragma unroll
      for (int ks = 0; ks < 4; ks++) qf[ks] = *(const bf16x8*)(qrow + ks * 16 + hf * 8);
      bf16x8 x1r = *(const bf16x8*)(qrow + 64 + hf * 8);
      bf16x8 x2r = *(const bf16x8*)(qrow + 80 + hf * 8);
      const float* cp = p.ropec + q * 16 + hf * 8;
      const float* sp = p.ropes + q * 16 + hf * 8;
      float ra[8], rb[8];
#pragma unroll
      for (int j = 0; j < 8; j++) {
        float xa = bf2f((u16)x1r[j]), ya = bf2f((u16)x2r[j]);
        float c0 = cp[j], s0 = sp[j];
        ra[j] = xa * c0 - ya * s0;
        rb[j] = xa * s0 + ya * c0;
      }
      u32x4_t o1 = {pack2(ra[0], ra[1]), pack2(ra[2], ra[3]), pack2(ra[4], ra[5]), pack2(ra[6], ra[7])};
      u32x4_t o2 = {pack2(rb[0], rb[1]), pack2(rb[2], rb[3]), pack2(rb[4], rb[5]), pack2(rb[6], rb[7])};
      qf[4] = __builtin_bit_cast(bf16x8, o1);
      qf[5] = __builtin_bit_cast(bf16x8, o2);
    }
    const u16* Kg = p.Kb + tb * 384 + h * 96;
    const u16* Vg = p.Vt + ((size_t)(b * 4 + h) * 64) * N;
    uint4 kr0, kr1, kr2, vr0, vr1;
    const int lkey = tid >> 2, lpart = tid & 3;
    const int lrow = swap23(lkey);
#define AT_GLOAD(kt_)                                                              \
  {                                                                                \
    const u16* kp_ = Kg + (size_t)((kt_) * 64 + lkey) * 384 + lpart * 24;          \
    kr0 = *(const uint4*)(kp_);                                                    \
    kr1 = *(const uint4*)(kp_ + 8);                                                \
    kr2 = *(const uint4*)(kp_ + 16);                                               \
    const u16* vp_ = Vg + (size_t)lkey * N + (kt_) * 64 + lpart * 16;              \
    vr0 = *(const uint4*)(vp_);                                                    \
    vr1 = *(const uint4*)(vp_ + 8);                                                \
  }
#define AT_LSTORE(buf_)                                                            \
  {                                                                                \
    char* Kl_ = lds + (buf_) * AT_BUF;                                             \
    char* Vl_ = Kl_ + 64 * AT_KP;                                                  \
    *(uint4*)(Kl_ + lrow * AT_KP + (lpart * 3 + 0) * 16) = kr0;                    \
    *(uint4*)(Kl_ + lrow * AT_KP + (lpart * 3 + 1) * 16) = kr1;                    \
    *(uint4*)(Kl_ + lrow * AT_KP + (lpart * 3 + 2) * 16) = kr2;                    \
    *(uint4*)(Vl_ + lkey * AT_VP + (lpart * 2 + 0) * 16) = vr0;                    \
    *(uint4*)(Vl_ + lkey * AT_VP + (lpart * 2 + 1) * 16) = vr1;                    \
  }
    f32x16 O0, O1;
#pragma unroll
    for (int i = 0; i < 16; i++) { O0[i] = 0.f; O1[i] = 0.f; }
    float mrun = 0.f, lrun = 0.f;
    const int nt = N >> 6;
    __syncthreads();
    AT_GLOAD(0);
    AT_LSTORE(0);
    __syncthreads();
    for (int kt = 0; kt < nt; kt++) {
      if (kt + 1 < nt) AT_GLOAD(kt + 1);
      __builtin_amdgcn_sched_barrier(0);
      const char* Kl = lds + (kt & 1) * AT_BUF;
      const char* Vl = Kl + 64 * AT_KP;
      f32x16 S0, S1;
      {
        const float nm = -mrun;
#pragma unroll
        for (int i = 0; i < 16; i++) { S0[i] = nm; S1[i] = nm; }
      }
#pragma unroll
      for (int ks = 0; ks < 6; ks++) {
        bf16x8 a0 = *(const bf16x8*)(Kl + r * AT_KP + ks * 32 + hf * 16);
        bf16x8 a1 = *(const bf16x8*)(Kl + (32 + r) * AT_KP + ks * 32 + hf * 16);
        S0 = __builtin_amdgcn_mfma_f32_32x32x16_bf16(a0, qf[ks], S0, 0, 0, 0);
        S1 = __builtin_amdgcn_mfma_f32_32x32x16_bf16(a1, qf[ks], S1, 0, 0, 0);
      }
      float mx = fmaxf(S0[0], S1[0]);
#pragma unroll
      for (int i = 1; i < 16; i++) mx = fmaxf(mx, fmaxf(S0[i], S1[i]));
      if (__any((mx > 12.f) || (kt == 0))) {
        const float mq = fmaxf(mx, __shfl_xor(mx, 32));
        const float shift = (kt == 0) ? mq : ((mq > 12.f) ? mq : 0.f);
        const float sc = (kt == 0) ? 1.f : ex2(-shift);
        mrun += shift;
        lrun *= sc;
#pragma unroll
        for (int i = 0; i < 16; i++) {
          S0[i] -= shift;
          S1[i] -= shift;
          O0[i] *= sc;
          O1[i] *= sc;
        }
      }
      float ls = 0.f;
#pragma unroll
      for (int i = 0; i < 16; i++) {
        S0[i] = ex2(S0[i]);
        S1[i] = ex2(S1[i]);
        ls += S0[i] + S1[i];
      }
      lrun += ls;
#pragma unroll
      for (int sp = 0; sp < 4; sp++) {
        bf16x8 pb = (sp < 2) ? pack8(S0, (sp & 1) * 8) : pack8(S1, (sp & 1) * 8);
        bf16x8 v0 = *(const bf16x8*)(Vl + r * AT_VP + sp * 32 + hf * 16);
        bf16x8 v1 = *(const bf16x8*)(Vl + (32 + r) * AT_VP + sp * 32 + hf * 16);
        O0 = __builtin_amdgcn_mfma_f32_32x32x16_bf16(v0, pb, O0, 0, 0, 0);
        O1 = __builtin_amdgcn_mfma_f32_32x32x16_bf16(v1, pb, O1, 0, 0, 0);
      }
      __builtin_amdgcn_sched_barrier(0);
      if (kt + 1 < nt) AT_LSTORE((kt + 1) & 1);
      __syncthreads();
    }
    float lt = lrun + __shfl_xor(lrun, 32);
    float inv = 1.f / lt;
    u16* orow = p.cat + (tb + q) * 1024 + h * 64;
#pragma unroll
    for (int g = 0; g < 4; g++) {
      int d0 = 8 * g + 4 * hf;
      *(uint2*)(orow + d0) = make_uint2(pack2(O0[4 * g] * inv, O0[4 * g + 1] * inv), pack2(O0[4 * g + 2] * inv, O0[4 * g + 3] * inv));
      *(uint2*)(orow + 32 + d0) = make_uint2(pack2(O1[4 * g] * inv, O1[4 * g + 1] * inv), pack2(O1[4 * g + 2] * inv, O1[4 * g + 3] * inv));
    }
  }
}

DI void na_task(const Params& p, int l, int task, int N, int tid) {
  const int lane = tid & 63, head = tid >> 6, r = lane & 31, hf = lane >> 5;
  const int rows = N >> 6;
  const int nrb = rows >> 1;
  const float* bias = p.na_bias + (size_t)(l * 4 + head) * 15 * 31;
  {
    const int cb = task & 3, rb = (task >> 2) % nrb, b = (task >> 2) / nrb;
    const size_t tb = (size_t)b * N;
    const int qrow0 = rb * 2;
    const int rstart0 = clampi(qrow0 - 4, 0, rows - 8);
    const int k0 = clampi(rstart0, 0, rows - 9);
    const int kstart = clampi(cb * 16 - 8, 0, 32);
    const int iq = r >> 4, u = r & 15;
    const int qrow = qrow0 + iq, qcol = cb * 16 + u;
    const int rstart = clampi(qrow - 4, 0, rows - 8);
    const int cstart = clampi(qcol - 8, 0, 48);
    bf16x8 qf[4];
    {
      const u16* qp = p.z + (tb + qrow * 64 + qcol) * ZLD + ZB_OFF + head * 64;
#pragma unroll
      for (int ks = 0; ks < 4; ks++) qf[ks] = *(const bf16x8*)(qp + ks * 16 + hf * 8);
    }
    f32x16 O0, O1;
#pragma unroll
    for (int i = 0; i < 16; i++) { O0[i] = 0.f; O1[i] = 0.f; }
    float mrun = -1e30f, lrun = 0.f;
    const int wk = swap23(r);
    for (int j = 0; j < 9; j++) {
      const int krow = k0 + j;
      const u16* kp = p.z + (tb + krow * 64 + kstart + wk) * ZLD + ZB_OFF + 256 + head * 64;
      f32x16 S;
#pragma unroll
      for (int i = 0; i < 16; i++) S[i] = 0.f;
#pragma unroll
      for (int ks = 0; ks < 4; ks++) {
        bf16x8 a = *(const bf16x8*)(kp + ks * 16 + hf * 8);
        S = __builtin_amdgcn_mfma_f32_32x32x16_bf16(a, qf[ks], S, 0, 0, 0);
      }
      const bool rok = (krow >= rstart) && (krow < rstart + 8);
      const int drow = clampi(krow - qrow + 7, 0, 14);
      const float* brow = bias + drow * 31;
      float mx = -1e30f;
#pragma unroll
      for (int i = 0; i < 16; i++) {
        int w = 16 * (i >> 3) + 8 * hf + 4 * ((i >> 2) & 1) + (i & 3);
        int kcol = kstart + w;
        bool ok = rok && (kcol >= cstart) && (kcol < cstart + 16);
        int dcol = clampi(kcol - qcol + 15, 0, 30);
        float s = (S[i] * 0.125f + brow[dcol]) * LOG2E;
        S[i] = ok ? s : -1e30f;
        mx = fmaxf(mx, S[i]);
      }
      mx = fmaxf(mx, __shfl_xor(mx, 32));
      float mn = fmaxf(mrun, mx);
      float alpha = ex2(mrun - mn);
      mrun = mn;
      float ls = 0.f;
#pragma unroll
      for (int i = 0; i < 16; i++) {
        float pv = (S[i] > -1e29f) ? ex2(S[i] - mn) : 0.f;
        S[i] = pv;
        ls += pv;
      }
      lrun = lrun * alpha + ls;
#pragma unroll
      for (int i = 0; i < 16; i++) { O0[i] *= alpha; O1[i] *= alpha; }
      const u16* vbase = p.z + (tb + krow * 64 + kstart) * ZLD + ZB_OFF + 512 + head * 64 + r;
#pragma unroll
      for (int s = 0; s < 2; s++) {
        bf16x8 pb = pack8(S, s * 8);
        bf16x8 v0, v1;
#pragma unroll
        for (int jj = 0; jj < 8; jj++) {
          const u16* vp = vbase + (size_t)(16 * s + 8 * hf + jj) * ZLD;
          v0[jj] = (short)vp[0];
          v1[jj] = (short)vp[32];
        }
        O0 = __builtin_amdgcn_mfma_f32_32x32x16_bf16(v0, pb, O0, 0, 0, 0);
        O1 = __builtin_amdgcn_mfma_f32_32x32x16_bf16(v1, pb, O1, 0, 0, 0);
      }
    }
    float lt = lrun + __shfl_xor(lrun, 32);
    float inv = 1.f / lt;
    u16* orow = p.cat + (tb + qrow * 64 + qcol) * 1024 + 256 + head * 64;
#pragma unroll
    for (int g = 0; g < 4; g++) {
      int d0 = 8 * g + 4 * hf;
      *(uint2*)(orow + d0) = make_uint2(pack2(O0[4 * g] * inv, O0[4 * g + 1] * inv), pack2(O0[4 * g + 2] * inv, O0[4 * g + 3] * inv));
      *(uint2*)(orow + 32 + d0) = make_uint2(pack2(O1[4 * g] * inv, O1[4 * g + 1] * inv), pack2(O1[4 * g + 2] * inv, O1[4 * g + 3] * inv));
    }
  }
}

using f32x2 = __attribute__((ext_vector_type(2))) float;
constexpr int SC_STEPS = 16;

DI void sc_store(char* buf, int dst, uint4 R, bool hgw) {
  float4 lo = make_float4(blo(R.x), bhi(R.x), blo(R.y), bhi(R.y));
  float4 hi = make_float4(blo(R.z), bhi(R.z), blo(R.w), bhi(R.w));
  *(float4*)(buf + dst) = lo;
  *(float4*)(buf + dst + 16) = hi;
  if (hgw) {
    *(float4*)(buf + dst + 256) = make_float4(1.f - lo.x, 1.f - lo.y, 1.f - lo.z, 1.f - lo.w);
    *(float4*)(buf + dst + 272) = make_float4(1.f - hi.x, 1.f - hi.y, 1.f - hi.z, 1.f - hi.w);
  }
}

DI float reduce8(float v) {
  v += dpp_f<0xB1>(v);
  v += dpp_f<0x4E>(v);
  v += dpp_f<0x141>(v);
  return v;
}

template <bool RW>
DI void scan_task(const Params& p, int task, int N, char* lds, int tid) {
  constexpr int NA = RW ? 5 : 3;
  constexpr int VOFF = SC_STEPS * NA * 256;
  constexpr int BUF = VOFF + SC_STEPS * 128;
  const int lane = tid & 63, wv = tid >> 6, kq = lane & 7, rg = lane >> 3;
  const int rq = task & 1, hh = (task >> 1) & 3, dir = (task >> 3) & 1, b = task >> 4;
  const size_t tb = (size_t)b * N;
  const int sub = tid >> 7, lt = tid & 127, lstep = lt >> 3, lpart = lt & 7;
  const int vstep = lt >> 2, vq = lt & 3;
  const u16 *src0 = nullptr, *src1 = nullptr, *src2 = nullptr;
  int dst0 = 0, dst1 = 0, dst2 = 0, st0 = 0, st1 = 0, st2 = 0;
  bool act0 = false, act1 = false, act2 = false, hgw = false;
  int ld;
  const int acol = hh * 64 + lpart * 8;
  const int vcol = hh * 64 + rq * 32 + vq * 8;
  const int vdst = VOFF + vstep * 128 + vq * 32;
  if (RW) {
    ld = 256;
    act0 = true; st0 = lstep;
    src0 = sub ? (p.dec + (size_t)dir * T_SUB * 256 + acol) : (p.rs + acol);
    dst0 = (lstep * NA + (sub ? 1 : 0)) * 256 + lpart * 32;
    act1 = true; st1 = lstep;
    src1 = sub ? (p.kk + acol) : (p.kt + (size_t)dir * T_SUB * 256 + acol);
    dst1 = (lstep * NA + (sub ? 3 : 2)) * 256 + lpart * 32;
    if (sub == 0) { act2 = true; st2 = lstep; src2 = p.kka + (size_t)dir * T_SUB * 256 + acol; dst2 = (lstep * NA + 4) * 256 + lpart * 32; }
    else { act2 = lt < 64; st2 = vstep; src2 = p.vs + vcol; dst2 = vdst; }
  } else {
    ld = ZLD;
    act0 = true; st0 = lstep;
    src0 = sub ? (p.z + ZC_OFF + 256 * (1 + dir) + acol) : (p.z + ZC_OFF + acol);
    dst0 = (lstep * NA + (sub ? 1 : 0)) * 256 + lpart * 32;
    hgw = sub != 0;
    if (sub == 0) { act1 = lt < 64; st1 = vstep; src1 = p.z + ZC_OFF + 768 + vcol; dst1 = vdst; }
  }
  u16* pout = (RW ? p.oD : p.oC) + (size_t)dir * T_SUB * 256 + hh * 64 + rq * 32 + wv * 8 + rg;
  pout += (tb + (dir ? (N - 1) : 0)) * 256;
  const int ostride = dir ? -256 : 256;

#define SC_TOK(c_, st_) (tb + (size_t)(dir ? (N - 1 - ((c_) * SC_STEPS + (st_))) : ((c_) * SC_STEPS + (st_))))
#define SC_ISSUE(Ra, Rb, Rc, c_)                                               \
  {                                                                            \
    if (act0) Ra = *(const uint4*)(src0 + SC_TOK(c_, st0) * ld);               \
    if (act1) Rb = *(const uint4*)(src1 + SC_TOK(c_, st1) * ld);               \
    if (act2) Rc = *(const uint4*)(src2 + SC_TOK(c_, st2) * ld);               \
  }
#define SC_STORE(Ra, Rb, Rc, buf_)                                             \
  {                                                                            \
    if (act0) sc_store(buf_, dst0, Ra, hgw);                                   \
    if (act1) sc_store(buf_, dst1, Rb, false);                                 \
    if (act2) sc_store(buf_, dst2, Rc, false);                                 \
  }
  f32x2 S0 = {0.f, 0.f}, S1 = {0.f, 0.f}, S2 = {0.f, 0.f}, S3 = {0.f, 0.f};
#define SC_LD(buf_, s_, ra_, rb_, wa_, wb_, ta_, tb_, ka_, kb_, aa_, ab_, v_)                \
  {                                                                                          \
    const char* rowp_ = (buf_) + (s_) * NA * 256 + kq * 32;                                  \
    ra_ = *(const float4*)(rowp_);                                                           \
    rb_ = *(const float4*)(rowp_ + 16);                                                      \
    wa_ = *(const float4*)(rowp_ + 256);                                                     \
    wb_ = *(const float4*)(rowp_ + 272);                                                     \
    ta_ = *(const float4*)(rowp_ + 512);                                                     \
    tb_ = *(const float4*)(rowp_ + 528);                                                     \
    if (RW) {                                                                                \
      ka_ = *(const float4*)(rowp_ + 768);                                                   \
      kb_ = *(const float4*)(rowp_ + 784);                                                   \
      aa_ = *(const float4*)(rowp_ + 1024);                                                  \
      ab_ = *(const float4*)(rowp_ + 1040);                                                  \
    }                                                                                        \
    v_ = *(const float*)((buf_) + VOFF + (s_) * 128 + (wv * 8 + rg) * 4);                    \
  }
#define F2A(q_) f32x2{(q_).x, (q_).y}
#define F2B(q_) f32x2{(q_).z, (q_).w}
#define SC_COMPUTE(buf_)                                                                     \
  {                                                                                          \
    float oselA = 0.f, oselB = 0.f;                                                          \
    float4 ra, rb, wa, wb, ta, tb_, ka, kb, aa, ab, nra, nrb, nwa, nwb, nta, ntb, nka, nkb, naa, nab; \
    float vv, nvv;                                                                           \
    ka = kb = aa = ab = nka = nkb = naa = nab = make_float4(0.f, 0.f, 0.f, 0.f);             \
    SC_LD(buf_, 0, ra, rb, wa, wb, ta, tb_, ka, kb, aa, ab, vv);                             \
    _Pragma("unroll") for (int s = 0; s < SC_STEPS; s++) {                                   \
      if (s + 1 < SC_STEPS) SC_LD(buf_, s + 1, nra, nrb, nwa, nwb, nta, ntb, nka, nkb, naa, nab, nvv); \
      f32x2 u0 = F2A(ta) * vv, u1 = F2B(ta) * vv, u2 = F2A(tb_) * vv, u3 = F2B(tb_) * vv;     \
      if (RW) {                                                                              \
        f32x2 pa = S0 * F2A(ka), pb = S1 * F2B(ka);                                          \
        pa = S2 * F2A(kb) + pa;                                                              \
        pb = S3 * F2B(kb) + pb;                                                              \
        pa = pa + pb;                                                                        \
        const float sa = -reduce8(pa.x + pa.y);                                              \
        u0 = F2A(aa) * sa + u0;                                                              \
        u1 = F2B(aa) * sa + u1;                                                              \
        u2 = F2A(ab) * sa + u2;                                                              \
        u3 = F2B(ab) * sa + u3;                                                              \
      }                                                                                      \
      S0 = S0 * F2A(wa) + u0;                                                                \
      S1 = S1 * F2B(wa) + u1;                                                                \
      S2 = S2 * F2A(wb) + u2;                                                                \
      S3 = S3 * F2B(wb) + u3;                                                                \
      f32x2 qa = S0 * F2A(ra), qb = S1 * F2B(ra);                                            \
      qa = S2 * F2A(rb) + qa;                                                                \
      qb = S3 * F2B(rb) + qb;                                                                \
      qa = qa + qb;                                                                          \
      const float o = reduce8(qa.x + qa.y);                                                  \
      if (s < 8) oselA = (kq == s) ? o : oselA;                                              \
      else oselB = (kq == s - 8) ? o : oselB;                                                \
      ra = nra; rb = nrb; wa = nwa; wb = nwb; ta = nta; tb_ = ntb;                           \
      ka = nka; kb = nkb; aa = naa; ab = nab; vv = nvv;                                      \
    }                                                                                        \
    pout[kq * ostride] = f2bf(oselA);                                                        \
    pout[(kq + 8) * ostride] = f2bf(oselB);                                                  \
    pout += SC_STEPS * ostride;                                                              \
  }
  uint4 A0 = make_uint4(0, 0, 0, 0), A1 = A0, A2 = A0, B0 = A0, B1 = A0, B2 = A0;
  char* buf0 = lds;
  char* buf1 = lds + BUF;
  const int nch = N / SC_STEPS;
  __syncthreads();
  SC_ISSUE(A0, A1, A2, 0);
  SC_ISSUE(B0, B1, B2, 1);
  SC_STORE(A0, A1, A2, buf0);
  __syncthreads();
  for (int c = 0; c < nch; c += 2) {
    if (c + 2 < nch) SC_ISSUE(A0, A1, A2, c + 2);
    __builtin_amdgcn_sched_barrier(0);
    SC_COMPUTE(buf0);
    __builtin_amdgcn_sched_barrier(0);
    SC_STORE(B0, B1, B2, buf1);
    __syncthreads();
    if (c + 3 < nch) SC_ISSUE(B0, B1, B2, c + 3);
    __builtin_amdgcn_sched_barrier(0);
    SC_COMPUTE(buf1);
    __builtin_amdgcn_sched_barrier(0);
    if (c + 2 < nch) SC_STORE(A0, A1, A2, buf0);
    __syncthreads();
  }
}

template <bool RW>
DI void scan_task16(const Params& p, int task, int N, char* lds, int tid) {
  constexpr int NA = RW ? 5 : 3;
  constexpr int VOFF = SC_STEPS * NA * 256;
  constexpr int BUF = VOFF + SC_STEPS * 64;
  const int lane = tid & 63, wv = tid >> 6, kq = lane & 15, rg = lane >> 4;
  const int rq = task & 3, hh = (task >> 2) & 3, dir = (task >> 4) & 1, b = task >> 5;
  const size_t tb = (size_t)b * N;
  const int sub = tid >> 7, lt = tid & 127, lstep = lt >> 3, lpart = lt & 7;
  const int vstep = lt >> 1, vhalf = lt & 1;
  const u16 *src0 = nullptr, *src1 = nullptr, *src2 = nullptr;
  int dst0 = 0, dst1 = 0, dst2 = 0, st0 = 0, st1 = 0, st2 = 0;
  bool act0 = false, act1 = false, act2 = false, hgw = false;
  int ld;
  const int acol = hh * 64 + lpart * 8;
  const int vcol = hh * 64 + rq * 16 + vhalf * 8;
  const int vdst = VOFF + vstep * 64 + vhalf * 32;
  if (RW) {
    ld = 256;
    act0 = true; st0 = lstep;
    src0 = sub ? (p.dec + (size_t)dir * T_SUB * 256 + acol) : (p.rs + acol);
    dst0 = (lstep * NA + (sub ? 1 : 0)) * 256 + lpart * 32;
    act1 = true; st1 = lstep;
    src1 = sub ? (p.kk + acol) : (p.kt + (size_t)dir * T_SUB * 256 + acol);
    dst1 = (lstep * NA + (sub ? 3 : 2)) * 256 + lpart * 32;
    if (sub == 0) { act2 = true; st2 = lstep; src2 = p.kka + (size_t)dir * T_SUB * 256 + acol; dst2 = (lstep * NA + 4) * 256 + lpart * 32; }
    else { act2 = lt < 32; st2 = vstep; src2 = p.vs + vcol; dst2 = vdst; }
  } else {
    ld = ZLD;
    act0 = true; st0 = lstep;
    src0 = sub ? (p.z + ZC_OFF + 256 * (1 + dir) + acol) : (p.z + ZC_OFF + acol);
    dst0 = (lstep * NA + (sub ? 1 : 0)) * 256 + lpart * 32;
    hgw = sub != 0;
    if (sub == 0) { act1 = lt < 32; st1 = vstep; src1 = p.z + ZC_OFF + 768 + vcol; dst1 = vdst; }
  }
  u16* pout = (RW ? p.oD : p.oC) + (size_t)dir * T_SUB * 256 + hh * 64 + rq * 16 + wv * 4 + rg;
  pout += (tb + (dir ? (N - 1) : 0)) * 256;
  const int ostride = dir ? -256 : 256;

#define SC16_TOK(c_, st_) (tb + (size_t)(dir ? (N - 1 - ((c_) * SC_STEPS + (st_))) : ((c_) * SC_STEPS + (st_))))
#define SC16_ISSUE(Ra, Rb, Rc, c_)                                               \
  {                                                                            \
    if (act0) Ra = *(const uint4*)(src0 + SC16_TOK(c_, st0) * ld);               \
    if (act1) Rb = *(const uint4*)(src1 + SC16_TOK(c_, st1) * ld);               \
    if (act2) Rc = *(const uint4*)(src2 + SC16_TOK(c_, st2) * ld);               \
  }
#define SC16_STORE(Ra, Rb, Rc, buf_)                                             \
  {                                                                            \
    if (act0) sc_store(buf_, dst0, Ra, hgw);                                   \
    if (act1) sc_store(buf_, dst1, Rb, false);                                 \
    if (act2) sc_store(buf_, dst2, Rc, false);                                 \
  }
  f32x2 S01 = {0.f, 0.f}, S23 = {0.f, 0.f};
#define SC16_LD(buf_, s_, r_, w_, t_, k_, a_, v_)                                              \
  {                                                                                          \
    const char* rowp_ = (buf_) + (s_) * NA * 256 + kq * 16;                                  \
    r_ = *(const float4*)(rowp_);                                                            \
    w_ = *(const float4*)(rowp_ + 256);                                                      \
    t_ = *(const float4*)(rowp_ + 512);                                                      \
    if (RW) {                                                                                \
      k_ = *(const float4*)(rowp_ + 768);                                                    \
      a_ = *(const float4*)(rowp_ + 1024);                                                   \
    }                                                                                        \
    v_ = *(const float*)((buf_) + VOFF + (s_) * 64 + (wv * 4 + rg) * 4);                     \
  }
#define SC16_COMPUTE(buf_)                                                                     \
  {                                                                                          \
    float osel = 0.f;                                                                        \
    float4 r4, w4, t4, k4, a4, nr4, nw4, nt4, nk4, na4;                                      \
    float vv, nvv;                                                                           \
    k4 = a4 = nk4 = na4 = make_float4(0.f, 0.f, 0.f, 0.f);                                   \
    SC16_LD(buf_, 0, r4, w4, t4, k4, a4, vv);                                                  \
    _Pragma("unroll") for (int s = 0; s < SC_STEPS; s++) {                                   \
      if (s + 1 < SC_STEPS) SC16_LD(buf_, s + 1, nr4, nw4, nt4, nk4, na4, nvv);                \
      f32x2 ta = f32x2{t4.x, t4.y} * vv, tb2 = f32x2{t4.z, t4.w} * vv;                       \
      if (RW) {                                                                              \
        f32x2 pp = S01 * f32x2{k4.x, k4.y};                                                  \
        pp = S23 * f32x2{k4.z, k4.w} + pp;                                                   \
        const float sa = -reduce16(pp.x + pp.y);                                             \
        ta = f32x2{a4.x, a4.y} * sa + ta;                                                    \
        tb2 = f32x2{a4.z, a4.w} * sa + tb2;                                                  \
      }                                                                                      \
      S01 = S01 * f32x2{w4.x, w4.y} + ta;                                                    \
      S23 = S23 * f32x2{w4.z, w4.w} + tb2;                                                   \
      f32x2 qq = S01 * f32x2{r4.x, r4.y};                                                    \
      qq = S23 * f32x2{r4.z, r4.w} + qq;                                                     \
      const float o = reduce16(qq.x + qq.y);                                                 \
      osel = (kq == s) ? o : osel;                                                           \
      r4 = nr4; w4 = nw4; t4 = nt4; k4 = nk4; a4 = na4; vv = nvv;                            \
    }                                                                                        \
    pout[kq * ostride] = f2bf(osel);                                                         \
    pout += SC_STEPS * ostride;                                                              \
  }
  uint4 A0 = make_uint4(0, 0, 0, 0), A1 = A0, A2 = A0, B0 = A0, B1 = A0, B2 = A0;
  char* buf0 = lds;
  char* buf1 = lds + BUF;
  const int nch = N / SC_STEPS;
  __syncthreads();
  SC16_ISSUE(A0, A1, A2, 0);
  SC16_ISSUE(B0, B1, B2, 1);
  SC16_STORE(A0, A1, A2, buf0);
  __syncthreads();
  for (int c = 0; c < nch; c += 2) {
    if (c + 2 < nch) SC16_ISSUE(A0, A1, A2, c + 2);
    __builtin_amdgcn_sched_barrier(0);
    SC16_COMPUTE(buf0);
    __builtin_amdgcn_sched_barrier(0);
    SC16_STORE(B0, B1, B2, buf1);
    __syncthreads();
    if (c + 3 < nch) SC16_ISSUE(B0, B1, B2, c + 3);
    __builtin_amdgcn_sched_barrier(0);
    SC16_COMPUTE(buf1);
    __builtin_amdgcn_sched_barrier(0);
    if (c + 2 < nch) SC16_STORE(A0, A1, A2, buf0);
    __syncthreads();
  }
}


DI void phase_mix(const Params& p, int l, int B, int N, unsigned* ctr, char* lds, int bid, int nb, int tid) {
  __shared__ int s_task[2];
  const bool wide = (N > 4096);
  const int nper = wide ? B * 32 : B * 16;
  const int nscan = 2 * nper;
  const int nattn = B * 4 * (N >> 7);
  const int nna = B * (N >> 7) * 4;
  const bool prefer_scan = bid < (nb >> 1);
  bool scan_dry = false, attn_dry = false;
  for (;;) {
    if (tid == 0) {
      int kind = -1, task = 0;
      for (int attempt = 0; attempt < 2 && kind < 0; attempt++) {
        const bool try_scan = (attempt == 0) == prefer_scan;
        if (try_scan) {
          if (!scan_dry) {
            const int t = (int)atomicAdd(&ctr[0], 1u);
            if (t < nscan) { kind = 0; task = t; } else scan_dry = true;
          }
        } else {
          if (!attn_dry) {
            const int t = (int)atomicAdd(&ctr[64], 1u);
            if (t < nattn + nna) { kind = 1; task = t; } else attn_dry = true;
          }
        }
      }
      s_task[0] = kind;
      s_task[1] = task;
    }
    __syncthreads();
    const int kind = s_task[0], task = s_task[1];
    __syncthreads();
    if (kind < 0) break;
    if (kind == 0) {
      if (wide) {
        if (task < nper) scan_task16<true>(p, task, N, lds, tid);
        else scan_task16<false>(p, task - nper, N, lds, tid);
      } else {
        if (task < nper) scan_task<true>(p, task, N, lds, tid);
        else scan_task<false>(p, task - nper, N, lds, tid);
      }
    } else {
      if (task < nattn) attn_task(p, task, N, lds, tid);
      else na_task(p, l, task - nattn, N, tid);
    }
  }
}

DI void phase_final(const Params& p, int l, int bid, int nb, int tid) {
  const int lane = tid & 63, wv = tid >> 6, c4 = lane * 4;
  float gn[4], lw[4], lbb[4];
#pragma unroll
  for (int j = 0; j < 4; j++) {
    gn[j] = p.hg_gnorm[l * 256 + c4 + j];
    lw[j] = p.rw_ln_w[l * 256 + c4 + j];
    lbb[j] = p.rw_ln_b[l * 256 + c4 + j];
  }
  for (int t = bid * 4 + wv; t < T_SUB; t += nb * 4) {
    const uint2 ca = *(const uint2*)(p.oC + (size_t)t * 256 + c4);
    const uint2 cb = *(const uint2*)(p.oC + (size_t)(T_SUB + t) * 256 + c4);
    const uint2 cg = *(const uint2*)(p.z + (size_t)t * ZLD + ZC_OFF + 1024 + c4);
    const uint2 da = *(const uint2*)(p.oD + (size_t)t * 256 + c4);
    const uint2 db = *(const uint2*)(p.oD + (size_t)(T_SUB + t) * 256 + c4);
    const float bo = p.bonus[(size_t)t * 4 + (lane >> 4)];
    const uint2 vr = *(const uint2*)(p.vs + (size_t)t * 256 + c4);
    const uint2 gr = *(const uint2*)(p.gD + (size_t)t * 256 + c4);
    {
      float o[4] = {blo(ca.x) + blo(cb.x), bhi(ca.x) + bhi(cb.x), blo(ca.y) + blo(cb.y), bhi(ca.y) + bhi(cb.y)};
      float ss = reduce16(o[0] * o[0] + o[1] * o[1] + o[2] * o[2] + o[3] * o[3]);
      float ri = rsqrtf(ss * (1.f / 64.f) + 1e-6f);
      float g[4] = {blo(cg.x), bhi(cg.x), blo(cg.y), bhi(cg.y)};
      float y[4];
#pragma unroll
      for (int j = 0; j < 4; j++) y[j] = o[j] * ri * gn[j] * (g[j] * sigm(g[j]));
      *(uint2*)(p.cat + (size_t)t * 1024 + 512 + c4) = make_uint2(pack2(y[0], y[1]), pack2(y[2], y[3]));
    }
    {
      float o[4] = {blo(da.x) + blo(db.x), bhi(da.x) + bhi(db.x), blo(da.y) + blo(db.y), bhi(da.y) + bhi(db.y)};
      float mu = reduce16(o[0] + o[1] + o[2] + o[3]) * (1.f / 64.f);
      float d0 = o[0] - mu, d1 = o[1] - mu, d2 = o[2] - mu, d3 = o[3] - mu;
      float var = reduce16(d0 * d0 + d1 * d1 + d2 * d2 + d3 * d3) * (1.f / 64.f);
      float ri = rsqrtf(var + 64e-5f);
      float vv[4] = {blo(vr.x), bhi(vr.x), blo(vr.y), bhi(vr.y)};
      float g[4] = {blo(gr.x), bhi(gr.x), blo(gr.y), bhi(gr.y)};
      float dd[4] = {d0, d1, d2, d3};
      float y[4];
#pragma unroll
      for (int j = 0; j < 4; j++) y[j] = (dd[j] * ri * lw[j] + lbb[j] + bo * vv[j]) * g[j];
      *(uint2*)(p.cat + (size_t)t * 1024 + 768 + c4) = make_uint2(pack2(y[0], y[1]), pack2(y[2], y[3]));
    }
  }
}

DI void phase_wout(const Params& p, int l, int tok0, char* lds, int bid, int nb, int tid) {
  const int NT = 8, MT = T_SUB / 128;
  for (int it = 0;; it++) {
    int nt, mt;
    if (!xcd_tile(it, bid, nb, MT, NT, mt, nt)) break;
    int m0 = mt * 128, n0 = nt * 128;
    auto rowfn = [&](int r) -> const void* { return p.cat + (size_t)(m0 + r) * 1024; };
    auto epi = [&](f32x4(&acc)[4][4], int rbase, int cbase) {
      EPI_LOOP({
        int tg = tok0 + m0 + row;
        float4 xv = *(const float4*)(xin_row(p, l, tg) + n0 + col);
        float4 o = make_float4(ALPHA_F * xv.x + v[0], ALPHA_F * xv.y + v[1], ALPHA_F * xv.z + v[2], ALPHA_F * xv.w + v[3]);
        *(float4*)(p.out + (size_t)tg * 1024 + n0 + col) = o;
      })
    };
    gemm_tile<false>(rowfn, p.wout_t + ((size_t)l * 1024 + n0) * 1024, 1024, epi, lds, tid);
  }
}

template <bool ROUTER>
DI void phase_ln(const Params& p, const float* g, const float* bta, const float* wrouter, int tok0, int ntok, char* lds,
                 int bid, int nb, int tid) {
  const int lane = tid & 63, wv = tid >> 6;
  float* wl = (float*)lds;
  if (ROUTER) {
    __syncthreads();
    for (int i = tid; i < 16384; i += NTHR) {
      int k = i >> 4, e = i & 15;
      wl[e * 1024 + k] = wrouter[i];
    }
    __syncthreads();
  }
  auto ln_load = [&](float4 (&d)[4], int trow, bool ok) {
#pragma unroll
    for (int i = 0; i < 4; i++) {
      if (!ok) { d[i] = make_float4(0.f, 0.f, 0.f, 0.f); continue; }
      if (ROUTER) {
        d[i] = *(const float4*)(p.out + (size_t)trow * 1024 + i * 256 + lane * 4);
      } else {
        const uint2 r = *(const uint2*)(p.O + (size_t)trow * 1024 + i * 256 + lane * 4);
        d[i] = make_float4(blo(r.x), bhi(r.x), blo(r.y), bhi(r.y));
      }
    }
  };
  float4 x[4], xn[4];
  {
    const int t0 = bid * 4 + wv;
    ln_load(x, tok0 + t0, t0 < ntok);
  }
  for (int t = bid * 4 + wv; t < ntok; t += nb * 4) {
    const int tg = tok0 + t;
    float* xr = p.out + (size_t)tg * 1024;
    {
      const int tn = t + nb * 4;
      ln_load(xn, tok0 + tn, tn < ntok);
    }
    float s = 0.f;
#pragma unroll
    for (int i = 0; i < 4; i++) s += x[i].x + x[i].y + x[i].z + x[i].w;
    float mu = wave_sum(s) * (1.f / 1024.f);
    float vs = 0.f;
#pragma unroll
    for (int i = 0; i < 4; i++) {
      x[i].x -= mu; x[i].y -= mu; x[i].z -= mu; x[i].w -= mu;
      vs += x[i].x * x[i].x + x[i].y * x[i].y + x[i].z * x[i].z + x[i].w * x[i].w;
    }
    float ri = rsqrtf(wave_sum(vs) * (1.f / 1024.f) + 1e-5f);
#pragma unroll
    for (int i = 0; i < 4; i++) {
      float4 gg = *(const float4*)(g + i * 256 + lane * 4);
      float4 bb = *(const float4*)(bta + i * 256 + lane * 4);
      x[i].x = x[i].x * ri * gg.x + bb.x;
      x[i].y = x[i].y * ri * gg.y + bb.y;
      x[i].z = x[i].z * ri * gg.z + bb.z;
      x[i].w = x[i].w * ri * gg.w + bb.w;
      if (!ROUTER) *(float4*)(xr + i * 256 + lane * 4) = x[i];
      *(uint2*)(p.xb + (size_t)tg * 1024 + i * 256 + lane * 4) = make_uint2(pack2(x[i].x, x[i].y), pack2(x[i].z, x[i].w));
    }
    if (ROUTER) {
      float mine = 0.f;
#pragma unroll 1
      for (int e = 0; e < 16; e++) {
        float a = 0.f;
#pragma unroll
        for (int i = 0; i < 4; i++) {
          float4 w = *(const float4*)(wl + e * 1024 + i * 256 + lane * 4);
          a += x[i].x * w.x + x[i].y * w.y + x[i].z * w.z + x[i].w * w.w;
        }
        a = wave_sum(a);
        mine = (lane == e) ? a : mine;
      }
      float mx = mine;
      mx = fmaxf(mx, dpp_f<0xB1>(mx));
      mx = fmaxf(mx, dpp_f<0x4E>(mx));
      mx = fmaxf(mx, dpp_f<0x141>(mx));
      mx = fmaxf(mx, dpp_f<0x140>(mx));
      float ex = __expf(mine - mx);
      float sum = reduce16(ex);
      mine = ex / sum;
      if (lane == 0) p.inv_cnt[tg] = 0;
      if (lane < 16) {
        if (tg < 32768) p.affT[(size_t)lane * 32768 + tg] = mine;
        else p.affT[(size_t)16 * 32768 + (size_t)lane * 65536 + (tg - 32768)] = mine;
      }
    }
#pragma unroll
    for (int i = 0; i < 4; i++) x[i] = xn[i];
  }
}

DI void phase_topk(const Params& p, char* lds, int bid, int nb, int tid) {
  if (bid < 32) {
    unsigned* hist = (unsigned*)lds;
    unsigned* sh = hist + 256;
    unsigned* eqc = sh + 8;
    const int g = bid >> 4, e = bid & 15;
    const int T = g ? 65536 : 32768, cap = T >> 3;
    const int tok0 = g ? 32768 : 0;
    const float* vals = p.affT + (g ? (size_t)16 * 32768 : 0) + (size_t)e * T;
    const float4* v4 = (const float4*)vals;
    const int n4 = T >> 2;
    int* oidx = p.idx + (g ? 65536 : 0) + e * cap;
    float* ogate = p.gate + (g ? 65536 : 0) + e * cap;
    const int slot0 = (g ? 65536 : 0) + e * cap;
    unsigned prefix = 0, mask = 0;
    int remaining = cap;
    for (int pass = 0; pass < 4; pass++) {
      const int shift = 24 - 8 * pass;
      hist[tid] = 0;
      __syncthreads();
      for (int base = 0; base < n4; base += 2048) {
        float4 x[8];
#pragma unroll
        for (int u = 0; u < 8; u++) x[u] = v4[base + u * 256 + tid];
#pragma unroll
        for (int u = 0; u < 8; u++) {
          const unsigned b0 = __float_as_uint(x[u].x), b1 = __float_as_uint(x[u].y), b2 = __float_as_uint(x[u].z), b3 = __float_as_uint(x[u].w);
          if ((b0 & mask) == prefix) atomicAdd(&hist[(b0 >> shift) & 255], 1u);
          if ((b1 & mask) == prefix) atomicAdd(&hist[(b1 >> shift) & 255], 1u);
          if ((b2 & mask) == prefix) atomicAdd(&hist[(b2 >> shift) & 255], 1u);
          if ((b3 & mask) == prefix) atomicAdd(&hist[(b3 >> shift) & 255], 1u);
        }
      }
      __syncthreads();
      if (tid == 0) {
        int cum = 0, sel = 0;
        for (int bq = 255; bq >= 0; bq--) {
          int hc = (int)hist[bq];
          if (cum + hc >= remaining) { sel = bq; break; }
          cum += hc;
        }
        sh[0] = (unsigned)sel;
        sh[1] = (unsigned)(remaining - cum);
        sh[3] = hist[sel];
      }
      __syncthreads();
      prefix |= sh[0] << shift;
      remaining = (int)sh[1];
      mask |= 0xFFu << shift;
      __syncthreads();
    }
    const unsigned thr = prefix;
    const int need = remaining;
    const bool fast = ((int)sh[3] == need);
    if (tid == 0) sh[2] = 0;
    __syncthreads();
    if (fast) {
      for (int base = 0; base < n4; base += 2048) {
        float4 x[8];
#pragma unroll
        for (int u = 0; u < 8; u++) x[u] = v4[base + u * 256 + tid];
#pragma unroll
        for (int u = 0; u < 8; u++) {
          const float xv[4] = {x[u].x, x[u].y, x[u].z, x[u].w};
#pragma unroll
          for (int c = 0; c < 4; c++) {
            if (__float_as_uint(xv[c]) >= thr) {
              const int pos = (int)atomicAdd(&sh[2], 1u);
              const int tok = tok0 + (base + u * 256 + tid) * 4 + c;
              oidx[pos] = tok;
              ogate[pos] = xv[c];
              const int kslot = atomicAdd(&p.inv_cnt[tok], 1);
              p.inv_slot[(size_t)tok * 16 + kslot] = slot0 + pos;
            }
          }
        }
      }
    } else {
      const int ch = T >> 8;
      const float* my = vals + tid * ch;
      int ec = 0;
      for (int i = 0; i < ch; i++) ec += (__float_as_uint(my[i]) == thr) ? 1 : 0;
      eqc[tid] = ec;
      __syncthreads();
      int eq_rank = 0;
      for (int i = 0; i < tid; i++) eq_rank += eqc[i];
      for (int i = 0; i < ch; i++) {
        float v = my[i];
        unsigned u = __float_as_uint(v);
        int pos = -1;
        if (u > thr) {
          pos = (int)atomicAdd(&sh[2], 1u);
        } else if (u == thr) {
          if (eq_rank < need) pos = cap - need + eq_rank;
          eq_rank++;
        }
        if (pos >= 0) {
          const int tok = tok0 + tid * ch + i;
          oidx[pos] = tok;
          ogate[pos] = v;
          const int kslot = atomicAdd(&p.inv_cnt[tok], 1);
          p.inv_slot[(size_t)tok * 16 + kslot] = slot0 + pos;
        }
      }
    }
    __syncthreads();
  }
}

DI void moe_rowinfo(int row0, int l, int& e, int& ioff) {
  if (row0 < 65536) { e = row0 >> 12; }
  else { e = (row0 - 65536) >> 13; }
  ioff = row0;
}

DI void phase_moe1(const Params& p, int l, char* lds, int bid, int nb, int tid) {
  const int NT = 8, MT = 196608 / 128;
  for (int it = 0;; it++) {
    int nt, mt;
    if (!xcd_tile(it, bid, nb, MT, NT, mt, nt)) break;
    int m0 = mt * 128, n0 = nt * 128;
    int e, ioff;
    moe_rowinfo(m0, l, e, ioff);
    const int* ip = p.idx + ioff;
    auto rowfn = [&](int r) -> const void* { return p.xb + (size_t)ip[r] * 1024; };
    u16* H = p.H;
    auto epi = [&](f32x4(&acc)[4][4], int rbase, int cbase) {
#pragma unroll
      for (int m = 0; m < 4; m++)
#pragma unroll
        for (int n = 0; n < 4; n += 2) {
          int row = rbase + m * 16;
          int col = cbase + n * 16;
          int blk = (n0 + (col & ~31)) >> 1;
          int hc = blk + (col & 15);
          f32x4 a = acc[m][n], bq = acc[m][n + 1];
          f32x4 o;
          for (int j = 0; j < 4; j++) o[j] = a[j] * sigm(a[j]) * bq[j];
          st_bf4(H + (size_t)(m0 + row) * 512 + hc, o);
        }
    };
    gemm_tile<false>(rowfn, p.w13_t + ((size_t)(l * 16 + e) * 1024 + n0) * 1024, 1024, epi, lds, tid);
  }
}

DI void phase_moe2(const Params& p, int l, char* lds, int bid, int nb, int tid) {
  TileIter it{bid, nb, 0};
  {
    const int NT = 8, MT = 196608 / 128;
    for (int itx = 0;; itx++) {
      int nt, mt;
      if (!xcd_tile(itx, bid, nb, MT, NT, mt, nt)) break;
      int m0 = mt * 128, n0 = nt * 128;
      int e, ioff;
      moe_rowinfo(m0, l, e, ioff);
      auto rowfn = [&](int r) -> const void* { return p.H + (size_t)(m0 + r) * 512; };
      u16* O = p.O;
      auto epi = [&](f32x4(&acc)[4][4], int rbase, int cbase) {
        EPI_LOOP({ st_bf4(O + (size_t)(m0 + row) * 1024 + n0 + col, v); })
      };
      gemm_tile<false>(rowfn, p.w2_t + ((size_t)(l * 16 + e) * 1024 + n0) * 512, 512, epi, lds, tid);
    }
  }
  {
    const int NT = 8, MT = T_ALL / 128;
    for (int itx = 0;; itx++) {
      int nt, mt;
      if (!xcd_tile(itx, bid, nb, MT, NT, mt, nt)) break;
      int m0 = mt * 128, n0 = nt * 128;
      auto rowfn = [&](int r) -> const void* {
        int tg = m0 + r;
        return tg < 32768 ? p.p_prompt + ((size_t)l * 32768 + tg) * 256 : p.p_sample + ((size_t)l * 65536 + (tg - 32768)) * 256;
      };
      auto epi = [&](f32x4(&acc)[4][4], int rbase, int cbase) {
        EPI_LOOP({ st_bf4((u16*)p.out + (size_t)(m0 + row) * 1024 + n0 + col, v); })
      };
      gemm_tile<true>(rowfn, p.wp_t + ((size_t)l * 1024 + n0) * 256, 256, epi, lds, tid);
    }
  }
}

DI void phase_combine(const Params& p, int bid, int nb, int tid) {
  const int lane = tid & 63, wv = tid >> 6;
  u16* ub = p.H;
  const int stride = nb * 4;
  int t = bid * 4 + wv;
  uint2 xr_[4], xn_[4];
  int cnt = 0, myslot = 0, cntn = 0, myslotn = 0;
#pragma unroll
  for (int i = 0; i < 4; i++) xr_[i] = xn_[i] = make_uint2(0, 0);
  if (t < T_ALL) {
#pragma unroll
    for (int i = 0; i < 4; i++) xr_[i] = *(const uint2*)(p.xb + (size_t)t * 1024 + i * 256 + lane * 4);
    cnt = p.inv_cnt[t];
    myslot = p.inv_slot[(size_t)t * 16 + (lane & 15)];
  }
  for (; t < T_ALL; t += stride) {
    const int tn = t + stride;
    if (tn < T_ALL) {
#pragma unroll
      for (int i = 0; i < 4; i++) xn_[i] = *(const uint2*)(p.xb + (size_t)tn * 1024 + i * 256 + lane * 4);
      cntn = p.inv_cnt[tn];
      myslotn = p.inv_slot[(size_t)tn * 16 + (lane & 15)];
    }
    const float mygate = ((lane & 15) < cnt) ? p.gate[myslot] : 0.f;
    float4 a[4];
#pragma unroll
    for (int i = 0; i < 4; i++)
      a[i] = make_float4(blo(xr_[i].x) * ALPHA_F, bhi(xr_[i].x) * ALPHA_F, blo(xr_[i].y) * ALPHA_F, bhi(xr_[i].y) * ALPHA_F);
    for (int j0 = 0; j0 < cnt; j0 += 4) {
      uint2 r[4][4];
      float g[4];
#pragma unroll
      for (int jj = 0; jj < 4; jj++) {
        const int j = (j0 + jj < cnt) ? (j0 + jj) : j0;
        const int slot = __shfl(myslot, j);
        g[jj] = (j0 + jj < cnt) ? __shfl(mygate, j) : 0.f;
        const u16* orow = p.O + (size_t)slot * 1024 + lane * 4;
#pragma unroll
        for (int i = 0; i < 4; i++) r[jj][i] = *(const uint2*)(orow + i * 256);
      }
#pragma unroll
      for (int jj = 0; jj < 4; jj++)
#pragma unroll
        for (int i = 0; i < 4; i++) {
          a[i].x += g[jj] * blo(r[jj][i].x);
          a[i].y += g[jj] * bhi(r[jj][i].x);
          a[i].z += g[jj] * blo(r[jj][i].y);
          a[i].w += g[jj] * bhi(r[jj][i].y);
        }
    }
#pragma unroll
    for (int i = 0; i < 4; i++)
      *(uint2*)(ub + (size_t)t * 1024 + i * 256 + lane * 4) = make_uint2(pack2(a[i].x, a[i].y), pack2(a[i].z, a[i].w));
#pragma unroll
    for (int i = 0; i < 4; i++) xr_[i] = xn_[i];
    cnt = cntn;
    myslot = myslotn;
  }
}

DI void phase_ple(const Params& p, int l, char* lds, int bid, int nb, int tid) {
  const int NT = 8, MT = T_ALL / 128;
  for (int it = 0;; it++) {
    int nt, mt;
    if (!xcd_tile(it, bid, nb, MT, NT, mt, nt)) break;
    int m0 = mt * 128, n0 = nt * 128;
    auto rowfn = [&](int r) -> const void* { return p.H + (size_t)(m0 + r) * 1024; };
    auto epi = [&](f32x4(&acc)[4][4], int rbase, int cbase) {
      EPI_LOOP({
        size_t o = (size_t)(m0 + row) * 1024 + n0 + col;
        const uint2 ur = *(const uint2*)(p.H + o);
        const uint2 pr = *(const uint2*)((const u16*)p.out + o);
        f32x4 w4;
        w4[0] = blo(ur.x) + sigm(v[0]) * blo(pr.x);
        w4[1] = bhi(ur.x) + sigm(v[1]) * bhi(pr.x);
        w4[2] = blo(ur.y) + sigm(v[2]) * blo(pr.y);
        w4[3] = bhi(ur.y) + sigm(v[3]) * bhi(pr.y);
        st_bf4(p.O + o, w4);
      })
    };
    gemm_tile<false>(rowfn, p.wg_t + ((size_t)l * 1024 + n0) * 1024, 1024, epi, lds, tid);
  }
}

#define XB_TMO      128
#define XB_XCNT(j)  (256  + 64 * (j))
#define XB_XSUB(j)  (1280 + 64 * (j))
#define XB_XGEN(j)  (2304 + 64 * (j))
#define XB_TOP      3328
#define XB_TOPGEN   3392
#define XCD_BAR_WORDS 3456
#define XB_SPIN_CAP (1u << 22)
#define LAS __attribute__((address_space(3)))
DI unsigned xb_ld(unsigned* p) { return __hip_atomic_load(p, __ATOMIC_RELAXED, __HIP_MEMORY_SCOPE_AGENT); }
DI unsigned xb_add(unsigned* p, unsigned v) { return __hip_atomic_fetch_add(p, v, __ATOMIC_RELAXED, __HIP_MEMORY_SCOPE_AGENT); }
DI unsigned xb_xcc_id() { return (unsigned)__builtin_amdgcn_s_getreg((3 << 11) | 20) & 0xFu; }
#define XB_SPIN(cond, bar) do { unsigned _sp = 0; while (cond) { __builtin_amdgcn_s_sleep(1); \
    if ((++_sp & 255u) == 0u) { if (xb_ld(&(bar)[XB_TMO])) break; if (_sp > XB_SPIN_CAP) { atomicAdd(&(bar)[XB_TMO], 1u); break; } } } } while (0)
struct XcdBarrier { unsigned* bar; unsigned x; volatile LAS unsigned* st; };
DI XcdBarrier xcd_barrier_post(unsigned* bar, volatile LAS unsigned* st) {
  XcdBarrier b; b.bar = bar; b.x = xb_xcc_id(); b.st = st;
  if (threadIdx.x == 0) (void)xb_add(&bar[XB_XCNT(b.x)], 1u);
  return b;
}
DI void xcd_barrier_complete(unsigned* bar, unsigned x, unsigned& nloc, unsigned& nx) {
  const unsigned G = gridDim.x * gridDim.y * gridDim.z;
  unsigned sum, cnt, mine, sp = 0u;
  for (;;) {
    sum = 0u; cnt = 0u; mine = 0u;
#pragma unroll
    for (unsigned j = 0; j < 16; ++j) { const unsigned c = xb_ld(&bar[XB_XCNT(j)]); sum += c; cnt += (c > 0u) ? 1u : 0u; mine = (j == x) ? c : mine; }
    if (sum == G) break;
    __builtin_amdgcn_s_sleep(1);
    if ((++sp & 255u) == 0u) { if (xb_ld(&bar[XB_TMO])) break; if (sp > XB_SPIN_CAP) { atomicAdd(&bar[XB_TMO], 1u); break; } }
  }
  nloc = mine > 0u ? mine : 1u; nx = cnt > 0u ? cnt : 1u;
}
DI void xcd_barrier(const XcdBarrier& b) {
  asm volatile("s_waitcnt vmcnt(0)" ::: "memory");
  __syncthreads();
  if (threadIdx.x == 0) {
    unsigned* bar = b.bar;
    __builtin_amdgcn_s_waitcnt(0);
    unsigned nloc = b.st[0], nx = b.st[1];
    if (nloc == 0u) { xcd_barrier_complete(bar, b.x, nloc, nx); b.st[0] = nloc; b.st[1] = nx; }
    const unsigned old = xb_add(&bar[XB_XSUB(b.x)], 1u);
    const unsigned gen = old / nloc;
    if (old + 1u == (gen + 1u) * nloc) {
      __builtin_amdgcn_fence(__ATOMIC_RELEASE, "agent");
      asm volatile("s_waitcnt vmcnt(0)" ::: "memory");
      const unsigned og = xb_add(&bar[XB_TOP], 1u);
      const unsigned tg = og / nx;
      if (og + 1u == (tg + 1u) * nx) xb_add(&bar[XB_TOPGEN], 1u);
      else XB_SPIN(xb_ld(&bar[XB_TOPGEN]) == tg, bar);
      __builtin_amdgcn_fence(__ATOMIC_ACQUIRE, "agent");
      xb_add(&bar[XB_XGEN(b.x)], 1u);
      asm volatile("s_waitcnt vmcnt(0)" ::: "memory");
    } else {
      XB_SPIN(xb_ld(&bar[XB_XGEN(b.x)]) == gen, bar);
      __builtin_amdgcn_fence(__ATOMIC_ACQUIRE, "agent");
      asm volatile("s_waitcnt vmcnt(0)" ::: "memory");
    }
  }
  __syncthreads();
}

__global__ void __launch_bounds__(NTHR, 2) mega(Params p) {
  __shared__ __attribute__((aligned(16))) char lds[73728];
  cg::grid_group grid = cg::this_grid();
  const int tid0 = threadIdx.x, bid0 = blockIdx.x, nb = gridDim.x;
  __shared__ uint4 xb_words;
  if (tid0 == 0) xb_words = make_uint4(0u, 0u, 0u, 0u);
  __syncthreads();
  const XcdBarrier xb = xcd_barrier_post(p.bar, (volatile LAS unsigned*)&xb_words);
  int pc = 0;
#define PHASE(...)                                      \
  {                                                     \
    if (pc >= p.pb && pc < p.pe) {                      \
      if (pc == p.pb + 1) grid.sync();                  \
      else if (pc > p.pb + 1) xcd_barrier(xb);          \
      int tid = tid0, bid = bid0;                       \
      asm volatile("" : "+v"(tid), "+s"(bid));          \
      __VA_ARGS__;                                      \
    }                                                   \
    pc++;                                               \
  }
  PHASE(phase_convert(p, lds, bid, nb, tid));
  for (int i = 0; i < REP_SYNC; i++) PHASE((void)0);
  for (int l = 0; l < 2; l++) {
    for (int sg = 0; sg < 3; sg++) {
      const int tok0 = sg * T_SUB;
      const int B = sg == 0 ? 4 : 8, N = sg == 0 ? 8192 : 4096;
      PHASE(phase_inproj(p, l, tok0, lds, bid, nb, tid));
#if REP_INPROJ || REP_GEMMS
      PHASE(phase_inproj(p, l, tok0, lds, bid, nb, tid));
#endif
      PHASE(phase_prep(p, l, N, bid, nb, tid));
      PHASE(phase_smallgemm(p, l, B, N, lds, bid, nb, tid));
#if REP_GEMMS
      PHASE(phase_smallgemm(p, l, B, N, lds, bid, nb, tid));
#endif
      PHASE(phase_mix(p, l, B, N, p.bar + XCD_BAR_WORDS + (l * 3 + sg) * 128, lds, bid, nb, tid));
#if REP_MIX
      PHASE(phase_mix(p, l, B, N, p.bar + XCD_BAR_WORDS + (6 + l * 3 + sg) * 128, lds, bid, nb, tid));
#endif
      PHASE(phase_final(p, l, bid, nb, tid));
      PHASE(phase_wout(p, l, tok0, lds, bid, nb, tid));
      PHASE(phase_ln<true>(p, p.ln1_g + l * 1024, p.ln1_b + l * 1024, p.moe_router + (size_t)l * 16384, tok0, T_SUB, lds, bid, nb, tid));
    }
    PHASE(phase_topk(p, lds, bid, nb, tid));
    PHASE(phase_moe1(p, l, lds, bid, nb, tid));
#if REP_MOE1 || REP_GEMMS
    PHASE(phase_moe1(p, l, lds, bid, nb, tid));
#endif
    PHASE(phase_moe2(p, l, lds, bid, nb, tid));
#if REP_GEMMS
    PHASE(phase_moe2(p, l, lds, bid, nb, tid));
#endif
    PHASE(phase_combine(p, bid, nb, tid));
    PHASE(phase_ple(p, l, lds, bid, nb, tid));
    PHASE(phase_ln<false>(p, p.ln2_g + l * 1024, p.ln2_b + l * 1024, nullptr, 0, T_ALL, lds, bid, nb, tid));
  }
}

#define N_PHASES 1000
#ifndef FUSED
#define FUSED 1
#endif

extern "C" void kernel_launch(void* const* d_in, const int* in_sizes, int n_in, void* d_out, int out_size, void* d_ws,
                              size_t ws_size, hipStream_t stream) {
  static int grid_blocks = 0;
  if (!grid_blocks) {
    int dev = 0, cus = 0, per_cu = 0;
    (void)hipGetDevice(&dev);
    (void)hipDeviceGetAttribute(&cus, hipDeviceAttributeMultiprocessorCount, dev);
    (void)hipOccupancyMaxActiveBlocksPerMultiprocessor(&per_cu, mega, NTHR, 0);
    if (per_cu > 2) per_cu = 2;
    if (per_cu < 1) per_cu = 1;
    grid_blocks = cus * per_cu;
  }
  Params p;
  memset(&p, 0, sizeof(p));
  const float* const* in = (const float* const*)d_in;
  int k = 0;
  p.x_prompt = in[k++]; p.x_sample = in[k++]; p.p_prompt = in[k++]; p.p_sample = in[k++];
  p.w_in = in[k++]; p.mla_gq = in[k++]; p.mla_gkv = in[k++]; p.mla_wuq = in[k++]; p.mla_wuk = in[k++]; p.mla_wuv = in[k++];
  p.na_bias = in[k++]; p.hg_lb = in[k++]; p.hg_gnorm = in[k++];
  p.rw_mu = in[k++]; p.rw_w0 = in[k++]; p.rw_w_up = in[k++]; p.rw_a0 = in[k++]; p.rw_a_up = in[k++]; p.rw_g_up = in[k++];
  p.rw_kk = in[k++]; p.rw_ka = in[k++]; p.rw_rk = in[k++]; p.rw_ln_w = in[k++]; p.rw_ln_b = in[k++];
  p.w_out = in[k++]; p.ln1_g = in[k++]; p.ln1_b = in[k++]; p.moe_router = in[k++]; p.moe_w1 = in[k++]; p.moe_w3 = in[k++];
  p.moe_w2 = in[k++]; p.ln2_g = in[k++]; p.ln2_b = in[k++]; p.ple_gate = in[k++]; p.ple_proj = in[k++];
  p.out = (float*)d_out;
  char* ws = (char*)d_ws;
  size_t off = 0;
  auto take = [&](size_t bytes) { char* r = ws + off; off += (bytes + 255) & ~(size_t)255; return r; };
  p.w_in_t = (u16*)take((size_t)2 * 3712 * 1024 * 2);
  p.wuq_t = (u16*)take((size_t)2 * 384 * 256 * 2);
  p.wkv_t = (u16*)take((size_t)2 * 512 * 128 * 2);
  p.wup_t = (u16*)take((size_t)4 * 256 * 64 * 2);
  p.aup_t = (u16*)take((size_t)4 * 256 * 64 * 2);
  p.gup_t = (u16*)take((size_t)2 * 256 * 128 * 2);
  p.wout_t = (u16*)take((size_t)2 * 1024 * 1024 * 2);
  p.w13_t = (u16*)take((size_t)32 * 1024 * 1024 * 2);
  p.w2_t = (u16*)take((size_t)32 * 1024 * 512 * 2);
  p.wg_t = (u16*)take((size_t)2 * 1024 * 1024 * 2);
  p.wp_t = (u16*)take((size_t)2 * 1024 * 256 * 2);
  p.ropec = (float*)take((size_t)8192 * 16 * 4);
  p.ropes = (float*)take((size_t)8192 * 16 * 4);
  p.lb = (float*)take(1024 * 4);
  p.affT = (float*)take((size_t)16 * T_ALL * 4);
  p.gate = (float*)take((size_t)196608 * 4);
  p.idx = (int*)take((size_t)196608 * 4);
  p.bar = (unsigned*)take((size_t)(XCD_BAR_WORDS + 12 * 128) * 4);
  p.inv_cnt = (int*)take((size_t)T_ALL * 4);
  p.inv_slot = (int*)take((size_t)T_ALL * 16 * 4);
  p.xb = (u16*)take((size_t)T_ALL * 1024 * 2);
  const size_t stage0 = off;
  p.z = (u16*)take((size_t)T_SUB * ZLD * 2);
  p.cat = (u16*)take((size_t)T_SUB * 1024 * 2);
  p.Q = (u16*)take((size_t)T_SUB * 384 * 2);
  p.Kb = (u16*)take((size_t)T_SUB * 384 * 2);
  p.Vt = (u16*)take((size_t)T_SUB * 256 * 2);
  p.cqn = (u16*)take((size_t)T_SUB * 256 * 2);
  p.ckvn = (u16*)take((size_t)T_SUB * 128 * 2);
  p.S1 = (u16*)take((size_t)T_SUB * 384 * 2);
  p.rs = (u16*)take((size_t)T_SUB * 256 * 2);
  p.ks = (u16*)take((size_t)T_SUB * 256 * 2);
  p.vs = (u16*)take((size_t)T_SUB * 256 * 2);
  p.kk = (u16*)take((size_t)T_SUB * 256 * 2);
  p.gD = (u16*)take((size_t)T_SUB * 256 * 2);
  p.dec = (u16*)take((size_t)2 * T_SUB * 256 * 2);
  p.kka = (u16*)take((size_t)2 * T_SUB * 256 * 2);
  p.kt = (u16*)take((size_t)2 * T_SUB * 256 * 2);
  p.oC = (u16*)take((size_t)2 * T_SUB * 256 * 2);
  p.oD = (u16*)take((size_t)2 * T_SUB * 256 * 2);
  p.bonus = (float*)take((size_t)T_SUB * 4 * 4);
  off = stage0;
  p.O = (u16*)take((size_t)196608 * 1024 * 2);
  p.H = (u16*)take((size_t)196608 * 512 * 2);
  for (int i = 0; i < 16; i++) p.inv_freq[i] = pow(10000.0, -(double)i / 16.0);
  (void)hipMemsetAsync(p.bar, 0, (size_t)(XCD_BAR_WORDS + 12 * 128) * 4, stream);
#if FUSED
  p.pb = 0;
  p.pe = N_PHASES;
  {
    void* args[] = {&p};
    hipError_t e = hipLaunchCooperativeKernel((void*)mega, dim3(grid_blocks), dim3(NTHR), args, 0, stream);
    if (e != hipSuccess) fprintf(stderr, "cooperative launch failed: %s (grid %d)\n", hipGetErrorString(e), grid_blocks);
  }
#else
  for (int ph = 0; ph < N_PHASES; ph++) {
    p.pb = ph;
    p.pe = ph + 1;
    void* args[] = {&p};
    hipError_t e = hipLaunchCooperativeKernel((void*)mega, dim3(grid_blocks), dim3(NTHR), args, 0, stream);
    if (e != hipSuccess) fprintf(stderr, "cooperative launch failed: %s (grid %d)\n", hipGetErrorString(e), grid_blocks);
  }
#endif
}
```

```cpp
#include <hip/hip_runtime.h>
#include <hip/hip_cooperative_groups.h>
#include <cstdio>
#include <cmath>
#include <cstring>
namespace cg = cooperative_groups;

typedef unsigned short u16;
using bf16x8 = __attribute__((ext_vector_type(8))) short;
using f32x4 = __attribute__((ext_vector_type(4))) float;
using f32x16 = __attribute__((ext_vector_type(16))) float;

#define REP_INPROJ 0
#define REP_ATTN 0
#define REP_NA 0
#define REP_SCAN 0
#define REP_MOE1 0
#define REP_MOE2 0
#define REP_SYNC 0
#define REP_MIX 0
#define REP_GEMMS 0
#define DI __device__ __forceinline__
#define NTHR 256
#define T_ALL 98304
#define T_SUB 32768
#define ZLD 3616
#define ZB_OFF 416
#define ZC_OFF 1184
#define ZD_OFF 2464
#define LOG2E 1.4426950408889634f
#define ALPHA_F 1.4142135623730951f

struct Params {
  const float *x_prompt, *x_sample, *p_prompt, *p_sample;
  const float *w_in, *mla_gq, *mla_gkv, *mla_wuq, *mla_wuk, *mla_wuv, *na_bias, *hg_lb, *hg_gnorm;
  const float *rw_mu, *rw_w0, *rw_w_up, *rw_a0, *rw_a_up, *rw_g_up, *rw_kk, *rw_ka, *rw_rk, *rw_ln_w, *rw_ln_b;
  const float *w_out, *ln1_g, *ln1_b, *moe_router, *moe_w1, *moe_w3, *moe_w2, *ln2_g, *ln2_b, *ple_gate, *ple_proj;
  float* out;
  u16 *w_in_t, *wuq_t, *wkv_t, *wup_t, *aup_t, *gup_t, *wout_t, *w13_t, *w2_t, *wg_t, *wp_t;
  float *ropec, *ropes, *lb, *affT, *gate;
  int* idx;
  unsigned* bar;
  int *inv_cnt, *inv_slot;
  u16 *z, *cat, *Q, *Kb, *Vt, *cqn, *ckvn, *S1, *rs, *ks, *vs, *kk, *gD, *dec, *kka, *kt, *oC, *oD;
  float* bonus;
  u16* xb;
  u16* O;
  u16* H;
  double inv_freq[16];
  int pb, pe;
};

typedef __bf16 v2bf_t __attribute__((ext_vector_type(2)));
typedef float v2f_t __attribute__((ext_vector_type(2)));
typedef unsigned u32x4_t __attribute__((ext_vector_type(4)));
DI unsigned pack2(float a, float b) {
  v2f_t f = {a, b};
  v2bf_t h = __builtin_convertvector(f, v2bf_t);
  return __builtin_bit_cast(unsigned, h);
}
DI u16 f2bf(float f) { return (u16)(pack2(f, 0.f) & 0xffffu); }
DI float bf2f(u16 h) { return __uint_as_float(((unsigned)h) << 16); }
DI float blo(unsigned u) { return __uint_as_float(u << 16); }
DI float bhi(unsigned u) { return __uint_as_float(u & 0xffff0000u); }
DI float sigm(float x) { return 1.f / (1.f + __expf(-x)); }
DI float tanh_(float x) { return 1.f - 2.f / (__expf(2.f * x) + 1.f); }
DI float ex2(float x) { return __builtin_amdgcn_exp2f(x); }
DI int clampi(int v, int lo, int hi) { return v < lo ? lo : (v > hi ? hi : v); }
DI int swap23(int x) { return (x & ~12) | ((x & 4) << 1) | ((x & 8) >> 1); }

template <int CTRL> DI float dpp_f(float v) {
  return __int_as_float(__builtin_amdgcn_update_dpp(0, __float_as_int(v), CTRL, 0xF, 0xF, true));
}
DI float reduce16(float v) {
  v += dpp_f<0xB1>(v);
  v += dpp_f<0x4E>(v);
  v += dpp_f<0x141>(v);
  v += dpp_f<0x140>(v);
  return v;
}
DI float wave_sum(float v) {
  v = reduce16(v);
  v += __shfl_xor(v, 16);
  v += __shfl_xor(v, 32);
  return v;
}

struct TileIter {
  int bid, nb, off;
  DI int first(int n) { int f = bid - off; if (f < 0) f += nb; off = (off + n) % nb; return f; }
};

DI bool xcd_tile(int it, int bid, int nb, int MT, int NT, int& mt, int& nt) {
  const int x = bid & 7, slot = bid >> 3, nslots = nb >> 3;
  const int mper = MT >> 3;
  const int i = slot + it * nslots;
  if (i >= mper * NT) return false;
  const int mi = i & 7, rest = i >> 3;
  nt = rest % NT;
  mt = x * mper + (rest / NT) * 8 + mi;
  return true;
}

DI void convT_job(const float* __restrict__ W, int K, int N, int Npad, u16* __restrict__ Wt, int mode, char* lds,
                  TileIter& it, int tid) {
  float(*tile)[65] = (float(*)[65])lds;
  int tk = K >> 6, tn = Npad >> 6;
  int nt = tk * tn;
  for (int t = it.first(nt); t < nt; t += it.nb) {
    int k0 = (t % tk) << 6, n0 = (t / tk) << 6;
#pragma unroll
    for (int i = 0; i < 16; i++) {
      int kl = (tid >> 6) + 4 * i, nl = tid & 63;
      int n = n0 + nl;
      tile[kl][nl] = (n < N) ? W[(size_t)(k0 + kl) * N + n] : 0.f;
    }
    __syncthreads();
    {
      int nl = tid >> 2, ks = (tid & 3) * 16;
      int n = n0 + nl;
      int row = n;
      if (mode == 1) row = (n >> 4) * 32 + (n & 15);
      if (mode == 2) row = (n >> 4) * 32 + 16 + (n & 15);
      unsigned pk[8];
#pragma unroll
      for (int j = 0; j < 8; j++) pk[j] = pack2(tile[ks + 2 * j][nl], tile[ks + 2 * j + 1][nl]);
      uint4* dst = (uint4*)(Wt + (size_t)row * K + k0 + ks);
      dst[0] = make_uint4(pk[0], pk[1], pk[2], pk[3]);
      dst[1] = make_uint4(pk[4], pk[5], pk[6], pk[7]);
    }
    __syncthreads();
  }
}

DI void phase_convert(const Params& p, char* lds, int bid, int nb, int tid) {
  TileIter it{bid, nb, 0};
  for (int l = 0; l < 2; l++) {
    convT_job(p.w_in + (size_t)l * 1024 * 3616, 1024, 3616, 3712, p.w_in_t + (size_t)l * 3712 * 1024, 0, lds, it, tid);
    convT_job(p.mla_wuq + (size_t)l * 256 * 384, 256, 384, 384, p.wuq_t + (size_t)l * 384 * 256, 0, lds, it, tid);
    convT_job(p.mla_wuk + (size_t)l * 128 * 256, 128, 256, 256, p.wkv_t + (size_t)l * 512 * 128, 0, lds, it, tid);
    convT_job(p.mla_wuv + (size_t)l * 128 * 256, 128, 256, 256, p.wkv_t + (size_t)l * 512 * 128 + 256 * 128, 0, lds, it, tid);
    for (int d = 0; d < 2; d++) {
      convT_job(p.rw_w_up + (size_t)(l * 2 + d) * 64 * 256, 64, 256, 256, p.wup_t + (size_t)(l * 2 + d) * 256 * 64, 0, lds, it, tid);
      convT_job(p.rw_a_up + (size_t)(l * 2 + d) * 64 * 256, 64, 256, 256, p.aup_t + (size_t)(l * 2 + d) * 256 * 64, 0, lds, it, tid);
    }
    convT_job(p.rw_g_up + (size_t)l * 128 * 256, 128, 256, 256, p.gup_t + (size_t)l * 256 * 128, 0, lds, it, tid);
    convT_job(p.w_out + (size_t)l * 1024 * 1024, 1024, 1024, 1024, p.wout_t + (size_t)l * 1024 * 1024, 0, lds, it, tid);
    for (int e = 0; e < 16; e++) {
      size_t le = (size_t)(l * 16 + e);
      convT_job(p.moe_w1 + le * 1024 * 512, 1024, 512, 512, p.w13_t + le * 1024 * 1024, 1, lds, it, tid);
      convT_job(p.moe_w3 + le * 1024 * 512, 1024, 512, 512, p.w13_t + le * 1024 * 1024, 2, lds, it, tid);
      convT_job(p.moe_w2 + le * 512 * 1024, 512, 1024, 1024, p.w2_t + le * 1024 * 512, 0, lds, it, tid);
    }
    convT_job(p.ple_gate + (size_t)l * 1024 * 1024, 1024, 1024, 1024, p.wg_t + (size_t)l * 1024 * 1024, 0, lds, it, tid);
    convT_job(p.ple_proj + (size_t)l * 256 * 1024, 256, 1024, 1024, p.wp_t + (size_t)l * 1024 * 256, 0, lds, it, tid);
  }
  int gt = bid * NTHR + tid, ng = nb * NTHR;
  for (size_t i0 = gt; i0 < (size_t)T_ALL * 256; i0 += (size_t)ng * 8) {
    float4 v[8];
#pragma unroll
    for (int u = 0; u < 8; u++) {
      const size_t i = i0 + (size_t)u * ng;
      v[u] = make_float4(0.f, 0.f, 0.f, 0.f);
      if (i < (size_t)T_ALL * 256)
        v[u] = (i < (size_t)32768 * 256) ? ((const float4*)p.x_prompt)[i] : ((const float4*)p.x_sample)[i - (size_t)32768 * 256];
    }
#pragma unroll
    for (int u = 0; u < 8; u++) {
      const size_t i = i0 + (size_t)u * ng;
      if (i < (size_t)T_ALL * 256) ((uint2*)p.xb)[i] = make_uint2(pack2(v[u].x, v[u].y), pack2(v[u].z, v[u].w));
    }
  }
  for (int i = gt; i < 8192 * 16; i += ng) {
    int n = i >> 4, f = i & 15;
    double ifq = 0.0;
#pragma unroll
    for (int j = 0; j < 16; j++) ifq = (f == j) ? p.inv_freq[j] : ifq;
    double rev = (double)n * ifq * 0.15915494309189535;
    double fr = rev - rint(rev);
    float ff = (float)fr;
    p.ropec[i] = __builtin_amdgcn_cosf(ff);
    p.ropes[i] = __builtin_amdgcn_sinf(ff);
  }
  for (int i = gt; i < 512; i += ng) {
    float h0 = p.hg_lb[i], h1 = p.hg_lb[512 + i];
    p.lb[i] = 0.f;
    p.lb[512 + i] = 1.f / (1.f + __expf(h0 - h1));
  }
}

constexpr int G_STAGE = 32768;

template <bool AF32, class RowFn, class Epi>
DI void gemm_tile(RowFn rowfn, const u16* __restrict__ Bt, int K, Epi epi, char* lds, int tid) {
  const int lane = tid & 63, wid = tid >> 6, wr = wid >> 1, wc = wid & 1, fr = lane & 15, fq = lane >> 4;
  f32x4 acc[4][4];
#pragma unroll
  for (int m = 0; m < 4; m++)
#pragma unroll
    for (int n = 0; n < 4; n++) acc[m][n] = f32x4{0.f, 0.f, 0.f, 0.f};

  const int lrow = tid >> 3;
  const int lc = (tid & 7) ^ ((tid >> 4) & 7);
  const float* apf[8];
  const u16* aph[4];
  const u16* bp[4];
  if constexpr (AF32) {
#pragma unroll
    for (int i = 0; i < 8; i++) apf[i] = (const float*)rowfn(i * 16 + (tid >> 4)) + (tid & 15) * 4;
  } else {
#pragma unroll
    for (int i = 0; i < 4; i++) aph[i] = (const u16*)rowfn(lrow + i * 32) + lc * 8;
  }
#pragma unroll
  for (int i = 0; i < 4; i++) bp[i] = Bt + (size_t)(lrow + i * 32) * K + lc * 8;
  const int afoff = (tid >> 4) * 128 + ((((tid & 15) >> 1) ^ ((tid >> 5) & 7)) * 16) + (tid & 1) * 8;

  float4 raf[8];
  auto issue = [&](int buf, int k0) {
    char* A = lds + buf * G_STAGE;
    char* B = A + 16384;
#pragma unroll
    for (int i = 0; i < 4; i++)
      __builtin_amdgcn_global_load_lds((const unsigned*)(bp[i] + k0), (unsigned*)(B + wid * 1024 + i * 4096), 16, 0, 0);
    if constexpr (AF32) {
#pragma unroll
      for (int i = 0; i < 8; i++) raf[i] = *(const float4*)(apf[i] + k0);
    } else {
#pragma unroll
      for (int i = 0; i < 4; i++)
        __builtin_amdgcn_global_load_lds((const unsigned*)(aph[i] + k0), (unsigned*)(A + wid * 1024 + i * 4096), 16, 0, 0);
    }
  };
  auto astore = [&](int buf) {
    if constexpr (AF32) {
      char* A = lds + buf * G_STAGE;
#pragma unroll
      for (int i = 0; i < 8; i++) asm volatile("" : "+v"(raf[i].x), "+v"(raf[i].y), "+v"(raf[i].z), "+v"(raf[i].w));
#pragma unroll
      for (int i = 0; i < 8; i++)
        *(uint2*)(A + afoff + i * 2048) = make_uint2(pack2(raf[i].x, raf[i].y), pack2(raf[i].z, raf[i].w));
    }
  };
  const int abase = (wr * 64 + fr) * 128, bbase = 16384 + (wc * 64 + fr) * 128;
  const int sw0 = ((fq) ^ (fr >> 1)) * 16, sw1 = ((4 + fq) ^ (fr >> 1)) * 16;

  const int nk = K >> 6;
  issue(0, 0);
  astore(0);
  __syncthreads();
  for (int kt = 0; kt < nk; kt++) {
    if (kt + 1 < nk) issue((kt + 1) & 1, (kt + 1) << 6);
    __builtin_amdgcn_sched_barrier(0);
    const char* S = lds + (kt & 1) * G_STAGE;
    bf16x8 af[2][4], bfr[2][4];
#pragma unroll
    for (int kk = 0; kk < 2; kk++) {
      const int sw = kk ? sw1 : sw0;
#pragma unroll
      for (int m = 0; m < 4; m++) af[kk][m] = *(const bf16x8*)(S + abase + m * 2048 + sw);
#pragma unroll
      for (int n = 0; n < 4; n++) bfr[kk][n] = *(const bf16x8*)(S + bbase + n * 2048 + sw);
    }
    __builtin_amdgcn_sched_barrier(0);
#pragma unroll
    for (int kk = 0; kk < 2; kk++)
#pragma unroll
      for (int m = 0; m < 4; m++)
#pragma unroll
        for (int n = 0; n < 4; n++) acc[m][n] = __builtin_amdgcn_mfma_f32_16x16x32_bf16(bfr[kk][n], af[kk][m], acc[m][n], 0, 0, 0);
    __builtin_amdgcn_sched_barrier(0);
    if (kt + 1 < nk) astore((kt + 1) & 1);
    __syncthreads();
  }
  epi(acc, wr * 64 + fr, wc * 64 + fq * 4);
}

#define EPI_LOOP(...)                                    \
  _Pragma("unroll") for (int m = 0; m < 4; m++)          \
  _Pragma("unroll") for (int n = 0; n < 4; n++) {        \
    const int row = rbase + m * 16;                      \
    const int col = cbase + n * 16;                      \
    const f32x4 v = acc[m][n];                           \
    __VA_ARGS__                                          \
  }

DI void st_bf4(u16* dst, f32x4 v) { *(uint2*)dst = make_uint2(pack2(v[0], v[1]), pack2(v[2], v[3])); }

DI const float* xin_row(const Params& p, int l, int tg) {
  if (l == 0) return tg < 32768 ? p.x_prompt + (size_t)tg * 1024 : p.x_sample + (size_t)(tg - 32768) * 1024;
  return p.out + (size_t)tg * 1024;
}

DI void phase_inproj(const Params& p, int l, int tok0, char* lds, int bid, int nb, int tid) {
  const int NT = 29, MT = T_SUB / 128;
  for (int it = 0;; it++) {
    int nt, mt;
    if (!xcd_tile(it, bid, nb, MT, NT, mt, nt)) break;
    int m0 = mt * 128, n0 = nt * 128;
    auto rowfn = [&](int r) -> const void* { return p.xb + (size_t)(tok0 + m0 + r) * 1024; };
    u16* z = p.z;
    auto epi = [&](f32x4(&acc)[4][4], int rbase, int cbase) {
      EPI_LOOP({
        int c = n0 + col;
        if (c < ZLD) st_bf4(z + (size_t)(m0 + row) * ZLD + c, v);
      })
    };
    gemm_tile<false>(rowfn, p.w_in_t + ((size_t)l * 3712 + n0) * 1024, 1024, epi, lds, tid);
  }
}

struct PrepIn {
  uint2 cq;
  unsigned ckv;
  u16 kr1, kr2;
  float rc, rsn;
  uint4 f;
  uint2 cur[3], prv[3], nxt[3];
  u16 sc[6], sp[6], sn[6];
};
DI void prep_load(PrepIn& in, const Params& p, int t, int N, int lane) {
  const int l15 = lane & 15, c4 = lane * 4;
  const u16* zr = p.z + (size_t)t * ZLD;
  const int n = t & (N - 1);
  const bool hp = n > 0, hn = n < N - 1;
  const u16* zd = zr + ZD_OFF;
  const u16* zdp = zd - (hp ? ZLD : 0);
  const u16* zdn = zd + (hn ? ZLD : 0);
  in.cq = *(const uint2*)(zr + c4);
  in.ckv = *(const unsigned*)(zr + 256 + lane * 2);
  in.kr1 = zr[384 + l15];
  in.kr2 = zr[400 + l15];
  in.rc = p.ropec[n * 16 + l15];
  in.rsn = p.ropes[n * 16 + l15];
  in.f = *(const uint4*)(zr + ZC_OFF + 256 + lane * 8);
#pragma unroll
  for (int part = 0; part < 3; part++) {
    in.cur[part] = *(const uint2*)(zd + part * 256 + c4);
    in.prv[part] = *(const uint2*)(zdp + part * 256 + c4);
    in.nxt[part] = *(const uint2*)(zdn + part * 256 + c4);
  }
#pragma unroll
  for (int i = 0; i < 6; i++) {
    in.sc[i] = zd[768 + lane + 64 * i];
    in.sp[i] = zdp[768 + lane + 64 * i];
    in.sn[i] = zdn[768 + lane + 64 * i];
  }
}

DI void phase_prep(const Params& p, int l, int N, int bid, int nb, int tid) {
  const int lane = tid & 63, wv = tid >> 6, l15 = lane & 15, c4 = lane * 4;
  float gqv[4], gkvv[2], lbv[8], m0[12], m1[12], m0s[6], m1s[6], kkc[4], rkc[4];
  {
    const float* mu0 = p.rw_mu + (size_t)l * 2 * 1152;
    const float* mu1 = mu0 + 1152;
#pragma unroll
    for (int j = 0; j < 4; j++) {
      gqv[j] = p.mla_gq[l * 256 + c4 + j];
      kkc[j] = p.rw_kk[l * 256 + c4 + j];
      rkc[j] = p.rw_rk[l * 256 + c4 + j];
    }
    gkvv[0] = p.mla_gkv[l * 128 + lane * 2];
    gkvv[1] = p.mla_gkv[l * 128 + lane * 2 + 1];
#pragma unroll
    for (int j = 0; j < 8; j++) lbv[j] = p.lb[l * 512 + lane * 8 + j];
#pragma unroll
    for (int part = 0; part < 3; part++)
#pragma unroll
      for (int j = 0; j < 4; j++) {
        m0[part * 4 + j] = mu0[part * 256 + c4 + j];
        m1[part * 4 + j] = mu1[part * 256 + c4 + j];
      }
#pragma unroll
    for (int i = 0; i < 6; i++) {
      m0s[i] = mu0[768 + lane + 64 * i];
      m1s[i] = mu1[768 + lane + 64 * i];
    }
  }
  PrepIn in, inn;
  {
    const int t0 = bid * 4 + wv;
    if (t0 < T_SUB) prep_load(in, p, t0, N, lane);
  }
  for (int t = bid * 4 + wv; t < T_SUB; t += nb * 4) {
    u16* zr = p.z + (size_t)t * ZLD;
    const int n = t & (N - 1);
    const bool hp = n > 0, hn = n < N - 1;
    {
      const int tn = t + nb * 4;
      if (tn < T_SUB) prep_load(inn, p, tn, N, lane);
      else inn = in;
    }
    const uint2 raw_cq = in.cq;
    const unsigned raw_ckv = in.ckv;
    const u16 kr1 = in.kr1, kr2 = in.kr2;
    const float rc = in.rc, rsn = in.rsn;
    uint4* fptr = (uint4*)(zr + ZC_OFF + 256 + lane * 8);
    const uint4 raw_f = in.f;
    uint2 cur[3], prv[3], nxt[3];
    u16 sc[6], sp[6], sn[6];
#pragma unroll
    for (int part = 0; part < 3; part++) { cur[part] = in.cur[part]; prv[part] = in.prv[part]; nxt[part] = in.nxt[part]; }
#pragma unroll
    for (int i = 0; i < 6; i++) { sc[i] = in.sc[i]; sp[i] = in.sp[i]; sn[i] = in.sn[i]; }
    {
      float v0 = blo(raw_cq.x), v1 = bhi(raw_cq.x), v2 = blo(raw_cq.y), v3 = bhi(raw_cq.y);
      float ss = wave_sum(v0 * v0 + v1 * v1 + v2 * v2 + v3 * v3);
      float ri = rsqrtf(ss * (1.f / 256.f) + 1e-6f);
      *(uint2*)(p.cqn + (size_t)t * 256 + c4) =
          make_uint2(pack2(v0 * ri * gqv[0], v1 * ri * gqv[1]), pack2(v2 * ri * gqv[2], v3 * ri * gqv[3]));
    }
    {
      float v0 = blo(raw_ckv), v1 = bhi(raw_ckv);
      float ss = wave_sum(v0 * v0 + v1 * v1);
      float ri = rsqrtf(ss * (1.f / 128.f) + 1e-6f);
      *(unsigned*)(p.ckvn + (size_t)t * 128 + lane * 2) = pack2(v0 * ri * gkvv[0], v1 * ri * gkvv[1]);
    }
    if (lane < 16) {
      float x1 = bf2f(kr1), x2 = bf2f(kr2);
      u16 k1 = f2bf(x1 * rc - x2 * rsn), k2 = f2bf(x1 * rsn + x2 * rc);
      u16* kb = p.Kb + (size_t)t * 384;
#pragma unroll
      for (int h = 0; h < 4; h++) {
        kb[h * 96 + 64 + lane] = k1;
        kb[h * 96 + 80 + lane] = k2;
      }
    }
    {
      unsigned w[4] = {raw_f.x, raw_f.y, raw_f.z, raw_f.w};
#pragma unroll
      for (int j = 0; j < 4; j++) {
        float a = blo(w[j]), bq = bhi(w[j]);
        float la = lbv[2 * j], lb2 = lbv[2 * j + 1];
        a = la + (1.f - la) * sigm(a);
        bq = lb2 + (1.f - lb2) * sigm(bq);
        w[j] = pack2(a, bq);
      }
      *fptr = make_uint4(w[0], w[1], w[2], w[3]);
    }
    {
      float rr[4], kx[4], vx[4];
#pragma unroll
      for (int part = 0; part < 3; part++) {
        float cz[4] = {blo(cur[part].x), bhi(cur[part].x), blo(cur[part].y), bhi(cur[part].y)};
        float pz[4] = {blo(prv[part].x), bhi(prv[part].x), blo(prv[part].y), bhi(prv[part].y)};
        float nz[4] = {blo(nxt[part].x), bhi(nxt[part].x), blo(nxt[part].y), bhi(nxt[part].y)};
#pragma unroll
        for (int j = 0; j < 4; j++) {
          float pzz = hp ? pz[j] : 0.f, nzz = hn ? nz[j] : 0.f;
          float o = cz[j] + m0[part * 4 + j] * (pzz - cz[j]) + m1[part * 4 + j] * (nzz - cz[j]);
          if (part == 0) rr[j] = o;
          if (part == 1) kx[j] = o;
          if (part == 2) vx[j] = o;
        }
      }
      *(uint2*)(p.rs + (size_t)t * 256 + c4) = make_uint2(pack2(rr[0], rr[1]), pack2(rr[2], rr[3]));
      *(uint2*)(p.ks + (size_t)t * 256 + c4) = make_uint2(pack2(kx[0], kx[1]), pack2(kx[2], kx[3]));
      *(uint2*)(p.vs + (size_t)t * 256 + c4) = make_uint2(pack2(vx[0], vx[1]), pack2(vx[2], vx[3]));
      float kq[4], ss = 0.f, bo = 0.f;
#pragma unroll
      for (int j = 0; j < 4; j++) {
        kq[j] = kx[j] * kkc[j];
        ss += kq[j] * kq[j];
        bo += rr[j] * kx[j] * rkc[j];
      }
      ss = reduce16(ss);
      bo = reduce16(bo);
      float inv = 1.f / fmaxf(sqrtf(ss), 1e-12f);
      *(uint2*)(p.kk + (size_t)t * 256 + c4) = make_uint2(pack2(kq[0] * inv, kq[1] * inv), pack2(kq[2] * inv, kq[3] * inv));
      if (l15 == 0) p.bonus[(size_t)t * 4 + (lane >> 4)] = bo;
#pragma unroll
      for (int i = 0; i < 6; i++) {
        float cz = bf2f(sc[i]);
        float pz = hp ? bf2f(sp[i]) : 0.f;
        float nz = hn ? bf2f(sn[i]) : 0.f;
        float o = cz + m0s[i] * (pz - cz) + m1s[i] * (nz - cz);
        if (i < 2) o = tanh_(o);
        else if (i >= 4) o = sigm(o);
        p.S1[(size_t)t * 384 + lane + 64 * i] = f2bf(o);
      }
    }
    in = inn;
  }
}

DI void phase_smallgemm(const Params& p, int l, int B, int N, char* lds, int bid, int nb, int tid) {
  TileIter it{bid, nb, 0};
  const int MT = T_SUB / 128;
  {
    const int NT = 3;
    for (int itx = 0;; itx++) {
      int nt, mt;
      if (!xcd_tile(itx, bid, nb, MT, NT, mt, nt)) break;
      int m0 = mt * 128, n0 = nt * 128;
      auto rowfn = [&](int r) -> const void* { return p.cqn + (size_t)(m0 + r) * 256; };
      u16* Q = p.Q;
      auto epi = [&](f32x4(&acc)[4][4], int rbase, int cbase) {
        const float SC = 0.10206207261596577f * LOG2E;
        EPI_LOOP({ st_bf4(Q + (size_t)(m0 + row) * 384 + n0 + col, v * SC); })
      };
      gemm_tile<false>(rowfn, p.wuq_t + ((size_t)l * 384 + n0) * 256, 256, epi, lds, tid);
    }
  }
  {
    const int NT = 4;
    for (int itx = 0;; itx++) {
      int nt, mt;
      if (!xcd_tile(itx, bid, nb, MT, NT, mt, nt)) break;
      int m0 = mt * 128, n0 = nt * 128;
      auto rowfn = [&](int r) -> const void* { return p.ckvn + (size_t)(m0 + r) * 128; };
      u16* Kb = p.Kb;
      u16* Vt = p.Vt;
      auto epi = [&](f32x4(&acc)[4][4], int rbase, int cbase) {
        EPI_LOOP({
          int c = n0 + col;
          int tk = m0 + row;
          if (c < 256) {
            int h = c >> 6, d = c & 63;
            st_bf4(Kb + (size_t)tk * 384 + h * 96 + d, v);
          } else {
            int cc = c - 256;
            int b = tk / N, nn = tk - b * N;
            u16* dst = Vt + ((size_t)(b * 256 + cc)) * N + nn;
            dst[0] = f2bf(v[0]);
            dst[(size_t)N] = f2bf(v[1]);
            dst[(size_t)2 * N] = f2bf(v[2]);
            dst[(size_t)3 * N] = f2bf(v[3]);
          }
        })
      };
      gemm_tile<false>(rowfn, p.wkv_t + ((size_t)l * 512 + n0) * 128, 128, epi, lds, tid);
    }
  }
  for (int d = 0; d < 2; d++) {
    const int NT = 2;
    for (int itx = 0;; itx++) {
      int nt, mt;
      if (!xcd_tile(itx, bid, nb, MT, NT, mt, nt)) break;
      int m0 = mt * 128, n0 = nt * 128;
      auto rowfn = [&](int r) -> const void* { return p.S1 + (size_t)(m0 + r) * 384 + d * 64; };
      u16* dst = p.dec + (size_t)d * T_SUB * 256;
      const float* w0 = p.rw_w0 + (l * 2 + d) * 256;
      auto epi = [&](f32x4(&acc)[4][4], int rbase, int cbase) {
        EPI_LOOP({
          f32x4 o;
          for (int j = 0; j < 4; j++) o[j] = __expf(-0.6065306597126334f * sigm(w0[n0 + col + j] + v[j]));
          st_bf4(dst + (size_t)(m0 + row) * 256 + n0 + col, o);
        })
      };
      gemm_tile<false>(rowfn, p.wup_t + ((size_t)(l * 2 + d) * 256 + n0) * 64, 64, epi, lds, tid);
    }
  }
  for (int d = 0; d < 2; d++) {
    const int NT = 2;
    for (int itx = 0;; itx++) {
      int nt, mt;
      if (!xcd_tile(itx, bid, nb, MT, NT, mt, nt)) break;
      int m0 = mt * 128, n0 = nt * 128;
      auto rowfn = [&](int r) -> const void* { return p.S1 + (size_t)(m0 + r) * 384 + 128 + d * 64; };
      u16* dka = p.kka + (size_t)d * T_SUB * 256;
      u16* dkt = p.kt + (size_t)d * T_SUB * 256;
      const float* a0 = p.rw_a0 + (l * 2 + d) * 256;
      const float* ka = p.rw_ka + l * 256;
      const u16* kkp = p.kk;
      const u16* ksp = p.ks;
      auto epi = [&](f32x4(&acc)[4][4], int rbase, int cbase) {
        EPI_LOOP({
          size_t o = (size_t)(m0 + row) * 256 + n0 + col;
          uint2 kkr = *(const uint2*)(kkp + o);
          uint2 ksr = *(const uint2*)(ksp + o);
          float kkv[4] = {blo(kkr.x), bhi(kkr.x), blo(kkr.y), bhi(kkr.y)};
          float ksv[4] = {blo(ksr.x), bhi(ksr.x), blo(ksr.y), bhi(ksr.y)};
          f32x4 o1, o2;
          for (int j = 0; j < 4; j++) {
            float a = sigm(a0[n0 + col + j] + v[j]);
            o1[j] = kkv[j] * a;
            o2[j] = ksv[j] * (1.f + (a - 1.f) * ka[n0 + col + j]);
          }
          st_bf4(dka + o, o1);
          st_bf4(dkt + o, o2);
        })
      };
      gemm_tile<false>(rowfn, p.aup_t + ((size_t)(l * 2 + d) * 256 + n0) * 64, 64, epi, lds, tid);
    }
  }
  {
    const int NT = 2;
    for (int itx = 0;; itx++) {
      int nt, mt;
      if (!xcd_tile(itx, bid, nb, MT, NT, mt, nt)) break;
      int m0 = mt * 128, n0 = nt * 128;
      auto rowfn = [&](int r) -> const void* { return p.S1 + (size_t)(m0 + r) * 384 + 256; };
      u16* dst = p.gD;
      auto epi = [&](f32x4(&acc)[4][4], int rbase, int cbase) {
        EPI_LOOP({ st_bf4(dst + (size_t)(m0 + row) * 256 + n0 + col, v); })
      };
      gemm_tile<false>(rowfn, p.gup_t + ((size_t)l * 256 + n0) * 128, 128, epi, lds, tid);
    }
  }
}

DI bf16x8 pack8(const f32x16& s, int o) {
  u32x4_t r = {pack2(s[o], s[o + 1]), pack2(s[o + 2], s[o + 3]), pack2(s[o + 4], s[o + 5]), pack2(s[o + 6], s[o + 7])};
  return __builtin_bit_cast(bf16x8, r);
}

constexpr int AT_KP = 208, AT_VP = 144, AT_BUF = 64 * AT_KP + 64 * AT_VP;
DI void attn_task(const Params& p, int task, int N, char* lds, int tid) {
  const int lane = tid & 63, wv = tid >> 6, r = lane & 31, hf = lane >> 5;
  const int nqb = N >> 7;
  {
    const int qb = task % nqb, bh = task / nqb, h = bh & 3, b = bh >> 2;
    const size_t tb = (size_t)b * N;
    const int q = qb * 128 + wv * 32 + r;
    bf16x8 qf[6];
    {
      const u16* qrow = p.Q + (tb + q) * 384 + h * 96;
#pragma unroll
      for (int ks = 0; ks < 4; ks++) qf[ks] = *(const bf16x8*)(qrow + ks * 16 + hf * 8);
      bf16x8 x1r = *(const bf16x8*)(qrow + 64 + hf * 8);
      bf16x8 x2r = *(const bf16x8*)(qrow + 80 + hf * 8);
      const float* cp = p.ropec + q * 16 + hf * 8;
      const float* sp = p.ropes + q * 16 + hf * 8;
      float ra[8], rb[8];
#pragma unroll
      for (int j = 0; j < 8; j++) {
        float xa = bf2f((u16)x1r[j]), ya = bf2f((u16)x2r[j]);
        float c0 = cp[j], s0 = sp[j];
        ra[j] = xa * c0 - ya * s0;
        rb[j] = xa * s0 + ya * c0;
      }
      u32x4_t o1 = {pack2(ra[0], ra[1]), pack2(ra[2], ra[3]), pack2(ra[4], ra[5]), pack2(ra[6], ra[7])};
      u32x4_t o2 = {pack2(rb[0], rb[1]), pack2(rb[2], rb[3]), pack2(rb[4], rb[5]), pack2(rb[6], rb[7])};
      qf[4] = __builtin_bit_cast(bf16x8, o1);
      qf[5] = __builtin_bit_cast(bf16x8, o2);
    }
    const u16* Kg = p.Kb + tb * 384 + h * 96;
    const u16* Vg = p.Vt + ((size_t)(b * 4 + h) * 64) * N;
    uint4 kr0, kr1, kr2, vr0, vr1;
    const int lkey = tid >> 2, lpart = tid & 3;
    const int lrow = swap23(lkey);
#define AT_GLOAD(kt_)                                                              \
  {                                                                                \
    const u16* kp_ = Kg + (size_t)((kt_) * 64 + lkey) * 384 + lpart * 24;          \
    kr0 = *(const uint4*)(kp_);                                                    \
    kr1 = *(const uint4*)(kp_ + 8);                                                \
    kr2 = *(const uint4*)(kp_ + 16);                                               \
    const u16* vp_ = Vg + (size_t)lkey * N + (kt_) * 64 + lpart * 16;              \
    vr0 = *(const uint4*)(vp_);                                                    \
    vr1 = *(const uint4*)(vp_ + 8);                                                \
  }
#define AT_LSTORE(buf_)                                                            \
  {                                                                                \
    char* Kl_ = lds + (buf_) * AT_BUF;                                             \
    char* Vl_ = Kl_ + 64 * AT_KP;                                                  \
    *(uint4*)(Kl_ + lrow * AT_KP + (lpart * 3 + 0) * 16) = kr0;                    \
    *(uint4*)(Kl_ + lrow * AT_KP + (lpart * 3 + 1) * 16) = kr1;                    \
    *(uint4*)(Kl_ + lrow * AT_KP + (lpart * 3 + 2) * 16) = kr2;                    \
    *(uint4*)(Vl_ + lkey * AT_VP + (lpart * 2 + 0) * 16) = vr0;                    \
    *(uint4*)(Vl_ + lkey * AT_VP + (lpart * 2 + 1) * 16) = vr1;                    \
  }
    f32x16 O0, O1;
#pragma unroll
    for (int i = 0; i < 16; i++) { O0[i] = 0.f; O1[i] = 0.f; }
    float mrun = 0.f, lrun = 0.f;
    const int nt = N >> 6;
    __syncthreads();
    AT_GLOAD(0);
    AT_LSTORE(0);
    __syncthreads();
    for (int kt = 0; kt < nt; kt++) {
      if (kt + 1 < nt) AT_GLOAD(kt + 1);
      __builtin_amdgcn_sched_barrier(0);
      const char* Kl = lds + (kt & 1) * AT_BUF;
      const char* Vl = Kl + 64 * AT_KP;
      f32x16 S0, S1;
      {
        const float nm = -mrun;
#pragma unroll
        for (int i = 0; i < 16; i++) { S0[i] = nm; S1[i] = nm; }
      }
#pragma unroll
      for (int ks = 0; ks < 6; ks++) {
        bf16x8 a0 = *(const bf16x8*)(Kl + r * AT_KP + ks * 32 + hf * 16);
        bf16x8 a1 = *(const bf16x8*)(Kl + (32 + r) * AT_KP + ks * 32 + hf * 16);
        S0 = __builtin_amdgcn_mfma_f32_32x32x16_bf16(a0, qf[ks], S0, 0, 0, 0);
        S1 = __builtin_amdgcn_mfma_f32_32x32x16_bf16(a1, qf[ks], S1, 0, 0, 0);
      }
      float mx = fmaxf(S0[0], S1[0]);
#pragma unroll
      for (int i = 1; i < 16; i++) mx = fmaxf(mx, fmaxf(S0[i], S1[i]));
      if (__any((mx > 12.f) || (kt == 0))) {
        const float mq = fmaxf(mx, __shfl_xor(mx, 32));
        const float shift = (kt == 0) ? mq : ((mq > 12.f) ? mq : 0.f);
        const float sc = (kt == 0) ? 1.f : ex2(-shift);
        mrun += shift;
        lrun *= sc;
#pragma unroll
        for (int i = 0; i < 16; i++) {
          S0[i] -= shift;
          S1[i] -= shift;
          O0[i] *= sc;
          O1[i] *= sc;
        }
      }
      float ls = 0.f;
#pragma unroll
      for (int i = 0; i < 16; i++) {
        S0[i] = ex2(S0[i]);
        S1[i] = ex2(S1[i]);
        ls += S0[i] + S1[i];
      }
      lrun += ls;
#pragma unroll
      for (int sp = 0; sp < 4; sp++) {
        bf16x8 pb = (sp < 2) ? pack8(S0, (sp & 1) * 8) : pack8(S1, (sp & 1) * 8);
        bf16x8 v0 = *(const bf16x8*)(Vl + r * AT_VP + sp * 32 + hf * 16);
        bf16x8 v1 = *(const bf16x8*)(Vl + (32 + r) * AT_VP + sp * 32 + hf * 16);
        O0 = __builtin_amdgcn_mfma_f32_32x32x16_bf16(v0, pb, O0, 0, 0, 0);
        O1 = __builtin_amdgcn_mfma_f32_32x32x16_bf16(v1, pb, O1, 0, 0, 0);
      }
      __builtin_amdgcn_sched_barrier(0);
      if (kt + 1 < nt) AT_LSTORE((kt + 1) & 1);
      __syncthreads();
    }
    float lt = lrun + __shfl_xor(lrun, 32);
    float inv = 1.f / lt;
    u16* orow = p.cat + (tb + q) * 1024 + h * 64;
#pragma unroll
    for (int g = 0; g < 4; g++) {
      int d0 = 8 * g + 4 * hf;
      *(uint2*)(orow + d0) = make_uint2(pack2(O0[4 * g] * inv, O0[4 * g + 1] * inv), pack2(O0[4 * g + 2] * inv, O0[4 * g + 3] * inv));
      *(uint2*)(orow + 32 + d0) = make_uint2(pack2(O1[4 * g] * inv, O1[4 * g + 1] * inv), pack2(O1[4 * g + 2] * inv, O1[4 * g + 3] * inv));
    }
  }
}

DI void na_task(const Params& p, int l, int task, int N, int tid) {
  const int lane = tid & 63, head = tid >> 6, r = lane & 31, hf = lane >> 5;
  const int rows = N >> 6;
  const int nrb = rows >> 1;
  const float* bias = p.na_bias + (size_t)(l * 4 + head) * 15 * 31;
  {
    const int cb = task & 3, rb = (task >> 2) % nrb, b = (task >> 2) / nrb;
    const size_t tb = (size_t)b * N;
    const int qrow0 = rb * 2;
    const int rstart0 = clampi(qrow0 - 4, 0, rows - 8);
    const int k0 = clampi(rstart0, 0, rows - 9);
    const int kstart = clampi(cb * 16 - 8, 0, 32);
    const int iq = r >> 4, u = r & 15;
    const int qrow = qrow0 + iq, qcol = cb * 16 + u;
    const int rstart = clampi(qrow - 4, 0, rows - 8);
    const int cstart = clampi(qcol - 8, 0, 48);
    bf16x8 qf[4];
    {
      const u16* qp = p.z + (tb + qrow * 64 + qcol) * ZLD + ZB_OFF + head * 64;
#pragma unroll
      for (int ks = 0; ks < 4; ks++) qf[ks] = *(const bf16x8*)(qp + ks * 16 + hf * 8);
    }
    f32x16 O0, O1;
#pragma unroll
    for (int i = 0; i < 16; i++) { O0[i] = 0.f; O1[i] = 0.f; }
    float mrun = -1e30f, lrun = 0.f;
    const int wk = swap23(r);
    for (int j = 0; j < 9; j++) {
      const int krow = k0 + j;
      const u16* kp = p.z + (tb + krow * 64 + kstart + wk) * ZLD + ZB_OFF + 256 + head * 64;
      f32x16 S;
#pragma unroll
      for (int i = 0; i < 16; i++) S[i] = 0.f;
#pragma unroll
      for (int ks = 0; ks < 4; ks++) {
        bf16x8 a = *(const bf16x8*)(kp + ks * 16 + hf * 8);
        S = __builtin_amdgcn_mfma_f32_32x32x16_bf16(a, qf[ks], S, 0, 0, 0);
      }
      const bool rok = (krow >= rstart) && (krow < rstart + 8);
      const int drow = clampi(krow - qrow + 7, 0, 14);
      const float* brow = bias + drow * 31;
      float mx = -1e30f;
#pragma unroll
      for (int i = 0; i < 16; i++) {
        int w = 16 * (i >> 3) + 8 * hf + 4 * ((i >> 2) & 1) + (i & 3);
        int kcol = kstart + w;
        bool ok = rok && (kcol >= cstart) && (kcol < cstart + 16);
        int dcol = clampi(kcol - qcol + 15, 0, 30);
        float s = (S[i] * 0.125f + brow[dcol]) * LOG2E;
        S[i] = ok ? s : -1e30f;
        mx = fmaxf(mx, S[i]);
      }
      mx = fmaxf(mx, __shfl_xor(mx, 32));
      float mn = fmaxf(mrun, mx);
      float alpha = ex2(mrun - mn);
      mrun = mn;
      float ls = 0.f;
#pragma unroll
      for (int i = 0; i < 16; i++) {
        float pv = (S[i] > -1e29f) ? ex2(S[i] - mn) : 0.f;
        S[i] = pv;
        ls += pv;
      }
      lrun = lrun * alpha + ls;
#pragma unroll
      for (int i = 0; i < 16; i++) { O0[i] *= alpha; O1[i] *= alpha; }
      const u16* vbase = p.z + (tb + krow * 64 + kstart) * ZLD + ZB_OFF + 512 + head * 64 + r;
#pragma unroll
      for (int s = 0; s < 2; s++) {
        bf16x8 pb = pack8(S, s * 8);
        bf16x8 v0, v1;
#pragma unroll
        for (int jj = 0; jj < 8; jj++) {
          const u16* vp = vbase + (size_t)(16 * s + 8 * hf + jj) * ZLD;
          v0[jj] = (short)vp[0];
          v1[jj] = (short)vp[32];
        }
        O0 = __builtin_amdgcn_mfma_f32_32x32x16_bf16(v0, pb, O0, 0, 0, 0);
        O1 = __builtin_amdgcn_mfma_f32_32x32x16_bf16(v1, pb, O1, 0, 0, 0);
      }
    }
    float lt = lrun + __shfl_xor(lrun, 32);
    float inv = 1.f / lt;
    u16* orow = p.cat + (tb + qrow * 64 + qcol) * 1024 + 256 + head * 64;
#pragma unroll
    for (int g = 0; g < 4; g++) {
      int d0 = 8 * g + 4 * hf;
      *(uint2*)(orow + d0) = make_uint2(pack2(O0[4 * g] * inv, O0[4 * g + 1] * inv), pack2(O0[4 * g + 2] * inv, O0[4 * g + 3] * inv));
      *(uint2*)(orow + 32 + d0) = make_uint2(pack2(O1[4 * g] * inv, O1[4 * g + 1] * inv), pack2(O1[4 * g + 2] * inv, O1[4 * g + 3] * inv));
    }
  }
}

using f32x2 = __attribute__((ext_vector_type(2))) float;
constexpr int SC_STEPS = 16;

DI void sc_store(char* buf, int dst, uint4 R, bool hgw) {
  float4 lo = make_float4(blo(R.x), bhi(R.x), blo(R.y), bhi(R.y));
  float4 hi = make_float4(blo(R.z), bhi(R.z), blo(R.w), bhi(R.w));
  *(float4*)(buf + dst) = lo;
  *(float4*)(buf + dst + 16) = hi;
  if (hgw) {
    *(float4*)(buf + dst + 256) = make_float4(1.f - lo.x, 1.f - lo.y, 1.f - lo.z, 1.f - lo.w);
    *(float4*)(buf + dst + 272) = make_float4(1.f - hi.x, 1.f - hi.y, 1.f - hi.z, 1.f - hi.w);
  }
}

DI float reduce8(float v) {
  v += dpp_f<0xB1>(v);
  v += dpp_f<0x4E>(v);
  v += dpp_f<0x141>(v);
  return v;
}

template <bool RW>
DI void scan_task(const Params& p, int task, int N, char* lds, int tid) {
  constexpr int NA = RW ? 5 : 3;
  constexpr int VOFF = SC_STEPS * NA * 256;
  constexpr int BUF = VOFF + SC_STEPS * 128;
  const int lane = tid & 63, wv = tid >> 6, kq = lane & 7, rg = lane >> 3;
  const int rq = task & 1, hh = (task >> 1) & 3, dir = (task >> 3) & 1, b = task >> 4;
  const size_t tb = (size_t)b * N;
  const int sub = tid >> 7, lt = tid & 127, lstep = lt >> 3, lpart = lt & 7;
  const int vstep = lt >> 2, vq = lt & 3;
  const u16 *src0 = nullptr, *src1 = nullptr, *src2 = nullptr;
  int dst0 = 0, dst1 = 0, dst2 = 0, st0 = 0, st1 = 0, st2 = 0;
  bool act0 = false, act1 = false, act2 = false, hgw = false;
  int ld;
  const int acol = hh * 64 + lpart * 8;
  const int vcol = hh * 64 + rq * 32 + vq * 8;
  const int vdst = VOFF + vstep * 128 + vq * 32;
  if (RW) {
    ld = 256;
    act0 = true; st0 = lstep;
    src0 = sub ? (p.dec + (size_t)dir * T_SUB * 256 + acol) : (p.rs + acol);
    dst0 = (lstep * NA + (sub ? 1 : 0)) * 256 + lpart * 32;
    act1 = true; st1 = lstep;
    src1 = sub ? (p.kk + acol) : (p.kt + (size_t)dir * T_SUB * 256 + acol);
    dst1 = (lstep * NA + (sub ? 3 : 2)) * 256 + lpart * 32;
    if (sub == 0) { act2 = true; st2 = lstep; src2 = p.kka + (size_t)dir * T_SUB * 256 + acol; dst2 = (lstep * NA + 4) * 256 + lpart * 32; }
    else { act2 = lt < 64; st2 = vstep; src2 = p.vs + vcol; dst2 = vdst; }
  } else {
    ld = ZLD;
    act0 = true; st0 = lstep;
    src0 = sub ? (p.z + ZC_OFF + 256 * (1 + dir) + acol) : (p.z + ZC_OFF + acol);
    dst0 = (lstep * NA + (sub ? 1 : 0)) * 256 + lpart * 32;
    hgw = sub != 0;
    if (sub == 0) { act1 = lt < 64; st1 = vstep; src1 = p.z + ZC_OFF + 768 + vcol; dst1 = vdst; }
  }
  u16* pout = (RW ? p.oD : p.oC) + (size_t)dir * T_SUB * 256 + hh * 64 + rq * 32 + wv * 8 + rg;
  pout += (tb + (dir ? (N - 1) : 0)) * 256;
  const int ostride = dir ? -256 : 256;

#define SC_TOK(c_, st_) (tb + (size_t)(dir ? (N - 1 - ((c_) * SC_STEPS + (st_))) : ((c_) * SC_STEPS + (st_))))
#define SC_ISSUE(Ra, Rb, Rc, c_)                                               \
  {                                                                            \
    if (act0) Ra = *(const uint4*)(src0 + SC_TOK(c_, st0) * ld);               \
    if (act1) Rb = *(const uint4*)(src1 + SC_TOK(c_, st1) * ld);               \
    if (act2) Rc = *(const uint4*)(src2 + SC_TOK(c_, st2) * ld);               \
  }
#define SC_STORE(Ra, Rb, Rc, buf_)                                             \
  {                                                                            \
    if (act0) sc_store(buf_, dst0, Ra, hgw);                                   \
    if (act1) sc_store(buf_, dst1, Rb, false);                                 \
    if (act2) sc_store(buf_, dst2, Rc, false);                                 \
  }
  f32x2 S0 = {0.f, 0.f}, S1 = {0.f, 0.f}, S2 = {0.f, 0.f}, S3 = {0.f, 0.f};
#define SC_LD(buf_, s_, ra_, rb_, wa_, wb_, ta_, tb_, ka_, kb_, aa_, ab_, v_)                \
  {                                                                                          \
    const char* rowp_ = (buf_) + (s_) * NA * 256 + kq * 32;                                  \
    ra_ = *(const float4*)(rowp_);                                                           \
    rb_ = *(const float4*)(rowp_ + 16);                                                      \
    wa_ = *(const float4*)(rowp_ + 256);                                                     \
    wb_ = *(const float4*)(rowp_ + 272);                                                     \
    ta_ = *(const float4*)(rowp_ + 512);                                                     \
    tb_ = *(const float4*)(rowp_ + 528);                                                     \
    if (RW) {                                                                                \
      ka_ = *(const float4*)(rowp_ + 768);                                                   \
      kb_ = *(const float4*)(rowp_ + 784);                                                   \
      aa_ = *(const float4*)(rowp_ + 1024);                                                  \
      ab_ = *(const float4*)(rowp_ + 1040);                                                  \
    }                                                                                        \
    v_ = *(const float*)((buf_) + VOFF + (s_) * 128 + (wv * 8 + rg) * 4);                    \
  }
#define F2A(q_) f32x2{(q_).x, (q_).y}
#define F2B(q_) f32x2{(q_).z, (q_).w}
#define SC_COMPUTE(buf_)                                                                     \
  {                                                                                          \
    float oselA = 0.f, oselB = 0.f;                                                          \
    float4 ra, rb, wa, wb, ta, tb_, ka, kb, aa, ab, nra, nrb, nwa, nwb, nta, ntb, nka, nkb, naa, nab; \
    float vv, nvv;                                                                           \
    ka = kb = aa = ab = nka = nkb = naa = nab = make_float4(0.f, 0.f, 0.f, 0.f);             \
    SC_LD(buf_, 0, ra, rb, wa, wb, ta, tb_, ka, kb, aa, ab, vv);                             \
    _Pragma("unroll") for (int s = 0; s < SC_STEPS; s++) {                                   \
      if (s + 1 < SC_STEPS) SC_LD(buf_, s + 1, nra, nrb, nwa, nwb, nta, ntb, nka, nkb, naa, nab, nvv); \
      f32x2 u0 = F2A(ta) * vv, u1 = F2B(ta) * vv, u2 = F2A(tb_) * vv, u3 = F2B(tb_) * vv;     \
      if (RW) {                                                                              \
        f32x2 pa = S0 * F2A(ka), pb = S1 * F2B(ka);                                          \
        pa = S2 * F2A(kb) + pa;                                                              \
        pb = S3 * F2B(kb) + pb;                                                              \
        pa = pa + pb;                                                                        \
        const float sa = -reduce8(pa.x + pa.y);                                              \
        u0 = F2A(aa) * sa + u0;                                                              \
        u1 = F2B(aa) * sa + u1;                                                              \
        u2 = F2A(ab) * sa + u2;                                                              \
        u3 = F2B(ab) * sa + u3;                                                              \
      }                                                                                      \
      S0 = S0 * F2A(wa) + u0;                                                                \
      S1 = S1 * F2B(wa) + u1;                                                                \
      S2 = S2 * F2A(wb) + u2;                                                                \
      S3 = S3 * F2B(wb) + u3;                                                                \
      f32x2 qa = S0 * F2A(ra), qb = S1 * F2B(ra);                                            \
      qa = S2 * F2A(rb) + qa;                                                                \
      qb = S3 * F2B(rb) + qb;                                                                \
      qa = qa + qb;                                                                          \
      const float o = reduce8(qa.x + qa.y);                                                  \
      if (s < 8) oselA = (kq == s) ? o : oselA;                                              \
      else oselB = (kq == s - 8) ? o : oselB;                                                \
      ra = nra; rb = nrb; wa = nwa; wb = nwb; ta = nta; tb_ = ntb;                           \
      ka = nka; kb = nkb; aa = naa; ab = nab; vv = nvv;                                      \
    }                                                                                        \
    pout[kq * ostride] = f2bf(oselA);                                                        \
    pout[(kq + 8) * ostride] = f2bf(oselB);                                                  \
    pout += SC_STEPS * ostride;                                                              \
  }
  uint4 A0 = make_uint4(0, 0, 0, 0), A1 = A0, A2 = A0, B0 = A0, B1 = A0, B2 = A0;
  char* buf0 = lds;
  char* buf1 = lds + BUF;
  const int nch = N / SC_STEPS;
  __syncthreads();
  SC_ISSUE(A0, A1, A2, 0);
  SC_ISSUE(B0, B1, B2, 1);
  SC_STORE(A0, A1, A2, buf0);
  __syncthreads();
  for (int c = 0; c < nch; c += 2) {
    if (c + 2 < nch) SC_ISSUE(A0, A1, A2, c + 2);
    __builtin_amdgcn_sched_barrier(0);
    SC_COMPUTE(buf0);
    __builtin_amdgcn_sched_barrier(0);
    SC_STORE(B0, B1, B2, buf1);
    __syncthreads();
    if (c + 3 < nch) SC_ISSUE(B0, B1, B2, c + 3);
    __builtin_amdgcn_sched_barrier(0);
    SC_COMPUTE(buf1);
    __builtin_amdgcn_sched_barrier(0);
    if (c + 2 < nch) SC_STORE(A0, A1, A2, buf0);
    __syncthreads();
  }
}

template <bool RW>
DI void scan_task16(const Params& p, int task, int N, char* lds, int tid) {
  constexpr int NA = RW ? 5 : 3;
  constexpr int VOFF = SC_STEPS * NA * 256;
  constexpr int BUF = VOFF + SC_STEPS * 64;
  const int lane = tid & 63, wv = tid >> 6, kq = lane & 15, rg = lane >> 4;
  const int rq = task & 3, hh = (task >> 2) & 3, dir = (task >> 4) & 1, b = task >> 5;
  const size_t tb = (size_t)b * N;
  const int sub = tid >> 7, lt = tid & 127, lstep = lt >> 3, lpart = lt & 7;
  const int vstep = lt >> 1, vhalf = lt & 1;
  const u16 *src0 = nullptr, *src1 = nullptr, *src2 = nullptr;
  int dst0 = 0, dst1 = 0, dst2 = 0, st0 = 0, st1 = 0, st2 = 0;
  bool act0 = false, act1 = false, act2 = false, hgw = false;
  int ld;
  const int acol = hh * 64 + lpart * 8;
  const int vcol = hh * 64 + rq * 16 + vhalf * 8;
  const int vdst = VOFF + vstep * 64 + vhalf * 32;
  if (RW) {
    ld = 256;
    act0 = true; st0 = lstep;
    src0 = sub ? (p.dec + (size_t)dir * T_SUB * 256 + acol) : (p.rs + acol);
    dst0 = (lstep * NA + (sub ? 1 : 0)) * 256 + lpart * 32;
    act1 = true; st1 = lstep;
    src1 = sub ? (p.kk + acol) : (p.kt + (size_t)dir * T_SUB * 256 + acol);
    dst1 = (lstep * NA + (sub ? 3 : 2)) * 256 + lpart * 32;
    if (sub == 0) { act2 = true; st2 = lstep; src2 = p.kka + (size_t)dir * T_SUB * 256 + acol; dst2 = (lstep * NA + 4) * 256 + lpart * 32; }
    else { act2 = lt < 32; st2 = vstep; src2 = p.vs + vcol; dst2 = vdst; }
  } else {
    ld = ZLD;
    act0 = true; st0 = lstep;
    src0 = sub ? (p.z + ZC_OFF + 256 * (1 + dir) + acol) : (p.z + ZC_OFF + acol);
    dst0 = (lstep * NA + (sub ? 1 : 0)) * 256 + lpart * 32;
    hgw = sub != 0;
    if (sub == 0) { act1 = lt < 32; st1 = vstep; src1 = p.z + ZC_OFF + 768 + vcol; dst1 = vdst; }
  }
  u16* pout = (RW ? p.oD : p.oC) + (size_t)dir * T_SUB * 256 + hh * 64 + rq * 16 + wv * 4 + rg;
  pout += (tb + (dir ? (N - 1) : 0)) * 256;
  const int ostride = dir ? -256 : 256;

#define SC16_TOK(c_, st_) (tb + (size_t)(dir ? (N - 1 - ((c_) * SC_STEPS + (st_))) : ((c_) * SC_STEPS + (st_))))
#define SC16_ISSUE(Ra, Rb, Rc, c_)                                               \
  {                                                                            \
    if (act0) Ra = *(const uint4*)(src0 + SC16_TOK(c_, st0) * ld);               \
    if (act1) Rb = *(const uint4*)(src1 + SC16_TOK(c_, st1) * ld);               \
    if (act2) Rc = *(const uint4*)(src2 + SC16_TOK(c_, st2) * ld);               \
  }
#define SC16_STORE(Ra, Rb, Rc, buf_)                                             \
  {                                                                            \
    if (act0) sc_store(buf_, dst0, Ra, hgw);                                   \
    if (act1) sc_store(buf_, dst1, Rb, false);                                 \
    if (act2) sc_store(buf_, dst2, Rc, false);                                 \
  }
  f32x2 S01 = {0.f, 0.f}, S23 = {0.f, 0.f};
#define SC16_LD(buf_, s_, r_, w_, t_, k_, a_, v_)                                              \
  {                                                                                          \
    const char* rowp_ = (buf_) + (s_) * NA * 256 + kq * 16;                                  \
    r_ = *(const float4*)(rowp_);                                                            \
    w_ = *(const float4*)(rowp_ + 256);                                                      \
    t_ = *(const float4*)(rowp_ + 512);                                                      \
    if (RW) {                                                                                \
      k_ = *(const float4*)(rowp_ + 768);                                                    \
      a_ = *(const float4*)(rowp_ + 1024);                                                   \
    }                                                                                        \
    v_ = *(const float*)((buf_) + VOFF + (s_) * 64 + (wv * 4 + rg) * 4);                     \
  }
#define SC16_COMPUTE(buf_)                                                                     \
  {                                                                                          \
    float osel = 0.f;                                                                        \
    float4 r4, w4, t4, k4, a4, nr4, nw4, nt4, nk4, na4;                                      \
    float vv, nvv;                                                                           \
    k4 = a4 = nk4 = na4 = make_float4(0.f, 0.f, 0.f, 0.f);                                   \
    SC16_LD(buf_, 0, r4, w4, t4, k4, a4, vv);                                                  \
    _Pragma("unroll") for (int s = 0; s < SC_STEPS; s++) {                                   \
      if (s + 1 < SC_STEPS) SC16_LD(buf_, s + 1, nr4, nw4, nt4, nk4, na4, nvv);                \
      f32x2 ta = f32x2{t4.x, t4.y} * vv, tb2 = f32x2{t4.z, t4.w} * vv;                       \
      if (RW) {                                                                              \
        f32x2 pp = S01 * f32x2{k4.x, k4.y};                                                  \
        pp = S23 * f32x2{k4.z, k4.w} + pp;                                                   \
        const float sa = -reduce16(pp.x + pp.y);                                             \
        ta = f32x2{a4.x, a4.y} * sa + ta;                                                    \
        tb2 = f32x2{a4.z, a4.w} * sa + tb2;                                                  \
      }                                                                                      \
      S01 = S01 * f32x2{w4.x, w4.y} + ta;                                                    \
      S23 = S23 * f32x2{w4.z, w4.w} + tb2;                                                   \
      f32x2 qq = S01 * f32x2{r4.x, r4.y};                                                    \
      qq = S23 * f32x2{r4.z, r4.w} + qq;                                                     \
      const float o = reduce16(qq.x + qq.y);                                                 \
      osel = (kq == s) ? o : osel;                                                           \
      r4 = nr4; w4 = nw4; t4 = nt4; k4 = nk4; a4 = na4; vv = nvv;                            \
    }                                                                                        \
    pout[kq * ostride] = f2bf(osel);                                                         \
    pout += SC_STEPS * ostride;                                                              \
  }
  uint4 A0 = make_uint4(0, 0, 0, 0), A1 = A0, A2 = A0, B0 = A0, B1 = A0, B2 = A0;
  char* buf0 = lds;
  char* buf1 = lds + BUF;
  const int nch = N / SC_STEPS;
  __syncthreads();
  SC16_ISSUE(A0, A1, A2, 0);
  SC16_ISSUE(B0, B1, B2, 1);
  SC16_STORE(A0, A1, A2, buf0);
  __syncthreads();
  for (int c = 0; c < nch; c += 2) {
    if (c + 2 < nch) SC16_ISSUE(A0, A1, A2, c + 2);
    __builtin_amdgcn_sched_barrier(0);
    SC16_COMPUTE(buf0);
    __builtin_amdgcn_sched_barrier(0);
    SC16_STORE(B0, B1, B2, buf1);
    __syncthreads();
    if (c + 3 < nch) SC16_ISSUE(B0, B1, B2, c + 3);
    __builtin_amdgcn_sched_barrier(0);
    SC16_COMPUTE(buf1);
    __builtin_amdgcn_sched_barrier(0);
    if (c + 2 < nch) SC16_STORE(A0, A1, A2, buf0);
    __syncthreads();
  }
}


DI void phase_mix(const Params& p, int l, int B, int N, unsigned* ctr, char* lds, int bid, int nb, int tid) {
  __shared__ int s_task[2];
  const bool wide = (N > 4096);
  const int nper = wide ? B * 32 : B * 16;
  const int nscan = 2 * nper;
  const int nattn = B * 4 * (N >> 7);
  const int nna = B * (N >> 7) * 4;
  const bool prefer_scan = bid < (nb >> 1);
  bool scan_dry = false, attn_dry = false;
  for (;;) {
    if (tid == 0) {
      int kind = -1, task = 0;
      for (int attempt = 0; attempt < 2 && kind < 0; attempt++) {
        const bool try_scan = (attempt == 0) == prefer_scan;
        if (try_scan) {
          if (!scan_dry) {
            const int t = (int)atomicAdd(&ctr[0], 1u);
            if (t < nscan) { kind = 0; task = t; } else scan_dry = true;
          }
        } else {
          if (!attn_dry) {
            const int t = (int)atomicAdd(&ctr[64], 1u);
            if (t < nattn + nna) { kind = 1; task = t; } else attn_dry = true;
          }
        }
      }
      s_task[0] = kind;
      s_task[1] = task;
    }
    __syncthreads();
    const int kind = s_task[0], task = s_task[1];
    __syncthreads();
    if (kind < 0) break;
    if (kind == 0) {
      if (wide) {
        if (task < nper) scan_task16<true>(p, task, N, lds, tid);
        else scan_task16<false>(p, task - nper, N, lds, tid);
      } else {
        if (task < nper) scan_task<true>(p, task, N, lds, tid);
        else scan_task<false>(p, task - nper, N, lds, tid);
      }
    } else {
      if (task < nattn) attn_task(p, task, N, lds, tid);
      else na_task(p, l, task - nattn, N, tid);
    }
  }
}

DI void phase_final(const Params& p, int l, int bid, int nb, int tid) {
  const int lane = tid & 63, wv = tid >> 6, c4 = lane * 4;
  float gn[4], lw[4], lbb[4];
#pragma unroll
  for (int j = 0; j < 4; j++) {
    gn[j] = p.hg_gnorm[l * 256 + c4 + j];
    lw[j] = p.rw_ln_w[l * 256 + c4 + j];
    lbb[j] = p.rw_ln_b[l * 256 + c4 + j];
  }
  for (int t = bid * 4 + wv; t < T_SUB; t += nb * 4) {
    const uint2 ca = *(const uint2*)(p.oC + (size_t)t * 256 + c4);
    const uint2 cb = *(const uint2*)(p.oC + (size_t)(T_SUB + t) * 256 + c4);
    const uint2 cg = *(const uint2*)(p.z + (size_t)t * ZLD + ZC_OFF + 1024 + c4);
    const uint2 da = *(const uint2*)(p.oD + (size_t)t * 256 + c4);
    const uint2 db = *(const uint2*)(p.oD + (size_t)(T_SUB + t) * 256 + c4);
    const float bo = p.bonus[(size_t)t * 4 + (lane >> 4)];
    const uint2 vr = *(const uint2*)(p.vs + (size_t)t * 256 + c4);
    const uint2 gr = *(const uint2*)(p.gD + (size_t)t * 256 + c4);
    {
      float o[4] = {blo(ca.x) + blo(cb.x), bhi(ca.x) + bhi(cb.x), blo(ca.y) + blo(cb.y), bhi(ca.y) + bhi(cb.y)};
      float ss = reduce16(o[0] * o[0] + o[1] * o[1] + o[2] * o[2] + o[3] * o[3]);
      float ri = rsqrtf(ss * (1.f / 64.f) + 1e-6f);
      float g[4] = {blo(cg.x), bhi(cg.x), blo(cg.y), bhi(cg.y)};
      float y[4];
#pragma unroll
      for (int j = 0; j < 4; j++) y[j] = o[j] * ri * gn[j] * (g[j] * sigm(g[j]));
      *(uint2*)(p.cat + (size_t)t * 1024 + 512 + c4) = make_uint2(pack2(y[0], y[1]), pack2(y[2], y[3]));
    }
    {
      float o[4] = {blo(da.x) + blo(db.x), bhi(da.x) + bhi(db.x), blo(da.y) + blo(db.y), bhi(da.y) + bhi(db.y)};
      float mu = reduce16(o[0] + o[1] + o[2] + o[3]) * (1.f / 64.f);
      float d0 = o[0] - mu, d1 = o[1] - mu, d2 = o[2] - mu, d3 = o[3] - mu;
      float var = reduce16(d0 * d0 + d1 * d1 + d2 * d2 + d3 * d3) * (1.f / 64.f);
      float ri = rsqrtf(var + 64e-5f);
      float vv[4] = {blo(vr.x), bhi(vr.x), blo(vr.y), bhi(vr.y)};
      float g[4] = {blo(gr.x), bhi(gr.x), blo(gr.y), bhi(gr.y)};
      float dd[4] = {d0, d1, d2, d3};
      float y[4];
#pragma unroll
      for (int j = 0; j < 4; j++) y[j] = (dd[j] * ri * lw[j] + lbb[j] + bo * vv[j]) * g[j];
      *(uint2*)(p.cat + (size_t)t * 1024 + 768 + c4) = make_uint2(pack2(y[0], y[1]), pack2(y[2], y[3]));
    }
  }
}

DI void phase_wout(const Params& p, int l, int tok0, char* lds, int bid, int nb, int tid) {
  const int NT = 8, MT = T_SUB / 128;
  for (int it = 0;; it++) {
    int nt, mt;
    if (!xcd_tile(it, bid, nb, MT, NT, mt, nt)) break;
    int m0 = mt * 128, n0 = nt * 128;
    auto rowfn = [&](int r) -> const void* { return p.cat + (size_t)(m0 + r) * 1024; };
    auto epi = [&](f32x4(&acc)[4][4], int rbase, int cbase) {
      EPI_LOOP({
        int tg = tok0 + m0 + row;
        float4 xv = *(const float4*)(xin_row(p, l, tg) + n0 + col);
        float4 o = make_float4(ALPHA_F * xv.x + v[0], ALPHA_F * xv.y + v[1], ALPHA_F * xv.z + v[2], ALPHA_F * xv.w + v[3]);
        *(float4*)(p.out + (size_t)tg * 1024 + n0 + col) = o;
      })
    };
    gemm_tile<false>(rowfn, p.wout_t + ((size_t)l * 1024 + n0) * 1024, 1024, epi, lds, tid);
  }
}

template <bool ROUTER>
DI void phase_ln(const Params& p, const float* g, const float* bta, const float* wrouter, int tok0, int ntok, char* lds,
                 int bid, int nb, int tid) {
  const int lane = tid & 63, wv = tid >> 6;
  float* wl = (float*)lds;
  if (ROUTER) {
    __syncthreads();
    for (int i = tid; i < 16384; i += NTHR) {
      int k = i >> 4, e = i & 15;
      wl[e * 1024 + k] = wrouter[i];
    }
    __syncthreads();
  }
  auto ln_load = [&](float4 (&d)[4], int trow, bool ok) {
#pragma unroll
    for (int i = 0; i < 4; i++) {
      if (!ok) { d[i] = make_float4(0.f, 0.f, 0.f, 0.f); continue; }
      if (ROUTER) {
        d[i] = *(const float4*)(p.out + (size_t)trow * 1024 + i * 256 + lane * 4);
      } else {
        const uint2 r = *(const uint2*)(p.O + (size_t)trow * 1024 + i * 256 + lane * 4);
        d[i] = make_float4(blo(r.x), bhi(r.x), blo(r.y), bhi(r.y));
      }
    }
  };
  float4 x[4], xn[4];
  {
    const int t0 = bid * 4 + wv;
    ln_load(x, tok0 + t0, t0 < ntok);
  }
  for (int t = bid * 4 + wv; t < ntok; t += nb * 4) {
    const int tg = tok0 + t;
    float* xr = p.out + (size_t)tg * 1024;
    {
      const int tn = t + nb * 4;
      ln_load(xn, tok0 + tn, tn < ntok);
    }
    float s = 0.f;
#pragma unroll
    for (int i = 0; i < 4; i++) s += x[i].x + x[i].y + x[i].z + x[i].w;
    float mu = wave_sum(s) * (1.f / 1024.f);
    float vs = 0.f;
#pragma unroll
    for (int i = 0; i < 4; i++) {
      x[i].x -= mu; x[i].y -= mu; x[i].z -= mu; x[i].w -= mu;
      vs += x[i].x * x[i].x + x[i].y * x[i].y + x[i].z * x[i].z + x[i].w * x[i].w;
    }
    float ri = rsqrtf(wave_sum(vs) * (1.f / 1024.f) + 1e-5f);
#pragma unroll
    for (int i = 0; i < 4; i++) {
      float4 gg = *(const float4*)(g + i * 256 + lane * 4);
      float4 bb = *(const float4*)(bta + i * 256 + lane * 4);
      x[i].x = x[i].x * ri * gg.x + bb.x;
      x[i].y = x[i].y * ri * gg.y + bb.y;
      x[i].z = x[i].z * ri * gg.z + bb.z;
      x[i].w = x[i].w * ri * gg.w + bb.w;
      if (!ROUTER) *(float4*)(xr + i * 256 + lane * 4) = x[i];
      *(uint2*)(p.xb + (size_t)tg * 1024 + i * 256 + lane * 4) = make_uint2(pack2(x[i].x, x[i].y), pack2(x[i].z, x[i].w));
    }
    if (ROUTER) {
      float mine = 0.f;
#pragma unroll 2
      for (int e = 0; e < 16; e++) {
        float a = 0.f;
#pragma unroll
        for (int i = 0; i < 4; i++) {
          float4 w = *(const float4*)(wl + e * 1024 + i * 256 + lane * 4);
          a += x[i].x * w.x + x[i].y * w.y + x[i].z * w.z + x[i].w * w.w;
        }
        a = reduce16(a);
        mine = ((lane & 15) == e) ? a : mine;
      }
      mine += __shfl_xor(mine, 16);
      mine += __shfl_xor(mine, 32);
      float mx = mine;
      mx = fmaxf(mx, dpp_f<0xB1>(mx));
      mx = fmaxf(mx, dpp_f<0x4E>(mx));
      mx = fmaxf(mx, dpp_f<0x141>(mx));
      mx = fmaxf(mx, dpp_f<0x140>(mx));
      float ex = __expf(mine - mx);
      float sum = reduce16(ex);
      mine = ex / sum;
      if (lane == 0) p.inv_cnt[tg] = 0;
      if (lane < 16) {
        if (tg < 32768) p.affT[(size_t)lane * 32768 + tg] = mine;
        else p.affT[(size_t)16 * 32768 + (size_t)lane * 65536 + (tg - 32768)] = mine;
      }
    }
#pragma unroll
    for (int i = 0; i < 4; i++) x[i] = xn[i];
  }
}

DI void phase_topk(const Params& p, char* lds, int bid, int nb, int tid) {
  if (bid < 32) {
    unsigned* hist = (unsigned*)lds;
    unsigned* sh = hist + 256;
    unsigned* eqc = sh + 8;
    const int g = bid >> 4, e = bid & 15;
    const int T = g ? 65536 : 32768, cap = T >> 3;
    const int tok0 = g ? 32768 : 0;
    const float* vals = p.affT + (g ? (size_t)16 * 32768 : 0) + (size_t)e * T;
    const float4* v4 = (const float4*)vals;
    const int n4 = T >> 2;
    int* oidx = p.idx + (g ? 65536 : 0) + e * cap;
    float* ogate = p.gate + (g ? 65536 : 0) + e * cap;
    const int slot0 = (g ? 65536 : 0) + e * cap;
    unsigned prefix = 0, mask = 0;
    int remaining = cap;
    for (int pass = 0; pass < 4; pass++) {
      const int shift = 24 - 8 * pass;
      hist[tid] = 0;
      __syncthreads();
      for (int base = 0; base < n4; base += 2048) {
        float4 x[8];
#pragma unroll
        for (int u = 0; u < 8; u++) x[u] = v4[base + u * 256 + tid];
#pragma unroll
        for (int u = 0; u < 8; u++) {
          const unsigned b0 = __float_as_uint(x[u].x), b1 = __float_as_uint(x[u].y), b2 = __float_as_uint(x[u].z), b3 = __float_as_uint(x[u].w);
          if ((b0 & mask) == prefix) atomicAdd(&hist[(b0 >> shift) & 255], 1u);
          if ((b1 & mask) == prefix) atomicAdd(&hist[(b1 >> shift) & 255], 1u);
          if ((b2 & mask) == prefix) atomicAdd(&hist[(b2 >> shift) & 255], 1u);
          if ((b3 & mask) == prefix) atomicAdd(&hist[(b3 >> shift) & 255], 1u);
        }
      }
      __syncthreads();
      if (tid == 0) {
        int cum = 0, sel = 0;
        for (int bq = 255; bq >= 0; bq--) {
          int hc = (int)hist[bq];
          if (cum + hc >= remaining) { sel = bq; break; }
          cum += hc;
        }
        sh[0] = (unsigned)sel;
        sh[1] = (unsigned)(remaining - cum);
        sh[3] = hist[sel];
      }
      __syncthreads();
      prefix |= sh[0] << shift;
      remaining = (int)sh[1];
      mask |= 0xFFu << shift;
      __syncthreads();
    }
    const unsigned thr = prefix;
    const int need = remaining;
    const bool fast = ((int)sh[3] == need);
    if (tid == 0) sh[2] = 0;
    __syncthreads();
    if (fast) {
      for (int base = 0; base < n4; base += 2048) {
        float4 x[8];
#pragma unroll
        for (int u = 0; u < 8; u++) x[u] = v4[base + u * 256 + tid];
#pragma unroll
        for (int u = 0; u < 8; u++) {
          const float xv[4] = {x[u].x, x[u].y, x[u].z, x[u].w};
#pragma unroll
          for (int c = 0; c < 4; c++) {
            if (__float_as_uint(xv[c]) >= thr) {
              const int pos = (int)atomicAdd(&sh[2], 1u);
              const int tok = tok0 + (base + u * 256 + tid) * 4 + c;
              oidx[pos] = tok;
              ogate[pos] = xv[c];
              const int kslot = atomicAdd(&p.inv_cnt[tok], 1);
              p.inv_slot[(size_t)tok * 16 + kslot] = slot0 + pos;
            }
          }
        }
      }
    } else {
      const int ch = T >> 8;
      const float* my = vals + tid * ch;
      int ec = 0;
      for (int i = 0; i < ch; i++) ec += (__float_as_uint(my[i]) == thr) ? 1 : 0;
      eqc[tid] = ec;
      __syncthreads();
      int eq_rank = 0;
      for (int i = 0; i < tid; i++) eq_rank += eqc[i];
      for (int i = 0; i < ch; i++) {
        float v = my[i];
        unsigned u = __float_as_uint(v);
        int pos = -1;
        if (u > thr) {
          pos = (int)atomicAdd(&sh[2], 1u);
        } else if (u == thr) {
          if (eq_rank < need) pos = cap - need + eq_rank;
          eq_rank++;
        }
        if (pos >= 0) {
          const int tok = tok0 + tid * ch + i;
          oidx[pos] = tok;
          ogate[pos] = v;
          const int kslot = atomicAdd(&p.inv_cnt[tok], 1);
          p.inv_slot[(size_t)tok * 16 + kslot] = slot0 + pos;
        }
      }
    }
    __syncthreads();
  }
}

DI void moe_rowinfo(int row0, int l, int& e, int& ioff) {
  if (row0 < 65536) { e = row0 >> 12; }
  else { e = (row0 - 65536) >> 13; }
  ioff = row0;
}

DI void phase_moe1(const Params& p, int l, char* lds, int bid, int nb, int tid) {
  const int NT = 8, MT = 196608 / 128;
  for (int it = 0;; it++) {
    int nt, mt;
    if (!xcd_tile(it, bid, nb, MT, NT, mt, nt)) break;
    int m0 = mt * 128, n0 = nt * 128;
    int e, ioff;
    moe_rowinfo(m0, l, e, ioff);
    const int* ip = p.idx + ioff;
    auto rowfn = [&](int r) -> const void* { return p.xb + (size_t)ip[r] * 1024; };
    u16* H = p.H;
    auto epi = [&](f32x4(&acc)[4][4], int rbase, int cbase) {
#pragma unroll
      for (int m = 0; m < 4; m++)
#pragma unroll
        for (int n = 0; n < 4; n += 2) {
          int row = rbase + m * 16;
          int col = cbase + n * 16;
          int blk = (n0 + (col & ~31)) >> 1;
          int hc = blk + (col & 15);
          f32x4 a = acc[m][n], bq = acc[m][n + 1];
          f32x4 o;
          for (int j = 0; j < 4; j++) o[j] = a[j] * sigm(a[j]) * bq[j];
          st_bf4(H + (size_t)(m0 + row) * 512 + hc, o);
        }
    };
    gemm_tile<false>(rowfn, p.w13_t + ((size_t)(l * 16 + e) * 1024 + n0) * 1024, 1024, epi, lds, tid);
  }
}

DI void phase_moe2(const Params& p, int l, char* lds, int bid, int nb, int tid) {
  TileIter it{bid, nb, 0};
  {
    const int NT = 8, MT = 196608 / 128;
    for (int itx = 0;; itx++) {
      int nt, mt;
      if (!xcd_tile(itx, bid, nb, MT, NT, mt, nt)) break;
      int m0 = mt * 128, n0 = nt * 128;
      int e, ioff;
      moe_rowinfo(m0, l, e, ioff);
      auto rowfn = [&](int r) -> const void* { return p.H + (size_t)(m0 + r) * 512; };
      u16* O = p.O;
      auto epi = [&](f32x4(&acc)[4][4], int rbase, int cbase) {
        EPI_LOOP({ st_bf4(O + (size_t)(m0 + row) * 1024 + n0 + col, v); })
      };
      gemm_tile<false>(rowfn, p.w2_t + ((size_t)(l * 16 + e) * 1024 + n0) * 512, 512, epi, lds, tid);
    }
  }
  {
    const int NT = 8, MT = T_ALL / 128;
    for (int itx = 0;; itx++) {
      int nt, mt;
      if (!xcd_tile(itx, bid, nb, MT, NT, mt, nt)) break;
      int m0 = mt * 128, n0 = nt * 128;
      auto rowfn = [&](int r) -> const void* {
        int tg = m0 + r;
        return tg < 32768 ? p.p_prompt + ((size_t)l * 32768 + tg) * 256 : p.p_sample + ((size_t)l * 65536 + (tg - 32768)) * 256;
      };
      auto epi = [&](f32x4(&acc)[4][4], int rbase, int cbase) {
        EPI_LOOP({ st_bf4((u16*)p.out + (size_t)(m0 + row) * 1024 + n0 + col, v); })
      };
      gemm_tile<true>(rowfn, p.wp_t + ((size_t)l * 1024 + n0) * 256, 256, epi, lds, tid);
    }
  }
}

DI void phase_combine(const Params& p, int bid, int nb, int tid) {
  const int lane = tid & 63, wv = tid >> 6;
  u16* ub = p.H;
  const int stride = nb * 4;
  int t = bid * 4 + wv;
  uint2 xr_[4], xn_[4];
  int cnt = 0, myslot = 0, cntn = 0, myslotn = 0;
#pragma unroll
  for (int i = 0; i < 4; i++) xr_[i] = xn_[i] = make_uint2(0, 0);
  if (t < T_ALL) {
#pragma unroll
    for (int i = 0; i < 4; i++) xr_[i] = *(const uint2*)(p.xb + (size_t)t * 1024 + i * 256 + lane * 4);
    cnt = p.inv_cnt[t];
    myslot = p.inv_slot[(size_t)t * 16 + (lane & 15)];
  }
  for (; t < T_ALL; t += stride) {
    const int tn = t + stride;
    if (tn < T_ALL) {
#pragma unroll
      for (int i = 0; i < 4; i++) xn_[i] = *(const uint2*)(p.xb + (size_t)tn * 1024 + i * 256 + lane * 4);
      cntn = p.inv_cnt[tn];
      myslotn = p.inv_slot[(size_t)tn * 16 + (lane & 15)];
    }
    const float mygate = ((lane & 15) < cnt) ? p.gate[myslot] : 0.f;
    float4 a[4];
#pragma unroll
    for (int i = 0; i < 4; i++)
      a[i] = make_float4(blo(xr_[i].x) * ALPHA_F, bhi(xr_[i].x) * ALPHA_F, blo(xr_[i].y) * ALPHA_F, bhi(xr_[i].y) * ALPHA_F);
    for (int j0 = 0; j0 < cnt; j0 += 4) {
      uint2 r[4][4];
      float g[4];
#pragma unroll
      for (int jj = 0; jj < 4; jj++) {
        const int j = (j0 + jj < cnt) ? (j0 + jj) : j0;
        const int slot = __shfl(myslot, j);
        g[jj] = (j0 + jj < cnt) ? __shfl(mygate, j) : 0.f;
        const u16* orow = p.O + (size_t)slot * 1024 + lane * 4;
#pragma unroll
        for (int i = 0; i < 4; i++) r[jj][i] = *(const uint2*)(orow + i * 256);
      }
#pragma unroll
      for (int jj = 0; jj < 4; jj++)
#pragma unroll
        for (int i = 0; i < 4; i++) {
          a[i].x += g[jj] * blo(r[jj][i].x);
          a[i].y += g[jj] * bhi(r[jj][i].x);
          a[i].z += g[jj] * blo(r[jj][i].y);
          a[i].w += g[jj] * bhi(r[jj][i].y);
        }
    }
#pragma unroll
    for (int i = 0; i < 4; i++)
      *(uint2*)(ub + (size_t)t * 1024 + i * 256 + lane * 4) = make_uint2(pack2(a[i].x, a[i].y), pack2(a[i].z, a[i].w));
#pragma unroll
    for (int i = 0; i < 4; i++) xr_[i] = xn_[i];
    cnt = cntn;
    myslot = myslotn;
  }
}

DI void phase_ple(const Params& p, int l, char* lds, int bid, int nb, int tid) {
  const int NT = 8, MT = T_ALL / 128;
  for (int it = 0;; it++) {
    int nt, mt;
    if (!xcd_tile(it, bid, nb, MT, NT, mt, nt)) break;
    int m0 = mt * 128, n0 = nt * 128;
    auto rowfn = [&](int r) -> const void* { return p.H + (size_t)(m0 + r) * 1024; };
    auto epi = [&](f32x4(&acc)[4][4], int rbase, int cbase) {
      EPI_LOOP({
        size_t o = (size_t)(m0 + row) * 1024 + n0 + col;
        const uint2 ur = *(const uint2*)(p.H + o);
        const uint2 pr = *(const uint2*)((const u16*)p.out + o);
        f32x4 w4;
        w4[0] = blo(ur.x) + sigm(v[0]) * blo(pr.x);
        w4[1] = bhi(ur.x) + sigm(v[1]) * bhi(pr.x);
        w4[2] = blo(ur.y) + sigm(v[2]) * blo(pr.y);
        w4[3] = bhi(ur.y) + sigm(v[3]) * bhi(pr.y);
        st_bf4(p.O + o, w4);
      })
    };
    gemm_tile<false>(rowfn, p.wg_t + ((size_t)l * 1024 + n0) * 1024, 1024, epi, lds, tid);
  }
}

#define XB_TMO      128
#define XB_XCNT(j)  (256  + 64 * (j))
#define XB_XSUB(j)  (1280 + 64 * (j))
#define XB_XGEN(j)  (2304 + 64 * (j))
#define XB_TOP      3328
#define XB_TOPGEN   3392
#define XCD_BAR_WORDS 3456
#define XB_SPIN_CAP (1u << 22)
#define LAS __attribute__((address_space(3)))
DI unsigned xb_ld(unsigned* p) { return __hip_atomic_load(p, __ATOMIC_RELAXED, __HIP_MEMORY_SCOPE_AGENT); }
DI unsigned xb_add(unsigned* p, unsigned v) { return __hip_atomic_fetch_add(p, v, __ATOMIC_RELAXED, __HIP_MEMORY_SCOPE_AGENT); }
DI unsigned xb_xcc_id() { return (unsigned)__builtin_amdgcn_s_getreg((3 << 11) | 20) & 0xFu; }
#define XB_SPIN(cond, bar) do { unsigned _sp = 0; while (cond) { __builtin_amdgcn_s_sleep(1); \
    if ((++_sp & 255u) == 0u) { if (xb_ld(&(bar)[XB_TMO])) break; if (_sp > XB_SPIN_CAP) { atomicAdd(&(bar)[XB_TMO], 1u); break; } } } } while (0)
struct XcdBarrier { unsigned* bar; unsigned x; volatile LAS unsigned* st; };
DI XcdBarrier xcd_barrier_post(unsigned* bar, volatile LAS unsigned* st) {
  XcdBarrier b; b.bar = bar; b.x = xb_xcc_id(); b.st = st;
  if (threadIdx.x == 0) (void)xb_add(&bar[XB_XCNT(b.x)], 1u);
  return b;
}
DI void xcd_barrier_complete(unsigned* bar, unsigned x, unsigned& nloc, unsigned& nx) {
  const unsigned G = gridDim.x * gridDim.y * gridDim.z;
  unsigned sum, cnt, mine, sp = 0u;
  for (;;) {
    sum = 0u; cnt = 0u; mine = 0u;
#pragma unroll
    for (unsigned j = 0; j < 16; ++j) { const unsigned c = xb_ld(&bar[XB_XCNT(j)]); sum += c; cnt += (c > 0u) ? 1u : 0u; mine = (j == x) ? c : mine; }
    if (sum == G) break;
    __builtin_amdgcn_s_sleep(1);
    if ((++sp & 255u) == 0u) { if (xb_ld(&bar[XB_TMO])) break; if (sp > XB_SPIN_CAP) { atomicAdd(&bar[XB_TMO], 1u); break; } }
  }
  nloc = mine > 0u ? mine : 1u; nx = cnt > 0u ? cnt : 1u;
}
DI void xcd_barrier(const XcdBarrier& b) {
  asm volatile("s_waitcnt vmcnt(0)" ::: "memory");
  __syncthreads();
  if (threadIdx.x == 0) {
    unsigned* bar = b.bar;
    __builtin_amdgcn_s_waitcnt(0);
    unsigned nloc = b.st[0], nx = b.st[1];
    if (nloc == 0u) { xcd_barrier_complete(bar, b.x, nloc, nx); b.st[0] = nloc; b.st[1] = nx; }
    const unsigned old = xb_add(&bar[XB_XSUB(b.x)], 1u);
    const unsigned gen = old / nloc;
    if (old + 1u == (gen + 1u) * nloc) {
      __builtin_amdgcn_fence(__ATOMIC_RELEASE, "agent");
      asm volatile("s_waitcnt vmcnt(0)" ::: "memory");
      const unsigned og = xb_add(&bar[XB_TOP], 1u);
      const unsigned tg = og / nx;
      if (og + 1u == (tg + 1u) * nx) xb_add(&bar[XB_TOPGEN], 1u);
      else XB_SPIN(xb_ld(&bar[XB_TOPGEN]) == tg, bar);
      __builtin_amdgcn_fence(__ATOMIC_ACQUIRE, "agent");
      xb_add(&bar[XB_XGEN(b.x)], 1u);
      asm volatile("s_waitcnt vmcnt(0)" ::: "memory");
    } else {
      XB_SPIN(xb_ld(&bar[XB_XGEN(b.x)]) == gen, bar);
      __builtin_amdgcn_fence(__ATOMIC_ACQUIRE, "agent");
      asm volatile("s_waitcnt vmcnt(0)" ::: "memory");
    }
  }
  __syncthreads();
}

__global__ void __launch_bounds__(NTHR, 2) mega(Params p) {
  __shared__ __attribute__((aligned(16))) char lds[73728];
  cg::grid_group grid = cg::this_grid();
  const int tid0 = threadIdx.x, bid0 = blockIdx.x, nb = gridDim.x;
  __shared__ uint4 xb_words;
  if (tid0 == 0) xb_words = make_uint4(0u, 0u, 0u, 0u);
  __syncthreads();
  const XcdBarrier xb = xcd_barrier_post(p.bar, (volatile LAS unsigned*)&xb_words);
  int pc = 0;
#define PHASE(...)                                      \
  {                                                     \
    if (pc >= p.pb && pc < p.pe) {                      \
      if (pc == p.pb + 1) grid.sync();                  \
      else if (pc > p.pb + 1) xcd_barrier(xb);          \
      int tid = tid0, bid = bid0;                       \
      asm volatile("" : "+v"(tid), "+s"(bid));          \
      __VA_ARGS__;                                      \
    }                                                   \
    pc++;                                               \
  }
  PHASE(phase_convert(p, lds, bid, nb, tid));
  for (int i = 0; i < REP_SYNC; i++) PHASE((void)0);
  for (int l = 0; l < 2; l++) {
    for (int sg = 0; sg < 3; sg++) {
      const int tok0 = sg * T_SUB;
      const int B = sg == 0 ? 4 : 8, N = sg == 0 ? 8192 : 4096;
      PHASE(phase_inproj(p, l, tok0, lds, bid, nb, tid));
#if REP_INPROJ || REP_GEMMS
      PHASE(phase_inproj(p, l, tok0, lds, bid, nb, tid));
#endif
      PHASE(phase_prep(p, l, N, bid, nb, tid));
      PHASE(phase_smallgemm(p, l, B, N, lds, bid, nb, tid));
#if REP_GEMMS
      PHASE(phase_smallgemm(p, l, B, N, lds, bid, nb, tid));
#endif
      PHASE(phase_mix(p, l, B, N, p.bar + XCD_BAR_WORDS + (l * 3 + sg) * 128, lds, bid, nb, tid));
#if REP_MIX
      PHASE(phase_mix(p, l, B, N, p.bar + XCD_BAR_WORDS + (6 + l * 3 + sg) * 128, lds, bid, nb, tid));
#endif
      PHASE(phase_final(p, l, bid, nb, tid));
      PHASE(phase_wout(p, l, tok0, lds, bid, nb, tid));
      PHASE(phase_ln<true>(p, p.ln1_g + l * 1024, p.ln1_b + l * 1024, p.moe_router + (size_t)l * 16384, tok0, T_SUB, lds, bid, nb, tid));
    }
    PHASE(phase_topk(p, lds, bid, nb, tid));
    PHASE(phase_moe1(p, l, lds, bid, nb, tid));
#if REP_MOE1 || REP_GEMMS
    PHASE(phase_moe1(p, l, lds, bid, nb, tid));
#endif
    PHASE(phase_moe2(p, l, lds, bid, nb, tid));
#if REP_GEMMS
    PHASE(phase_moe2(p, l, lds, bid, nb, tid));
#endif
    PHASE(phase_combine(p, bid, nb, tid));
    PHASE(phase_ple(p, l, lds, bid, nb, tid));
    PHASE(phase_ln<false>(p, p.ln2_g + l * 1024, p.ln2_b + l * 1024, nullptr, 0, T_ALL, lds, bid, nb, tid));
  }
}

#define N_PHASES 1000
#ifndef FUSED
#define FUSED 1
#endif

extern "C" void kernel_launch(void* const* d_in, const int* in_sizes, int n_in, void* d_out, int out_size, void* d_ws,
                              size_t ws_size, hipStream_t stream) {
  static int grid_blocks = 0;
  if (!grid_blocks) {
    int dev = 0, cus = 0, per_cu = 0;
    (void)hipGetDevice(&dev);
    (void)hipDeviceGetAttribute(&cus, hipDeviceAttributeMultiprocessorCount, dev);
    (void)hipOccupancyMaxActiveBlocksPerMultiprocessor(&per_cu, mega, NTHR, 0);
    if (per_cu > 2) per_cu = 2;
    if (per_cu < 1) per_cu = 1;
    grid_blocks = cus * per_cu;
  }
  Params p;
  memset(&p, 0, sizeof(p));
  const float* const* in = (const float* const*)d_in;
  int k = 0;
  p.x_prompt = in[k++]; p.x_sample = in[k++]; p.p_prompt = in[k++]; p.p_sample = in[k++];
  p.w_in = in[k++]; p.mla_gq = in[k++]; p.mla_gkv = in[k++]; p.mla_wuq = in[k++]; p.mla_wuk = in[k++]; p.mla_wuv = in[k++];
  p.na_bias = in[k++]; p.hg_lb = in[k++]; p.hg_gnorm = in[k++];
  p.rw_mu = in[k++]; p.rw_w0 = in[k++]; p.rw_w_up = in[k++]; p.rw_a0 = in[k++]; p.rw_a_up = in[k++]; p.rw_g_up = in[k++];
  p.rw_kk = in[k++]; p.rw_ka = in[k++]; p.rw_rk = in[k++]; p.rw_ln_w = in[k++]; p.rw_ln_b = in[k++];
  p.w_out = in[k++]; p.ln1_g = in[k++]; p.ln1_b = in[k++]; p.moe_router = in[k++]; p.moe_w1 = in[k++]; p.moe_w3 = in[k++];
  p.moe_w2 = in[k++]; p.ln2_g = in[k++]; p.ln2_b = in[k++]; p.ple_gate = in[k++]; p.ple_proj = in[k++];
  p.out = (float*)d_out;
  char* ws = (char*)d_ws;
  size_t off = 0;
  auto take = [&](size_t bytes) { char* r = ws + off; off += (bytes + 255) & ~(size_t)255; return r; };
  p.w_in_t = (u16*)take((size_t)2 * 3712 * 1024 * 2);
  p.wuq_t = (u16*)take((size_t)2 * 384 * 256 * 2);
  p.wkv_t = (u16*)take((size_t)2 * 512 * 128 * 2);
  p.wup_t = (u16*)take((size_t)4 * 256 * 64 * 2);
  p.aup_t = (u16*)take((size_t)4 * 256 * 64 * 2);
  p.gup_t = (u16*)take((size_t)2 * 256 * 128 * 2);
  p.wout_t = (u16*)take((size_t)2 * 1024 * 1024 * 2);
  p.w13_t = (u16*)take((size_t)32 * 1024 * 1024 * 2);
  p.w2_t = (u16*)take((size_t)32 * 1024 * 512 * 2);
  p.wg_t = (u16*)take((size_t)2 * 1024 * 1024 * 2);
  p.wp_t = (u16*)take((size_t)2 * 1024 * 256 * 2);
  p.ropec = (float*)take((size_t)8192 * 16 * 4);
  p.ropes = (float*)take((size_t)8192 * 16 * 4);
  p.lb = (float*)take(1024 * 4);
  p.affT = (float*)take((size_t)16 * T_ALL * 4);
  p.gate = (float*)take((size_t)196608 * 4);
  p.idx = (int*)take((size_t)196608 * 4);
  p.bar = (unsigned*)take((size_t)(XCD_BAR_WORDS + 12 * 128) * 4);
  p.inv_cnt = (int*)take((size_t)T_ALL * 4);
  p.inv_slot = (int*)take((size_t)T_ALL * 16 * 4);
  p.xb = (u16*)take((size_t)T_ALL * 1024 * 2);
  const size_t stage0 = off;
  p.z = (u16*)take((size_t)T_SUB * ZLD * 2);
  p.cat = (u16*)take((size_t)T_SUB * 1024 * 2);
  p.Q = (u16*)take((size_t)T_SUB * 384 * 2);
  p.Kb = (u16*)take((size_t)T_SUB * 384 * 2);
  p.Vt = (u16*)take((size_t)T_SUB * 256 * 2);
  p.cqn = (u16*)take((size_t)T_SUB * 256 * 2);
  p.ckvn = (u16*)take((size_t)T_SUB * 128 * 2);
  p.S1 = (u16*)take((size_t)T_SUB * 384 * 2);
  p.rs = (u16*)take((size_t)T_SUB * 256 * 2);
  p.ks = (u16*)take((size_t)T_SUB * 256 * 2);
  p.vs = (u16*)take((size_t)T_SUB * 256 * 2);
  p.kk = (u16*)take((size_t)T_SUB * 256 * 2);
  p.gD = (u16*)take((size_t)T_SUB * 256 * 2);
  p.dec = (u16*)take((size_t)2 * T_SUB * 256 * 2);
  p.kka = (u16*)take((size_t)2 * T_SUB * 256 * 2);
  p.kt = (u16*)take((size_t)2 * T_SUB * 256 * 2);
  p.oC = (u16*)take((size_t)2 * T_SUB * 256 * 2);
  p.oD = (u16*)take((size_t)2 * T_SUB * 256 * 2);
  p.bonus = (float*)take((size_t)T_SUB * 4 * 4);
  off = stage0;
  p.O = (u16*)take((size_t)196608 * 1024 * 2);
  p.H = (u16*)take((size_t)196608 * 512 * 2);
  for (int i = 0; i < 16; i++) p.inv_freq[i] = pow(10000.0, -(double)i / 16.0);
  (void)hipMemsetAsync(p.bar, 0, (size_t)(XCD_BAR_WORDS + 12 * 128) * 4, stream);
#if FUSED
  p.pb = 0;
  p.pe = N_PHASES;
  {
    void* args[] = {&p};
    hipError_t e = hipLaunchCooperativeKernel((void*)mega, dim3(grid_blocks), dim3(NTHR), args, 0, stream);
    if (e != hipSuccess) fprintf(stderr, "cooperative launch failed: %s (grid %d)\n", hipGetErrorString(e), grid_blocks);
  }
#else
  for (int ph = 0; ph < N_PHASES; ph++) {
    p.pb = ph;
    p.pe = ph + 1;
    void* args[] = {&p};
    hipError_t e = hipLaunchCooperativeKernel((void*)mega, dim3(grid_blocks), dim3(NTHR), args, 0, stream);
    if (e != hipSuccess) fprintf(stderr, "cooperative launch failed: %s (grid %d)\n", hipGetErrorString(e), grid_blocks);
  }
#endif
}
```

```cpp
#include <hip/hip_runtime.h>
#include <hip/hip_cooperative_groups.h>
#include <cstdio>
#include <cmath>
#include <cstring>
namespace cg = cooperative_groups;

typedef unsigned short u16;
using bf16x8 = __attribute__((ext_vector_type(8))) short;
using f32x4 = __attribute__((ext_vector_type(4))) float;
using f32x16 = __attribute__((ext_vector_type(16))) float;

#define REP_INPROJ 0
#define REP_ATTN 0
#define REP_NA 0
#define REP_SCAN 0
#define REP_MOE1 0
#define REP_MOE2 0
#define REP_SYNC 0
#define REP_MIX 0
#define REP_GEMMS 0
#define DI __device__ __forceinline__
#define NTHR 256
#define T_ALL 98304
#define T_SUB 32768
#define ZLD 3616
#define ZB_OFF 416
#define ZC_OFF 1184
#define ZD_OFF 2464
#define LOG2E 1.4426950408889634f
#define ALPHA_F 1.4142135623730951f

struct Params {
  const float *x_prompt, *x_sample, *p_prompt, *p_sample;
  const float *w_in, *mla_gq, *mla_gkv, *mla_wuq, *mla_wuk, *mla_wuv, *na_bias, *hg_lb, *hg_gnorm;
  const float *rw_mu, *rw_w0, *rw_w_up, *rw_a0, *rw_a_up, *rw_g_up, *rw_kk, *rw_ka, *rw_rk, *rw_ln_w, *rw_ln_b;
  const float *w_out, *ln1_g, *ln1_b, *moe_router, *moe_w1, *moe_w3, *moe_w2, *ln2_g, *ln2_b, *ple_gate, *ple_proj;
  float* out;
  u16 *w_in_t, *wuq_t, *wkv_t, *wup_t, *aup_t, *gup_t, *wout_t, *w13_t, *w2_t, *wg_t, *wp_t;
  float *ropec, *ropes, *lb, *affT, *gate;
  int* idx;
  unsigned* bar;
  int *inv_cnt, *inv_slot;
  u16 *z, *cat, *Q, *Kb, *Vt, *cqn, *ckvn, *S1, *rs, *ks, *vs, *kk, *gD, *dec, *kka, *kt, *oC, *oD;
  float* bonus;
  u16* xb;
  u16* O;
  u16* H;
  double inv_freq[16];
  int pb, pe;
};

typedef __bf16 v2bf_t __attribute__((ext_vector_type(2)));
typedef float v2f_t __attribute__((ext_vector_type(2)));
typedef unsigned u32x4_t __attribute__((ext_vector_type(4)));
DI unsigned pack2(float a, float b) {
  v2f_t f = {a, b};
  v2bf_t h = __builtin_convertvector(f, v2bf_t);
  return __builtin_bit_cast(unsigned, h);
}
DI u16 f2bf(float f) { return (u16)(pack2(f, 0.f) & 0xffffu); }
DI float bf2f(u16 h) { return __uint_as_float(((unsigned)h) << 16); }
DI float blo(unsigned u) { return __uint_as_float(u << 16); }
DI float bhi(unsigned u) { return __uint_as_float(u & 0xffff0000u); }
DI float sigm(float x) { return 1.f / (1.f + __expf(-x)); }
DI float tanh_(float x) { return 1.f - 2.f / (__expf(2.f * x) + 1.f); }
DI float ex2(float x) { return __builtin_amdgcn_exp2f(x); }
DI int clampi(int v, int lo, int hi) { return v < lo ? lo : (v > hi ? hi : v); }
DI int swap23(int x) { return (x & ~12) | ((x & 4) << 1) | ((x & 8) >> 1); }

template <int CTRL> DI float dpp_f(float v) {
  return __int_as_float(__builtin_amdgcn_update_dpp(0, __float_as_int(v), CTRL, 0xF, 0xF, true));
}
DI float reduce16(float v) {
  v += dpp_f<0xB1>(v);
  v += dpp_f<0x4E>(v);
  v += dpp_f<0x141>(v);
  v += dpp_f<0x140>(v);
  return v;
}
DI float wave_sum(float v) {
  v = reduce16(v);
  v += __shfl_xor(v, 16);
  v += __shfl_xor(v, 32);
  return v;
}

struct TileIter {
  int bid, nb, off;
  DI int first(int n) { int f = bid - off; if (f < 0) f += nb; off = (off + n) % nb; return f; }
};

DI bool xcd_tile(int it, int bid, int nb, int MT, int NT, int& mt, int& nt) {
  const int x = bid & 7, slot = bid >> 3, nslots = nb >> 3;
  const int mper = MT >> 3;
  const int i = slot + it * nslots;
  if (i >= mper * NT) return false;
  const int mi = i & 7, rest = i >> 3;
  nt = rest % NT;
  mt = x * mper + (rest / NT) * 8 + mi;
  return true;
}

DI void convT_job(const float* __restrict__ W, int K, int N, int Npad, u16* __restrict__ Wt, int mode, char* lds,
                  TileIter& it, int tid) {
  float(*tile)[65] = (float(*)[65])lds;
  int tk = K >> 6, tn = Npad >> 6;
  int nt = tk * tn;
  for (int t = it.first(nt); t < nt; t += it.nb) {
    int k0 = (t % tk) << 6, n0 = (t / tk) << 6;
#pragma unroll
    for (int i = 0; i < 16; i++) {
      int kl = (tid >> 6) + 4 * i, nl = tid & 63;
      int n = n0 + nl;
      tile[kl][nl] = (n < N) ? W[(size_t)(k0 + kl) * N + n] : 0.f;
    }
    __syncthreads();
    {
      int nl = tid >> 2, ks = (tid & 3) * 16;
      int n = n0 + nl;
      int row = n;
      if (mode == 1) row = (n >> 4) * 32 + (n & 15);
      if (mode == 2) row = (n >> 4) * 32 + 16 + (n & 15);
      unsigned pk[8];
#pragma unroll
      for (int j = 0; j < 8; j++) pk[j] = pack2(tile[ks + 2 * j][nl], tile[ks + 2 * j + 1][nl]);
      uint4* dst = (uint4*)(Wt + (size_t)row * K + k0 + ks);
      dst[0] = make_uint4(pk[0], pk[1], pk[2], pk[3]);
      dst[1] = make_uint4(pk[4], pk[5], pk[6], pk[7]);
    }
    __syncthreads();
  }
}

DI void phase_convert(const Params& p, char* lds, int bid, int nb, int tid) {
  TileIter it{bid, nb, 0};
  for (int l = 0; l < 2; l++) {
    convT_job(p.w_in + (size_t)l * 1024 * 3616, 1024, 3616, 3712, p.w_in_t + (size_t)l * 3712 * 1024, 0, lds, it, tid);
    convT_job(p.mla_wuq + (size_t)l * 256 * 384, 256, 384, 384, p.wuq_t + (size_t)l * 384 * 256, 0, lds, it, tid);
    convT_job(p.mla_wuk + (size_t)l * 128 * 256, 128, 256, 256, p.wkv_t + (size_t)l * 512 * 128, 0, lds, it, tid);
    convT_job(p.mla_wuv + (size_t)l * 128 * 256, 128, 256, 256, p.wkv_t + (size_t)l * 512 * 128 + 256 * 128, 0, lds, it, tid);
    for (int d = 0; d < 2; d++) {
      convT_job(p.rw_w_up + (size_t)(l * 2 + d) * 64 * 256, 64, 256, 256, p.wup_t + (size_t)(l * 2 + d) * 256 * 64, 0, lds, it, tid);
      convT_job(p.rw_a_up + (size_t)(l * 2 + d) * 64 * 256, 64, 256, 256, p.aup_t + (size_t)(l * 2 + d) * 256 * 64, 0, lds, it, tid);
    }
    convT_job(p.rw_g_up + (size_t)l * 128 * 256, 128, 256, 256, p.gup_t + (size_t)l * 256 * 128, 0, lds, it, tid);
    convT_job(p.w_out + (size_t)l * 1024 * 1024, 1024, 1024, 1024, p.wout_t + (size_t)l * 1024 * 1024, 0, lds, it, tid);
    for (int e = 0; e < 16; e++) {
      size_t le = (size_t)(l * 16 + e);
      convT_job(p.moe_w1 + le * 1024 * 512, 1024, 512, 512, p.w13_t + le * 1024 * 1024, 1, lds, it, tid);
      convT_job(p.moe_w3 + le * 1024 * 512, 1024, 512, 512, p.w13_t + le * 1024 * 1024, 2, lds, it, tid);
      convT_job(p.moe_w2 + le * 512 * 1024, 512, 1024, 1024, p.w2_t + le * 1024 * 512, 0, lds, it, tid);
    }
    convT_job(p.ple_gate + (size_t)l * 1024 * 1024, 1024, 1024, 1024, p.wg_t + (size_t)l * 1024 * 1024, 0, lds, it, tid);
    convT_job(p.ple_proj + (size_t)l * 256 * 1024, 256, 1024, 1024, p.wp_t + (size_t)l * 1024 * 256, 0, lds, it, tid);
  }
  int gt = bid * NTHR + tid, ng = nb * NTHR;
  for (size_t i0 = gt; i0 < (size_t)T_ALL * 256; i0 += (size_t)ng * 8) {
    float4 v[8];
#pragma unroll
    for (int u = 0; u < 8; u++) {
      const size_t i = i0 + (size_t)u * ng;
      v[u] = make_float4(0.f, 0.f, 0.f, 0.f);
      if (i < (size_t)T_ALL * 256)
        v[u] = (i < (size_t)32768 * 256) ? ((const float4*)p.x_prompt)[i] : ((const float4*)p.x_sample)[i - (size_t)32768 * 256];
    }
#pragma unroll
    for (int u = 0; u < 8; u++) {
      const size_t i = i0 + (size_t)u * ng;
      if (i < (size_t)T_ALL * 256) ((uint2*)p.xb)[i] = make_uint2(pack2(v[u].x, v[u].y), pack2(v[u].z, v[u].w));
    }
  }
  for (int i = gt; i < 8192 * 16; i += ng) {
    int n = i >> 4, f = i & 15;
    double ifq = 0.0;
#pragma unroll
    for (int j = 0; j < 16; j++) ifq = (f == j) ? p.inv_freq[j] : ifq;
    double rev = (double)n * ifq * 0.15915494309189535;
    double fr = rev - rint(rev);
    float ff = (float)fr;
    p.ropec[i] = __builtin_amdgcn_cosf(ff);
    p.ropes[i] = __builtin_amdgcn_sinf(ff);
  }
  for (int i = gt; i < 512; i += ng) {
    float h0 = p.hg_lb[i], h1 = p.hg_lb[512 + i];
    p.lb[i] = 0.f;
    p.lb[512 + i] = 1.f / (1.f + __expf(h0 - h1));
  }
}

constexpr int G_STAGE = 32768;

template <bool AF32, class RowFn, class Epi>
DI void gemm_tile(RowFn rowfn, const u16* __restrict__ Bt, int K, Epi epi, char* lds, int tid) {
  const int lane = tid & 63, wid = tid >> 6, wr = wid >> 1, wc = wid & 1, fr = lane & 15, fq = lane >> 4;
  f32x4 acc[4][4];
#pragma unroll
  for (int m = 0; m < 4; m++)
#pragma unroll
    for (int n = 0; n < 4; n++) acc[m][n] = f32x4{0.f, 0.f, 0.f, 0.f};

  const int lrow = tid >> 3;
  const int lc = (tid & 7) ^ ((tid >> 4) & 7);
  const float* apf[8];
  const u16* aph[4];
  const u16* bp[4];
  if constexpr (AF32) {
#pragma unroll
    for (int i = 0; i < 8; i++) apf[i] = (const float*)rowfn(i * 16 + (tid >> 4)) + (tid & 15) * 4;
  } else {
#pragma unroll
    for (int i = 0; i < 4; i++) aph[i] = (const u16*)rowfn(lrow + i * 32) + lc * 8;
  }
#pragma unroll
  for (int i = 0; i < 4; i++) bp[i] = Bt + (size_t)(lrow + i * 32) * K + lc * 8;
  const int afoff = (tid >> 4) * 128 + ((((tid & 15) >> 1) ^ ((tid >> 5) & 7)) * 16) + (tid & 1) * 8;

  float4 raf[8];
  auto issue = [&](int buf, int k0) {
    char* A = lds + buf * G_STAGE;
    char* B = A + 16384;
#pragma unroll
    for (int i = 0; i < 4; i++)
      __builtin_amdgcn_global_load_lds((const unsigned*)(bp[i] + k0), (unsigned*)(B + wid * 1024 + i * 4096), 16, 0, 0);
    if constexpr (AF32) {
#pragma unroll
      for (int i = 0; i < 8; i++) raf[i] = *(const float4*)(apf[i] + k0);
    } else {
#pragma unroll
      for (int i = 0; i < 4; i++)
        __builtin_amdgcn_global_load_lds((const unsigned*)(aph[i] + k0), (unsigned*)(A + wid * 1024 + i * 4096), 16, 0, 0);
    }
  };
  auto astore = [&](int buf) {
    if constexpr (AF32) {
      char* A = lds + buf * G_STAGE;
#pragma unroll
      for (int i = 0; i < 8; i++) asm volatile("" : "+v"(raf[i].x), "+v"(raf[i].y), "+v"(raf[i].z), "+v"(raf[i].w));
#pragma unroll
      for (int i = 0; i < 8; i++)
        *(uint2*)(A + afoff + i * 2048) = make_uint2(pack2(raf[i].x, raf[i].y), pack2(raf[i].z, raf[i].w));
    }
  };
  const int abase = (wr * 64 + fr) * 128, bbase = 16384 + (wc * 64 + fr) * 128;
  const int sw0 = ((fq) ^ (fr >> 1)) * 16, sw1 = ((4 + fq) ^ (fr >> 1)) * 16;

  const int nk = K >> 6;
  if constexpr (AF32) {
    issue(0, 0);
    astore(0);
    __syncthreads();
    for (int kt = 0; kt < nk; kt++) {
      const char* S = lds + (kt & 1) * G_STAGE;
      bf16x8 af[2][4], bfr[2][4];
#pragma unroll
      for (int kk = 0; kk < 2; kk++) {
        const int sw = kk ? sw1 : sw0;
#pragma unroll
        for (int m = 0; m < 4; m++) af[kk][m] = *(const bf16x8*)(S + abase + m * 2048 + sw);
#pragma unroll
        for (int n = 0; n < 4; n++) bfr[kk][n] = *(const bf16x8*)(S + bbase + n * 2048 + sw);
      }
      __builtin_amdgcn_sched_barrier(0);
      if (kt + 1 < nk) issue((kt + 1) & 1, (kt + 1) << 6);
      __builtin_amdgcn_sched_barrier(0);
#pragma unroll
      for (int kk = 0; kk < 2; kk++)
#pragma unroll
        for (int m = 0; m < 4; m++)
#pragma unroll
          for (int n = 0; n < 4; n++) acc[m][n] = __builtin_amdgcn_mfma_f32_16x16x32_bf16(bfr[kk][n], af[kk][m], acc[m][n], 0, 0, 0);
      __builtin_amdgcn_sched_barrier(0);
      if (kt + 1 < nk) astore((kt + 1) & 1);
      __syncthreads();
    }
  } else {
    const unsigned lds0 = (unsigned)(size_t)(__attribute__((address_space(3))) char*)lds;
    const unsigned aA0 = lds0 + abase + sw0, aA1 = lds0 + abase + sw1, aB0 = lds0 + bbase + sw0, aB1 = lds0 + bbase + sw1;
#define G_DSR(dst, addr, off) asm volatile("ds_read_b128 %0, %1 offset:%2" : "=v"(dst) : "v"(addr), "n"(off))
    issue(0, 0);
    if (nk > 1) issue(1, 64);
    for (int kt = 0; kt < nk; kt++) {
      if (kt + 1 < nk) asm volatile("s_waitcnt vmcnt(8)" ::: "memory");
      else asm volatile("s_waitcnt vmcnt(0)" ::: "memory");
      __builtin_amdgcn_s_barrier();
      const unsigned so = (kt & 1) * G_STAGE;
      const unsigned pA0 = aA0 + so, pA1 = aA1 + so, pB0 = aB0 + so, pB1 = aB1 + so;
      bf16x8 a00, a01, a02, a03, a10, a11, a12, a13, b00, b01, b02, b03, b10, b11, b12, b13;
      G_DSR(a00, pA0, 0); G_DSR(a01, pA0, 2048); G_DSR(a02, pA0, 4096); G_DSR(a03, pA0, 6144);
      G_DSR(b00, pB0, 0); G_DSR(b01, pB0, 2048); G_DSR(b02, pB0, 4096); G_DSR(b03, pB0, 6144);
      G_DSR(a10, pA1, 0); G_DSR(a11, pA1, 2048); G_DSR(a12, pA1, 4096); G_DSR(a13, pA1, 6144);
      G_DSR(b10, pB1, 0); G_DSR(b11, pB1, 2048); G_DSR(b12, pB1, 4096); G_DSR(b13, pB1, 6144);
      asm volatile("s_waitcnt lgkmcnt(0)" : "+v"(a00), "+v"(a01), "+v"(a02), "+v"(a03), "+v"(b00), "+v"(b01), "+v"(b02), "+v"(b03));
      asm volatile("" : "+v"(a10), "+v"(a11), "+v"(a12), "+v"(a13), "+v"(b10), "+v"(b11), "+v"(b12), "+v"(b13));
      __builtin_amdgcn_s_barrier();
      if (kt + 2 < nk) issue(kt & 1, (kt + 2) << 6);
      __builtin_amdgcn_sched_barrier(0);
      {
        const bf16x8 af0[4] = {a00, a01, a02, a03}, af1[4] = {a10, a11, a12, a13};
        const bf16x8 bf0[4] = {b00, b01, b02, b03}, bf1[4] = {b10, b11, b12, b13};
#pragma unroll
        for (int m = 0; m < 4; m++)
#pragma unroll
          for (int n = 0; n < 4; n++) acc[m][n] = __builtin_amdgcn_mfma_f32_16x16x32_bf16(bf0[n], af0[m], acc[m][n], 0, 0, 0);
#pragma unroll
        for (int m = 0; m < 4; m++)
#pragma unroll
          for (int n = 0; n < 4; n++) acc[m][n] = __builtin_amdgcn_mfma_f32_16x16x32_bf16(bf1[n], af1[m], acc[m][n], 0, 0, 0);
      }
      __builtin_amdgcn_sched_barrier(0);
    }
  }
  epi(acc, wr * 64 + fr, wc * 64 + fq * 4);
}

#define EPI_LOOP(...)                                    \
  _Pragma("unroll") for (int m = 0; m < 4; m++)          \
  _Pragma("unroll") for (int n = 0; n < 4; n++) {        \
    const int row = rbase + m * 16;                      \
    const int col = cbase + n * 16;                      \
    const f32x4 v = acc[m][n];                           \
    __VA_ARGS__                                          \
  }

DI void st_bf4(u16* dst, f32x4 v) { *(uint2*)dst = make_uint2(pack2(v[0], v[1]), pack2(v[2], v[3])); }

DI const float* xin_row(const Params& p, int l, int tg) {
  if (l == 0) return tg < 32768 ? p.x_prompt + (size_t)tg * 1024 : p.x_sample + (size_t)(tg - 32768) * 1024;
  return p.out + (size_t)tg * 1024;
}

DI void phase_inproj(const Params& p, int l, int tok0, char* lds, int bid, int nb, int tid) {
  const int NT = 29, MT = T_SUB / 128;
  for (int it = 0;; it++) {
    int nt, mt;
    if (!xcd_tile(it, bid, nb, MT, NT, mt, nt)) break;
    int m0 = mt * 128, n0 = nt * 128;
    auto rowfn = [&](int r) -> const void* { return p.xb + (size_t)(tok0 + m0 + r) * 1024; };
    u16* z = p.z;
    auto epi = [&](f32x4(&acc)[4][4], int rbase, int cbase) {
      EPI_LOOP({
        int c = n0 + col;
        if (c < ZLD) st_bf4(z + (size_t)(m0 + row) * ZLD + c, v);
      })
    };
    gemm_tile<false>(rowfn, p.w_in_t + ((size_t)l * 3712 + n0) * 1024, 1024, epi, lds, tid);
  }
}

struct PrepIn {
  uint2 cq;
  unsigned ckv;
  u16 kr1, kr2;
  float rc, rsn;
  uint4 f;
  uint2 cur[3], prv[3], nxt[3];
  u16 sc[6], sp[6], sn[6];
};
DI void prep_load(PrepIn& in, const Params& p, int t, int N, int lane) {
  const int l15 = lane & 15, c4 = lane * 4;
  const u16* zr = p.z + (size_t)t * ZLD;
  const int n = t & (N - 1);
  const bool hp = n > 0, hn = n < N - 1;
  const u16* zd = zr + ZD_OFF;
  const u16* zdp = zd - (hp ? ZLD : 0);
  const u16* zdn = zd + (hn ? ZLD : 0);
  in.cq = *(const uint2*)(zr + c4);
  in.ckv = *(const unsigned*)(zr + 256 + lane * 2);
  in.kr1 = zr[384 + l15];
  in.kr2 = zr[400 + l15];
  in.rc = p.ropec[n * 16 + l15];
  in.rsn = p.ropes[n * 16 + l15];
  in.f = *(const uint4*)(zr + ZC_OFF + 256 + lane * 8);
#pragma unroll
  for (int part = 0; part < 3; part++) {
    in.cur[part] = *(const uint2*)(zd + part * 256 + c4);
    in.prv[part] = *(const uint2*)(zdp + part * 256 + c4);
    in.nxt[part] = *(const uint2*)(zdn + part * 256 + c4);
  }
#pragma unroll
  for (int i = 0; i < 6; i++) {
    in.sc[i] = zd[768 + lane + 64 * i];
    in.sp[i] = zdp[768 + lane + 64 * i];
    in.sn[i] = zdn[768 + lane + 64 * i];
  }
}

DI void phase_prep(const Params& p, int l, int N, int bid, int nb, int tid) {
  const int lane = tid & 63, wv = tid >> 6, l15 = lane & 15, c4 = lane * 4;
  float gqv[4], gkvv[2], lbv[8], m0[12], m1[12], m0s[6], m1s[6], kkc[4], rkc[4];
  {
    const float* mu0 = p.rw_mu + (size_t)l * 2 * 1152;
    const float* mu1 = mu0 + 1152;
#pragma unroll
    for (int j = 0; j < 4; j++) {
      gqv[j] = p.mla_gq[l * 256 + c4 + j];
      kkc[j] = p.rw_kk[l * 256 + c4 + j];
      rkc[j] = p.rw_rk[l * 256 + c4 + j];
    }
    gkvv[0] = p.mla_gkv[l * 128 + lane * 2];
    gkvv[1] = p.mla_gkv[l * 128 + lane * 2 + 1];
#pragma unroll
    for (int j = 0; j < 8; j++) lbv[j] = p.lb[l * 512 + lane * 8 + j];
#pragma unroll
    for (int part = 0; part < 3; part++)
#pragma unroll
      for (int j = 0; j < 4; j++) {
        m0[part * 4 + j] = mu0[part * 256 + c4 + j];
        m1[part * 4 + j] = mu1[part * 256 + c4 + j];
      }
#pragma unroll
    for (int i = 0; i < 6; i++) {
      m0s[i] = mu0[768 + lane + 64 * i];
      m1s[i] = mu1[768 + lane + 64 * i];
    }
  }
  PrepIn in, inn;
  {
    const int t0 = bid * 4 + wv;
    if (t0 < T_SUB) prep_load(in, p, t0, N, lane);
  }
  for (int t = bid * 4 + wv; t < T_SUB; t += nb * 4) {
    u16* zr = p.z + (size_t)t * ZLD;
    const int n = t & (N - 1);
    const bool hp = n > 0, hn = n < N - 1;
    {
      const int tn = t + nb * 4;
      if (tn < T_SUB) prep_load(inn, p, tn, N, lane);
      else inn = in;
    }
    const uint2 raw_cq = in.cq;
    const unsigned raw_ckv = in.ckv;
    const u16 kr1 = in.kr1, kr2 = in.kr2;
    const float rc = in.rc, rsn = in.rsn;
    uint4* fptr = (uint4*)(zr + ZC_OFF + 256 + lane * 8);
    const uint4 raw_f = in.f;
    uint2 cur[3], prv[3], nxt[3];
    u16 sc[6], sp[6], sn[6];
#pragma unroll
    for (int part = 0; part < 3; part++) { cur[part] = in.cur[part]; prv[part] = in.prv[part]; nxt[part] = in.nxt[part]; }
#pragma unroll
    for (int i = 0; i < 6; i++) { sc[i] = in.sc[i]; sp[i] = in.sp[i]; sn[i] = in.sn[i]; }
    {
      float v0 = blo(raw_cq.x), v1 = bhi(raw_cq.x), v2 = blo(raw_cq.y), v3 = bhi(raw_cq.y);
      float ss = wave_sum(v0 * v0 + v1 * v1 + v2 * v2 + v3 * v3);
      float ri = rsqrtf(ss * (1.f / 256.f) + 1e-6f);
      *(uint2*)(p.cqn + (size_t)t * 256 + c4) =
          make_uint2(pack2(v0 * ri * gqv[0], v1 * ri * gqv[1]), pack2(v2 * ri * gqv[2], v3 * ri * gqv[3]));
    }
    {
      float v0 = blo(raw_ckv), v1 = bhi(raw_ckv);
      float ss = wave_sum(v0 * v0 + v1 * v1);
      float ri = rsqrtf(ss * (1.f / 128.f) + 1e-6f);
      *(unsigned*)(p.ckvn + (size_t)t * 128 + lane * 2) = pack2(v0 * ri * gkvv[0], v1 * ri * gkvv[1]);
    }
    if (lane < 16) {
      float x1 = bf2f(kr1), x2 = bf2f(kr2);
      u16 k1 = f2bf(x1 * rc - x2 * rsn), k2 = f2bf(x1 * rsn + x2 * rc);
      u16* kb = p.Kb + (size_t)t * 384;
#pragma unroll
      for (int h = 0; h < 4; h++) {
        kb[h * 96 + 64 + lane] = k1;
        kb[h * 96 + 80 + lane] = k2;
      }
    }
    {
      unsigned w[4] = {raw_f.x, raw_f.y, raw_f.z, raw_f.w};
#pragma unroll
      for (int j = 0; j < 4; j++) {
        float a = blo(w[j]), bq = bhi(w[j]);
        float la = lbv[2 * j], lb2 = lbv[2 * j + 1];
        a = la + (1.f - la) * sigm(a);
        bq = lb2 + (1.f - lb2) * sigm(bq);
        w[j] = pack2(a, bq);
      }
      *fptr = make_uint4(w[0], w[1], w[2], w[3]);
    }
    {
      float rr[4], kx[4], vx[4];
#pragma unroll
      for (int part = 0; part < 3; part++) {
        float cz[4] = {blo(cur[part].x), bhi(cur[part].x), blo(cur[part].y), bhi(cur[part].y)};
        float pz[4] = {blo(prv[part].x), bhi(prv[part].x), blo(prv[part].y), bhi(prv[part].y)};
        float nz[4] = {blo(nxt[part].x), bhi(nxt[part].x), blo(nxt[part].y), bhi(nxt[part].y)};
#pragma unroll
        for (int j = 0; j < 4; j++) {
          float pzz = hp ? pz[j] : 0.f, nzz = hn ? nz[j] : 0.f;
          float o = cz[j] + m0[part * 4 + j] * (pzz - cz[j]) + m1[part * 4 + j] * (nzz - cz[j]);
          if (part == 0) rr[j] = o;
          if (part == 1) kx[j] = o;
          if (part == 2) vx[j] = o;
        }
      }
      *(uint2*)(p.rs + (size_t)t * 256 + c4) = make_uint2(pack2(rr[0], rr[1]), pack2(rr[2], rr[3]));
      *(uint2*)(p.ks + (size_t)t * 256 + c4) = make_uint2(pack2(kx[0], kx[1]), pack2(kx[2], kx[3]));
      *(uint2*)(p.vs + (size_t)t * 256 + c4) = make_uint2(pack2(vx[0], vx[1]), pack2(vx[2], vx[3]));
      float kq[4], ss = 0.f, bo = 0.f;
#pragma unroll
      for (int j = 0; j < 4; j++) {
        kq[j] = kx[j] * kkc[j];
        ss += kq[j] * kq[j];
        bo += rr[j] * kx[j] * rkc[j];
      }
      ss = reduce16(ss);
      bo = reduce16(bo);
      float inv = 1.f / fmaxf(sqrtf(ss), 1e-12f);
      *(uint2*)(p.kk + (size_t)t * 256 + c4) = make_uint2(pack2(kq[0] * inv, kq[1] * inv), pack2(kq[2] * inv, kq[3] * inv));
      if (l15 == 0) p.bonus[(size_t)t * 4 + (lane >> 4)] = bo;
#pragma unroll
      for (int i = 0; i < 6; i++) {
        float cz = bf2f(sc[i]);
        float pz = hp ? bf2f(sp[i]) : 0.f;
        float nz = hn ? bf2f(sn[i]) : 0.f;
        float o = cz + m0s[i] * (pz - cz) + m1s[i] * (nz - cz);
        if (i < 2) o = tanh_(o);
        else if (i >= 4) o = sigm(o);
        p.S1[(size_t)t * 384 + lane + 64 * i] = f2bf(o);
      }
    }
    in = inn;
  }
}

DI void phase_smallgemm(const Params& p, int l, int B, int N, char* lds, int bid, int nb, int tid) {
  TileIter it{bid, nb, 0};
  const int MT = T_SUB / 128;
  {
    const int NT = 3;
    for (int itx = 0;; itx++) {
      int nt, mt;
      if (!xcd_tile(itx, bid, nb, MT, NT, mt, nt)) break;
      int m0 = mt * 128, n0 = nt * 128;
      auto rowfn = [&](int r) -> const void* { return p.cqn + (size_t)(m0 + r) * 256; };
      u16* Q = p.Q;
      auto epi = [&](f32x4(&acc)[4][4], int rbase, int cbase) {
        const float SC = 0.10206207261596577f * LOG2E;
        EPI_LOOP({ st_bf4(Q + (size_t)(m0 + row) * 384 + n0 + col, v * SC); })
      };
      gemm_tile<false>(rowfn, p.wuq_t + ((size_t)l * 384 + n0) * 256, 256, epi, lds, tid);
    }
  }
  {
    const int NT = 4;
    for (int itx = 0;; itx++) {
      int nt, mt;
      if (!xcd_tile(itx, bid, nb, MT, NT, mt, nt)) break;
      int m0 = mt * 128, n0 = nt * 128;
      auto rowfn = [&](int r) -> const void* { return p.ckvn + (size_t)(m0 + r) * 128; };
      u16* Kb = p.Kb;
      u16* Vt = p.Vt;
      auto epi = [&](f32x4(&acc)[4][4], int rbase, int cbase) {
        EPI_LOOP({
          int c = n0 + col;
          int tk = m0 + row;
          if (c < 256) {
            int h = c >> 6, d = c & 63;
            st_bf4(Kb + (size_t)tk * 384 + h * 96 + d, v);
          } else {
            int cc = c - 256;
            int b = tk / N, nn = tk - b * N;
            u16* dst = Vt + ((size_t)(b * 256 + cc)) * N + nn;
            dst[0] = f2bf(v[0]);
            dst[(size_t)N] = f2bf(v[1]);
            dst[(size_t)2 * N] = f2bf(v[2]);
            dst[(size_t)3 * N] = f2bf(v[3]);
          }
        })
      };
      gemm_tile<false>(rowfn, p.wkv_t + ((size_t)l * 512 + n0) * 128, 128, epi, lds, tid);
    }
  }
  for (int d = 0; d < 2; d++) {
    const int NT = 2;
    for (int itx = 0;; itx++) {
      int nt, mt;
      if (!xcd_tile(itx, bid, nb, MT, NT, mt, nt)) break;
      int m0 = mt * 128, n0 = nt * 128;
      auto rowfn = [&](int r) -> const void* { return p.S1 + (size_t)(m0 + r) * 384 + d * 64; };
      u16* dst = p.dec + (size_t)d * T_SUB * 256;
      const float* w0 = p.rw_w0 + (l * 2 + d) * 256;
      auto epi = [&](f32x4(&acc)[4][4], int rbase, int cbase) {
        EPI_LOOP({
          f32x4 o;
          for (int j = 0; j < 4; j++) o[j] = __expf(-0.6065306597126334f * sigm(w0[n0 + col + j] + v[j]));
          st_bf4(dst + (size_t)(m0 + row) * 256 + n0 + col, o);
        })
      };
      gemm_tile<false>(rowfn, p.wup_t + ((size_t)(l * 2 + d) * 256 + n0) * 64, 64, epi, lds, tid);
    }
  }
  for (int d = 0; d < 2; d++) {
    const int NT = 2;
    for (int itx = 0;; itx++) {
      int nt, mt;
      if (!xcd_tile(itx, bid, nb, MT, NT, mt, nt)) break;
      int m0 = mt * 128, n0 = nt * 128;
      auto rowfn = [&](int r) -> const void* { return p.S1 + (size_t)(m0 + r) * 384 + 128 + d * 64; };
      u16* dka = p.kka + (size_t)d * T_SUB * 256;
      u16* dkt = p.kt + (size_t)d * T_SUB * 256;
      const float* a0 = p.rw_a0 + (l * 2 + d) * 256;
      const float* ka = p.rw_ka + l * 256;
      const u16* kkp = p.kk;
      const u16* ksp = p.ks;
      auto epi = [&](f32x4(&acc)[4][4], int rbase, int cbase) {
        EPI_LOOP({
          size_t o = (size_t)(m0 + row) * 256 + n0 + col;
          uint2 kkr = *(const uint2*)(kkp + o);
          uint2 ksr = *(const uint2*)(ksp + o);
          float kkv[4] = {blo(kkr.x), bhi(kkr.x), blo(kkr.y), bhi(kkr.y)};
          float ksv[4] = {blo(ksr.x), bhi(ksr.x), blo(ksr.y), bhi(ksr.y)};
          f32x4 o1, o2;
          for (int j = 0; j < 4; j++) {
            float a = sigm(a0[n0 + col + j] + v[j]);
            o1[j] = kkv[j] * a;
            o2[j] = ksv[j] * (1.f + (a - 1.f) * ka[n0 + col + j]);
          }
          st_bf4(dka + o, o1);
          st_bf4(dkt + o, o2);
        })
      };
      gemm_tile<false>(rowfn, p.aup_t + ((size_t)(l * 2 + d) * 256 + n0) * 64, 64, epi, lds, tid);
    }
  }
  {
    const int NT = 2;
    for (int itx = 0;; itx++) {
      int nt, mt;
      if (!xcd_tile(itx, bid, nb, MT, NT, mt, nt)) break;
      int m0 = mt * 128, n0 = nt * 128;
      auto rowfn = [&](int r) -> const void* { return p.S1 + (size_t)(m0 + r) * 384 + 256; };
      u16* dst = p.gD;
      auto epi = [&](f32x4(&acc)[4][4], int rbase, int cbase) {
        EPI_LOOP({ st_bf4(dst + (size_t)(m0 + row) * 256 + n0 + col, v); })
      };
      gemm_tile<false>(rowfn, p.gup_t + ((size_t)l * 256 + n0) * 128, 128, epi, lds, tid);
    }
  }
}

DI bf16x8 pack8(const f32x16& s, int o) {
  u32x4_t r = {pack2(s[o], s[o + 1]), pack2(s[o + 2], s[o + 3]), pack2(s[o + 4], s[o + 5]), pack2(s[o + 6], s[o + 7])};
  return __builtin_bit_cast(bf16x8, r);
}

constexpr int AT_KP = 208, AT_VP = 144, AT_BUF = 64 * AT_KP + 64 * AT_VP;
DI void attn_task(const Params& p, int task, int N, char* lds, int tid) {
  const int lane = tid & 63, wv = tid >> 6, r = lane & 31, hf = lane >> 5;
  const int nqb = N >> 7;
  {
    const int qb = task % nqb, bh = task / nqb, h = bh & 3, b = bh >> 2;
    const size_t tb = (size_t)b * N;
    const int q = qb * 128 + wv * 32 + r;
    bf16x8 qf[6];
    {
      const u16* qrow = p.Q + (tb + q) * 384 + h * 96;
#pragma unroll
      for (int ks = 0; ks < 4; ks++) qf[ks] = *(const bf16x8*)(qrow + ks * 16 + hf * 8);
      bf16x8 x1r = *(const bf16x8*)(qrow + 64 + hf * 8);
      bf16x8 x2r = *(const bf16x8*)(qrow + 80 + hf * 8);
      const float* cp = p.ropec + q * 16 + hf * 8;
      const float* sp = p.ropes + q * 16 + hf * 8;
      float ra[8], rb[8];
#pragma unroll
      for (int j = 0; j < 8; j++) {
        float xa = bf2f((u16)x1r[j]), ya = bf2f((u16)x2r[j]);
        float c0 = cp[j], s0 = sp[j];
        ra[j] = xa * c0 - ya * s0;
        rb[j] = xa * s0 + ya * c0;
      }
      u32x4_t o1 = {pack2(ra[0], ra[1]), pack2(ra[2], ra[3]), pack2(ra[4], ra[5]), pack2(ra[6], ra[7])};
      u32x4_t o2 = {pack2(rb[0], rb[1]), pack2(rb[2], rb[3]), pack2(rb[4], rb[5]), pack2(rb[6], rb[7])};
      qf[4] = __builtin_bit_cast(bf16x8, o1);
      qf[5] = __builtin_bit_cast(bf16x8, o2);
    }
    const u16* Kg = p.Kb + tb * 384 + h * 96;
    const u16* Vg = p.Vt + ((size_t)(b * 4 + h) * 64) * N;
    uint4 kr0, kr1, kr2, vr0, vr1;
    const int lkey = tid >> 2, lpart = tid & 3;
    const int lrow = swap23(lkey);
#define AT_GLOAD(kt_)                                                              \
  {                                                                                \
    const u16* kp_ = Kg + (size_t)((kt_) * 64 + lkey) * 384 + lpart * 24;          \
    kr0 = *(const uint4*)(kp_);                                                    \
    kr1 = *(const uint4*)(kp_ + 8);                                                \
    kr2 = *(const uint4*)(kp_ + 16);                                               \
    const u16* vp_ = Vg + (size_t)lkey * N + (kt_) * 64 + lpart * 16;              \
    vr0 = *(const uint4*)(vp_);                                                    \
    vr1 = *(const uint4*)(vp_ + 8);                                                \
  }
#define AT_LSTORE(buf_)                                                            \
  {                                                                                \
    char* Kl_ = lds + (buf_) * AT_BUF;                                             \
    char* Vl_ = Kl_ + 64 * AT_KP;                                                  \
    *(uint4*)(Kl_ + lrow * AT_KP + (lpart * 3 + 0) * 16) = kr0;                    \
    *(uint4*)(Kl_ + lrow * AT_KP + (lpart * 3 + 1) * 16) = kr1;                    \
    *(uint4*)(Kl_ + lrow * AT_KP + (lpart * 3 + 2) * 16) = kr2;                    \
    *(uint4*)(Vl_ + lkey * AT_VP + (lpart * 2 + 0) * 16) = vr0;                    \
    *(uint4*)(Vl_ + lkey * AT_VP + (lpart * 2 + 1) * 16) = vr1;                    \
  }
    f32x16 O0, O1;
#pragma unroll
    for (int i = 0; i < 16; i++) { O0[i] = 0.f; O1[i] = 0.f; }
    float mrun = 0.f, lrun = 0.f;
    const int nt = N >> 6;
    __syncthreads();
    AT_GLOAD(0);
    AT_LSTORE(0);
    __syncthreads();
    for (int kt = 0; kt < nt; kt++) {
      if (kt + 1 < nt) AT_GLOAD(kt + 1);
      __builtin_amdgcn_sched_barrier(0);
      const char* Kl = lds + (kt & 1) * AT_BUF;
      const char* Vl = Kl + 64 * AT_KP;
      f32x16 S0, S1;
      {
        const float nm = -mrun;
#pragma unroll
        for (int i = 0; i < 16; i++) { S0[i] = nm; S1[i] = nm; }
      }
#pragma unroll
      for (int ks = 0; ks < 6; ks++) {
        bf16x8 a0 = *(const bf16x8*)(Kl + r * AT_KP + ks * 32 + hf * 16);
        bf16x8 a1 = *(const bf16x8*)(Kl + (32 + r) * AT_KP + ks * 32 + hf * 16);
        S0 = __builtin_amdgcn_mfma_f32_32x32x16_bf16(a0, qf[ks], S0, 0, 0, 0);
        S1 = __builtin_amdgcn_mfma_f32_32x32x16_bf16(a1, qf[ks], S1, 0, 0, 0);
      }
      float mx = fmaxf(S0[0], S1[0]);
#pragma unroll
      for (int i = 1; i < 16; i++) mx = fmaxf(mx, fmaxf(S0[i], S1[i]));
      if (__any((mx > 12.f) || (kt == 0))) {
        const float mq = fmaxf(mx, __shfl_xor(mx, 32));
        const float shift = (kt == 0) ? mq : ((mq > 12.f) ? mq : 0.f);
        const float sc = (kt == 0) ? 1.f : ex2(-shift);
        mrun += shift;
        lrun *= sc;
#pragma unroll
        for (int i = 0; i < 16; i++) {
          S0[i] -= shift;
          S1[i] -= shift;
          O0[i] *= sc;
          O1[i] *= sc;
        }
      }
      float ls = 0.f;
#pragma unroll
      for (int i = 0; i < 16; i++) {
        S0[i] = ex2(S0[i]);
        S1[i] = ex2(S1[i]);
        ls += S0[i] + S1[i];
      }
      lrun += ls;
#pragma unroll
      for (int sp = 0; sp < 4; sp++) {
        bf16x8 pb = (sp < 2) ? pack8(S0, (sp & 1) * 8) : pack8(S1, (sp & 1) * 8);
        bf16x8 v0 = *(const bf16x8*)(Vl + r * AT_VP + sp * 32 + hf * 16);
        bf16x8 v1 = *(const bf16x8*)(Vl + (32 + r) * AT_VP + sp * 32 + hf * 16);
        O0 = __builtin_amdgcn_mfma_f32_32x32x16_bf16(v0, pb, O0, 0, 0, 0);
        O1 = __builtin_amdgcn_mfma_f32_32x32x16_bf16(v1, pb, O1, 0, 0, 0);
      }
      __builtin_amdgcn_sched_barrier(0);
      if (kt + 1 < nt) AT_LSTORE((kt + 1) & 1);
      __syncthreads();
    }
    float lt = lrun + __shfl_xor(lrun, 32);
    float inv = 1.f / lt;
    u16* orow = p.cat + (tb + q) * 1024 + h * 64;
#pragma unroll
    for (int g = 0; g < 4; g++) {
      int d0 = 8 * g + 4 * hf;
      *(uint2*)(orow + d0) = make_uint2(pack2(O0[4 * g] * inv, O0[4 * g + 1] * inv), pack2(O0[4 * g + 2] * inv, O0[4 * g + 3] * inv));
      *(uint2*)(orow + 32 + d0) = make_uint2(pack2(O1[4 * g] * inv, O1[4 * g + 1] * inv), pack2(O1[4 * g + 2] * inv, O1[4 * g + 3] * inv));
    }
  }
}

DI void na_task(const Params& p, int l, int task, int N, int tid) {
  const int lane = tid & 63, head = tid >> 6, r = lane & 31, hf = lane >> 5;
  const int rows = N >> 6;
  const int nrb = rows >> 1;
  const float* bias = p.na_bias + (size_t)(l * 4 + head) * 15 * 31;
  {
    const int cb = task & 3, rb = (task >> 2) % nrb, b = (task >> 2) / nrb;
    const size_t tb = (size_t)b * N;
    const int qrow0 = rb * 2;
    const int rstart0 = clampi(qrow0 - 4, 0, rows - 8);
    const int k0 = clampi(rstart0, 0, rows - 9);
    const int kstart = clampi(cb * 16 - 8, 0, 32);
    const int iq = r >> 4, u = r & 15;
    const int qrow = qrow0 + iq, qcol = cb * 16 + u;
    const int rstart = clampi(qrow - 4, 0, rows - 8);
    const int cstart = clampi(qcol - 8, 0, 48);
    bf16x8 qf[4];
    {
      const u16* qp = p.z + (tb + qrow * 64 + qcol) * ZLD + ZB_OFF + head * 64;
#pragma unroll
      for (int ks = 0; ks < 4; ks++) qf[ks] = *(const bf16x8*)(qp + ks * 16 + hf * 8);
    }
    f32x16 O0, O1;
#pragma unroll
    for (int i = 0; i < 16; i++) { O0[i] = 0.f; O1[i] = 0.f; }
    float mrun = -1e30f, lrun = 0.f;
    const int wk = swap23(r);
    for (int j = 0; j < 9; j++) {
      const int krow = k0 + j;
      const u16* kp = p.z + (tb + krow * 64 + kstart + wk) * ZLD + ZB_OFF + 256 + head * 64;
      f32x16 S;
#pragma unroll
      for (int i = 0; i < 16; i++) S[i] = 0.f;
#pragma unroll
      for (int ks = 0; ks < 4; ks++) {
        bf16x8 a = *(const bf16x8*)(kp + ks * 16 + hf * 8);
        S = __builtin_amdgcn_mfma_f32_32x32x16_bf16(a, qf[ks], S, 0, 0, 0);
      }
      const bool rok = (krow >= rstart) && (krow < rstart + 8);
      const int drow = clampi(krow - qrow + 7, 0, 14);
      const float* brow = bias + drow * 31;
      float mx = -1e30f;
#pragma unroll
      for (int i = 0; i < 16; i++) {
        int w = 16 * (i >> 3) + 8 * hf + 4 * ((i >> 2) & 1) + (i & 3);
        int kcol = kstart + w;
        bool ok = rok && (kcol >= cstart) && (kcol < cstart + 16);
        int dcol = clampi(kcol - qcol + 15, 0, 30);
        float s = (S[i] * 0.125f + brow[dcol]) * LOG2E;
        S[i] = ok ? s : -1e30f;
        mx = fmaxf(mx, S[i]);
      }
      mx = fmaxf(mx, __shfl_xor(mx, 32));
      float mn = fmaxf(mrun, mx);
      float alpha = ex2(mrun - mn);
      mrun = mn;
      float ls = 0.f;
#pragma unroll
      for (int i = 0; i < 16; i++) {
        float pv = (S[i] > -1e29f) ? ex2(S[i] - mn) : 0.f;
        S[i] = pv;
        ls += pv;
      }
      lrun = lrun * alpha + ls;
#pragma unroll
      for (int i = 0; i < 16; i++) { O0[i] *= alpha; O1[i] *= alpha; }
      const u16* vbase = p.z + (tb + krow * 64 + kstart) * ZLD + ZB_OFF + 512 + head * 64 + r;
#pragma unroll
      for (int s = 0; s < 2; s++) {
        bf16x8 pb = pack8(S, s * 8);
        bf16x8 v0, v1;
#pragma unroll
        for (int jj = 0; jj < 8; jj++) {
          const u16* vp = vbase + (size_t)(16 * s + 8 * hf + jj) * ZLD;
          v0[jj] = (short)vp[0];
          v1[jj] = (short)vp[32];
        }
        O0 = __builtin_amdgcn_mfma_f32_32x32x16_bf16(v0, pb, O0, 0, 0, 0);
        O1 = __builtin_amdgcn_mfma_f32_32x32x16_bf16(v1, pb, O1, 0, 0, 0);
      }
    }
    float lt = lrun + __shfl_xor(lrun, 32);
    float inv = 1.f / lt;
    u16* orow = p.cat + (tb + qrow * 64 + qcol) * 1024 + 256 + head * 64;
#pragma unroll
    for (int g = 0; g < 4; g++) {
      int d0 = 8 * g + 4 * hf;
      *(uint2*)(orow + d0) = make_uint2(pack2(O0[4 * g] * inv, O0[4 * g + 1] * inv), pack2(O0[4 * g + 2] * inv, O0[4 * g + 3] * inv));
      *(uint2*)(orow + 32 + d0) = make_uint2(pack2(O1[4 * g] * inv, O1[4 * g + 1] * inv), pack2(O1[4 * g + 2] * inv, O1[4 * g + 3] * inv));
    }
  }
}

using f32x2 = __attribute__((ext_vector_type(2))) float;
constexpr int SC_STEPS = 16;

DI void sc_store(char* buf, int dst, uint4 R, bool hgw) {
  float4 lo = make_float4(blo(R.x), bhi(R.x), blo(R.y), bhi(R.y));
  float4 hi = make_float4(blo(R.z), bhi(R.z), blo(R.w), bhi(R.w));
  *(float4*)(buf + dst) = lo;
  *(float4*)(buf + dst + 16) = hi;
  if (hgw) {
    *(float4*)(buf + dst + 256) = make_float4(1.f - lo.x, 1.f - lo.y, 1.f - lo.z, 1.f - lo.w);
    *(float4*)(buf + dst + 272) = make_float4(1.f - hi.x, 1.f - hi.y, 1.f - hi.z, 1.f - hi.w);
  }
}

DI float reduce8(float v) {
  v += dpp_f<0xB1>(v);
  v += dpp_f<0x4E>(v);
  v += dpp_f<0x141>(v);
  return v;
}

template <bool RW>
DI void scan_task(const Params& p, int task, int N, char* lds, int tid) {
  constexpr int NA = RW ? 5 : 3;
  constexpr int VOFF = SC_STEPS * NA * 256;
  constexpr int BUF = VOFF + SC_STEPS * 128;
  const int lane = tid & 63, wv = tid >> 6, kq = lane & 7, rg = lane >> 3;
  const int rq = task & 1, hh = (task >> 1) & 3, dir = (task >> 3) & 1, b = task >> 4;
  const size_t tb = (size_t)b * N;
  const int sub = tid >> 7, lt = tid & 127, lstep = lt >> 3, lpart = lt & 7;
  const int vstep = lt >> 2, vq = lt & 3;
  const u16 *src0 = nullptr, *src1 = nullptr, *src2 = nullptr;
  int dst0 = 0, dst1 = 0, dst2 = 0, st0 = 0, st1 = 0, st2 = 0;
  bool act0 = false, act1 = false, act2 = false, hgw = false;
  int ld;
  const int acol = hh * 64 + lpart * 8;
  const int vcol = hh * 64 + rq * 32 + vq * 8;
  const int vdst = VOFF + vstep * 128 + vq * 32;
  if (RW) {
    ld = 256;
    act0 = true; st0 = lstep;
    src0 = sub ? (p.dec + (size_t)dir * T_SUB * 256 + acol) : (p.rs + acol);
    dst0 = (lstep * NA + (sub ? 1 : 0)) * 256 + lpart * 32;
    act1 = true; st1 = lstep;
    src1 = sub ? (p.kk + acol) : (p.kt + (size_t)dir * T_SUB * 256 + acol);
    dst1 = (lstep * NA + (sub ? 3 : 2)) * 256 + lpart * 32;
    if (sub == 0) { act2 = true; st2 = lstep; src2 = p.kka + (size_t)dir * T_SUB * 256 + acol; dst2 = (lstep * NA + 4) * 256 + lpart * 32; }
    else { act2 = lt < 64; st2 = vstep; src2 = p.vs + vcol; dst2 = vdst; }
  } else {
    ld = ZLD;
    act0 = true; st0 = lstep;
    src0 = sub ? (p.z + ZC_OFF + 256 * (1 + dir) + acol) : (p.z + ZC_OFF + acol);
    dst0 = (lstep * NA + (sub ? 1 : 0)) * 256 + lpart * 32;
    hgw = sub != 0;
    if (sub == 0) { act1 = lt < 64; st1 = vstep; src1 = p.z + ZC_OFF + 768 + vcol; dst1 = vdst; }
  }
  u16* pout = (RW ? p.oD : p.oC) + (size_t)dir * T_SUB * 256 + hh * 64 + rq * 32 + wv * 8 + rg;
  pout += (tb + (dir ? (N - 1) : 0)) * 256;
  const int ostride = dir ? -256 : 256;

#define SC_TOK(c_, st_) (tb + (size_t)(dir ? (N - 1 - ((c_) * SC_STEPS + (st_))) : ((c_) * SC_STEPS + (st_))))
#define SC_ISSUE(Ra, Rb, Rc, c_)                                               \
  {                                                                            \
    if (act0) Ra = *(const uint4*)(src0 + SC_TOK(c_, st0) * ld);               \
    if (act1) Rb = *(const uint4*)(src1 + SC_TOK(c_, st1) * ld);               \
    if (act2) Rc = *(const uint4*)(src2 + SC_TOK(c_, st2) * ld);               \
  }
#define SC_STORE(Ra, Rb, Rc, buf_)                                             \
  {                                                                            \
    if (act0) sc_store(buf_, dst0, Ra, hgw);                                   \
    if (act1) sc_store(buf_, dst1, Rb, false);                                 \
    if (act2) sc_store(buf_, dst2, Rc, false);                                 \
  }
  f32x2 S0 = {0.f, 0.f}, S1 = {0.f, 0.f}, S2 = {0.f, 0.f}, S3 = {0.f, 0.f};
#define SC_LD(buf_, s_, ra_, rb_, wa_, wb_, ta_, tb_, ka_, kb_, aa_, ab_, v_)                \
  {                                                                                          \
    const char* rowp_ = (buf_) + (s_) * NA * 256 + kq * 32;                                  \
    ra_ = *(const float4*)(rowp_);                                                           \
    rb_ = *(const float4*)(rowp_ + 16);                                                      \
    wa_ = *(const float4*)(rowp_ + 256);                                                     \
    wb_ = *(const float4*)(rowp_ + 272);                                                     \
    ta_ = *(const float4*)(rowp_ + 512);                                                     \
    tb_ = *(const float4*)(rowp_ + 528);                                                     \
    if (RW) {                                                                                \
      ka_ = *(const float4*)(rowp_ + 768);                                                   \
      kb_ = *(const float4*)(rowp_ + 784);                                                   \
      aa_ = *(const float4*)(rowp_ + 1024);                                                  \
      ab_ = *(const float4*)(rowp_ + 1040);                                                  \
    }                                                                                        \
    v_ = *(const float*)((buf_) + VOFF + (s_) * 128 + (wv * 8 + rg) * 4);                    \
  }
#define F2A(q_) f32x2{(q_).x, (q_).y}
#define F2B(q_) f32x2{(q_).z, (q_).w}
#define SC_COMPUTE(buf_)                                                                     \
  {                                                                                          \
    float oselA = 0.f, oselB = 0.f;                                                          \
    float4 ra, rb, wa, wb, ta, tb_, ka, kb, aa, ab, nra, nrb, nwa, nwb, nta, ntb, nka, nkb, naa, nab; \
    float vv, nvv;                                                                           \
    ka = kb = aa = ab = nka = nkb = naa = nab = make_float4(0.f, 0.f, 0.f, 0.f);             \
    SC_LD(buf_, 0, ra, rb, wa, wb, ta, tb_, ka, kb, aa, ab, vv);                             \
    _Pragma("unroll") for (int s = 0; s < SC_STEPS; s++) {                                   \
      if (s + 1 < SC_STEPS) SC_LD(buf_, s + 1, nra, nrb, nwa, nwb, nta, ntb, nka, nkb, naa, nab, nvv); \
      f32x2 u0 = F2A(ta) * vv, u1 = F2B(ta) * vv, u2 = F2A(tb_) * vv, u3 = F2B(tb_) * vv;     \
      if (RW) {                                                                              \
        f32x2 pa = S0 * F2A(ka), pb = S1 * F2B(ka);                                          \
        pa = S2 * F2A(kb) + pa;                                                              \
        pb = S3 * F2B(kb) + pb;                                                              \
        pa = pa + pb;                                                                        \
        const float sa = -reduce8(pa.x + pa.y);                                              \
        u0 = F2A(aa) * sa + u0;                                                              \
        u1 = F2B(aa) * sa + u1;                                                              \
        u2 = F2A(ab) * sa + u2;                                                              \
        u3 = F2B(ab) * sa + u3;                                                              \
      }                                                                                      \
      S0 = S0 * F2A(wa) + u0;                                                                \
      S1 = S1 * F2B(wa) + u1;                                                                \
      S2 = S2 * F2A(wb) + u2;                                                                \
      S3 = S3 * F2B(wb) + u3;                                                                \
      f32x2 qa = S0 * F2A(ra), qb = S1 * F2B(ra);                                            \
      qa = S2 * F2A(rb) + qa;                                                                \
      qb = S3 * F2B(rb) + qb;                                                                \
      qa = qa + qb;                                                                          \
      const float o = reduce8(qa.x + qa.y);                                                  \
      if (s < 8) oselA = (kq == s) ? o : oselA;                                              \
      else oselB = (kq == s - 8) ? o : oselB;                                                \
      ra = nra; rb = nrb; wa = nwa; wb = nwb; ta = nta; tb_ = ntb;                           \
      ka = nka; kb = nkb; aa = naa; ab = nab; vv = nvv;                                      \
    }                                                                                        \
    pout[kq * ostride] = f2bf(oselA);                                                        \
    pout[(kq + 8) * ostride] = f2bf(oselB);                                                  \
    pout += SC_STEPS * ostride;                                                              \
  }
  uint4 A0 = make_uint4(0, 0, 0, 0), A1 = A0, A2 = A0, B0 = A0, B1 = A0, B2 = A0;
  char* buf0 = lds;
  char* buf1 = lds + BUF;
  const int nch = N / SC_STEPS;
  __syncthreads();
  SC_ISSUE(A0, A1, A2, 0);
  SC_ISSUE(B0, B1, B2, 1);
  SC_STORE(A0, A1, A2, buf0);
  __syncthreads();
  for (int c = 0; c < nch; c += 2) {
    if (c + 2 < nch) SC_ISSUE(A0, A1, A2, c + 2);
    __builtin_amdgcn_sched_barrier(0);
    SC_COMPUTE(buf0);
    __builtin_amdgcn_sched_barrier(0);
    SC_STORE(B0, B1, B2, buf1);
    __syncthreads();
    if (c + 3 < nch) SC_ISSUE(B0, B1, B2, c + 3);
    __builtin_amdgcn_sched_barrier(0);
    SC_COMPUTE(buf1);
    __builtin_amdgcn_sched_barrier(0);
    if (c + 2 < nch) SC_STORE(A0, A1, A2, buf0);
    __syncthreads();
  }
}

template <bool RW>
DI void scan_task16(const Params& p, int task, int N, char* lds, int tid) {
  constexpr int NA = RW ? 5 : 3;
  constexpr int VOFF = SC_STEPS * NA * 256;
  constexpr int BUF = VOFF + SC_STEPS * 64;
  const int lane = tid & 63, wv = tid >> 6, kq = lane & 15, rg = lane >> 4;
  const int rq = task & 3, hh = (task >> 2) & 3, dir = (task >> 4) & 1, b = task >> 5;
  const size_t tb = (size_t)b * N;
  const int sub = tid >> 7, lt = tid & 127, lstep = lt >> 3, lpart = lt & 7;
  const int vstep = lt >> 1, vhalf = lt & 1;
  const u16 *src0 = nullptr, *src1 = nullptr, *src2 = nullptr;
  int dst0 = 0, dst1 = 0, dst2 = 0, st0 = 0, st1 = 0, st2 = 0;
  bool act0 = false, act1 = false, act2 = false, hgw = false;
  int ld;
  const int acol = hh * 64 + lpart * 8;
  const int vcol = hh * 64 + rq * 16 + vhalf * 8;
  const int vdst = VOFF + vstep * 64 + vhalf * 32;
  if (RW) {
    ld = 256;
    act0 = true; st0 = lstep;
    src0 = sub ? (p.dec + (size_t)dir * T_SUB * 256 + acol) : (p.rs + acol);
    dst0 = (lstep * NA + (sub ? 1 : 0)) * 256 + lpart * 32;
    act1 = true; st1 = lstep;
    src1 = sub ? (p.kk + acol) : (p.kt + (size_t)dir * T_SUB * 256 + acol);
    dst1 = (lstep * NA + (sub ? 3 : 2)) * 256 + lpart * 32;
    if (sub == 0) { act2 = true; st2 = lstep; src2 = p.kka + (size_t)dir * T_SUB * 256 + acol; dst2 = (lstep * NA + 4) * 256 + lpart * 32; }
    else { act2 = lt < 32; st2 = vstep; src2 = p.vs + vcol; dst2 = vdst; }
  } else {
    ld = ZLD;
    act0 = true; st0 = lstep;
    src0 = sub ? (p.z + ZC_OFF + 256 * (1 + dir) + acol) : (p.z + ZC_OFF + acol);
    dst0 = (lstep * NA + (sub ? 1 : 0)) * 256 + lpart * 32;
    hgw = sub != 0;
    if (sub == 0) { act1 = lt < 32; st1 = vstep; src1 = p.z + ZC_OFF + 768 + vcol; dst1 = vdst; }
  }
  u16* pout = (RW ? p.oD : p.oC) + (size_t)dir * T_SUB * 256 + hh * 64 + rq * 16 + wv * 4 + rg;
  pout += (tb + (dir ? (N - 1) : 0)) * 256;
  const int ostride = dir ? -256 : 256;

#define SC16_TOK(c_, st_) (tb + (size_t)(dir ? (N - 1 - ((c_) * SC_STEPS + (st_))) : ((c_) * SC_STEPS + (st_))))
#define SC16_ISSUE(Ra, Rb, Rc, c_)                                               \
  {                                                                            \
    if (act0) Ra = *(const uint4*)(src0 + SC16_TOK(c_, st0) * ld);               \
    if (act1) Rb = *(const uint4*)(src1 + SC16_TOK(c_, st1) * ld);               \
    if (act2) Rc = *(const uint4*)(src2 + SC16_TOK(c_, st2) * ld);               \
  }
#define SC16_STORE(Ra, Rb, Rc, buf_)                                             \
  {                                                                            \
    if (act0) sc_store(buf_, dst0, Ra, hgw);                                   \
    if (act1) sc_store(buf_, dst1, Rb, false);                                 \
    if (act2) sc_store(buf_, dst2, Rc, false);                                 \
  }
  f32x2 S01 = {0.f, 0.f}, S23 = {0.f, 0.f};
#define SC16_LD(buf_, s_, r_, w_, t_, k_, a_, v_)                                              \
  {                                                                                          \
    const char* rowp_ = (buf_) + (s_) * NA * 256 + kq * 16;                                  \
    r_ = *(const float4*)(rowp_);                                                            \
    w_ = *(const float4*)(rowp_ + 256);                                                      \
    t_ = *(const float4*)(rowp_ + 512);                                                      \
    if (RW) {                                                                                \
      k_ = *(const float4*)(rowp_ + 768);                                                    \
      a_ = *(const float4*)(rowp_ + 1024);                                                   \
    }                                                                                        \
    v_ = *(const float*)((buf_) + VOFF + (s_) * 64 + (wv * 4 + rg) * 4);                     \
  }
#define SC16_COMPUTE(buf_)                                                                     \
  {                                                                                          \
    float osel = 0.f;                                                                        \
    float4 r4, w4, t4, k4, a4, nr4, nw4, nt4, nk4, na4;                                      \
    float vv, nvv;                                                                           \
    k4 = a4 = nk4 = na4 = make_float4(0.f, 0.f, 0.f, 0.f);                                   \
    SC16_LD(buf_, 0, r4, w4, t4, k4, a4, vv);                                                  \
    _Pragma("unroll") for (int s = 0; s < SC_STEPS; s++) {                                   \
      if (s + 1 < SC_STEPS) SC16_LD(buf_, s + 1, nr4, nw4, nt4, nk4, na4, nvv);                \
      f32x2 ta = f32x2{t4.x, t4.y} * vv, tb2 = f32x2{t4.z, t4.w} * vv;                       \
      if (RW) {                                                                              \
        f32x2 pp = S01 * f32x2{k4.x, k4.y};                                                  \
        pp = S23 * f32x2{k4.z, k4.w} + pp;                                                   \
        const float sa = -reduce16(pp.x + pp.y);                                             \
        ta = f32x2{a4.x, a4.y} * sa + ta;                                                    \
        tb2 = f32x2{a4.z, a4.w} * sa + tb2;                                                  \
      }                                                                                      \
      S01 = S01 * f32x2{w4.x, w4.y} + ta;                                                    \
      S23 = S23 * f32x2{w4.z, w4.w} + tb2;                                                   \
      f32x2 qq = S01 * f32x2{r4.x, r4.y};                                                    \
      qq = S23 * f32x2{r4.z, r4.w} + qq;                                                     \
      const float o = reduce16(qq.x + qq.y);                                                 \
      osel = (kq == s) ? o : osel;                                                           \
      r4 = nr4; w4 = nw4; t4 = nt4; k4 = nk4; a4 = na4; vv = nvv;                            \
    }                                                                                        \
    pout[kq * ostride] = f2bf(osel);                                                         \
    pout += SC_STEPS * ostride;                                                              \
  }
  uint4 A0 = make_uint4(0, 0, 0, 0), A1 = A0, A2 = A0, B0 = A0, B1 = A0, B2 = A0;
  char* buf0 = lds;
  char* buf1 = lds + BUF;
  const int nch = N / SC_STEPS;
  __syncthreads();
  SC16_ISSUE(A0, A1, A2, 0);
  SC16_ISSUE(B0, B1, B2, 1);
  SC16_STORE(A0, A1, A2, buf0);
  __syncthreads();
  for (int c = 0; c < nch; c += 2) {
    if (c + 2 < nch) SC16_ISSUE(A0, A1, A2, c + 2);
    __builtin_amdgcn_sched_barrier(0);
    SC16_COMPUTE(buf0);
    __builtin_amdgcn_sched_barrier(0);
    SC16_STORE(B0, B1, B2, buf1);
    __syncthreads();
    if (c + 3 < nch) SC16_ISSUE(B0, B1, B2, c + 3);
    __builtin_amdgcn_sched_barrier(0);
    SC16_COMPUTE(buf1);
    __builtin_amdgcn_sched_barrier(0);
    if (c + 2 < nch) SC16_STORE(A0, A1, A2, buf0);
    __syncthreads();
  }
}


DI void phase_mix(const Params& p, int l, int B, int N, unsigned* ctr, char* lds, int bid, int nb, int tid) {
  __shared__ int s_task[2];
  const bool wide = (N > 4096);
  const int nper = wide ? B * 32 : B * 16;
  const int nscan = 2 * nper;
  const int nattn = B * 4 * (N >> 7);
  const int nna = B * (N >> 7) * 4;
  const bool prefer_scan = bid < (nb >> 1);
  bool scan_dry = false, attn_dry = false;
  for (;;) {
    if (tid == 0) {
      int kind = -1, task = 0;
      for (int attempt = 0; attempt < 2 && kind < 0; attempt++) {
        const bool try_scan = (attempt == 0) == prefer_scan;
        if (try_scan) {
          if (!scan_dry) {
            const int t = (int)atomicAdd(&ctr[0], 1u);
            if (t < nscan) { kind = 0; task = t; } else scan_dry = true;
          }
        } else {
          if (!attn_dry) {
            const int t = (int)atomicAdd(&ctr[64], 1u);
            if (t < nattn + nna) { kind = 1; task = t; } else attn_dry = true;
          }
        }
      }
      s_task[0] = kind;
      s_task[1] = task;
    }
    __syncthreads();
    const int kind = s_task[0], task = s_task[1];
    __syncthreads();
    if (kind < 0) break;
    if (kind == 0) {
      if (wide) {
        if (task < nper) scan_task16<true>(p, task, N, lds, tid);
        else scan_task16<false>(p, task - nper, N, lds, tid);
      } else {
        if (task < nper) scan_task<true>(p, task, N, lds, tid);
        else scan_task<false>(p, task - nper, N, lds, tid);
      }
    } else {
      if (task < nattn) attn_task(p, task, N, lds, tid);
      else na_task(p, l, task - nattn, N, tid);
    }
  }
}

DI void phase_final(const Params& p, int l, int bid, int nb, int tid) {
  const int lane = tid & 63, wv = tid >> 6, c4 = lane * 4;
  float gn[4], lw[4], lbb[4];
#pragma unroll
  for (int j = 0; j < 4; j++) {
    gn[j] = p.hg_gnorm[l * 256 + c4 + j];
    lw[j] = p.rw_ln_w[l * 256 + c4 + j];
    lbb[j] = p.rw_ln_b[l * 256 + c4 + j];
  }
  for (int t = bid * 4 + wv; t < T_SUB; t += nb * 4) {
    const uint2 ca = *(const uint2*)(p.oC + (size_t)t * 256 + c4);
    const uint2 cb = *(const uint2*)(p.oC + (size_t)(T_SUB + t) * 256 + c4);
    const uint2 cg = *(const uint2*)(p.z + (size_t)t * ZLD + ZC_OFF + 1024 + c4);
    const uint2 da = *(const uint2*)(p.oD + (size_t)t * 256 + c4);
    const uint2 db = *(const uint2*)(p.oD + (size_t)(T_SUB + t) * 256 + c4);
    const float bo = p.bonus[(size_t)t * 4 + (lane >> 4)];
    const uint2 vr = *(const uint2*)(p.vs + (size_t)t * 256 + c4);
    const uint2 gr = *(const uint2*)(p.gD + (size_t)t * 256 + c4);
    {
      float o[4] = {blo(ca.x) + blo(cb.x), bhi(ca.x) + bhi(cb.x), blo(ca.y) + blo(cb.y), bhi(ca.y) + bhi(cb.y)};
      float ss = reduce16(o[0] * o[0] + o[1] * o[1] + o[2] * o[2] + o[3] * o[3]);
      float ri = rsqrtf(ss * (1.f / 64.f) + 1e-6f);
      float g[4] = {blo(cg.x), bhi(cg.x), blo(cg.y), bhi(cg.y)};
      float y[4];
#pragma unroll
      for (int j = 0; j < 4; j++) y[j] = o[j] * ri * gn[j] * (g[j] * sigm(g[j]));
      *(uint2*)(p.cat + (size_t)t * 1024 + 512 + c4) = make_uint2(pack2(y[0], y[1]), pack2(y[2], y[3]));
    }
    {
      float o[4] = {blo(da.x) + blo(db.x), bhi(da.x) + bhi(db.x), blo(da.y) + blo(db.y), bhi(da.y) + bhi(db.y)};
      float mu = reduce16(o[0] + o[1] + o[2] + o[3]) * (1.f / 64.f);
      float d0 = o[0] - mu, d1 = o[1] - mu, d2 = o[2] - mu, d3 = o[3] - mu;
      float var = reduce16(d0 * d0 + d1 * d1 + d2 * d2 + d3 * d3) * (1.f / 64.f);
      float ri = rsqrtf(var + 64e-5f);
      float vv[4] = {blo(vr.x), bhi(vr.x), blo(vr.y), bhi(vr.y)};
      float g[4] = {blo(gr.x), bhi(gr.x), blo(gr.y), bhi(gr.y)};
      float dd[4] = {d0, d1, d2, d3};
      float y[4];
#pragma unroll
      for (int j = 0; j < 4; j++) y[j] = (dd[j] * ri * lw[j] + lbb[j] + bo * vv[j]) * g[j];
      *(uint2*)(p.cat + (size_t)t * 1024 + 768 + c4) = make_uint2(pack2(y[0], y[1]), pack2(y[2], y[3]));
    }
  }
}

DI void phase_wout(const Params& p, int l, int tok0, char* lds, int bid, int nb, int tid) {
  const int NT = 8, MT = T_SUB / 128;
  for (int it = 0;; it++) {
    int nt, mt;
    if (!xcd_tile(it, bid, nb, MT, NT, mt, nt)) break;
    int m0 = mt * 128, n0 = nt * 128;
    auto rowfn = [&](int r) -> const void* { return p.cat + (size_t)(m0 + r) * 1024; };
    auto epi = [&](f32x4(&acc)[4][4], int rbase, int cbase) {
      EPI_LOOP({
        int tg = tok0 + m0 + row;
        float4 xv = *(const float4*)(xin_row(p, l, tg) + n0 + col);
        float4 o = make_float4(ALPHA_F * xv.x + v[0], ALPHA_F * xv.y + v[1], ALPHA_F * xv.z + v[2], ALPHA_F * xv.w + v[3]);
        *(float4*)(p.out + (size_t)tg * 1024 + n0 + col) = o;
      })
    };
    gemm_tile<false>(rowfn, p.wout_t + ((size_t)l * 1024 + n0) * 1024, 1024, epi, lds, tid);
  }
}

template <bool ROUTER>
DI void phase_ln(const Params& p, const float* g, const float* bta, const float* wrouter, int tok0, int ntok, char* lds,
                 int bid, int nb, int tid) {
  const int lane = tid & 63, wv = tid >> 6;
  float* wl = (float*)lds;
  if (ROUTER) {
    __syncthreads();
    for (int i = tid; i < 16384; i += NTHR) {
      int k = i >> 4, e = i & 15;
      wl[e * 1024 + k] = wrouter[i];
    }
    __syncthreads();
  }
  auto ln_load = [&](float4 (&d)[4], int trow, bool ok) {
#pragma unroll
    for (int i = 0; i < 4; i++) {
      if (!ok) { d[i] = make_float4(0.f, 0.f, 0.f, 0.f); continue; }
      if (ROUTER) {
        d[i] = *(const float4*)(p.out + (size_t)trow * 1024 + i * 256 + lane * 4);
      } else {
        const uint2 r = *(const uint2*)(p.O + (size_t)trow * 1024 + i * 256 + lane * 4);
        d[i] = make_float4(blo(r.x), bhi(r.x), blo(r.y), bhi(r.y));
      }
    }
  };
  float4 x[4], xn[4];
  {
    const int t0 = bid * 4 + wv;
    ln_load(x, tok0 + t0, t0 < ntok);
  }
  for (int t = bid * 4 + wv; t < ntok; t += nb * 4) {
    const int tg = tok0 + t;
    float* xr = p.out + (size_t)tg * 1024;
    {
      const int tn = t + nb * 4;
      ln_load(xn, tok0 + tn, tn < ntok);
    }
    float s = 0.f;
#pragma unroll
    for (int i = 0; i < 4; i++) s += x[i].x + x[i].y + x[i].z + x[i].w;
    float mu = wave_sum(s) * (1.f / 1024.f);
    float vs = 0.f;
#pragma unroll
    for (int i = 0; i < 4; i++) {
      x[i].x -= mu; x[i].y -= mu; x[i].z -= mu; x[i].w -= mu;
      vs += x[i].x * x[i].x + x[i].y * x[i].y + x[i].z * x[i].z + x[i].w * x[i].w;
    }
    float ri = rsqrtf(wave_sum(vs) * (1.f / 1024.f) + 1e-5f);
#pragma unroll
    for (int i = 0; i < 4; i++) {
      float4 gg = *(const float4*)(g + i * 256 + lane * 4);
      float4 bb = *(const float4*)(bta + i * 256 + lane * 4);
      x[i].x = x[i].x * ri * gg.x + bb.x;
      x[i].y = x[i].y * ri * gg.y + bb.y;
      x[i].z = x[i].z * ri * gg.z + bb.z;
      x[i].w = x[i].w * ri * gg.w + bb.w;
      if (!ROUTER) *(float4*)(xr + i * 256 + lane * 4) = x[i];
      *(uint2*)(p.xb + (size_t)tg * 1024 + i * 256 + lane * 4) = make_uint2(pack2(x[i].x, x[i].y), pack2(x[i].z, x[i].w));
    }
    if (ROUTER) {
      float mine = 0.f;
#pragma unroll 2
      for (int e = 0; e < 16; e++) {
        float a = 0.f;
#pragma unroll
        for (int i = 0; i < 4; i++) {
          float4 w = *(const float4*)(wl + e * 1024 + i * 256 + lane * 4);
          a += x[i].x * w.x + x[i].y * w.y + x[i].z * w.z + x[i].w * w.w;
        }
        a = reduce16(a);
        mine = ((lane & 15) == e) ? a : mine;
      }
      mine += __shfl_xor(mine, 16);
      mine += __shfl_xor(mine, 32);
      float mx = mine;
      mx = fmaxf(mx, dpp_f<0xB1>(mx));
      mx = fmaxf(mx, dpp_f<0x4E>(mx));
      mx = fmaxf(mx, dpp_f<0x141>(mx));
      mx = fmaxf(mx, dpp_f<0x140>(mx));
      float ex = __expf(mine - mx);
      float sum = reduce16(ex);
      mine = ex / sum;
      if (lane == 0) p.inv_cnt[tg] = 0;
      if (lane < 16) {
        if (tg < 32768) p.affT[(size_t)lane * 32768 + tg] = mine;
        else p.affT[(size_t)16 * 32768 + (size_t)lane * 65536 + (tg - 32768)] = mine;
      }
    }
#pragma unroll
    for (int i = 0; i < 4; i++) x[i] = xn[i];
  }
}

DI void phase_topk(const Params& p, char* lds, int bid, int nb, int tid) {
  if (bid < 32) {
    unsigned* hist = (unsigned*)lds;
    unsigned* sh = hist + 256;
    unsigned* eqc = sh + 8;
    const int g = bid >> 4, e = bid & 15;
    const int T = g ? 65536 : 32768, cap = T >> 3;
    const int tok0 = g ? 32768 : 0;
    const float* vals = p.affT + (g ? (size_t)16 * 32768 : 0) + (size_t)e * T;
    const float4* v4 = (const float4*)vals;
    const int n4 = T >> 2;
    int* oidx = p.idx + (g ? 65536 : 0) + e * cap;
    float* ogate = p.gate + (g ? 65536 : 0) + e * cap;
    const int slot0 = (g ? 65536 : 0) + e * cap;
    unsigned prefix = 0, mask = 0;
    int remaining = cap;
    for (int pass = 0; pass < 4; pass++) {
      const int shift = 24 - 8 * pass;
      hist[tid] = 0;
      __syncthreads();
      for (int base = 0; base < n4; base += 2048) {
        float4 x[8];
#pragma unroll
        for (int u = 0; u < 8; u++) x[u] = v4[base + u * 256 + tid];
#pragma unroll
        for (int u = 0; u < 8; u++) {
          const unsigned b0 = __float_as_uint(x[u].x), b1 = __float_as_uint(x[u].y), b2 = __float_as_uint(x[u].z), b3 = __float_as_uint(x[u].w);
          if ((b0 & mask) == prefix) atomicAdd(&hist[(b0 >> shift) & 255], 1u);
          if ((b1 & mask) == prefix) atomicAdd(&hist[(b1 >> shift) & 255], 1u);
          if ((b2 & mask) == prefix) atomicAdd(&hist[(b2 >> shift) & 255], 1u);
          if ((b3 & mask) == prefix) atomicAdd(&hist[(b3 >> shift) & 255], 1u);
        }
      }
      __syncthreads();
      if (tid == 0) {
        int cum = 0, sel = 0;
        for (int bq = 255; bq >= 0; bq--) {
          int hc = (int)hist[bq];
          if (cum + hc >= remaining) { sel = bq; break; }
          cum += hc;
        }
        sh[0] = (unsigned)sel;
        sh[1] = (unsigned)(remaining - cum);
        sh[3] = hist[sel];
      }
      __syncthreads();
      prefix |= sh[0] << shift;
      remaining = (int)sh[1];
      mask |= 0xFFu << shift;
      __syncthreads();
    }
    const unsigned thr = prefix;
    const int need = remaining;
    const bool fast = ((int)sh[3] == need);
    if (tid == 0) sh[2] = 0;
    __syncthreads();
    if (fast) {
      for (int base = 0; base < n4; base += 2048) {
        float4 x[8];
#pragma unroll
        for (int u = 0; u < 8; u++) x[u] = v4[base + u * 256 + tid];
#pragma unroll
        for (int u = 0; u < 8; u++) {
          const float xv[4] = {x[u].x, x[u].y, x[u].z, x[u].w};
#pragma unroll
          for (int c = 0; c < 4; c++) {
            if (__float_as_uint(xv[c]) >= thr) {
              const int pos = (int)atomicAdd(&sh[2], 1u);
              const int tok = tok0 + (base + u * 256 + tid) * 4 + c;
              oidx[pos] = tok;
              ogate[pos] = xv[c];
              const int kslot = atomicAdd(&p.inv_cnt[tok], 1);
              p.inv_slot[(size_t)tok * 16 + kslot] = slot0 + pos;
            }
          }
        }
      }
    } else {
      const int ch = T >> 8;
      const float* my = vals + tid * ch;
      int ec = 0;
      for (int i = 0; i < ch; i++) ec += (__float_as_uint(my[i]) == thr) ? 1 : 0;
      eqc[tid] = ec;
      __syncthreads();
      int eq_rank = 0;
      for (int i = 0; i < tid; i++) eq_rank += eqc[i];
      for (int i = 0; i < ch; i++) {
        float v = my[i];
        unsigned u = __float_as_uint(v);
        int pos = -1;
        if (u > thr) {
          pos = (int)atomicAdd(&sh[2], 1u);
        } else if (u == thr) {
          if (eq_rank < need) pos = cap - need + eq_rank;
          eq_rank++;
        }
        if (pos >= 0) {
          const int tok = tok0 + tid * ch + i;
          oidx[pos] = tok;
          ogate[pos] = v;
          const int kslot = atomicAdd(&p.inv_cnt[tok], 1);
          p.inv_slot[(size_t)tok * 16 + kslot] = slot0 + pos;
        }
      }
    }
    __syncthreads();
  }
}

DI void moe_rowinfo(int row0, int l, int& e, int& ioff) {
  if (row0 < 65536) { e = row0 >> 12; }
  else { e = (row0 - 65536) >> 13; }
  ioff = row0;
}

DI void phase_moe1(const Params& p, int l, char* lds, int bid, int nb, int tid) {
  const int NT = 8, MT = 196608 / 128;
  for (int it = 0;; it++) {
    int nt, mt;
    if (!xcd_tile(it, bid, nb, MT, NT, mt, nt)) break;
    int m0 = mt * 128, n0 = nt * 128;
    int e, ioff;
    moe_rowinfo(m0, l, e, ioff);
    const int* ip = p.idx + ioff;
    auto rowfn = [&](int r) -> const void* { return p.xb + (size_t)ip[r] * 1024; };
    u16* H = p.H;
    auto epi = [&](f32x4(&acc)[4][4], int rbase, int cbase) {
#pragma unroll
      for (int m = 0; m < 4; m++)
#pragma unroll
        for (int n = 0; n < 4; n += 2) {
          int row = rbase + m * 16;
          int col = cbase + n * 16;
          int blk = (n0 + (col & ~31)) >> 1;
          int hc = blk + (col & 15);
          f32x4 a = acc[m][n], bq = acc[m][n + 1];
          f32x4 o;
          for (int j = 0; j < 4; j++) o[j] = a[j] * sigm(a[j]) * bq[j];
          st_bf4(H + (size_t)(m0 + row) * 512 + hc, o);
        }
    };
    gemm_tile<false>(rowfn, p.w13_t + ((size_t)(l * 16 + e) * 1024 + n0) * 1024, 1024, epi, lds, tid);
  }
}

DI void phase_moe2(const Params& p, int l, char* lds, int bid, int nb, int tid) {
  TileIter it{bid, nb, 0};
  {
    const int NT = 8, MT = 196608 / 128;
    for (int itx = 0;; itx++) {
      int nt, mt;
      if (!xcd_tile(itx, bid, nb, MT, NT, mt, nt)) break;
      int m0 = mt * 128, n0 = nt * 128;
      int e, ioff;
      moe_rowinfo(m0, l, e, ioff);
      auto rowfn = [&](int r) -> const void* { return p.H + (size_t)(m0 + r) * 512; };
      u16* O = p.O;
      auto epi = [&](f32x4(&acc)[4][4], int rbase, int cbase) {
        EPI_LOOP({ st_bf4(O + (size_t)(m0 + row) * 1024 + n0 + col, v); })
      };
      gemm_tile<false>(rowfn, p.w2_t + ((size_t)(l * 16 + e) * 1024 + n0) * 512, 512, epi, lds, tid);
    }
  }
  {
    const int NT = 8, MT = T_ALL / 128;
    for (int itx = 0;; itx++) {
      int nt, mt;
      if (!xcd_tile(itx, bid, nb, MT, NT, mt, nt)) break;
      int m0 = mt * 128, n0 = nt * 128;
      auto rowfn = [&](int r) -> const void* {
        int tg = m0 + r;
        return tg < 32768 ? p.p_prompt + ((size_t)l * 32768 + tg) * 256 : p.p_sample + ((size_t)l * 65536 + (tg - 32768)) * 256;
      };
      auto epi = [&](f32x4(&acc)[4][4], int rbase, int cbase) {
        EPI_LOOP({ st_bf4((u16*)p.out + (size_t)(m0 + row) * 1024 + n0 + col, v); })
      };
      gemm_tile<true>(rowfn, p.wp_t + ((size_t)l * 1024 + n0) * 256, 256, epi, lds, tid);
    }
  }
}

DI void phase_combine(const Params& p, int bid, int nb, int tid) {
  const int lane = tid & 63, wv = tid >> 6;
  u16* ub = p.H;
  const int stride = nb * 4;
  int t = bid * 4 + wv;
  uint2 xr_[4], xn_[4];
  int cnt = 0, myslot = 0, cntn = 0, myslotn = 0;
#pragma unroll
  for (int i = 0; i < 4; i++) xr_[i] = xn_[i] = make_uint2(0, 0);
  if (t < T_ALL) {
#pragma unroll
    for (int i = 0; i < 4; i++) xr_[i] = *(const uint2*)(p.xb + (size_t)t * 1024 + i * 256 + lane * 4);
    cnt = p.inv_cnt[t];
    myslot = p.inv_slot[(size_t)t * 16 + (lane & 15)];
  }
  for (; t < T_ALL; t += stride) {
    const int tn = t + stride;
    if (tn < T_ALL) {
#pragma unroll
      for (int i = 0; i < 4; i++) xn_[i] = *(const uint2*)(p.xb + (size_t)tn * 1024 + i * 256 + lane * 4);
      cntn = p.inv_cnt[tn];
      myslotn = p.inv_slot[(size_t)tn * 16 + (lane & 15)];
    }
    const float mygate = ((lane & 15) < cnt) ? p.gate[myslot] : 0.f;
    float4 a[4];
#pragma unroll
    for (int i = 0; i < 4; i++)
      a[i] = make_float4(blo(xr_[i].x) * ALPHA_F, bhi(xr_[i].x) * ALPHA_F, blo(xr_[i].y) * ALPHA_F, bhi(xr_[i].y) * ALPHA_F);
    for (int j0 = 0; j0 < cnt; j0 += 4) {
      uint2 r[4][4];
      float g[4];
#pragma unroll
      for (int jj = 0; jj < 4; jj++) {
        const int j = (j0 + jj < cnt) ? (j0 + jj) : j0;
        const int slot = __shfl(myslot, j);
        g[jj] = (j0 + jj < cnt) ? __shfl(mygate, j) : 0.f;
        const u16* orow = p.O + (size_t)slot * 1024 + lane * 4;
#pragma unroll
        for (int i = 0; i < 4; i++) r[jj][i] = *(const uint2*)(orow + i * 256);
      }
#pragma unroll
      for (int jj = 0; jj < 4; jj++)
#pragma unroll
        for (int i = 0; i < 4; i++) {
          a[i].x += g[jj] * blo(r[jj][i].x);
          a[i].y += g[jj] * bhi(r[jj][i].x);
          a[i].z += g[jj] * blo(r[jj][i].y);
          a[i].w += g[jj] * bhi(r[jj][i].y);
        }
    }
#pragma unroll
    for (int i = 0; i < 4; i++)
      *(uint2*)(ub + (size_t)t * 1024 + i * 256 + lane * 4) = make_uint2(pack2(a[i].x, a[i].y), pack2(a[i].z, a[i].w));
#pragma unroll
    for (int i = 0; i < 4; i++) xr_[i] = xn_[i];
    cnt = cntn;
    myslot = myslotn;
  }
}

DI void phase_ple(const Params& p, int l, char* lds, int bid, int nb, int tid) {
  const int NT = 8, MT = T_ALL / 128;
  for (int it = 0;; it++) {
    int nt, mt;
    if (!xcd_tile(it, bid, nb, MT, NT, mt, nt)) break;
    int m0 = mt * 128, n0 = nt * 128;
    auto rowfn = [&](int r) -> const void* { return p.H + (size_t)(m0 + r) * 1024; };
    auto epi = [&](f32x4(&acc)[4][4], int rbase, int cbase) {
      EPI_LOOP({
        size_t o = (size_t)(m0 + row) * 1024 + n0 + col;
        const uint2 ur = *(const uint2*)(p.H + o);
        const uint2 pr = *(const uint2*)((const u16*)p.out + o);
        f32x4 w4;
        w4[0] = blo(ur.x) + sigm(v[0]) * blo(pr.x);
        w4[1] = bhi(ur.x) + sigm(v[1]) * bhi(pr.x);
        w4[2] = blo(ur.y) + sigm(v[2]) * blo(pr.y);
        w4[3] = bhi(ur.y) + sigm(v[3]) * bhi(pr.y);
        st_bf4(p.O + o, w4);
      })
    };
    gemm_tile<false>(rowfn, p.wg_t + ((size_t)l * 1024 + n0) * 1024, 1024, epi, lds, tid);
  }
}

#define XB_TMO      128
#define XB_XCNT(j)  (256  + 64 * (j))
#define XB_XSUB(j)  (1280 + 64 * (j))
#define XB_XGEN(j)  (2304 + 64 * (j))
#define XB_TOP      3328
#define XB_TOPGEN   3392
#define XCD_BAR_WORDS 3456
#define XB_SPIN_CAP (1u << 22)
#define LAS __attribute__((address_space(3)))
DI unsigned xb_ld(unsigned* p) { return __hip_atomic_load(p, __ATOMIC_RELAXED, __HIP_MEMORY_SCOPE_AGENT); }
DI unsigned xb_add(unsigned* p, unsigned v) { return __hip_atomic_fetch_add(p, v, __ATOMIC_RELAXED, __HIP_MEMORY_SCOPE_AGENT); }
DI unsigned xb_xcc_id() { return (unsigned)__builtin_amdgcn_s_getreg((3 << 11) | 20) & 0xFu; }
#define XB_SPIN(cond, bar) do { unsigned _sp = 0; while (cond) { __builtin_amdgcn_s_sleep(1); \
    if ((++_sp & 255u) == 0u) { if (xb_ld(&(bar)[XB_TMO])) break; if (_sp > XB_SPIN_CAP) { atomicAdd(&(bar)[XB_TMO], 1u); break; } } } } while (0)
struct XcdBarrier { unsigned* bar; unsigned x; volatile LAS unsigned* st; };
DI XcdBarrier xcd_barrier_post(unsigned* bar, volatile LAS unsigned* st) {
  XcdBarrier b; b.bar = bar; b.x = xb_xcc_id(); b.st = st;
  if (threadIdx.x == 0) (void)xb_add(&bar[XB_XCNT(b.x)], 1u);
  return b;
}
DI void xcd_barrier_complete(unsigned* bar, unsigned x, unsigned& nloc, unsigned& nx) {
  const unsigned G = gridDim.x * gridDim.y * gridDim.z;
  unsigned sum, cnt, mine, sp = 0u;
  for (;;) {
    sum = 0u; cnt = 0u; mine = 0u;
#pragma unroll
    for (unsigned j = 0; j < 16; ++j) { const unsigned c = xb_ld(&bar[XB_XCNT(j)]); sum += c; cnt += (c > 0u) ? 1u : 0u; mine = (j == x) ? c : mine; }
    if (sum == G) break;
    __builtin_amdgcn_s_sleep(1);
    if ((++sp & 255u) == 0u) { if (xb_ld(&bar[XB_TMO])) break; if (sp > XB_SPIN_CAP) { atomicAdd(&bar[XB_TMO], 1u); break; } }
  }
  nloc = mine > 0u ? mine : 1u; nx = cnt > 0u ? cnt : 1u;
}
DI void xcd_barrier(const XcdBarrier& b) {
  asm volatile("s_waitcnt vmcnt(0)" ::: "memory");
  __syncthreads();
  if (threadIdx.x == 0) {
    unsigned* bar = b.bar;
    __builtin_amdgcn_s_waitcnt(0);
    unsigned nloc = b.st[0], nx = b.st[1];
    if (nloc == 0u) { xcd_barrier_complete(bar, b.x, nloc, nx); b.st[0] = nloc; b.st[1] = nx; }
    const unsigned old = xb_add(&bar[XB_XSUB(b.x)], 1u);
    const unsigned gen = old / nloc;
    if (old + 1u == (gen + 1u) * nloc) {
      __builtin_amdgcn_fence(__ATOMIC_RELEASE, "agent");
      asm volatile("s_waitcnt vmcnt(0)" ::: "memory");
      const unsigned og = xb_add(&bar[XB_TOP], 1u);
      const unsigned tg = og / nx;
      if (og + 1u == (tg + 1u) * nx) xb_add(&bar[XB_TOPGEN], 1u);
      else XB_SPIN(xb_ld(&bar[XB_TOPGEN]) == tg, bar);
      __builtin_amdgcn_fence(__ATOMIC_ACQUIRE, "agent");
      xb_add(&bar[XB_XGEN(b.x)], 1u);
      asm volatile("s_waitcnt vmcnt(0)" ::: "memory");
    } else {
      XB_SPIN(xb_ld(&bar[XB_XGEN(b.x)]) == gen, bar);
      __builtin_amdgcn_fence(__ATOMIC_ACQUIRE, "agent");
      asm volatile("s_waitcnt vmcnt(0)" ::: "memory");
    }
  }
  __syncthreads();
}

__global__ void __launch_bounds__(NTHR, 2) mega(Params p) {
  __shared__ __attribute__((aligned(16))) char lds[73728];
  cg::grid_group grid = cg::this_grid();
  const int tid0 = threadIdx.x, bid0 = blockIdx.x, nb = gridDim.x;
  __shared__ uint4 xb_words;
  if (tid0 == 0) xb_words = make_uint4(0u, 0u, 0u, 0u);
  __syncthreads();
  const XcdBarrier xb = xcd_barrier_post(p.bar, (volatile LAS unsigned*)&xb_words);
  int pc = 0;
#define PHASE(...)                                      \
  {                                                     \
    if (pc >= p.pb && pc < p.pe) {                      \
      if (pc == p.pb + 1) grid.sync();                  \
      else if (pc > p.pb + 1) xcd_barrier(xb);          \
      int tid = tid0, bid = bid0;                       \
      asm volatile("" : "+v"(tid), "+s"(bid));          \
      __VA_ARGS__;                                      \
    }                                                   \
    pc++;                                               \
  }
  PHASE(phase_convert(p, lds, bid, nb, tid));
  for (int i = 0; i < REP_SYNC; i++) PHASE((void)0);
  for (int l = 0; l < 2; l++) {
    for (int sg = 0; sg < 3; sg++) {
      const int tok0 = sg * T_SUB;
      const int B = sg == 0 ? 4 : 8, N = sg == 0 ? 8192 : 4096;
      PHASE(phase_inproj(p, l, tok0, lds, bid, nb, tid));
#if REP_INPROJ || REP_GEMMS
      PHASE(phase_inproj(p, l, tok0, lds, bid, nb, tid));
#endif
      PHASE(phase_prep(p, l, N, bid, nb, tid));
      PHASE(phase_smallgemm(p, l, B, N, lds, bid, nb, tid));
#if REP_GEMMS
      PHASE(phase_smallgemm(p, l, B, N, lds, bid, nb, tid));
#endif
      PHASE(phase_mix(p, l, B, N, p.bar + XCD_BAR_WORDS + (l * 3 + sg) * 128, lds, bid, nb, tid));
#if REP_MIX
      PHASE(phase_mix(p, l, B, N, p.bar + XCD_BAR_WORDS + (6 + l * 3 + sg) * 128, lds, bid, nb, tid));
#endif
      PHASE(phase_final(p, l, bid, nb, tid));
      PHASE(phase_wout(p, l, tok0, lds, bid, nb, tid));
      PHASE(phase_ln<true>(p, p.ln1_g + l * 1024, p.ln1_b + l * 1024, p.moe_router + (size_t)l * 16384, tok0, T_SUB, lds, bid, nb, tid));
    }
    PHASE(phase_topk(p, lds, bid, nb, tid));
    PHASE(phase_moe1(p, l, lds, bid, nb, tid));
#if REP_MOE1 || REP_GEMMS
    PHASE(phase_moe1(p, l, lds, bid, nb, tid));
#endif
    PHASE(phase_moe2(p, l, lds, bid, nb, tid));
#if REP_GEMMS
    PHASE(phase_moe2(p, l, lds, bid, nb, tid));
#endif
    PHASE(phase_combine(p, bid, nb, tid));
    PHASE(phase_ple(p, l, lds, bid, nb, tid));
    PHASE(phase_ln<false>(p, p.ln2_g + l * 1024, p.ln2_b + l * 1024, nullptr, 0, T_ALL, lds, bid, nb, tid));
  }
}

#define N_PHASES 1000
#ifndef FUSED
#define FUSED 1
#endif

extern "C" void kernel_launch(void* const* d_in, const int* in_sizes, int n_in, void* d_out, int out_size, void* d_ws,
                              size_t ws_size, hipStream_t stream) {
  static int grid_blocks = 0;
  if (!grid_blocks) {
    int dev = 0, cus = 0, per_cu = 0;
    (void)hipGetDevice(&dev);
    (void)hipDeviceGetAttribute(&cus, hipDeviceAttributeMultiprocessorCount, dev);
    (void)hipOccupancyMaxActiveBlocksPerMultiprocessor(&per_cu, mega, NTHR, 0);
    if (per_cu > 2) per_cu = 2;
    if (per_cu < 1) per_cu = 1;
    grid_blocks = cus * per_cu;
  }
  Params p;
  memset(&p, 0, sizeof(p));
  const float* const* in = (const float* const*)d_in;
  int k = 0;
  p.x_prompt = in[k++]; p.x_sample = in[k++]; p.p_prompt = in[k++]; p.p_sample = in[k++];
  p.w_in = in[k++]; p.mla_gq = in[k++]; p.mla_gkv = in[k++]; p.mla_wuq = in[k++]; p.mla_wuk = in[k++]; p.mla_wuv = in[k++];
  p.na_bias = in[k++]; p.hg_lb = in[k++]; p.hg_gnorm = in[k++];
  p.rw_mu = in[k++]; p.rw_w0 = in[k++]; p.rw_w_up = in[k++]; p.rw_a0 = in[k++]; p.rw_a_up = in[k++]; p.rw_g_up = in[k++];
  p.rw_kk = in[k++]; p.rw_ka = in[k++]; p.rw_rk = in[k++]; p.rw_ln_w = in[k++]; p.rw_ln_b = in[k++];
  p.w_out = in[k++]; p.ln1_g = in[k++]; p.ln1_b = in[k++]; p.moe_router = in[k++]; p.moe_w1 = in[k++]; p.moe_w3 = in[k++];
  p.moe_w2 = in[k++]; p.ln2_g = in[k++]; p.ln2_b = in[k++]; p.ple_gate = in[k++]; p.ple_proj = in[k++];
  p.out = (float*)d_out;
  char* ws = (char*)d_ws;
  size_t off = 0;
  auto take = [&](size_t bytes) { char* r = ws + off; off += (bytes + 255) & ~(size_t)255; return r; };
  p.w_in_t = (u16*)take((size_t)2 * 3712 * 1024 * 2);
  p.wuq_t = (u16*)take((size_t)2 * 384 * 256 * 2);
  p.wkv_t = (u16*)take((size_t)2 * 512 * 128 * 2);
  p.wup_t = (u16*)take((size_t)4 * 256 * 64 * 2);
  p.aup_t = (u16*)take((size_t)4 * 256 * 64 * 2);
  p.gup_t = (u16*)take((size_t)2 * 256 * 128 * 2);
  p.wout_t = (u16*)take((size_t)2 * 1024 * 1024 * 2);
  p.w13_t = (u16*)take((size_t)32 * 1024 * 1024 * 2);
  p.w2_t = (u16*)take((size_t)32 * 1024 * 512 * 2);
  p.wg_t = (u16*)take((size_t)2 * 1024 * 1024 * 2);
  p.wp_t = (u16*)take((size_t)2 * 1024 * 256 * 2);
  p.ropec = (float*)take((size_t)8192 * 16 * 4);
  p.ropes = (float*)take((size_t)8192 * 16 * 4);
  p.lb = (float*)take(1024 * 4);
  p.affT = (float*)take((size_t)16 * T_ALL * 4);
  p.gate = (float*)take((size_t)196608 * 4);
  p.idx = (int*)take((size_t)196608 * 4);
  p.bar = (unsigned*)take((size_t)(XCD_BAR_WORDS + 12 * 128) * 4);
  p.inv_cnt = (int*)take((size_t)T_ALL * 4);
  p.inv_slot = (int*)take((size_t)T_ALL * 16 * 4);
  p.xb = (u16*)take((size_t)T_ALL * 1024 * 2);
  const size_t stage0 = off;
  p.z = (u16*)take((size_t)T_SUB * ZLD * 2);
  p.cat = (u16*)take((size_t)T_SUB * 1024 * 2);
  p.Q = (u16*)take((size_t)T_SUB * 384 * 2);
  p.Kb = (u16*)take((size_t)T_SUB * 384 * 2);
  p.Vt = (u16*)take((size_t)T_SUB * 256 * 2);
  p.cqn = (u16*)take((size_t)T_SUB * 256 * 2);
  p.ckvn = (u16*)take((size_t)T_SUB * 128 * 2);
  p.S1 = (u16*)take((size_t)T_SUB * 384 * 2);
  p.rs = (u16*)take((size_t)T_SUB * 256 * 2);
  p.ks = (u16*)take((size_t)T_SUB * 256 * 2);
  p.vs = (u16*)take((size_t)T_SUB * 256 * 2);
  p.kk = (u16*)take((size_t)T_SUB * 256 * 2);
  p.gD = (u16*)take((size_t)T_SUB * 256 * 2);
  p.dec = (u16*)take((size_t)2 * T_SUB * 256 * 2);
  p.kka = (u16*)take((size_t)2 * T_SUB * 256 * 2);
  p.kt = (u16*)take((size_t)2 * T_SUB * 256 * 2);
  p.oC = (u16*)take((size_t)2 * T_SUB * 256 * 2);
  p.oD = (u16*)take((size_t)2 * T_SUB * 256 * 2);
  p.bonus = (float*)take((size_t)T_SUB * 4 * 4);
  off = stage0;
  p.O = (u16*)take((size_t)196608 * 1024 * 2);
  p.H = (u16*)take((size_t)196608 * 512 * 2);
  for (int i = 0; i < 16; i++) p.inv_freq[i] = pow(10000.0, -(double)i / 16.0);
  (void)hipMemsetAsync(p.bar, 0, (size_t)(XCD_BAR_WORDS + 12 * 128) * 4, stream);
#if FUSED
  p.pb = 0;
  p.pe = N_PHASES;
  {
    void* args[] = {&p};
    hipError_t e = hipLaunchCooperativeKernel((void*)mega, dim3(grid_blocks), dim3(NTHR), args, 0, stream);
    if (e != hipSuccess) fprintf(stderr, "cooperative launch failed: %s (grid %d)\n", hipGetErrorString(e), grid_blocks);
  }
#else
  for (int ph = 0; ph < N_PHASES; ph++) {
    p.pb = ph;
    p.pe = ph + 1;
    void* args[] = {&p};
    hipError_t e = hipLaunchCooperativeKernel((void*)mega, dim3(grid_blocks), dim3(NTHR), args, 0, stream);
    if (e != hipSuccess) fprintf(stderr, "cooperative launch failed: %s (grid %d)\n", hipGetErrorString(e), grid_blocks);
  }
#endif
}
```

```cpp
#include <hip/hip_runtime.h>
#include <hip/hip_cooperative_groups.h>
#include <cstdio>
#include <cmath>
#include <cstring>
namespace cg = cooperative_groups;

typedef unsigned short u16;
using bf16x8 = __attribute__((ext_vector_type(8))) short;
using f32x4 = __attribute__((ext_vector_type(4))) float;
using f32x16 = __attribute__((ext_vector_type(16))) float;

#define REP_INPROJ 0
#define REP_ATTN 0
#define REP_NA 0
#define REP_SCAN 0
#define REP_MOE1 0
#define REP_MOE2 0
#define REP_SYNC 0
#define REP_MIX 0
#define REP_GEMMS 0
#define DI __device__ __forceinline__
#define NTHR 256
#define T_ALL 98304
#define T_SUB 32768
#define ZLD 3616
#define ZB_OFF 416
#define ZC_OFF 1184
#define ZD_OFF 2464
#define LOG2E 1.4426950408889634f
#define ALPHA_F 1.4142135623730951f

struct Params {
  const float *x_prompt, *x_sample, *p_prompt, *p_sample;
  const float *w_in, *mla_gq, *mla_gkv, *mla_wuq, *mla_wuk, *mla_wuv, *na_bias, *hg_lb, *hg_gnorm;
  const float *rw_mu, *rw_w0, *rw_w_up, *rw_a0, *rw_a_up, *rw_g_up, *rw_kk, *rw_ka, *rw_rk, *rw_ln_w, *rw_ln_b;
  const float *w_out, *ln1_g, *ln1_b, *moe_router, *moe_w1, *moe_w3, *moe_w2, *ln2_g, *ln2_b, *ple_gate, *ple_proj;
  float* out;
  u16 *w_in_t, *wuq_t, *wkv_t, *wup_t, *aup_t, *gup_t, *wout_t, *w13_t, *w2_t, *wg_t, *wp_t;
  float *ropec, *ropes, *lb, *affT, *gate;
  int* idx;
  unsigned* bar;
  int *inv_cnt, *inv_slot;
  u16 *z, *cat, *Q, *Kb, *Vt, *cqn, *ckvn, *S1, *rs, *ks, *vs, *kk, *gD, *dec, *kka, *kt, *oC, *oD;
  float* bonus;
  u16* xb;
  u16* O;
  u16* H;
  double inv_freq[16];
  int pb, pe;
};

typedef __bf16 v2bf_t __attribute__((ext_vector_type(2)));
typedef float v2f_t __attribute__((ext_vector_type(2)));
typedef unsigned u32x4_t __attribute__((ext_vector_type(4)));
DI unsigned pack2(float a, float b) {
  v2f_t f = {a, b};
  v2bf_t h = __builtin_convertvector(f, v2bf_t);
  return __builtin_bit_cast(unsigned, h);
}
DI u16 f2bf(float f) { return (u16)(pack2(f, 0.f) & 0xffffu); }
DI float bf2f(u16 h) { return __uint_as_float(((unsigned)h) << 16); }
DI float blo(unsigned u) { return __uint_as_float(u << 16); }
DI float bhi(unsigned u) { return __uint_as_float(u & 0xffff0000u); }
DI float sigm(float x) { return 1.f / (1.f + __expf(-x)); }
DI float tanh_(float x) { return 1.f - 2.f / (__expf(2.f * x) + 1.f); }
DI float ex2(float x) { return __builtin_amdgcn_exp2f(x); }
DI int clampi(int v, int lo, int hi) { return v < lo ? lo : (v > hi ? hi : v); }
DI int swap23(int x) { return (x & ~12) | ((x & 4) << 1) | ((x & 8) >> 1); }

template <int CTRL> DI float dpp_f(float v) {
  return __int_as_float(__builtin_amdgcn_update_dpp(0, __float_as_int(v), CTRL, 0xF, 0xF, true));
}
DI float reduce16(float v) {
  v += dpp_f<0xB1>(v);
  v += dpp_f<0x4E>(v);
  v += dpp_f<0x141>(v);
  v += dpp_f<0x140>(v);
  return v;
}
DI float wave_sum(float v) {
  v = reduce16(v);
  v += __shfl_xor(v, 16);
  v += __shfl_xor(v, 32);
  return v;
}

struct TileIter {
  int bid, nb, off;
  DI int first(int n) { int f = bid - off; if (f < 0) f += nb; off = (off + n) % nb; return f; }
};

DI bool xcd_tile(int it, int bid, int nb, int MT, int NT, int& mt, int& nt) {
  const int x = bid & 7, slot = bid >> 3, nslots = nb >> 3;
  const int mper = MT >> 3;
  const int i = slot + it * nslots;
  if (i >= mper * NT) return false;
  const int mi = i & 7, rest = i >> 3;
  nt = rest % NT;
  mt = x * mper + (rest / NT) * 8 + mi;
  return true;
}

DI void convT_job(const float* __restrict__ W, int K, int N, int Npad, u16* __restrict__ Wt, int mode, char* lds,
                  TileIter& it, int tid) {
  float(*tile)[65] = (float(*)[65])lds;
  int tk = K >> 6, tn = Npad >> 6;
  int nt = tk * tn;
  for (int t = it.first(nt); t < nt; t += it.nb) {
    int k0 = (t % tk) << 6, n0 = (t / tk) << 6;
#pragma unroll
    for (int i = 0; i < 16; i++) {
      int kl = (tid >> 6) + 4 * i, nl = tid & 63;
      int n = n0 + nl;
      tile[kl][nl] = (n < N) ? W[(size_t)(k0 + kl) * N + n] : 0.f;
    }
    __syncthreads();
    {
      int nl = tid >> 2, ks = (tid & 3) * 16;
      int n = n0 + nl;
      int row = n;
      if (mode == 1) row = (n >> 4) * 32 + (n & 15);
      if (mode == 2) row = (n >> 4) * 32 + 16 + (n & 15);
      unsigned pk[8];
#pragma unroll
      for (int j = 0; j < 8; j++) pk[j] = pack2(tile[ks + 2 * j][nl], tile[ks + 2 * j + 1][nl]);
      uint4* dst = (uint4*)(Wt + (size_t)row * K + k0 + ks);
      dst[0] = make_uint4(pk[0], pk[1], pk[2], pk[3]);
      dst[1] = make_uint4(pk[4], pk[5], pk[6], pk[7]);
    }
    __syncthreads();
  }
}

DI void phase_convert(const Params& p, char* lds, int bid, int nb, int tid) {
  TileIter it{bid, nb, 0};
  for (int l = 0; l < 2; l++) {
    convT_job(p.w_in + (size_t)l * 1024 * 3616, 1024, 3616, 3712, p.w_in_t + (size_t)l * 3712 * 1024, 0, lds, it, tid);
    convT_job(p.mla_wuq + (size_t)l * 256 * 384, 256, 384, 384, p.wuq_t + (size_t)l * 384 * 256, 0, lds, it, tid);
    convT_job(p.mla_wuk + (size_t)l * 128 * 256, 128, 256, 256, p.wkv_t + (size_t)l * 512 * 128, 0, lds, it, tid);
    convT_job(p.mla_wuv + (size_t)l * 128 * 256, 128, 256, 256, p.wkv_t + (size_t)l * 512 * 128 + 256 * 128, 0, lds, it, tid);
    for (int d = 0; d < 2; d++) {
      convT_job(p.rw_w_up + (size_t)(l * 2 + d) * 64 * 256, 64, 256, 256, p.wup_t + (size_t)(l * 2 + d) * 256 * 64, 0, lds, it, tid);
      convT_job(p.rw_a_up + (size_t)(l * 2 + d) * 64 * 256, 64, 256, 256, p.aup_t + (size_t)(l * 2 + d) * 256 * 64, 0, lds, it, tid);
    }
    convT_job(p.rw_g_up + (size_t)l * 128 * 256, 128, 256, 256, p.gup_t + (size_t)l * 256 * 128, 0, lds, it, tid);
    convT_job(p.w_out + (size_t)l * 1024 * 1024, 1024, 1024, 1024, p.wout_t + (size_t)l * 1024 * 1024, 0, lds, it, tid);
    for (int e = 0; e < 16; e++) {
      size_t le = (size_t)(l * 16 + e);
      convT_job(p.moe_w1 + le * 1024 * 512, 1024, 512, 512, p.w13_t + le * 1024 * 1024, 1, lds, it, tid);
      convT_job(p.moe_w3 + le * 1024 * 512, 1024, 512, 512, p.w13_t + le * 1024 * 1024, 2, lds, it, tid);
      convT_job(p.moe_w2 + le * 512 * 1024, 512, 1024, 1024, p.w2_t + le * 1024 * 512, 0, lds, it, tid);
    }
    convT_job(p.ple_gate + (size_t)l * 1024 * 1024, 1024, 1024, 1024, p.wg_t + (size_t)l * 1024 * 1024, 0, lds, it, tid);
    convT_job(p.ple_proj + (size_t)l * 256 * 1024, 256, 1024, 1024, p.wp_t + (size_t)l * 1024 * 256, 0, lds, it, tid);
  }
  int gt = bid * NTHR + tid, ng = nb * NTHR;
  for (size_t i0 = gt; i0 < (size_t)T_ALL * 256; i0 += (size_t)ng * 8) {
    float4 v[8];
#pragma unroll
    for (int u = 0; u < 8; u++) {
      const size_t i = i0 + (size_t)u * ng;
      v[u] = make_float4(0.f, 0.f, 0.f, 0.f);
      if (i < (size_t)T_ALL * 256)
        v[u] = (i < (size_t)32768 * 256) ? ((const float4*)p.x_prompt)[i] : ((const float4*)p.x_sample)[i - (size_t)32768 * 256];
    }
#pragma unroll
    for (int u = 0; u < 8; u++) {
      const size_t i = i0 + (size_t)u * ng;
      if (i < (size_t)T_ALL * 256) ((uint2*)p.xb)[i] = make_uint2(pack2(v[u].x, v[u].y), pack2(v[u].z, v[u].w));
    }
  }
  for (int i = gt; i < 8192 * 16; i += ng) {
    int n = i >> 4, f = i & 15;
    double ifq = 0.0;
#pragma unroll
    for (int j = 0; j < 16; j++) ifq = (f == j) ? p.inv_freq[j] : ifq;
    double rev = (double)n * ifq * 0.15915494309189535;
    double fr = rev - rint(rev);
    float ff = (float)fr;
    p.ropec[i] = __builtin_amdgcn_cosf(ff);
    p.ropes[i] = __builtin_amdgcn_sinf(ff);
  }
  for (int i = gt; i < 512; i += ng) {
    float h0 = p.hg_lb[i], h1 = p.hg_lb[512 + i];
    p.lb[i] = 0.f;
    p.lb[512 + i] = 1.f / (1.f + __expf(h0 - h1));
  }
}

constexpr int G_STAGE = 32768;

template <bool AF32, class RowFn, class Epi>
DI void gemm_tile(RowFn rowfn, const u16* __restrict__ Bt, int K, Epi epi, char* lds, int tid) {
  const int lane = tid & 63, wid = tid >> 6, wr = wid >> 1, wc = wid & 1, fr = lane & 15, fq = lane >> 4;
  f32x4 acc[4][4];
#pragma unroll
  for (int m = 0; m < 4; m++)
#pragma unroll
    for (int n = 0; n < 4; n++) acc[m][n] = f32x4{0.f, 0.f, 0.f, 0.f};

  const int lrow = tid >> 3;
  const int lc = (tid & 7) ^ ((tid >> 4) & 7);
  const float* apf[8];
  const u16* aph[4];
  const u16* bp[4];
  if constexpr (AF32) {
#pragma unroll
    for (int i = 0; i < 8; i++) apf[i] = (const float*)rowfn(i * 16 + (tid >> 4)) + (tid & 15) * 4;
  } else {
#pragma unroll
    for (int i = 0; i < 4; i++) aph[i] = (const u16*)rowfn(lrow + i * 32) + lc * 8;
  }
#pragma unroll
  for (int i = 0; i < 4; i++) bp[i] = Bt + (size_t)(lrow + i * 32) * K + lc * 8;
  const int afoff = (tid >> 4) * 128 + ((((tid & 15) >> 1) ^ ((tid >> 5) & 7)) * 16) + (tid & 1) * 8;

  float4 raf[8];
  auto issue = [&](int buf, int k0) {
    char* A = lds + buf * G_STAGE;
    char* B = A + 16384;
#pragma unroll
    for (int i = 0; i < 4; i++)
      __builtin_amdgcn_global_load_lds((const unsigned*)(bp[i] + k0), (unsigned*)(B + wid * 1024 + i * 4096), 16, 0, 0);
    if constexpr (AF32) {
#pragma unroll
      for (int i = 0; i < 8; i++) raf[i] = *(const float4*)(apf[i] + k0);
    } else {
#pragma unroll
      for (int i = 0; i < 4; i++)
        __builtin_amdgcn_global_load_lds((const unsigned*)(aph[i] + k0), (unsigned*)(A + wid * 1024 + i * 4096), 16, 0, 0);
    }
  };
  auto astore = [&](int buf) {
    if constexpr (AF32) {
      char* A = lds + buf * G_STAGE;
#pragma unroll
      for (int i = 0; i < 8; i++) asm volatile("" : "+v"(raf[i].x), "+v"(raf[i].y), "+v"(raf[i].z), "+v"(raf[i].w));
#pragma unroll
      for (int i = 0; i < 8; i++)
        *(uint2*)(A + afoff + i * 2048) = make_uint2(pack2(raf[i].x, raf[i].y), pack2(raf[i].z, raf[i].w));
    }
  };
  const int abase = (wr * 64 + fr) * 128, bbase = 16384 + (wc * 64 + fr) * 128;
  const int sw0 = ((fq) ^ (fr >> 1)) * 16, sw1 = ((4 + fq) ^ (fr >> 1)) * 16;

  const int nk = K >> 6;
  if constexpr (AF32) {
    issue(0, 0);
    astore(0);
    __syncthreads();
    for (int kt = 0; kt < nk; kt++) {
      const char* S = lds + (kt & 1) * G_STAGE;
      bf16x8 af[2][4], bfr[2][4];
#pragma unroll
      for (int kk = 0; kk < 2; kk++) {
        const int sw = kk ? sw1 : sw0;
#pragma unroll
        for (int m = 0; m < 4; m++) af[kk][m] = *(const bf16x8*)(S + abase + m * 2048 + sw);
#pragma unroll
        for (int n = 0; n < 4; n++) bfr[kk][n] = *(const bf16x8*)(S + bbase + n * 2048 + sw);
      }
      __builtin_amdgcn_sched_barrier(0);
      if (kt + 1 < nk) issue((kt + 1) & 1, (kt + 1) << 6);
      __builtin_amdgcn_sched_barrier(0);
#pragma unroll
      for (int kk = 0; kk < 2; kk++)
#pragma unroll
        for (int m = 0; m < 4; m++)
#pragma unroll
          for (int n = 0; n < 4; n++) acc[m][n] = __builtin_amdgcn_mfma_f32_16x16x32_bf16(bfr[kk][n], af[kk][m], acc[m][n], 0, 0, 0);
      __builtin_amdgcn_sched_barrier(0);
      if (kt + 1 < nk) astore((kt + 1) & 1);
      __syncthreads();
    }
  } else {
    const unsigned lds0 = (unsigned)(size_t)(__attribute__((address_space(3))) char*)lds;
    const unsigned aA0 = lds0 + abase + sw0, aA1 = lds0 + abase + sw1, aB0 = lds0 + bbase + sw0, aB1 = lds0 + bbase + sw1;
#define G_DSR(dst, addr, off) asm volatile("ds_read_b128 %0, %1 offset:%2" : "=v"(dst) : "v"(addr), "n"(off))
    issue(0, 0);
    if (nk > 1) issue(1, 64);
    for (int kt = 0; kt < nk; kt++) {
      if (kt + 1 < nk) asm volatile("s_waitcnt vmcnt(8)" ::: "memory");
      else asm volatile("s_waitcnt vmcnt(0)" ::: "memory");
      __builtin_amdgcn_s_barrier();
      const unsigned so = (kt & 1) * G_STAGE;
      const unsigned pA0 = aA0 + so, pA1 = aA1 + so, pB0 = aB0 + so, pB1 = aB1 + so;
      bf16x8 a00, a01, a02, a03, a10, a11, a12, a13, b00, b01, b02, b03, b10, b11, b12, b13;
      G_DSR(a00, pA0, 0); G_DSR(a01, pA0, 2048); G_DSR(a02, pA0, 4096); G_DSR(a03, pA0, 6144);
      G_DSR(b00, pB0, 0); G_DSR(b01, pB0, 2048); G_DSR(b02, pB0, 4096); G_DSR(b03, pB0, 6144);
      G_DSR(a10, pA1, 0); G_DSR(a11, pA1, 2048); G_DSR(a12, pA1, 4096); G_DSR(a13, pA1, 6144);
      G_DSR(b10, pB1, 0); G_DSR(b11, pB1, 2048); G_DSR(b12, pB1, 4096); G_DSR(b13, pB1, 6144);
      asm volatile("s_waitcnt lgkmcnt(0)" : "+v"(a00), "+v"(a01), "+v"(a02), "+v"(a03), "+v"(b00), "+v"(b01), "+v"(b02), "+v"(b03));
      asm volatile("" : "+v"(a10), "+v"(a11), "+v"(a12), "+v"(a13), "+v"(b10), "+v"(b11), "+v"(b12), "+v"(b13));
      __builtin_amdgcn_s_barrier();
      if (kt + 2 < nk) issue(kt & 1, (kt + 2) << 6);
      __builtin_amdgcn_sched_barrier(0);
      {
        const bf16x8 af0[4] = {a00, a01, a02, a03}, af1[4] = {a10, a11, a12, a13};
        const bf16x8 bf0[4] = {b00, b01, b02, b03}, bf1[4] = {b10, b11, b12, b13};
#pragma unroll
        for (int m = 0; m < 4; m++)
#pragma unroll
          for (int n = 0; n < 4; n++) acc[m][n] = __builtin_amdgcn_mfma_f32_16x16x32_bf16(bf0[n], af0[m], acc[m][n], 0, 0, 0);
#pragma unroll
        for (int m = 0; m < 4; m++)
#pragma unroll
          for (int n = 0; n < 4; n++) acc[m][n] = __builtin_amdgcn_mfma_f32_16x16x32_bf16(bf1[n], af1[m], acc[m][n], 0, 0, 0);
      }
      __builtin_amdgcn_sched_barrier(0);
    }
  }
  epi(acc, wr * 64 + fr, wc * 64 + fq * 4);
}

#define EPI_LOOP(...)                                    \
  _Pragma("unroll") for (int m = 0; m < 4; m++)          \
  _Pragma("unroll") for (int n = 0; n < 4; n++) {        \
    const int row = rbase + m * 16;                      \
    const int col = cbase + n * 16;                      \
    const f32x4 v = acc[m][n];                           \
    __VA_ARGS__                                          \
  }

DI void st_bf4(u16* dst, f32x4 v) { *(uint2*)dst = make_uint2(pack2(v[0], v[1]), pack2(v[2], v[3])); }

DI void epi_store_rows_bf16(f32x4 (&acc)[4][4], int rbase, int cbase, char* lds, int tid, u16* dst, size_t ld, int ncols) {
#pragma unroll
  for (int m = 0; m < 4; m++)
#pragma unroll
    for (int n = 0; n < 4; n++)
      *(uint2*)(lds + (rbase + m * 16) * 272 + (cbase + n * 16) * 2) =
          make_uint2(pack2(acc[m][n][0], acc[m][n][1]), pack2(acc[m][n][2], acc[m][n][3]));
  __syncthreads();
#pragma unroll
  for (int i = 0; i < 8; i++) {
    const int id = tid + 256 * i, row = id >> 4, c = id & 15;
    if (c * 8 < ncols) *(uint4*)(dst + (size_t)row * ld + c * 8) = *(const uint4*)(lds + row * 272 + c * 16);
  }
  __syncthreads();
}

DI const float* xin_row(const Params& p, int l, int tg) {
  if (l == 0) return tg < 32768 ? p.x_prompt + (size_t)tg * 1024 : p.x_sample + (size_t)(tg - 32768) * 1024;
  return p.out + (size_t)tg * 1024;
}

DI void phase_inproj(const Params& p, int l, int tok0, char* lds, int bid, int nb, int tid) {
  const int NT = 29, MT = T_SUB / 128;
  for (int it = 0;; it++) {
    int nt, mt;
    if (!xcd_tile(it, bid, nb, MT, NT, mt, nt)) break;
    int m0 = mt * 128, n0 = nt * 128;
    auto rowfn = [&](int r) -> const void* { return p.xb + (size_t)(tok0 + m0 + r) * 1024; };
    u16* z = p.z;
    auto epi = [&](f32x4(&acc)[4][4], int rbase, int cbase) {
      epi_store_rows_bf16(acc, rbase, cbase, lds, tid, z + (size_t)m0 * ZLD + n0, ZLD, min(128, ZLD - n0));
    };
    gemm_tile<false>(rowfn, p.w_in_t + ((size_t)l * 3712 + n0) * 1024, 1024, epi, lds, tid);
  }
}

struct PrepIn {
  uint2 cq;
  unsigned ckv;
  u16 kr1, kr2;
  float rc, rsn;
  uint4 f;
  uint2 cur[3], prv[3], nxt[3];
  u16 sc[6], sp[6], sn[6];
};
DI void prep_load(PrepIn& in, const Params& p, int t, int N, int lane) {
  const int l15 = lane & 15, c4 = lane * 4;
  const u16* zr = p.z + (size_t)t * ZLD;
  const int n = t & (N - 1);
  const bool hp = n > 0, hn = n < N - 1;
  const u16* zd = zr + ZD_OFF;
  const u16* zdp = zd - (hp ? ZLD : 0);
  const u16* zdn = zd + (hn ? ZLD : 0);
  in.cq = *(const uint2*)(zr + c4);
  in.ckv = *(const unsigned*)(zr + 256 + lane * 2);
  in.kr1 = zr[384 + l15];
  in.kr2 = zr[400 + l15];
  in.rc = p.ropec[n * 16 + l15];
  in.rsn = p.ropes[n * 16 + l15];
  in.f = *(const uint4*)(zr + ZC_OFF + 256 + lane * 8);
#pragma unroll
  for (int part = 0; part < 3; part++) {
    in.cur[part] = *(const uint2*)(zd + part * 256 + c4);
    in.prv[part] = *(const uint2*)(zdp + part * 256 + c4);
    in.nxt[part] = *(const uint2*)(zdn + part * 256 + c4);
  }
#pragma unroll
  for (int i = 0; i < 6; i++) {
    in.sc[i] = zd[768 + lane + 64 * i];
    in.sp[i] = zdp[768 + lane + 64 * i];
    in.sn[i] = zdn[768 + lane + 64 * i];
  }
}

DI void phase_prep(const Params& p, int l, int N, int bid, int nb, int tid) {
  const int lane = tid & 63, wv = tid >> 6, l15 = lane & 15, c4 = lane * 4;
  float gqv[4], gkvv[2], lbv[8], m0[12], m1[12], m0s[6], m1s[6], kkc[4], rkc[4];
  {
    const float* mu0 = p.rw_mu + (size_t)l * 2 * 1152;
    const float* mu1 = mu0 + 1152;
#pragma unroll
    for (int j = 0; j < 4; j++) {
      gqv[j] = p.mla_gq[l * 256 + c4 + j];
      kkc[j] = p.rw_kk[l * 256 + c4 + j];
      rkc[j] = p.rw_rk[l * 256 + c4 + j];
    }
    gkvv[0] = p.mla_gkv[l * 128 + lane * 2];
    gkvv[1] = p.mla_gkv[l * 128 + lane * 2 + 1];
#pragma unroll
    for (int j = 0; j < 8; j++) lbv[j] = p.lb[l * 512 + lane * 8 + j];
#pragma unroll
    for (int part = 0; part < 3; part++)
#pragma unroll
      for (int j = 0; j < 4; j++) {
        m0[part * 4 + j] = mu0[part * 256 + c4 + j];
        m1[part * 4 + j] = mu1[part * 256 + c4 + j];
      }
#pragma unroll
    for (int i = 0; i < 6; i++) {
      m0s[i] = mu0[768 + lane + 64 * i];
      m1s[i] = mu1[768 + lane + 64 * i];
    }
  }
  PrepIn in, inn;
  {
    const int t0 = bid * 4 + wv;
    if (t0 < T_SUB) prep_load(in, p, t0, N, lane);
  }
  for (int t = bid * 4 + wv; t < T_SUB; t += nb * 4) {
    u16* zr = p.z + (size_t)t * ZLD;
    const int n = t & (N - 1);
    const bool hp = n > 0, hn = n < N - 1;
    {
      const int tn = t + nb * 4;
      if (tn < T_SUB) prep_load(inn, p, tn, N, lane);
      else inn = in;
    }
    const uint2 raw_cq = in.cq;
    const unsigned raw_ckv = in.ckv;
    const u16 kr1 = in.kr1, kr2 = in.kr2;
    const float rc = in.rc, rsn = in.rsn;
    uint4* fptr = (uint4*)(zr + ZC_OFF + 256 + lane * 8);
    const uint4 raw_f = in.f;
    uint2 cur[3], prv[3], nxt[3];
    u16 sc[6], sp[6], sn[6];
#pragma unroll
    for (int part = 0; part < 3; part++) { cur[part] = in.cur[part]; prv[part] = in.prv[part]; nxt[part] = in.nxt[part]; }
#pragma unroll
    for (int i = 0; i < 6; i++) { sc[i] = in.sc[i]; sp[i] = in.sp[i]; sn[i] = in.sn[i]; }
    {
      float v0 = blo(raw_cq.x), v1 = bhi(raw_cq.x), v2 = blo(raw_cq.y), v3 = bhi(raw_cq.y);
      float ss = wave_sum(v0 * v0 + v1 * v1 + v2 * v2 + v3 * v3);
      float ri = rsqrtf(ss * (1.f / 256.f) + 1e-6f);
      *(uint2*)(p.cqn + (size_t)t * 256 + c4) =
          make_uint2(pack2(v0 * ri * gqv[0], v1 * ri * gqv[1]), pack2(v2 * ri * gqv[2], v3 * ri * gqv[3]));
    }
    {
      float v0 = blo(raw_ckv), v1 = bhi(raw_ckv);
      float ss = wave_sum(v0 * v0 + v1 * v1);
      float ri = rsqrtf(ss * (1.f / 128.f) + 1e-6f);
      *(unsigned*)(p.ckvn + (size_t)t * 128 + lane * 2) = pack2(v0 * ri * gkvv[0], v1 * ri * gkvv[1]);
    }
    if (lane < 16) {
      float x1 = bf2f(kr1), x2 = bf2f(kr2);
      u16 k1 = f2bf(x1 * rc - x2 * rsn), k2 = f2bf(x1 * rsn + x2 * rc);
      u16* kb = p.Kb + (size_t)t * 384;
#pragma unroll
      for (int h = 0; h < 4; h++) {
        kb[h * 96 + 64 + lane] = k1;
        kb[h * 96 + 80 + lane] = k2;
      }
    }
    {
      unsigned w[4] = {raw_f.x, raw_f.y, raw_f.z, raw_f.w};
#pragma unroll
      for (int j = 0; j < 4; j++) {
        float a = blo(w[j]), bq = bhi(w[j]);
        float la = lbv[2 * j], lb2 = lbv[2 * j + 1];
        a = la + (1.f - la) * sigm(a);
        bq = lb2 + (1.f - lb2) * sigm(bq);
        w[j] = pack2(a, bq);
      }
      *fptr = make_uint4(w[0], w[1], w[2], w[3]);
    }
    {
      float rr[4], kx[4], vx[4];
#pragma unroll
      for (int part = 0; part < 3; part++) {
        float cz[4] = {blo(cur[part].x), bhi(cur[part].x), blo(cur[part].y), bhi(cur[part].y)};
        float pz[4] = {blo(prv[part].x), bhi(prv[part].x), blo(prv[part].y), bhi(prv[part].y)};
        float nz[4] = {blo(nxt[part].x), bhi(nxt[part].x), blo(nxt[part].y), bhi(nxt[part].y)};
#pragma unroll
        for (int j = 0; j < 4; j++) {
          float pzz = hp ? pz[j] : 0.f, nzz = hn ? nz[j] : 0.f;
          float o = cz[j] + m0[part * 4 + j] * (pzz - cz[j]) + m1[part * 4 + j] * (nzz - cz[j]);
          if (part == 0) rr[j] = o;
          if (part == 1) kx[j] = o;
          if (part == 2) vx[j] = o;
        }
      }
      *(uint2*)(p.rs + (size_t)t * 256 + c4) = make_uint2(pack2(rr[0], rr[1]), pack2(rr[2], rr[3]));
      *(uint2*)(p.ks + (size_t)t * 256 + c4) = make_uint2(pack2(kx[0], kx[1]), pack2(kx[2], kx[3]));
      *(uint2*)(p.vs + (size_t)t * 256 + c4) = make_uint2(pack2(vx[0], vx[1]), pack2(vx[2], vx[3]));
      float kq[4], ss = 0.f, bo = 0.f;
#pragma unroll
      for (int j = 0; j < 4; j++) {
        kq[j] = kx[j] * kkc[j];
        ss += kq[j] * kq[j];
        bo += rr[j] * kx[j] * rkc[j];
      }
      ss = reduce16(ss);
      bo = reduce16(bo);
      float inv = 1.f / fmaxf(sqrtf(ss), 1e-12f);
      *(uint2*)(p.kk + (size_t)t * 256 + c4) = make_uint2(pack2(kq[0] * inv, kq[1] * inv), pack2(kq[2] * inv, kq[3] * inv));
      if (l15 == 0) p.bonus[(size_t)t * 4 + (lane >> 4)] = bo;
#pragma unroll
      for (int i = 0; i < 6; i++) {
        float cz = bf2f(sc[i]);
        float pz = hp ? bf2f(sp[i]) : 0.f;
        float nz = hn ? bf2f(sn[i]) : 0.f;
        float o = cz + m0s[i] * (pz - cz) + m1s[i] * (nz - cz);
        if (i < 2) o = tanh_(o);
        else if (i >= 4) o = sigm(o);
        p.S1[(size_t)t * 384 + lane + 64 * i] = f2bf(o);
      }
    }
    in = inn;
  }
}

DI void phase_smallgemm(const Params& p, int l, int B, int N, char* lds, int bid, int nb, int tid) {
  TileIter it{bid, nb, 0};
  const int MT = T_SUB / 128;
  {
    const int NT = 3;
    for (int itx = 0;; itx++) {
      int nt, mt;
      if (!xcd_tile(itx, bid, nb, MT, NT, mt, nt)) break;
      int m0 = mt * 128, n0 = nt * 128;
      auto rowfn = [&](int r) -> const void* { return p.cqn + (size_t)(m0 + r) * 256; };
      u16* Q = p.Q;
      auto epi = [&](f32x4(&acc)[4][4], int rbase, int cbase) {
        const float SC = 0.10206207261596577f * LOG2E;
        EPI_LOOP({ st_bf4(Q + (size_t)(m0 + row) * 384 + n0 + col, v * SC); })
      };
      gemm_tile<false>(rowfn, p.wuq_t + ((size_t)l * 384 + n0) * 256, 256, epi, lds, tid);
    }
  }
  {
    const int NT = 4;
    for (int itx = 0;; itx++) {
      int nt, mt;
      if (!xcd_tile(itx, bid, nb, MT, NT, mt, nt)) break;
      int m0 = mt * 128, n0 = nt * 128;
      auto rowfn = [&](int r) -> const void* { return p.ckvn + (size_t)(m0 + r) * 128; };
      u16* Kb = p.Kb;
      u16* Vt = p.Vt;
      auto epi = [&](f32x4(&acc)[4][4], int rbase, int cbase) {
        EPI_LOOP({
          int c = n0 + col;
          int tk = m0 + row;
          if (c < 256) {
            int h = c >> 6, d = c & 63;
            st_bf4(Kb + (size_t)tk * 384 + h * 96 + d, v);
          } else {
            int cc = c - 256;
            int b = tk / N, nn = tk - b * N;
            u16* dst = Vt + ((size_t)(b * 256 + cc)) * N + nn;
            dst[0] = f2bf(v[0]);
            dst[(size_t)N] = f2bf(v[1]);
            dst[(size_t)2 * N] = f2bf(v[2]);
            dst[(size_t)3 * N] = f2bf(v[3]);
          }
        })
      };
      gemm_tile<false>(rowfn, p.wkv_t + ((size_t)l * 512 + n0) * 128, 128, epi, lds, tid);
    }
  }
  for (int d = 0; d < 2; d++) {
    const int NT = 2;
    for (int itx = 0;; itx++) {
      int nt, mt;
      if (!xcd_tile(itx, bid, nb, MT, NT, mt, nt)) break;
      int m0 = mt * 128, n0 = nt * 128;
      auto rowfn = [&](int r) -> const void* { return p.S1 + (size_t)(m0 + r) * 384 + d * 64; };
      u16* dst = p.dec + (size_t)d * T_SUB * 256;
      const float* w0 = p.rw_w0 + (l * 2 + d) * 256;
      auto epi = [&](f32x4(&acc)[4][4], int rbase, int cbase) {
        EPI_LOOP({
          f32x4 o;
          for (int j = 0; j < 4; j++) o[j] = __expf(-0.6065306597126334f * sigm(w0[n0 + col + j] + v[j]));
          st_bf4(dst + (size_t)(m0 + row) * 256 + n0 + col, o);
        })
      };
      gemm_tile<false>(rowfn, p.wup_t + ((size_t)(l * 2 + d) * 256 + n0) * 64, 64, epi, lds, tid);
    }
  }
  for (int d = 0; d < 2; d++) {
    const int NT = 2;
    for (int itx = 0;; itx++) {
      int nt, mt;
      if (!xcd_tile(itx, bid, nb, MT, NT, mt, nt)) break;
      int m0 = mt * 128, n0 = nt * 128;
      auto rowfn = [&](int r) -> const void* { return p.S1 + (size_t)(m0 + r) * 384 + 128 + d * 64; };
      u16* dka = p.kka + (size_t)d * T_SUB * 256;
      u16* dkt = p.kt + (size_t)d * T_SUB * 256;
      const float* a0 = p.rw_a0 + (l * 2 + d) * 256;
      const float* ka = p.rw_ka + l * 256;
      const u16* kkp = p.kk;
      const u16* ksp = p.ks;
      auto epi = [&](f32x4(&acc)[4][4], int rbase, int cbase) {
        EPI_LOOP({
          size_t o = (size_t)(m0 + row) * 256 + n0 + col;
          uint2 kkr = *(const uint2*)(kkp + o);
          uint2 ksr = *(const uint2*)(ksp + o);
          float kkv[4] = {blo(kkr.x), bhi(kkr.x), blo(kkr.y), bhi(kkr.y)};
          float ksv[4] = {blo(ksr.x), bhi(ksr.x), blo(ksr.y), bhi(ksr.y)};
          f32x4 o1, o2;
          for (int j = 0; j < 4; j++) {
            float a = sigm(a0[n0 + col + j] + v[j]);
            o1[j] = kkv[j] * a;
            o2[j] = ksv[j] * (1.f + (a - 1.f) * ka[n0 + col + j]);
          }
          st_bf4(dka + o, o1);
          st_bf4(dkt + o, o2);
        })
      };
      gemm_tile<false>(rowfn, p.aup_t + ((size_t)(l * 2 + d) * 256 + n0) * 64, 64, epi, lds, tid);
    }
  }
  {
    const int NT = 2;
    for (int itx = 0;; itx++) {
      int nt, mt;
      if (!xcd_tile(itx, bid, nb, MT, NT, mt, nt)) break;
      int m0 = mt * 128, n0 = nt * 128;
      auto rowfn = [&](int r) -> const void* { return p.S1 + (size_t)(m0 + r) * 384 + 256; };
      u16* dst = p.gD;
      auto epi = [&](f32x4(&acc)[4][4], int rbase, int cbase) {
        EPI_LOOP({ st_bf4(dst + (size_t)(m0 + row) * 256 + n0 + col, v); })
      };
      gemm_tile<false>(rowfn, p.gup_t + ((size_t)l * 256 + n0) * 128, 128, epi, lds, tid);
    }
  }
}

DI bf16x8 pack8(const f32x16& s, int o) {
  u32x4_t r = {pack2(s[o], s[o + 1]), pack2(s[o + 2], s[o + 3]), pack2(s[o + 4], s[o + 5]), pack2(s[o + 6], s[o + 7])};
  return __builtin_bit_cast(bf16x8, r);
}

constexpr int AT_KP = 208, AT_VP = 144, AT_BUF = 64 * AT_KP + 64 * AT_VP;
DI void attn_task(const Params& p, int task, int N, char* lds, int tid) {
  const int lane = tid & 63, wv = tid >> 6, r = lane & 31, hf = lane >> 5;
  const int nqb = N >> 7;
  {
    const int qb = task % nqb, bh = task / nqb, h = bh & 3, b = bh >> 2;
    const size_t tb = (size_t)b * N;
    const int q = qb * 128 + wv * 32 + r;
    bf16x8 qf[6];
    {
      const u16* qrow = p.Q + (tb + q) * 384 + h * 96;
#pragma unroll
      for (int ks = 0; ks < 4; ks++) qf[ks] = *(const bf16x8*)(qrow + ks * 16 + hf * 8);
      bf16x8 x1r = *(const bf16x8*)(qrow + 64 + hf * 8);
      bf16x8 x2r = *(const bf16x8*)(qrow + 80 + hf * 8);
      const float* cp = p.ropec + q * 16 + hf * 8;
      const float* sp = p.ropes + q * 16 + hf * 8;
      float ra[8], rb[8];
#pragma unroll
      for (int j = 0; j < 8; j++) {
        float xa = bf2f((u16)x1r[j]), ya = bf2f((u16)x2r[j]);
        float c0 = cp[j], s0 = sp[j];
        ra[j] = xa * c0 - ya * s0;
        rb[j] = xa * s0 + ya * c0;
      }
      u32x4_t o1 = {pack2(ra[0], ra[1]), pack2(ra[2], ra[3]), pack2(ra[4], ra[5]), pack2(ra[6], ra[7])};
      u32x4_t o2 = {pack2(rb[0], rb[1]), pack2(rb[2], rb[3]), pack2(rb[4], rb[5]), pack2(rb[6], rb[7])};
      qf[4] = __builtin_bit_cast(bf16x8, o1);
      qf[5] = __builtin_bit_cast(bf16x8, o2);
    }
    const u16* Kg = p.Kb + tb * 384 + h * 96;
    const u16* Vg = p.Vt + ((size_t)(b * 4 + h) * 64) * N;
    uint4 kr0, kr1, kr2, vr0, vr1;
    const int lkey = tid >> 2, lpart = tid & 3;
    const int lrow = swap23(lkey);
#define AT_GLOAD(kt_)                                                              \
  {                                                                                \
    const u16* kp_ = Kg + (size_t)((kt_) * 64 + lkey) * 384 + lpart * 24;          \
    kr0 = *(const uint4*)(kp_);                                                    \
    kr1 = *(const uint4*)(kp_ + 8);                                                \
    kr2 = *(const uint4*)(kp_ + 16);                                               \
    const u16* vp_ = Vg + (size_t)lkey * N + (kt_) * 64 + lpart * 16;              \
    vr0 = *(const uint4*)(vp_);                                                    \
    vr1 = *(const uint4*)(vp_ + 8);                                                \
  }
#define AT_LSTORE(buf_)                                                            \
  {                                                                                \
    char* Kl_ = lds + (buf_) * AT_BUF;                                             \
    char* Vl_ = Kl_ + 64 * AT_KP;                                                  \
    *(uint4*)(Kl_ + lrow * AT_KP + (lpart * 3 + 0) * 16) = kr0;                    \
    *(uint4*)(Kl_ + lrow * AT_KP + (lpart * 3 + 1) * 16) = kr1;                    \
    *(uint4*)(Kl_ + lrow * AT_KP + (lpart * 3 + 2) * 16) = kr2;                    \
    *(uint4*)(Vl_ + lkey * AT_VP + (lpart * 2 + 0) * 16) = vr0;                    \
    *(uint4*)(Vl_ + lkey * AT_VP + (lpart * 2 + 1) * 16) = vr1;                    \
  }
    f32x16 O0, O1;
#pragma unroll
    for (int i = 0; i < 16; i++) { O0[i] = 0.f; O1[i] = 0.f; }
    float mrun = 0.f, lrun = 0.f;
    const int nt = N >> 6;
    __syncthreads();
    AT_GLOAD(0);
    AT_LSTORE(0);
    __syncthreads();
    for (int kt = 0; kt < nt; kt++) {
      if (kt + 1 < nt) AT_GLOAD(kt + 1);
      __builtin_amdgcn_sched_barrier(0);
      const char* Kl = lds + (kt & 1) * AT_BUF;
      const char* Vl = Kl + 64 * AT_KP;
      f32x16 S0, S1;
      {
        const float nm = -mrun;
#pragma unroll
        for (int i = 0; i < 16; i++) { S0[i] = nm; S1[i] = nm; }
      }
#pragma unroll
      for (int ks = 0; ks < 6; ks++) {
        bf16x8 a0 = *(const bf16x8*)(Kl + r * AT_KP + ks * 32 + hf * 16);
        bf16x8 a1 = *(const bf16x8*)(Kl + (32 + r) * AT_KP + ks * 32 + hf * 16);
        S0 = __builtin_amdgcn_mfma_f32_32x32x16_bf16(a0, qf[ks], S0, 0, 0, 0);
        S1 = __builtin_amdgcn_mfma_f32_32x32x16_bf16(a1, qf[ks], S1, 0, 0, 0);
      }
      float mx = fmaxf(S0[0], S1[0]);
#pragma unroll
      for (int i = 1; i < 16; i++) mx = fmaxf(mx, fmaxf(S0[i], S1[i]));
      if (__any((mx > 12.f) || (kt == 0))) {
        const float mq = fmaxf(mx, __shfl_xor(mx, 32));
        const float shift = (kt == 0) ? mq : ((mq > 12.f) ? mq : 0.f);
        const float sc = (kt == 0) ? 1.f : ex2(-shift);
        mrun += shift;
        lrun *= sc;
#pragma unroll
        for (int i = 0; i < 16; i++) {
          S0[i] -= shift;
          S1[i] -= shift;
          O0[i] *= sc;
          O1[i] *= sc;
        }
      }
      float ls = 0.f;
#pragma unroll
      for (int i = 0; i < 16; i++) {
        S0[i] = ex2(S0[i]);
        S1[i] = ex2(S1[i]);
        ls += S0[i] + S1[i];
      }
      lrun += ls;
#pragma unroll
      for (int sp = 0; sp < 4; sp++) {
        bf16x8 pb = (sp < 2) ? pack8(S0, (sp & 1) * 8) : pack8(S1, (sp & 1) * 8);
        bf16x8 v0 = *(const bf16x8*)(Vl + r * AT_VP + sp * 32 + hf * 16);
        bf16x8 v1 = *(const bf16x8*)(Vl + (32 + r) * AT_VP + sp * 32 + hf * 16);
        O0 = __builtin_amdgcn_mfma_f32_32x32x16_bf16(v0, pb, O0, 0, 0, 0);
        O1 = __builtin_amdgcn_mfma_f32_32x32x16_bf16(v1, pb, O1, 0, 0, 0);
      }
      __builtin_amdgcn_sched_barrier(0);
      if (kt + 1 < nt) AT_LSTORE((kt + 1) & 1);
      __syncthreads();
    }
    float lt = lrun + __shfl_xor(lrun, 32);
    float inv = 1.f / lt;
    u16* orow = p.cat + (tb + q) * 1024 + h * 64;
#pragma unroll
    for (int g = 0; g < 4; g++) {
      int d0 = 8 * g + 4 * hf;
      *(uint2*)(orow + d0) = make_uint2(pack2(O0[4 * g] * inv, O0[4 * g + 1] * inv), pack2(O0[4 * g + 2] * inv, O0[4 * g + 3] * inv));
      *(uint2*)(orow + 32 + d0) = make_uint2(pack2(O1[4 * g] * inv, O1[4 * g + 1] * inv), pack2(O1[4 * g + 2] * inv, O1[4 * g + 3] * inv));
    }
  }
}

DI void na_task(const Params& p, int l, int task, int N, int tid) {
  const int lane = tid & 63, head = tid >> 6, r = lane & 31, hf = lane >> 5;
  const int rows = N >> 6;
  const int nrb = rows >> 1;
  const float* bias = p.na_bias + (size_t)(l * 4 + head) * 15 * 31;
  {
    const int cb = task & 3, rb = (task >> 2) % nrb, b = (task >> 2) / nrb;
    const size_t tb = (size_t)b * N;
    const int qrow0 = rb * 2;
    const int rstart0 = clampi(qrow0 - 4, 0, rows - 8);
    const int k0 = clampi(rstart0, 0, rows - 9);
    const int kstart = clampi(cb * 16 - 8, 0, 32);
    const int iq = r >> 4, u = r & 15;
    const int qrow = qrow0 + iq, qcol = cb * 16 + u;
    const int rstart = clampi(qrow - 4, 0, rows - 8);
    const int cstart = clampi(qcol - 8, 0, 48);
    bf16x8 qf[4];
    {
      const u16* qp = p.z + (tb + qrow * 64 + qcol) * ZLD + ZB_OFF + head * 64;
#pragma unroll
      for (int ks = 0; ks < 4; ks++) qf[ks] = *(const bf16x8*)(qp + ks * 16 + hf * 8);
    }
    f32x16 O0, O1;
#pragma unroll
    for (int i = 0; i < 16; i++) { O0[i] = 0.f; O1[i] = 0.f; }
    float mrun = -1e30f, lrun = 0.f;
    const int wk = swap23(r);
    for (int j = 0; j < 9; j++) {
      const int krow = k0 + j;
      const u16* kp = p.z + (tb + krow * 64 + kstart + wk) * ZLD + ZB_OFF + 256 + head * 64;
      f32x16 S;
#pragma unroll
      for (int i = 0; i < 16; i++) S[i] = 0.f;
#pragma unroll
      for (int ks = 0; ks < 4; ks++) {
        bf16x8 a = *(const bf16x8*)(kp + ks * 16 + hf * 8);
        S = __builtin_amdgcn_mfma_f32_32x32x16_bf16(a, qf[ks], S, 0, 0, 0);
      }
      const bool rok = (krow >= rstart) && (krow < rstart + 8);
      const int drow = clampi(krow - qrow + 7, 0, 14);
      const float* brow = bias + drow * 31;
      float mx = -1e30f;
#pragma unroll
      for (int i = 0; i < 16; i++) {
        int w = 16 * (i >> 3) + 8 * hf + 4 * ((i >> 2) & 1) + (i & 3);
        int kcol = kstart + w;
        bool ok = rok && (kcol >= cstart) && (kcol < cstart + 16);
        int dcol = clampi(kcol - qcol + 15, 0, 30);
        float s = (S[i] * 0.125f + brow[dcol]) * LOG2E;
        S[i] = ok ? s : -1e30f;
        mx = fmaxf(mx, S[i]);
      }
      mx = fmaxf(mx, __shfl_xor(mx, 32));
      float mn = fmaxf(mrun, mx);
      float alpha = ex2(mrun - mn);
      mrun = mn;
      float ls = 0.f;
#pragma unroll
      for (int i = 0; i < 16; i++) {
        float pv = (S[i] > -1e29f) ? ex2(S[i] - mn) : 0.f;
        S[i] = pv;
        ls += pv;
      }
      lrun = lrun * alpha + ls;
#pragma unroll
      for (int i = 0; i < 16; i++) { O0[i] *= alpha; O1[i] *= alpha; }
      const u16* vbase = p.z + (tb + krow * 64 + kstart) * ZLD + ZB_OFF + 512 + head * 64 + r;
#pragma unroll
      for (int s = 0; s < 2; s++) {
        bf16x8 pb = pack8(S, s * 8);
        bf16x8 v0, v1;
#pragma unroll
        for (int jj = 0; jj < 8; jj++) {
          const u16* vp = vbase + (size_t)(16 * s + 8 * hf + jj) * ZLD;
          v0[jj] = (short)vp[0];
          v1[jj] = (short)vp[32];
        }
        O0 = __builtin_amdgcn_mfma_f32_32x32x16_bf16(v0, pb, O0, 0, 0, 0);
        O1 = __builtin_amdgcn_mfma_f32_32x32x16_bf16(v1, pb, O1, 0, 0, 0);
      }
    }
    float lt = lrun + __shfl_xor(lrun, 32);
    float inv = 1.f / lt;
    u16* orow = p.cat + (tb + qrow * 64 + qcol) * 1024 + 256 + head * 64;
#pragma unroll
    for (int g = 0; g < 4; g++) {
      int d0 = 8 * g + 4 * hf;
      *(uint2*)(orow + d0) = make_uint2(pack2(O0[4 * g] * inv, O0[4 * g + 1] * inv), pack2(O0[4 * g + 2] * inv, O0[4 * g + 3] * inv));
      *(uint2*)(orow + 32 + d0) = make_uint2(pack2(O1[4 * g] * inv, O1[4 * g + 1] * inv), pack2(O1[4 * g + 2] * inv, O1[4 * g + 3] * inv));
    }
  }
}

using f32x2 = __attribute__((ext_vector_type(2))) float;
constexpr int SC_STEPS = 16;

DI void sc_store(char* buf, int dst, uint4 R, bool hgw) {
  float4 lo = make_float4(blo(R.x), bhi(R.x), blo(R.y), bhi(R.y));
  float4 hi = make_float4(blo(R.z), bhi(R.z), blo(R.w), bhi(R.w));
  *(float4*)(buf + dst) = lo;
  *(float4*)(buf + dst + 16) = hi;
  if (hgw) {
    *(float4*)(buf + dst + 256) = make_float4(1.f - lo.x, 1.f - lo.y, 1.f - lo.z, 1.f - lo.w);
    *(float4*)(buf + dst + 272) = make_float4(1.f - hi.x, 1.f - hi.y, 1.f - hi.z, 1.f - hi.w);
  }
}

DI float reduce8(float v) {
  v += dpp_f<0xB1>(v);
  v += dpp_f<0x4E>(v);
  v += dpp_f<0x141>(v);
  return v;
}

template <bool RW>
DI void scan_task(const Params& p, int task, int N, char* lds, int tid) {
  constexpr int NA = RW ? 5 : 3;
  constexpr int VOFF = SC_STEPS * NA * 256;
  constexpr int BUF = VOFF + SC_STEPS * 128;
  const int lane = tid & 63, wv = tid >> 6, kq = lane & 7, rg = lane >> 3;
  const int rq = task & 1, hh = (task >> 1) & 3, dir = (task >> 3) & 1, b = task >> 4;
  const size_t tb = (size_t)b * N;
  const int sub = tid >> 7, lt = tid & 127, lstep = lt >> 3, lpart = lt & 7;
  const int vstep = lt >> 2, vq = lt & 3;
  const u16 *src0 = nullptr, *src1 = nullptr, *src2 = nullptr;
  int dst0 = 0, dst1 = 0, dst2 = 0, st0 = 0, st1 = 0, st2 = 0;
  bool act0 = false, act1 = false, act2 = false, hgw = false;
  int ld;
  const int acol = hh * 64 + lpart * 8;
  const int vcol = hh * 64 + rq * 32 + vq * 8;
  const int vdst = VOFF + vstep * 128 + vq * 32;
  if (RW) {
    ld = 256;
    act0 = true; st0 = lstep;
    src0 = sub ? (p.dec + (size_t)dir * T_SUB * 256 + acol) : (p.rs + acol);
    dst0 = (lstep * NA + (sub ? 1 : 0)) * 256 + lpart * 32;
    act1 = true; st1 = lstep;
    src1 = sub ? (p.kk + acol) : (p.kt + (size_t)dir * T_SUB * 256 + acol);
    dst1 = (lstep * NA + (sub ? 3 : 2)) * 256 + lpart * 32;
    if (sub == 0) { act2 = true; st2 = lstep; src2 = p.kka + (size_t)dir * T_SUB * 256 + acol; dst2 = (lstep * NA + 4) * 256 + lpart * 32; }
    else { act2 = lt < 64; st2 = vstep; src2 = p.vs + vcol; dst2 = vdst; }
  } else {
    ld = ZLD;
    act0 = true; st0 = lstep;
    src0 = sub ? (p.z + ZC_OFF + 256 * (1 + dir) + acol) : (p.z + ZC_OFF + acol);
    dst0 = (lstep * NA + (sub ? 1 : 0)) * 256 + lpart * 32;
    hgw = sub != 0;
    if (sub == 0) { act1 = lt < 64; st1 = vstep; src1 = p.z + ZC_OFF + 768 + vcol; dst1 = vdst; }
  }
  u16* pout = (RW ? p.oD : p.oC) + (size_t)dir * T_SUB * 256 + hh * 64 + rq * 32 + wv * 8 + rg;
  pout += (tb + (dir ? (N - 1) : 0)) * 256;
  const int ostride = dir ? -256 : 256;

#define SC_TOK(c_, st_) (tb + (size_t)(dir ? (N - 1 - ((c_) * SC_STEPS + (st_))) : ((c_) * SC_STEPS + (st_))))
#define SC_ISSUE(Ra, Rb, Rc, c_)                                               \
  {                                                                            \
    if (act0) Ra = *(const uint4*)(src0 + SC_TOK(c_, st0) * ld);               \
    if (act1) Rb = *(const uint4*)(src1 + SC_TOK(c_, st1) * ld);               \
    if (act2) Rc = *(const uint4*)(src2 + SC_TOK(c_, st2) * ld);               \
  }
#define SC_STORE(Ra, Rb, Rc, buf_)                                             \
  {                                                                            \
    if (act0) sc_store(buf_, dst0, Ra, hgw);                                   \
    if (act1) sc_store(buf_, dst1, Rb, false);                                 \
    if (act2) sc_store(buf_, dst2, Rc, false);                                 \
  }
  f32x2 S0 = {0.f, 0.f}, S1 = {0.f, 0.f}, S2 = {0.f, 0.f}, S3 = {0.f, 0.f};
#define SC_LD(buf_, s_, ra_, rb_, wa_, wb_, ta_, tb_, ka_, kb_, aa_, ab_, v_)                \
  {                                                                                          \
    const char* rowp_ = (buf_) + (s_) * NA * 256 + kq * 32;                                  \
    ra_ = *(const float4*)(rowp_);                                                           \
    rb_ = *(const float4*)(rowp_ + 16);                                                      \
    wa_ = *(const float4*)(rowp_ + 256);                                                     \
    wb_ = *(const float4*)(rowp_ + 272);                                                     \
    ta_ = *(const float4*)(rowp_ + 512);                                                     \
    tb_ = *(const float4*)(rowp_ + 528);                                                     \
    if (RW) {                                                                                \
      ka_ = *(const float4*)(rowp_ + 768);                                                   \
      kb_ = *(const float4*)(rowp_ + 784);                                                   \
      aa_ = *(const float4*)(rowp_ + 1024);                                                  \
      ab_ = *(const float4*)(rowp_ + 1040);                                                  \
    }                                                                                        \
    v_ = *(const float*)((buf_) + VOFF + (s_) * 128 + (wv * 8 + rg) * 4);                    \
  }
#define F2A(q_) f32x2{(q_).x, (q_).y}
#define F2B(q_) f32x2{(q_).z, (q_).w}
#define SC_COMPUTE(buf_)                                                                     \
  {                                                                                          \
    float oselA = 0.f, oselB = 0.f;                                                          \
    float4 ra, rb, wa, wb, ta, tb_, ka, kb, aa, ab, nra, nrb, nwa, nwb, nta, ntb, nka, nkb, naa, nab; \
    float vv, nvv;                                                                           \
    ka = kb = aa = ab = nka = nkb = naa = nab = make_float4(0.f, 0.f, 0.f, 0.f);             \
    SC_LD(buf_, 0, ra, rb, wa, wb, ta, tb_, ka, kb, aa, ab, vv);                             \
    _Pragma("unroll") for (int s = 0; s < SC_STEPS; s++) {                                   \
      if (s + 1 < SC_STEPS) SC_LD(buf_, s + 1, nra, nrb, nwa, nwb, nta, ntb, nka, nkb, naa, nab, nvv); \
      f32x2 u0 = F2A(ta) * vv, u1 = F2B(ta) * vv, u2 = F2A(tb_) * vv, u3 = F2B(tb_) * vv;     \
      if (RW) {                                                                              \
        f32x2 pa = S0 * F2A(ka), pb = S1 * F2B(ka);                                          \
        pa = S2 * F2A(kb) + pa;                                                              \
        pb = S3 * F2B(kb) + pb;                                                              \
        pa = pa + pb;                                                                        \
        const float sa = -reduce8(pa.x + pa.y);                                              \
        u0 = F2A(aa) * sa + u0;                                                              \
        u1 = F2B(aa) * sa + u1;                                                              \
        u2 = F2A(ab) * sa + u2;                                                              \
        u3 = F2B(ab) * sa + u3;                                                              \
      }                                                                                      \
      S0 = S0 * F2A(wa) + u0;                                                                \
      S1 = S1 * F2B(wa) + u1;                                                                \
      S2 = S2 * F2A(wb) + u2;                                                                \
      S3 = S3 * F2B(wb) + u3;                                                                \
      f32x2 qa = S0 * F2A(ra), qb = S1 * F2B(ra);                                            \
      qa = S2 * F2A(rb) + qa;                                                                \
      qb = S3 * F2B(rb) + qb;                                                                \
      qa = qa + qb;                                                                          \
      const float o = reduce8(qa.x + qa.y);                                                  \
      if (s < 8) oselA = (kq == s) ? o : oselA;                                              \
      else oselB = (kq == s - 8) ? o : oselB;                                                \
      ra = nra; rb = nrb; wa = nwa; wb = nwb; ta = nta; tb_ = ntb;                           \
      ka = nka; kb = nkb; aa = naa; ab = nab; vv = nvv;                                      \
    }                                                                                        \
    pout[kq * ostride] = f2bf(oselA);                                                        \
    pout[(kq + 8) * ostride] = f2bf(oselB);                                                  \
    pout += SC_STEPS * ostride;                                                              \
  }
  uint4 A0 = make_uint4(0, 0, 0, 0), A1 = A0, A2 = A0, B0 = A0, B1 = A0, B2 = A0;
  char* buf0 = lds;
  char* buf1 = lds + BUF;
  const int nch = N / SC_STEPS;
  __syncthreads();
  SC_ISSUE(A0, A1, A2, 0);
  SC_ISSUE(B0, B1, B2, 1);
  SC_STORE(A0, A1, A2, buf0);
  __syncthreads();
  for (int c = 0; c < nch; c += 2) {
    if (c + 2 < nch) SC_ISSUE(A0, A1, A2, c + 2);
    __builtin_amdgcn_sched_barrier(0);
    SC_COMPUTE(buf0);
    __builtin_amdgcn_sched_barrier(0);
    SC_STORE(B0, B1, B2, buf1);
    __syncthreads();
    if (c + 3 < nch) SC_ISSUE(B0, B1, B2, c + 3);
    __builtin_amdgcn_sched_barrier(0);
    SC_COMPUTE(buf1);
    __builtin_amdgcn_sched_barrier(0);
    if (c + 2 < nch) SC_STORE(A0, A1, A2, buf0);
    __syncthreads();
  }
}

template <bool RW>
DI void scan_task16(const Params& p, int task, int N, char* lds, int tid) {
  constexpr int NA = RW ? 5 : 3;
  constexpr int VOFF = SC_STEPS * NA * 256;
  constexpr int BUF = VOFF + SC_STEPS * 64;
  const int lane = tid & 63, wv = tid >> 6, kq = lane & 15, rg = lane >> 4;
  const int rq = task & 3, hh = (task >> 2) & 3, dir = (task >> 4) & 1, b = task >> 5;
  const size_t tb = (size_t)b * N;
  const int sub = tid >> 7, lt = tid & 127, lstep = lt >> 3, lpart = lt & 7;
  const int vstep = lt >> 1, vhalf = lt & 1;
  const u16 *src0 = nullptr, *src1 = nullptr, *src2 = nullptr;
  int dst0 = 0, dst1 = 0, dst2 = 0, st0 = 0, st1 = 0, st2 = 0;
  bool act0 = false, act1 = false, act2 = false, hgw = false;
  int ld;
  const int acol = hh * 64 + lpart * 8;
  const int vcol = hh * 64 + rq * 16 + vhalf * 8;
  const int vdst = VOFF + vstep * 64 + vhalf * 32;
  if (RW) {
    ld = 256;
    act0 = true; st0 = lstep;
    src0 = sub ? (p.dec + (size_t)dir * T_SUB * 256 + acol) : (p.rs + acol);
    dst0 = (lstep * NA + (sub ? 1 : 0)) * 256 + lpart * 32;
    act1 = true; st1 = lstep;
    src1 = sub ? (p.kk + acol) : (p.kt + (size_t)dir * T_SUB * 256 + acol);
    dst1 = (lstep * NA + (sub ? 3 : 2)) * 256 + lpart * 32;
    if (sub == 0) { act2 = true; st2 = lstep; src2 = p.kka + (size_t)dir * T_SUB * 256 + acol; dst2 = (lstep * NA + 4) * 256 + lpart * 32; }
    else { act2 = lt < 32; st2 = vstep; src2 = p.vs + vcol; dst2 = vdst; }
  } else {
    ld = ZLD;
    act0 = true; st0 = lstep;
    src0 = sub ? (p.z + ZC_OFF + 256 * (1 + dir) + acol) : (p.z + ZC_OFF + acol);
    dst0 = (lstep * NA + (sub ? 1 : 0)) * 256 + lpart * 32;
    hgw = sub != 0;
    if (sub == 0) { act1 = lt < 32; st1 = vstep; src1 = p.z + ZC_OFF + 768 + vcol; dst1 = vdst; }
  }
  u16* pout = (RW ? p.oD : p.oC) + (size_t)dir * T_SUB * 256 + hh * 64 + rq * 16 + wv * 4 + rg;
  pout += (tb + (dir ? (N - 1) : 0)) * 256;
  const int ostride = dir ? -256 : 256;

#define SC16_TOK(c_, st_) (tb + (size_t)(dir ? (N - 1 - ((c_) * SC_STEPS + (st_))) : ((c_) * SC_STEPS + (st_))))
#define SC16_ISSUE(Ra, Rb, Rc, c_)                                               \
  {                                                                            \
    if (act0) Ra = *(const uint4*)(src0 + SC16_TOK(c_, st0) * ld);               \
    if (act1) Rb = *(const uint4*)(src1 + SC16_TOK(c_, st1) * ld);               \
    if (act2) Rc = *(const uint4*)(src2 + SC16_TOK(c_, st2) * ld);               \
  }
#define SC16_STORE(Ra, Rb, Rc, buf_)                                             \
  {                                                                            \
    if (act0) sc_store(buf_, dst0, Ra, hgw);                                   \
    if (act1) sc_store(buf_, dst1, Rb, false);                                 \
    if (act2) sc_store(buf_, dst2, Rc, false);                                 \
  }
  f32x2 S01 = {0.f, 0.f}, S23 = {0.f, 0.f};
#define SC16_LD(buf_, s_, r_, w_, t_, k_, a_, v_)                                              \
  {                                                                                          \
    const char* rowp_ = (buf_) + (s_) * NA * 256 + kq * 16;                                  \
    r_ = *(const float4*)(rowp_);                                                            \
    w_ = *(const float4*)(rowp_ + 256);                                                      \
    t_ = *(const float4*)(rowp_ + 512);                                                      \
    if (RW) {                                                                                \
      k_ = *(const float4*)(rowp_ + 768);                                                    \
      a_ = *(const float4*)(rowp_ + 1024);                                                   \
    }                                                                                        \
    v_ = *(const float*)((buf_) + VOFF + (s_) * 64 + (wv * 4 + rg) * 4);                     \
  }
#define SC16_COMPUTE(buf_)                                                                     \
  {                                                                                          \
    float osel = 0.f;                                                                        \
    float4 r4, w4, t4, k4, a4, nr4, nw4, nt4, nk4, na4;                                      \
    float vv, nvv;                                                                           \
    k4 = a4 = nk4 = na4 = make_float4(0.f, 0.f, 0.f, 0.f);                                   \
    SC16_LD(buf_, 0, r4, w4, t4, k4, a4, vv);                                                  \
    _Pragma("unroll") for (int s = 0; s < SC_STEPS; s++) {                                   \
      if (s + 1 < SC_STEPS) SC16_LD(buf_, s + 1, nr4, nw4, nt4, nk4, na4, nvv);                \
      f32x2 ta = f32x2{t4.x, t4.y} * vv, tb2 = f32x2{t4.z, t4.w} * vv;                       \
      if (RW) {                                                                              \
        f32x2 pp = S01 * f32x2{k4.x, k4.y};                                                  \
        pp = S23 * f32x2{k4.z, k4.w} + pp;                                                   \
        const float sa = -reduce16(pp.x + pp.y);                                             \
        ta = f32x2{a4.x, a4.y} * sa + ta;                                                    \
        tb2 = f32x2{a4.z, a4.w} * sa + tb2;                                                  \
      }                                                                                      \
      S01 = S01 * f32x2{w4.x, w4.y} + ta;                                                    \
      S23 = S23 * f32x2{w4.z, w4.w} + tb2;                                                   \
      f32x2 qq = S01 * f32x2{r4.x, r4.y};                                                    \
      qq = S23 * f32x2{r4.z, r4.w} + qq;                                                     \
      const float o = reduce16(qq.x + qq.y);                                                 \
      osel = (kq == s) ? o : osel;                                                           \
      r4 = nr4; w4 = nw4; t4 = nt4; k4 = nk4; a4 = na4; vv = nvv;                            \
    }                                                                                        \
    pout[kq * ostride] = f2bf(osel);                                                         \
    pout += SC_STEPS * ostride;                                                              \
  }
  uint4 A0 = make_uint4(0, 0, 0, 0), A1 = A0, A2 = A0, B0 = A0, B1 = A0, B2 = A0;
  char* buf0 = lds;
  char* buf1 = lds + BUF;
  const int nch = N / SC_STEPS;
  __syncthreads();
  SC16_ISSUE(A0, A1, A2, 0);
  SC16_ISSUE(B0, B1, B2, 1);
  SC16_STORE(A0, A1, A2, buf0);
  __syncthreads();
  for (int c = 0; c < nch; c += 2) {
    if (c + 2 < nch) SC16_ISSUE(A0, A1, A2, c + 2);
    __builtin_amdgcn_sched_barrier(0);
    SC16_COMPUTE(buf0);
    __builtin_amdgcn_sched_barrier(0);
    SC16_STORE(B0, B1, B2, buf1);
    __syncthreads();
    if (c + 3 < nch) SC16_ISSUE(B0, B1, B2, c + 3);
    __builtin_amdgcn_sched_barrier(0);
    SC16_COMPUTE(buf1);
    __builtin_amdgcn_sched_barrier(0);
    if (c + 2 < nch) SC16_STORE(A0, A1, A2, buf0);
    __syncthreads();
  }
}


DI void phase_mix(const Params& p, int l, int B, int N, unsigned* ctr, char* lds, int bid, int nb, int tid) {
  __shared__ int s_task[2];
  const bool wide = (N > 4096);
  const int nper = wide ? B * 32 : B * 16;
  const int nscan = 2 * nper;
  const int nattn = B * 4 * (N >> 7);
  const int nna = B * (N >> 7) * 4;
  const bool prefer_scan = bid < (nb >> 1);
  bool scan_dry = false, attn_dry = false;
  for (;;) {
    if (tid == 0) {
      int kind = -1, task = 0;
      for (int attempt = 0; attempt < 2 && kind < 0; attempt++) {
        const bool try_scan = (attempt == 0) == prefer_scan;
        if (try_scan) {
          if (!scan_dry) {
            const int t = (int)atomicAdd(&ctr[0], 1u);
            if (t < nscan) { kind = 0; task = t; } else scan_dry = true;
          }
        } else {
          if (!attn_dry) {
            const int t = (int)atomicAdd(&ctr[64], 1u);
            if (t < nattn + nna) { kind = 1; task = t; } else attn_dry = true;
          }
        }
      }
      s_task[0] = kind;
      s_task[1] = task;
    }
    __syncthreads();
    const int kind = s_task[0], task = s_task[1];
    __syncthreads();
    if (kind < 0) break;
    if (kind == 0) {
      if (wide) {
        if (task < nper) scan_task16<true>(p, task, N, lds, tid);
        else scan_task16<false>(p, task - nper, N, lds, tid);
      } else {
        if (task < nper) scan_task<true>(p, task, N, lds, tid);
        else scan_task<false>(p, task - nper, N, lds, tid);
      }
    } else {
      if (task < nattn) attn_task(p, task, N, lds, tid);
      else na_task(p, l, task - nattn, N, tid);
    }
  }
}

DI void phase_final(const Params& p, int l, int bid, int nb, int tid) {
  const int lane = tid & 63, wv = tid >> 6, c4 = lane * 4;
  float gn[4], lw[4], lbb[4];
#pragma unroll
  for (int j = 0; j < 4; j++) {
    gn[j] = p.hg_gnorm[l * 256 + c4 + j];
    lw[j] = p.rw_ln_w[l * 256 + c4 + j];
    lbb[j] = p.rw_ln_b[l * 256 + c4 + j];
  }
  for (int t = bid * 4 + wv; t < T_SUB; t += nb * 4) {
    const uint2 ca = *(const uint2*)(p.oC + (size_t)t * 256 + c4);
    const uint2 cb = *(const uint2*)(p.oC + (size_t)(T_SUB + t) * 256 + c4);
    const uint2 cg = *(const uint2*)(p.z + (size_t)t * ZLD + ZC_OFF + 1024 + c4);
    const uint2 da = *(const uint2*)(p.oD + (size_t)t * 256 + c4);
    const uint2 db = *(const uint2*)(p.oD + (size_t)(T_SUB + t) * 256 + c4);
    const float bo = p.bonus[(size_t)t * 4 + (lane >> 4)];
    const uint2 vr = *(const uint2*)(p.vs + (size_t)t * 256 + c4);
    const uint2 gr = *(const uint2*)(p.gD + (size_t)t * 256 + c4);
    {
      float o[4] = {blo(ca.x) + blo(cb.x), bhi(ca.x) + bhi(cb.x), blo(ca.y) + blo(cb.y), bhi(ca.y) + bhi(cb.y)};
      float ss = reduce16(o[0] * o[0] + o[1] * o[1] + o[2] * o[2] + o[3] * o[3]);
      float ri = rsqrtf(ss * (1.f / 64.f) + 1e-6f);
      float g[4] = {blo(cg.x), bhi(cg.x), blo(cg.y), bhi(cg.y)};
      float y[4];
#pragma unroll
      for (int j = 0; j < 4; j++) y[j] = o[j] * ri * gn[j] * (g[j] * sigm(g[j]));
      *(uint2*)(p.cat + (size_t)t * 1024 + 512 + c4) = make_uint2(pack2(y[0], y[1]), pack2(y[2], y[3]));
    }
    {
      float o[4] = {blo(da.x) + blo(db.x), bhi(da.x) + bhi(db.x), blo(da.y) + blo(db.y), bhi(da.y) + bhi(db.y)};
      float mu = reduce16(o[0] + o[1] + o[2] + o[3]) * (1.f / 64.f);
      float d0 = o[0] - mu, d1 = o[1] - mu, d2 = o[2] - mu, d3 = o[3] - mu;
      float var = reduce16(d0 * d0 + d1 * d1 + d2 * d2 + d3 * d3) * (1.f / 64.f);
      float ri = rsqrtf(var + 64e-5f);
      float vv[4] = {blo(vr.x), bhi(vr.x), blo(vr.y), bhi(vr.y)};
      float g[4] = {blo(gr.x), bhi(gr.x), blo(gr.y), bhi(gr.y)};
      float dd[4] = {d0, d1, d2, d3};
      float y[4];
#pragma unroll
      for (int j = 0; j < 4; j++) y[j] = (dd[j] * ri * lw[j] + lbb[j] + bo * vv[j]) * g[j];
      *(uint2*)(p.cat + (size_t)t * 1024 + 768 + c4) = make_uint2(pack2(y[0], y[1]), pack2(y[2], y[3]));
    }
  }
}

DI void phase_wout(const Params& p, int l, int tok0, char* lds, int bid, int nb, int tid) {
  const int NT = 8, MT = T_SUB / 128;
  for (int it = 0;; it++) {
    int nt, mt;
    if (!xcd_tile(it, bid, nb, MT, NT, mt, nt)) break;
    int m0 = mt * 128, n0 = nt * 128;
    auto rowfn = [&](int r) -> const void* { return p.cat + (size_t)(m0 + r) * 1024; };
    auto epi = [&](f32x4(&acc)[4][4], int rbase, int cbase) {
      EPI_LOOP({
        int tg = tok0 + m0 + row;
        float4 xv = *(const float4*)(xin_row(p, l, tg) + n0 + col);
        float4 o = make_float4(ALPHA_F * xv.x + v[0], ALPHA_F * xv.y + v[1], ALPHA_F * xv.z + v[2], ALPHA_F * xv.w + v[3]);
        *(float4*)(p.out + (size_t)tg * 1024 + n0 + col) = o;
      })
    };
    gemm_tile<false>(rowfn, p.wout_t + ((size_t)l * 1024 + n0) * 1024, 1024, epi, lds, tid);
  }
}

template <bool ROUTER>
DI void phase_ln(const Params& p, const float* g, const float* bta, const float* wrouter, int tok0, int ntok, char* lds,
                 int bid, int nb, int tid) {
  const int lane = tid & 63, wv = tid >> 6;
  float* wl = (float*)lds;
  if (ROUTER) {
    __syncthreads();
    for (int i = tid; i < 16384; i += NTHR) {
      int k = i >> 4, e = i & 15;
      wl[e * 1024 + k] = wrouter[i];
    }
    __syncthreads();
  }
  auto ln_load = [&](float4 (&d)[4], int trow, bool ok) {
#pragma unroll
    for (int i = 0; i < 4; i++) {
      if (!ok) { d[i] = make_float4(0.f, 0.f, 0.f, 0.f); continue; }
      if (ROUTER) {
        d[i] = *(const float4*)(p.out + (size_t)trow * 1024 + i * 256 + lane * 4);
      } else {
        const uint2 r = *(const uint2*)(p.O + (size_t)trow * 1024 + i * 256 + lane * 4);
        d[i] = make_float4(blo(r.x), bhi(r.x), blo(r.y), bhi(r.y));
      }
    }
  };
  float4 x[4], xn[4];
  {
    const int t0 = bid * 4 + wv;
    ln_load(x, tok0 + t0, t0 < ntok);
  }
  for (int t = bid * 4 + wv; t < ntok; t += nb * 4) {
    const int tg = tok0 + t;
    float* xr = p.out + (size_t)tg * 1024;
    {
      const int tn = t + nb * 4;
      ln_load(xn, tok0 + tn, tn < ntok);
    }
    float s = 0.f;
#pragma unroll
    for (int i = 0; i < 4; i++) s += x[i].x + x[i].y + x[i].z + x[i].w;
    float mu = wave_sum(s) * (1.f / 1024.f);
    float vs = 0.f;
#pragma unroll
    for (int i = 0; i < 4; i++) {
      x[i].x -= mu; x[i].y -= mu; x[i].z -= mu; x[i].w -= mu;
      vs += x[i].x * x[i].x + x[i].y * x[i].y + x[i].z * x[i].z + x[i].w * x[i].w;
    }
    float ri = rsqrtf(wave_sum(vs) * (1.f / 1024.f) + 1e-5f);
#pragma unroll
    for (int i = 0; i < 4; i++) {
      float4 gg = *(const float4*)(g + i * 256 + lane * 4);
      float4 bb = *(const float4*)(bta + i * 256 + lane * 4);
      x[i].x = x[i].x * ri * gg.x + bb.x;
      x[i].y = x[i].y * ri * gg.y + bb.y;
      x[i].z = x[i].z * ri * gg.z + bb.z;
      x[i].w = x[i].w * ri * gg.w + bb.w;
      if (!ROUTER) *(float4*)(xr + i * 256 + lane * 4) = x[i];
      *(uint2*)(p.xb + (size_t)tg * 1024 + i * 256 + lane * 4) = make_uint2(pack2(x[i].x, x[i].y), pack2(x[i].z, x[i].w));
    }
    if (ROUTER) {
      float mine = 0.f;
#pragma unroll 2
      for (int e = 0; e < 16; e++) {
        float a = 0.f;
#pragma unroll
        for (int i = 0; i < 4; i++) {
          float4 w = *(const float4*)(wl + e * 1024 + i * 256 + lane * 4);
          a += x[i].x * w.x + x[i].y * w.y + x[i].z * w.z + x[i].w * w.w;
        }
        a = reduce16(a);
        mine = ((lane & 15) == e) ? a : mine;
      }
      mine += __shfl_xor(mine, 16);
      mine += __shfl_xor(mine, 32);
      float mx = mine;
      mx = fmaxf(mx, dpp_f<0xB1>(mx));
      mx = fmaxf(mx, dpp_f<0x4E>(mx));
      mx = fmaxf(mx, dpp_f<0x141>(mx));
      mx = fmaxf(mx, dpp_f<0x140>(mx));
      float ex = __expf(mine - mx);
      float sum = reduce16(ex);
      mine = ex / sum;
      if (lane == 0) p.inv_cnt[tg] = 0;
      if (lane < 16) {
        if (tg < 32768) p.affT[(size_t)lane * 32768 + tg] = mine;
        else p.affT[(size_t)16 * 32768 + (size_t)lane * 65536 + (tg - 32768)] = mine;
      }
    }
#pragma unroll
    for (int i = 0; i < 4; i++) x[i] = xn[i];
  }
}

DI void phase_topk(const Params& p, char* lds, int bid, int nb, int tid) {
  if (bid < 32) {
    unsigned* hist = (unsigned*)lds;
    unsigned* sh = hist + 256;
    unsigned* eqc = sh + 8;
    const int g = bid >> 4, e = bid & 15;
    const int T = g ? 65536 : 32768, cap = T >> 3;
    const int tok0 = g ? 32768 : 0;
    const float* vals = p.affT + (g ? (size_t)16 * 32768 : 0) + (size_t)e * T;
    const float4* v4 = (const float4*)vals;
    const int n4 = T >> 2;
    int* oidx = p.idx + (g ? 65536 : 0) + e * cap;
    float* ogate = p.gate + (g ? 65536 : 0) + e * cap;
    const int slot0 = (g ? 65536 : 0) + e * cap;
    unsigned prefix = 0, mask = 0;
    int remaining = cap;
    for (int pass = 0; pass < 4; pass++) {
      const int shift = 24 - 8 * pass;
      hist[tid] = 0;
      __syncthreads();
      for (int base = 0; base < n4; base += 2048) {
        float4 x[8];
#pragma unroll
        for (int u = 0; u < 8; u++) x[u] = v4[base + u * 256 + tid];
#pragma unroll
        for (int u = 0; u < 8; u++) {
          const unsigned b0 = __float_as_uint(x[u].x), b1 = __float_as_uint(x[u].y), b2 = __float_as_uint(x[u].z), b3 = __float_as_uint(x[u].w);
          if ((b0 & mask) == prefix) atomicAdd(&hist[(b0 >> shift) & 255], 1u);
          if ((b1 & mask) == prefix) atomicAdd(&hist[(b1 >> shift) & 255], 1u);
          if ((b2 & mask) == prefix) atomicAdd(&hist[(b2 >> shift) & 255], 1u);
          if ((b3 & mask) == prefix) atomicAdd(&hist[(b3 >> shift) & 255], 1u);
        }
      }
      __syncthreads();
      if (tid == 0) {
        int cum = 0, sel = 0;
        for (int bq = 255; bq >= 0; bq--) {
          int hc = (int)hist[bq];
          if (cum + hc >= remaining) { sel = bq; break; }
          cum += hc;
        }
        sh[0] = (unsigned)sel;
        sh[1] = (unsigned)(remaining - cum);
        sh[3] = hist[sel];
      }
      __syncthreads();
      prefix |= sh[0] << shift;
      remaining = (int)sh[1];
      mask |= 0xFFu << shift;
      __syncthreads();
    }
    const unsigned thr = prefix;
    const int need = remaining;
    const bool fast = ((int)sh[3] == need);
    if (tid == 0) sh[2] = 0;
    __syncthreads();
    if (fast) {
      for (int base = 0; base < n4; base += 2048) {
        float4 x[8];
#pragma unroll
        for (int u = 0; u < 8; u++) x[u] = v4[base + u * 256 + tid];
#pragma unroll
        for (int u = 0; u < 8; u++) {
          const float xv[4] = {x[u].x, x[u].y, x[u].z, x[u].w};
#pragma unroll
          for (int c = 0; c < 4; c++) {
            if (__float_as_uint(xv[c]) >= thr) {
              const int pos = (int)atomicAdd(&sh[2], 1u);
              const int tok = tok0 + (base + u * 256 + tid) * 4 + c;
              oidx[pos] = tok;
              ogate[pos] = xv[c];
              const int kslot = atomicAdd(&p.inv_cnt[tok], 1);
              p.inv_slot[(size_t)tok * 16 + kslot] = slot0 + pos;
            }
          }
        }
      }
    } else {
      const int ch = T >> 8;
      const float* my = vals + tid * ch;
      int ec = 0;
      for (int i = 0; i < ch; i++) ec += (__float_as_uint(my[i]) == thr) ? 1 : 0;
      eqc[tid] = ec;
      __syncthreads();
      int eq_rank = 0;
      for (int i = 0; i < tid; i++) eq_rank += eqc[i];
      for (int i = 0; i < ch; i++) {
        float v = my[i];
        unsigned u = __float_as_uint(v);
        int pos = -1;
        if (u > thr) {
          pos = (int)atomicAdd(&sh[2], 1u);
        } else if (u == thr) {
          if (eq_rank < need) pos = cap - need + eq_rank;
          eq_rank++;
        }
        if (pos >= 0) {
          const int tok = tok0 + tid * ch + i;
          oidx[pos] = tok;
          ogate[pos] = v;
          const int kslot = atomicAdd(&p.inv_cnt[tok], 1);
          p.inv_slot[(size_t)tok * 16 + kslot] = slot0 + pos;
        }
      }
    }
    __syncthreads();
  }
}

DI void moe_rowinfo(int row0, int l, int& e, int& ioff) {
  if (row0 < 65536) { e = row0 >> 12; }
  else { e = (row0 - 65536) >> 13; }
  ioff = row0;
}

DI void phase_moe1(const Params& p, int l, char* lds, int bid, int nb, int tid) {
  const int NT = 8, MT = 196608 / 128;
  for (int it = 0;; it++) {
    int nt, mt;
    if (!xcd_tile(it, bid, nb, MT, NT, mt, nt)) break;
    int m0 = mt * 128, n0 = nt * 128;
    int e, ioff;
    moe_rowinfo(m0, l, e, ioff);
    const int* ip = p.idx + ioff;
    auto rowfn = [&](int r) -> const void* { return p.xb + (size_t)ip[r] * 1024; };
    u16* H = p.H;
    auto epi = [&](f32x4(&acc)[4][4], int rbase, int cbase) {
#pragma unroll
      for (int m = 0; m < 4; m++)
#pragma unroll
        for (int n = 0; n < 4; n += 2) {
          int row = rbase + m * 16;
          int col = cbase + n * 16;
          int blk = (n0 + (col & ~31)) >> 1;
          int hc = blk + (col & 15);
          f32x4 a = acc[m][n], bq = acc[m][n + 1];
          f32x4 o;
          for (int j = 0; j < 4; j++) o[j] = a[j] * sigm(a[j]) * bq[j];
          st_bf4(H + (size_t)(m0 + row) * 512 + hc, o);
        }
    };
    gemm_tile<false>(rowfn, p.w13_t + ((size_t)(l * 16 + e) * 1024 + n0) * 1024, 1024, epi, lds, tid);
  }
}

DI void phase_moe2(const Params& p, int l, char* lds, int bid, int nb, int tid) {
  TileIter it{bid, nb, 0};
  {
    const int NT = 8, MT = 196608 / 128;
    for (int itx = 0;; itx++) {
      int nt, mt;
      if (!xcd_tile(itx, bid, nb, MT, NT, mt, nt)) break;
      int m0 = mt * 128, n0 = nt * 128;
      int e, ioff;
      moe_rowinfo(m0, l, e, ioff);
      auto rowfn = [&](int r) -> const void* { return p.H + (size_t)(m0 + r) * 512; };
      u16* O = p.O;
      auto epi = [&](f32x4(&acc)[4][4], int rbase, int cbase) {
        epi_store_rows_bf16(acc, rbase, cbase, lds, tid, O + (size_t)m0 * 1024 + n0, 1024, 128);
      };
      gemm_tile<false>(rowfn, p.w2_t + ((size_t)(l * 16 + e) * 1024 + n0) * 512, 512, epi, lds, tid);
    }
  }
  {
    const int NT = 8, MT = T_ALL / 128;
    for (int itx = 0;; itx++) {
      int nt, mt;
      if (!xcd_tile(itx, bid, nb, MT, NT, mt, nt)) break;
      int m0 = mt * 128, n0 = nt * 128;
      auto rowfn = [&](int r) -> const void* {
        int tg = m0 + r;
        return tg < 32768 ? p.p_prompt + ((size_t)l * 32768 + tg) * 256 : p.p_sample + ((size_t)l * 65536 + (tg - 32768)) * 256;
      };
      auto epi = [&](f32x4(&acc)[4][4], int rbase, int cbase) {
        epi_store_rows_bf16(acc, rbase, cbase, lds, tid, (u16*)p.out + (size_t)m0 * 1024 + n0, 1024, 128);
      };
      gemm_tile<true>(rowfn, p.wp_t + ((size_t)l * 1024 + n0) * 256, 256, epi, lds, tid);
    }
  }
}

DI void phase_combine(const Params& p, int bid, int nb, int tid) {
  const int lane = tid & 63, wv = tid >> 6;
  u16* ub = p.H;
  const int stride = nb * 4;
  int t = bid * 4 + wv;
  uint2 xr_[4], xn_[4];
  int cnt = 0, myslot = 0, cntn = 0, myslotn = 0;
#pragma unroll
  for (int i = 0; i < 4; i++) xr_[i] = xn_[i] = make_uint2(0, 0);
  if (t < T_ALL) {
#pragma unroll
    for (int i = 0; i < 4; i++) xr_[i] = *(const uint2*)(p.xb + (size_t)t * 1024 + i * 256 + lane * 4);
    cnt = p.inv_cnt[t];
    myslot = p.inv_slot[(size_t)t * 16 + (lane & 15)];
  }
  for (; t < T_ALL; t += stride) {
    const int tn = t + stride;
    if (tn < T_ALL) {
#pragma unroll
      for (int i = 0; i < 4; i++) xn_[i] = *(const uint2*)(p.xb + (size_t)tn * 1024 + i * 256 + lane * 4);
      cntn = p.inv_cnt[tn];
      myslotn = p.inv_slot[(size_t)tn * 16 + (lane & 15)];
    }
    const float mygate = ((lane & 15) < cnt) ? p.gate[myslot] : 0.f;
    float4 a[4];
#pragma unroll
    for (int i = 0; i < 4; i++)
      a[i] = make_float4(blo(xr_[i].x) * ALPHA_F, bhi(xr_[i].x) * ALPHA_F, blo(xr_[i].y) * ALPHA_F, bhi(xr_[i].y) * ALPHA_F);
    for (int j0 = 0; j0 < cnt; j0 += 4) {
      uint2 r[4][4];
      float g[4];
#pragma unroll
      for (int jj = 0; jj < 4; jj++) {
        const int j = (j0 + jj < cnt) ? (j0 + jj) : j0;
        const int slot = __shfl(myslot, j);
        g[jj] = (j0 + jj < cnt) ? __shfl(mygate, j) : 0.f;
        const u16* orow = p.O + (size_t)slot * 1024 + lane * 4;
#pragma unroll
        for (int i = 0; i < 4; i++) r[jj][i] = *(const uint2*)(orow + i * 256);
      }
#pragma unroll
      for (int jj = 0; jj < 4; jj++)
#pragma unroll
        for (int i = 0; i < 4; i++) {
          a[i].x += g[jj] * blo(r[jj][i].x);
          a[i].y += g[jj] * bhi(r[jj][i].x);
          a[i].z += g[jj] * blo(r[jj][i].y);
          a[i].w += g[jj] * bhi(r[jj][i].y);
        }
    }
#pragma unroll
    for (int i = 0; i < 4; i++)
      *(uint2*)(ub + (size_t)t * 1024 + i * 256 + lane * 4) = make_uint2(pack2(a[i].x, a[i].y), pack2(a[i].z, a[i].w));
#pragma unroll
    for (int i = 0; i < 4; i++) xr_[i] = xn_[i];
    cnt = cntn;
    myslot = myslotn;
  }
}

DI void phase_ple(const Params& p, int l, char* lds, int bid, int nb, int tid) {
  const int NT = 8, MT = T_ALL / 128;
  for (int it = 0;; it++) {
    int nt, mt;
    if (!xcd_tile(it, bid, nb, MT, NT, mt, nt)) break;
    int m0 = mt * 128, n0 = nt * 128;
    auto rowfn = [&](int r) -> const void* { return p.H + (size_t)(m0 + r) * 1024; };
    auto epi = [&](f32x4(&acc)[4][4], int rbase, int cbase) {
      EPI_LOOP({
        size_t o = (size_t)(m0 + row) * 1024 + n0 + col;
        const uint2 ur = *(const uint2*)(p.H + o);
        const uint2 pr = *(const uint2*)((const u16*)p.out + o);
        f32x4 w4;
        w4[0] = blo(ur.x) + sigm(v[0]) * blo(pr.x);
        w4[1] = bhi(ur.x) + sigm(v[1]) * bhi(pr.x);
        w4[2] = blo(ur.y) + sigm(v[2]) * blo(pr.y);
        w4[3] = bhi(ur.y) + sigm(v[3]) * bhi(pr.y);
        st_bf4(p.O + o, w4);
      })
    };
    gemm_tile<false>(rowfn, p.wg_t + ((size_t)l * 1024 + n0) * 1024, 1024, epi, lds, tid);
  }
}

#define XB_TMO      128
#define XB_XCNT(j)  (256  + 64 * (j))
#define XB_XSUB(j)  (1280 + 64 * (j))
#define XB_XGEN(j)  (2304 + 64 * (j))
#define XB_TOP      3328
#define XB_TOPGEN   3392
#define XCD_BAR_WORDS 3456
#define XB_SPIN_CAP (1u << 22)
#define LAS __attribute__((address_space(3)))
DI unsigned xb_ld(unsigned* p) { return __hip_atomic_load(p, __ATOMIC_RELAXED, __HIP_MEMORY_SCOPE_AGENT); }
DI unsigned xb_add(unsigned* p, unsigned v) { return __hip_atomic_fetch_add(p, v, __ATOMIC_RELAXED, __HIP_MEMORY_SCOPE_AGENT); }
DI unsigned xb_xcc_id() { return (unsigned)__builtin_amdgcn_s_getreg((3 << 11) | 20) & 0xFu; }
#define XB_SPIN(cond, bar) do { unsigned _sp = 0; while (cond) { __builtin_amdgcn_s_sleep(1); \
    if ((++_sp & 255u) == 0u) { if (xb_ld(&(bar)[XB_TMO])) break; if (_sp > XB_SPIN_CAP) { atomicAdd(&(bar)[XB_TMO], 1u); break; } } } } while (0)
struct XcdBarrier { unsigned* bar; unsigned x; volatile LAS unsigned* st; };
DI XcdBarrier xcd_barrier_post(unsigned* bar, volatile LAS unsigned* st) {
  XcdBarrier b; b.bar = bar; b.x = xb_xcc_id(); b.st = st;
  if (threadIdx.x == 0) (void)xb_add(&bar[XB_XCNT(b.x)], 1u);
  return b;
}
DI void xcd_barrier_complete(unsigned* bar, unsigned x, unsigned& nloc, unsigned& nx) {
  const unsigned G = gridDim.x * gridDim.y * gridDim.z;
  unsigned sum, cnt, mine, sp = 0u;
  for (;;) {
    sum = 0u; cnt = 0u; mine = 0u;
#pragma unroll
    for (unsigned j = 0; j < 16; ++j) { const unsigned c = xb_ld(&bar[XB_XCNT(j)]); sum += c; cnt += (c > 0u) ? 1u : 0u; mine = (j == x) ? c : mine; }
    if (sum == G) break;
    __builtin_amdgcn_s_sleep(1);
    if ((++sp & 255u) == 0u) { if (xb_ld(&bar[XB_TMO])) break; if (sp > XB_SPIN_CAP) { atomicAdd(&bar[XB_TMO], 1u); break; } }
  }
  nloc = mine > 0u ? mine : 1u; nx = cnt > 0u ? cnt : 1u;
}
DI void xcd_barrier(const XcdBarrier& b) {
  asm volatile("s_waitcnt vmcnt(0)" ::: "memory");
  __syncthreads();
  if (threadIdx.x == 0) {
    unsigned* bar = b.bar;
    __builtin_amdgcn_s_waitcnt(0);
    unsigned nloc = b.st[0], nx = b.st[1];
    if (nloc == 0u) { xcd_barrier_complete(bar, b.x, nloc, nx); b.st[0] = nloc; b.st[1] = nx; }
    const unsigned old = xb_add(&bar[XB_XSUB(b.x)], 1u);
    const unsigned gen = old / nloc;
    if (old + 1u == (gen + 1u) * nloc) {
      __builtin_amdgcn_fence(__ATOMIC_RELEASE, "agent");
      asm volatile("s_waitcnt vmcnt(0)" ::: "memory");
      const unsigned og = xb_add(&bar[XB_TOP], 1u);
      const unsigned tg = og / nx;
      if (og + 1u == (tg + 1u) * nx) xb_add(&bar[XB_TOPGEN], 1u);
      else XB_SPIN(xb_ld(&bar[XB_TOPGEN]) == tg, bar);
      __builtin_amdgcn_fence(__ATOMIC_ACQUIRE, "agent");
      xb_add(&bar[XB_XGEN(b.x)], 1u);
      asm volatile("s_waitcnt vmcnt(0)" ::: "memory");
    } else {
      XB_SPIN(xb_ld(&bar[XB_XGEN(b.x)]) == gen, bar);
      __builtin_amdgcn_fence(__ATOMIC_ACQUIRE, "agent");
      asm volatile("s_waitcnt vmcnt(0)" ::: "memory");
    }
  }
  __syncthreads();
}

__global__ void __launch_bounds__(NTHR, 2) mega(Params p) {
  __shared__ __attribute__((aligned(16))) char lds[73728];
  cg::grid_group grid = cg::this_grid();
  const int tid0 = threadIdx.x, bid0 = blockIdx.x, nb = gridDim.x;
  __shared__ uint4 xb_words;
  if (tid0 == 0) xb_words = make_uint4(0u, 0u, 0u, 0u);
  __syncthreads();
  const XcdBarrier xb = xcd_barrier_post(p.bar, (volatile LAS unsigned*)&xb_words);
  int pc = 0;
#define PHASE(...)                                      \
  {                                                     \
    if (pc >= p.pb && pc < p.pe) {                      \
      if (pc == p.pb + 1) grid.sync();                  \
      else if (pc > p.pb + 1) xcd_barrier(xb);          \
      int tid = tid0, bid = bid0;                       \
      asm volatile("" : "+v"(tid), "+s"(bid));          \
      __VA_ARGS__;                                      \
    }                                                   \
    pc++;                                               \
  }
  PHASE(phase_convert(p, lds, bid, nb, tid));
  for (int i = 0; i < REP_SYNC; i++) PHASE((void)0);
  for (int l = 0; l < 2; l++) {
    for (int sg = 0; sg < 3; sg++) {
      const int tok0 = sg * T_SUB;
      const int B = sg == 0 ? 4 : 8, N = sg == 0 ? 8192 : 4096;
      PHASE(phase_inproj(p, l, tok0, lds, bid, nb, tid));
#if REP_INPROJ || REP_GEMMS
      PHASE(phase_inproj(p, l, tok0, lds, bid, nb, tid));
#endif
      PHASE(phase_prep(p, l, N, bid, nb, tid));
      PHASE(phase_smallgemm(p, l, B, N, lds, bid, nb, tid));
#if REP_GEMMS
      PHASE(phase_smallgemm(p, l, B, N, lds, bid, nb, tid));
#endif
      PHASE(phase_mix(p, l, B, N, p.bar + XCD_BAR_WORDS + (l * 3 + sg) * 128, lds, bid, nb, tid));
#if REP_MIX
      PHASE(phase_mix(p, l, B, N, p.bar + XCD_BAR_WORDS + (6 + l * 3 + sg) * 128, lds, bid, nb, tid));
#endif
      PHASE(phase_final(p, l, bid, nb, tid));
      PHASE(phase_wout(p, l, tok0, lds, bid, nb, tid));
      PHASE(phase_ln<true>(p, p.ln1_g + l * 1024, p.ln1_b + l * 1024, p.moe_router + (size_t)l * 16384, tok0, T_SUB, lds, bid, nb, tid));
    }
    PHASE(phase_topk(p, lds, bid, nb, tid));
    PHASE(phase_moe1(p, l, lds, bid, nb, tid));
#if REP_MOE1 || REP_GEMMS
    PHASE(phase_moe1(p, l, lds, bid, nb, tid));
#endif
    PHASE(phase_moe2(p, l, lds, bid, nb, tid));
#if REP_GEMMS
    PHASE(phase_moe2(p, l, lds, bid, nb, tid));
#endif
    PHASE(phase_combine(p, bid, nb, tid));
    PHASE(phase_ple(p, l, lds, bid, nb, tid));
    PHASE(phase_ln<false>(p, p.ln2_g + l * 1024, p.ln2_b + l * 1024, nullptr, 0, T_ALL, lds, bid, nb, tid));
  }
}

#define N_PHASES 1000
#ifndef FUSED
#define FUSED 1
#endif

extern "C" void kernel_launch(void* const* d_in, const int* in_sizes, int n_in, void* d_out, int out_size, void* d_ws,
                              size_t ws_size, hipStream_t stream) {
  static int grid_blocks = 0;
  if (!grid_blocks) {
    int dev = 0, cus = 0, per_cu = 0;
    (void)hipGetDevice(&dev);
    (void)hipDeviceGetAttribute(&cus, hipDeviceAttributeMultiprocessorCount, dev);
    (void)hipOccupancyMaxActiveBlocksPerMultiprocessor(&per_cu, mega, NTHR, 0);
    if (per_cu > 2) per_cu = 2;
    if (per_cu < 1) per_cu = 1;
    grid_blocks = cus * per_cu;
  }
  Params p;
  memset(&p, 0, sizeof(p));
  const float* const* in = (const float* const*)d_in;
  int k = 0;
  p.x_prompt = in[k++]; p.x_sample = in[k++]; p.p_prompt = in[k++]; p.p_sample = in[k++];
  p.w_in = in[k++]; p.mla_gq = in[k++]; p.mla_gkv = in[k++]; p.mla_wuq = in[k++]; p.mla_wuk = in[k++]; p.mla_wuv = in[k++];
  p.na_bias = in[k++]; p.hg_lb = in[k++]; p.hg_gnorm = in[k++];
  p.rw_mu = in[k++]; p.rw_w0 = in[k++]; p.rw_w_up = in[k++]; p.rw_a0 = in[k++]; p.rw_a_up = in[k++]; p.rw_g_up = in[k++];
  p.rw_kk = in[k++]; p.rw_ka = in[k++]; p.rw_rk = in[k++]; p.rw_ln_w = in[k++]; p.rw_ln_b = in[k++];
  p.w_out = in[k++]; p.ln1_g = in[k++]; p.ln1_b = in[k++]; p.moe_router = in[k++]; p.moe_w1 = in[k++]; p.moe_w3 = in[k++];
  p.moe_w2 = in[k++]; p.ln2_g = in[k++]; p.ln2_b = in[k++]; p.ple_gate = in[k++]; p.ple_proj = in[k++];
  p.out = (float*)d_out;
  char* ws = (char*)d_ws;
  size_t off = 0;
  auto take = [&](size_t bytes) { char* r = ws + off; off += (bytes + 255) & ~(size_t)255; return r; };
  p.w_in_t = (u16*)take((size_t)2 * 3712 * 1024 * 2);
  p.wuq_t = (u16*)take((size_t)2 * 384 * 256 * 2);
  p.wkv_t = (u16*)take((size_t)2 * 512 * 128 * 2);
  p.wup_t = (u16*)take((size_t)4 * 256 * 64 * 2);
  p.aup_t = (u16*)take((size_t)4 * 256 * 64 * 2);
  p.gup_t = (u16*)take((size_t)2 * 256 * 128 * 2);
  p.wout_t = (u16*)take((size_t)2 * 1024 * 1024 * 2);
  p.w13_t = (u16*)take((size_t)32 * 1024 * 1024 * 2);
  p.w2_t = (u16*)take((size_t)32 * 1024 * 512 * 2);
  p.wg_t = (u16*)take((size_t)2 * 1024 * 1024 * 2);
  p.wp_t = (u16*)take((size_t)2 * 1024 * 256 * 2);
  p.ropec = (float*)take((size_t)8192 * 16 * 4);
  p.ropes = (float*)take((size_t)8192 * 16 * 4);
  p.lb = (float*)take(1024 * 4);
  p.affT = (float*)take((size_t)16 * T_ALL * 4);
  p.gate = (float*)take((size_t)196608 * 4);
  p.idx = (int*)take((size_t)196608 * 4);
  p.bar = (unsigned*)take((size_t)(XCD_BAR_WORDS + 12 * 128) * 4);
  p.inv_cnt = (int*)take((size_t)T_ALL * 4);
  p.inv_slot = (int*)take((size_t)T_ALL * 16 * 4);
  p.xb = (u16*)take((size_t)T_ALL * 1024 * 2);
  const size_t stage0 = off;
  p.z = (u16*)take((size_t)T_SUB * ZLD * 2);
  p.cat = (u16*)take((size_t)T_SUB * 1024 * 2);
  p.Q = (u16*)take((size_t)T_SUB * 384 * 2);
  p.Kb = (u16*)take((size_t)T_SUB * 384 * 2);
  p.Vt = (u16*)take((size_t)T_SUB * 256 * 2);
  p.cqn = (u16*)take((size_t)T_SUB * 256 * 2);
  p.ckvn = (u16*)take((size_t)T_SUB * 128 * 2);
  p.S1 = (u16*)take((size_t)T_SUB * 384 * 2);
  p.rs = (u16*)take((size_t)T_SUB * 256 * 2);
  p.ks = (u16*)take((size_t)T_SUB * 256 * 2);
  p.vs = (u16*)take((size_t)T_SUB * 256 * 2);
  p.kk = (u16*)take((size_t)T_SUB * 256 * 2);
  p.gD = (u16*)take((size_t)T_SUB * 256 * 2);
  p.dec = (u16*)take((size_t)2 * T_SUB * 256 * 2);
  p.kka = (u16*)take((size_t)2 * T_SUB * 256 * 2);
  p.kt = (u16*)take((size_t)2 * T_SUB * 256 * 2);
  p.oC = (u16*)take((size_t)2 * T_SUB * 256 * 2);
  p.oD = (u16*)take((size_t)2 * T_SUB * 256 * 2);
  p.bonus = (float*)take((size_t)T_SUB * 4 * 4);
  off = stage0;
  p.O = (u16*)take((size_t)196608 * 1024 * 2);
  p.H = (u16*)take((size_t)196608 * 512 * 2);
  for (int i = 0; i < 16; i++) p.inv_freq[i] = pow(10000.0, -(double)i / 16.0);
  (void)hipMemsetAsync(p.bar, 0, (size_t)(XCD_BAR_WORDS + 12 * 128) * 4, stream);
#if FUSED
  p.pb = 0;
  p.pe = N_PHASES;
  {
    void* args[] = {&p};
    hipError_t e = hipLaunchCooperativeKernel((void*)mega, dim3(grid_blocks), dim3(NTHR), args, 0, stream);
    if (e != hipSuccess) fprintf(stderr, "cooperative launch failed: %s (grid %d)\n", hipGetErrorString(e), grid_blocks);
  }
#else
  for (int ph = 0; ph < N_PHASES; ph++) {
    p.pb = ph;
    p.pe = ph + 1;
    void* args[] = {&p};
    hipError_t e = hipLaunchCooperativeKernel((void*)mega, dim3(grid_blocks), dim3(NTHR), args, 0, stream);
    if (e != hipSuccess) fprintf(stderr, "cooperative launch failed: %s (grid %d)\n", hipGetErrorString(e), grid_blocks);
  }
#endif
}
```

```cpp
#include <hip/hip_runtime.h>
#include <hip/hip_cooperative_groups.h>
#include <cstdio>
#include <cmath>
#include <cstring>
namespace cg = cooperative_groups;

typedef unsigned short u16;
using bf16x8 = __attribute__((ext_vector_type(8))) short;
using f32x4 = __attribute__((ext_vector_type(4))) float;
using f32x16 = __attribute__((ext_vector_type(16))) float;

#define REP_INPROJ 0
#define REP_ATTN 0
#define REP_NA 0
#define REP_SCAN 0
#define REP_MOE1 0
#define REP_MOE2 0
#define REP_SYNC 0
#define REP_MIX 0
#define REP_GEMMS 0
#define DI __device__ __forceinline__
#define NTHR 256
#define T_ALL 98304
#define T_SUB 32768
#define ZLD 3616
#define ZB_OFF 416
#define ZC_OFF 1184
#define ZD_OFF 2464
#define LOG2E 1.4426950408889634f
#define ALPHA_F 1.4142135623730951f

struct Params {
  const float *x_prompt, *x_sample, *p_prompt, *p_sample;
  const float *w_in, *mla_gq, *mla_gkv, *mla_wuq, *mla_wuk, *mla_wuv, *na_bias, *hg_lb, *hg_gnorm;
  const float *rw_mu, *rw_w0, *rw_w_up, *rw_a0, *rw_a_up, *rw_g_up, *rw_kk, *rw_ka, *rw_rk, *rw_ln_w, *rw_ln_b;
  const float *w_out, *ln1_g, *ln1_b, *moe_router, *moe_w1, *moe_w3, *moe_w2, *ln2_g, *ln2_b, *ple_gate, *ple_proj;
  float* out;
  u16 *w_in_t, *wuq_t, *wkv_t, *wup_t, *aup_t, *gup_t, *wout_t, *w13_t, *w2_t, *wg_t, *wp_t;
  float *ropec, *ropes, *lb, *affT, *gate;
  int* idx;
  unsigned* bar;
  int *inv_cnt, *inv_slot;
  u16 *z, *cat, *Q, *Kb, *Vt, *cqn, *ckvn, *S1, *rs, *ks, *vs, *kk, *gD, *dec, *kka, *kt, *oC, *oD;
  float* bonus;
  u16* xb;
  u16* O;
  u16* H;
  double inv_freq[16];
  int pb, pe;
};

typedef __bf16 v2bf_t __attribute__((ext_vector_type(2)));
typedef float v2f_t __attribute__((ext_vector_type(2)));
typedef unsigned u32x4_t __attribute__((ext_vector_type(4)));
DI unsigned pack2(float a, float b) {
  v2f_t f = {a, b};
  v2bf_t h = __builtin_convertvector(f, v2bf_t);
  return __builtin_bit_cast(unsigned, h);
}
DI u16 f2bf(float f) { return (u16)(pack2(f, 0.f) & 0xffffu); }
DI float bf2f(u16 h) { return __uint_as_float(((unsigned)h) << 16); }
DI float blo(unsigned u) { return __uint_as_float(u << 16); }
DI float bhi(unsigned u) { return __uint_as_float(u & 0xffff0000u); }
DI float sigm(float x) { return 1.f / (1.f + __expf(-x)); }
DI float tanh_(float x) { return 1.f - 2.f / (__expf(2.f * x) + 1.f); }
DI float ex2(float x) { return __builtin_amdgcn_exp2f(x); }
DI int clampi(int v, int lo, int hi) { return v < lo ? lo : (v > hi ? hi : v); }
DI int swap23(int x) { return (x & ~12) | ((x & 4) << 1) | ((x & 8) >> 1); }

template <int CTRL> DI float dpp_f(float v) {
  return __int_as_float(__builtin_amdgcn_update_dpp(0, __float_as_int(v), CTRL, 0xF, 0xF, true));
}
DI float reduce16(float v) {
  v += dpp_f<0xB1>(v);
  v += dpp_f<0x4E>(v);
  v += dpp_f<0x141>(v);
  v += dpp_f<0x140>(v);
  return v;
}
DI float wave_sum(float v) {
  v = reduce16(v);
  v += __shfl_xor(v, 16);
  v += __shfl_xor(v, 32);
  return v;
}

struct TileIter {
  int bid, nb, off;
  DI int first(int n) { int f = bid - off; if (f < 0) f += nb; off = (off + n) % nb; return f; }
};

DI bool xcd_tile(int it, int bid, int nb, int MT, int NT, int& mt, int& nt) {
  const int x = bid & 7, slot = bid >> 3, nslots = nb >> 3;
  const int mper = MT >> 3;
  const int i = slot + it * nslots;
  if (i >= mper * NT) return false;
  const int mi = i & 7, rest = i >> 3;
  nt = rest % NT;
  mt = x * mper + (rest / NT) * 8 + mi;
  return true;
}

DI void convT_job(const float* __restrict__ W, int K, int N, int Npad, u16* __restrict__ Wt, int mode, char* lds,
                  TileIter& it, int tid) {
  float(*tile)[65] = (float(*)[65])lds;
  int tk = K >> 6, tn = Npad >> 6;
  int nt = tk * tn;
  for (int t = it.first(nt); t < nt; t += it.nb) {
    int k0 = (t % tk) << 6, n0 = (t / tk) << 6;
#pragma unroll
    for (int i = 0; i < 16; i++) {
      int kl = (tid >> 6) + 4 * i, nl = tid & 63;
      int n = n0 + nl;
      tile[kl][nl] = (n < N) ? W[(size_t)(k0 + kl) * N + n] : 0.f;
    }
    __syncthreads();
    {
      int nl = tid >> 2, ks = (tid & 3) * 16;
      int n = n0 + nl;
      int row = n;
      if (mode == 1) row = (n >> 4) * 32 + (n & 15);
      if (mode == 2) row = (n >> 4) * 32 + 16 + (n & 15);
      unsigned pk[8];
#pragma unroll
      for (int j = 0; j < 8; j++) pk[j] = pack2(tile[ks + 2 * j][nl], tile[ks + 2 * j + 1][nl]);
      uint4* dst = (uint4*)(Wt + (size_t)row * K + k0 + ks);
      dst[0] = make_uint4(pk[0], pk[1], pk[2], pk[3]);
      dst[1] = make_uint4(pk[4], pk[5], pk[6], pk[7]);
    }
    __syncthreads();
  }
}

DI void phase_convert(const Params& p, char* lds, int bid, int nb, int tid) {
  TileIter it{bid, nb, 0};
  for (int l = 0; l < 2; l++) {
    convT_job(p.w_in + (size_t)l * 1024 * 3616, 1024, 3616, 3712, p.w_in_t + (size_t)l * 3712 * 1024, 0, lds, it, tid);
    convT_job(p.mla_wuq + (size_t)l * 256 * 384, 256, 384, 384, p.wuq_t + (size_t)l * 384 * 256, 0, lds, it, tid);
    convT_job(p.mla_wuk + (size_t)l * 128 * 256, 128, 256, 256, p.wkv_t + (size_t)l * 512 * 128, 0, lds, it, tid);
    convT_job(p.mla_wuv + (size_t)l * 128 * 256, 128, 256, 256, p.wkv_t + (size_t)l * 512 * 128 + 256 * 128, 0, lds, it, tid);
    for (int d = 0; d < 2; d++) {
      convT_job(p.rw_w_up + (size_t)(l * 2 + d) * 64 * 256, 64, 256, 256, p.wup_t + (size_t)(l * 2 + d) * 256 * 64, 0, lds, it, tid);
      convT_job(p.rw_a_up + (size_t)(l * 2 + d) * 64 * 256, 64, 256, 256, p.aup_t + (size_t)(l * 2 + d) * 256 * 64, 0, lds, it, tid);
    }
    convT_job(p.rw_g_up + (size_t)l * 128 * 256, 128, 256, 256, p.gup_t + (size_t)l * 256 * 128, 0, lds, it, tid);
    convT_job(p.w_out + (size_t)l * 1024 * 1024, 1024, 1024, 1024, p.wout_t + (size_t)l * 1024 * 1024, 0, lds, it, tid);
    for (int e = 0; e < 16; e++) {
      size_t le = (size_t)(l * 16 + e);
      convT_job(p.moe_w1 + le * 1024 * 512, 1024, 512, 512, p.w13_t + le * 1024 * 1024, 1, lds, it, tid);
      convT_job(p.moe_w3 + le * 1024 * 512, 1024, 512, 512, p.w13_t + le * 1024 * 1024, 2, lds, it, tid);
      convT_job(p.moe_w2 + le * 512 * 1024, 512, 1024, 1024, p.w2_t + le * 1024 * 512, 0, lds, it, tid);
    }
    convT_job(p.ple_gate + (size_t)l * 1024 * 1024, 1024, 1024, 1024, p.wg_t + (size_t)l * 1024 * 1024, 0, lds, it, tid);
    convT_job(p.ple_proj + (size_t)l * 256 * 1024, 256, 1024, 1024, p.wp_t + (size_t)l * 1024 * 256, 0, lds, it, tid);
  }
  int gt = bid * NTHR + tid, ng = nb * NTHR;
  for (size_t i0 = gt; i0 < (size_t)T_ALL * 256; i0 += (size_t)ng * 8) {
    float4 v[8];
#pragma unroll
    for (int u = 0; u < 8; u++) {
      const size_t i = i0 + (size_t)u * ng;
      v[u] = make_float4(0.f, 0.f, 0.f, 0.f);
      if (i < (size_t)T_ALL * 256)
        v[u] = (i < (size_t)32768 * 256) ? ((const float4*)p.x_prompt)[i] : ((const float4*)p.x_sample)[i - (size_t)32768 * 256];
    }
#pragma unroll
    for (int u = 0; u < 8; u++) {
      const size_t i = i0 + (size_t)u * ng;
      if (i < (size_t)T_ALL * 256) ((uint2*)p.xb)[i] = make_uint2(pack2(v[u].x, v[u].y), pack2(v[u].z, v[u].w));
    }
  }
  for (int i = gt; i < 8192 * 16; i += ng) {
    int n = i >> 4, f = i & 15;
    double ifq = 0.0;
#pragma unroll
    for (int j = 0; j < 16; j++) ifq = (f == j) ? p.inv_freq[j] : ifq;
    double rev = (double)n * ifq * 0.15915494309189535;
    double fr = rev - rint(rev);
    float ff = (float)fr;
    p.ropec[i] = __builtin_amdgcn_cosf(ff);
    p.ropes[i] = __builtin_amdgcn_sinf(ff);
  }
  for (int i = gt; i < 512; i += ng) {
    float h0 = p.hg_lb[i], h1 = p.hg_lb[512 + i];
    p.lb[i] = 0.f;
    p.lb[512 + i] = 1.f / (1.f + __expf(h0 - h1));
  }
}

constexpr int G_STAGE = 32768;

template <bool AF32, class RowFn, class Epi>
DI void gemm_tile(RowFn rowfn, const u16* __restrict__ Bt, int K, Epi epi, char* lds, int tid) {
  const int lane = tid & 63, wid = tid >> 6, wr = wid >> 1, wc = wid & 1, fr = lane & 15, fq = lane >> 4;
  f32x4 acc[4][4];
#pragma unroll
  for (int m = 0; m < 4; m++)
#pragma unroll
    for (int n = 0; n < 4; n++) acc[m][n] = f32x4{0.f, 0.f, 0.f, 0.f};

  const int lrow = tid >> 3;
  const int lc = (tid & 7) ^ ((tid >> 4) & 7);
  const float* apf[8];
  const u16* aph[4];
  const u16* bp[4];
  if constexpr (AF32) {
#pragma unroll
    for (int i = 0; i < 8; i++) apf[i] = (const float*)rowfn(i * 16 + (tid >> 4)) + (tid & 15) * 4;
  } else {
#pragma unroll
    for (int i = 0; i < 4; i++) aph[i] = (const u16*)rowfn(lrow + i * 32) + lc * 8;
  }
#pragma unroll
  for (int i = 0; i < 4; i++) bp[i] = Bt + (size_t)(lrow + i * 32) * K + lc * 8;
  const int afoff = (tid >> 4) * 128 + ((((tid & 15) >> 1) ^ ((tid >> 5) & 7)) * 16) + (tid & 1) * 8;

  float4 raf[8];
  auto issue = [&](int buf, int k0) {
    char* A = lds + buf * G_STAGE;
    char* B = A + 16384;
#pragma unroll
    for (int i = 0; i < 4; i++)
      __builtin_amdgcn_global_load_lds((const unsigned*)(bp[i] + k0), (unsigned*)(B + wid * 1024 + i * 4096), 16, 0, 0);
    if constexpr (AF32) {
#pragma unroll
      for (int i = 0; i < 8; i++) raf[i] = *(const float4*)(apf[i] + k0);
    } else {
#pragma unroll
      for (int i = 0; i < 4; i++)
        __builtin_amdgcn_global_load_lds((const unsigned*)(aph[i] + k0), (unsigned*)(A + wid * 1024 + i * 4096), 16, 0, 0);
    }
  };
  auto astore = [&](int buf) {
    if constexpr (AF32) {
      char* A = lds + buf * G_STAGE;
#pragma unroll
      for (int i = 0; i < 8; i++) asm volatile("" : "+v"(raf[i].x), "+v"(raf[i].y), "+v"(raf[i].z), "+v"(raf[i].w));
#pragma unroll
      for (int i = 0; i < 8; i++)
        *(uint2*)(A + afoff + i * 2048) = make_uint2(pack2(raf[i].x, raf[i].y), pack2(raf[i].z, raf[i].w));
    }
  };
  const int abase = (wr * 64 + fr) * 128, bbase = 16384 + (wc * 64 + fr) * 128;
  const int sw0 = ((fq) ^ (fr >> 1)) * 16, sw1 = ((4 + fq) ^ (fr >> 1)) * 16;

  const int nk = K >> 6;
  if constexpr (AF32) {
    issue(0, 0);
    astore(0);
    __syncthreads();
    for (int kt = 0; kt < nk; kt++) {
      const char* S = lds + (kt & 1) * G_STAGE;
      bf16x8 af[2][4], bfr[2][4];
#pragma unroll
      for (int kk = 0; kk < 2; kk++) {
        const int sw = kk ? sw1 : sw0;
#pragma unroll
        for (int m = 0; m < 4; m++) af[kk][m] = *(const bf16x8*)(S + abase + m * 2048 + sw);
#pragma unroll
        for (int n = 0; n < 4; n++) bfr[kk][n] = *(const bf16x8*)(S + bbase + n * 2048 + sw);
      }
      __builtin_amdgcn_sched_barrier(0);
      if (kt + 1 < nk) issue((kt + 1) & 1, (kt + 1) << 6);
      __builtin_amdgcn_sched_barrier(0);
#pragma unroll
      for (int kk = 0; kk < 2; kk++)
#pragma unroll
        for (int m = 0; m < 4; m++)
#pragma unroll
          for (int n = 0; n < 4; n++) acc[m][n] = __builtin_amdgcn_mfma_f32_16x16x32_bf16(bfr[kk][n], af[kk][m], acc[m][n], 0, 0, 0);
      __builtin_amdgcn_sched_barrier(0);
      if (kt + 1 < nk) astore((kt + 1) & 1);
      __syncthreads();
    }
  } else {
    const unsigned lds0 = (unsigned)(size_t)(__attribute__((address_space(3))) char*)lds;
    const unsigned aA0 = lds0 + abase + sw0, aA1 = lds0 + abase + sw1, aB0 = lds0 + bbase + sw0, aB1 = lds0 + bbase + sw1;
#define G_DSR(dst, addr, off) asm volatile("ds_read_b128 %0, %1 offset:%2" : "=v"(dst) : "v"(addr), "n"(off))
    issue(0, 0);
    if (nk > 1) issue(1, 64);
    for (int kt = 0; kt < nk; kt++) {
      if (kt + 1 < nk) asm volatile("s_waitcnt vmcnt(8)" ::: "memory");
      else asm volatile("s_waitcnt vmcnt(0)" ::: "memory");
      __builtin_amdgcn_s_barrier();
      const unsigned so = (kt & 1) * G_STAGE;
      const unsigned pA0 = aA0 + so, pA1 = aA1 + so, pB0 = aB0 + so, pB1 = aB1 + so;
      bf16x8 a00, a01, a02, a03, a10, a11, a12, a13, b00, b01, b02, b03, b10, b11, b12, b13;
      G_DSR(a00, pA0, 0); G_DSR(a01, pA0, 2048); G_DSR(a02, pA0, 4096); G_DSR(a03, pA0, 6144);
      G_DSR(b00, pB0, 0); G_DSR(b01, pB0, 2048); G_DSR(b02, pB0, 4096); G_DSR(b03, pB0, 6144);
      G_DSR(a10, pA1, 0); G_DSR(a11, pA1, 2048); G_DSR(a12, pA1, 4096); G_DSR(a13, pA1, 6144);
      G_DSR(b10, pB1, 0); G_DSR(b11, pB1, 2048); G_DSR(b12, pB1, 4096); G_DSR(b13, pB1, 6144);
      asm volatile("s_waitcnt lgkmcnt(0)" : "+v"(a00), "+v"(a01), "+v"(a02), "+v"(a03), "+v"(b00), "+v"(b01), "+v"(b02), "+v"(b03));
      asm volatile("" : "+v"(a10), "+v"(a11), "+v"(a12), "+v"(a13), "+v"(b10), "+v"(b11), "+v"(b12), "+v"(b13));
      __builtin_amdgcn_s_barrier();
      if (kt + 2 < nk) issue(kt & 1, (kt + 2) << 6);
      __builtin_amdgcn_sched_barrier(0);
      {
        const bf16x8 af0[4] = {a00, a01, a02, a03}, af1[4] = {a10, a11, a12, a13};
        const bf16x8 bf0[4] = {b00, b01, b02, b03}, bf1[4] = {b10, b11, b12, b13};
#pragma unroll
        for (int m = 0; m < 4; m++)
#pragma unroll
          for (int n = 0; n < 4; n++) acc[m][n] = __builtin_amdgcn_mfma_f32_16x16x32_bf16(bf0[n], af0[m], acc[m][n], 0, 0, 0);
#pragma unroll
        for (int m = 0; m < 4; m++)
#pragma unroll
          for (int n = 0; n < 4; n++) acc[m][n] = __builtin_amdgcn_mfma_f32_16x16x32_bf16(bf1[n], af1[m], acc[m][n], 0, 0, 0);
      }
      __builtin_amdgcn_sched_barrier(0);
    }
  }
  epi(acc, wr * 64 + fr, wc * 64 + fq * 4);
}

#define EPI_LOOP(...)                                    \
  _Pragma("unroll") for (int m = 0; m < 4; m++)          \
  _Pragma("unroll") for (int n = 0; n < 4; n++) {        \
    const int row = rbase + m * 16;                      \
    const int col = cbase + n * 16;                      \
    const f32x4 v = acc[m][n];                           \
    __VA_ARGS__                                          \
  }

DI void st_bf4(u16* dst, f32x4 v) { *(uint2*)dst = make_uint2(pack2(v[0], v[1]), pack2(v[2], v[3])); }

DI void epi_store_rows_bf16(f32x4 (&acc)[4][4], int rbase, int cbase, char* lds, int tid, u16* dst, size_t ld, int ncols) {
#pragma unroll
  for (int m = 0; m < 4; m++)
#pragma unroll
    for (int n = 0; n < 4; n++)
      *(uint2*)(lds + (rbase + m * 16) * 272 + (cbase + n * 16) * 2) =
          make_uint2(pack2(acc[m][n][0], acc[m][n][1]), pack2(acc[m][n][2], acc[m][n][3]));
  __syncthreads();
#pragma unroll
  for (int i = 0; i < 8; i++) {
    const int id = tid + 256 * i, row = id >> 4, c = id & 15;
    if (c * 8 < ncols) *(uint4*)(dst + (size_t)row * ld + c * 8) = *(const uint4*)(lds + row * 272 + c * 16);
  }
  __syncthreads();
}

DI const float* xin_row(const Params& p, int l, int tg) {
  if (l == 0) return tg < 32768 ? p.x_prompt + (size_t)tg * 1024 : p.x_sample + (size_t)(tg - 32768) * 1024;
  return p.out + (size_t)tg * 1024;
}

DI void phase_inproj(const Params& p, int l, int tok0, char* lds, int bid, int nb, int tid) {
  const int NT = 29, MT = T_SUB / 128;
  for (int it = 0;; it++) {
    int nt, mt;
    if (!xcd_tile(it, bid, nb, MT, NT, mt, nt)) break;
    int m0 = mt * 128, n0 = nt * 128;
    auto rowfn = [&](int r) -> const void* { return p.xb + (size_t)(tok0 + m0 + r) * 1024; };
    u16* z = p.z;
    auto epi = [&](f32x4(&acc)[4][4], int rbase, int cbase) {
      epi_store_rows_bf16(acc, rbase, cbase, lds, tid, z + (size_t)m0 * ZLD + n0, ZLD, min(128, ZLD - n0));
    };
    gemm_tile<false>(rowfn, p.w_in_t + ((size_t)l * 3712 + n0) * 1024, 1024, epi, lds, tid);
  }
}

struct PrepIn {
  uint2 cq;
  unsigned ckv;
  u16 kr1, kr2;
  float rc, rsn;
  uint4 f;
  uint2 cur[3], prv[3], nxt[3];
  u16 sc[6], sp[6], sn[6];
};
DI void prep_load(PrepIn& in, const Params& p, int t, int N, int lane) {
  const int l15 = lane & 15, c4 = lane * 4;
  const u16* zr = p.z + (size_t)t * ZLD;
  const int n = t & (N - 1);
  const bool hp = n > 0, hn = n < N - 1;
  const u16* zd = zr + ZD_OFF;
  const u16* zdp = zd - (hp ? ZLD : 0);
  const u16* zdn = zd + (hn ? ZLD : 0);
  in.cq = *(const uint2*)(zr + c4);
  in.ckv = *(const unsigned*)(zr + 256 + lane * 2);
  in.kr1 = zr[384 + l15];
  in.kr2 = zr[400 + l15];
  in.rc = p.ropec[n * 16 + l15];
  in.rsn = p.ropes[n * 16 + l15];
  in.f = *(const uint4*)(zr + ZC_OFF + 256 + lane * 8);
#pragma unroll
  for (int part = 0; part < 3; part++) {
    in.cur[part] = *(const uint2*)(zd + part * 256 + c4);
    in.prv[part] = *(const uint2*)(zdp + part * 256 + c4);
    in.nxt[part] = *(const uint2*)(zdn + part * 256 + c4);
  }
#pragma unroll
  for (int i = 0; i < 6; i++) {
    in.sc[i] = zd[768 + lane + 64 * i];
    in.sp[i] = zdp[768 + lane + 64 * i];
    in.sn[i] = zdn[768 + lane + 64 * i];
  }
}

DI void phase_prep(const Params& p, int l, int N, int bid, int nb, int tid) {
  const int lane = tid & 63, wv = tid >> 6, l15 = lane & 15, c4 = lane * 4;
  float gqv[4], gkvv[2], lbv[8], m0[12], m1[12], m0s[6], m1s[6], kkc[4], rkc[4];
  {
    const float* mu0 = p.rw_mu + (size_t)l * 2 * 1152;
    const float* mu1 = mu0 + 1152;
#pragma unroll
    for (int j = 0; j < 4; j++) {
      gqv[j] = p.mla_gq[l * 256 + c4 + j];
      kkc[j] = p.rw_kk[l * 256 + c4 + j];
      rkc[j] = p.rw_rk[l * 256 + c4 + j];
    }
    gkvv[0] = p.mla_gkv[l * 128 + lane * 2];
    gkvv[1] = p.mla_gkv[l * 128 + lane * 2 + 1];
#pragma unroll
    for (int j = 0; j < 8; j++) lbv[j] = p.lb[l * 512 + lane * 8 + j];
#pragma unroll
    for (int part = 0; part < 3; part++)
#pragma unroll
      for (int j = 0; j < 4; j++) {
        m0[part * 4 + j] = mu0[part * 256 + c4 + j];
        m1[part * 4 + j] = mu1[part * 256 + c4 + j];
      }
#pragma unroll
    for (int i = 0; i < 6; i++) {
      m0s[i] = mu0[768 + lane + 64 * i];
      m1s[i] = mu1[768 + lane + 64 * i];
    }
  }
  PrepIn in, inn;
  {
    const int t0 = bid * 4 + wv;
    if (t0 < T_SUB) prep_load(in, p, t0, N, lane);
  }
  for (int t = bid * 4 + wv; t < T_SUB; t += nb * 4) {
    u16* zr = p.z + (size_t)t * ZLD;
    const int n = t & (N - 1);
    const bool hp = n > 0, hn = n < N - 1;
    {
      const int tn = t + nb * 4;
      if (tn < T_SUB) prep_load(inn, p, tn, N, lane);
      else inn = in;
    }
    const uint2 raw_cq = in.cq;
    const unsigned raw_ckv = in.ckv;
    const u16 kr1 = in.kr1, kr2 = in.kr2;
    const float rc = in.rc, rsn = in.rsn;
    uint4* fptr = (uint4*)(zr + ZC_OFF + 256 + lane * 8);
    const uint4 raw_f = in.f;
    uint2 cur[3], prv[3], nxt[3];
    u16 sc[6], sp[6], sn[6];
#pragma unroll
    for (int part = 0; part < 3; part++) { cur[part] = in.cur[part]; prv[part] = in.prv[part]; nxt[part] = in.nxt[part]; }
#pragma unroll
    for (int i = 0; i < 6; i++) { sc[i] = in.sc[i]; sp[i] = in.sp[i]; sn[i] = in.sn[i]; }
    {
      float v0 = blo(raw_cq.x), v1 = bhi(raw_cq.x), v2 = blo(raw_cq.y), v3 = bhi(raw_cq.y);
      float ss = wave_sum(v0 * v0 + v1 * v1 + v2 * v2 + v3 * v3);
      float ri = rsqrtf(ss * (1.f / 256.f) + 1e-6f);
      *(uint2*)(p.cqn + (size_t)t * 256 + c4) =
          make_uint2(pack2(v0 * ri * gqv[0], v1 * ri * gqv[1]), pack2(v2 * ri * gqv[2], v3 * ri * gqv[3]));
    }
    {
      float v0 = blo(raw_ckv), v1 = bhi(raw_ckv);
      float ss = wave_sum(v0 * v0 + v1 * v1);
      float ri = rsqrtf(ss * (1.f / 128.f) + 1e-6f);
      *(unsigned*)(p.ckvn + (size_t)t * 128 + lane * 2) = pack2(v0 * ri * gkvv[0], v1 * ri * gkvv[1]);
    }
    if (lane < 16) {
      float x1 = bf2f(kr1), x2 = bf2f(kr2);
      u16 k1 = f2bf(x1 * rc - x2 * rsn), k2 = f2bf(x1 * rsn + x2 * rc);
      u16* kb = p.Kb + (size_t)t * 384;
#pragma unroll
      for (int h = 0; h < 4; h++) {
        kb[h * 96 + 64 + lane] = k1;
        kb[h * 96 + 80 + lane] = k2;
      }
    }
    {
      unsigned w[4] = {raw_f.x, raw_f.y, raw_f.z, raw_f.w};
#pragma unroll
      for (int j = 0; j < 4; j++) {
        float a = blo(w[j]), bq = bhi(w[j]);
        float la = lbv[2 * j], lb2 = lbv[2 * j + 1];
        a = la + (1.f - la) * sigm(a);
        bq = lb2 + (1.f - lb2) * sigm(bq);
        w[j] = pack2(a, bq);
      }
      *fptr = make_uint4(w[0], w[1], w[2], w[3]);
    }
    {
      float rr[4], kx[4], vx[4];
#pragma unroll
      for (int part = 0; part < 3; part++) {
        float cz[4] = {blo(cur[part].x), bhi(cur[part].x), blo(cur[part].y), bhi(cur[part].y)};
        float pz[4] = {blo(prv[part].x), bhi(prv[part].x), blo(prv[part].y), bhi(prv[part].y)};
        float nz[4] = {blo(nxt[part].x), bhi(nxt[part].x), blo(nxt[part].y), bhi(nxt[part].y)};
#pragma unroll
        for (int j = 0; j < 4; j++) {
          float pzz = hp ? pz[j] : 0.f, nzz = hn ? nz[j] : 0.f;
          float o = cz[j] + m0[part * 4 + j] * (pzz - cz[j]) + m1[part * 4 + j] * (nzz - cz[j]);
          if (part == 0) rr[j] = o;
          if (part == 1) kx[j] = o;
          if (part == 2) vx[j] = o;
        }
      }
      *(uint2*)(p.rs + (size_t)t * 256 + c4) = make_uint2(pack2(rr[0], rr[1]), pack2(rr[2], rr[3]));
      *(uint2*)(p.ks + (size_t)t * 256 + c4) = make_uint2(pack2(kx[0], kx[1]), pack2(kx[2], kx[3]));
      *(uint2*)(p.vs + (size_t)t * 256 + c4) = make_uint2(pack2(vx[0], vx[1]), pack2(vx[2], vx[3]));
      float kq[4], ss = 0.f, bo = 0.f;
#pragma unroll
      for (int j = 0; j < 4; j++) {
        kq[j] = kx[j] * kkc[j];
        ss += kq[j] * kq[j];
        bo += rr[j] * kx[j] * rkc[j];
      }
      ss = reduce16(ss);
      bo = reduce16(bo);
      float inv = 1.f / fmaxf(sqrtf(ss), 1e-12f);
      *(uint2*)(p.kk + (size_t)t * 256 + c4) = make_uint2(pack2(kq[0] * inv, kq[1] * inv), pack2(kq[2] * inv, kq[3] * inv));
      if (l15 == 0) p.bonus[(size_t)t * 4 + (lane >> 4)] = bo;
#pragma unroll
      for (int i = 0; i < 6; i++) {
        float cz = bf2f(sc[i]);
        float pz = hp ? bf2f(sp[i]) : 0.f;
        float nz = hn ? bf2f(sn[i]) : 0.f;
        float o = cz + m0s[i] * (pz - cz) + m1s[i] * (nz - cz);
        if (i < 2) o = tanh_(o);
        else if (i >= 4) o = sigm(o);
        p.S1[(size_t)t * 384 + lane + 64 * i] = f2bf(o);
      }
    }
    in = inn;
  }
}

DI void phase_smallgemm(const Params& p, int l, int B, int N, char* lds, int bid, int nb, int tid) {
  TileIter it{bid, nb, 0};
  const int MT = T_SUB / 128;
  {
    const int NT = 3;
    for (int itx = 0;; itx++) {
      int nt, mt;
      if (!xcd_tile(itx, bid, nb, MT, NT, mt, nt)) break;
      int m0 = mt * 128, n0 = nt * 128;
      auto rowfn = [&](int r) -> const void* { return p.cqn + (size_t)(m0 + r) * 256; };
      u16* Q = p.Q;
      auto epi = [&](f32x4(&acc)[4][4], int rbase, int cbase) {
        const float SC = 0.10206207261596577f * LOG2E;
#pragma unroll
        for (int m = 0; m < 4; m++)
#pragma unroll
          for (int n = 0; n < 4; n++) acc[m][n] = acc[m][n] * SC;
        epi_store_rows_bf16(acc, rbase, cbase, lds, tid, Q + (size_t)m0 * 384 + n0, 384, 128);
      };
      gemm_tile<false>(rowfn, p.wuq_t + ((size_t)l * 384 + n0) * 256, 256, epi, lds, tid);
    }
  }
  {
    const int NT = 4;
    for (int itx = 0;; itx++) {
      int nt, mt;
      if (!xcd_tile(itx, bid, nb, MT, NT, mt, nt)) break;
      int m0 = mt * 128, n0 = nt * 128;
      auto rowfn = [&](int r) -> const void* { return p.ckvn + (size_t)(m0 + r) * 128; };
      u16* Kb = p.Kb;
      u16* Vt = p.Vt;
      auto epi = [&](f32x4(&acc)[4][4], int rbase, int cbase) {
        EPI_LOOP({
          int c = n0 + col;
          int tk = m0 + row;
          if (c < 256) {
            int h = c >> 6, d = c & 63;
            st_bf4(Kb + (size_t)tk * 384 + h * 96 + d, v);
          } else {
            int cc = c - 256;
            int b = tk / N, nn = tk - b * N;
            u16* dst = Vt + ((size_t)(b * 256 + cc)) * N + nn;
            dst[0] = f2bf(v[0]);
            dst[(size_t)N] = f2bf(v[1]);
            dst[(size_t)2 * N] = f2bf(v[2]);
            dst[(size_t)3 * N] = f2bf(v[3]);
          }
        })
      };
      gemm_tile<false>(rowfn, p.wkv_t + ((size_t)l * 512 + n0) * 128, 128, epi, lds, tid);
    }
  }
  for (int d = 0; d < 2; d++) {
    const int NT = 2;
    for (int itx = 0;; itx++) {
      int nt, mt;
      if (!xcd_tile(itx, bid, nb, MT, NT, mt, nt)) break;
      int m0 = mt * 128, n0 = nt * 128;
      auto rowfn = [&](int r) -> const void* { return p.S1 + (size_t)(m0 + r) * 384 + d * 64; };
      u16* dst = p.dec + (size_t)d * T_SUB * 256;
      const float* w0 = p.rw_w0 + (l * 2 + d) * 256;
      auto epi = [&](f32x4(&acc)[4][4], int rbase, int cbase) {
#pragma unroll
        for (int m = 0; m < 4; m++)
#pragma unroll
          for (int n = 0; n < 4; n++) {
            const int col = cbase + n * 16;
            for (int j = 0; j < 4; j++) acc[m][n][j] = __expf(-0.6065306597126334f * sigm(w0[n0 + col + j] + acc[m][n][j]));
          }
        epi_store_rows_bf16(acc, rbase, cbase, lds, tid, dst + (size_t)m0 * 256 + n0, 256, 128);
      };
      gemm_tile<false>(rowfn, p.wup_t + ((size_t)(l * 2 + d) * 256 + n0) * 64, 64, epi, lds, tid);
    }
  }
  for (int d = 0; d < 2; d++) {
    const int NT = 2;
    for (int itx = 0;; itx++) {
      int nt, mt;
      if (!xcd_tile(itx, bid, nb, MT, NT, mt, nt)) break;
      int m0 = mt * 128, n0 = nt * 128;
      auto rowfn = [&](int r) -> const void* { return p.S1 + (size_t)(m0 + r) * 384 + 128 + d * 64; };
      u16* dka = p.kka + (size_t)d * T_SUB * 256;
      u16* dkt = p.kt + (size_t)d * T_SUB * 256;
      const float* a0 = p.rw_a0 + (l * 2 + d) * 256;
      const float* ka = p.rw_ka + l * 256;
      const u16* kkp = p.kk;
      const u16* ksp = p.ks;
      auto epi = [&](f32x4(&acc)[4][4], int rbase, int cbase) {
        EPI_LOOP({
          size_t o = (size_t)(m0 + row) * 256 + n0 + col;
          uint2 kkr = *(const uint2*)(kkp + o);
          uint2 ksr = *(const uint2*)(ksp + o);
          float kkv[4] = {blo(kkr.x), bhi(kkr.x), blo(kkr.y), bhi(kkr.y)};
          float ksv[4] = {blo(ksr.x), bhi(ksr.x), blo(ksr.y), bhi(ksr.y)};
          f32x4 o1, o2;
          for (int j = 0; j < 4; j++) {
            float a = sigm(a0[n0 + col + j] + v[j]);
            o1[j] = kkv[j] * a;
            o2[j] = ksv[j] * (1.f + (a - 1.f) * ka[n0 + col + j]);
          }
          st_bf4(dka + o, o1);
          st_bf4(dkt + o, o2);
        })
      };
      gemm_tile<false>(rowfn, p.aup_t + ((size_t)(l * 2 + d) * 256 + n0) * 64, 64, epi, lds, tid);
    }
  }
  {
    const int NT = 2;
    for (int itx = 0;; itx++) {
      int nt, mt;
      if (!xcd_tile(itx, bid, nb, MT, NT, mt, nt)) break;
      int m0 = mt * 128, n0 = nt * 128;
      auto rowfn = [&](int r) -> const void* { return p.S1 + (size_t)(m0 + r) * 384 + 256; };
      u16* dst = p.gD;
      auto epi = [&](f32x4(&acc)[4][4], int rbase, int cbase) {
        epi_store_rows_bf16(acc, rbase, cbase, lds, tid, dst + (size_t)m0 * 256 + n0, 256, 128);
      };
      gemm_tile<false>(rowfn, p.gup_t + ((size_t)l * 256 + n0) * 128, 128, epi, lds, tid);
    }
  }
}

DI bf16x8 pack8(const f32x16& s, int o) {
  u32x4_t r = {pack2(s[o], s[o + 1]), pack2(s[o + 2], s[o + 3]), pack2(s[o + 4], s[o + 5]), pack2(s[o + 6], s[o + 7])};
  return __builtin_bit_cast(bf16x8, r);
}

constexpr int AT_KP = 208, AT_VP = 144, AT_BUF = 64 * AT_KP + 64 * AT_VP;
DI void attn_task(const Params& p, int task, int N, char* lds, int tid) {
  const int lane = tid & 63, wv = tid >> 6, r = lane & 31, hf = lane >> 5;
  const int nqb = N >> 7;
  {
    const int qb = task % nqb, bh = task / nqb, h = bh & 3, b = bh >> 2;
    const size_t tb = (size_t)b * N;
    const int q = qb * 128 + wv * 32 + r;
    bf16x8 qf[6];
    {
      const u16* qrow = p.Q + (tb + q) * 384 + h * 96;
#pragma unroll
      for (int ks = 0; ks < 4; ks++) qf[ks] = *(const bf16x8*)(qrow + ks * 16 + hf * 8);
      bf16x8 x1r = *(const bf16x8*)(qrow + 64 + hf * 8);
      bf16x8 x2r = *(const bf16x8*)(qrow + 80 + hf * 8);
      const float* cp = p.ropec + q * 16 + hf * 8;
      const float* sp = p.ropes + q * 16 + hf * 8;
      float ra[8], rb[8];
#pragma unroll
      for (int j = 0; j < 8; j++) {
        float xa = bf2f((u16)x1r[j]), ya = bf2f((u16)x2r[j]);
        float c0 = cp[j], s0 = sp[j];
        ra[j] = xa * c0 - ya * s0;
        rb[j] = xa * s0 + ya * c0;
      }
      u32x4_t o1 = {pack2(ra[0], ra[1]), pack2(ra[2], ra[3]), pack2(ra[4], ra[5]), pack2(ra[6], ra[7])};
      u32x4_t o2 = {pack2(rb[0], rb[1]), pack2(rb[2], rb[3]), pack2(rb[4], rb[5]), pack2(rb[6], rb[7])};
      qf[4] = __builtin_bit_cast(bf16x8, o1);
      qf[5] = __builtin_bit_cast(bf16x8, o2);
    }
    const u16* Kg = p.Kb + tb * 384 + h * 96;
    const u16* Vg = p.Vt + ((size_t)(b * 4 + h) * 64) * N;
    uint4 kr0, kr1, kr2, vr0, vr1;
    const int lkey = tid >> 2, lpart = tid & 3;
    const int lrow = swap23(lkey);
#define AT_GLOAD(kt_)                                                              \
  {                                                                                \
    const u16* kp_ = Kg + (size_t)((kt_) * 64 + lkey) * 384 + lpart * 24;          \
    kr0 = *(const uint4*)(kp_);                                                    \
    kr1 = *(const uint4*)(kp_ + 8);                                                \
    kr2 = *(const uint4*)(kp_ + 16);                                               \
    const u16* vp_ = Vg + (size_t)lkey * N + (kt_) * 64 + lpart * 16;              \
    vr0 = *(const uint4*)(vp_);                                                    \
    vr1 = *(const uint4*)(vp_ + 8);                                                \
  }
#define AT_LSTORE(buf_)                                                            \
  {                                                                                \
    char* Kl_ = lds + (buf_) * AT_BUF;                                             \
    char* Vl_ = Kl_ + 64 * AT_KP;                                                  \
    *(uint4*)(Kl_ + lrow * AT_KP + (lpart * 3 + 0) * 16) = kr0;                    \
    *(uint4*)(Kl_ + lrow * AT_KP + (lpart * 3 + 1) * 16) = kr1;                    \
    *(uint4*)(Kl_ + lrow * AT_KP + (lpart * 3 + 2) * 16) = kr2;                    \
    *(uint4*)(Vl_ + lkey * AT_VP + (lpart * 2 + 0) * 16) = vr0;                    \
    *(uint4*)(Vl_ + lkey * AT_VP + (lpart * 2 + 1) * 16) = vr1;                    \
  }
    f32x16 O0, O1;
#pragma unroll
    for (int i = 0; i < 16; i++) { O0[i] = 0.f; O1[i] = 0.f; }
    float mrun = 0.f, lrun = 0.f;
    const int nt = N >> 6;
    __syncthreads();
    AT_GLOAD(0);
    AT_LSTORE(0);
    __syncthreads();
    for (int kt = 0; kt < nt; kt++) {
      if (kt + 1 < nt) AT_GLOAD(kt + 1);
      __builtin_amdgcn_sched_barrier(0);
      const char* Kl = lds + (kt & 1) * AT_BUF;
      const char* Vl = Kl + 64 * AT_KP;
      f32x16 S0, S1;
      {
        const float nm = -mrun;
#pragma unroll
        for (int i = 0; i < 16; i++) { S0[i] = nm; S1[i] = nm; }
      }
#pragma unroll
      for (int ks = 0; ks < 6; ks++) {
        bf16x8 a0 = *(const bf16x8*)(Kl + r * AT_KP + ks * 32 + hf * 16);
        bf16x8 a1 = *(const bf16x8*)(Kl + (32 + r) * AT_KP + ks * 32 + hf * 16);
        S0 = __builtin_amdgcn_mfma_f32_32x32x16_bf16(a0, qf[ks], S0, 0, 0, 0);
        S1 = __builtin_amdgcn_mfma_f32_32x32x16_bf16(a1, qf[ks], S1, 0, 0, 0);
      }
      float mx = fmaxf(S0[0], S1[0]);
#pragma unroll
      for (int i = 1; i < 16; i++) mx = fmaxf(mx, fmaxf(S0[i], S1[i]));
      if (__any((mx > 12.f) || (kt == 0))) {
        const float mq = fmaxf(mx, __shfl_xor(mx, 32));
        const float shift = (kt == 0) ? mq : ((mq > 12.f) ? mq : 0.f);
        const float sc = (kt == 0) ? 1.f : ex2(-shift);
        mrun += shift;
        lrun *= sc;
#pragma unroll
        for (int i = 0; i < 16; i++) {
          S0[i] -= shift;
          S1[i] -= shift;
          O0[i] *= sc;
          O1[i] *= sc;
        }
      }
      float ls = 0.f;
#pragma unroll
      for (int i = 0; i < 16; i++) {
        S0[i] = ex2(S0[i]);
        S1[i] = ex2(S1[i]);
        ls += S0[i] + S1[i];
      }
      lrun += ls;
#pragma unroll
      for (int sp = 0; sp < 4; sp++) {
        bf16x8 pb = (sp < 2) ? pack8(S0, (sp & 1) * 8) : pack8(S1, (sp & 1) * 8);
        bf16x8 v0 = *(const bf16x8*)(Vl + r * AT_VP + sp * 32 + hf * 16);
        bf16x8 v1 = *(const bf16x8*)(Vl + (32 + r) * AT_VP + sp * 32 + hf * 16);
        O0 = __builtin_amdgcn_mfma_f32_32x32x16_bf16(v0, pb, O0, 0, 0, 0);
        O1 = __builtin_amdgcn_mfma_f32_32x32x16_bf16(v1, pb, O1, 0, 0, 0);
      }
      __builtin_amdgcn_sched_barrier(0);
      if (kt + 1 < nt) AT_LSTORE((kt + 1) & 1);
      __syncthreads();
    }
    float lt = lrun + __shfl_xor(lrun, 32);
    float inv = 1.f / lt;
    u16* orow = p.cat + (tb + q) * 1024 + h * 64;
#pragma unroll
    for (int g = 0; g < 4; g++) {
      int d0 = 8 * g + 4 * hf;
      *(uint2*)(orow + d0) = make_uint2(pack2(O0[4 * g] * inv, O0[4 * g + 1] * inv), pack2(O0[4 * g + 2] * inv, O0[4 * g + 3] * inv));
      *(uint2*)(orow + 32 + d0) = make_uint2(pack2(O1[4 * g] * inv, O1[4 * g + 1] * inv), pack2(O1[4 * g + 2] * inv, O1[4 * g + 3] * inv));
    }
  }
}

DI void na_task(const Params& p, int l, int task, int N, int tid) {
  const int lane = tid & 63, head = tid >> 6, r = lane & 31, hf = lane >> 5;
  const int rows = N >> 6;
  const int nrb = rows >> 1;
  const float* bias = p.na_bias + (size_t)(l * 4 + head) * 15 * 31;
  {
    const int cb = task & 3, rb = (task >> 2) % nrb, b = (task >> 2) / nrb;
    const size_t tb = (size_t)b * N;
    const int qrow0 = rb * 2;
    const int rstart0 = clampi(qrow0 - 4, 0, rows - 8);
    const int k0 = clampi(rstart0, 0, rows - 9);
    const int kstart = clampi(cb * 16 - 8, 0, 32);
    const int iq = r >> 4, u = r & 15;
    const int qrow = qrow0 + iq, qcol = cb * 16 + u;
    const int rstart = clampi(qrow - 4, 0, rows - 8);
    const int cstart = clampi(qcol - 8, 0, 48);
    bf16x8 qf[4];
    {
      const u16* qp = p.z + (tb + qrow * 64 + qcol) * ZLD + ZB_OFF + head * 64;
#pragma unroll
      for (int ks = 0; ks < 4; ks++) qf[ks] = *(const bf16x8*)(qp + ks * 16 + hf * 8);
    }
    f32x16 O0, O1;
#pragma unroll
    for (int i = 0; i < 16; i++) { O0[i] = 0.f; O1[i] = 0.f; }
    float mrun = -1e30f, lrun = 0.f;
    const int wk = swap23(r);
    for (int j = 0; j < 9; j++) {
      const int krow = k0 + j;
      const u16* kp = p.z + (tb + krow * 64 + kstart + wk) * ZLD + ZB_OFF + 256 + head * 64;
      f32x16 S;
#pragma unroll
      for (int i = 0; i < 16; i++) S[i] = 0.f;
#pragma unroll
      for (int ks = 0; ks < 4; ks++) {
        bf16x8 a = *(const bf16x8*)(kp + ks * 16 + hf * 8);
        S = __builtin_amdgcn_mfma_f32_32x32x16_bf16(a, qf[ks], S, 0, 0, 0);
      }
      const bool rok = (krow >= rstart) && (krow < rstart + 8);
      const int drow = clampi(krow - qrow + 7, 0, 14);
      const float* brow = bias + drow * 31;
      float mx = -1e30f;
#pragma unroll
      for (int i = 0; i < 16; i++) {
        int w = 16 * (i >> 3) + 8 * hf + 4 * ((i >> 2) & 1) + (i & 3);
        int kcol = kstart + w;
        bool ok = rok && (kcol >= cstart) && (kcol < cstart + 16);
        int dcol = clampi(kcol - qcol + 15, 0, 30);
        float s = (S[i] * 0.125f + brow[dcol]) * LOG2E;
        S[i] = ok ? s : -1e30f;
        mx = fmaxf(mx, S[i]);
      }
      mx = fmaxf(mx, __shfl_xor(mx, 32));
      float mn = fmaxf(mrun, mx);
      float alpha = ex2(mrun - mn);
      mrun = mn;
      float ls = 0.f;
#pragma unroll
      for (int i = 0; i < 16; i++) {
        float pv = (S[i] > -1e29f) ? ex2(S[i] - mn) : 0.f;
        S[i] = pv;
        ls += pv;
      }
      lrun = lrun * alpha + ls;
#pragma unroll
      for (int i = 0; i < 16; i++) { O0[i] *= alpha; O1[i] *= alpha; }
      const u16* vbase = p.z + (tb + krow * 64 + kstart) * ZLD + ZB_OFF + 512 + head * 64 + r;
#pragma unroll
      for (int s = 0; s < 2; s++) {
        bf16x8 pb = pack8(S, s * 8);
        bf16x8 v0, v1;
#pragma unroll
        for (int jj = 0; jj < 8; jj++) {
          const u16* vp = vbase + (size_t)(16 * s + 8 * hf + jj) * ZLD;
          v0[jj] = (short)vp[0];
          v1[jj] = (short)vp[32];
        }
        O0 = __builtin_amdgcn_mfma_f32_32x32x16_bf16(v0, pb, O0, 0, 0, 0);
        O1 = __builtin_amdgcn_mfma_f32_32x32x16_bf16(v1, pb, O1, 0, 0, 0);
      }
    }
    float lt = lrun + __shfl_xor(lrun, 32);
    float inv = 1.f / lt;
    u16* orow = p.cat + (tb + qrow * 64 + qcol) * 1024 + 256 + head * 64;
#pragma unroll
    for (int g = 0; g < 4; g++) {
      int d0 = 8 * g + 4 * hf;
      *(uint2*)(orow + d0) = make_uint2(pack2(O0[4 * g] * inv, O0[4 * g + 1] * inv), pack2(O0[4 * g + 2] * inv, O0[4 * g + 3] * inv));
      *(uint2*)(orow + 32 + d0) = make_uint2(pack2(O1[4 * g] * inv, O1[4 * g + 1] * inv), pack2(O1[4 * g + 2] * inv, O1[4 * g + 3] * inv));
    }
  }
}

using f32x2 = __attribute__((ext_vector_type(2))) float;
constexpr int SC_STEPS = 16;

DI void sc_store(char* buf, int dst, uint4 R, bool hgw) {
  float4 lo = make_float4(blo(R.x), bhi(R.x), blo(R.y), bhi(R.y));
  float4 hi = make_float4(blo(R.z), bhi(R.z), blo(R.w), bhi(R.w));
  *(float4*)(buf + dst) = lo;
  *(float4*)(buf + dst + 16) = hi;
  if (hgw) {
    *(float4*)(buf + dst + 256) = make_float4(1.f - lo.x, 1.f - lo.y, 1.f - lo.z, 1.f - lo.w);
    *(float4*)(buf + dst + 272) = make_float4(1.f - hi.x, 1.f - hi.y, 1.f - hi.z, 1.f - hi.w);
  }
}

DI float reduce8(float v) {
  v += dpp_f<0xB1>(v);
  v += dpp_f<0x4E>(v);
  v += dpp_f<0x141>(v);
  return v;
}

template <bool RW>
DI void scan_task(const Params& p, int task, int N, char* lds, int tid) {
  constexpr int NA = RW ? 5 : 3;
  constexpr int VOFF = SC_STEPS * NA * 256;
  constexpr int BUF = VOFF + SC_STEPS * 128;
  const int lane = tid & 63, wv = tid >> 6, kq = lane & 7, rg = lane >> 3;
  const int rq = task & 1, hh = (task >> 1) & 3, dir = (task >> 3) & 1, b = task >> 4;
  const size_t tb = (size_t)b * N;
  const int sub = tid >> 7, lt = tid & 127, lstep = lt >> 3, lpart = lt & 7;
  const int vstep = lt >> 2, vq = lt & 3;
  const u16 *src0 = nullptr, *src1 = nullptr, *src2 = nullptr;
  int dst0 = 0, dst1 = 0, dst2 = 0, st0 = 0, st1 = 0, st2 = 0;
  bool act0 = false, act1 = false, act2 = false, hgw = false;
  int ld;
  const int acol = hh * 64 + lpart * 8;
  const int vcol = hh * 64 + rq * 32 + vq * 8;
  const int vdst = VOFF + vstep * 128 + vq * 32;
  if (RW) {
    ld = 256;
    act0 = true; st0 = lstep;
    src0 = sub ? (p.dec + (size_t)dir * T_SUB * 256 + acol) : (p.rs + acol);
    dst0 = (lstep * NA + (sub ? 1 : 0)) * 256 + lpart * 32;
    act1 = true; st1 = lstep;
    src1 = sub ? (p.kk + acol) : (p.kt + (size_t)dir * T_SUB * 256 + acol);
    dst1 = (lstep * NA + (sub ? 3 : 2)) * 256 + lpart * 32;
    if (sub == 0) { act2 = true; st2 = lstep; src2 = p.kka + (size_t)dir * T_SUB * 256 + acol; dst2 = (lstep * NA + 4) * 256 + lpart * 32; }
    else { act2 = lt < 64; st2 = vstep; src2 = p.vs + vcol; dst2 = vdst; }
  } else {
    ld = ZLD;
    act0 = true; st0 = lstep;
    src0 = sub ? (p.z + ZC_OFF + 256 * (1 + dir) + acol) : (p.z + ZC_OFF + acol);
    dst0 = (lstep * NA + (sub ? 1 : 0)) * 256 + lpart * 32;
    hgw = sub != 0;
    if (sub == 0) { act1 = lt < 64; st1 = vstep; src1 = p.z + ZC_OFF + 768 + vcol; dst1 = vdst; }
  }
  u16* pout = (RW ? p.oD : p.oC) + (size_t)dir * T_SUB * 256 + hh * 64 + rq * 32 + wv * 8 + rg;
  pout += (tb + (dir ? (N - 1) : 0)) * 256;
  const int ostride = dir ? -256 : 256;

#define SC_TOK(c_, st_) (tb + (size_t)(dir ? (N - 1 - ((c_) * SC_STEPS + (st_))) : ((c_) * SC_STEPS + (st_))))
#define SC_ISSUE(Ra, Rb, Rc, c_)                                               \
  {                                                                            \
    if (act0) Ra = *(const uint4*)(src0 + SC_TOK(c_, st0) * ld);               \
    if (act1) Rb = *(const uint4*)(src1 + SC_TOK(c_, st1) * ld);               \
    if (act2) Rc = *(const uint4*)(src2 + SC_TOK(c_, st2) * ld);               \
  }
#define SC_STORE(Ra, Rb, Rc, buf_)                                             \
  {                                                                            \
    if (act0) sc_store(buf_, dst0, Ra, hgw);                                   \
    if (act1) sc_store(buf_, dst1, Rb, false);                                 \
    if (act2) sc_store(buf_, dst2, Rc, false);                                 \
  }
  f32x2 S0 = {0.f, 0.f}, S1 = {0.f, 0.f}, S2 = {0.f, 0.f}, S3 = {0.f, 0.f};
#define SC_LD(buf_, s_, ra_, rb_, wa_, wb_, ta_, tb_, ka_, kb_, aa_, ab_, v_)                \
  {                                                                                          \
    const char* rowp_ = (buf_) + (s_) * NA * 256 + kq * 32;                                  \
    ra_ = *(const float4*)(rowp_);                                                           \
    rb_ = *(const float4*)(rowp_ + 16);                                                      \
    wa_ = *(const float4*)(rowp_ + 256);                                                     \
    wb_ = *(const float4*)(rowp_ + 272);                                                     \
    ta_ = *(const float4*)(rowp_ + 512);                                                     \
    tb_ = *(const float4*)(rowp_ + 528);                                                     \
    if (RW) {                                                                                \
      ka_ = *(const float4*)(rowp_ + 768);                                                   \
      kb_ = *(const float4*)(rowp_ + 784);                                                   \
      aa_ = *(const float4*)(rowp_ + 1024);                                                  \
      ab_ = *(const float4*)(rowp_ + 1040);                                                  \
    }                                                                                        \
    v_ = *(const float*)((buf_) + VOFF + (s_) * 128 + (wv * 8 + rg) * 4);                    \
  }
#define F2A(q_) f32x2{(q_).x, (q_).y}
#define F2B(q_) f32x2{(q_).z, (q_).w}
#define SC_COMPUTE(buf_)                                                                     \
  {                                                                                          \
    float oselA = 0.f, oselB = 0.f;                                                          \
    float4 ra, rb, wa, wb, ta, tb_, ka, kb, aa, ab, nra, nrb, nwa, nwb, nta, ntb, nka, nkb, naa, nab; \
    float vv, nvv;                                                                           \
    ka = kb = aa = ab = nka = nkb = naa = nab = make_float4(0.f, 0.f, 0.f, 0.f);             \
    SC_LD(buf_, 0, ra, rb, wa, wb, ta, tb_, ka, kb, aa, ab, vv);                             \
    _Pragma("unroll") for (int s = 0; s < SC_STEPS; s++) {                                   \
      if (s + 1 < SC_STEPS) SC_LD(buf_, s + 1, nra, nrb, nwa, nwb, nta, ntb, nka, nkb, naa, nab, nvv); \
      f32x2 u0 = F2A(ta) * vv, u1 = F2B(ta) * vv, u2 = F2A(tb_) * vv, u3 = F2B(tb_) * vv;     \
      if (RW) {                                                                              \
        f32x2 pa = S0 * F2A(ka), pb = S1 * F2B(ka);                                          \
        pa = S2 * F2A(kb) + pa;                                                              \
        pb = S3 * F2B(kb) + pb;                                                              \
        pa = pa + pb;                                                                        \
        const float sa = -reduce8(pa.x + pa.y);                                              \
        u0 = F2A(aa) * sa + u0;                                                              \
        u1 = F2B(aa) * sa + u1;                                                              \
        u2 = F2A(ab) * sa + u2;                                                              \
        u3 = F2B(ab) * sa + u3;                                                              \
      }                                                                                      \
      S0 = S0 * F2A(wa) + u0;                                                                \
      S1 = S1 * F2B(wa) + u1;                                                                \
      S2 = S2 * F2A(wb) + u2;                                                                \
      S3 = S3 * F2B(wb) + u3;                                                                \
      f32x2 qa = S0 * F2A(ra), qb = S1 * F2B(ra);                                            \
      qa = S2 * F2A(rb) + qa;                                                                \
      qb = S3 * F2B(rb) + qb;                                                                \
      qa = qa + qb;                                                                          \
      const float o = reduce8(qa.x + qa.y);                                                  \
      if (s < 8) oselA = (kq == s) ? o : oselA;                                              \
      else oselB = (kq == s - 8) ? o : oselB;                                                \
      ra = nra; rb = nrb; wa = nwa; wb = nwb; ta = nta; tb_ = ntb;                           \
      ka = nka; kb = nkb; aa = naa; ab = nab; vv = nvv;                                      \
    }                                                                                        \
    pout[kq * ostride] = f2bf(oselA);                                                        \
    pout[(kq + 8) * ostride] = f2bf(oselB);                                                  \
    pout += SC_STEPS * ostride;                                                              \
  }
  uint4 A0 = make_uint4(0, 0, 0, 0), A1 = A0, A2 = A0, B0 = A0, B1 = A0, B2 = A0;
  char* buf0 = lds;
  char* buf1 = lds + BUF;
  const int nch = N / SC_STEPS;
  __syncthreads();
  SC_ISSUE(A0, A1, A2, 0);
  SC_ISSUE(B0, B1, B2, 1);
  SC_STORE(A0, A1, A2, buf0);
  __syncthreads();
  for (int c = 0; c < nch; c += 2) {
    if (c + 2 < nch) SC_ISSUE(A0, A1, A2, c + 2);
    __builtin_amdgcn_sched_barrier(0);
    SC_COMPUTE(buf0);
    __builtin_amdgcn_sched_barrier(0);
    SC_STORE(B0, B1, B2, buf1);
    __syncthreads();
    if (c + 3 < nch) SC_ISSUE(B0, B1, B2, c + 3);
    __builtin_amdgcn_sched_barrier(0);
    SC_COMPUTE(buf1);
    __builtin_amdgcn_sched_barrier(0);
    if (c + 2 < nch) SC_STORE(A0, A1, A2, buf0);
    __syncthreads();
  }
}

template <bool RW>
DI void scan_task16(const Params& p, int task, int N, char* lds, int tid) {
  constexpr int NA = RW ? 5 : 3;
  constexpr int VOFF = SC_STEPS * NA * 256;
  constexpr int BUF = VOFF + SC_STEPS * 64;
  const int lane = tid & 63, wv = tid >> 6, kq = lane & 15, rg = lane >> 4;
  const int rq = task & 3, hh = (task >> 2) & 3, dir = (task >> 4) & 1, b = task >> 5;
  const size_t tb = (size_t)b * N;
  const int sub = tid >> 7, lt = tid & 127, lstep = lt >> 3, lpart = lt & 7;
  const int vstep = lt >> 1, vhalf = lt & 1;
  const u16 *src0 = nullptr, *src1 = nullptr, *src2 = nullptr;
  int dst0 = 0, dst1 = 0, dst2 = 0, st0 = 0, st1 = 0, st2 = 0;
  bool act0 = false, act1 = false, act2 = false, hgw = false;
  int ld;
  const int acol = hh * 64 + lpart * 8;
  const int vcol = hh * 64 + rq * 16 + vhalf * 8;
  const int vdst = VOFF + vstep * 64 + vhalf * 32;
  if (RW) {
    ld = 256;
    act0 = true; st0 = lstep;
    src0 = sub ? (p.dec + (size_t)dir * T_SUB * 256 + acol) : (p.rs + acol);
    dst0 = (lstep * NA + (sub ? 1 : 0)) * 256 + lpart * 32;
    act1 = true; st1 = lstep;
    src1 = sub ? (p.kk + acol) : (p.kt + (size_t)dir * T_SUB * 256 + acol);
    dst1 = (lstep * NA + (sub ? 3 : 2)) * 256 + lpart * 32;
    if (sub == 0) { act2 = true; st2 = lstep; src2 = p.kka + (size_t)dir * T_SUB * 256 + acol; dst2 = (lstep * NA + 4) * 256 + lpart * 32; }
    else { act2 = lt < 32; st2 = vstep; src2 = p.vs + vcol; dst2 = vdst; }
  } else {
    ld = ZLD;
    act0 = true; st0 = lstep;
    src0 = sub ? (p.z + ZC_OFF + 256 * (1 + dir) + acol) : (p.z + ZC_OFF + acol);
    dst0 = (lstep * NA + (sub ? 1 : 0)) * 256 + lpart * 32;
    hgw = sub != 0;
    if (sub == 0) { act1 = lt < 32; st1 = vstep; src1 = p.z + ZC_OFF + 768 + vcol; dst1 = vdst; }
  }
  u16* pout = (RW ? p.oD : p.oC) + (size_t)dir * T_SUB * 256 + hh * 64 + rq * 16 + wv * 4 + rg;
  pout += (tb + (dir ? (N - 1) : 0)) * 256;
  const int ostride = dir ? -256 : 256;

#define SC16_TOK(c_, st_) (tb + (size_t)(dir ? (N - 1 - ((c_) * SC_STEPS + (st_))) : ((c_) * SC_STEPS + (st_))))
#define SC16_ISSUE(Ra, Rb, Rc, c_)                                               \
  {                                                                            \
    if (act0) Ra = *(const uint4*)(src0 + SC16_TOK(c_, st0) * ld);               \
    if (act1) Rb = *(const uint4*)(src1 + SC16_TOK(c_, st1) * ld);               \
    if (act2) Rc = *(const uint4*)(src2 + SC16_TOK(c_, st2) * ld);               \
  }
#define SC16_STORE(Ra, Rb, Rc, buf_)                                             \
  {                                                                            \
    if (act0) sc_store(buf_, dst0, Ra, hgw);                                   \
    if (act1) sc_store(buf_, dst1, Rb, false);                                 \
    if (act2) sc_store(buf_, dst2, Rc, false);                                 \
  }
  f32x2 S01 = {0.f, 0.f}, S23 = {0.f, 0.f};
#define SC16_LD(buf_, s_, r_, w_, t_, k_, a_, v_)                                              \
  {                                                                                          \
    const char* rowp_ = (buf_) + (s_) * NA * 256 + kq * 16;                                  \
    r_ = *(const float4*)(rowp_);                                                            \
    w_ = *(const float4*)(rowp_ + 256);                                                      \
    t_ = *(const float4*)(rowp_ + 512);                                                      \
    if (RW) {                                                                                \
      k_ = *(const float4*)(rowp_ + 768);                                                    \
      a_ = *(const float4*)(rowp_ + 1024);                                                   \
    }                                                                                        \
    v_ = *(const float*)((buf_) + VOFF + (s_) * 64 + (wv * 4 + rg) * 4);                     \
  }
#define SC16_COMPUTE(buf_)                                                                     \
  {                                                                                          \
    float osel = 0.f;                                                                        \
    float4 r4, w4, t4, k4, a4, nr4, nw4, nt4, nk4, na4;                                      \
    float vv, nvv;                                                                           \
    k4 = a4 = nk4 = na4 = make_float4(0.f, 0.f, 0.f, 0.f);                                   \
    SC16_LD(buf_, 0, r4, w4, t4, k4, a4, vv);                                                  \
    _Pragma("unroll") for (int s = 0; s < SC_STEPS; s++) {                                   \
      if (s + 1 < SC_STEPS) SC16_LD(buf_, s + 1, nr4, nw4, nt4, nk4, na4, nvv);                \
      f32x2 ta = f32x2{t4.x, t4.y} * vv, tb2 = f32x2{t4.z, t4.w} * vv;                       \
      if (RW) {                                                                              \
        f32x2 pp = S01 * f32x2{k4.x, k4.y};                                                  \
        pp = S23 * f32x2{k4.z, k4.w} + pp;                                                   \
        const float sa = -reduce16(pp.x + pp.y);                                             \
        ta = f32x2{a4.x, a4.y} * sa + ta;                                                    \
        tb2 = f32x2{a4.z, a4.w} * sa + tb2;                                                  \
      }                                                                                      \
      S01 = S01 * f32x2{w4.x, w4.y} + ta;                                                    \
      S23 = S23 * f32x2{w4.z, w4.w} + tb2;                                                   \
      f32x2 qq = S01 * f32x2{r4.x, r4.y};                                                    \
      qq = S23 * f32x2{r4.z, r4.w} + qq;                                                     \
      const float o = reduce16(qq.x + qq.y);                                                 \
      osel = (kq == s) ? o : osel;                                                           \
      r4 = nr4; w4 = nw4; t4 = nt4; k4 = nk4; a4 = na4; vv = nvv;                            \
    }                                                                                        \
    pout[kq * ostride] = f2bf(osel);                                                         \
    pout += SC_STEPS * ostride;                                                              \
  }
  uint4 A0 = make_uint4(0, 0, 0, 0), A1 = A0, A2 = A0, B0 = A0, B1 = A0, B2 = A0;
  char* buf0 = lds;
  char* buf1 = lds + BUF;
  const int nch = N / SC_STEPS;
  __syncthreads();
  SC16_ISSUE(A0, A1, A2, 0);
  SC16_ISSUE(B0, B1, B2, 1);
  SC16_STORE(A0, A1, A2, buf0);
  __syncthreads();
  for (int c = 0; c < nch; c += 2) {
    if (c + 2 < nch) SC16_ISSUE(A0, A1, A2, c + 2);
    __builtin_amdgcn_sched_barrier(0);
    SC16_COMPUTE(buf0);
    __builtin_amdgcn_sched_barrier(0);
    SC16_STORE(B0, B1, B2, buf1);
    __syncthreads();
    if (c + 3 < nch) SC16_ISSUE(B0, B1, B2, c + 3);
    __builtin_amdgcn_sched_barrier(0);
    SC16_COMPUTE(buf1);
    __builtin_amdgcn_sched_barrier(0);
    if (c + 2 < nch) SC16_STORE(A0, A1, A2, buf0);
    __syncthreads();
  }
}


DI void phase_mix(const Params& p, int l, int B, int N, unsigned* ctr, char* lds, int bid, int nb, int tid) {
  __shared__ int s_task[2];
  const bool wide = (N > 4096);
  const int nper = wide ? B * 32 : B * 16;
  const int nscan = 2 * nper;
  const int nattn = B * 4 * (N >> 7);
  const int nna = B * (N >> 7) * 4;
  const bool prefer_scan = bid < (nb >> 1);
  bool scan_dry = false, attn_dry = false;
  for (;;) {
    if (tid == 0) {
      int kind = -1, task = 0;
      for (int attempt = 0; attempt < 2 && kind < 0; attempt++) {
        const bool try_scan = (attempt == 0) == prefer_scan;
        if (try_scan) {
          if (!scan_dry) {
            const int t = (int)atomicAdd(&ctr[0], 1u);
            if (t < nscan) { kind = 0; task = t; } else scan_dry = true;
          }
        } else {
          if (!attn_dry) {
            const int t = (int)atomicAdd(&ctr[64], 1u);
            if (t < nattn + nna) { kind = 1; task = t; } else attn_dry = true;
          }
        }
      }
      s_task[0] = kind;
      s_task[1] = task;
    }
    __syncthreads();
    const int kind = s_task[0], task = s_task[1];
    __syncthreads();
    if (kind < 0) break;
    if (kind == 0) {
      if (wide) {
        if (task < nper) scan_task16<true>(p, task, N, lds, tid);
        else scan_task16<false>(p, task - nper, N, lds, tid);
      } else {
        if (task < nper) scan_task<true>(p, task, N, lds, tid);
        else scan_task<false>(p, task - nper, N, lds, tid);
      }
    } else {
      if (task < nattn) attn_task(p, task, N, lds, tid);
      else na_task(p, l, task - nattn, N, tid);
    }
  }
}

DI void phase_final(const Params& p, int l, int bid, int nb, int tid) {
  const int lane = tid & 63, wv = tid >> 6, c4 = lane * 4;
  float gn[4], lw[4], lbb[4];
#pragma unroll
  for (int j = 0; j < 4; j++) {
    gn[j] = p.hg_gnorm[l * 256 + c4 + j];
    lw[j] = p.rw_ln_w[l * 256 + c4 + j];
    lbb[j] = p.rw_ln_b[l * 256 + c4 + j];
  }
  for (int t = bid * 4 + wv; t < T_SUB; t += nb * 4) {
    const uint2 ca = *(const uint2*)(p.oC + (size_t)t * 256 + c4);
    const uint2 cb = *(const uint2*)(p.oC + (size_t)(T_SUB + t) * 256 + c4);
    const uint2 cg = *(const uint2*)(p.z + (size_t)t * ZLD + ZC_OFF + 1024 + c4);
    const uint2 da = *(const uint2*)(p.oD + (size_t)t * 256 + c4);
    const uint2 db = *(const uint2*)(p.oD + (size_t)(T_SUB + t) * 256 + c4);
    const float bo = p.bonus[(size_t)t * 4 + (lane >> 4)];
    const uint2 vr = *(const uint2*)(p.vs + (size_t)t * 256 + c4);
    const uint2 gr = *(const uint2*)(p.gD + (size_t)t * 256 + c4);
    {
      float o[4] = {blo(ca.x) + blo(cb.x), bhi(ca.x) + bhi(cb.x), blo(ca.y) + blo(cb.y), bhi(ca.y) + bhi(cb.y)};
      float ss = reduce16(o[0] * o[0] + o[1] * o[1] + o[2] * o[2] + o[3] * o[3]);
      float ri = rsqrtf(ss * (1.f / 64.f) + 1e-6f);
      float g[4] = {blo(cg.x), bhi(cg.x), blo(cg.y), bhi(cg.y)};
      float y[4];
#pragma unroll
      for (int j = 0; j < 4; j++) y[j] = o[j] * ri * gn[j] * (g[j] * sigm(g[j]));
      *(uint2*)(p.cat + (size_t)t * 1024 + 512 + c4) = make_uint2(pack2(y[0], y[1]), pack2(y[2], y[3]));
    }
    {
      float o[4] = {blo(da.x) + blo(db.x), bhi(da.x) + bhi(db.x), blo(da.y) + blo(db.y), bhi(da.y) + bhi(db.y)};
      float mu = reduce16(o[0] + o[1] + o[2] + o[3]) * (1.f / 64.f);
      float d0 = o[0] - mu, d1 = o[1] - mu, d2 = o[2] - mu, d3 = o[3] - mu;
      float var = reduce16(d0 * d0 + d1 * d1 + d2 * d2 + d3 * d3) * (1.f / 64.f);
      float ri = rsqrtf(var + 64e-5f);
      float vv[4] = {blo(vr.x), bhi(vr.x), blo(vr.y), bhi(vr.y)};
      float g[4] = {blo(gr.x), bhi(gr.x), blo(gr.y), bhi(gr.y)};
      float dd[4] = {d0, d1, d2, d3};
      float y[4];
#pragma unroll
      for (int j = 0; j < 4; j++) y[j] = (dd[j] * ri * lw[j] + lbb[j] + bo * vv[j]) * g[j];
      *(uint2*)(p.cat + (size_t)t * 1024 + 768 + c4) = make_uint2(pack2(y[0], y[1]), pack2(y[2], y[3]));
    }
  }
}

DI void phase_wout(const Params& p, int l, int tok0, char* lds, int bid, int nb, int tid) {
  const int NT = 8, MT = T_SUB / 128;
  for (int it = 0;; it++) {
    int nt, mt;
    if (!xcd_tile(it, bid, nb, MT, NT, mt, nt)) break;
    int m0 = mt * 128, n0 = nt * 128;
    auto rowfn = [&](int r) -> const void* { return p.cat + (size_t)(m0 + r) * 1024; };
    auto epi = [&](f32x4(&acc)[4][4], int rbase, int cbase) {
#pragma unroll
      for (int m = 0; m < 4; m++)
#pragma unroll
        for (int n = 0; n < 4; n++)
          *(float4*)(lds + (rbase + m * 16) * 528 + (cbase + n * 16) * 4) = make_float4(acc[m][n][0], acc[m][n][1], acc[m][n][2], acc[m][n][3]);
      __syncthreads();
#pragma unroll 4
      for (int i = 0; i < 16; i++) {
        const int id = tid + 256 * i, row = id >> 5, c = id & 31;
        const int tg = tok0 + m0 + row;
        const float4 a = *(const float4*)(lds + row * 528 + c * 16);
        const float4 xv = *(const float4*)(xin_row(p, l, tg) + n0 + c * 4);
        *(float4*)(p.out + (size_t)tg * 1024 + n0 + c * 4) =
            make_float4(ALPHA_F * xv.x + a.x, ALPHA_F * xv.y + a.y, ALPHA_F * xv.z + a.z, ALPHA_F * xv.w + a.w);
      }
      __syncthreads();
    };
    gemm_tile<false>(rowfn, p.wout_t + ((size_t)l * 1024 + n0) * 1024, 1024, epi, lds, tid);
  }
}

template <bool ROUTER>
DI void phase_ln(const Params& p, const float* g, const float* bta, const float* wrouter, int tok0, int ntok, char* lds,
                 int bid, int nb, int tid) {
  const int lane = tid & 63, wv = tid >> 6;
  float* wl = (float*)lds;
  if (ROUTER) {
    __syncthreads();
    for (int i = tid; i < 16384; i += NTHR) {
      int k = i >> 4, e = i & 15;
      wl[e * 1024 + k] = wrouter[i];
    }
    __syncthreads();
  }
  auto ln_load = [&](float4 (&d)[4], int trow, bool ok) {
#pragma unroll
    for (int i = 0; i < 4; i++) {
      if (!ok) { d[i] = make_float4(0.f, 0.f, 0.f, 0.f); continue; }
      if (ROUTER) {
        d[i] = *(const float4*)(p.out + (size_t)trow * 1024 + i * 256 + lane * 4);
      } else {
        const uint2 r = *(const uint2*)(p.O + (size_t)trow * 1024 + i * 256 + lane * 4);
        d[i] = make_float4(blo(r.x), bhi(r.x), blo(r.y), bhi(r.y));
      }
    }
  };
  float4 x[4], xn[4];
  {
    const int t0 = bid * 4 + wv;
    ln_load(x, tok0 + t0, t0 < ntok);
  }
  for (int t = bid * 4 + wv; t < ntok; t += nb * 4) {
    const int tg = tok0 + t;
    float* xr = p.out + (size_t)tg * 1024;
    {
      const int tn = t + nb * 4;
      ln_load(xn, tok0 + tn, tn < ntok);
    }
    float s = 0.f;
#pragma unroll
    for (int i = 0; i < 4; i++) s += x[i].x + x[i].y + x[i].z + x[i].w;
    float mu = wave_sum(s) * (1.f / 1024.f);
    float vs = 0.f;
#pragma unroll
    for (int i = 0; i < 4; i++) {
      x[i].x -= mu; x[i].y -= mu; x[i].z -= mu; x[i].w -= mu;
      vs += x[i].x * x[i].x + x[i].y * x[i].y + x[i].z * x[i].z + x[i].w * x[i].w;
    }
    float ri = rsqrtf(wave_sum(vs) * (1.f / 1024.f) + 1e-5f);
#pragma unroll
    for (int i = 0; i < 4; i++) {
      float4 gg = *(const float4*)(g + i * 256 + lane * 4);
      float4 bb = *(const float4*)(bta + i * 256 + lane * 4);
      x[i].x = x[i].x * ri * gg.x + bb.x;
      x[i].y = x[i].y * ri * gg.y + bb.y;
      x[i].z = x[i].z * ri * gg.z + bb.z;
      x[i].w = x[i].w * ri * gg.w + bb.w;
      if (!ROUTER) *(float4*)(xr + i * 256 + lane * 4) = x[i];
      *(uint2*)(p.xb + (size_t)tg * 1024 + i * 256 + lane * 4) = make_uint2(pack2(x[i].x, x[i].y), pack2(x[i].z, x[i].w));
    }
    if (ROUTER) {
      float mine = 0.f;
#pragma unroll 2
      for (int e = 0; e < 16; e++) {
        float a = 0.f;
#pragma unroll
        for (int i = 0; i < 4; i++) {
          float4 w = *(const float4*)(wl + e * 1024 + i * 256 + lane * 4);
          a += x[i].x * w.x + x[i].y * w.y + x[i].z * w.z + x[i].w * w.w;
        }
        a = reduce16(a);
        mine = ((lane & 15) == e) ? a : mine;
      }
      mine += __shfl_xor(mine, 16);
      mine += __shfl_xor(mine, 32);
      float mx = mine;
      mx = fmaxf(mx, dpp_f<0xB1>(mx));
      mx = fmaxf(mx, dpp_f<0x4E>(mx));
      mx = fmaxf(mx, dpp_f<0x141>(mx));
      mx = fmaxf(mx, dpp_f<0x140>(mx));
      float ex = __expf(mine - mx);
      float sum = reduce16(ex);
      mine = ex / sum;
      if (lane == 0) p.inv_cnt[tg] = 0;
      if (lane < 16) {
        if (tg < 32768) p.affT[(size_t)lane * 32768 + tg] = mine;
        else p.affT[(size_t)16 * 32768 + (size_t)lane * 65536 + (tg - 32768)] = mine;
      }
    }
#pragma unroll
    for (int i = 0; i < 4; i++) x[i] = xn[i];
  }
}

DI void phase_topk(const Params& p, char* lds, int bid, int nb, int tid) {
  if (bid < 32) {
    unsigned* hist = (unsigned*)lds;
    unsigned* sh = hist + 256;
    unsigned* eqc = sh + 8;
    const int g = bid >> 4, e = bid & 15;
    const int T = g ? 65536 : 32768, cap = T >> 3;
    const int tok0 = g ? 32768 : 0;
    const float* vals = p.affT + (g ? (size_t)16 * 32768 : 0) + (size_t)e * T;
    const float4* v4 = (const float4*)vals;
    const int n4 = T >> 2;
    int* oidx = p.idx + (g ? 65536 : 0) + e * cap;
    float* ogate = p.gate + (g ? 65536 : 0) + e * cap;
    const int slot0 = (g ? 65536 : 0) + e * cap;
    unsigned prefix = 0, mask = 0;
    int remaining = cap;
    for (int pass = 0; pass < 4; pass++) {
      const int shift = 24 - 8 * pass;
      hist[tid] = 0;
      __syncthreads();
      for (int base = 0; base < n4; base += 2048) {
        float4 x[8];
#pragma unroll
        for (int u = 0; u < 8; u++) x[u] = v4[base + u * 256 + tid];
#pragma unroll
        for (int u = 0; u < 8; u++) {
          const unsigned b0 = __float_as_uint(x[u].x), b1 = __float_as_uint(x[u].y), b2 = __float_as_uint(x[u].z), b3 = __float_as_uint(x[u].w);
          if ((b0 & mask) == prefix) atomicAdd(&hist[(b0 >> shift) & 255], 1u);
          if ((b1 & mask) == prefix) atomicAdd(&hist[(b1 >> shift) & 255], 1u);
          if ((b2 & mask) == prefix) atomicAdd(&hist[(b2 >> shift) & 255], 1u);
          if ((b3 & mask) == prefix) atomicAdd(&hist[(b3 >> shift) & 255], 1u);
        }
      }
      __syncthreads();
      if (tid == 0) {
        int cum = 0, sel = 0;
        for (int bq = 255; bq >= 0; bq--) {
          int hc = (int)hist[bq];
          if (cum + hc >= remaining) { sel = bq; break; }
          cum += hc;
        }
        sh[0] = (unsigned)sel;
        sh[1] = (unsigned)(remaining - cum);
        sh[3] = hist[sel];
      }
      __syncthreads();
      prefix |= sh[0] << shift;
      remaining = (int)sh[1];
      mask |= 0xFFu << shift;
      __syncthreads();
    }
    const unsigned thr = prefix;
    const int need = remaining;
    const bool fast = ((int)sh[3] == need);
    if (tid == 0) sh[2] = 0;
    __syncthreads();
    if (fast) {
      for (int base = 0; base < n4; base += 2048) {
        float4 x[8];
#pragma unroll
        for (int u = 0; u < 8; u++) x[u] = v4[base + u * 256 + tid];
#pragma unroll
        for (int u = 0; u < 8; u++) {
          const float xv[4] = {x[u].x, x[u].y, x[u].z, x[u].w};
#pragma unroll
          for (int c = 0; c < 4; c++) {
            if (__float_as_uint(xv[c]) >= thr) {
              const int pos = (int)atomicAdd(&sh[2], 1u);
              const int tok = tok0 + (base + u * 256 + tid) * 4 + c;
              oidx[pos] = tok;
              ogate[pos] = xv[c];
              const int kslot = atomicAdd(&p.inv_cnt[tok], 1);
              p.inv_slot[(size_t)tok * 16 + kslot] = slot0 + pos;
            }
          }
        }
      }
    } else {
      const int ch = T >> 8;
      const float* my = vals + tid * ch;
      int ec = 0;
      for (int i = 0; i < ch; i++) ec += (__float_as_uint(my[i]) == thr) ? 1 : 0;
      eqc[tid] = ec;
      __syncthreads();
      int eq_rank = 0;
      for (int i = 0; i < tid; i++) eq_rank += eqc[i];
      for (int i = 0; i < ch; i++) {
        float v = my[i];
        unsigned u = __float_as_uint(v);
        int pos = -1;
        if (u > thr) {
          pos = (int)atomicAdd(&sh[2], 1u);
        } else if (u == thr) {
          if (eq_rank < need) pos = cap - need + eq_rank;
          eq_rank++;
        }
        if (pos >= 0) {
          const int tok = tok0 + tid * ch + i;
          oidx[pos] = tok;
          ogate[pos] = v;
          const int kslot = atomicAdd(&p.inv_cnt[tok], 1);
          p.inv_slot[(size_t)tok * 16 + kslot] = slot0 + pos;
        }
      }
    }
    __syncthreads();
  }
}

DI void moe_rowinfo(int row0, int l, int& e, int& ioff) {
  if (row0 < 65536) { e = row0 >> 12; }
  else { e = (row0 - 65536) >> 13; }
  ioff = row0;
}

DI void phase_moe1(const Params& p, int l, char* lds, int bid, int nb, int tid) {
  const int NT = 8, MT = 196608 / 128;
  for (int it = 0;; it++) {
    int nt, mt;
    if (!xcd_tile(it, bid, nb, MT, NT, mt, nt)) break;
    int m0 = mt * 128, n0 = nt * 128;
    int e, ioff;
    moe_rowinfo(m0, l, e, ioff);
    const int* ip = p.idx + ioff;
    auto rowfn = [&](int r) -> const void* { return p.xb + (size_t)ip[r] * 1024; };
    u16* H = p.H;
    auto epi = [&](f32x4(&acc)[4][4], int rbase, int cbase) {
#pragma unroll
      for (int m = 0; m < 4; m++)
#pragma unroll
        for (int n = 0; n < 4; n += 2) {
          const int row = rbase + m * 16;
          const int col = cbase + n * 16;
          const int hl = ((col & ~31) >> 1) + (col & 15);
          f32x4 a = acc[m][n], bq = acc[m][n + 1];
          f32x4 o;
          for (int j = 0; j < 4; j++) o[j] = a[j] * sigm(a[j]) * bq[j];
          *(uint2*)(lds + row * 144 + hl * 2) = make_uint2(pack2(o[0], o[1]), pack2(o[2], o[3]));
        }
      __syncthreads();
#pragma unroll
      for (int i = 0; i < 4; i++) {
        const int id = tid + 256 * i, row = id >> 3, c = id & 7;
        *(uint4*)(H + (size_t)(m0 + row) * 512 + (n0 >> 1) + c * 8) = *(const uint4*)(lds + row * 144 + c * 16);
      }
      __syncthreads();
    };
    gemm_tile<false>(rowfn, p.w13_t + ((size_t)(l * 16 + e) * 1024 + n0) * 1024, 1024, epi, lds, tid);
  }
}

DI void phase_moe2(const Params& p, int l, char* lds, int bid, int nb, int tid) {
  TileIter it{bid, nb, 0};
  {
    const int NT = 8, MT = 196608 / 128;
    for (int itx = 0;; itx++) {
      int nt, mt;
      if (!xcd_tile(itx, bid, nb, MT, NT, mt, nt)) break;
      int m0 = mt * 128, n0 = nt * 128;
      int e, ioff;
      moe_rowinfo(m0, l, e, ioff);
      auto rowfn = [&](int r) -> const void* { return p.H + (size_t)(m0 + r) * 512; };
      u16* O = p.O;
      auto epi = [&](f32x4(&acc)[4][4], int rbase, int cbase) {
        epi_store_rows_bf16(acc, rbase, cbase, lds, tid, O + (size_t)m0 * 1024 + n0, 1024, 128);
      };
      gemm_tile<false>(rowfn, p.w2_t + ((size_t)(l * 16 + e) * 1024 + n0) * 512, 512, epi, lds, tid);
    }
  }
  {
    const int NT = 8, MT = T_ALL / 128;
    for (int itx = 0;; itx++) {
      int nt, mt;
      if (!xcd_tile(itx, bid, nb, MT, NT, mt, nt)) break;
      int m0 = mt * 128, n0 = nt * 128;
      auto rowfn = [&](int r) -> const void* {
        int tg = m0 + r;
        return tg < 32768 ? p.p_prompt + ((size_t)l * 32768 + tg) * 256 : p.p_sample + ((size_t)l * 65536 + (tg - 32768)) * 256;
      };
      auto epi = [&](f32x4(&acc)[4][4], int rbase, int cbase) {
        epi_store_rows_bf16(acc, rbase, cbase, lds, tid, (u16*)p.out + (size_t)m0 * 1024 + n0, 1024, 128);
      };
      gemm_tile<true>(rowfn, p.wp_t + ((size_t)l * 1024 + n0) * 256, 256, epi, lds, tid);
    }
  }
}

DI void phase_combine(const Params& p, int bid, int nb, int tid) {
  const int lane = tid & 63, wv = tid >> 6;
  u16* ub = p.H;
  const int stride = nb * 4;
  int t = bid * 4 + wv;
  uint2 xr_[4], xn_[4];
  int cnt = 0, myslot = 0, cntn = 0, myslotn = 0;
#pragma unroll
  for (int i = 0; i < 4; i++) xr_[i] = xn_[i] = make_uint2(0, 0);
  if (t < T_ALL) {
#pragma unroll
    for (int i = 0; i < 4; i++) xr_[i] = *(const uint2*)(p.xb + (size_t)t * 1024 + i * 256 + lane * 4);
    cnt = p.inv_cnt[t];
    myslot = p.inv_slot[(size_t)t * 16 + (lane & 15)];
  }
  for (; t < T_ALL; t += stride) {
    const int tn = t + stride;
    if (tn < T_ALL) {
#pragma unroll
      for (int i = 0; i < 4; i++) xn_[i] = *(const uint2*)(p.xb + (size_t)tn * 1024 + i * 256 + lane * 4);
      cntn = p.inv_cnt[tn];
      myslotn = p.inv_slot[(size_t)tn * 16 + (lane & 15)];
    }
    const float mygate = ((lane & 15) < cnt) ? p.gate[myslot] : 0.f;
    float4 a[4];
#pragma unroll
    for (int i = 0; i < 4; i++)
      a[i] = make_float4(blo(xr_[i].x) * ALPHA_F, bhi(xr_[i].x) * ALPHA_F, blo(xr_[i].y) * ALPHA_F, bhi(xr_[i].y) * ALPHA_F);
    for (int j0 = 0; j0 < cnt; j0 += 4) {
      uint2 r[4][4];
      float g[4];
#pragma unroll
      for (int jj = 0; jj < 4; jj++) {
        const int j = (j0 + jj < cnt) ? (j0 + jj) : j0;
        const int slot = __shfl(myslot, j);
        g[jj] = (j0 + jj < cnt) ? __shfl(mygate, j) : 0.f;
        const u16* orow = p.O + (size_t)slot * 1024 + lane * 4;
#pragma unroll
        for (int i = 0; i < 4; i++) r[jj][i] = *(const uint2*)(orow + i * 256);
      }
#pragma unroll
      for (int jj = 0; jj < 4; jj++)
#pragma unroll
        for (int i = 0; i < 4; i++) {
          a[i].x += g[jj] * blo(r[jj][i].x);
          a[i].y += g[jj] * bhi(r[jj][i].x);
          a[i].z += g[jj] * blo(r[jj][i].y);
          a[i].w += g[jj] * bhi(r[jj][i].y);
        }
    }
#pragma unroll
    for (int i = 0; i < 4; i++)
      *(uint2*)(ub + (size_t)t * 1024 + i * 256 + lane * 4) = make_uint2(pack2(a[i].x, a[i].y), pack2(a[i].z, a[i].w));
#pragma unroll
    for (int i = 0; i < 4; i++) xr_[i] = xn_[i];
    cnt = cntn;
    myslot = myslotn;
  }
}

DI void phase_ple(const Params& p, int l, char* lds, int bid, int nb, int tid) {
  const int NT = 8, MT = T_ALL / 128;
  for (int it = 0;; it++) {
    int nt, mt;
    if (!xcd_tile(it, bid, nb, MT, NT, mt, nt)) break;
    int m0 = mt * 128, n0 = nt * 128;
    auto rowfn = [&](int r) -> const void* { return p.H + (size_t)(m0 + r) * 1024; };
    auto epi = [&](f32x4(&acc)[4][4], int rbase, int cbase) {
#pragma unroll
      for (int m = 0; m < 4; m++)
#pragma unroll
        for (int n = 0; n < 4; n++)
          *(uint2*)(lds + (rbase + m * 16) * 272 + (cbase + n * 16) * 2) =
              make_uint2(pack2(sigm(acc[m][n][0]), sigm(acc[m][n][1])), pack2(sigm(acc[m][n][2]), sigm(acc[m][n][3])));
      __syncthreads();
#pragma unroll 2
      for (int i = 0; i < 8; i++) {
        const int id = tid + 256 * i, row = id >> 4, c = id & 15;
        const size_t o = (size_t)(m0 + row) * 1024 + n0 + c * 8;
        const uint4 sg = *(const uint4*)(lds + row * 272 + c * 16);
        const uint4 ur = *(const uint4*)(p.H + o);
        const uint4 pr = *(const uint4*)((const u16*)p.out + o);
        uint4 w;
        w.x = pack2(blo(ur.x) + blo(sg.x) * blo(pr.x), bhi(ur.x) + bhi(sg.x) * bhi(pr.x));
        w.y = pack2(blo(ur.y) + blo(sg.y) * blo(pr.y), bhi(ur.y) + bhi(sg.y) * bhi(pr.y));
        w.z = pack2(blo(ur.z) + blo(sg.z) * blo(pr.z), bhi(ur.z) + bhi(sg.z) * bhi(pr.z));
        w.w = pack2(blo(ur.w) + blo(sg.w) * blo(pr.w), bhi(ur.w) + bhi(sg.w) * bhi(pr.w));
        *(uint4*)(p.O + o) = w;
      }
      __syncthreads();
    };
    gemm_tile<false>(rowfn, p.wg_t + ((size_t)l * 1024 + n0) * 1024, 1024, epi, lds, tid);
  }
}

#define XB_TMO      128
#define XB_XCNT(j)  (256  + 64 * (j))
#define XB_XSUB(j)  (1280 + 64 * (j))
#define XB_XGEN(j)  (2304 + 64 * (j))
#define XB_TOP      3328
#define XB_TOPGEN   3392
#define XCD_BAR_WORDS 3456
#define XB_SPIN_CAP (1u << 22)
#define LAS __attribute__((address_space(3)))
DI unsigned xb_ld(unsigned* p) { return __hip_atomic_load(p, __ATOMIC_RELAXED, __HIP_MEMORY_SCOPE_AGENT); }
DI unsigned xb_add(unsigned* p, unsigned v) { return __hip_atomic_fetch_add(p, v, __ATOMIC_RELAXED, __HIP_MEMORY_SCOPE_AGENT); }
DI unsigned xb_xcc_id() { return (unsigned)__builtin_amdgcn_s_getreg((3 << 11) | 20) & 0xFu; }
#define XB_SPIN(cond, bar) do { unsigned _sp = 0; while (cond) { __builtin_amdgcn_s_sleep(1); \
    if ((++_sp & 255u) == 0u) { if (xb_ld(&(bar)[XB_TMO])) break; if (_sp > XB_SPIN_CAP) { atomicAdd(&(bar)[XB_TMO], 1u); break; } } } } while (0)
struct XcdBarrier { unsigned* bar; unsigned x; volatile LAS unsigned* st; };
DI XcdBarrier xcd_barrier_post(unsigned* bar, volatile LAS unsigned* st) {
  XcdBarrier b; b.bar = bar; b.x = xb_xcc_id(); b.st = st;
  if (threadIdx.x == 0) (void)xb_add(&bar[XB_XCNT(b.x)], 1u);
  return b;
}
DI void xcd_barrier_complete(unsigned* bar, unsigned x, unsigned& nloc, unsigned& nx) {
  const unsigned G = gridDim.x * gridDim.y * gridDim.z;
  unsigned sum, cnt, mine, sp = 0u;
  for (;;) {
    sum = 0u; cnt = 0u; mine = 0u;
#pragma unroll
    for (unsigned j = 0; j < 16; ++j) { const unsigned c = xb_ld(&bar[XB_XCNT(j)]); sum += c; cnt += (c > 0u) ? 1u : 0u; mine = (j == x) ? c : mine; }
    if (sum == G) break;
    __builtin_amdgcn_s_sleep(1);
    if ((++sp & 255u) == 0u) { if (xb_ld(&bar[XB_TMO])) break; if (sp > XB_SPIN_CAP) { atomicAdd(&bar[XB_TMO], 1u); break; } }
  }
  nloc = mine > 0u ? mine : 1u; nx = cnt > 0u ? cnt : 1u;
}
DI void xcd_barrier(const XcdBarrier& b) {
  asm volatile("s_waitcnt vmcnt(0)" ::: "memory");
  __syncthreads();
  if (threadIdx.x == 0) {
    unsigned* bar = b.bar;
    __builtin_amdgcn_s_waitcnt(0);
    unsigned nloc = b.st[0], nx = b.st[1];
    if (nloc == 0u) { xcd_barrier_complete(bar, b.x, nloc, nx); b.st[0] = nloc; b.st[1] = nx; }
    const unsigned old = xb_add(&bar[XB_XSUB(b.x)], 1u);
    const unsigned gen = old / nloc;
    if (old + 1u == (gen + 1u) * nloc) {
      __builtin_amdgcn_fence(__ATOMIC_RELEASE, "agent");
      asm volatile("s_waitcnt vmcnt(0)" ::: "memory");
      const unsigned og = xb_add(&bar[XB_TOP], 1u);
      const unsigned tg = og / nx;
      if (og + 1u == (tg + 1u) * nx) xb_add(&bar[XB_TOPGEN], 1u);
      else XB_SPIN(xb_ld(&bar[XB_TOPGEN]) == tg, bar);
      __builtin_amdgcn_fence(__ATOMIC_ACQUIRE, "agent");
      xb_add(&bar[XB_XGEN(b.x)], 1u);
      asm volatile("s_waitcnt vmcnt(0)" ::: "memory");
    } else {
      XB_SPIN(xb_ld(&bar[XB_XGEN(b.x)]) == gen, bar);
      __builtin_amdgcn_fence(__ATOMIC_ACQUIRE, "agent");
      asm volatile("s_waitcnt vmcnt(0)" ::: "memory");
    }
  }
  __syncthreads();
}

__global__ void __launch_bounds__(NTHR, 2) mega(Params p) {
  __shared__ __attribute__((aligned(16))) char lds[73728];
  cg::grid_group grid = cg::this_grid();
  const int tid0 = threadIdx.x, bid0 = blockIdx.x, nb = gridDim.x;
  __shared__ uint4 xb_words;
  if (tid0 == 0) xb_words = make_uint4(0u, 0u, 0u, 0u);
  __syncthreads();
  const XcdBarrier xb = xcd_barrier_post(p.bar, (volatile LAS unsigned*)&xb_words);
  int pc = 0;
#define PHASE(...)                                      \
  {                                                     \
    if (pc >= p.pb && pc < p.pe) {                      \
      if (pc == p.pb + 1) grid.sync();                  \
      else if (pc > p.pb + 1) xcd_barrier(xb);          \
      int tid = tid0, bid = bid0;                       \
      asm volatile("" : "+v"(tid), "+s"(bid));          \
      __VA_ARGS__;                                      \
    }                                                   \
    pc++;                                               \
  }
  PHASE(phase_convert(p, lds, bid, nb, tid));
  for (int i = 0; i < REP_SYNC; i++) PHASE((void)0);
  for (int l = 0; l < 2; l++) {
    for (int sg = 0; sg < 3; sg++) {
      const int tok0 = sg * T_SUB;
      const int B = sg == 0 ? 4 : 8, N = sg == 0 ? 8192 : 4096;
      PHASE(phase_inproj(p, l, tok0, lds, bid, nb, tid));
#if REP_INPROJ || REP_GEMMS
      PHASE(phase_inproj(p, l, tok0, lds, bid, nb, tid));
#endif
      PHASE(phase_prep(p, l, N, bid, nb, tid));
      PHASE(phase_smallgemm(p, l, B, N, lds, bid, nb, tid));
#if REP_GEMMS
      PHASE(phase_smallgemm(p, l, B, N, lds, bid, nb, tid));
#endif
      PHASE(phase_mix(p, l, B, N, p.bar + XCD_BAR_WORDS + (l * 3 + sg) * 128, lds, bid, nb, tid));
#if REP_MIX
      PHASE(phase_mix(p, l, B, N, p.bar + XCD_BAR_WORDS + (6 + l * 3 + sg) * 128, lds, bid, nb, tid));
#endif
      PHASE(phase_final(p, l, bid, nb, tid));
      PHASE(phase_wout(p, l, tok0, lds, bid, nb, tid));
      PHASE(phase_ln<true>(p, p.ln1_g + l * 1024, p.ln1_b + l * 1024, p.moe_router + (size_t)l * 16384, tok0, T_SUB, lds, bid, nb, tid));
    }
    PHASE(phase_topk(p, lds, bid, nb, tid));
    PHASE(phase_moe1(p, l, lds, bid, nb, tid));
#if REP_MOE1 || REP_GEMMS
    PHASE(phase_moe1(p, l, lds, bid, nb, tid));
#endif
    PHASE(phase_moe2(p, l, lds, bid, nb, tid));
#if REP_GEMMS
    PHASE(phase_moe2(p, l, lds, bid, nb, tid));
#endif
    PHASE(phase_combine(p, bid, nb, tid));
    PHASE(phase_ple(p, l, lds, bid, nb, tid));
    PHASE(phase_ln<false>(p, p.ln2_g + l * 1024, p.ln2_b + l * 1024, nullptr, 0, T_ALL, lds, bid, nb, tid));
  }
}

#define N_PHASES 1000
#ifndef FUSED
#define FUSED 1
#endif

extern "C" void kernel_launch(void* const* d_in, const int* in_sizes, int n_in, void* d_out, int out_size, void* d_ws,
                              size_t ws_size, hipStream_t stream) {
  static int grid_blocks = 0;
  if (!grid_blocks) {
    int dev = 0, cus = 0, per_cu = 0;
    (void)hipGetDevice(&dev);
    (void)hipDeviceGetAttribute(&cus, hipDeviceAttributeMultiprocessorCount, dev);
    (void)hipOccupancyMaxActiveBlocksPerMultiprocessor(&per_cu, mega, NTHR, 0);
    if (per_cu > 2) per_cu = 2;
    if (per_cu < 1) per_cu = 1;
    grid_blocks = cus * per_cu;
  }
  Params p;
  memset(&p, 0, sizeof(p));
  const float* const* in = (const float* const*)d_in;
  int k = 0;
  p.x_prompt = in[k++]; p.x_sample = in[k++]; p.p_prompt = in[k++]; p.p_sample = in[k++];
  p.w_in = in[k++]; p.mla_gq = in[k++]; p.mla_gkv = in[k++]; p.mla_wuq = in[k++]; p.mla_wuk = in[k++]; p.mla_wuv = in[k++];
  p.na_bias = in[k++]; p.hg_lb = in[k++]; p.hg_gnorm = in[k++];
  p.rw_mu = in[k++]; p.rw_w0 = in[k++]; p.rw_w_up = in[k++]; p.rw_a0 = in[k++]; p.rw_a_up = in[k++]; p.rw_g_up = in[k++];
  p.rw_kk = in[k++]; p.rw_ka = in[k++]; p.rw_rk = in[k++]; p.rw_ln_w = in[k++]; p.rw_ln_b = in[k++];
  p.w_out = in[k++]; p.ln1_g = in[k++]; p.ln1_b = in[k++]; p.moe_router = in[k++]; p.moe_w1 = in[k++]; p.moe_w3 = in[k++];
  p.moe_w2 = in[k++]; p.ln2_g = in[k++]; p.ln2_b = in[k++]; p.ple_gate = in[k++]; p.ple_proj = in[k++];
  p.out = (float*)d_out;
  char* ws = (char*)d_ws;
  size_t off = 0;
  auto take = [&](size_t bytes) { char* r = ws + off; off += (bytes + 255) & ~(size_t)255; return r; };
  p.w_in_t = (u16*)take((size_t)2 * 3712 * 1024 * 2);
  p.wuq_t = (u16*)take((size_t)2 * 384 * 256 * 2);
  p.wkv_t = (u16*)take((size_t)2 * 512 * 128 * 2);
  p.wup_t = (u16*)take((size_t)4 * 256 * 64 * 2);
  p.aup_t = (u16*)take((size_t)4 * 256 * 64 * 2);
  p.gup_t = (u16*)take((size_t)2 * 256 * 128 * 2);
  p.wout_t = (u16*)take((size_t)2 * 1024 * 1024 * 2);
  p.w13_t = (u16*)take((size_t)32 * 1024 * 1024 * 2);
  p.w2_t = (u16*)take((size_t)32 * 1024 * 512 * 2);
  p.wg_t = (u16*)take((size_t)2 * 1024 * 1024 * 2);
  p.wp_t = (u16*)take((size_t)2 * 1024 * 256 * 2);
  p.ropec = (float*)take((size_t)8192 * 16 * 4);
  p.ropes = (float*)take((size_t)8192 * 16 * 4);
  p.lb = (float*)take(1024 * 4);
  p.affT = (float*)take((size_t)16 * T_ALL * 4);
  p.gate = (float*)take((size_t)196608 * 4);
  p.idx = (int*)take((size_t)196608 * 4);
  p.bar = (unsigned*)take((size_t)(XCD_BAR_WORDS + 12 * 128) * 4);
  p.inv_cnt = (int*)take((size_t)T_ALL * 4);
  p.inv_slot = (int*)take((size_t)T_ALL * 16 * 4);
  p.xb = (u16*)take((size_t)T_ALL * 1024 * 2);
  const size_t stage0 = off;
  p.z = (u16*)take((size_t)T_SUB * ZLD * 2);
  p.cat = (u16*)take((size_t)T_SUB * 1024 * 2);
  p.Q = (u16*)take((size_t)T_SUB * 384 * 2);
  p.Kb = (u16*)take((size_t)T_SUB * 384 * 2);
  p.Vt = (u16*)take((size_t)T_SUB * 256 * 2);
  p.cqn = (u16*)take((size_t)T_SUB * 256 * 2);
  p.ckvn = (u16*)take((size_t)T_SUB * 128 * 2);
  p.S1 = (u16*)take((size_t)T_SUB * 384 * 2);
  p.rs = (u16*)take((size_t)T_SUB * 256 * 2);
  p.ks = (u16*)take((size_t)T_SUB * 256 * 2);
  p.vs = (u16*)take((size_t)T_SUB * 256 * 2);
  p.kk = (u16*)take((size_t)T_SUB * 256 * 2);
  p.gD = (u16*)take((size_t)T_SUB * 256 * 2);
  p.dec = (u16*)take((size_t)2 * T_SUB * 256 * 2);
  p.kka = (u16*)take((size_t)2 * T_SUB * 256 * 2);
  p.kt = (u16*)take((size_t)2 * T_SUB * 256 * 2);
  p.oC = (u16*)take((size_t)2 * T_SUB * 256 * 2);
  p.oD = (u16*)take((size_t)2 * T_SUB * 256 * 2);
  p.bonus = (float*)take((size_t)T_SUB * 4 * 4);
  off = stage0;
  p.O = (u16*)take((size_t)196608 * 1024 * 2);
  p.H = (u16*)take((size_t)196608 * 512 * 2);
  for (int i = 0; i < 16; i++) p.inv_freq[i] = pow(10000.0, -(double)i / 16.0);
  (void)hipMemsetAsync(p.bar, 0, (size_t)(XCD_BAR_WORDS + 12 * 128) * 4, stream);
#if FUSED
  p.pb = 0;
  p.pe = N_PHASES;
  {
    void* args[] = {&p};
    hipError_t e = hipLaunchCooperativeKernel((void*)mega, dim3(grid_blocks), dim3(NTHR), args, 0, stream);
    if (e != hipSuccess) fprintf(stderr, "cooperative launch failed: %s (grid %d)\n", hipGetErrorString(e), grid_blocks);
  }
#else
  for (int ph = 0; ph < N_PHASES; ph++) {
    p.pb = ph;
    p.pe = ph + 1;
    void* args[] = {&p};
    hipError_t e = hipLaunchCooperativeKernel((void*)mega, dim3(grid_blocks), dim3(NTHR), args, 0, stream);
    if (e != hipSuccess) fprintf(stderr, "cooperative launch failed: %s (grid %d)\n", hipGetErrorString(e), grid_blocks);
  }
#endif
}
```

```cpp
#include <hip/hip_runtime.h>
#include <hip/hip_cooperative_groups.h>
#include <cstdio>
#include <cmath>
#include <cstring>
namespace cg = cooperative_groups;

typedef unsigned short u16;
using bf16x8 = __attribute__((ext_vector_type(8))) short;
using f32x4 = __attribute__((ext_vector_type(4))) float;
using f32x16 = __attribute__((ext_vector_type(16))) float;

#define REP_INPROJ 0
#define REP_ATTN 0
#define REP_NA 0
#define REP_SCAN 0
#define REP_MOE1 0
#define REP_MOE2 0
#define REP_SYNC 0
#define REP_MIX 0
#define REP_GEMMS 0
#define DI __device__ __forceinline__
#define NTHR 256
#define T_ALL 98304
#define T_SUB 32768
#define ZLD 3616
#define ZB_OFF 416
#define ZC_OFF 1184
#define ZD_OFF 2464
#define LOG2E 1.4426950408889634f
#define ALPHA_F 1.4142135623730951f

struct Params {
  const float *x_prompt, *x_sample, *p_prompt, *p_sample;
  const float *w_in, *mla_gq, *mla_gkv, *mla_wuq, *mla_wuk, *mla_wuv, *na_bias, *hg_lb, *hg_gnorm;
  const float *rw_mu, *rw_w0, *rw_w_up, *rw_a0, *rw_a_up, *rw_g_up, *rw_kk, *rw_ka, *rw_rk, *rw_ln_w, *rw_ln_b;
  const float *w_out, *ln1_g, *ln1_b, *moe_router, *moe_w1, *moe_w3, *moe_w2, *ln2_g, *ln2_b, *ple_gate, *ple_proj;
  float* out;
  u16 *w_in_t, *wuq_t, *wkv_t, *wup_t, *aup_t, *gup_t, *wout_t, *w13_t, *w2_t, *wg_t, *wp_t;
  float *ropec, *ropes, *lb, *affT, *gate;
  int* idx;
  unsigned* bar;
  int *inv_cnt, *inv_slot;
  u16 *z, *cat, *Q, *Kb, *Vt, *cqn, *ckvn, *S1, *rs, *ks, *vs, *kk, *gD, *dec, *kka, *kt, *oC, *oD;
  float* bonus;
  u16* xb;
  u16* O;
  u16* H;
  double inv_freq[16];
  int pb, pe;
};

typedef __bf16 v2bf_t __attribute__((ext_vector_type(2)));
typedef float v2f_t __attribute__((ext_vector_type(2)));
typedef unsigned u32x4_t __attribute__((ext_vector_type(4)));
DI unsigned pack2(float a, float b) {
  v2f_t f = {a, b};
  v2bf_t h = __builtin_convertvector(f, v2bf_t);
  return __builtin_bit_cast(unsigned, h);
}
DI u16 f2bf(float f) { return (u16)(pack2(f, 0.f) & 0xffffu); }
DI float bf2f(u16 h) { return __uint_as_float(((unsigned)h) << 16); }
DI float blo(unsigned u) { return __uint_as_float(u << 16); }
DI float bhi(unsigned u) { return __uint_as_float(u & 0xffff0000u); }
DI float sigm(float x) { return 1.f / (1.f + __expf(-x)); }
DI float tanh_(float x) { return 1.f - 2.f / (__expf(2.f * x) + 1.f); }
DI float ex2(float x) { return __builtin_amdgcn_exp2f(x); }
DI int clampi(int v, int lo, int hi) { return v < lo ? lo : (v > hi ? hi : v); }
DI int swap23(int x) { return (x & ~12) | ((x & 4) << 1) | ((x & 8) >> 1); }

template <int CTRL> DI float dpp_f(float v) {
  return __int_as_float(__builtin_amdgcn_update_dpp(0, __float_as_int(v), CTRL, 0xF, 0xF, true));
}
DI float reduce16(float v) {
  v += dpp_f<0xB1>(v);
  v += dpp_f<0x4E>(v);
  v += dpp_f<0x141>(v);
  v += dpp_f<0x140>(v);
  return v;
}
DI float wave_sum(float v) {
  v = reduce16(v);
  v += __shfl_xor(v, 16);
  v += __shfl_xor(v, 32);
  return v;
}

struct TileIter {
  int bid, nb, off;
  DI int first(int n) { int f = bid - off; if (f < 0) f += nb; off = (off + n) % nb; return f; }
};

DI bool xcd_tile(int it, int bid, int nb, int MT, int NT, int& mt, int& nt) {
  const int x = bid & 7, slot = bid >> 3, nslots = nb >> 3;
  const int mper = MT >> 3;
  const int i = slot + it * nslots;
  if (i >= mper * NT) return false;
  const int mi = i & 7, rest = i >> 3;
  nt = rest % NT;
  mt = x * mper + (rest / NT) * 8 + mi;
  return true;
}

DI void convT_job(const float* __restrict__ W, int K, int N, int Npad, u16* __restrict__ Wt, int mode, char* lds,
                  TileIter& it, int tid) {
  float(*tile)[65] = (float(*)[65])lds;
  int tk = K >> 6, tn = Npad >> 6;
  int nt = tk * tn;
  for (int t = it.first(nt); t < nt; t += it.nb) {
    int k0 = (t % tk) << 6, n0 = (t / tk) << 6;
#pragma unroll
    for (int i = 0; i < 16; i++) {
      int kl = (tid >> 6) + 4 * i, nl = tid & 63;
      int n = n0 + nl;
      tile[kl][nl] = (n < N) ? W[(size_t)(k0 + kl) * N + n] : 0.f;
    }
    __syncthreads();
    {
      int nl = tid >> 2, ks = (tid & 3) * 16;
      int n = n0 + nl;
      int row = n;
      if (mode == 1) row = (n >> 4) * 32 + (n & 15);
      if (mode == 2) row = (n >> 4) * 32 + 16 + (n & 15);
      unsigned pk[8];
#pragma unroll
      for (int j = 0; j < 8; j++) pk[j] = pack2(tile[ks + 2 * j][nl], tile[ks + 2 * j + 1][nl]);
      uint4* dst = (uint4*)(Wt + (size_t)row * K + k0 + ks);
      dst[0] = make_uint4(pk[0], pk[1], pk[2], pk[3]);
      dst[1] = make_uint4(pk[4], pk[5], pk[6], pk[7]);
    }
    __syncthreads();
  }
}

DI void phase_convert(const Params& p, char* lds, int bid, int nb, int tid) {
  TileIter it{bid, nb, 0};
  for (int l = 0; l < 2; l++) {
    convT_job(p.w_in + (size_t)l * 1024 * 3616, 1024, 3616, 3712, p.w_in_t + (size_t)l * 3712 * 1024, 0, lds, it, tid);
    convT_job(p.mla_wuq + (size_t)l * 256 * 384, 256, 384, 384, p.wuq_t + (size_t)l * 384 * 256, 0, lds, it, tid);
    convT_job(p.mla_wuk + (size_t)l * 128 * 256, 128, 256, 256, p.wkv_t + (size_t)l * 512 * 128, 0, lds, it, tid);
    convT_job(p.mla_wuv + (size_t)l * 128 * 256, 128, 256, 256, p.wkv_t + (size_t)l * 512 * 128 + 256 * 128, 0, lds, it, tid);
    for (int d = 0; d < 2; d++) {
      convT_job(p.rw_w_up + (size_t)(l * 2 + d) * 64 * 256, 64, 256, 256, p.wup_t + (size_t)(l * 2 + d) * 256 * 64, 0, lds, it, tid);
      convT_job(p.rw_a_up + (size_t)(l * 2 + d) * 64 * 256, 64, 256, 256, p.aup_t + (size_t)(l * 2 + d) * 256 * 64, 0, lds, it, tid);
    }
    convT_job(p.rw_g_up + (size_t)l * 128 * 256, 128, 256, 256, p.gup_t + (size_t)l * 256 * 128, 0, lds, it, tid);
    convT_job(p.w_out + (size_t)l * 1024 * 1024, 1024, 1024, 1024, p.wout_t + (size_t)l * 1024 * 1024, 0, lds, it, tid);
    for (int e = 0; e < 16; e++) {
      size_t le = (size_t)(l * 16 + e);
      convT_job(p.moe_w1 + le * 1024 * 512, 1024, 512, 512, p.w13_t + le * 1024 * 1024, 1, lds, it, tid);
      convT_job(p.moe_w3 + le * 1024 * 512, 1024, 512, 512, p.w13_t + le * 1024 * 1024, 2, lds, it, tid);
      convT_job(p.moe_w2 + le * 512 * 1024, 512, 1024, 1024, p.w2_t + le * 1024 * 512, 0, lds, it, tid);
    }
    convT_job(p.ple_gate + (size_t)l * 1024 * 1024, 1024, 1024, 1024, p.wg_t + (size_t)l * 1024 * 1024, 0, lds, it, tid);
    convT_job(p.ple_proj + (size_t)l * 256 * 1024, 256, 1024, 1024, p.wp_t + (size_t)l * 1024 * 256, 0, lds, it, tid);
  }
  int gt = bid * NTHR + tid, ng = nb * NTHR;
  for (size_t i0 = gt; i0 < (size_t)T_ALL * 256; i0 += (size_t)ng * 8) {
    float4 v[8];
#pragma unroll
    for (int u = 0; u < 8; u++) {
      const size_t i = i0 + (size_t)u * ng;
      v[u] = make_float4(0.f, 0.f, 0.f, 0.f);
      if (i < (size_t)T_ALL * 256)
        v[u] = (i < (size_t)32768 * 256) ? ((const float4*)p.x_prompt)[i] : ((const float4*)p.x_sample)[i - (size_t)32768 * 256];
    }
#pragma unroll
    for (int u = 0; u < 8; u++) {
      const size_t i = i0 + (size_t)u * ng;
      if (i < (size_t)T_ALL * 256) ((uint2*)p.xb)[i] = make_uint2(pack2(v[u].x, v[u].y), pack2(v[u].z, v[u].w));
    }
  }
  for (int i = gt; i < 8192 * 16; i += ng) {
    int n = i >> 4, f = i & 15;
    double ifq = 0.0;
#pragma unroll
    for (int j = 0; j < 16; j++) ifq = (f == j) ? p.inv_freq[j] : ifq;
    double rev = (double)n * ifq * 0.15915494309189535;
    double fr = rev - rint(rev);
    float ff = (float)fr;
    p.ropec[i] = __builtin_amdgcn_cosf(ff);
    p.ropes[i] = __builtin_amdgcn_sinf(ff);
  }
  for (int i = gt; i < 512; i += ng) {
    float h0 = p.hg_lb[i], h1 = p.hg_lb[512 + i];
    p.lb[i] = 0.f;
    p.lb[512 + i] = 1.f / (1.f + __expf(h0 - h1));
  }
}

constexpr int G_STAGE = 32768;

template <bool AF32, class RowFn, class Epi>
DI void gemm_tile(RowFn rowfn, const u16* __restrict__ Bt, int K, Epi epi, char* lds, int tid) {
  const int lane = tid & 63, wid = tid >> 6, wr = wid >> 1, wc = wid & 1, fr = lane & 15, fq = lane >> 4;
  f32x4 acc[4][4];
#pragma unroll
  for (int m = 0; m < 4; m++)
#pragma unroll
    for (int n = 0; n < 4; n++) acc[m][n] = f32x4{0.f, 0.f, 0.f, 0.f};

  const int lrow = tid >> 3;
  const int lc = (tid & 7) ^ ((tid >> 4) & 7);
  const float* apf[8];
  const u16* aph[4];
  const u16* bp[4];
  if constexpr (AF32) {
#pragma unroll
    for (int i = 0; i < 8; i++) apf[i] = (const float*)rowfn(i * 16 + (tid >> 4)) + (tid & 15) * 4;
  } else {
#pragma unroll
    for (int i = 0; i < 4; i++) aph[i] = (const u16*)rowfn(lrow + i * 32) + lc * 8;
  }
#pragma unroll
  for (int i = 0; i < 4; i++) bp[i] = Bt + (size_t)(lrow + i * 32) * K + lc * 8;
  const int afoff = (tid >> 4) * 128 + ((((tid & 15) >> 1) ^ ((tid >> 5) & 7)) * 16) + (tid & 1) * 8;

  float4 raf[8];
  auto issue = [&](int buf, int k0) {
    char* A = lds + buf * G_STAGE;
    char* B = A + 16384;
#pragma unroll
    for (int i = 0; i < 4; i++)
      __builtin_amdgcn_global_load_lds((const unsigned*)(bp[i] + k0), (unsigned*)(B + wid * 1024 + i * 4096), 16, 0, 0);
    if constexpr (AF32) {
#pragma unroll
      for (int i = 0; i < 8; i++) raf[i] = *(const float4*)(apf[i] + k0);
    } else {
#pragma unroll
      for (int i = 0; i < 4; i++)
        __builtin_amdgcn_global_load_lds((const unsigned*)(aph[i] + k0), (unsigned*)(A + wid * 1024 + i * 4096), 16, 0, 0);
    }
  };
  auto astore = [&](int buf) {
    if constexpr (AF32) {
      char* A = lds + buf * G_STAGE;
#pragma unroll
      for (int i = 0; i < 8; i++) asm volatile("" : "+v"(raf[i].x), "+v"(raf[i].y), "+v"(raf[i].z), "+v"(raf[i].w));
#pragma unroll
      for (int i = 0; i < 8; i++)
        *(uint2*)(A + afoff + i * 2048) = make_uint2(pack2(raf[i].x, raf[i].y), pack2(raf[i].z, raf[i].w));
    }
  };
  const int abase = (wr * 64 + fr) * 128, bbase = 16384 + (wc * 64 + fr) * 128;
  const int sw0 = ((fq) ^ (fr >> 1)) * 16, sw1 = ((4 + fq) ^ (fr >> 1)) * 16;

  const int nk = K >> 6;
  if constexpr (AF32) {
    issue(0, 0);
    astore(0);
    __syncthreads();
    for (int kt = 0; kt < nk; kt++) {
      const char* S = lds + (kt & 1) * G_STAGE;
      bf16x8 af[2][4], bfr[2][4];
#pragma unroll
      for (int kk = 0; kk < 2; kk++) {
        const int sw = kk ? sw1 : sw0;
#pragma unroll
        for (int m = 0; m < 4; m++) af[kk][m] = *(const bf16x8*)(S + abase + m * 2048 + sw);
#pragma unroll
        for (int n = 0; n < 4; n++) bfr[kk][n] = *(const bf16x8*)(S + bbase + n * 2048 + sw);
      }
      __builtin_amdgcn_sched_barrier(0);
      if (kt + 1 < nk) issue((kt + 1) & 1, (kt + 1) << 6);
      __builtin_amdgcn_sched_barrier(0);
#pragma unroll
      for (int kk = 0; kk < 2; kk++)
#pragma unroll
        for (int m = 0; m < 4; m++)
#pragma unroll
          for (int n = 0; n < 4; n++) acc[m][n] = __builtin_amdgcn_mfma_f32_16x16x32_bf16(bfr[kk][n], af[kk][m], acc[m][n], 0, 0, 0);
      __builtin_amdgcn_sched_barrier(0);
      if (kt + 1 < nk) astore((kt + 1) & 1);
      __syncthreads();
    }
  } else {
    const unsigned lds0 = (unsigned)(size_t)(__attribute__((address_space(3))) char*)lds;
    const unsigned aA0 = lds0 + abase + sw0, aA1 = lds0 + abase + sw1, aB0 = lds0 + bbase + sw0, aB1 = lds0 + bbase + sw1;
#define G_DSR(dst, addr, off) asm volatile("ds_read_b128 %0, %1 offset:%2" : "=v"(dst) : "v"(addr), "n"(off))
    issue(0, 0);
    if (nk > 1) issue(1, 64);
    for (int kt = 0; kt < nk; kt++) {
      if (kt + 1 < nk) asm volatile("s_waitcnt vmcnt(8)" ::: "memory");
      else asm volatile("s_waitcnt vmcnt(0)" ::: "memory");
      __builtin_amdgcn_s_barrier();
      const unsigned so = (kt & 1) * G_STAGE;
      const unsigned pA0 = aA0 + so, pA1 = aA1 + so, pB0 = aB0 + so, pB1 = aB1 + so;
      bf16x8 a00, a01, a02, a03, a10, a11, a12, a13, b00, b01, b02, b03, b10, b11, b12, b13;
      G_DSR(a00, pA0, 0); G_DSR(a01, pA0, 2048); G_DSR(a02, pA0, 4096); G_DSR(a03, pA0, 6144);
      G_DSR(b00, pB0, 0); G_DSR(b01, pB0, 2048); G_DSR(b02, pB0, 4096); G_DSR(b03, pB0, 6144);
      G_DSR(a10, pA1, 0); G_DSR(a11, pA1, 2048); G_DSR(a12, pA1, 4096); G_DSR(a13, pA1, 6144);
      G_DSR(b10, pB1, 0); G_DSR(b11, pB1, 2048); G_DSR(b12, pB1, 4096); G_DSR(b13, pB1, 6144);
      asm volatile("s_waitcnt lgkmcnt(0)" : "+v"(a00), "+v"(a01), "+v"(a02), "+v"(a03), "+v"(b00), "+v"(b01), "+v"(b02), "+v"(b03));
      asm volatile("" : "+v"(a10), "+v"(a11), "+v"(a12), "+v"(a13), "+v"(b10), "+v"(b11), "+v"(b12), "+v"(b13));
      __builtin_amdgcn_s_barrier();
      if (kt + 2 < nk) issue(kt & 1, (kt + 2) << 6);
      __builtin_amdgcn_sched_barrier(0);
      {
        const bf16x8 af0[4] = {a00, a01, a02, a03}, af1[4] = {a10, a11, a12, a13};
        const bf16x8 bf0[4] = {b00, b01, b02, b03}, bf1[4] = {b10, b11, b12, b13};
#pragma unroll
        for (int m = 0; m < 4; m++)
#pragma unroll
          for (int n = 0; n < 4; n++) acc[m][n] = __builtin_amdgcn_mfma_f32_16x16x32_bf16(bf0[n], af0[m], acc[m][n], 0, 0, 0);
#pragma unroll
        for (int m = 0; m < 4; m++)
#pragma unroll
          for (int n = 0; n < 4; n++) acc[m][n] = __builtin_amdgcn_mfma_f32_16x16x32_bf16(bf1[n], af1[m], acc[m][n], 0, 0, 0);
      }
      __builtin_amdgcn_sched_barrier(0);
    }
  }
  epi(acc, wr * 64 + fr, wc * 64 + fq * 4);
}

#define EPI_LOOP(...)                                    \
  _Pragma("unroll") for (int m = 0; m < 4; m++)          \
  _Pragma("unroll") for (int n = 0; n < 4; n++) {        \
    const int row = rbase + m * 16;                      \
    const int col = cbase + n * 16;                      \
    const f32x4 v = acc[m][n];                           \
    __VA_ARGS__                                          \
  }

DI void st_bf4(u16* dst, f32x4 v) { *(uint2*)dst = make_uint2(pack2(v[0], v[1]), pack2(v[2], v[3])); }

DI void epi_store_rows_bf16(f32x4 (&acc)[4][4], int rbase, int cbase, char* lds, int tid, u16* dst, size_t ld, int ncols) {
#pragma unroll
  for (int m = 0; m < 4; m++)
#pragma unroll
    for (int n = 0; n < 4; n++)
      *(uint2*)(lds + (rbase + m * 16) * 272 + (cbase + n * 16) * 2) =
          make_uint2(pack2(acc[m][n][0], acc[m][n][1]), pack2(acc[m][n][2], acc[m][n][3]));
  __syncthreads();
#pragma unroll
  for (int i = 0; i < 8; i++) {
    const int id = tid + 256 * i, row = id >> 4, c = id & 15;
    if (c * 8 < ncols) *(uint4*)(dst + (size_t)row * ld + c * 8) = *(const uint4*)(lds + row * 272 + c * 16);
  }
  __syncthreads();
}

DI const float* xin_row(const Params& p, int l, int tg) {
  if (l == 0) return tg < 32768 ? p.x_prompt + (size_t)tg * 1024 : p.x_sample + (size_t)(tg - 32768) * 1024;
  return p.out + (size_t)tg * 1024;
}

DI void phase_inproj(const Params& p, int l, int tok0, char* lds, int bid, int nb, int tid) {
  const int NT = 29, MT = T_SUB / 128;
  for (int it = 0;; it++) {
    int nt, mt;
    if (!xcd_tile(it, bid, nb, MT, NT, mt, nt)) break;
    int m0 = mt * 128, n0 = nt * 128;
    auto rowfn = [&](int r) -> const void* { return p.xb + (size_t)(tok0 + m0 + r) * 1024; };
    u16* z = p.z;
    auto epi = [&](f32x4(&acc)[4][4], int rbase, int cbase) {
      epi_store_rows_bf16(acc, rbase, cbase, lds, tid, z + (size_t)m0 * ZLD + n0, ZLD, min(128, ZLD - n0));
    };
    gemm_tile<false>(rowfn, p.w_in_t + ((size_t)l * 3712 + n0) * 1024, 1024, epi, lds, tid);
  }
}

struct PrepIn {
  uint2 cq;
  unsigned ckv;
  u16 kr1, kr2;
  float rc, rsn;
  uint4 f;
  uint2 cur[3], prv[3], nxt[3];
  u16 sc[6], sp[6], sn[6];
};
DI void prep_load(PrepIn& in, const Params& p, int t, int N, int lane) {
  const int l15 = lane & 15, c4 = lane * 4;
  const u16* zr = p.z + (size_t)t * ZLD;
  const int n = t & (N - 1);
  const bool hp = n > 0, hn = n < N - 1;
  const u16* zd = zr + ZD_OFF;
  const u16* zdp = zd - (hp ? ZLD : 0);
  const u16* zdn = zd + (hn ? ZLD : 0);
  in.cq = *(const uint2*)(zr + c4);
  in.ckv = *(const unsigned*)(zr + 256 + lane * 2);
  in.kr1 = zr[384 + l15];
  in.kr2 = zr[400 + l15];
  in.rc = p.ropec[n * 16 + l15];
  in.rsn = p.ropes[n * 16 + l15];
  in.f = *(const uint4*)(zr + ZC_OFF + 256 + lane * 8);
#pragma unroll
  for (int part = 0; part < 3; part++) {
    in.cur[part] = *(const uint2*)(zd + part * 256 + c4);
    in.prv[part] = *(const uint2*)(zdp + part * 256 + c4);
    in.nxt[part] = *(const uint2*)(zdn + part * 256 + c4);
  }
#pragma unroll
  for (int i = 0; i < 6; i++) {
    in.sc[i] = zd[768 + lane + 64 * i];
    in.sp[i] = zdp[768 + lane + 64 * i];
    in.sn[i] = zdn[768 + lane + 64 * i];
  }
}

DI void phase_prep(const Params& p, int l, int N, int bid, int nb, int tid) {
  const int lane = tid & 63, wv = tid >> 6, l15 = lane & 15, c4 = lane * 4;
  float gqv[4], gkvv[2], lbv[8], m0[12], m1[12], m0s[6], m1s[6], kkc[4], rkc[4];
  {
    const float* mu0 = p.rw_mu + (size_t)l * 2 * 1152;
    const float* mu1 = mu0 + 1152;
#pragma unroll
    for (int j = 0; j < 4; j++) {
      gqv[j] = p.mla_gq[l * 256 + c4 + j];
      kkc[j] = p.rw_kk[l * 256 + c4 + j];
      rkc[j] = p.rw_rk[l * 256 + c4 + j];
    }
    gkvv[0] = p.mla_gkv[l * 128 + lane * 2];
    gkvv[1] = p.mla_gkv[l * 128 + lane * 2 + 1];
#pragma unroll
    for (int j = 0; j < 8; j++) lbv[j] = p.lb[l * 512 + lane * 8 + j];
#pragma unroll
    for (int part = 0; part < 3; part++)
#pragma unroll
      for (int j = 0; j < 4; j++) {
        m0[part * 4 + j] = mu0[part * 256 + c4 + j];
        m1[part * 4 + j] = mu1[part * 256 + c4 + j];
      }
#pragma unroll
    for (int i = 0; i < 6; i++) {
      m0s[i] = mu0[768 + lane + 64 * i];
      m1s[i] = mu1[768 + lane + 64 * i];
    }
  }
  PrepIn in, inn;
  {
    const int t0 = bid * 4 + wv;
    if (t0 < T_SUB) prep_load(in, p, t0, N, lane);
  }
  for (int t = bid * 4 + wv; t < T_SUB; t += nb * 4) {
    u16* zr = p.z + (size_t)t * ZLD;
    const int n = t & (N - 1);
    const bool hp = n > 0, hn = n < N - 1;
    {
      const int tn = t + nb * 4;
      if (tn < T_SUB) prep_load(inn, p, tn, N, lane);
      else inn = in;
    }
    const uint2 raw_cq = in.cq;
    const unsigned raw_ckv = in.ckv;
    const u16 kr1 = in.kr1, kr2 = in.kr2;
    const float rc = in.rc, rsn = in.rsn;
    uint4* fptr = (uint4*)(zr + ZC_OFF + 256 + lane * 8);
    const uint4 raw_f = in.f;
    uint2 cur[3], prv[3], nxt[3];
    u16 sc[6], sp[6], sn[6];
#pragma unroll
    for (int part = 0; part < 3; part++) { cur[part] = in.cur[part]; prv[part] = in.prv[part]; nxt[part] = in.nxt[part]; }
#pragma unroll
    for (int i = 0; i < 6; i++) { sc[i] = in.sc[i]; sp[i] = in.sp[i]; sn[i] = in.sn[i]; }
    {
      float v0 = blo(raw_cq.x), v1 = bhi(raw_cq.x), v2 = blo(raw_cq.y), v3 = bhi(raw_cq.y);
      float ss = wave_sum(v0 * v0 + v1 * v1 + v2 * v2 + v3 * v3);
      float ri = rsqrtf(ss * (1.f / 256.f) + 1e-6f);
      *(uint2*)(p.cqn + (size_t)t * 256 + c4) =
          make_uint2(pack2(v0 * ri * gqv[0], v1 * ri * gqv[1]), pack2(v2 * ri * gqv[2], v3 * ri * gqv[3]));
    }
    {
      float v0 = blo(raw_ckv), v1 = bhi(raw_ckv);
      float ss = wave_sum(v0 * v0 + v1 * v1);
      float ri = rsqrtf(ss * (1.f / 128.f) + 1e-6f);
      *(unsigned*)(p.ckvn + (size_t)t * 128 + lane * 2) = pack2(v0 * ri * gkvv[0], v1 * ri * gkvv[1]);
    }
    if (lane < 16) {
      float x1 = bf2f(kr1), x2 = bf2f(kr2);
      u16 k1 = f2bf(x1 * rc - x2 * rsn), k2 = f2bf(x1 * rsn + x2 * rc);
      u16* kb = p.Kb + (size_t)t * 384;
#pragma unroll
      for (int h = 0; h < 4; h++) {
        kb[h * 96 + 64 + lane] = k1;
        kb[h * 96 + 80 + lane] = k2;
      }
    }
    {
      unsigned w[4] = {raw_f.x, raw_f.y, raw_f.z, raw_f.w};
#pragma unroll
      for (int j = 0; j < 4; j++) {
        float a = blo(w[j]), bq = bhi(w[j]);
        float la = lbv[2 * j], lb2 = lbv[2 * j + 1];
        a = la + (1.f - la) * sigm(a);
        bq = lb2 + (1.f - lb2) * sigm(bq);
        w[j] = pack2(a, bq);
      }
      *fptr = make_uint4(w[0], w[1], w[2], w[3]);
    }
    {
      float rr[4], kx[4], vx[4];
#pragma unroll
      for (int part = 0; part < 3; part++) {
        float cz[4] = {blo(cur[part].x), bhi(cur[part].x), blo(cur[part].y), bhi(cur[part].y)};
        float pz[4] = {blo(prv[part].x), bhi(prv[part].x), blo(prv[part].y), bhi(prv[part].y)};
        float nz[4] = {blo(nxt[part].x), bhi(nxt[part].x), blo(nxt[part].y), bhi(nxt[part].y)};
#pragma unroll
        for (int j = 0; j < 4; j++) {
          float pzz = hp ? pz[j] : 0.f, nzz = hn ? nz[j] : 0.f;
          float o = cz[j] + m0[part * 4 + j] * (pzz - cz[j]) + m1[part * 4 + j] * (nzz - cz[j]);
          if (part == 0) rr[j] = o;
          if (part == 1) kx[j] = o;
          if (part == 2) vx[j] = o;
        }
      }
      *(uint2*)(p.rs + (size_t)t * 256 + c4) = make_uint2(pack2(rr[0], rr[1]), pack2(rr[2], rr[3]));
      *(uint2*)(p.ks + (size_t)t * 256 + c4) = make_uint2(pack2(kx[0], kx[1]), pack2(kx[2], kx[3]));
      *(uint2*)(p.vs + (size_t)t * 256 + c4) = make_uint2(pack2(vx[0], vx[1]), pack2(vx[2], vx[3]));
      float kq[4], ss = 0.f, bo = 0.f;
#pragma unroll
      for (int j = 0; j < 4; j++) {
        kq[j] = kx[j] * kkc[j];
        ss += kq[j] * kq[j];
        bo += rr[j] * kx[j] * rkc[j];
      }
      ss = reduce16(ss);
      bo = reduce16(bo);
      float inv = 1.f / fmaxf(sqrtf(ss), 1e-12f);
      *(uint2*)(p.kk + (size_t)t * 256 + c4) = make_uint2(pack2(kq[0] * inv, kq[1] * inv), pack2(kq[2] * inv, kq[3] * inv));
      if (l15 == 0) p.bonus[(size_t)t * 4 + (lane >> 4)] = bo;
#pragma unroll
      for (int i = 0; i < 6; i++) {
        float cz = bf2f(sc[i]);
        float pz = hp ? bf2f(sp[i]) : 0.f;
        float nz = hn ? bf2f(sn[i]) : 0.f;
        float o = cz + m0s[i] * (pz - cz) + m1s[i] * (nz - cz);
        if (i < 2) o = tanh_(o);
        else if (i >= 4) o = sigm(o);
        p.S1[(size_t)t * 384 + lane + 64 * i] = f2bf(o);
      }
    }
    in = inn;
  }
}

DI void phase_smallgemm(const Params& p, int l, int B, int N, char* lds, int bid, int nb, int tid) {
  TileIter it{bid, nb, 0};
  const int MT = T_SUB / 128;
  {
    const int NT = 3;
    for (int itx = 0;; itx++) {
      int nt, mt;
      if (!xcd_tile(itx, bid, nb, MT, NT, mt, nt)) break;
      int m0 = mt * 128, n0 = nt * 128;
      auto rowfn = [&](int r) -> const void* { return p.cqn + (size_t)(m0 + r) * 256; };
      u16* Q = p.Q;
      auto epi = [&](f32x4(&acc)[4][4], int rbase, int cbase) {
        const float SC = 0.10206207261596577f * LOG2E;
#pragma unroll
        for (int m = 0; m < 4; m++)
#pragma unroll
          for (int n = 0; n < 4; n++) acc[m][n] = acc[m][n] * SC;
        epi_store_rows_bf16(acc, rbase, cbase, lds, tid, Q + (size_t)m0 * 384 + n0, 384, 128);
      };
      gemm_tile<false>(rowfn, p.wuq_t + ((size_t)l * 384 + n0) * 256, 256, epi, lds, tid);
    }
  }
  {
    const int NT = 4;
    for (int itx = 0;; itx++) {
      int nt, mt;
      if (!xcd_tile(itx, bid, nb, MT, NT, mt, nt)) break;
      int m0 = mt * 128, n0 = nt * 128;
      auto rowfn = [&](int r) -> const void* { return p.ckvn + (size_t)(m0 + r) * 128; };
      u16* Kb = p.Kb;
      u16* Vt = p.Vt;
      auto epi = [&](f32x4(&acc)[4][4], int rbase, int cbase) {
        EPI_LOOP({
          int c = n0 + col;
          int tk = m0 + row;
          if (c < 256) {
            int h = c >> 6, d = c & 63;
            st_bf4(Kb + (size_t)tk * 384 + h * 96 + d, v);
          } else {
            int cc = c - 256;
            int b = tk / N, nn = tk - b * N;
            u16* dst = Vt + ((size_t)(b * 256 + cc)) * N + nn;
            dst[0] = f2bf(v[0]);
            dst[(size_t)N] = f2bf(v[1]);
            dst[(size_t)2 * N] = f2bf(v[2]);
            dst[(size_t)3 * N] = f2bf(v[3]);
          }
        })
      };
      gemm_tile<false>(rowfn, p.wkv_t + ((size_t)l * 512 + n0) * 128, 128, epi, lds, tid);
    }
  }
  for (int d = 0; d < 2; d++) {
    const int NT = 2;
    for (int itx = 0;; itx++) {
      int nt, mt;
      if (!xcd_tile(itx, bid, nb, MT, NT, mt, nt)) break;
      int m0 = mt * 128, n0 = nt * 128;
      auto rowfn = [&](int r) -> const void* { return p.S1 + (size_t)(m0 + r) * 384 + d * 64; };
      u16* dst = p.dec + (size_t)d * T_SUB * 256;
      const float* w0 = p.rw_w0 + (l * 2 + d) * 256;
      auto epi = [&](f32x4(&acc)[4][4], int rbase, int cbase) {
#pragma unroll
        for (int m = 0; m < 4; m++)
#pragma unroll
          for (int n = 0; n < 4; n++) {
            const int col = cbase + n * 16;
            for (int j = 0; j < 4; j++) acc[m][n][j] = __expf(-0.6065306597126334f * sigm(w0[n0 + col + j] + acc[m][n][j]));
          }
        epi_store_rows_bf16(acc, rbase, cbase, lds, tid, dst + (size_t)m0 * 256 + n0, 256, 128);
      };
      gemm_tile<false>(rowfn, p.wup_t + ((size_t)(l * 2 + d) * 256 + n0) * 64, 64, epi, lds, tid);
    }
  }
  for (int d = 0; d < 2; d++) {
    const int NT = 2;
    for (int itx = 0;; itx++) {
      int nt, mt;
      if (!xcd_tile(itx, bid, nb, MT, NT, mt, nt)) break;
      int m0 = mt * 128, n0 = nt * 128;
      auto rowfn = [&](int r) -> const void* { return p.S1 + (size_t)(m0 + r) * 384 + 128 + d * 64; };
      u16* dka = p.kka + (size_t)d * T_SUB * 256;
      u16* dkt = p.kt + (size_t)d * T_SUB * 256;
      const float* a0 = p.rw_a0 + (l * 2 + d) * 256;
      const float* ka = p.rw_ka + l * 256;
      const u16* kkp = p.kk;
      const u16* ksp = p.ks;
      auto epi = [&](f32x4(&acc)[4][4], int rbase, int cbase) {
#pragma unroll
        for (int m = 0; m < 4; m++)
#pragma unroll
          for (int n = 0; n < 4; n++) {
            const int col = cbase + n * 16;
            const float4 a04 = *(const float4*)(a0 + n0 + col);
            const float av0 = sigm(a04.x + acc[m][n][0]), av1 = sigm(a04.y + acc[m][n][1]);
            const float av2 = sigm(a04.z + acc[m][n][2]), av3 = sigm(a04.w + acc[m][n][3]);
            *(uint2*)(lds + (rbase + m * 16) * 272 + col * 2) = make_uint2(pack2(av0, av1), pack2(av2, av3));
            __builtin_amdgcn_sched_barrier(0);
          }
        __syncthreads();
#pragma unroll 1
        for (int i = 0; i < 8; i++) {
          const int id = tid + 256 * i, row = id >> 4, c = id & 15;
          const size_t o = (size_t)(m0 + row) * 256 + n0 + c * 8;
          const uint4 ar = *(const uint4*)(lds + row * 272 + c * 16);
          const uint4 kkr = *(const uint4*)(kkp + o);
          const uint4 ksr = *(const uint4*)(ksp + o);
          const float4 ka0 = *(const float4*)(ka + n0 + c * 8);
          const float4 ka1 = *(const float4*)(ka + n0 + c * 8 + 4);
          uint4 w1, w2;
#define A_PAIR(AR, KK, KS, KA_LO, KA_HI, W1, W2)                                                     \
  {                                                                                                  \
    const float alo = blo(AR), ahi = bhi(AR);                                                        \
    W1 = pack2(blo(KK) * alo, bhi(KK) * ahi);                                                        \
    W2 = pack2(blo(KS) * (1.f + (alo - 1.f) * (KA_LO)), bhi(KS) * (1.f + (ahi - 1.f) * (KA_HI)));    \
  }
          A_PAIR(ar.x, kkr.x, ksr.x, ka0.x, ka0.y, w1.x, w2.x)
          A_PAIR(ar.y, kkr.y, ksr.y, ka0.z, ka0.w, w1.y, w2.y)
          A_PAIR(ar.z, kkr.z, ksr.z, ka1.x, ka1.y, w1.z, w2.z)
          A_PAIR(ar.w, kkr.w, ksr.w, ka1.z, ka1.w, w1.w, w2.w)
          *(uint4*)(dka + o) = w1;
          *(uint4*)(dkt + o) = w2;
        }
        __syncthreads();
      };
      gemm_tile<false>(rowfn, p.aup_t + ((size_t)(l * 2 + d) * 256 + n0) * 64, 64, epi, lds, tid);
    }
  }
  {
    const int NT = 2;
    for (int itx = 0;; itx++) {
      int nt, mt;
      if (!xcd_tile(itx, bid, nb, MT, NT, mt, nt)) break;
      int m0 = mt * 128, n0 = nt * 128;
      auto rowfn = [&](int r) -> const void* { return p.S1 + (size_t)(m0 + r) * 384 + 256; };
      u16* dst = p.gD;
      auto epi = [&](f32x4(&acc)[4][4], int rbase, int cbase) {
        epi_store_rows_bf16(acc, rbase, cbase, lds, tid, dst + (size_t)m0 * 256 + n0, 256, 128);
      };
      gemm_tile<false>(rowfn, p.gup_t + ((size_t)l * 256 + n0) * 128, 128, epi, lds, tid);
    }
  }
}

DI bf16x8 pack8(const f32x16& s, int o) {
  u32x4_t r = {pack2(s[o], s[o + 1]), pack2(s[o + 2], s[o + 3]), pack2(s[o + 4], s[o + 5]), pack2(s[o + 6], s[o + 7])};
  return __builtin_bit_cast(bf16x8, r);
}

constexpr int AT_KP = 208, AT_VP = 144, AT_BUF = 64 * AT_KP + 64 * AT_VP;
DI void attn_task(const Params& p, int task, int N, char* lds, int tid) {
  const int lane = tid & 63, wv = tid >> 6, r = lane & 31, hf = lane >> 5;
  const int nqb = N >> 7;
  {
    const int qb = task % nqb, bh = task / nqb, h = bh & 3, b = bh >> 2;
    const size_t tb = (size_t)b * N;
    const int q = qb * 128 + wv * 32 + r;
    bf16x8 qf[6];
    {
      const u16* qrow = p.Q + (tb + q) * 384 + h * 96;
#pragma unroll
      for (int ks = 0; ks < 4; ks++) qf[ks] = *(const bf16x8*)(qrow + ks * 16 + hf * 8);
      bf16x8 x1r = *(const bf16x8*)(qrow + 64 + hf * 8);
      bf16x8 x2r = *(const bf16x8*)(qrow + 80 + hf * 8);
      const float* cp = p.ropec + q * 16 + hf * 8;
      const float* sp = p.ropes + q * 16 + hf * 8;
      float ra[8], rb[8];
#pragma unroll
      for (int j = 0; j < 8; j++) {
        float xa = bf2f((u16)x1r[j]), ya = bf2f((u16)x2r[j]);
        float c0 = cp[j], s0 = sp[j];
        ra[j] = xa * c0 - ya * s0;
        rb[j] = xa * s0 + ya * c0;
      }
      u32x4_t o1 = {pack2(ra[0], ra[1]), pack2(ra[2], ra[3]), pack2(ra[4], ra[5]), pack2(ra[6], ra[7])};
      u32x4_t o2 = {pack2(rb[0], rb[1]), pack2(rb[2], rb[3]), pack2(rb[4], rb[5]), pack2(rb[6], rb[7])};
      qf[4] = __builtin_bit_cast(bf16x8, o1);
      qf[5] = __builtin_bit_cast(bf16x8, o2);
    }
    const u16* Kg = p.Kb + tb * 384 + h * 96;
    const u16* Vg = p.Vt + ((size_t)(b * 4 + h) * 64) * N;
    uint4 kr0, kr1, kr2, vr0, vr1;
    const int lkey = tid >> 2, lpart = tid & 3;
    const int lrow = swap23(lkey);
#define AT_GLOAD(kt_)                                                              \
  {                                                                                \
    const u16* kp_ = Kg + (size_t)((kt_) * 64 + lkey) * 384 + lpart * 24;          \
    kr0 = *(const uint4*)(kp_);                                                    \
    kr1 = *(const uint4*)(kp_ + 8);                                                \
    kr2 = *(const uint4*)(kp_ + 16);                                               \
    const u16* vp_ = Vg + (size_t)lkey * N + (kt_) * 64 + lpart * 16;              \
    vr0 = *(const uint4*)(vp_);                                                    \
    vr1 = *(const uint4*)(vp_ + 8);                                                \
  }
#define AT_LSTORE(buf_)                                                            \
  {                                                                                \
    char* Kl_ = lds + (buf_) * AT_BUF;                                             \
    char* Vl_ = Kl_ + 64 * AT_KP;                                                  \
    *(uint4*)(Kl_ + lrow * AT_KP + (lpart * 3 + 0) * 16) = kr0;                    \
    *(uint4*)(Kl_ + lrow * AT_KP + (lpart * 3 + 1) * 16) = kr1;                    \
    *(uint4*)(Kl_ + lrow * AT_KP + (lpart * 3 + 2) * 16) = kr2;                    \
    *(uint4*)(Vl_ + lkey * AT_VP + (lpart * 2 + 0) * 16) = vr0;                    \
    *(uint4*)(Vl_ + lkey * AT_VP + (lpart * 2 + 1) * 16) = vr1;                    \
  }
    f32x16 O0, O1;
#pragma unroll
    for (int i = 0; i < 16; i++) { O0[i] = 0.f; O1[i] = 0.f; }
    float mrun = 0.f, lrun = 0.f;
    const int nt = N >> 6;
    __syncthreads();
    AT_GLOAD(0);
    AT_LSTORE(0);
    __syncthreads();
    for (int kt = 0; kt < nt; kt++) {
      if (kt + 1 < nt) AT_GLOAD(kt + 1);
      __builtin_amdgcn_sched_barrier(0);
      const char* Kl = lds + (kt & 1) * AT_BUF;
      const char* Vl = Kl + 64 * AT_KP;
      f32x16 S0, S1;
      {
        const float nm = -mrun;
#pragma unroll
        for (int i = 0; i < 16; i++) { S0[i] = nm; S1[i] = nm; }
      }
#pragma unroll
      for (int ks = 0; ks < 6; ks++) {
        bf16x8 a0 = *(const bf16x8*)(Kl + r * AT_KP + ks * 32 + hf * 16);
        bf16x8 a1 = *(const bf16x8*)(Kl + (32 + r) * AT_KP + ks * 32 + hf * 16);
        S0 = __builtin_amdgcn_mfma_f32_32x32x16_bf16(a0, qf[ks], S0, 0, 0, 0);
        S1 = __builtin_amdgcn_mfma_f32_32x32x16_bf16(a1, qf[ks], S1, 0, 0, 0);
      }
      float mx = fmaxf(S0[0], S1[0]);
#pragma unroll
      for (int i = 1; i < 16; i++) mx = fmaxf(mx, fmaxf(S0[i], S1[i]));
      if (__any((mx > 12.f) || (kt == 0))) {
        const float mq = fmaxf(mx, __shfl_xor(mx, 32));
        const float shift = (kt == 0) ? mq : ((mq > 12.f) ? mq : 0.f);
        const float sc = (kt == 0) ? 1.f : ex2(-shift);
        mrun += shift;
        lrun *= sc;
#pragma unroll
        for (int i = 0; i < 16; i++) {
          S0[i] -= shift;
          S1[i] -= shift;
          O0[i] *= sc;
          O1[i] *= sc;
        }
      }
      float ls = 0.f;
#pragma unroll
      for (int i = 0; i < 16; i++) {
        S0[i] = ex2(S0[i]);
        S1[i] = ex2(S1[i]);
        ls += S0[i] + S1[i];
      }
      lrun += ls;
#pragma unroll
      for (int sp = 0; sp < 4; sp++) {
        bf16x8 pb = (sp < 2) ? pack8(S0, (sp & 1) * 8) : pack8(S1, (sp & 1) * 8);
        bf16x8 v0 = *(const bf16x8*)(Vl + r * AT_VP + sp * 32 + hf * 16);
        bf16x8 v1 = *(const bf16x8*)(Vl + (32 + r) * AT_VP + sp * 32 + hf * 16);
        O0 = __builtin_amdgcn_mfma_f32_32x32x16_bf16(v0, pb, O0, 0, 0, 0);
        O1 = __builtin_amdgcn_mfma_f32_32x32x16_bf16(v1, pb, O1, 0, 0, 0);
      }
      __builtin_amdgcn_sched_barrier(0);
      if (kt + 1 < nt) AT_LSTORE((kt + 1) & 1);
      __syncthreads();
    }
    float lt = lrun + __shfl_xor(lrun, 32);
    float inv = 1.f / lt;
    u16* orow = p.cat + (tb + q) * 1024 + h * 64;
#pragma unroll
    for (int g = 0; g < 4; g++) {
      int d0 = 8 * g + 4 * hf;
      *(uint2*)(orow + d0) = make_uint2(pack2(O0[4 * g] * inv, O0[4 * g + 1] * inv), pack2(O0[4 * g + 2] * inv, O0[4 * g + 3] * inv));
      *(uint2*)(orow + 32 + d0) = make_uint2(pack2(O1[4 * g] * inv, O1[4 * g + 1] * inv), pack2(O1[4 * g + 2] * inv, O1[4 * g + 3] * inv));
    }
  }
}

DI void na_task(const Params& p, int l, int task, int N, int tid) {
  const int lane = tid & 63, head = tid >> 6, r = lane & 31, hf = lane >> 5;
  const int rows = N >> 6;
  const int nrb = rows >> 1;
  const float* bias = p.na_bias + (size_t)(l * 4 + head) * 15 * 31;
  {
    const int cb = task & 3, rb = (task >> 2) % nrb, b = (task >> 2) / nrb;
    const size_t tb = (size_t)b * N;
    const int qrow0 = rb * 2;
    const int rstart0 = clampi(qrow0 - 4, 0, rows - 8);
    const int k0 = clampi(rstart0, 0, rows - 9);
    const int kstart = clampi(cb * 16 - 8, 0, 32);
    const int iq = r >> 4, u = r & 15;
    const int qrow = qrow0 + iq, qcol = cb * 16 + u;
    const int rstart = clampi(qrow - 4, 0, rows - 8);
    const int cstart = clampi(qcol - 8, 0, 48);
    bf16x8 qf[4];
    {
      const u16* qp = p.z + (tb + qrow * 64 + qcol) * ZLD + ZB_OFF + head * 64;
#pragma unroll
      for (int ks = 0; ks < 4; ks++) qf[ks] = *(const bf16x8*)(qp + ks * 16 + hf * 8);
    }
    f32x16 O0, O1;
#pragma unroll
    for (int i = 0; i < 16; i++) { O0[i] = 0.f; O1[i] = 0.f; }
    float mrun = -1e30f, lrun = 0.f;
    const int wk = swap23(r);
    for (int j = 0; j < 9; j++) {
      const int krow = k0 + j;
      const u16* kp = p.z + (tb + krow * 64 + kstart + wk) * ZLD + ZB_OFF + 256 + head * 64;
      f32x16 S;
#pragma unroll
      for (int i = 0; i < 16; i++) S[i] = 0.f;
#pragma unroll
      for (int ks = 0; ks < 4; ks++) {
        bf16x8 a = *(const bf16x8*)(kp + ks * 16 + hf * 8);
        S = __builtin_amdgcn_mfma_f32_32x32x16_bf16(a, qf[ks], S, 0, 0, 0);
      }
      const bool rok = (krow >= rstart) && (krow < rstart + 8);
      const int drow = clampi(krow - qrow + 7, 0, 14);
      const float* brow = bias + drow * 31;
      float mx = -1e30f;
#pragma unroll
      for (int i = 0; i < 16; i++) {
        int w = 16 * (i >> 3) + 8 * hf + 4 * ((i >> 2) & 1) + (i & 3);
        int kcol = kstart + w;
        bool ok = rok && (kcol >= cstart) && (kcol < cstart + 16);
        int dcol = clampi(kcol - qcol + 15, 0, 30);
        float s = (S[i] * 0.125f + brow[dcol]) * LOG2E;
        S[i] = ok ? s : -1e30f;
        mx = fmaxf(mx, S[i]);
      }
      mx = fmaxf(mx, __shfl_xor(mx, 32));
      float mn = fmaxf(mrun, mx);
      float alpha = ex2(mrun - mn);
      mrun = mn;
      float ls = 0.f;
#pragma unroll
      for (int i = 0; i < 16; i++) {
        float pv = (S[i] > -1e29f) ? ex2(S[i] - mn) : 0.f;
        S[i] = pv;
        ls += pv;
      }
      lrun = lrun * alpha + ls;
#pragma unroll
      for (int i = 0; i < 16; i++) { O0[i] *= alpha; O1[i] *= alpha; }
      const u16* vbase = p.z + (tb + krow * 64 + kstart) * ZLD + ZB_OFF + 512 + head * 64 + r;
#pragma unroll
      for (int s = 0; s < 2; s++) {
        bf16x8 pb = pack8(S, s * 8);
        bf16x8 v0, v1;
#pragma unroll
        for (int jj = 0; jj < 8; jj++) {
          const u16* vp = vbase + (size_t)(16 * s + 8 * hf + jj) * ZLD;
          v0[jj] = (short)vp[0];
          v1[jj] = (short)vp[32];
        }
        O0 = __builtin_amdgcn_mfma_f32_32x32x16_bf16(v0, pb, O0, 0, 0, 0);
        O1 = __builtin_amdgcn_mfma_f32_32x32x16_bf16(v1, pb, O1, 0, 0, 0);
      }
    }
    float lt = lrun + __shfl_xor(lrun, 32);
    float inv = 1.f / lt;
    u16* orow = p.cat + (tb + qrow * 64 + qcol) * 1024 + 256 + head * 64;
#pragma unroll
    for (int g = 0; g < 4; g++) {
      int d0 = 8 * g + 4 * hf;
      *(uint2*)(orow + d0) = make_uint2(pack2(O0[4 * g] * inv, O0[4 * g + 1] * inv), pack2(O0[4 * g + 2] * inv, O0[4 * g + 3] * inv));
      *(uint2*)(orow + 32 + d0) = make_uint2(pack2(O1[4 * g] * inv, O1[4 * g + 1] * inv), pack2(O1[4 * g + 2] * inv, O1[4 * g + 3] * inv));
    }
  }
}

using f32x2 = __attribute__((ext_vector_type(2))) float;
constexpr int SC_STEPS = 16;

DI void sc_store(char* buf, int dst, uint4 R, bool hgw) {
  float4 lo = make_float4(blo(R.x), bhi(R.x), blo(R.y), bhi(R.y));
  float4 hi = make_float4(blo(R.z), bhi(R.z), blo(R.w), bhi(R.w));
  *(float4*)(buf + dst) = lo;
  *(float4*)(buf + dst + 16) = hi;
  if (hgw) {
    *(float4*)(buf + dst + 256) = make_float4(1.f - lo.x, 1.f - lo.y, 1.f - lo.z, 1.f - lo.w);
    *(float4*)(buf + dst + 272) = make_float4(1.f - hi.x, 1.f - hi.y, 1.f - hi.z, 1.f - hi.w);
  }
}

DI float reduce8(float v) {
  v += dpp_f<0xB1>(v);
  v += dpp_f<0x4E>(v);
  v += dpp_f<0x141>(v);
  return v;
}

template <bool RW>
DI void scan_task(const Params& p, int task, int N, char* lds, int tid) {
  constexpr int NA = RW ? 5 : 3;
  constexpr int VOFF = SC_STEPS * NA * 256;
  constexpr int BUF = VOFF + SC_STEPS * 128;
  const int lane = tid & 63, wv = tid >> 6, kq = lane & 7, rg = lane >> 3;
  const int rq = task & 1, hh = (task >> 1) & 3, dir = (task >> 3) & 1, b = task >> 4;
  const size_t tb = (size_t)b * N;
  const int sub = tid >> 7, lt = tid & 127, lstep = lt >> 3, lpart = lt & 7;
  const int vstep = lt >> 2, vq = lt & 3;
  const u16 *src0 = nullptr, *src1 = nullptr, *src2 = nullptr;
  int dst0 = 0, dst1 = 0, dst2 = 0, st0 = 0, st1 = 0, st2 = 0;
  bool act0 = false, act1 = false, act2 = false, hgw = false;
  int ld;
  const int acol = hh * 64 + lpart * 8;
  const int vcol = hh * 64 + rq * 32 + vq * 8;
  const int vdst = VOFF + vstep * 128 + vq * 32;
  if (RW) {
    ld = 256;
    act0 = true; st0 = lstep;
    src0 = sub ? (p.dec + (size_t)dir * T_SUB * 256 + acol) : (p.rs + acol);
    dst0 = (lstep * NA + (sub ? 1 : 0)) * 256 + lpart * 32;
    act1 = true; st1 = lstep;
    src1 = sub ? (p.kk + acol) : (p.kt + (size_t)dir * T_SUB * 256 + acol);
    dst1 = (lstep * NA + (sub ? 3 : 2)) * 256 + lpart * 32;
    if (sub == 0) { act2 = true; st2 = lstep; src2 = p.kka + (size_t)dir * T_SUB * 256 + acol; dst2 = (lstep * NA + 4) * 256 + lpart * 32; }
    else { act2 = lt < 64; st2 = vstep; src2 = p.vs + vcol; dst2 = vdst; }
  } else {
    ld = ZLD;
    act0 = true; st0 = lstep;
    src0 = sub ? (p.z + ZC_OFF + 256 * (1 + dir) + acol) : (p.z + ZC_OFF + acol);
    dst0 = (lstep * NA + (sub ? 1 : 0)) * 256 + lpart * 32;
    hgw = sub != 0;
    if (sub == 0) { act1 = lt < 64; st1 = vstep; src1 = p.z + ZC_OFF + 768 + vcol; dst1 = vdst; }
  }
  u16* pout = (RW ? p.oD : p.oC) + (size_t)dir * T_SUB * 256 + hh * 64 + rq * 32 + wv * 8 + rg;
  pout += (tb + (dir ? (N - 1) : 0)) * 256;
  const int ostride = dir ? -256 : 256;

#define SC_TOK(c_, st_) (tb + (size_t)(dir ? (N - 1 - ((c_) * SC_STEPS + (st_))) : ((c_) * SC_STEPS + (st_))))
#define SC_ISSUE(Ra, Rb, Rc, c_)                                               \
  {                                                                            \
    if (act0) Ra = *(const uint4*)(src0 + SC_TOK(c_, st0) * ld);               \
    if (act1) Rb = *(const uint4*)(src1 + SC_TOK(c_, st1) * ld);               \
    if (act2) Rc = *(const uint4*)(src2 + SC_TOK(c_, st2) * ld);               \
  }
#define SC_STORE(Ra, Rb, Rc, buf_)                                             \
  {                                                                            \
    if (act0) sc_store(buf_, dst0, Ra, hgw);                                   \
    if (act1) sc_store(buf_, dst1, Rb, false);                                 \
    if (act2) sc_store(buf_, dst2, Rc, false);                                 \
  }
  f32x2 S0 = {0.f, 0.f}, S1 = {0.f, 0.f}, S2 = {0.f, 0.f}, S3 = {0.f, 0.f};
#define SC_LD(buf_, s_, ra_, rb_, wa_, wb_, ta_, tb_, ka_, kb_, aa_, ab_, v_)                \
  {                                                                                          \
    const char* rowp_ = (buf_) + (s_) * NA * 256 + kq * 32;                                  \
    ra_ = *(const float4*)(rowp_);                                                           \
    rb_ = *(const float4*)(rowp_ + 16);                                                      \
    wa_ = *(const float4*)(rowp_ + 256);                                                     \
    wb_ = *(const float4*)(rowp_ + 272);                                                     \
    ta_ = *(const float4*)(rowp_ + 512);                                                     \
    tb_ = *(const float4*)(rowp_ + 528);                                                     \
    if (RW) {                                                                                \
      ka_ = *(const float4*)(rowp_ + 768);                                                   \
      kb_ = *(const float4*)(rowp_ + 784);                                                   \
      aa_ = *(const float4*)(rowp_ + 1024);                                                  \
      ab_ = *(const float4*)(rowp_ + 1040);                                                  \
    }                                                                                        \
    v_ = *(const float*)((buf_) + VOFF + (s_) * 128 + (wv * 8 + rg) * 4);                    \
  }
#define F2A(q_) f32x2{(q_).x, (q_).y}
#define F2B(q_) f32x2{(q_).z, (q_).w}
#define SC_COMPUTE(buf_)                                                                     \
  {                                                                                          \
    float oselA = 0.f, oselB = 0.f;                                                          \
    float4 ra, rb, wa, wb, ta, tb_, ka, kb, aa, ab, nra, nrb, nwa, nwb, nta, ntb, nka, nkb, naa, nab; \
    float vv, nvv;                                                                           \
    ka = kb = aa = ab = nka = nkb = naa = nab = make_float4(0.f, 0.f, 0.f, 0.f);             \
    SC_LD(buf_, 0, ra, rb, wa, wb, ta, tb_, ka, kb, aa, ab, vv);                             \
    _Pragma("unroll") for (int s = 0; s < SC_STEPS; s++) {                                   \
      if (s + 1 < SC_STEPS) SC_LD(buf_, s + 1, nra, nrb, nwa, nwb, nta, ntb, nka, nkb, naa, nab, nvv); \
      f32x2 u0 = F2A(ta) * vv, u1 = F2B(ta) * vv, u2 = F2A(tb_) * vv, u3 = F2B(tb_) * vv;     \
      if (RW) {                                                                              \
        f32x2 pa = S0 * F2A(ka), pb = S1 * F2B(ka);                                          \
        pa = S2 * F2A(kb) + pa;                                                              \
        pb = S3 * F2B(kb) + pb;                                                              \
        pa = pa + pb;                                                                        \
        const float sa = -reduce8(pa.x + pa.y);                                              \
        u0 = F2A(aa) * sa + u0;                                                              \
        u1 = F2B(aa) * sa + u1;                                                              \
        u2 = F2A(ab) * sa + u2;                                                              \
        u3 = F2B(ab) * sa + u3;                                                              \
      }                                                                                      \
      S0 = S0 * F2A(wa) + u0;                                                                \
      S1 = S1 * F2B(wa) + u1;                                                                \
      S2 = S2 * F2A(wb) + u2;                                                                \
      S3 = S3 * F2B(wb) + u3;                                                                \
      f32x2 qa = S0 * F2A(ra), qb = S1 * F2B(ra);                                            \
      qa = S2 * F2A(rb) + qa;                                                                \
      qb = S3 * F2B(rb) + qb;                                                                \
      qa = qa + qb;                                                                          \
      const float o = reduce8(qa.x + qa.y);                                                  \
      if (s < 8) oselA = (kq == s) ? o : oselA;                                              \
      else oselB = (kq == s - 8) ? o : oselB;                                                \
      ra = nra; rb = nrb; wa = nwa; wb = nwb; ta = nta; tb_ = ntb;                           \
      ka = nka; kb = nkb; aa = naa; ab = nab; vv = nvv;                                      \
    }                                                                                        \
    pout[kq * ostride] = f2bf(oselA);                                                        \
    pout[(kq + 8) * ostride] = f2bf(oselB);                                                  \
    pout += SC_STEPS * ostride;                                                              \
  }
  uint4 A0 = make_uint4(0, 0, 0, 0), A1 = A0, A2 = A0, B0 = A0, B1 = A0, B2 = A0;
  char* buf0 = lds;
  char* buf1 = lds + BUF;
  const int nch = N / SC_STEPS;
  __syncthreads();
  SC_ISSUE(A0, A1, A2, 0);
  SC_ISSUE(B0, B1, B2, 1);
  SC_STORE(A0, A1, A2, buf0);
  __syncthreads();
  for (int c = 0; c < nch; c += 2) {
    if (c + 2 < nch) SC_ISSUE(A0, A1, A2, c + 2);
    __builtin_amdgcn_sched_barrier(0);
    SC_COMPUTE(buf0);
    __builtin_amdgcn_sched_barrier(0);
    SC_STORE(B0, B1, B2, buf1);
    __syncthreads();
    if (c + 3 < nch) SC_ISSUE(B0, B1, B2, c + 3);
    __builtin_amdgcn_sched_barrier(0);
    SC_COMPUTE(buf1);
    __builtin_amdgcn_sched_barrier(0);
    if (c + 2 < nch) SC_STORE(A0, A1, A2, buf0);
    __syncthreads();
  }
}

template <bool RW>
DI void scan_task16(const Params& p, int task, int N, char* lds, int tid) {
  constexpr int NA = RW ? 5 : 3;
  constexpr int VOFF = SC_STEPS * NA * 256;
  constexpr int BUF = VOFF + SC_STEPS * 64;
  const int lane = tid & 63, wv = tid >> 6, kq = lane & 15, rg = lane >> 4;
  const int rq = task & 3, hh = (task >> 2) & 3, dir = (task >> 4) & 1, b = task >> 5;
  const size_t tb = (size_t)b * N;
  const int sub = tid >> 7, lt = tid & 127, lstep = lt >> 3, lpart = lt & 7;
  const int vstep = lt >> 1, vhalf = lt & 1;
  const u16 *src0 = nullptr, *src1 = nullptr, *src2 = nullptr;
  int dst0 = 0, dst1 = 0, dst2 = 0, st0 = 0, st1 = 0, st2 = 0;
  bool act0 = false, act1 = false, act2 = false, hgw = false;
  int ld;
  const int acol = hh * 64 + lpart * 8;
  const int vcol = hh * 64 + rq * 16 + vhalf * 8;
  const int vdst = VOFF + vstep * 64 + vhalf * 32;
  if (RW) {
    ld = 256;
    act0 = true; st0 = lstep;
    src0 = sub ? (p.dec + (size_t)dir * T_SUB * 256 + acol) : (p.rs + acol);
    dst0 = (lstep * NA + (sub ? 1 : 0)) * 256 + lpart * 32;
    act1 = true; st1 = lstep;
    src1 = sub ? (p.kk + acol) : (p.kt + (size_t)dir * T_SUB * 256 + acol);
    dst1 = (lstep * NA + (sub ? 3 : 2)) * 256 + lpart * 32;
    if (sub == 0) { act2 = true; st2 = lstep; src2 = p.kka + (size_t)dir * T_SUB * 256 + acol; dst2 = (lstep * NA + 4) * 256 + lpart * 32; }
    else { act2 = lt < 32; st2 = vstep; src2 = p.vs + vcol; dst2 = vdst; }
  } else {
    ld = ZLD;
    act0 = true; st0 = lstep;
    src0 = sub ? (p.z + ZC_OFF + 256 * (1 + dir) + acol) : (p.z + ZC_OFF + acol);
    dst0 = (lstep * NA + (sub ? 1 : 0)) * 256 + lpart * 32;
    hgw = sub != 0;
    if (sub == 0) { act1 = lt < 32; st1 = vstep; src1 = p.z + ZC_OFF + 768 + vcol; dst1 = vdst; }
  }
  u16* pout = (RW ? p.oD : p.oC) + (size_t)dir * T_SUB * 256 + hh * 64 + rq * 16 + wv * 4 + rg;
  pout += (tb + (dir ? (N - 1) : 0)) * 256;
  const int ostride = dir ? -256 : 256;

#define SC16_TOK(c_, st_) (tb + (size_t)(dir ? (N - 1 - ((c_) * SC_STEPS + (st_))) : ((c_) * SC_STEPS + (st_))))
#define SC16_ISSUE(Ra, Rb, Rc, c_)                                               \
  {                                                                            \
    if (act0) Ra = *(const uint4*)(src0 + SC16_TOK(c_, st0) * ld);               \
    if (act1) Rb = *(const uint4*)(src1 + SC16_TOK(c_, st1) * ld);               \
    if (act2) Rc = *(const uint4*)(src2 + SC16_TOK(c_, st2) * ld);               \
  }
#define SC16_STORE(Ra, Rb, Rc, buf_)                                             \
  {                                                                            \
    if (act0) sc_store(buf_, dst0, Ra, hgw);                                   \
    if (act1) sc_store(buf_, dst1, Rb, false);                                 \
    if (act2) sc_store(buf_, dst2, Rc, false);                                 \
  }
  f32x2 S01 = {0.f, 0.f}, S23 = {0.f, 0.f};
#define SC16_LD(buf_, s_, r_, w_, t_, k_, a_, v_)                                              \
  {                                                                                          \
    const char* rowp_ = (buf_) + (s_) * NA * 256 + kq * 16;                                  \
    r_ = *(const float4*)(rowp_);                                                            \
    w_ = *(const float4*)(rowp_ + 256);                                                      \
    t_ = *(const float4*)(rowp_ + 512);                                                      \
    if (RW) {                                                                                \
      k_ = *(const float4*)(rowp_ + 768);                                                    \
      a_ = *(const float4*)(rowp_ + 1024);                                                   \
    }                                                                                        \
    v_ = *(const float*)((buf_) + VOFF + (s_) * 64 + (wv * 4 + rg) * 4);                     \
  }
#define SC16_COMPUTE(buf_)                                                                     \
  {                                                                                          \
    float osel = 0.f;                                                                        \
    float4 r4, w4, t4, k4, a4, nr4, nw4, nt4, nk4, na4;                                      \
    float vv, nvv;                                                                           \
    k4 = a4 = nk4 = na4 = make_float4(0.f, 0.f, 0.f, 0.f);                                   \
    SC16_LD(buf_, 0, r4, w4, t4, k4, a4, vv);                                                  \
    _Pragma("unroll") for (int s = 0; s < SC_STEPS; s++) {                                   \
      if (s + 1 < SC_STEPS) SC16_LD(buf_, s + 1, nr4, nw4, nt4, nk4, na4, nvv);                \
      f32x2 ta = f32x2{t4.x, t4.y} * vv, tb2 = f32x2{t4.z, t4.w} * vv;                       \
      if (RW) {                                                                              \
        f32x2 pp = S01 * f32x2{k4.x, k4.y};                                                  \
        pp = S23 * f32x2{k4.z, k4.w} + pp;                                                   \
        const float sa = -reduce16(pp.x + pp.y);                                             \
        ta = f32x2{a4.x, a4.y} * sa + ta;                                                    \
        tb2 = f32x2{a4.z, a4.w} * sa + tb2;                                                  \
      }                                                                                      \
      S01 = S01 * f32x2{w4.x, w4.y} + ta;                                                    \
      S23 = S23 * f32x2{w4.z, w4.w} + tb2;                                                   \
      f32x2 qq = S01 * f32x2{r4.x, r4.y};                                                    \
      qq = S23 * f32x2{r4.z, r4.w} + qq;                                                     \
      const float o = reduce16(qq.x + qq.y);                                                 \
      osel = (kq == s) ? o : osel;                                                           \
      r4 = nr4; w4 = nw4; t4 = nt4; k4 = nk4; a4 = na4; vv = nvv;                            \
    }                                                                                        \
    pout[kq * ostride] = f2bf(osel);                                                         \
    pout += SC_STEPS * ostride;                                                              \
  }
  uint4 A0 = make_uint4(0, 0, 0, 0), A1 = A0, A2 = A0, B0 = A0, B1 = A0, B2 = A0;
  char* buf0 = lds;
  char* buf1 = lds + BUF;
  const int nch = N / SC_STEPS;
  __syncthreads();
  SC16_ISSUE(A0, A1, A2, 0);
  SC16_ISSUE(B0, B1, B2, 1);
  SC16_STORE(A0, A1, A2, buf0);
  __syncthreads();
  for (int c = 0; c < nch; c += 2) {
    if (c + 2 < nch) SC16_ISSUE(A0, A1, A2, c + 2);
    __builtin_amdgcn_sched_barrier(0);
    SC16_COMPUTE(buf0);
    __builtin_amdgcn_sched_barrier(0);
    SC16_STORE(B0, B1, B2, buf1);
    __syncthreads();
    if (c + 3 < nch) SC16_ISSUE(B0, B1, B2, c + 3);
    __builtin_amdgcn_sched_barrier(0);
    SC16_COMPUTE(buf1);
    __builtin_amdgcn_sched_barrier(0);
    if (c + 2 < nch) SC16_STORE(A0, A1, A2, buf0);
    __syncthreads();
  }
}


DI void phase_mix(const Params& p, int l, int B, int N, unsigned* ctr, char* lds, int bid, int nb, int tid) {
  __shared__ int s_task[2];
  const bool wide = (N > 4096);
  const int nper = wide ? B * 32 : B * 16;
  const int nscan = 2 * nper;
  const int nattn = B * 4 * (N >> 7);
  const int nna = B * (N >> 7) * 4;
  const bool prefer_scan = bid < (nb >> 1);
  bool scan_dry = false, attn_dry = false;
  for (;;) {
    if (tid == 0) {
      int kind = -1, task = 0;
      for (int attempt = 0; attempt < 2 && kind < 0; attempt++) {
        const bool try_scan = (attempt == 0) == prefer_scan;
        if (try_scan) {
          if (!scan_dry) {
            const int t = (int)atomicAdd(&ctr[0], 1u);
            if (t < nscan) { kind = 0; task = t; } else scan_dry = true;
          }
        } else {
          if (!attn_dry) {
            const int t = (int)atomicAdd(&ctr[64], 1u);
            if (t < nattn + nna) { kind = 1; task = t; } else attn_dry = true;
          }
        }
      }
      s_task[0] = kind;
      s_task[1] = task;
    }
    __syncthreads();
    const int kind = s_task[0], task = s_task[1];
    __syncthreads();
    if (kind < 0) break;
    if (kind == 0) {
      if (wide) {
        if (task < nper) scan_task16<true>(p, task, N, lds, tid);
        else scan_task16<false>(p, task - nper, N, lds, tid);
      } else {
        if (task < nper) scan_task<true>(p, task, N, lds, tid);
        else scan_task<false>(p, task - nper, N, lds, tid);
      }
    } else {
      if (task < nattn) attn_task(p, task, N, lds, tid);
      else na_task(p, l, task - nattn, N, tid);
    }
  }
}

DI void phase_final(const Params& p, int l, int bid, int nb, int tid) {
  const int lane = tid & 63, wv = tid >> 6, c4 = lane * 4;
  float gn[4], lw[4], lbb[4];
#pragma unroll
  for (int j = 0; j < 4; j++) {
    gn[j] = p.hg_gnorm[l * 256 + c4 + j];
    lw[j] = p.rw_ln_w[l * 256 + c4 + j];
    lbb[j] = p.rw_ln_b[l * 256 + c4 + j];
  }
  for (int t = bid * 4 + wv; t < T_SUB; t += nb * 4) {
    const uint2 ca = *(const uint2*)(p.oC + (size_t)t * 256 + c4);
    const uint2 cb = *(const uint2*)(p.oC + (size_t)(T_SUB + t) * 256 + c4);
    const uint2 cg = *(const uint2*)(p.z + (size_t)t * ZLD + ZC_OFF + 1024 + c4);
    const uint2 da = *(const uint2*)(p.oD + (size_t)t * 256 + c4);
    const uint2 db = *(const uint2*)(p.oD + (size_t)(T_SUB + t) * 256 + c4);
    const float bo = p.bonus[(size_t)t * 4 + (lane >> 4)];
    const uint2 vr = *(const uint2*)(p.vs + (size_t)t * 256 + c4);
    const uint2 gr = *(const uint2*)(p.gD + (size_t)t * 256 + c4);
    {
      float o[4] = {blo(ca.x) + blo(cb.x), bhi(ca.x) + bhi(cb.x), blo(ca.y) + blo(cb.y), bhi(ca.y) + bhi(cb.y)};
      float ss = reduce16(o[0] * o[0] + o[1] * o[1] + o[2] * o[2] + o[3] * o[3]);
      float ri = rsqrtf(ss * (1.f / 64.f) + 1e-6f);
      float g[4] = {blo(cg.x), bhi(cg.x), blo(cg.y), bhi(cg.y)};
      float y[4];
#pragma unroll
      for (int j = 0; j < 4; j++) y[j] = o[j] * ri * gn[j] * (g[j] * sigm(g[j]));
      *(uint2*)(p.cat + (size_t)t * 1024 + 512 + c4) = make_uint2(pack2(y[0], y[1]), pack2(y[2], y[3]));
    }
    {
      float o[4] = {blo(da.x) + blo(db.x), bhi(da.x) + bhi(db.x), blo(da.y) + blo(db.y), bhi(da.y) + bhi(db.y)};
      float mu = reduce16(o[0] + o[1] + o[2] + o[3]) * (1.f / 64.f);
      float d0 = o[0] - mu, d1 = o[1] - mu, d2 = o[2] - mu, d3 = o[3] - mu;
      float var = reduce16(d0 * d0 + d1 * d1 + d2 * d2 + d3 * d3) * (1.f / 64.f);
      float ri = rsqrtf(var + 64e-5f);
      float vv[4] = {blo(vr.x), bhi(vr.x), blo(vr.y), bhi(vr.y)};
      float g[4] = {blo(gr.x), bhi(gr.x), blo(gr.y), bhi(gr.y)};
      float dd[4] = {d0, d1, d2, d3};
      float y[4];
#pragma unroll
      for (int j = 0; j < 4; j++) y[j] = (dd[j] * ri * lw[j] + lbb[j] + bo * vv[j]) * g[j];
      *(uint2*)(p.cat + (size_t)t * 1024 + 768 + c4) = make_uint2(pack2(y[0], y[1]), pack2(y[2], y[3]));
    }
  }
}

DI void phase_wout(const Params& p, int l, int tok0, char* lds, int bid, int nb, int tid) {
  const int NT = 8, MT = T_SUB / 128;
  for (int it = 0;; it++) {
    int nt, mt;
    if (!xcd_tile(it, bid, nb, MT, NT, mt, nt)) break;
    int m0 = mt * 128, n0 = nt * 128;
    auto rowfn = [&](int r) -> const void* { return p.cat + (size_t)(m0 + r) * 1024; };
    auto epi = [&](f32x4(&acc)[4][4], int rbase, int cbase) {
#pragma unroll
      for (int m = 0; m < 4; m++)
#pragma unroll
        for (int n = 0; n < 4; n++)
          *(float4*)(lds + (rbase + m * 16) * 528 + (cbase + n * 16) * 4) = make_float4(acc[m][n][0], acc[m][n][1], acc[m][n][2], acc[m][n][3]);
      __syncthreads();
#pragma unroll 4
      for (int i = 0; i < 16; i++) {
        const int id = tid + 256 * i, row = id >> 5, c = id & 31;
        const int tg = tok0 + m0 + row;
        const float4 a = *(const float4*)(lds + row * 528 + c * 16);
        const float4 xv = *(const float4*)(xin_row(p, l, tg) + n0 + c * 4);
        *(float4*)(p.out + (size_t)tg * 1024 + n0 + c * 4) =
            make_float4(ALPHA_F * xv.x + a.x, ALPHA_F * xv.y + a.y, ALPHA_F * xv.z + a.z, ALPHA_F * xv.w + a.w);
      }
      __syncthreads();
    };
    gemm_tile<false>(rowfn, p.wout_t + ((size_t)l * 1024 + n0) * 1024, 1024, epi, lds, tid);
  }
}

template <bool ROUTER>
DI void phase_ln(const Params& p, const float* g, const float* bta, const float* wrouter, int tok0, int ntok, char* lds,
                 int bid, int nb, int tid) {
  const int lane = tid & 63, wv = tid >> 6;
  float* wl = (float*)lds;
  if (ROUTER) {
    __syncthreads();
    for (int i = tid; i < 16384; i += NTHR) {
      int k = i >> 4, e = i & 15;
      wl[e * 1024 + k] = wrouter[i];
    }
    __syncthreads();
  }
  auto ln_load = [&](float4 (&d)[4], int trow, bool ok) {
#pragma unroll
    for (int i = 0; i < 4; i++) {
      if (!ok) { d[i] = make_float4(0.f, 0.f, 0.f, 0.f); continue; }
      if (ROUTER) {
        d[i] = *(const float4*)(p.out + (size_t)trow * 1024 + i * 256 + lane * 4);
      } else {
        const uint2 r = *(const uint2*)(p.O + (size_t)trow * 1024 + i * 256 + lane * 4);
        d[i] = make_float4(blo(r.x), bhi(r.x), blo(r.y), bhi(r.y));
      }
    }
  };
  float4 x[4], xn[4];
  {
    const int t0 = bid * 4 + wv;
    ln_load(x, tok0 + t0, t0 < ntok);
  }
  for (int t = bid * 4 + wv; t < ntok; t += nb * 4) {
    const int tg = tok0 + t;
    float* xr = p.out + (size_t)tg * 1024;
    {
      const int tn = t + nb * 4;
      ln_load(xn, tok0 + tn, tn < ntok);
    }
    float s = 0.f;
#pragma unroll
    for (int i = 0; i < 4; i++) s += x[i].x + x[i].y + x[i].z + x[i].w;
    float mu = wave_sum(s) * (1.f / 1024.f);
    float vs = 0.f;
#pragma unroll
    for (int i = 0; i < 4; i++) {
      x[i].x -= mu; x[i].y -= mu; x[i].z -= mu; x[i].w -= mu;
      vs += x[i].x * x[i].x + x[i].y * x[i].y + x[i].z * x[i].z + x[i].w * x[i].w;
    }
    float ri = rsqrtf(wave_sum(vs) * (1.f / 1024.f) + 1e-5f);
#pragma unroll
    for (int i = 0; i < 4; i++) {
      float4 gg = *(const float4*)(g + i * 256 + lane * 4);
      float4 bb = *(const float4*)(bta + i * 256 + lane * 4);
      x[i].x = x[i].x * ri * gg.x + bb.x;
      x[i].y = x[i].y * ri * gg.y + bb.y;
      x[i].z = x[i].z * ri * gg.z + bb.z;
      x[i].w = x[i].w * ri * gg.w + bb.w;
      if (!ROUTER) *(float4*)(xr + i * 256 + lane * 4) = x[i];
      *(uint2*)(p.xb + (size_t)tg * 1024 + i * 256 + lane * 4) = make_uint2(pack2(x[i].x, x[i].y), pack2(x[i].z, x[i].w));
    }
    if (ROUTER) {
      float mine = 0.f;
#pragma unroll 2
      for (int e = 0; e < 16; e++) {
        float a = 0.f;
#pragma unroll
        for (int i = 0; i < 4; i++) {
          float4 w = *(const float4*)(wl + e * 1024 + i * 256 + lane * 4);
          a += x[i].x * w.x + x[i].y * w.y + x[i].z * w.z + x[i].w * w.w;
        }
        a = reduce16(a);
        mine = ((lane & 15) == e) ? a : mine;
      }
      mine += __shfl_xor(mine, 16);
      mine += __shfl_xor(mine, 32);
      float mx = mine;
      mx = fmaxf(mx, dpp_f<0xB1>(mx));
      mx = fmaxf(mx, dpp_f<0x4E>(mx));
      mx = fmaxf(mx, dpp_f<0x141>(mx));
      mx = fmaxf(mx, dpp_f<0x140>(mx));
      float ex = __expf(mine - mx);
      float sum = reduce16(ex);
      mine = ex / sum;
      if (lane == 0) p.inv_cnt[tg] = 0;
      if (lane < 16) {
        if (tg < 32768) p.affT[(size_t)lane * 32768 + tg] = mine;
        else p.affT[(size_t)16 * 32768 + (size_t)lane * 65536 + (tg - 32768)] = mine;
      }
    }
#pragma unroll
    for (int i = 0; i < 4; i++) x[i] = xn[i];
  }
}

DI void phase_topk(const Params& p, char* lds, int bid, int nb, int tid) {
  if (bid < 32) {
    unsigned* hist = (unsigned*)lds;
    unsigned* sh = hist + 256;
    unsigned* eqc = sh + 8;
    const int g = bid >> 4, e = bid & 15;
    const int T = g ? 65536 : 32768, cap = T >> 3;
    const int tok0 = g ? 32768 : 0;
    const float* vals = p.affT + (g ? (size_t)16 * 32768 : 0) + (size_t)e * T;
    const float4* v4 = (const float4*)vals;
    const int n4 = T >> 2;
    int* oidx = p.idx + (g ? 65536 : 0) + e * cap;
    float* ogate = p.gate + (g ? 65536 : 0) + e * cap;
    const int slot0 = (g ? 65536 : 0) + e * cap;
    unsigned prefix = 0, mask = 0;
    int remaining = cap;
    for (int pass = 0; pass < 4; pass++) {
      const int shift = 24 - 8 * pass;
      hist[tid] = 0;
      __syncthreads();
      for (int base = 0; base < n4; base += 2048) {
        float4 x[8];
#pragma unroll
        for (int u = 0; u < 8; u++) x[u] = v4[base + u * 256 + tid];
#pragma unroll
        for (int u = 0; u < 8; u++) {
          const unsigned b0 = __float_as_uint(x[u].x), b1 = __float_as_uint(x[u].y), b2 = __float_as_uint(x[u].z), b3 = __float_as_uint(x[u].w);
          if ((b0 & mask) == prefix) atomicAdd(&hist[(b0 >> shift) & 255], 1u);
          if ((b1 & mask) == prefix) atomicAdd(&hist[(b1 >> shift) & 255], 1u);
          if ((b2 & mask) == prefix) atomicAdd(&hist[(b2 >> shift) & 255], 1u);
          if ((b3 & mask) == prefix) atomicAdd(&hist[(b3 >> shift) & 255], 1u);
        }
      }
      __syncthreads();
      if (tid == 0) {
        int cum = 0, sel = 0;
        for (int bq = 255; bq >= 0; bq--) {
          int hc = (int)hist[bq];
          if (cum + hc >= remaining) { sel = bq; break; }
          cum += hc;
        }
        sh[0] = (unsigned)sel;
        sh[1] = (unsigned)(remaining - cum);
        sh[3] = hist[sel];
      }
      __syncthreads();
      prefix |= sh[0] << shift;
      remaining = (int)sh[1];
      mask |= 0xFFu << shift;
      __syncthreads();
    }
    const unsigned thr = prefix;
    const int need = remaining;
    const bool fast = ((int)sh[3] == need);
    if (tid == 0) sh[2] = 0;
    __syncthreads();
    if (fast) {
      for (int base = 0; base < n4; base += 2048) {
        float4 x[8];
#pragma unroll
        for (int u = 0; u < 8; u++) x[u] = v4[base + u * 256 + tid];
#pragma unroll
        for (int u = 0; u < 8; u++) {
          const float xv[4] = {x[u].x, x[u].y, x[u].z, x[u].w};
#pragma unroll
          for (int c = 0; c < 4; c++) {
            if (__float_as_uint(xv[c]) >= thr) {
              const int pos = (int)atomicAdd(&sh[2], 1u);
              const int tok = tok0 + (base + u * 256 + tid) * 4 + c;
              oidx[pos] = tok;
              ogate[pos] = xv[c];
              const int kslot = atomicAdd(&p.inv_cnt[tok], 1);
              p.inv_slot[(size_t)tok * 16 + kslot] = slot0 + pos;
            }
          }
        }
      }
    } else {
      const int ch = T >> 8;
      const float* my = vals + tid * ch;
      int ec = 0;
      for (int i = 0; i < ch; i++) ec += (__float_as_uint(my[i]) == thr) ? 1 : 0;
      eqc[tid] = ec;
      __syncthreads();
      int eq_rank = 0;
      for (int i = 0; i < tid; i++) eq_rank += eqc[i];
      for (int i = 0; i < ch; i++) {
        float v = my[i];
        unsigned u = __float_as_uint(v);
        int pos = -1;
        if (u > thr) {
          pos = (int)atomicAdd(&sh[2], 1u);
        } else if (u == thr) {
          if (eq_rank < need) pos = cap - need + eq_rank;
          eq_rank++;
        }
        if (pos >= 0) {
          const int tok = tok0 + tid * ch + i;
          oidx[pos] = tok;
          ogate[pos] = v;
          const int kslot = atomicAdd(&p.inv_cnt[tok], 1);
          p.inv_slot[(size_t)tok * 16 + kslot] = slot0 + pos;
        }
      }
    }
    __syncthreads();
  }
}

DI void moe_rowinfo(int row0, int l, int& e, int& ioff) {
  if (row0 < 65536) { e = row0 >> 12; }
  else { e = (row0 - 65536) >> 13; }
  ioff = row0;
}

DI void phase_moe1(const Params& p, int l, char* lds, int bid, int nb, int tid) {
  const int NT = 8, MT = 196608 / 128;
  for (int it = 0;; it++) {
    int nt, mt;
    if (!xcd_tile(it, bid, nb, MT, NT, mt, nt)) break;
    int m0 = mt * 128, n0 = nt * 128;
    int e, ioff;
    moe_rowinfo(m0, l, e, ioff);
    const int* ip = p.idx + ioff;
    auto rowfn = [&](int r) -> const void* { return p.xb + (size_t)ip[r] * 1024; };
    u16* H = p.H;
    auto epi = [&](f32x4(&acc)[4][4], int rbase, int cbase) {
#pragma unroll
      for (int m = 0; m < 4; m++)
#pragma unroll
        for (int n = 0; n < 4; n += 2) {
          const int row = rbase + m * 16;
          const int col = cbase + n * 16;
          const int hl = ((col & ~31) >> 1) + (col & 15);
          f32x4 a = acc[m][n], bq = acc[m][n + 1];
          f32x4 o;
          for (int j = 0; j < 4; j++) o[j] = a[j] * sigm(a[j]) * bq[j];
          *(uint2*)(lds + row * 144 + hl * 2) = make_uint2(pack2(o[0], o[1]), pack2(o[2], o[3]));
        }
      __syncthreads();
#pragma unroll
      for (int i = 0; i < 4; i++) {
        const int id = tid + 256 * i, row = id >> 3, c = id & 7;
        *(uint4*)(H + (size_t)(m0 + row) * 512 + (n0 >> 1) + c * 8) = *(const uint4*)(lds + row * 144 + c * 16);
      }
      __syncthreads();
    };
    gemm_tile<false>(rowfn, p.w13_t + ((size_t)(l * 16 + e) * 1024 + n0) * 1024, 1024, epi, lds, tid);
  }
}

DI void phase_moe2(const Params& p, int l, char* lds, int bid, int nb, int tid) {
  TileIter it{bid, nb, 0};
  {
    const int NT = 8, MT = 196608 / 128;
    for (int itx = 0;; itx++) {
      int nt, mt;
      if (!xcd_tile(itx, bid, nb, MT, NT, mt, nt)) break;
      int m0 = mt * 128, n0 = nt * 128;
      int e, ioff;
      moe_rowinfo(m0, l, e, ioff);
      auto rowfn = [&](int r) -> const void* { return p.H + (size_t)(m0 + r) * 512; };
      u16* O = p.O;
      auto epi = [&](f32x4(&acc)[4][4], int rbase, int cbase) {
        epi_store_rows_bf16(acc, rbase, cbase, lds, tid, O + (size_t)m0 * 1024 + n0, 1024, 128);
      };
      gemm_tile<false>(rowfn, p.w2_t + ((size_t)(l * 16 + e) * 1024 + n0) * 512, 512, epi, lds, tid);
    }
  }
  {
    const int NT = 8, MT = T_ALL / 128;
    for (int itx = 0;; itx++) {
      int nt, mt;
      if (!xcd_tile(itx, bid, nb, MT, NT, mt, nt)) break;
      int m0 = mt * 128, n0 = nt * 128;
      auto rowfn = [&](int r) -> const void* {
        int tg = m0 + r;
        return tg < 32768 ? p.p_prompt + ((size_t)l * 32768 + tg) * 256 : p.p_sample + ((size_t)l * 65536 + (tg - 32768)) * 256;
      };
      auto epi = [&](f32x4(&acc)[4][4], int rbase, int cbase) {
        epi_store_rows_bf16(acc, rbase, cbase, lds, tid, (u16*)p.out + (size_t)m0 * 1024 + n0, 1024, 128);
      };
      gemm_tile<true>(rowfn, p.wp_t + ((size_t)l * 1024 + n0) * 256, 256, epi, lds, tid);
    }
  }
}

DI void phase_combine(const Params& p, int bid, int nb, int tid) {
  const int lane = tid & 63, wv = tid >> 6;
  u16* ub = p.H;
  const int stride = nb * 4;
  int t = bid * 4 + wv;
  uint2 xr_[4], xn_[4];
  int cnt = 0, myslot = 0, cntn = 0, myslotn = 0;
#pragma unroll
  for (int i = 0; i < 4; i++) xr_[i] = xn_[i] = make_uint2(0, 0);
  if (t < T_ALL) {
#pragma unroll
    for (int i = 0; i < 4; i++) xr_[i] = *(const uint2*)(p.xb + (size_t)t * 1024 + i * 256 + lane * 4);
    cnt = p.inv_cnt[t];
    myslot = p.inv_slot[(size_t)t * 16 + (lane & 15)];
  }
  for (; t < T_ALL; t += stride) {
    const int tn = t + stride;
    if (tn < T_ALL) {
#pragma unroll
      for (int i = 0; i < 4; i++) xn_[i] = *(const uint2*)(p.xb + (size_t)tn * 1024 + i * 256 + lane * 4);
      cntn = p.inv_cnt[tn];
      myslotn = p.inv_slot[(size_t)tn * 16 + (lane & 15)];
    }
    const float mygate = ((lane & 15) < cnt) ? p.gate[myslot] : 0.f;
    float4 a[4];
#pragma unroll
    for (int i = 0; i < 4; i++)
      a[i] = make_float4(blo(xr_[i].x) * ALPHA_F, bhi(xr_[i].x) * ALPHA_F, blo(xr_[i].y) * ALPHA_F, bhi(xr_[i].y) * ALPHA_F);
    for (int j0 = 0; j0 < cnt; j0 += 4) {
      uint2 r[4][4];
      float g[4];
#pragma unroll
      for (int jj = 0; jj < 4; jj++) {
        const int j = (j0 + jj < cnt) ? (j0 + jj) : j0;
        const int slot = __shfl(myslot, j);
        g[jj] = (j0 + jj < cnt) ? __shfl(mygate, j) : 0.f;
        const u16* orow = p.O + (size_t)slot * 1024 + lane * 4;
#pragma unroll
        for (int i = 0; i < 4; i++) r[jj][i] = *(const uint2*)(orow + i * 256);
      }
#pragma unroll
      for (int jj = 0; jj < 4; jj++)
#pragma unroll
        for (int i = 0; i < 4; i++) {
          a[i].x += g[jj] * blo(r[jj][i].x);
          a[i].y += g[jj] * bhi(r[jj][i].x);
          a[i].z += g[jj] * blo(r[jj][i].y);
          a[i].w += g[jj] * bhi(r[jj][i].y);
        }
    }
#pragma unroll
    for (int i = 0; i < 4; i++)
      *(uint2*)(ub + (size_t)t * 1024 + i * 256 + lane * 4) = make_uint2(pack2(a[i].x, a[i].y), pack2(a[i].z, a[i].w));
#pragma unroll
    for (int i = 0; i < 4; i++) xr_[i] = xn_[i];
    cnt = cntn;
    myslot = myslotn;
  }
}

DI void phase_ple(const Params& p, int l, char* lds, int bid, int nb, int tid) {
  const int NT = 8, MT = T_ALL / 128;
  for (int it = 0;; it++) {
    int nt, mt;
    if (!xcd_tile(it, bid, nb, MT, NT, mt, nt)) break;
    int m0 = mt * 128, n0 = nt * 128;
    auto rowfn = [&](int r) -> const void* { return p.H + (size_t)(m0 + r) * 1024; };
    auto epi = [&](f32x4(&acc)[4][4], int rbase, int cbase) {
#pragma unroll
      for (int m = 0; m < 4; m++)
#pragma unroll
        for (int n = 0; n < 4; n++)
          *(uint2*)(lds + (rbase + m * 16) * 272 + (cbase + n * 16) * 2) =
              make_uint2(pack2(sigm(acc[m][n][0]), sigm(acc[m][n][1])), pack2(sigm(acc[m][n][2]), sigm(acc[m][n][3])));
      __syncthreads();
#pragma unroll 2
      for (int i = 0; i < 8; i++) {
        const int id = tid + 256 * i, row = id >> 4, c = id & 15;
        const size_t o = (size_t)(m0 + row) * 1024 + n0 + c * 8;
        const uint4 sg = *(const uint4*)(lds + row * 272 + c * 16);
        const uint4 ur = *(const uint4*)(p.H + o);
        const uint4 pr = *(const uint4*)((const u16*)p.out + o);
        uint4 w;
        w.x = pack2(blo(ur.x) + blo(sg.x) * blo(pr.x), bhi(ur.x) + bhi(sg.x) * bhi(pr.x));
        w.y = pack2(blo(ur.y) + blo(sg.y) * blo(pr.y), bhi(ur.y) + bhi(sg.y) * bhi(pr.y));
        w.z = pack2(blo(ur.z) + blo(sg.z) * blo(pr.z), bhi(ur.z) + bhi(sg.z) * bhi(pr.z));
        w.w = pack2(blo(ur.w) + blo(sg.w) * blo(pr.w), bhi(ur.w) + bhi(sg.w) * bhi(pr.w));
        *(uint4*)(p.O + o) = w;
      }
      __syncthreads();
    };
    gemm_tile<false>(rowfn, p.wg_t + ((size_t)l * 1024 + n0) * 1024, 1024, epi, lds, tid);
  }
}

#define XB_TMO      128
#define XB_XCNT(j)  (256  + 64 * (j))
#define XB_XSUB(j)  (1280 + 64 * (j))
#define XB_XGEN(j)  (2304 + 64 * (j))
#define XB_TOP      3328
#define XB_TOPGEN   3392
#define XCD_BAR_WORDS 3456
#define XB_SPIN_CAP (1u << 22)
#define LAS __attribute__((address_space(3)))
DI unsigned xb_ld(unsigned* p) { return __hip_atomic_load(p, __ATOMIC_RELAXED, __HIP_MEMORY_SCOPE_AGENT); }
DI unsigned xb_add(unsigned* p, unsigned v) { return __hip_atomic_fetch_add(p, v, __ATOMIC_RELAXED, __HIP_MEMORY_SCOPE_AGENT); }
DI unsigned xb_xcc_id() { return (unsigned)__builtin_amdgcn_s_getreg((3 << 11) | 20) & 0xFu; }
#define XB_SPIN(cond, bar) do { unsigned _sp = 0; while (cond) { __builtin_amdgcn_s_sleep(1); \
    if ((++_sp & 255u) == 0u) { if (xb_ld(&(bar)[XB_TMO])) break; if (_sp > XB_SPIN_CAP) { atomicAdd(&(bar)[XB_TMO], 1u); break; } } } } while (0)
struct XcdBarrier { unsigned* bar; unsigned x; volatile LAS unsigned* st; };
DI XcdBarrier xcd_barrier_post(unsigned* bar, volatile LAS unsigned* st) {
  XcdBarrier b; b.bar = bar; b.x = xb_xcc_id(); b.st = st;
  if (threadIdx.x == 0) (void)xb_add(&bar[XB_XCNT(b.x)], 1u);
  return b;
}
DI void xcd_barrier_complete(unsigned* bar, unsigned x, unsigned& nloc, unsigned& nx) {
  const unsigned G = gridDim.x * gridDim.y * gridDim.z;
  unsigned sum, cnt, mine, sp = 0u;
  for (;;) {
    sum = 0u; cnt = 0u; mine = 0u;
#pragma unroll
    for (unsigned j = 0; j < 16; ++j) { const unsigned c = xb_ld(&bar[XB_XCNT(j)]); sum += c; cnt += (c > 0u) ? 1u : 0u; mine = (j == x) ? c : mine; }
    if (sum == G) break;
    __builtin_amdgcn_s_sleep(1);
    if ((++sp & 255u) == 0u) { if (xb_ld(&bar[XB_TMO])) break; if (sp > XB_SPIN_CAP) { atomicAdd(&bar[XB_TMO], 1u); break; } }
  }
  nloc = mine > 0u ? mine : 1u; nx = cnt > 0u ? cnt : 1u;
}
DI void xcd_barrier(const XcdBarrier& b) {
  asm volatile("s_waitcnt vmcnt(0)" ::: "memory");
  __syncthreads();
  if (threadIdx.x == 0) {
    unsigned* bar = b.bar;
    __builtin_amdgcn_s_waitcnt(0);
    unsigned nloc = b.st[0], nx = b.st[1];
    if (nloc == 0u) { xcd_barrier_complete(bar, b.x, nloc, nx); b.st[0] = nloc; b.st[1] = nx; }
    const unsigned old = xb_add(&bar[XB_XSUB(b.x)], 1u);
    const unsigned gen = old / nloc;
    if (old + 1u == (gen + 1u) * nloc) {
      __builtin_amdgcn_fence(__ATOMIC_RELEASE, "agent");
      asm volatile("s_waitcnt vmcnt(0)" ::: "memory");
      const unsigned og = xb_add(&bar[XB_TOP], 1u);
      const unsigned tg = og / nx;
      if (og + 1u == (tg + 1u) * nx) xb_add(&bar[XB_TOPGEN], 1u);
      else XB_SPIN(xb_ld(&bar[XB_TOPGEN]) == tg, bar);
      __builtin_amdgcn_fence(__ATOMIC_ACQUIRE, "agent");
      xb_add(&bar[XB_XGEN(b.x)], 1u);
      asm volatile("s_waitcnt vmcnt(0)" ::: "memory");
    } else {
      XB_SPIN(xb_ld(&bar[XB_XGEN(b.x)]) == gen, bar);
      __builtin_amdgcn_fence(__ATOMIC_ACQUIRE, "agent");
      asm volatile("s_waitcnt vmcnt(0)" ::: "memory");
    }
  }
  __syncthreads();
}

__global__ void __launch_bounds__(NTHR, 2) mega(Params p) {
  __shared__ __attribute__((aligned(16))) char lds[73728];
  cg::grid_group grid = cg::this_grid();
  const int tid0 = threadIdx.x, bid0 = blockIdx.x, nb = gridDim.x;
  __shared__ uint4 xb_words;
  if (tid0 == 0) xb_words = make_uint4(0u, 0u, 0u, 0u);
  __syncthreads();
  const XcdBarrier xb = xcd_barrier_post(p.bar, (volatile LAS unsigned*)&xb_words);
  int pc = 0;
#define PHASE(...)                                      \
  {                                                     \
    if (pc >= p.pb && pc < p.pe) {                      \
      if (pc == p.pb + 1) grid.sync();                  \
      else if (pc > p.pb + 1) xcd_barrier(xb);          \
      int tid = tid0, bid = bid0;                       \
      asm volatile("" : "+v"(tid), "+s"(bid));          \
      __VA_ARGS__;                                      \
    }                                                   \
    pc++;                                               \
  }
  PHASE(phase_convert(p, lds, bid, nb, tid));
  for (int i = 0; i < REP_SYNC; i++) PHASE((void)0);
  for (int l = 0; l < 2; l++) {
    for (int sg = 0; sg < 3; sg++) {
      const int tok0 = sg * T_SUB;
      const int B = sg == 0 ? 4 : 8, N = sg == 0 ? 8192 : 4096;
      PHASE(phase_inproj(p, l, tok0, lds, bid, nb, tid));
#if REP_INPROJ || REP_GEMMS
      PHASE(phase_inproj(p, l, tok0, lds, bid, nb, tid));
#endif
      PHASE(phase_prep(p, l, N, bid, nb, tid));
      PHASE(phase_smallgemm(p, l, B, N, lds, bid, nb, tid));
#if REP_GEMMS
      PHASE(phase_smallgemm(p, l, B, N, lds, bid, nb, tid));
#endif
      PHASE(phase_mix(p, l, B, N, p.bar + XCD_BAR_WORDS + (l * 3 + sg) * 128, lds, bid, nb, tid));
#if REP_MIX
      PHASE(phase_mix(p, l, B, N, p.bar + XCD_BAR_WORDS + (6 + l * 3 + sg) * 128, lds, bid, nb, tid));
#endif
      PHASE(phase_final(p, l, bid, nb, tid));
      PHASE(phase_wout(p, l, tok0, lds, bid, nb, tid));
      PHASE(phase_ln<true>(p, p.ln1_g + l * 1024, p.ln1_b + l * 1024, p.moe_router + (size_t)l * 16384, tok0, T_SUB, lds, bid, nb, tid));
    }
    PHASE(phase_topk(p, lds, bid, nb, tid));
    PHASE(phase_moe1(p, l, lds, bid, nb, tid));
#if REP_MOE1 || REP_GEMMS
    PHASE(phase_moe1(p, l, lds, bid, nb, tid));
#endif
    PHASE(phase_moe2(p, l, lds, bid, nb, tid));
#if REP_GEMMS
    PHASE(phase_moe2(p, l, lds, bid, nb, tid));
#endif
    PHASE(phase_combine(p, bid, nb, tid));
    PHASE(phase_ple(p, l, lds, bid, nb, tid));
    PHASE(phase_ln<false>(p, p.ln2_g + l * 1024, p.ln2_b + l * 1024, nullptr, 0, T_ALL, lds, bid, nb, tid));
  }
}

#define N_PHASES 1000
#ifndef FUSED
#define FUSED 1
#endif

extern "C" void kernel_launch(void* const* d_in, const int* in_sizes, int n_in, void* d_out, int out_size, void* d_ws,
                              size_t ws_size, hipStream_t stream) {
  static int grid_blocks = 0;
  if (!grid_blocks) {
    int dev = 0, cus = 0, per_cu = 0;
    (void)hipGetDevice(&dev);
    (void)hipDeviceGetAttribute(&cus, hipDeviceAttributeMultiprocessorCount, dev);
    (void)hipOccupancyMaxActiveBlocksPerMultiprocessor(&per_cu, mega, NTHR, 0);
    if (per_cu > 2) per_cu = 2;
    if (per_cu < 1) per_cu = 1;
    grid_blocks = cus * per_cu;
  }
  Params p;
  memset(&p, 0, sizeof(p));
  const float* const* in = (const float* const*)d_in;
  int k = 0;
  p.x_prompt = in[k++]; p.x_sample = in[k++]; p.p_prompt = in[k++]; p.p_sample = in[k++];
  p.w_in = in[k++]; p.mla_gq = in[k++]; p.mla_gkv = in[k++]; p.mla_wuq = in[k++]; p.mla_wuk = in[k++]; p.mla_wuv = in[k++];
  p.na_bias = in[k++]; p.hg_lb = in[k++]; p.hg_gnorm = in[k++];
  p.rw_mu = in[k++]; p.rw_w0 = in[k++]; p.rw_w_up = in[k++]; p.rw_a0 = in[k++]; p.rw_a_up = in[k++]; p.rw_g_up = in[k++];
  p.rw_kk = in[k++]; p.rw_ka = in[k++]; p.rw_rk = in[k++]; p.rw_ln_w = in[k++]; p.rw_ln_b = in[k++];
  p.w_out = in[k++]; p.ln1_g = in[k++]; p.ln1_b = in[k++]; p.moe_router = in[k++]; p.moe_w1 = in[k++]; p.moe_w3 = in[k++];
  p.moe_w2 = in[k++]; p.ln2_g = in[k++]; p.ln2_b = in[k++]; p.ple_gate = in[k++]; p.ple_proj = in[k++];
  p.out = (float*)d_out;
  char* ws = (char*)d_ws;
  size_t off = 0;
  auto take = [&](size_t bytes) { char* r = ws + off; off += (bytes + 255) & ~(size_t)255; return r; };
  p.w_in_t = (u16*)take((size_t)2 * 3712 * 1024 * 2);
  p.wuq_t = (u16*)take((size_t)2 * 384 * 256 * 2);
  p.wkv_t = (u16*)take((size_t)2 * 512 * 128 * 2);
  p.wup_t = (u16*)take((size_t)4 * 256 * 64 * 2);
  p.aup_t = (u16*)take((size_t)4 * 256 * 64 * 2);
  p.gup_t = (u16*)take((size_t)2 * 256 * 128 * 2);
  p.wout_t = (u16*)take((size_t)2 * 1024 * 1024 * 2);
  p.w13_t = (u16*)take((size_t)32 * 1024 * 1024 * 2);
  p.w2_t = (u16*)take((size_t)32 * 1024 * 512 * 2);
  p.wg_t = (u16*)take((size_t)2 * 1024 * 1024 * 2);
  p.wp_t = (u16*)take((size_t)2 * 1024 * 256 * 2);
  p.ropec = (float*)take((size_t)8192 * 16 * 4);
  p.ropes = (float*)take((size_t)8192 * 16 * 4);
  p.lb = (float*)take(1024 * 4);
  p.affT = (float*)take((size_t)16 * T_ALL * 4);
  p.gate = (float*)take((size_t)196608 * 4);
  p.idx = (int*)take((size_t)196608 * 4);
  p.bar = (unsigned*)take((size_t)(XCD_BAR_WORDS + 12 * 128) * 4);
  p.inv_cnt = (int*)take((size_t)T_ALL * 4);
  p.inv_slot = (int*)take((size_t)T_ALL * 16 * 4);
  p.xb = (u16*)take((size_t)T_ALL * 1024 * 2);
  const size_t stage0 = off;
  p.z = (u16*)take((size_t)T_SUB * ZLD * 2);
  p.cat = (u16*)take((size_t)T_SUB * 1024 * 2);
  p.Q = (u16*)take((size_t)T_SUB * 384 * 2);
  p.Kb = (u16*)take((size_t)T_SUB * 384 * 2);
  p.Vt = (u16*)take((size_t)T_SUB * 256 * 2);
  p.cqn = (u16*)take((size_t)T_SUB * 256 * 2);
  p.ckvn = (u16*)take((size_t)T_SUB * 128 * 2);
  p.S1 = (u16*)take((size_t)T_SUB * 384 * 2);
  p.rs = (u16*)take((size_t)T_SUB * 256 * 2);
  p.ks = (u16*)take((size_t)T_SUB * 256 * 2);
  p.vs = (u16*)take((size_t)T_SUB * 256 * 2);
  p.kk = (u16*)take((size_t)T_SUB * 256 * 2);
  p.gD = (u16*)take((size_t)T_SUB * 256 * 2);
  p.dec = (u16*)take((size_t)2 * T_SUB * 256 * 2);
  p.kka = (u16*)take((size_t)2 * T_SUB * 256 * 2);
  p.kt = (u16*)take((size_t)2 * T_SUB * 256 * 2);
  p.oC = (u16*)take((size_t)2 * T_SUB * 256 * 2);
  p.oD = (u16*)take((size_t)2 * T_SUB * 256 * 2);
  p.bonus = (float*)take((size_t)T_SUB * 4 * 4);
  off = stage0;
  p.O = (u16*)take((size_t)196608 * 1024 * 2);
  p.H = (u16*)take((size_t)196608 * 512 * 2);
  for (int i = 0; i < 16; i++) p.inv_freq[i] = pow(10000.0, -(double)i / 16.0);
  (void)hipMemsetAsync(p.bar, 0, (size_t)(XCD_BAR_WORDS + 12 * 128) * 4, stream);
#if FUSED
  p.pb = 0;
  p.pe = N_PHASES;
  {
    void* args[] = {&p};
    hipError_t e = hipLaunchCooperativeKernel((void*)mega, dim3(grid_blocks), dim3(NTHR), args, 0, stream);
    if (e != hipSuccess) fprintf(stderr, "cooperative launch failed: %s (grid %d)\n", hipGetErrorString(e), grid_blocks);
  }
#else
  for (int ph = 0; ph < N_PHASES; ph++) {
    p.pb = ph;
    p.pe = ph + 1;
    void* args[] = {&p};
    hipError_t e = hipLaunchCooperativeKernel((void*)mega, dim3(grid_blocks), dim3(NTHR), args, 0, stream);
    if (e != hipSuccess) fprintf(stderr, "cooperative launch failed: %s (grid %d)\n", hipGetErrorString(e), grid_blocks);
  }
#endif
}
```

```cpp
#include <hip/hip_runtime.h>
#include <hip/hip_cooperative_groups.h>
#include <cstdio>
#include <cmath>
#include <cstring>
namespace cg = cooperative_groups;

typedef unsigned short u16;
using bf16x8 = __attribute__((ext_vector_type(8))) short;
using f32x4 = __attribute__((ext_vector_type(4))) float;
using f32x16 = __attribute__((ext_vector_type(16))) float;

#define REP_INPROJ 0
#define REP_ATTN 0
#define REP_NA 0
#define REP_SCAN 0
#define REP_MOE1 0
#define REP_MOE2 0
#define REP_SYNC 0
#define REP_MIX 0
#define REP_GEMMS 0
#define DI __device__ __forceinline__
#define NTHR 256
#define T_ALL 98304
#define T_SUB 32768
#define ZLD 3616
#define ZB_OFF 416
#define ZC_OFF 1184
#define ZD_OFF 2464
#define LOG2E 1.4426950408889634f
#define ALPHA_F 1.4142135623730951f

struct Params {
  const float *x_prompt, *x_sample, *p_prompt, *p_sample;
  const float *w_in, *mla_gq, *mla_gkv, *mla_wuq, *mla_wuk, *mla_wuv, *na_bias, *hg_lb, *hg_gnorm;
  const float *rw_mu, *rw_w0, *rw_w_up, *rw_a0, *rw_a_up, *rw_g_up, *rw_kk, *rw_ka, *rw_rk, *rw_ln_w, *rw_ln_b;
  const float *w_out, *ln1_g, *ln1_b, *moe_router, *moe_w1, *moe_w3, *moe_w2, *ln2_g, *ln2_b, *ple_gate, *ple_proj;
  float* out;
  u16 *w_in_t, *wuq_t, *wkv_t, *wup_t, *aup_t, *gup_t, *wout_t, *w13_t, *w2_t, *wg_t, *wp_t;
  float *ropec, *ropes, *lb, *affT, *gate;
  int* idx;
  unsigned* bar;
  int *inv_cnt, *inv_slot;
  u16 *z, *cat, *Q, *Kb, *Vt, *cqn, *ckvn, *S1, *rs, *ks, *vs, *kk, *gD, *dec, *kka, *kt, *oC, *oD;
  float* bonus;
  u16* xb;
  u16* O;
  u16* H;
  double inv_freq[16];
  int pb, pe;
};

typedef __bf16 v2bf_t __attribute__((ext_vector_type(2)));
typedef float v2f_t __attribute__((ext_vector_type(2)));
typedef unsigned u32x4_t __attribute__((ext_vector_type(4)));
DI unsigned pack2(float a, float b) {
  v2f_t f = {a, b};
  v2bf_t h = __builtin_convertvector(f, v2bf_t);
  return __builtin_bit_cast(unsigned, h);
}
DI u16 f2bf(float f) { return (u16)(pack2(f, 0.f) & 0xffffu); }
DI float bf2f(u16 h) { return __uint_as_float(((unsigned)h) << 16); }
DI float blo(unsigned u) { return __uint_as_float(u << 16); }
DI float bhi(unsigned u) { return __uint_as_float(u & 0xffff0000u); }
DI float sigm(float x) { return 1.f / (1.f + __expf(-x)); }
DI float tanh_(float x) { return 1.f - 2.f / (__expf(2.f * x) + 1.f); }
DI float ex2(float x) { return __builtin_amdgcn_exp2f(x); }
DI int clampi(int v, int lo, int hi) { return v < lo ? lo : (v > hi ? hi : v); }
DI int swap23(int x) { return (x & ~12) | ((x & 4) << 1) | ((x & 8) >> 1); }

template <int CTRL> DI float dpp_f(float v) {
  return __int_as_float(__builtin_amdgcn_update_dpp(0, __float_as_int(v), CTRL, 0xF, 0xF, true));
}
DI float reduce16(float v) {
  v += dpp_f<0xB1>(v);
  v += dpp_f<0x4E>(v);
  v += dpp_f<0x141>(v);
  v += dpp_f<0x140>(v);
  return v;
}
DI float wave_sum(float v) {
  v = reduce16(v);
  v += __shfl_xor(v, 16);
  v += __shfl_xor(v, 32);
  return v;
}

struct TileIter {
  int bid, nb, off;
  DI int first(int n) { int f = bid - off; if (f < 0) f += nb; off = (off + n) % nb; return f; }
};

DI bool xcd_tile(int it, int bid, int nb, int MT, int NT, int& mt, int& nt) {
  const int x = bid & 7, slot = bid >> 3, nslots = nb >> 3;
  const int mper = MT >> 3;
  const int i = slot + it * nslots;
  if (i >= mper * NT) return false;
  const int mi = i & 7, rest = i >> 3;
  nt = rest % NT;
  mt = x * mper + (rest / NT) * 8 + mi;
  return true;
}

DI void convT_job(const float* __restrict__ W, int K, int N, int Npad, u16* __restrict__ Wt, int mode, char* lds,
                  TileIter& it, int tid) {
  float(*tile)[65] = (float(*)[65])lds;
  int tk = K >> 6, tn = Npad >> 6;
  int nt = tk * tn;
  for (int t = it.first(nt); t < nt; t += it.nb) {
    int k0 = (t % tk) << 6, n0 = (t / tk) << 6;
#pragma unroll
    for (int i = 0; i < 16; i++) {
      int kl = (tid >> 6) + 4 * i, nl = tid & 63;
      int n = n0 + nl;
      tile[kl][nl] = (n < N) ? W[(size_t)(k0 + kl) * N + n] : 0.f;
    }
    __syncthreads();
    {
      int nl = tid >> 2, ks = (tid & 3) * 16;
      int n = n0 + nl;
      int row = n;
      if (mode == 1) row = (n >> 4) * 32 + (n & 15);
      if (mode == 2) row = (n >> 4) * 32 + 16 + (n & 15);
      unsigned pk[8];
#pragma unroll
      for (int j = 0; j < 8; j++) pk[j] = pack2(tile[ks + 2 * j][nl], tile[ks + 2 * j + 1][nl]);
      uint4* dst = (uint4*)(Wt + (size_t)row * K + k0 + ks);
      dst[0] = make_uint4(pk[0], pk[1], pk[2], pk[3]);
      dst[1] = make_uint4(pk[4], pk[5], pk[6], pk[7]);
    }
    __syncthreads();
  }
}

DI void phase_convert(const Params& p, char* lds, int bid, int nb, int tid) {
  TileIter it{bid, nb, 0};
  for (int l = 0; l < 2; l++) {
    convT_job(p.w_in + (size_t)l * 1024 * 3616, 1024, 3616, 3712, p.w_in_t + (size_t)l * 3712 * 1024, 0, lds, it, tid);
    convT_job(p.mla_wuq + (size_t)l * 256 * 384, 256, 384, 384, p.wuq_t + (size_t)l * 384 * 256, 0, lds, it, tid);
    convT_job(p.mla_wuk + (size_t)l * 128 * 256, 128, 256, 256, p.wkv_t + (size_t)l * 512 * 128, 0, lds, it, tid);
    convT_job(p.mla_wuv + (size_t)l * 128 * 256, 128, 256, 256, p.wkv_t + (size_t)l * 512 * 128 + 256 * 128, 0, lds, it, tid);
    for (int d = 0; d < 2; d++) {
      convT_job(p.rw_w_up + (size_t)(l * 2 + d) * 64 * 256, 64, 256, 256, p.wup_t + (size_t)(l * 2 + d) * 256 * 64, 0, lds, it, tid);
      convT_job(p.rw_a_up + (size_t)(l * 2 + d) * 64 * 256, 64, 256, 256, p.aup_t + (size_t)(l * 2 + d) * 256 * 64, 0, lds, it, tid);
    }
    convT_job(p.rw_g_up + (size_t)l * 128 * 256, 128, 256, 256, p.gup_t + (size_t)l * 256 * 128, 0, lds, it, tid);
    convT_job(p.w_out + (size_t)l * 1024 * 1024, 1024, 1024, 1024, p.wout_t + (size_t)l * 1024 * 1024, 0, lds, it, tid);
    for (int e = 0; e < 16; e++) {
      size_t le = (size_t)(l * 16 + e);
      convT_job(p.moe_w1 + le * 1024 * 512, 1024, 512, 512, p.w13_t + le * 1024 * 1024, 1, lds, it, tid);
      convT_job(p.moe_w3 + le * 1024 * 512, 1024, 512, 512, p.w13_t + le * 1024 * 1024, 2, lds, it, tid);
      convT_job(p.moe_w2 + le * 512 * 1024, 512, 1024, 1024, p.w2_t + le * 1024 * 512, 0, lds, it, tid);
    }
    convT_job(p.ple_gate + (size_t)l * 1024 * 1024, 1024, 1024, 1024, p.wg_t + (size_t)l * 1024 * 1024, 0, lds, it, tid);
    convT_job(p.ple_proj + (size_t)l * 256 * 1024, 256, 1024, 1024, p.wp_t + (size_t)l * 1024 * 256, 0, lds, it, tid);
  }
  int gt = bid * NTHR + tid, ng = nb * NTHR;
  for (size_t i0 = gt; i0 < (size_t)T_ALL * 256; i0 += (size_t)ng * 8) {
    float4 v[8];
#pragma unroll
    for (int u = 0; u < 8; u++) {
      const size_t i = i0 + (size_t)u * ng;
      v[u] = make_float4(0.f, 0.f, 0.f, 0.f);
      if (i < (size_t)T_ALL * 256)
        v[u] = (i < (size_t)32768 * 256) ? ((const float4*)p.x_prompt)[i] : ((const float4*)p.x_sample)[i - (size_t)32768 * 256];
    }
#pragma unroll
    for (int u = 0; u < 8; u++) {
      const size_t i = i0 + (size_t)u * ng;
      if (i < (size_t)T_ALL * 256) ((uint2*)p.xb)[i] = make_uint2(pack2(v[u].x, v[u].y), pack2(v[u].z, v[u].w));
    }
  }
  for (int i = gt; i < 8192 * 16; i += ng) {
    int n = i >> 4, f = i & 15;
    double ifq = 0.0;
#pragma unroll
    for (int j = 0; j < 16; j++) ifq = (f == j) ? p.inv_freq[j] : ifq;
    double rev = (double)n * ifq * 0.15915494309189535;
    double fr = rev - rint(rev);
    float ff = (float)fr;
    p.ropec[i] = __builtin_amdgcn_cosf(ff);
    p.ropes[i] = __builtin_amdgcn_sinf(ff);
  }
  for (int i = gt; i < 512; i += ng) {
    float h0 = p.hg_lb[i], h1 = p.hg_lb[512 + i];
    p.lb[i] = 0.f;
    p.lb[512 + i] = 1.f / (1.f + __expf(h0 - h1));
  }
}

constexpr int G_STAGE = 32768;

template <bool AF32, class RowFn, class Epi>
DI void gemm_tile(RowFn rowfn, const u16* __restrict__ Bt, int K, Epi epi, char* lds, int tid) {
  const int lane = tid & 63, wid = tid >> 6, wr = wid >> 1, wc = wid & 1, fr = lane & 15, fq = lane >> 4;
  f32x4 acc[4][4];
#pragma unroll
  for (int m = 0; m < 4; m++)
#pragma unroll
    for (int n = 0; n < 4; n++) acc[m][n] = f32x4{0.f, 0.f, 0.f, 0.f};

  const int lrow = tid >> 3;
  const int lc = (tid & 7) ^ ((tid >> 4) & 7);
  const float* apf[8];
  const u16* aph[4];
  const u16* bp[4];
  if constexpr (AF32) {
#pragma unroll
    for (int i = 0; i < 8; i++) apf[i] = (const float*)rowfn(i * 16 + (tid >> 4)) + (tid & 15) * 4;
  } else {
#pragma unroll
    for (int i = 0; i < 4; i++) aph[i] = (const u16*)rowfn(lrow + i * 32) + lc * 8;
  }
#pragma unroll
  for (int i = 0; i < 4; i++) bp[i] = Bt + (size_t)(lrow + i * 32) * K + lc * 8;
  const int afoff = (tid >> 4) * 128 + ((((tid & 15) >> 1) ^ ((tid >> 5) & 7)) * 16) + (tid & 1) * 8;

  float4 raf[8];
  auto issue = [&](int buf, int k0) {
    char* A = lds + buf * G_STAGE;
    char* B = A + 16384;
#pragma unroll
    for (int i = 0; i < 4; i++)
      __builtin_amdgcn_global_load_lds((const unsigned*)(bp[i] + k0), (unsigned*)(B + wid * 1024 + i * 4096), 16, 0, 0);
    if constexpr (AF32) {
#pragma unroll
      for (int i = 0; i < 8; i++) raf[i] = *(const float4*)(apf[i] + k0);
    } else {
#pragma unroll
      for (int i = 0; i < 4; i++)
        __builtin_amdgcn_global_load_lds((const unsigned*)(aph[i] + k0), (unsigned*)(A + wid * 1024 + i * 4096), 16, 0, 0);
    }
  };
  auto astore = [&](int buf) {
    if constexpr (AF32) {
      char* A = lds + buf * G_STAGE;
#pragma unroll
      for (int i = 0; i < 8; i++) asm volatile("" : "+v"(raf[i].x), "+v"(raf[i].y), "+v"(raf[i].z), "+v"(raf[i].w));
#pragma unroll
      for (int i = 0; i < 8; i++)
        *(uint2*)(A + afoff + i * 2048) = make_uint2(pack2(raf[i].x, raf[i].y), pack2(raf[i].z, raf[i].w));
    }
  };
  const int abase = (wr * 64 + fr) * 128, bbase = 16384 + (wc * 64 + fr) * 128;
  const int sw0 = ((fq) ^ (fr >> 1)) * 16, sw1 = ((4 + fq) ^ (fr >> 1)) * 16;

  const int nk = K >> 6;
  if constexpr (AF32) {
    issue(0, 0);
    astore(0);
    __syncthreads();
    for (int kt = 0; kt < nk; kt++) {
      const char* S = lds + (kt & 1) * G_STAGE;
      bf16x8 af[2][4], bfr[2][4];
#pragma unroll
      for (int kk = 0; kk < 2; kk++) {
        const int sw = kk ? sw1 : sw0;
#pragma unroll
        for (int m = 0; m < 4; m++) af[kk][m] = *(const bf16x8*)(S + abase + m * 2048 + sw);
#pragma unroll
        for (int n = 0; n < 4; n++) bfr[kk][n] = *(const bf16x8*)(S + bbase + n * 2048 + sw);
      }
      __builtin_amdgcn_sched_barrier(0);
      if (kt + 1 < nk) issue((kt + 1) & 1, (kt + 1) << 6);
      __builtin_amdgcn_sched_barrier(0);
#pragma unroll
      for (int kk = 0; kk < 2; kk++)
#pragma unroll
        for (int m = 0; m < 4; m++)
#pragma unroll
          for (int n = 0; n < 4; n++) acc[m][n] = __builtin_amdgcn_mfma_f32_16x16x32_bf16(bfr[kk][n], af[kk][m], acc[m][n], 0, 0, 0);
      __builtin_amdgcn_sched_barrier(0);
      if (kt + 1 < nk) astore((kt + 1) & 1);
      __syncthreads();
    }
  } else {
    const unsigned lds0 = (unsigned)(size_t)(__attribute__((address_space(3))) char*)lds;
    const unsigned aA0 = lds0 + abase + sw0, aA1 = lds0 + abase + sw1, aB0 = lds0 + bbase + sw0, aB1 = lds0 + bbase + sw1;
#define G_DSR(dst, addr, off) asm volatile("ds_read_b128 %0, %1 offset:%2" : "=v"(dst) : "v"(addr), "n"(off))
    issue(0, 0);
    if (nk > 1) issue(1, 64);
    for (int kt = 0; kt < nk; kt++) {
      if (kt + 1 < nk) asm volatile("s_waitcnt vmcnt(8)" ::: "memory");
      else asm volatile("s_waitcnt vmcnt(0)" ::: "memory");
      __builtin_amdgcn_s_barrier();
      const unsigned so = (kt & 1) * G_STAGE;
      const unsigned pA0 = aA0 + so, pA1 = aA1 + so, pB0 = aB0 + so, pB1 = aB1 + so;
      bf16x8 a00, a01, a02, a03, a10, a11, a12, a13, b00, b01, b02, b03, b10, b11, b12, b13;
      G_DSR(a00, pA0, 0); G_DSR(a01, pA0, 2048); G_DSR(a02, pA0, 4096); G_DSR(a03, pA0, 6144);
      G_DSR(b00, pB0, 0); G_DSR(b01, pB0, 2048); G_DSR(b02, pB0, 4096); G_DSR(b03, pB0, 6144);
      G_DSR(a10, pA1, 0); G_DSR(a11, pA1, 2048); G_DSR(a12, pA1, 4096); G_DSR(a13, pA1, 6144);
      G_DSR(b10, pB1, 0); G_DSR(b11, pB1, 2048); G_DSR(b12, pB1, 4096); G_DSR(b13, pB1, 6144);
      asm volatile("s_waitcnt lgkmcnt(0)" : "+v"(a00), "+v"(a01), "+v"(a02), "+v"(a03), "+v"(b00), "+v"(b01), "+v"(b02), "+v"(b03));
      asm volatile("" : "+v"(a10), "+v"(a11), "+v"(a12), "+v"(a13), "+v"(b10), "+v"(b11), "+v"(b12), "+v"(b13));
      __builtin_amdgcn_s_barrier();
      if (kt + 2 < nk) issue(kt & 1, (kt + 2) << 6);
      __builtin_amdgcn_sched_barrier(0);
      {
        const bf16x8 af0[4] = {a00, a01, a02, a03}, af1[4] = {a10, a11, a12, a13};
        const bf16x8 bf0[4] = {b00, b01, b02, b03}, bf1[4] = {b10, b11, b12, b13};
#pragma unroll
        for (int m = 0; m < 4; m++)
#pragma unroll
          for (int n = 0; n < 4; n++) acc[m][n] = __builtin_amdgcn_mfma_f32_16x16x32_bf16(bf0[n], af0[m], acc[m][n], 0, 0, 0);
#pragma unroll
        for (int m = 0; m < 4; m++)
#pragma unroll
          for (int n = 0; n < 4; n++) acc[m][n] = __builtin_amdgcn_mfma_f32_16x16x32_bf16(bf1[n], af1[m], acc[m][n], 0, 0, 0);
      }
      __builtin_amdgcn_sched_barrier(0);
    }
  }
  epi(acc, wr * 64 + fr, wc * 64 + fq * 4);
}

#define EPI_LOOP(...)                                    \
  _Pragma("unroll") for (int m = 0; m < 4; m++)          \
  _Pragma("unroll") for (int n = 0; n < 4; n++) {        \
    const int row = rbase + m * 16;                      \
    const int col = cbase + n * 16;                      \
    const f32x4 v = acc[m][n];                           \
    __VA_ARGS__                                          \
  }

DI void st_bf4(u16* dst, f32x4 v) { *(uint2*)dst = make_uint2(pack2(v[0], v[1]), pack2(v[2], v[3])); }

DI void epi_store_rows_bf16(f32x4 (&acc)[4][4], int rbase, int cbase, char* lds, int tid, u16* dst, size_t ld, int ncols) {
#pragma unroll
  for (int m = 0; m < 4; m++)
#pragma unroll
    for (int n = 0; n < 4; n++)
      *(uint2*)(lds + (rbase + m * 16) * 272 + (cbase + n * 16) * 2) =
          make_uint2(pack2(acc[m][n][0], acc[m][n][1]), pack2(acc[m][n][2], acc[m][n][3]));
  __syncthreads();
#pragma unroll
  for (int i = 0; i < 8; i++) {
    const int id = tid + 256 * i, row = id >> 4, c = id & 15;
    if (c * 8 < ncols) *(uint4*)(dst + (size_t)row * ld + c * 8) = *(const uint4*)(lds + row * 272 + c * 16);
  }
  __syncthreads();
}

DI const float* xin_row(const Params& p, int l, int tg) {
  if (l == 0) return tg < 32768 ? p.x_prompt + (size_t)tg * 1024 : p.x_sample + (size_t)(tg - 32768) * 1024;
  return p.out + (size_t)tg * 1024;
}

DI void phase_inproj(const Params& p, int l, int tok0, char* lds, int bid, int nb, int tid) {
  const int NT = 29, MT = T_SUB / 128;
  for (int it = 0;; it++) {
    int nt, mt;
    if (!xcd_tile(it, bid, nb, MT, NT, mt, nt)) break;
    int m0 = mt * 128, n0 = nt * 128;
    auto rowfn = [&](int r) -> const void* { return p.xb + (size_t)(tok0 + m0 + r) * 1024; };
    u16* z = p.z;
    auto epi = [&](f32x4(&acc)[4][4], int rbase, int cbase) {
      epi_store_rows_bf16(acc, rbase, cbase, lds, tid, z + (size_t)m0 * ZLD + n0, ZLD, min(128, ZLD - n0));
    };
    gemm_tile<false>(rowfn, p.w_in_t + ((size_t)l * 3712 + n0) * 1024, 1024, epi, lds, tid);
  }
}

struct PrepIn {
  uint2 cq;
  unsigned ckv;
  u16 kr1, kr2;
  float rc, rsn;
  uint4 f;
  uint2 cur[3], prv[3], nxt[3];
  u16 sc[6], sp[6], sn[6];
};
DI void prep_load(PrepIn& in, const Params& p, int t, int N, int lane) {
  const int l15 = lane & 15, c4 = lane * 4;
  const u16* zr = p.z + (size_t)t * ZLD;
  const int n = t & (N - 1);
  const bool hp = n > 0, hn = n < N - 1;
  const u16* zd = zr + ZD_OFF;
  const u16* zdp = zd - (hp ? ZLD : 0);
  const u16* zdn = zd + (hn ? ZLD : 0);
  in.cq = *(const uint2*)(zr + c4);
  in.ckv = *(const unsigned*)(zr + 256 + lane * 2);
  in.kr1 = zr[384 + l15];
  in.kr2 = zr[400 + l15];
  in.rc = p.ropec[n * 16 + l15];
  in.rsn = p.ropes[n * 16 + l15];
  in.f = *(const uint4*)(zr + ZC_OFF + 256 + lane * 8);
#pragma unroll
  for (int part = 0; part < 3; part++) {
    in.cur[part] = *(const uint2*)(zd + part * 256 + c4);
    in.prv[part] = *(const uint2*)(zdp + part * 256 + c4);
    in.nxt[part] = *(const uint2*)(zdn + part * 256 + c4);
  }
#pragma unroll
  for (int i = 0; i < 6; i++) {
    in.sc[i] = zd[768 + lane + 64 * i];
    in.sp[i] = zdp[768 + lane + 64 * i];
    in.sn[i] = zdn[768 + lane + 64 * i];
  }
}

DI void phase_prep(const Params& p, int l, int N, int bid, int nb, int tid) {
  const int lane = tid & 63, wv = tid >> 6, l15 = lane & 15, c4 = lane * 4;
  float gqv[4], gkvv[2], lbv[8], m0[12], m1[12], m0s[6], m1s[6], kkc[4], rkc[4];
  {
    const float* mu0 = p.rw_mu + (size_t)l * 2 * 1152;
    const float* mu1 = mu0 + 1152;
#pragma unroll
    for (int j = 0; j < 4; j++) {
      gqv[j] = p.mla_gq[l * 256 + c4 + j];
      kkc[j] = p.rw_kk[l * 256 + c4 + j];
      rkc[j] = p.rw_rk[l * 256 + c4 + j];
    }
    gkvv[0] = p.mla_gkv[l * 128 + lane * 2];
    gkvv[1] = p.mla_gkv[l * 128 + lane * 2 + 1];
#pragma unroll
    for (int j = 0; j < 8; j++) lbv[j] = p.lb[l * 512 + lane * 8 + j];
#pragma unroll
    for (int part = 0; part < 3; part++)
#pragma unroll
      for (int j = 0; j < 4; j++) {
        m0[part * 4 + j] = mu0[part * 256 + c4 + j];
        m1[part * 4 + j] = mu1[part * 256 + c4 + j];
      }
#pragma unroll
    for (int i = 0; i < 6; i++) {
      m0s[i] = mu0[768 + lane + 64 * i];
      m1s[i] = mu1[768 + lane + 64 * i];
    }
  }
  PrepIn in, inn;
  {
    const int t0 = bid * 4 + wv;
    if (t0 < T_SUB) prep_load(in, p, t0, N, lane);
  }
  for (int t = bid * 4 + wv; t < T_SUB; t += nb * 4) {
    u16* zr = p.z + (size_t)t * ZLD;
    const int n = t & (N - 1);
    const bool hp = n > 0, hn = n < N - 1;
    {
      const int tn = t + nb * 4;
      if (tn < T_SUB) prep_load(inn, p, tn, N, lane);
      else inn = in;
    }
    const uint2 raw_cq = in.cq;
    const unsigned raw_ckv = in.ckv;
    const u16 kr1 = in.kr1, kr2 = in.kr2;
    const float rc = in.rc, rsn = in.rsn;
    uint4* fptr = (uint4*)(zr + ZC_OFF + 256 + lane * 8);
    const uint4 raw_f = in.f;
    uint2 cur[3], prv[3], nxt[3];
    u16 sc[6], sp[6], sn[6];
#pragma unroll
    for (int part = 0; part < 3; part++) { cur[part] = in.cur[part]; prv[part] = in.prv[part]; nxt[part] = in.nxt[part]; }
#pragma unroll
    for (int i = 0; i < 6; i++) { sc[i] = in.sc[i]; sp[i] = in.sp[i]; sn[i] = in.sn[i]; }
    {
      float v0 = blo(raw_cq.x), v1 = bhi(raw_cq.x), v2 = blo(raw_cq.y), v3 = bhi(raw_cq.y);
      float ss = wave_sum(v0 * v0 + v1 * v1 + v2 * v2 + v3 * v3);
      float ri = rsqrtf(ss * (1.f / 256.f) + 1e-6f);
      *(uint2*)(p.cqn + (size_t)t * 256 + c4) =
          make_uint2(pack2(v0 * ri * gqv[0], v1 * ri * gqv[1]), pack2(v2 * ri * gqv[2], v3 * ri * gqv[3]));
    }
    {
      float v0 = blo(raw_ckv), v1 = bhi(raw_ckv);
      float ss = wave_sum(v0 * v0 + v1 * v1);
      float ri = rsqrtf(ss * (1.f / 128.f) + 1e-6f);
      *(unsigned*)(p.ckvn + (size_t)t * 128 + lane * 2) = pack2(v0 * ri * gkvv[0], v1 * ri * gkvv[1]);
    }
    if (lane < 16) {
      float x1 = bf2f(kr1), x2 = bf2f(kr2);
      u16 k1 = f2bf(x1 * rc - x2 * rsn), k2 = f2bf(x1 * rsn + x2 * rc);
      u16* kb = p.Kb + (size_t)t * 384;
#pragma unroll
      for (int h = 0; h < 4; h++) {
        kb[h * 96 + 64 + lane] = k1;
        kb[h * 96 + 80 + lane] = k2;
      }
    }
    {
      unsigned w[4] = {raw_f.x, raw_f.y, raw_f.z, raw_f.w};
#pragma unroll
      for (int j = 0; j < 4; j++) {
        float a = blo(w[j]), bq = bhi(w[j]);
        float la = lbv[2 * j], lb2 = lbv[2 * j + 1];
        a = la + (1.f - la) * sigm(a);
        bq = lb2 + (1.f - lb2) * sigm(bq);
        w[j] = pack2(a, bq);
      }
      *fptr = make_uint4(w[0], w[1], w[2], w[3]);
    }
    {
      float rr[4], kx[4], vx[4];
#pragma unroll
      for (int part = 0; part < 3; part++) {
        float cz[4] = {blo(cur[part].x), bhi(cur[part].x), blo(cur[part].y), bhi(cur[part].y)};
        float pz[4] = {blo(prv[part].x), bhi(prv[part].x), blo(prv[part].y), bhi(prv[part].y)};
        float nz[4] = {blo(nxt[part].x), bhi(nxt[part].x), blo(nxt[part].y), bhi(nxt[part].y)};
#pragma unroll
        for (int j = 0; j < 4; j++) {
          float pzz = hp ? pz[j] : 0.f, nzz = hn ? nz[j] : 0.f;
          float o = cz[j] + m0[part * 4 + j] * (pzz - cz[j]) + m1[part * 4 + j] * (nzz - cz[j]);
          if (part == 0) rr[j] = o;
          if (part == 1) kx[j] = o;
          if (part == 2) vx[j] = o;
        }
      }
      *(uint2*)(p.rs + (size_t)t * 256 + c4) = make_uint2(pack2(rr[0], rr[1]), pack2(rr[2], rr[3]));
      *(uint2*)(p.ks + (size_t)t * 256 + c4) = make_uint2(pack2(kx[0], kx[1]), pack2(kx[2], kx[3]));
      *(uint2*)(p.vs + (size_t)t * 256 + c4) = make_uint2(pack2(vx[0], vx[1]), pack2(vx[2], vx[3]));
      float kq[4], ss = 0.f, bo = 0.f;
#pragma unroll
      for (int j = 0; j < 4; j++) {
        kq[j] = kx[j] * kkc[j];
        ss += kq[j] * kq[j];
        bo += rr[j] * kx[j] * rkc[j];
      }
      ss = reduce16(ss);
      bo = reduce16(bo);
      float inv = 1.f / fmaxf(sqrtf(ss), 1e-12f);
      *(uint2*)(p.kk + (size_t)t * 256 + c4) = make_uint2(pack2(kq[0] * inv, kq[1] * inv), pack2(kq[2] * inv, kq[3] * inv));
      if (l15 == 0) p.bonus[(size_t)t * 4 + (lane >> 4)] = bo;
#pragma unroll
      for (int i = 0; i < 6; i++) {
        float cz = bf2f(sc[i]);
        float pz = hp ? bf2f(sp[i]) : 0.f;
        float nz = hn ? bf2f(sn[i]) : 0.f;
        float o = cz + m0s[i] * (pz - cz) + m1s[i] * (nz - cz);
        if (i < 2) o = tanh_(o);
        else if (i >= 4) o = sigm(o);
        p.S1[(size_t)t * 384 + lane + 64 * i] = f2bf(o);
      }
    }
    in = inn;
  }
}

DI void phase_smallgemm(const Params& p, int l, int B, int N, char* lds, int bid, int nb, int tid) {
  TileIter it{bid, nb, 0};
  const int MT = T_SUB / 128;
  {
    const int NT = 3;
    for (int itx = 0;; itx++) {
      int nt, mt;
      if (!xcd_tile(itx, bid, nb, MT, NT, mt, nt)) break;
      int m0 = mt * 128, n0 = nt * 128;
      auto rowfn = [&](int r) -> const void* { return p.cqn + (size_t)(m0 + r) * 256; };
      u16* Q = p.Q;
      auto epi = [&](f32x4(&acc)[4][4], int rbase, int cbase) {
        const float SC = 0.10206207261596577f * LOG2E;
#pragma unroll
        for (int m = 0; m < 4; m++)
#pragma unroll
          for (int n = 0; n < 4; n++) acc[m][n] = acc[m][n] * SC;
        epi_store_rows_bf16(acc, rbase, cbase, lds, tid, Q + (size_t)m0 * 384 + n0, 384, 128);
      };
      gemm_tile<false>(rowfn, p.wuq_t + ((size_t)l * 384 + n0) * 256, 256, epi, lds, tid);
    }
  }
  {
    const int NT = 4;
    for (int itx = 0;; itx++) {
      int nt, mt;
      if (!xcd_tile(itx, bid, nb, MT, NT, mt, nt)) break;
      int m0 = mt * 128, n0 = nt * 128;
      auto rowfn = [&](int r) -> const void* { return p.ckvn + (size_t)(m0 + r) * 128; };
      u16* Kb = p.Kb;
      u16* Vt = p.Vt;
      auto epi = [&](f32x4(&acc)[4][4], int rbase, int cbase) {
        EPI_LOOP({
          int c = n0 + col;
          int tk = m0 + row;
          if (c < 256) {
            int h = c >> 6, d = c & 63;
            st_bf4(Kb + (size_t)tk * 384 + h * 96 + d, v);
          } else {
            int cc = c - 256;
            int b = tk / N, nn = tk - b * N;
            u16* dst = Vt + ((size_t)(b * 256 + cc)) * N + nn;
            dst[0] = f2bf(v[0]);
            dst[(size_t)N] = f2bf(v[1]);
            dst[(size_t)2 * N] = f2bf(v[2]);
            dst[(size_t)3 * N] = f2bf(v[3]);
          }
        })
      };
      gemm_tile<false>(rowfn, p.wkv_t + ((size_t)l * 512 + n0) * 128, 128, epi, lds, tid);
    }
  }
  for (int d = 0; d < 2; d++) {
    const int NT = 2;
    for (int itx = 0;; itx++) {
      int nt, mt;
      if (!xcd_tile(itx, bid, nb, MT, NT, mt, nt)) break;
      int m0 = mt * 128, n0 = nt * 128;
      auto rowfn = [&](int r) -> const void* { return p.S1 + (size_t)(m0 + r) * 384 + d * 64; };
      u16* dst = p.dec + (size_t)d * T_SUB * 256;
      const float* w0 = p.rw_w0 + (l * 2 + d) * 256;
      auto epi = [&](f32x4(&acc)[4][4], int rbase, int cbase) {
#pragma unroll
        for (int m = 0; m < 4; m++)
#pragma unroll
          for (int n = 0; n < 4; n++) {
            const int col = cbase + n * 16;
            for (int j = 0; j < 4; j++) acc[m][n][j] = __expf(-0.6065306597126334f * sigm(w0[n0 + col + j] + acc[m][n][j]));
          }
        epi_store_rows_bf16(acc, rbase, cbase, lds, tid, dst + (size_t)m0 * 256 + n0, 256, 128);
      };
      gemm_tile<false>(rowfn, p.wup_t + ((size_t)(l * 2 + d) * 256 + n0) * 64, 64, epi, lds, tid);
    }
  }
  for (int d = 0; d < 2; d++) {
    const int NT = 2;
    for (int itx = 0;; itx++) {
      int nt, mt;
      if (!xcd_tile(itx, bid, nb, MT, NT, mt, nt)) break;
      int m0 = mt * 128, n0 = nt * 128;
      auto rowfn = [&](int r) -> const void* { return p.S1 + (size_t)(m0 + r) * 384 + 128 + d * 64; };
      u16* dka = p.kka + (size_t)d * T_SUB * 256;
      u16* dkt = p.kt + (size_t)d * T_SUB * 256;
      const float* a0 = p.rw_a0 + (l * 2 + d) * 256;
      const float* ka = p.rw_ka + l * 256;
      const u16* kkp = p.kk;
      const u16* ksp = p.ks;
      auto epi = [&](f32x4(&acc)[4][4], int rbase, int cbase) {
#pragma unroll
        for (int m = 0; m < 4; m++)
#pragma unroll
          for (int n = 0; n < 4; n++) {
            const int col = cbase + n * 16;
            const float4 a04 = *(const float4*)(a0 + n0 + col);
            const float av0 = sigm(a04.x + acc[m][n][0]), av1 = sigm(a04.y + acc[m][n][1]);
            const float av2 = sigm(a04.z + acc[m][n][2]), av3 = sigm(a04.w + acc[m][n][3]);
            *(uint2*)(lds + (rbase + m * 16) * 272 + col * 2) = make_uint2(pack2(av0, av1), pack2(av2, av3));
            __builtin_amdgcn_sched_barrier(0);
          }
        __syncthreads();
#pragma unroll 1
        for (int i = 0; i < 8; i++) {
          const int id = tid + 256 * i, row = id >> 4, c = id & 15;
          const size_t o = (size_t)(m0 + row) * 256 + n0 + c * 8;
          const uint4 ar = *(const uint4*)(lds + row * 272 + c * 16);
          const uint4 kkr = *(const uint4*)(kkp + o);
          const uint4 ksr = *(const uint4*)(ksp + o);
          const float4 ka0 = *(const float4*)(ka + n0 + c * 8);
          const float4 ka1 = *(const float4*)(ka + n0 + c * 8 + 4);
          uint4 w1, w2;
#define A_PAIR(AR, KK, KS, KA_LO, KA_HI, W1, W2)                                                     \
  {                                                                                                  \
    const float alo = blo(AR), ahi = bhi(AR);                                                        \
    W1 = pack2(blo(KK) * alo, bhi(KK) * ahi);                                                        \
    W2 = pack2(blo(KS) * (1.f + (alo - 1.f) * (KA_LO)), bhi(KS) * (1.f + (ahi - 1.f) * (KA_HI)));    \
  }
          A_PAIR(ar.x, kkr.x, ksr.x, ka0.x, ka0.y, w1.x, w2.x)
          A_PAIR(ar.y, kkr.y, ksr.y, ka0.z, ka0.w, w1.y, w2.y)
          A_PAIR(ar.z, kkr.z, ksr.z, ka1.x, ka1.y, w1.z, w2.z)
          A_PAIR(ar.w, kkr.w, ksr.w, ka1.z, ka1.w, w1.w, w2.w)
          *(uint4*)(dka + o) = w1;
          *(uint4*)(dkt + o) = w2;
        }
        __syncthreads();
      };
      gemm_tile<false>(rowfn, p.aup_t + ((size_t)(l * 2 + d) * 256 + n0) * 64, 64, epi, lds, tid);
    }
  }
  {
    const int NT = 2;
    for (int itx = 0;; itx++) {
      int nt, mt;
      if (!xcd_tile(itx, bid, nb, MT, NT, mt, nt)) break;
      int m0 = mt * 128, n0 = nt * 128;
      auto rowfn = [&](int r) -> const void* { return p.S1 + (size_t)(m0 + r) * 384 + 256; };
      u16* dst = p.gD;
      auto epi = [&](f32x4(&acc)[4][4], int rbase, int cbase) {
        epi_store_rows_bf16(acc, rbase, cbase, lds, tid, dst + (size_t)m0 * 256 + n0, 256, 128);
      };
      gemm_tile<false>(rowfn, p.gup_t + ((size_t)l * 256 + n0) * 128, 128, epi, lds, tid);
    }
  }
}

DI bf16x8 pack8(const f32x16& s, int o) {
  u32x4_t r = {pack2(s[o], s[o + 1]), pack2(s[o + 2], s[o + 3]), pack2(s[o + 4], s[o + 5]), pack2(s[o + 6], s[o + 7])};
  return __builtin_bit_cast(bf16x8, r);
}

constexpr int AT_KP = 208, AT_VP = 144, AT_BUF = 64 * AT_KP + 64 * AT_VP;
DI void attn_task(const Params& p, int task, int N, char* lds, int tid) {
  const int lane = tid & 63, wv = tid >> 6, r = lane & 31, hf = lane >> 5;
  const int nqb = N >> 7;
  {
    const int qb = task % nqb, bh = task / nqb, h = bh & 3, b = bh >> 2;
    const size_t tb = (size_t)b * N;
    const int q = qb * 128 + wv * 32 + r;
    bf16x8 qf[6];
    {
      const u16* qrow = p.Q + (tb + q) * 384 + h * 96;
#pragma unroll
      for (int ks = 0; ks < 4; ks++) qf[ks] = *(const bf16x8*)(qrow + ks * 16 + hf * 8);
      bf16x8 x1r = *(const bf16x8*)(qrow + 64 + hf * 8);
      bf16x8 x2r = *(const bf16x8*)(qrow + 80 + hf * 8);
      const float* cp = p.ropec + q * 16 + hf * 8;
      const float* sp = p.ropes + q * 16 + hf * 8;
      float ra[8], rb[8];
#pragma unroll
      for (int j = 0; j < 8; j++) {
        float xa = bf2f((u16)x1r[j]), ya = bf2f((u16)x2r[j]);
        float c0 = cp[j], s0 = sp[j];
        ra[j] = xa * c0 - ya * s0;
        rb[j] = xa * s0 + ya * c0;
      }
      u32x4_t o1 = {pack2(ra[0], ra[1]), pack2(ra[2], ra[3]), pack2(ra[4], ra[5]), pack2(ra[6], ra[7])};
      u32x4_t o2 = {pack2(rb[0], rb[1]), pack2(rb[2], rb[3]), pack2(rb[4], rb[5]), pack2(rb[6], rb[7])};
      qf[4] = __builtin_bit_cast(bf16x8, o1);
      qf[5] = __builtin_bit_cast(bf16x8, o2);
    }
    const u16* Kg = p.Kb + tb * 384 + h * 96;
    const u16* Vg = p.Vt + ((size_t)(b * 4 + h) * 64) * N;
    uint4 kr0, kr1, kr2, vr0, vr1;
    const int lkey = tid >> 2, lpart = tid & 3;
    const int lrow = swap23(lkey);
#define AT_GLOAD(kt_)                                                              \
  {                                                                                \
    const u16* kp_ = Kg + (size_t)((kt_) * 64 + lkey) * 384 + lpart * 24;          \
    kr0 = *(const uint4*)(kp_);                                                    \
    kr1 = *(const uint4*)(kp_ + 8);                                                \
    kr2 = *(const uint4*)(kp_ + 16);                                               \
    const u16* vp_ = Vg + (size_t)lkey * N + (kt_) * 64 + lpart * 16;              \
    vr0 = *(const uint4*)(vp_);                                                    \
    vr1 = *(const uint4*)(vp_ + 8);                                                \
  }
#define AT_LSTORE(buf_)                                                            \
  {                                                                                \
    char* Kl_ = lds + (buf_) * AT_BUF;                                             \
    char* Vl_ = Kl_ + 64 * AT_KP;                                                  \
    *(uint4*)(Kl_ + lrow * AT_KP + (lpart * 3 + 0) * 16) = kr0;                    \
    *(uint4*)(Kl_ + lrow * AT_KP + (lpart * 3 + 1) * 16) = kr1;                    \
    *(uint4*)(Kl_ + lrow * AT_KP + (lpart * 3 + 2) * 16) = kr2;                    \
    *(uint4*)(Vl_ + lkey * AT_VP + (lpart * 2 + 0) * 16) = vr0;                    \
    *(uint4*)(Vl_ + lkey * AT_VP + (lpart * 2 + 1) * 16) = vr1;                    \
  }
    f32x16 O0, O1;
#pragma unroll
    for (int i = 0; i < 16; i++) { O0[i] = 0.f; O1[i] = 0.f; }
    float mrun = 0.f, lrun = 0.f;
    const int nt = N >> 6;
    __syncthreads();
    AT_GLOAD(0);
    AT_LSTORE(0);
    __syncthreads();
    for (int kt = 0; kt < nt; kt++) {
      if (kt + 1 < nt) AT_GLOAD(kt + 1);
      __builtin_amdgcn_sched_barrier(0);
      const char* Kl = lds + (kt & 1) * AT_BUF;
      const char* Vl = Kl + 64 * AT_KP;
      f32x16 S0, S1;
      {
        const float nm = -mrun;
#pragma unroll
        for (int i = 0; i < 16; i++) { S0[i] = nm; S1[i] = nm; }
      }
#pragma unroll
      for (int ks = 0; ks < 6; ks++) {
        bf16x8 a0 = *(const bf16x8*)(Kl + r * AT_KP + ks * 32 + hf * 16);
        bf16x8 a1 = *(const bf16x8*)(Kl + (32 + r) * AT_KP + ks * 32 + hf * 16);
        S0 = __builtin_amdgcn_mfma_f32_32x32x16_bf16(a0, qf[ks], S0, 0, 0, 0);
        S1 = __builtin_amdgcn_mfma_f32_32x32x16_bf16(a1, qf[ks], S1, 0, 0, 0);
      }
      float mx = fmaxf(S0[0], S1[0]);
#pragma unroll
      for (int i = 1; i < 16; i++) mx = fmaxf(mx, fmaxf(S0[i], S1[i]));
      if (__any((mx > 12.f) || (kt == 0))) {
        const float mq = fmaxf(mx, __shfl_xor(mx, 32));
        const float shift = (kt == 0) ? mq : ((mq > 12.f) ? mq : 0.f);
        const float sc = (kt == 0) ? 1.f : ex2(-shift);
        mrun += shift;
        lrun *= sc;
#pragma unroll
        for (int i = 0; i < 16; i++) {
          S0[i] -= shift;
          S1[i] -= shift;
          O0[i] *= sc;
          O1[i] *= sc;
        }
      }
      float ls = 0.f;
#pragma unroll
      for (int i = 0; i < 16; i++) {
        S0[i] = ex2(S0[i]);
        S1[i] = ex2(S1[i]);
        ls += S0[i] + S1[i];
      }
      lrun += ls;
#pragma unroll
      for (int sp = 0; sp < 4; sp++) {
        bf16x8 pb = (sp < 2) ? pack8(S0, (sp & 1) * 8) : pack8(S1, (sp & 1) * 8);
        bf16x8 v0 = *(const bf16x8*)(Vl + r * AT_VP + sp * 32 + hf * 16);
        bf16x8 v1 = *(const bf16x8*)(Vl + (32 + r) * AT_VP + sp * 32 + hf * 16);
        O0 = __builtin_amdgcn_mfma_f32_32x32x16_bf16(v0, pb, O0, 0, 0, 0);
        O1 = __builtin_amdgcn_mfma_f32_32x32x16_bf16(v1, pb, O1, 0, 0, 0);
      }
      __builtin_amdgcn_sched_barrier(0);
      if (kt + 1 < nt) AT_LSTORE((kt + 1) & 1);
      __syncthreads();
    }
    float lt = lrun + __shfl_xor(lrun, 32);
    float inv = 1.f / lt;
    u16* orow = p.cat + (tb + q) * 1024 + h * 64;
#pragma unroll
    for (int g = 0; g < 4; g++) {
      int d0 = 8 * g + 4 * hf;
      *(uint2*)(orow + d0) = make_uint2(pack2(O0[4 * g] * inv, O0[4 * g + 1] * inv), pack2(O0[4 * g + 2] * inv, O0[4 * g + 3] * inv));
      *(uint2*)(orow + 32 + d0) = make_uint2(pack2(O1[4 * g] * inv, O1[4 * g + 1] * inv), pack2(O1[4 * g + 2] * inv, O1[4 * g + 3] * inv));
    }
  }
}

DI void na_task(const Params& p, int l, int task, int N, int tid) {
  const int lane = tid & 63, head = tid >> 6, r = lane & 31, hf = lane >> 5;
  const int rows = N >> 6;
  const int nrb = rows >> 1;
  const float* bias = p.na_bias + (size_t)(l * 4 + head) * 15 * 31;
  {
    const int cb = task & 3, rb = (task >> 2) % nrb, b = (task >> 2) / nrb;
    const size_t tb = (size_t)b * N;
    const int qrow0 = rb * 2;
    const int rstart0 = clampi(qrow0 - 4, 0, rows - 8);
    const int k0 = clampi(rstart0, 0, rows - 9);
    const int kstart = clampi(cb * 16 - 8, 0, 32);
    const int iq = r >> 4, u = r & 15;
    const int qrow = qrow0 + iq, qcol = cb * 16 + u;
    const int rstart = clampi(qrow - 4, 0, rows - 8);
    const int cstart = clampi(qcol - 8, 0, 48);
    bf16x8 qf[4];
    {
      const u16* qp = p.z + (tb + qrow * 64 + qcol) * ZLD + ZB_OFF + head * 64;
#pragma unroll
      for (int ks = 0; ks < 4; ks++) qf[ks] = *(const bf16x8*)(qp + ks * 16 + hf * 8);
    }
    f32x16 O0, O1;
#pragma unroll
    for (int i = 0; i < 16; i++) { O0[i] = 0.f; O1[i] = 0.f; }
    float mrun = -1e30f, lrun = 0.f;
    const int wk = swap23(r);
    for (int j = 0; j < 9; j++) {
      const int krow = k0 + j;
      const u16* kp = p.z + (tb + krow * 64 + kstart + wk) * ZLD + ZB_OFF + 256 + head * 64;
      f32x16 S;
#pragma unroll
      for (int i = 0; i < 16; i++) S[i] = 0.f;
#pragma unroll
      for (int ks = 0; ks < 4; ks++) {
        bf16x8 a = *(const bf16x8*)(kp + ks * 16 + hf * 8);
        S = __builtin_amdgcn_mfma_f32_32x32x16_bf16(a, qf[ks], S, 0, 0, 0);
      }
      const bool rok = (krow >= rstart) && (krow < rstart + 8);
      const int drow = clampi(krow - qrow + 7, 0, 14);
      const float* brow = bias + drow * 31;
      float mx = -1e30f;
#pragma unroll
      for (int i = 0; i < 16; i++) {
        int w = 16 * (i >> 3) + 8 * hf + 4 * ((i >> 2) & 1) + (i & 3);
        int kcol = kstart + w;
        bool ok = rok && (kcol >= cstart) && (kcol < cstart + 16);
        int dcol = clampi(kcol - qcol + 15, 0, 30);
        float s = (S[i] * 0.125f + brow[dcol]) * LOG2E;
        S[i] = ok ? s : -1e30f;
        mx = fmaxf(mx, S[i]);
      }
      mx = fmaxf(mx, __shfl_xor(mx, 32));
      float mn = fmaxf(mrun, mx);
      float alpha = ex2(mrun - mn);
      mrun = mn;
      float ls = 0.f;
#pragma unroll
      for (int i = 0; i < 16; i++) {
        float pv = (S[i] > -1e29f) ? ex2(S[i] - mn) : 0.f;
        S[i] = pv;
        ls += pv;
      }
      lrun = lrun * alpha + ls;
#pragma unroll
      for (int i = 0; i < 16; i++) { O0[i] *= alpha; O1[i] *= alpha; }
      const u16* vbase = p.z + (tb + krow * 64 + kstart) * ZLD + ZB_OFF + 512 + head * 64 + r;
#pragma unroll
      for (int s = 0; s < 2; s++) {
        bf16x8 pb = pack8(S, s * 8);
        bf16x8 v0, v1;
#pragma unroll
        for (int jj = 0; jj < 8; jj++) {
          const u16* vp = vbase + (size_t)(16 * s + 8 * hf + jj) * ZLD;
          v0[jj] = (short)vp[0];
          v1[jj] = (short)vp[32];
        }
        O0 = __builtin_amdgcn_mfma_f32_32x32x16_bf16(v0, pb, O0, 0, 0, 0);
        O1 = __builtin_amdgcn_mfma_f32_32x32x16_bf16(v1, pb, O1, 0, 0, 0);
      }
    }
    float lt = lrun + __shfl_xor(lrun, 32);
    float inv = 1.f / lt;
    u16* orow = p.cat + (tb + qrow * 64 + qcol) * 1024 + 256 + head * 64;
#pragma unroll
    for (int g = 0; g < 4; g++) {
      int d0 = 8 * g + 4 * hf;
      *(uint2*)(orow + d0) = make_uint2(pack2(O0[4 * g] * inv, O0[4 * g + 1] * inv), pack2(O0[4 * g + 2] * inv, O0[4 * g + 3] * inv));
      *(uint2*)(orow + 32 + d0) = make_uint2(pack2(O1[4 * g] * inv, O1[4 * g + 1] * inv), pack2(O1[4 * g + 2] * inv, O1[4 * g + 3] * inv));
    }
  }
}

using f32x2 = __attribute__((ext_vector_type(2))) float;
constexpr int SC_STEPS = 16;

DI void sc_store(char* buf, int dst, uint4 R, bool hgw) {
  float4 lo = make_float4(blo(R.x), bhi(R.x), blo(R.y), bhi(R.y));
  float4 hi = make_float4(blo(R.z), bhi(R.z), blo(R.w), bhi(R.w));
  *(float4*)(buf + dst) = lo;
  *(float4*)(buf + dst + 16) = hi;
  if (hgw) {
    *(float4*)(buf + dst + 256) = make_float4(1.f - lo.x, 1.f - lo.y, 1.f - lo.z, 1.f - lo.w);
    *(float4*)(buf + dst + 272) = make_float4(1.f - hi.x, 1.f - hi.y, 1.f - hi.z, 1.f - hi.w);
  }
}

DI float reduce8(float v) {
  v += dpp_f<0xB1>(v);
  v += dpp_f<0x4E>(v);
  v += dpp_f<0x141>(v);
  return v;
}

template <bool RW>
DI void scan_task(const Params& p, int task, int N, char* lds, int tid) {
  constexpr int NA = RW ? 5 : 3;
  constexpr int VOFF = SC_STEPS * NA * 256;
  constexpr int BUF = VOFF + SC_STEPS * 128;
  const int lane = tid & 63, wv = tid >> 6, kq = lane & 7, rg = lane >> 3;
  const int rq = task & 1, hh = (task >> 1) & 3, dir = (task >> 3) & 1, b = task >> 4;
  const size_t tb = (size_t)b * N;
  const int sub = tid >> 7, lt = tid & 127, lstep = lt >> 3, lpart = lt & 7;
  const int vstep = lt >> 2, vq = lt & 3;
  const u16 *src0 = nullptr, *src1 = nullptr, *src2 = nullptr;
  int dst0 = 0, dst1 = 0, dst2 = 0, st0 = 0, st1 = 0, st2 = 0;
  bool act0 = false, act1 = false, act2 = false, hgw = false;
  int ld;
  const int acol = hh * 64 + lpart * 8;
  const int vcol = hh * 64 + rq * 32 + vq * 8;
  const int vdst = VOFF + vstep * 128 + vq * 32;
  if (RW) {
    ld = 256;
    act0 = true; st0 = lstep;
    src0 = sub ? (p.dec + (size_t)dir * T_SUB * 256 + acol) : (p.rs + acol);
    dst0 = (lstep * NA + (sub ? 1 : 0)) * 256 + lpart * 32;
    act1 = true; st1 = lstep;
    src1 = sub ? (p.kk + acol) : (p.kt + (size_t)dir * T_SUB * 256 + acol);
    dst1 = (lstep * NA + (sub ? 3 : 2)) * 256 + lpart * 32;
    if (sub == 0) { act2 = true; st2 = lstep; src2 = p.kka + (size_t)dir * T_SUB * 256 + acol; dst2 = (lstep * NA + 4) * 256 + lpart * 32; }
    else { act2 = lt < 64; st2 = vstep; src2 = p.vs + vcol; dst2 = vdst; }
  } else {
    ld = ZLD;
    act0 = true; st0 = lstep;
    src0 = sub ? (p.z + ZC_OFF + 256 * (1 + dir) + acol) : (p.z + ZC_OFF + acol);
    dst0 = (lstep * NA + (sub ? 1 : 0)) * 256 + lpart * 32;
    hgw = sub != 0;
    if (sub == 0) { act1 = lt < 64; st1 = vstep; src1 = p.z + ZC_OFF + 768 + vcol; dst1 = vdst; }
  }
  u16* pout = (RW ? p.oD : p.oC) + (size_t)dir * T_SUB * 256 + hh * 64 + rq * 32 + wv * 8 + rg;
  pout += (tb + (dir ? (N - 1) : 0)) * 256;
  const int ostride = dir ? -256 : 256;

#define SC_TOK(c_, st_) (tb + (size_t)(dir ? (N - 1 - ((c_) * SC_STEPS + (st_))) : ((c_) * SC_STEPS + (st_))))
#define SC_ISSUE(Ra, Rb, Rc, c_)                                               \
  {                                                                            \
    if (act0) Ra = *(const uint4*)(src0 + SC_TOK(c_, st0) * ld);               \
    if (act1) Rb = *(const uint4*)(src1 + SC_TOK(c_, st1) * ld);               \
    if (act2) Rc = *(const uint4*)(src2 + SC_TOK(c_, st2) * ld);               \
  }
#define SC_STORE(Ra, Rb, Rc, buf_)                                             \
  {                                                                            \
    if (act0) sc_store(buf_, dst0, Ra, hgw);                                   \
    if (act1) sc_store(buf_, dst1, Rb, false);                                 \
    if (act2) sc_store(buf_, dst2, Rc, false);                                 \
  }
  f32x2 S0 = {0.f, 0.f}, S1 = {0.f, 0.f}, S2 = {0.f, 0.f}, S3 = {0.f, 0.f};
#define SC_LD(buf_, s_, ra_, rb_, wa_, wb_, ta_, tb_, ka_, kb_, aa_, ab_, v_)                \
  {                                                                                          \
    const char* rowp_ = (buf_) + (s_) * NA * 256 + kq * 32;                                  \
    ra_ = *(const float4*)(rowp_);                                                           \
    rb_ = *(const float4*)(rowp_ + 16);                                                      \
    wa_ = *(const float4*)(rowp_ + 256);                                                     \
    wb_ = *(const float4*)(rowp_ + 272);                                                     \
    ta_ = *(const float4*)(rowp_ + 512);                                                     \
    tb_ = *(const float4*)(rowp_ + 528);                                                     \
    if (RW) {                                                                                \
      ka_ = *(const float4*)(rowp_ + 768);                                                   \
      kb_ = *(const float4*)(rowp_ + 784);                                                   \
      aa_ = *(const float4*)(rowp_ + 1024);                                                  \
      ab_ = *(const float4*)(rowp_ + 1040);                                                  \
    }                                                                                        \
    v_ = *(const float*)((buf_) + VOFF + (s_) * 128 + (wv * 8 + rg) * 4);                    \
  }
#define F2A(q_) f32x2{(q_).x, (q_).y}
#define F2B(q_) f32x2{(q_).z, (q_).w}
#define SC_COMPUTE(buf_)                                                                     \
  {                                                                                          \
    float oselA = 0.f, oselB = 0.f;                                                          \
    float4 ra, rb, wa, wb, ta, tb_, ka, kb, aa, ab, nra, nrb, nwa, nwb, nta, ntb, nka, nkb, naa, nab; \
    float vv, nvv;                                                                           \
    ka = kb = aa = ab = nka = nkb = naa = nab = make_float4(0.f, 0.f, 0.f, 0.f);             \
    SC_LD(buf_, 0, ra, rb, wa, wb, ta, tb_, ka, kb, aa, ab, vv);                             \
    _Pragma("unroll") for (int s = 0; s < SC_STEPS; s++) {                                   \
      if (s + 1 < SC_STEPS) SC_LD(buf_, s + 1, nra, nrb, nwa, nwb, nta, ntb, nka, nkb, naa, nab, nvv); \
      f32x2 u0 = F2A(ta) * vv, u1 = F2B(ta) * vv, u2 = F2A(tb_) * vv, u3 = F2B(tb_) * vv;     \
      if (RW) {                                                                              \
        f32x2 pa = S0 * F2A(ka), pb = S1 * F2B(ka);                                          \
        pa = S2 * F2A(kb) + pa;                                                              \
        pb = S3 * F2B(kb) + pb;                                                              \
        pa = pa + pb;                                                                        \
        const float sa = -reduce8(pa.x + pa.y);                                              \
        u0 = F2A(aa) * sa + u0;                                                              \
        u1 = F2B(aa) * sa + u1;                                                              \
        u2 = F2A(ab) * sa + u2;                                                              \
        u3 = F2B(ab) * sa + u3;                                                              \
      }                                                                                      \
      S0 = S0 * F2A(wa) + u0;                                                                \
      S1 = S1 * F2B(wa) + u1;                                                                \
      S2 = S2 * F2A(wb) + u2;                                                                \
      S3 = S3 * F2B(wb) + u3;                                                                \
      f32x2 qa = S0 * F2A(ra), qb = S1 * F2B(ra);                                            \
      qa = S2 * F2A(rb) + qa;                                                                \
      qb = S3 * F2B(rb) + qb;                                                                \
      qa = qa + qb;                                                                          \
      const float o = reduce8(qa.x + qa.y);                                                  \
      if (s < 8) oselA = (kq == s) ? o : oselA;                                              \
      else oselB = (kq == s - 8) ? o : oselB;                                                \
      ra = nra; rb = nrb; wa = nwa; wb = nwb; ta = nta; tb_ = ntb;                           \
      ka = nka; kb = nkb; aa = naa; ab = nab; vv = nvv;                                      \
    }                                                                                        \
    pout[kq * ostride] = f2bf(oselA);                                                        \
    pout[(kq + 8) * ostride] = f2bf(oselB);                                                  \
    pout += SC_STEPS * ostride;                                                              \
  }
  uint4 A0 = make_uint4(0, 0, 0, 0), A1 = A0, A2 = A0, B0 = A0, B1 = A0, B2 = A0;
  char* buf0 = lds;
  char* buf1 = lds + BUF;
  const int nch = N / SC_STEPS;
  __syncthreads();
  SC_ISSUE(A0, A1, A2, 0);
  SC_ISSUE(B0, B1, B2, 1);
  SC_STORE(A0, A1, A2, buf0);
  __syncthreads();
  for (int c = 0; c < nch; c += 2) {
    if (c + 2 < nch) SC_ISSUE(A0, A1, A2, c + 2);
    __builtin_amdgcn_sched_barrier(0);
    SC_COMPUTE(buf0);
    __builtin_amdgcn_sched_barrier(0);
    SC_STORE(B0, B1, B2, buf1);
    __syncthreads();
    if (c + 3 < nch) SC_ISSUE(B0, B1, B2, c + 3);
    __builtin_amdgcn_sched_barrier(0);
    SC_COMPUTE(buf1);
    __builtin_amdgcn_sched_barrier(0);
    if (c + 2 < nch) SC_STORE(A0, A1, A2, buf0);
    __syncthreads();
  }
}

template <bool RW>
DI void scan_task16(const Params& p, int task, int N, char* lds, int tid) {
  constexpr int NA = RW ? 5 : 3;
  constexpr int VOFF = SC_STEPS * NA * 256;
  constexpr int BUF = VOFF + SC_STEPS * 64;
  const int lane = tid & 63, wv = tid >> 6, kq = lane & 15, rg = lane >> 4;
  const int rq = task & 3, hh = (task >> 2) & 3, dir = (task >> 4) & 1, b = task >> 5;
  const size_t tb = (size_t)b * N;
  const int sub = tid >> 7, lt = tid & 127, lstep = lt >> 3, lpart = lt & 7;
  const int vstep = lt >> 1, vhalf = lt & 1;
  const u16 *src0 = nullptr, *src1 = nullptr, *src2 = nullptr;
  int dst0 = 0, dst1 = 0, dst2 = 0, st0 = 0, st1 = 0, st2 = 0;
  bool act0 = false, act1 = false, act2 = false, hgw = false;
  int ld;
  const int acol = hh * 64 + lpart * 8;
  const int vcol = hh * 64 + rq * 16 + vhalf * 8;
  const int vdst = VOFF + vstep * 64 + vhalf * 32;
  if (RW) {
    ld = 256;
    act0 = true; st0 = lstep;
    src0 = sub ? (p.dec + (size_t)dir * T_SUB * 256 + acol) : (p.rs + acol);
    dst0 = (lstep * NA + (sub ? 1 : 0)) * 256 + lpart * 32;
    act1 = true; st1 = lstep;
    src1 = sub ? (p.kk + acol) : (p.kt + (size_t)dir * T_SUB * 256 + acol);
    dst1 = (lstep * NA + (sub ? 3 : 2)) * 256 + lpart * 32;
    if (sub == 0) { act2 = true; st2 = lstep; src2 = p.kka + (size_t)dir * T_SUB * 256 + acol; dst2 = (lstep * NA + 4) * 256 + lpart * 32; }
    else { act2 = lt < 32; st2 = vstep; src2 = p.vs + vcol; dst2 = vdst; }
  } else {
    ld = ZLD;
    act0 = true; st0 = lstep;
    src0 = sub ? (p.z + ZC_OFF + 256 * (1 + dir) + acol) : (p.z + ZC_OFF + acol);
    dst0 = (lstep * NA + (sub ? 1 : 0)) * 256 + lpart * 32;
    hgw = sub != 0;
    if (sub == 0) { act1 = lt < 32; st1 = vstep; src1 = p.z + ZC_OFF + 768 + vcol; dst1 = vdst; }
  }
  u16* pout = (RW ? p.oD : p.oC) + (size_t)dir * T_SUB * 256 + hh * 64 + rq * 16 + wv * 4 + rg;
  pout += (tb + (dir ? (N - 1) : 0)) * 256;
  const int ostride = dir ? -256 : 256;

#define SC16_TOK(c_, st_) (tb + (size_t)(dir ? (N - 1 - ((c_) * SC_STEPS + (st_))) : ((c_) * SC_STEPS + (st_))))
#define SC16_ISSUE(Ra, Rb, Rc, c_)                                               \
  {                                                                            \
    if (act0) Ra = *(const uint4*)(src0 + SC16_TOK(c_, st0) * ld);               \
    if (act1) Rb = *(const uint4*)(src1 + SC16_TOK(c_, st1) * ld);               \
    if (act2) Rc = *(const uint4*)(src2 + SC16_TOK(c_, st2) * ld);               \
  }
#define SC16_STORE(Ra, Rb, Rc, buf_)                                             \
  {                                                                            \
    if (act0) sc_store(buf_, dst0, Ra, hgw);                                   \
    if (act1) sc_store(buf_, dst1, Rb, false);                                 \
    if (act2) sc_store(buf_, dst2, Rc, false);                                 \
  }
  f32x2 S01 = {0.f, 0.f}, S23 = {0.f, 0.f};
#define SC16_LD(buf_, s_, r_, w_, t_, k_, a_, v_)                                              \
  {                                                                                          \
    const char* rowp_ = (buf_) + (s_) * NA * 256 + kq * 16;                                  \
    r_ = *(const float4*)(rowp_);                                                            \
    w_ = *(const float4*)(rowp_ + 256);                                                      \
    t_ = *(const float4*)(rowp_ + 512);                                                      \
    if (RW) {                                                                                \
      k_ = *(const float4*)(rowp_ + 768);                                                    \
      a_ = *(const float4*)(rowp_ + 1024);                                                   \
    }                                                                                        \
    v_ = *(const float*)((buf_) + VOFF + (s_) * 64 + (wv * 4 + rg) * 4);                     \
  }
#define SC16_COMPUTE(buf_)                                                                     \
  {                                                                                          \
    float osel = 0.f;                                                                        \
    float4 r4, w4, t4, k4, a4, nr4, nw4, nt4, nk4, na4;                                      \
    float vv, nvv;                                                                           \
    k4 = a4 = nk4 = na4 = make_float4(0.f, 0.f, 0.f, 0.f);                                   \
    SC16_LD(buf_, 0, r4, w4, t4, k4, a4, vv);                                                  \
    _Pragma("unroll") for (int s = 0; s < SC_STEPS; s++) {                                   \
      if (s + 1 < SC_STEPS) SC16_LD(buf_, s + 1, nr4, nw4, nt4, nk4, na4, nvv);                \
      f32x2 ta = f32x2{t4.x, t4.y} * vv, tb2 = f32x2{t4.z, t4.w} * vv;                       \
      if (RW) {                                                                              \
        f32x2 pp = S01 * f32x2{k4.x, k4.y};                                                  \
        pp = S23 * f32x2{k4.z, k4.w} + pp;                                                   \
        const float sa = -reduce16(pp.x + pp.y);                                             \
        ta = f32x2{a4.x, a4.y} * sa + ta;                                                    \
        tb2 = f32x2{a4.z, a4.w} * sa + tb2;                                                  \
      }                                                                                      \
      S01 = S01 * f32x2{w4.x, w4.y} + ta;                                                    \
      S23 = S23 * f32x2{w4.z, w4.w} + tb2;                                                   \
      f32x2 qq = S01 * f32x2{r4.x, r4.y};                                                    \
      qq = S23 * f32x2{r4.z, r4.w} + qq;                                                     \
      const float o = reduce16(qq.x + qq.y);                                                 \
      osel = (kq == s) ? o : osel;                                                           \
      r4 = nr4; w4 = nw4; t4 = nt4; k4 = nk4; a4 = na4; vv = nvv;                            \
    }                                                                                        \
    pout[kq * ostride] = f2bf(osel);                                                         \
    pout += SC_STEPS * ostride;                                                              \
  }
  uint4 A0 = make_uint4(0, 0, 0, 0), A1 = A0, A2 = A0, B0 = A0, B1 = A0, B2 = A0;
  char* buf0 = lds;
  char* buf1 = lds + BUF;
  const int nch = N / SC_STEPS;
  __syncthreads();
  SC16_ISSUE(A0, A1, A2, 0);
  SC16_ISSUE(B0, B1, B2, 1);
  SC16_STORE(A0, A1, A2, buf0);
  __syncthreads();
  for (int c = 0; c < nch; c += 2) {
    if (c + 2 < nch) SC16_ISSUE(A0, A1, A2, c + 2);
    __builtin_amdgcn_sched_barrier(0);
    SC16_COMPUTE(buf0);
    __builtin_amdgcn_sched_barrier(0);
    SC16_STORE(B0, B1, B2, buf1);
    __syncthreads();
    if (c + 3 < nch) SC16_ISSUE(B0, B1, B2, c + 3);
    __builtin_amdgcn_sched_barrier(0);
    SC16_COMPUTE(buf1);
    __builtin_amdgcn_sched_barrier(0);
    if (c + 2 < nch) SC16_STORE(A0, A1, A2, buf0);
    __syncthreads();
  }
}


DI void phase_mix(const Params& p, int l, int B, int N, unsigned* ctr, char* lds, int bid, int nb, int tid) {
  __shared__ int s_task[2];
  const bool wide = (N > 4096);
  const int nper = wide ? B * 32 : B * 16;
  const int nscan = 2 * nper;
  const int nattn = B * 4 * (N >> 7);
  const int nna = B * (N >> 7) * 4;
  const bool prefer_scan = bid < (nb >> 1);
  bool scan_dry = false, attn_dry = false;
  for (;;) {
    if (tid == 0) {
      int kind = -1, task = 0;
      for (int attempt = 0; attempt < 2 && kind < 0; attempt++) {
        const bool try_scan = (attempt == 0) == prefer_scan;
        if (try_scan) {
          if (!scan_dry) {
            const int t = (int)atomicAdd(&ctr[0], 1u);
            if (t < nscan) { kind = 0; task = t; } else scan_dry = true;
          }
        } else {
          if (!attn_dry) {
            const int t = (int)atomicAdd(&ctr[64], 1u);
            if (t < nattn + nna) { kind = 1; task = t; } else attn_dry = true;
          }
        }
      }
      s_task[0] = kind;
      s_task[1] = task;
    }
    __syncthreads();
    const int kind = s_task[0], task = s_task[1];
    __syncthreads();
    if (kind < 0) break;
    if (kind == 0) {
      if (wide) {
        if (task < nper) scan_task16<true>(p, task, N, lds, tid);
        else scan_task16<false>(p, task - nper, N, lds, tid);
      } else {
        if (task < nper) scan_task<true>(p, task, N, lds, tid);
        else scan_task<false>(p, task - nper, N, lds, tid);
      }
    } else {
      if (task < nattn) attn_task(p, task, N, lds, tid);
      else na_task(p, l, task - nattn, N, tid);
    }
  }
}

DI void phase_final(const Params& p, int l, int bid, int nb, int tid) {
  const int lane = tid & 63, wv = tid >> 6, c4 = lane * 4;
  float gn[4], lw[4], lbb[4];
#pragma unroll
  for (int j = 0; j < 4; j++) {
    gn[j] = p.hg_gnorm[l * 256 + c4 + j];
    lw[j] = p.rw_ln_w[l * 256 + c4 + j];
    lbb[j] = p.rw_ln_b[l * 256 + c4 + j];
  }
  for (int t = bid * 4 + wv; t < T_SUB; t += nb * 4) {
    const uint2 ca = *(const uint2*)(p.oC + (size_t)t * 256 + c4);
    const uint2 cb = *(const uint2*)(p.oC + (size_t)(T_SUB + t) * 256 + c4);
    const uint2 cg = *(const uint2*)(p.z + (size_t)t * ZLD + ZC_OFF + 1024 + c4);
    const uint2 da = *(const uint2*)(p.oD + (size_t)t * 256 + c4);
    const uint2 db = *(const uint2*)(p.oD + (size_t)(T_SUB + t) * 256 + c4);
    const float bo = p.bonus[(size_t)t * 4 + (lane >> 4)];
    const uint2 vr = *(const uint2*)(p.vs + (size_t)t * 256 + c4);
    const uint2 gr = *(const uint2*)(p.gD + (size_t)t * 256 + c4);
    {
      float o[4] = {blo(ca.x) + blo(cb.x), bhi(ca.x) + bhi(cb.x), blo(ca.y) + blo(cb.y), bhi(ca.y) + bhi(cb.y)};
      float ss = reduce16(o[0] * o[0] + o[1] * o[1] + o[2] * o[2] + o[3] * o[3]);
      float ri = rsqrtf(ss * (1.f / 64.f) + 1e-6f);
      float g[4] = {blo(cg.x), bhi(cg.x), blo(cg.y), bhi(cg.y)};
      float y[4];
#pragma unroll
      for (int j = 0; j < 4; j++) y[j] = o[j] * ri * gn[j] * (g[j] * sigm(g[j]));
      *(uint2*)(p.cat + (size_t)t * 1024 + 512 + c4) = make_uint2(pack2(y[0], y[1]), pack2(y[2], y[3]));
    }
    {
      float o[4] = {blo(da.x) + blo(db.x), bhi(da.x) + bhi(db.x), blo(da.y) + blo(db.y), bhi(da.y) + bhi(db.y)};
      float mu = reduce16(o[0] + o[1] + o[2] + o[3]) * (1.f / 64.f);
      float d0 = o[0] - mu, d1 = o[1] - mu, d2 = o[2] - mu, d3 = o[3] - mu;
      float var = reduce16(d0 * d0 + d1 * d1 + d2 * d2 + d3 * d3) * (1.f / 64.f);
      float ri = rsqrtf(var + 64e-5f);
      float vv[4] = {blo(vr.x), bhi(vr.x), blo(vr.y), bhi(vr.y)};
      float g[4] = {blo(gr.x), bhi(gr.x), blo(gr.y), bhi(gr.y)};
      float dd[4] = {d0, d1, d2, d3};
      float y[4];
#pragma unroll
      for (int j = 0; j < 4; j++) y[j] = (dd[j] * ri * lw[j] + lbb[j] + bo * vv[j]) * g[j];
      *(uint2*)(p.cat + (size_t)t * 1024 + 768 + c4) = make_uint2(pack2(y[0], y[1]), pack2(y[2], y[3]));
    }
  }
}

DI void phase_wout(const Params& p, int l, int tok0, char* lds, int bid, int nb, int tid) {
  const int NT = 8, MT = T_SUB / 128;
  for (int it = 0;; it++) {
    int nt, mt;
    if (!xcd_tile(it, bid, nb, MT, NT, mt, nt)) break;
    int m0 = mt * 128, n0 = nt * 128;
    auto rowfn = [&](int r) -> const void* { return p.cat + (size_t)(m0 + r) * 1024; };
    auto epi = [&](f32x4(&acc)[4][4], int rbase, int cbase) {
#pragma unroll
      for (int m = 0; m < 4; m++)
#pragma unroll
        for (int n = 0; n < 4; n++)
          *(float4*)(lds + (rbase + m * 16) * 528 + (cbase + n * 16) * 4) = make_float4(acc[m][n][0], acc[m][n][1], acc[m][n][2], acc[m][n][3]);
      __syncthreads();
#pragma unroll 4
      for (int i = 0; i < 16; i++) {
        const int id = tid + 256 * i, row = id >> 5, c = id & 31;
        const int tg = tok0 + m0 + row;
        const float4 a = *(const float4*)(lds + row * 528 + c * 16);
        const float4 xv = *(const float4*)(xin_row(p, l, tg) + n0 + c * 4);
        *(float4*)(p.out + (size_t)tg * 1024 + n0 + c * 4) =
            make_float4(ALPHA_F * xv.x + a.x, ALPHA_F * xv.y + a.y, ALPHA_F * xv.z + a.z, ALPHA_F * xv.w + a.w);
      }
      __syncthreads();
    };
    gemm_tile<false>(rowfn, p.wout_t + ((size_t)l * 1024 + n0) * 1024, 1024, epi, lds, tid);
  }
}

template <bool ROUTER>
DI void phase_ln(const Params& p, const float* g, const float* bta, const float* wrouter, int tok0, int ntok, char* lds,
                 int bid, int nb, int tid) {
  const int lane = tid & 63, wv = tid >> 6;
  float* wl = (float*)lds;
  if (ROUTER) {
    __syncthreads();
    for (int i = tid; i < 16384; i += NTHR) {
      int k = i >> 4, e = i & 15;
      wl[e * 1024 + k] = wrouter[i];
    }
    __syncthreads();
  }
  auto ln_load = [&](float4 (&d)[4], int trow, bool ok) {
#pragma unroll
    for (int i = 0; i < 4; i++) {
      if (!ok) { d[i] = make_float4(0.f, 0.f, 0.f, 0.f); continue; }
      if (ROUTER) {
        d[i] = *(const float4*)(p.out + (size_t)trow * 1024 + i * 256 + lane * 4);
      } else {
        const uint2 r = *(const uint2*)(p.O + (size_t)trow * 1024 + i * 256 + lane * 4);
        d[i] = make_float4(blo(r.x), bhi(r.x), blo(r.y), bhi(r.y));
      }
    }
  };
  float4 x[4], xn[4];
  {
    const int t0 = bid * 4 + wv;
    ln_load(x, tok0 + t0, t0 < ntok);
  }
  for (int t = bid * 4 + wv; t < ntok; t += nb * 4) {
    const int tg = tok0 + t;
    float* xr = p.out + (size_t)tg * 1024;
    {
      const int tn = t + nb * 4;
      ln_load(xn, tok0 + tn, tn < ntok);
    }
    float s = 0.f;
#pragma unroll
    for (int i = 0; i < 4; i++) s += x[i].x + x[i].y + x[i].z + x[i].w;
    float mu = wave_sum(s) * (1.f / 1024.f);
    float vs = 0.f;
#pragma unroll
    for (int i = 0; i < 4; i++) {
      x[i].x -= mu; x[i].y -= mu; x[i].z -= mu; x[i].w -= mu;
      vs += x[i].x * x[i].x + x[i].y * x[i].y + x[i].z * x[i].z + x[i].w * x[i].w;
    }
    float ri = rsqrtf(wave_sum(vs) * (1.f / 1024.f) + 1e-5f);
#pragma unroll
    for (int i = 0; i < 4; i++) {
      float4 gg = *(const float4*)(g + i * 256 + lane * 4);
      float4 bb = *(const float4*)(bta + i * 256 + lane * 4);
      x[i].x = x[i].x * ri * gg.x + bb.x;
      x[i].y = x[i].y * ri * gg.y + bb.y;
      x[i].z = x[i].z * ri * gg.z + bb.z;
      x[i].w = x[i].w * ri * gg.w + bb.w;
      if (!ROUTER) *(float4*)(xr + i * 256 + lane * 4) = x[i];
      *(uint2*)(p.xb + (size_t)tg * 1024 + i * 256 + lane * 4) = make_uint2(pack2(x[i].x, x[i].y), pack2(x[i].z, x[i].w));
    }
    if (ROUTER) {
      float mine = 0.f;
#pragma unroll 2
      for (int e = 0; e < 16; e++) {
        float a = 0.f;
#pragma unroll
        for (int i = 0; i < 4; i++) {
          float4 w = *(const float4*)(wl + e * 1024 + i * 256 + lane * 4);
          a += x[i].x * w.x + x[i].y * w.y + x[i].z * w.z + x[i].w * w.w;
        }
        a = reduce16(a);
        mine = ((lane & 15) == e) ? a : mine;
      }
      mine += __shfl_xor(mine, 16);
      mine += __shfl_xor(mine, 32);
      float mx = mine;
      mx = fmaxf(mx, dpp_f<0xB1>(mx));
      mx = fmaxf(mx, dpp_f<0x4E>(mx));
      mx = fmaxf(mx, dpp_f<0x141>(mx));
      mx = fmaxf(mx, dpp_f<0x140>(mx));
      float ex = __expf(mine - mx);
      float sum = reduce16(ex);
      mine = ex / sum;
      if (lane == 0) p.inv_cnt[tg] = 0;
      if (lane < 16) {
        if (tg < 32768) p.affT[(size_t)lane * 32768 + tg] = mine;
        else p.affT[(size_t)16 * 32768 + (size_t)lane * 65536 + (tg - 32768)] = mine;
      }
    }
#pragma unroll
    for (int i = 0; i < 4; i++) x[i] = xn[i];
  }
}

DI void phase_topk(const Params& p, char* lds, int bid, int nb, int tid) {
  if (bid < 32) {
    unsigned* hist = (unsigned*)lds;
    unsigned* sh = hist + 256;
    unsigned* eqc = sh + 8;
    const int g = bid >> 4, e = bid & 15;
    const int T = g ? 65536 : 32768, cap = T >> 3;
    const int tok0 = g ? 32768 : 0;
    const float* vals = p.affT + (g ? (size_t)16 * 32768 : 0) + (size_t)e * T;
    const float4* v4 = (const float4*)vals;
    const int n4 = T >> 2;
    int* oidx = p.idx + (g ? 65536 : 0) + e * cap;
    float* ogate = p.gate + (g ? 65536 : 0) + e * cap;
    const int slot0 = (g ? 65536 : 0) + e * cap;
    unsigned prefix = 0, mask = 0;
    int remaining = cap;
    for (int pass = 0; pass < 4; pass++) {
      const int shift = 24 - 8 * pass;
      hist[tid] = 0;
      __syncthreads();
      for (int base = 0; base < n4; base += 2048) {
        float4 x[8];
#pragma unroll
        for (int u = 0; u < 8; u++) x[u] = v4[base + u * 256 + tid];
#pragma unroll
        for (int u = 0; u < 8; u++) {
          const unsigned b0 = __float_as_uint(x[u].x), b1 = __float_as_uint(x[u].y), b2 = __float_as_uint(x[u].z), b3 = __float_as_uint(x[u].w);
          if ((b0 & mask) == prefix) atomicAdd(&hist[(b0 >> shift) & 255], 1u);
          if ((b1 & mask) == prefix) atomicAdd(&hist[(b1 >> shift) & 255], 1u);
          if ((b2 & mask) == prefix) atomicAdd(&hist[(b2 >> shift) & 255], 1u);
          if ((b3 & mask) == prefix) atomicAdd(&hist[(b3 >> shift) & 255], 1u);
        }
      }
      __syncthreads();
      if (tid == 0) {
        int cum = 0, sel = 0;
        for (int bq = 255; bq >= 0; bq--) {
          int hc = (int)hist[bq];
          if (cum + hc >= remaining) { sel = bq; break; }
          cum += hc;
        }
        sh[0] = (unsigned)sel;
        sh[1] = (unsigned)(remaining - cum);
        sh[3] = hist[sel];
      }
      __syncthreads();
      prefix |= sh[0] << shift;
      remaining = (int)sh[1];
      mask |= 0xFFu << shift;
      __syncthreads();
    }
    const unsigned thr = prefix;
    const int need = remaining;
    const bool fast = ((int)sh[3] == need);
    if (tid == 0) sh[2] = 0;
    __syncthreads();
    if (fast) {
      for (int base = 0; base < n4; base += 2048) {
        float4 x[8];
#pragma unroll
        for (int u = 0; u < 8; u++) x[u] = v4[base + u * 256 + tid];
#pragma unroll
        for (int u = 0; u < 8; u++) {
          const float xv[4] = {x[u].x, x[u].y, x[u].z, x[u].w};
#pragma unroll
          for (int c = 0; c < 4; c++) {
            if (__float_as_uint(xv[c]) >= thr) {
              const int pos = (int)atomicAdd(&sh[2], 1u);
              const int tok = tok0 + (base + u * 256 + tid) * 4 + c;
              oidx[pos] = tok;
              ogate[pos] = xv[c];
              const int kslot = atomicAdd(&p.inv_cnt[tok], 1);
              p.inv_slot[(size_t)tok * 16 + kslot] = slot0 + pos;
            }
          }
        }
      }
    } else {
      const int ch = T >> 8;
      const float* my = vals + tid * ch;
      int ec = 0;
      for (int i = 0; i < ch; i++) ec += (__float_as_uint(my[i]) == thr) ? 1 : 0;
      eqc[tid] = ec;
      __syncthreads();
      int eq_rank = 0;
      for (int i = 0; i < tid; i++) eq_rank += eqc[i];
      for (int i = 0; i < ch; i++) {
        float v = my[i];
        unsigned u = __float_as_uint(v);
        int pos = -1;
        if (u > thr) {
          pos = (int)atomicAdd(&sh[2], 1u);
        } else if (u == thr) {
          if (eq_rank < need) pos = cap - need + eq_rank;
          eq_rank++;
        }
        if (pos >= 0) {
          const int tok = tok0 + tid * ch + i;
          oidx[pos] = tok;
          ogate[pos] = v;
          const int kslot = atomicAdd(&p.inv_cnt[tok], 1);
          p.inv_slot[(size_t)tok * 16 + kslot] = slot0 + pos;
        }
      }
    }
    __syncthreads();
  }
}

DI void moe_rowinfo(int row0, int l, int& e, int& ioff) {
  if (row0 < 65536) { e = row0 >> 12; }
  else { e = (row0 - 65536) >> 13; }
  ioff = row0;
}

DI void phase_moe1(const Params& p, int l, char* lds, int bid, int nb, int tid) {
  const int NT = 8, MT = 196608 / 128;
  for (int it = 0;; it++) {
    int nt, mt;
    if (!xcd_tile(it, bid, nb, MT, NT, mt, nt)) break;
    int m0 = mt * 128, n0 = nt * 128;
    int e, ioff;
    moe_rowinfo(m0, l, e, ioff);
    const int* ip = p.idx + ioff;
    auto rowfn = [&](int r) -> const void* { return p.xb + (size_t)ip[r] * 1024; };
    u16* H = p.H;
    auto epi = [&](f32x4(&acc)[4][4], int rbase, int cbase) {
#pragma unroll
      for (int m = 0; m < 4; m++)
#pragma unroll
        for (int n = 0; n < 4; n += 2) {
          const int row = rbase + m * 16;
          const int col = cbase + n * 16;
          const int hl = ((col & ~31) >> 1) + (col & 15);
          f32x4 a = acc[m][n], bq = acc[m][n + 1];
          f32x4 o;
          for (int j = 0; j < 4; j++) o[j] = a[j] * sigm(a[j]) * bq[j];
          *(uint2*)(lds + row * 144 + hl * 2) = make_uint2(pack2(o[0], o[1]), pack2(o[2], o[3]));
        }
      __syncthreads();
#pragma unroll
      for (int i = 0; i < 4; i++) {
        const int id = tid + 256 * i, row = id >> 3, c = id & 7;
        *(uint4*)(H + (size_t)(m0 + row) * 512 + (n0 >> 1) + c * 8) = *(const uint4*)(lds + row * 144 + c * 16);
      }
      __syncthreads();
    };
    gemm_tile<false>(rowfn, p.w13_t + ((size_t)(l * 16 + e) * 1024 + n0) * 1024, 1024, epi, lds, tid);
  }
}

DI void phase_moe2(const Params& p, int l, char* lds, int bid, int nb, int tid) {
  TileIter it{bid, nb, 0};
  {
    const int NT = 8, MT = 196608 / 128;
    for (int itx = 0;; itx++) {
      int nt, mt;
      if (!xcd_tile(itx, bid, nb, MT, NT, mt, nt)) break;
      int m0 = mt * 128, n0 = nt * 128;
      int e, ioff;
      moe_rowinfo(m0, l, e, ioff);
      auto rowfn = [&](int r) -> const void* { return p.H + (size_t)(m0 + r) * 512; };
      u16* O = p.O;
      auto epi = [&](f32x4(&acc)[4][4], int rbase, int cbase) {
        epi_store_rows_bf16(acc, rbase, cbase, lds, tid, O + (size_t)m0 * 1024 + n0, 1024, 128);
      };
      gemm_tile<false>(rowfn, p.w2_t + ((size_t)(l * 16 + e) * 1024 + n0) * 512, 512, epi, lds, tid);
    }
  }
  {
    const int NT = 8, MT = T_ALL / 128;
    for (int itx = 0;; itx++) {
      int nt, mt;
      if (!xcd_tile(itx, bid, nb, MT, NT, mt, nt)) break;
      int m0 = mt * 128, n0 = nt * 128;
      auto rowfn = [&](int r) -> const void* {
        int tg = m0 + r;
        return tg < 32768 ? p.p_prompt + ((size_t)l * 32768 + tg) * 256 : p.p_sample + ((size_t)l * 65536 + (tg - 32768)) * 256;
      };
      auto epi = [&](f32x4(&acc)[4][4], int rbase, int cbase) {
        epi_store_rows_bf16(acc, rbase, cbase, lds, tid, (u16*)p.out + (size_t)m0 * 1024 + n0, 1024, 128);
      };
      gemm_tile<true>(rowfn, p.wp_t + ((size_t)l * 1024 + n0) * 256, 256, epi, lds, tid);
    }
  }
}

DI void phase_combine(const Params& p, int bid, int nb, int tid) {
  const int lane = tid & 63, wv = tid >> 6;
  u16* ub = p.H;
  const int stride = nb * 4;
  int t = bid * 4 + wv;
  uint2 xr_[4], xn_[4];
  int cnt = 0, myslot = 0, cntn = 0, myslotn = 0;
#pragma unroll
  for (int i = 0; i < 4; i++) xr_[i] = xn_[i] = make_uint2(0, 0);
  if (t < T_ALL) {
#pragma unroll
    for (int i = 0; i < 4; i++) xr_[i] = *(const uint2*)(p.xb + (size_t)t * 1024 + i * 256 + lane * 4);
    cnt = p.inv_cnt[t];
    myslot = p.inv_slot[(size_t)t * 16 + (lane & 15)];
  }
  for (; t < T_ALL; t += stride) {
    const int tn = t + stride;
    if (tn < T_ALL) {
#pragma unroll
      for (int i = 0; i < 4; i++) xn_[i] = *(const uint2*)(p.xb + (size_t)tn * 1024 + i * 256 + lane * 4);
      cntn = p.inv_cnt[tn];
      myslotn = p.inv_slot[(size_t)tn * 16 + (lane & 15)];
    }
    const float mygate = ((lane & 15) < cnt) ? p.gate[myslot] : 0.f;
    float4 a[4];
#pragma unroll
    for (int i = 0; i < 4; i++)
      a[i] = make_float4(blo(xr_[i].x) * ALPHA_F, bhi(xr_[i].x) * ALPHA_F, blo(xr_[i].y) * ALPHA_F, bhi(xr_[i].y) * ALPHA_F);
    for (int j0 = 0; j0 < cnt; j0 += 4) {
      uint2 r[4][4];
      float g[4];
#pragma unroll
      for (int jj = 0; jj < 4; jj++) {
        const int j = (j0 + jj < cnt) ? (j0 + jj) : j0;
        const int slot = __shfl(myslot, j);
        g[jj] = (j0 + jj < cnt) ? __shfl(mygate, j) : 0.f;
        const u16* orow = p.O + (size_t)slot * 1024 + lane * 4;
#pragma unroll
        for (int i = 0; i < 4; i++) r[jj][i] = *(const uint2*)(orow + i * 256);
      }
#pragma unroll
      for (int jj = 0; jj < 4; jj++)
#pragma unroll
        for (int i = 0; i < 4; i++) {
          a[i].x += g[jj] * blo(r[jj][i].x);
          a[i].y += g[jj] * bhi(r[jj][i].x);
          a[i].z += g[jj] * blo(r[jj][i].y);
          a[i].w += g[jj] * bhi(r[jj][i].y);
        }
    }
#pragma unroll
    for (int i = 0; i < 4; i++)
      *(uint2*)(ub + (size_t)t * 1024 + i * 256 + lane * 4) = make_uint2(pack2(a[i].x, a[i].y), pack2(a[i].z, a[i].w));
#pragma unroll
    for (int i = 0; i < 4; i++) xr_[i] = xn_[i];
    cnt = cntn;
    myslot = myslotn;
  }
}

DI void phase_ple(const Params& p, int l, char* lds, int bid, int nb, int tid) {
  const int NT = 8, MT = T_ALL / 128;
  for (int it = 0;; it++) {
    int nt, mt;
    if (!xcd_tile(it, bid, nb, MT, NT, mt, nt)) break;
    int m0 = mt * 128, n0 = nt * 128;
    auto rowfn = [&](int r) -> const void* { return p.H + (size_t)(m0 + r) * 1024; };
    auto epi = [&](f32x4(&acc)[4][4], int rbase, int cbase) {
#pragma unroll
      for (int m = 0; m < 4; m++)
#pragma unroll
        for (int n = 0; n < 4; n++)
          *(uint2*)(lds + (rbase + m * 16) * 272 + (cbase + n * 16) * 2) =
              make_uint2(pack2(sigm(acc[m][n][0]), sigm(acc[m][n][1])), pack2(sigm(acc[m][n][2]), sigm(acc[m][n][3])));
      __syncthreads();
#pragma unroll 2
      for (int i = 0; i < 8; i++) {
        const int id = tid + 256 * i, row = id >> 4, c = id & 15;
        const size_t o = (size_t)(m0 + row) * 1024 + n0 + c * 8;
        const uint4 sg = *(const uint4*)(lds + row * 272 + c * 16);
        const uint4 ur = *(const uint4*)(p.H + o);
        const uint4 pr = *(const uint4*)((const u16*)p.out + o);
        uint4 w;
        w.x = pack2(blo(ur.x) + blo(sg.x) * blo(pr.x), bhi(ur.x) + bhi(sg.x) * bhi(pr.x));
        w.y = pack2(blo(ur.y) + blo(sg.y) * blo(pr.y), bhi(ur.y) + bhi(sg.y) * bhi(pr.y));
        w.z = pack2(blo(ur.z) + blo(sg.z) * blo(pr.z), bhi(ur.z) + bhi(sg.z) * bhi(pr.z));
        w.w = pack2(blo(ur.w) + blo(sg.w) * blo(pr.w), bhi(ur.w) + bhi(sg.w) * bhi(pr.w));
        *(uint4*)(p.O + o) = w;
      }
      __syncthreads();
    };
    gemm_tile<false>(rowfn, p.wg_t + ((size_t)l * 1024 + n0) * 1024, 1024, epi, lds, tid);
  }
}

#define XB_TMO      128
#define XB_XCNT(j)  (256  + 64 * (j))
#define XB_XSUB(j)  (1280 + 64 * (j))
#define XB_XGEN(j)  (2304 + 64 * (j))
#define XB_TOP      3328
#define XB_TOPGEN   3392
#define XCD_BAR_WORDS 3456
#define XB_SPIN_CAP (1u << 22)
#define LAS __attribute__((address_space(3)))
DI unsigned xb_ld(unsigned* p) { return __hip_atomic_load(p, __ATOMIC_RELAXED, __HIP_MEMORY_SCOPE_AGENT); }
DI unsigned xb_add(unsigned* p, unsigned v) { return __hip_atomic_fetch_add(p, v, __ATOMIC_RELAXED, __HIP_MEMORY_SCOPE_AGENT); }
DI unsigned xb_xcc_id() { return (unsigned)__builtin_amdgcn_s_getreg((3 << 11) | 20) & 0xFu; }
#define XB_SPIN(cond, bar) do { unsigned _sp = 0; while (cond) { __builtin_amdgcn_s_sleep(1); \
    if ((++_sp & 255u) == 0u) { if (xb_ld(&(bar)[XB_TMO])) break; if (_sp > XB_SPIN_CAP) { atomicAdd(&(bar)[XB_TMO], 1u); break; } } } } while (0)
struct XcdBarrier { unsigned* bar; unsigned x; volatile LAS unsigned* st; };
DI XcdBarrier xcd_barrier_post(unsigned* bar, volatile LAS unsigned* st) {
  XcdBarrier b; b.bar = bar; b.x = xb_xcc_id(); b.st = st;
  if (threadIdx.x == 0) (void)xb_add(&bar[XB_XCNT(b.x)], 1u);
  return b;
}
DI void xcd_barrier_complete(unsigned* bar, unsigned x, unsigned& nloc, unsigned& nx) {
  const unsigned G = gridDim.x * gridDim.y * gridDim.z;
  unsigned sum, cnt, mine, sp = 0u;
  for (;;) {
    sum = 0u; cnt = 0u; mine = 0u;
#pragma unroll
    for (unsigned j = 0; j < 16; ++j) { const unsigned c = xb_ld(&bar[XB_XCNT(j)]); sum += c; cnt += (c > 0u) ? 1u : 0u; mine = (j == x) ? c : mine; }
    if (sum == G) break;
    __builtin_amdgcn_s_sleep(1);
    if ((++sp & 255u) == 0u) { if (xb_ld(&bar[XB_TMO])) break; if (sp > XB_SPIN_CAP) { atomicAdd(&bar[XB_TMO], 1u); break; } }
  }
  nloc = mine > 0u ? mine : 1u; nx = cnt > 0u ? cnt : 1u;
}
DI void xcd_barrier(const XcdBarrier& b) {
  asm volatile("s_waitcnt vmcnt(0)" ::: "memory");
  __syncthreads();
  if (threadIdx.x == 0) {
    unsigned* bar = b.bar;
    __builtin_amdgcn_s_waitcnt(0);
    unsigned nloc = b.st[0], nx = b.st[1];
    if (nloc == 0u) { xcd_barrier_complete(bar, b.x, nloc, nx); b.st[0] = nloc; b.st[1] = nx; }
    const unsigned old = xb_add(&bar[XB_XSUB(b.x)], 1u);
    const unsigned gen = old / nloc;
    if (old + 1u == (gen + 1u) * nloc) {
      __builtin_amdgcn_fence(__ATOMIC_RELEASE, "agent");
      asm volatile("s_waitcnt vmcnt(0)" ::: "memory");
      const unsigned og = xb_add(&bar[XB_TOP], 1u);
      const unsigned tg = og / nx;
      if (og + 1u == (tg + 1u) * nx) xb_add(&bar[XB_TOPGEN], 1u);
      else XB_SPIN(xb_ld(&bar[XB_TOPGEN]) == tg, bar);
      __builtin_amdgcn_fence(__ATOMIC_ACQUIRE, "agent");
      xb_add(&bar[XB_XGEN(b.x)], 1u);
      asm volatile("s_waitcnt vmcnt(0)" ::: "memory");
    } else {
      XB_SPIN(xb_ld(&bar[XB_XGEN(b.x)]) == gen, bar);
      __builtin_amdgcn_fence(__ATOMIC_ACQUIRE, "agent");
      asm volatile("s_waitcnt vmcnt(0)" ::: "memory");
    }
  }
  __syncthreads();
}

__global__ void __launch_bounds__(NTHR, 2) mega(Params p) {
  __shared__ __attribute__((aligned(16))) char lds[73728];
  cg::grid_group grid = cg::this_grid();
  const int tid0 = threadIdx.x, bid0 = blockIdx.x, nb = gridDim.x;
  __shared__ uint4 xb_words;
  if (tid0 == 0) xb_words = make_uint4(0u, 0u, 0u, 0u);
  __syncthreads();
  const XcdBarrier xb = xcd_barrier_post(p.bar, (volatile LAS unsigned*)&xb_words);
  int pc = 0;
#define PHASE(...)                                      \
  {                                                     \
    if (pc >= p.pb && pc < p.pe) {                      \
      if (pc > p.pb) {                                  \
        if (p.pe < 0) grid.sync();   \
        xcd_barrier(xb);                                \
      }                                                 \
      int tid = tid0, bid = bid0;                       \
      asm volatile("" : "+v"(tid), "+s"(bid));          \
      __VA_ARGS__;                                      \
    }                                                   \
    pc++;                                               \
  }
  PHASE(phase_convert(p, lds, bid, nb, tid));
  for (int i = 0; i < REP_SYNC; i++) PHASE((void)0);
  for (int l = 0; l < 2; l++) {
    for (int sg = 0; sg < 3; sg++) {
      const int tok0 = sg * T_SUB;
      const int B = sg == 0 ? 4 : 8, N = sg == 0 ? 8192 : 4096;
      PHASE(phase_inproj(p, l, tok0, lds, bid, nb, tid));
#if REP_INPROJ || REP_GEMMS
      PHASE(phase_inproj(p, l, tok0, lds, bid, nb, tid));
#endif
      PHASE(phase_prep(p, l, N, bid, nb, tid));
      PHASE(phase_smallgemm(p, l, B, N, lds, bid, nb, tid));
#if REP_GEMMS
      PHASE(phase_smallgemm(p, l, B, N, lds, bid, nb, tid));
#endif
      PHASE(phase_mix(p, l, B, N, p.bar + XCD_BAR_WORDS + (l * 3 + sg) * 128, lds, bid, nb, tid));
#if REP_MIX
      PHASE(phase_mix(p, l, B, N, p.bar + XCD_BAR_WORDS + (6 + l * 3 + sg) * 128, lds, bid, nb, tid));
#endif
      PHASE(phase_final(p, l, bid, nb, tid));
      PHASE(phase_wout(p, l, tok0, lds, bid, nb, tid));
      PHASE(phase_ln<true>(p, p.ln1_g + l * 1024, p.ln1_b + l * 1024, p.moe_router + (size_t)l * 16384, tok0, T_SUB, lds, bid, nb, tid));
    }
    PHASE(phase_topk(p, lds, bid, nb, tid));
    PHASE(phase_moe1(p, l, lds, bid, nb, tid));
#if REP_MOE1 || REP_GEMMS
    PHASE(phase_moe1(p, l, lds, bid, nb, tid));
#endif
    PHASE(phase_moe2(p, l, lds, bid, nb, tid));
#if REP_GEMMS
    PHASE(phase_moe2(p, l, lds, bid, nb, tid));
#endif
    PHASE(phase_combine(p, bid, nb, tid));
    PHASE(phase_ple(p, l, lds, bid, nb, tid));
    PHASE(phase_ln<false>(p, p.ln2_g + l * 1024, p.ln2_b + l * 1024, nullptr, 0, T_ALL, lds, bid, nb, tid));
  }
}

#define N_PHASES 1000
#ifndef FUSED
#define FUSED 1
#endif

extern "C" void kernel_launch(void* const* d_in, const int* in_sizes, int n_in, void* d_out, int out_size, void* d_ws,
                              size_t ws_size, hipStream_t stream) {
  static int grid_blocks = 0;
  if (!grid_blocks) {
    int dev = 0, cus = 0, per_cu = 0;
    (void)hipGetDevice(&dev);
    (void)hipDeviceGetAttribute(&cus, hipDeviceAttributeMultiprocessorCount, dev);
    (void)hipOccupancyMaxActiveBlocksPerMultiprocessor(&per_cu, mega, NTHR, 0);
    if (per_cu > 2) per_cu = 2;
    if (per_cu < 1) per_cu = 1;
    grid_blocks = cus * per_cu;
  }
  Params p;
  memset(&p, 0, sizeof(p));
  const float* const* in = (const float* const*)d_in;
  int k = 0;
  p.x_prompt = in[k++]; p.x_sample = in[k++]; p.p_prompt = in[k++]; p.p_sample = in[k++];
  p.w_in = in[k++]; p.mla_gq = in[k++]; p.mla_gkv = in[k++]; p.mla_wuq = in[k++]; p.mla_wuk = in[k++]; p.mla_wuv = in[k++];
  p.na_bias = in[k++]; p.hg_lb = in[k++]; p.hg_gnorm = in[k++];
  p.rw_mu = in[k++]; p.rw_w0 = in[k++]; p.rw_w_up = in[k++]; p.rw_a0 = in[k++]; p.rw_a_up = in[k++]; p.rw_g_up = in[k++];
  p.rw_kk = in[k++]; p.rw_ka = in[k++]; p.rw_rk = in[k++]; p.rw_ln_w = in[k++]; p.rw_ln_b = in[k++];
  p.w_out = in[k++]; p.ln1_g = in[k++]; p.ln1_b = in[k++]; p.moe_router = in[k++]; p.moe_w1 = in[k++]; p.moe_w3 = in[k++];
  p.moe_w2 = in[k++]; p.ln2_g = in[k++]; p.ln2_b = in[k++]; p.ple_gate = in[k++]; p.ple_proj = in[k++];
  p.out = (float*)d_out;
  char* ws = (char*)d_ws;
  size_t off = 0;
  auto take = [&](size_t bytes) { char* r = ws + off; off += (bytes + 255) & ~(size_t)255; return r; };
  p.w_in_t = (u16*)take((size_t)2 * 3712 * 1024 * 2);
  p.wuq_t = (u16*)take((size_t)2 * 384 * 256 * 2);
  p.wkv_t = (u16*)take((size_t)2 * 512 * 128 * 2);
  p.wup_t = (u16*)take((size_t)4 * 256 * 64 * 2);
  p.aup_t = (u16*)take((size_t)4 * 256 * 64 * 2);
  p.gup_t = (u16*)take((size_t)2 * 256 * 128 * 2);
  p.wout_t = (u16*)take((size_t)2 * 1024 * 1024 * 2);
  p.w13_t = (u16*)take((size_t)32 * 1024 * 1024 * 2);
  p.w2_t = (u16*)take((size_t)32 * 1024 * 512 * 2);
  p.wg_t = (u16*)take((size_t)2 * 1024 * 1024 * 2);
  p.wp_t = (u16*)take((size_t)2 * 1024 * 256 * 2);
  p.ropec = (float*)take((size_t)8192 * 16 * 4);
  p.ropes = (float*)take((size_t)8192 * 16 * 4);
  p.lb = (float*)take(1024 * 4);
  p.affT = (float*)take((size_t)16 * T_ALL * 4);
  p.gate = (float*)take((size_t)196608 * 4);
  p.idx = (int*)take((size_t)196608 * 4);
  p.bar = (unsigned*)take((size_t)(XCD_BAR_WORDS + 12 * 128) * 4);
  p.inv_cnt = (int*)take((size_t)T_ALL * 4);
  p.inv_slot = (int*)take((size_t)T_ALL * 16 * 4);
  p.xb = (u16*)take((size_t)T_ALL * 1024 * 2);
  const size_t stage0 = off;
  p.z = (u16*)take((size_t)T_SUB * ZLD * 2);
  p.cat = (u16*)take((size_t)T_SUB * 1024 * 2);
  p.Q = (u16*)take((size_t)T_SUB * 384 * 2);
  p.Kb = (u16*)take((size_t)T_SUB * 384 * 2);
  p.Vt = (u16*)take((size_t)T_SUB * 256 * 2);
  p.cqn = (u16*)take((size_t)T_SUB * 256 * 2);
  p.ckvn = (u16*)take((size_t)T_SUB * 128 * 2);
  p.S1 = (u16*)take((size_t)T_SUB * 384 * 2);
  p.rs = (u16*)take((size_t)T_SUB * 256 * 2);
  p.ks = (u16*)take((size_t)T_SUB * 256 * 2);
  p.vs = (u16*)take((size_t)T_SUB * 256 * 2);
  p.kk = (u16*)take((size_t)T_SUB * 256 * 2);
  p.gD = (u16*)take((size_t)T_SUB * 256 * 2);
  p.dec = (u16*)take((size_t)2 * T_SUB * 256 * 2);
  p.kka = (u16*)take((size_t)2 * T_SUB * 256 * 2);
  p.kt = (u16*)take((size_t)2 * T_SUB * 256 * 2);
  p.oC = (u16*)take((size_t)2 * T_SUB * 256 * 2);
  p.oD = (u16*)take((size_t)2 * T_SUB * 256 * 2);
  p.bonus = (float*)take((size_t)T_SUB * 4 * 4);
  off = stage0;
  p.O = (u16*)take((size_t)196608 * 1024 * 2);
  p.H = (u16*)take((size_t)196608 * 512 * 2);
  for (int i = 0; i < 16; i++) p.inv_freq[i] = pow(10000.0, -(double)i / 16.0);
  (void)hipMemsetAsync(p.bar, 0, (size_t)(XCD_BAR_WORDS + 12 * 128) * 4, stream);
#if FUSED
  p.pb = 0;
  p.pe = N_PHASES;
  {
    void* args[] = {&p};
    hipError_t e = hipLaunchCooperativeKernel((void*)mega, dim3(grid_blocks), dim3(NTHR), args, 0, stream);
    if (e != hipSuccess) fprintf(stderr, "cooperative launch failed: %s (grid %d)\n", hipGetErrorString(e), grid_blocks);
  }
#else
  for (int ph = 0; ph < N_PHASES; ph++) {
    p.pb = ph;
    p.pe = ph + 1;
    void* args[] = {&p};
    hipError_t e = hipLaunchCooperativeKernel((void*)mega, dim3(grid_blocks), dim3(NTHR), args, 0, stream);
    if (e != hipSuccess) fprintf(stderr, "cooperative launch failed: %s (grid %d)\n", hipGetErrorString(e), grid_blocks);
  }
#endif
}
```
